# Optimizing an MI355X kernel written in HIP

```python
import math
import jax, jax.numpy as jnp
from jax import lax
import numpy as np

D_MODEL = 1024
BATCH = 4
SEQ = 4096
DEPTH = 2

HEAD_DIM = 64
EPS = 1e-6
DA_HEADS = 4
DA_QK = HEAD_DIM
DA_V = 2 * HEAD_DIM
DA_WIDTH = DA_HEADS * DA_V
Q_BLOCK = 128
ROPE_THETA = 500000.0
ROT_DIM = HEAD_DIM // 4
SC_WIDTH = 256
SC_GROUPS = 4
CONV_W = 3
GLA_HEADS = 4
GLA_DK = 32
GLA_DV = 64
GLA_KW = GLA_HEADS * GLA_DK
GLA_VW = GLA_HEADS * GLA_DV
GLA_GATE_RANK = 16
GLA_GATE_TEMP = 16.0
GLA_CHUNK = 64
MIX_WIDTH = DA_WIDTH + SC_WIDTH + GLA_VW
IN_SIZES = (DA_HEADS * 2 * DA_QK, DA_HEADS * 2 * DA_QK, DA_WIDTH,
            SC_WIDTH, SC_WIDTH, SC_WIDTH,
            GLA_KW, GLA_KW, GLA_VW, GLA_VW, GLA_GATE_RANK)
IN_WIDTH = 3088
PEER_HEADS = 8
PEER_NKEYS = 128
PEER_EXPERTS = PEER_NKEYS * PEER_NKEYS
PEER_HALF = 128
PEER_QDIM = 2 * PEER_HALF
PEER_TOPK = 16
PEER_TOKEN_BLOCK = 128

kernel_name = "hymba_style_diffattn_shortconv_gla_peer"


def rmsnorm(x, g):
    xf = x.astype(jnp.float32)
    y = xf * lax.rsqrt(jnp.mean(xf * xf, axis=-1, keepdims=True) + EPS)
    return (y * g.astype(jnp.float32)).astype(x.dtype)


def rope_tables(positions):
    inv = ROPE_THETA ** (-jnp.arange(0, ROT_DIM, 2, dtype=jnp.float32) / ROT_DIM)
    ang = positions.astype(jnp.float32)[..., None] * inv
    return jnp.cos(ang), jnp.sin(ang)


def apply_partial_rope(t, cos, sin):
    rot, rest = t[..., :ROT_DIM], t[..., ROT_DIM:]
    r1, r2 = rot[..., :ROT_DIM // 2], rot[..., ROT_DIM // 2:]
    c = cos[:, :, None, None, :].astype(t.dtype)
    s = sin[:, :, None, None, :].astype(t.dtype)
    return jnp.concatenate([r1 * c - r2 * s, r1 * s + r2 * c, rest], axis=-1)


def diff_attention(q, k, v, lam, out_scale, gain):
    B, S = q.shape[0], q.shape[1]
    nblk = S // Q_BLOCK
    qb = q.reshape(B, nblk, Q_BLOCK, DA_HEADS, 2, DA_QK).transpose(1, 0, 2, 3, 4, 5)
    kpos = jnp.arange(S)
    scale = DA_QK ** -0.5

    def block(args):
        qi, bi = args
        s = jnp.einsum('bqhmd,bkhmd->bhmqk', qi, k).astype(jnp.float32) * scale
        qpos = bi * Q_BLOCK + jnp.arange(Q_BLOCK)
        mask = kpos[None, :] <= qpos[:, None]
        p = jax.nn.softmax(jnp.where(mask, s, -jnp.inf), axis=-1)
        a = p[:, :, 0] - lam * p[:, :, 1]
        return jnp.einsum('bhqk,bkhe->bqhe', a.astype(v.dtype), v)

    o = lax.map(block, (qb, jnp.arange(nblk)))
    o = o.transpose(1, 0, 2, 3, 4).reshape(B, S, DA_HEADS, DA_V)
    o = rmsnorm(o, gain) * out_scale
    return o.reshape(B, S, DA_WIDTH)


def short_conv(b_gate, c_gate, h_in, w):
    z = c_gate * h_in
    S = z.shape[1]
    zp = jnp.pad(z, ((0, 0), (CONV_W - 1, 0), (0, 0)))
    y = w[0] * zp[:, 0:S]
    for j in range(1, CONV_W):
        y = y + w[j] * zp[:, j:j + S]
    return b_gate * y


def gla(q, k, v, log_a):
    B, S = q.shape[0], q.shape[1]
    nc = S // GLA_CHUNK

    def chunks(t):
        return t.astype(jnp.float32).reshape(B, nc, GLA_CHUNK, GLA_HEADS, t.shape[-1]).transpose(1, 0, 3, 2, 4)

    qc, kc, vc, ac = chunks(q * (GLA_DK ** -0.5)), chunks(k), chunks(v), chunks(log_a)
    causal = jnp.tril(jnp.ones((GLA_CHUNK, GLA_CHUNK), dtype=bool))

    def step(state, inp):
        qi, ki, vi, ai = inp
        b = lax.cumsum(ai, axis=2)
        diff = b[:, :, :, None, :] - b[:, :, None, :, :]
        decay = jnp.exp(jnp.where(causal[:, :, None], diff, -jnp.inf))
        attn = jnp.sum(qi[:, :, :, None, :] * ki[:, :, None, :, :] * decay, axis=-1)
        o = jnp.einsum('bhij,bhje->bhie', attn, vi) + jnp.einsum('bhid,bhde->bhie', qi * jnp.exp(b), state)
        b_last = b[:, :, -1:, :]
        state = jnp.exp(b_last[:, :, 0, :, None]) * state + jnp.einsum(
            'bhjd,bhje->bhde', ki * jnp.exp(b_last - b), vi)
        return state, o

    state0 = jnp.zeros((B, GLA_HEADS, GLA_DK, GLA_DV), jnp.float32)
    _, o = lax.scan(step, state0, (qc, kc, vc, ac))
    o = o.transpose(1, 0, 3, 2, 4).reshape(B, S, GLA_HEADS, GLA_DV)
    return o.astype(v.dtype)


def peer(xn, w_q, keys1, keys2, u, v):
    B, S, D = xn.shape
    T = B * S
    xt = xn.reshape(T, D)
    q = (xt @ w_q).reshape(T, PEER_HEADS, 2, PEER_HALF)
    s1 = jnp.einsum('thd,nd->thn', q[:, :, 0], keys1).astype(jnp.float32)
    s2 = jnp.einsum('thd,nd->thn', q[:, :, 1], keys2).astype(jnp.float32)
    v1, i1 = lax.top_k(s1, PEER_TOPK)
    v2, i2 = lax.top_k(s2, PEER_TOPK)
    cand = (v1[..., :, None] + v2[..., None, :]).reshape(T, PEER_HEADS, PEER_TOPK * PEER_TOPK)
    sc, ci = lax.top_k(cand, PEER_TOPK)
    e1 = jnp.take_along_axis(i1, ci // PEER_TOPK, axis=-1)
    e2 = jnp.take_along_axis(i2, ci % PEER_TOPK, axis=-1)
    hk = PEER_HEADS * PEER_TOPK
    experts = (e1 * PEER_NKEYS + e2).reshape(T, hk)
    gates = jax.nn.softmax(sc, axis=-1).reshape(T, hk).astype(xn.dtype)
    nb = T // PEER_TOKEN_BLOCK

    def block(args):
        xb, eb, gb = args
        ub = jnp.take(u, eb, axis=0)
        hb = jax.nn.gelu(jnp.einsum('tkd,td->tk', ub, xb), approximate=False)
        vb = jnp.take(v, eb, axis=0)
        return jnp.einsum('tk,tkd->td', gb * hb, vb)

    out = lax.map(block, (xt.reshape(nb, PEER_TOKEN_BLOCK, D),
                          experts.reshape(nb, PEER_TOKEN_BLOCK, hk),
                          gates.reshape(nb, PEER_TOKEN_BLOCK, hk)))
    return out.reshape(B, S, D)


def setup_inputs(seed: int = 0) -> dict:
    key = jax.random.key(seed)
    ks = jax.random.split(key, 24)
    f32 = jnp.float32
    L, D = DEPTH, D_MODEL
    nrm = lambda k, shape, s: jax.random.normal(k, shape, f32) * s
    return {
        "x": jax.random.normal(ks[0], (BATCH, SEQ, D), f32),
        "positions": jnp.broadcast_to(jnp.arange(SEQ, dtype=jnp.int32), (BATCH, SEQ)),
        "norm_mix": 1.0 + nrm(ks[1], (L, D), 0.02),
        "w_in": nrm(ks[2], (L, D, IN_WIDTH), D ** -0.5),
        "lam_q1": nrm(ks[3], (L, DA_QK), 0.1),
        "lam_k1": nrm(ks[4], (L, DA_QK), 0.1),
        "lam_q2": nrm(ks[5], (L, DA_QK), 0.1),
        "lam_k2": nrm(ks[6], (L, DA_QK), 0.1),
        "diff_norm": 1.0 + nrm(ks[7], (L, DA_V), 0.02),
        "conv_w": nrm(ks[8], (L, CONV_W, SC_WIDTH), CONV_W ** -0.5),
        "gla_w_gate2": nrm(ks[9], (L, GLA_GATE_RANK, GLA_KW), GLA_GATE_RANK ** -0.5),
        "gla_b_gate": nrm(ks[10], (L, GLA_KW), 0.1),
        "gla_norm": 1.0 + nrm(ks[11], (L, GLA_DV), 0.02),
        "w_out": nrm(ks[12], (L, MIX_WIDTH, D), MIX_WIDTH ** -0.5),
        "norm_ffn": 1.0 + nrm(ks[13], (L, D), 0.02),
        "peer_w_q": nrm(ks[14], (L, D, PEER_HEADS * PEER_QDIM), D ** -0.5),
        "peer_keys1": nrm(ks[15], (L, PEER_NKEYS, PEER_HALF), PEER_HALF ** -0.5),
        "peer_keys2": nrm(ks[16], (L, PEER_NKEYS, PEER_HALF), PEER_HALF ** -0.5),
        "peer_u": nrm(ks[17], (L, PEER_EXPERTS, D), D ** -0.5),
        "peer_v": nrm(ks[18], (L, PEER_EXPERTS, D), (PEER_HEADS * PEER_TOPK) ** -0.5),
        "norm_final": 1.0 + nrm(ks[19], (D,), 0.02),
    }


def reference(x, positions, norm_mix, w_in, lam_q1, lam_k1, lam_q2, lam_k2, diff_norm,
              conv_w, gla_w_gate2, gla_b_gate, gla_norm, w_out, norm_ffn, peer_w_q,
              peer_keys1, peer_keys2, peer_u, peer_v, norm_final):
    B, S, _ = x.shape
    cos, sin = rope_tables(positions)
    split_points = [int(p) for p in np.cumsum(IN_SIZES)[:-1]]
    for i in range(DEPTH):
        h = rmsnorm(x, norm_mix[i])
        proj = h @ w_in[i]
        (da_q, da_k, da_v, sc_b, sc_c, sc_h,
         g_q, g_k, g_v, g_r, g_lr) = jnp.split(proj, split_points, axis=-1)

        lam_init = 0.8 - 0.6 * math.exp(-0.3 * i)
        lam = (jnp.exp(jnp.sum(lam_q1[i].astype(jnp.float32) * lam_k1[i].astype(jnp.float32)))
               - jnp.exp(jnp.sum(lam_q2[i].astype(jnp.float32) * lam_k2[i].astype(jnp.float32)))
               + lam_init)
        q = apply_partial_rope(da_q.reshape(B, S, DA_HEADS, 2, DA_QK), cos, sin)
        k = apply_partial_rope(da_k.reshape(B, S, DA_HEADS, 2, DA_QK), cos, sin)
        o_da = diff_attention(q, k, da_v.reshape(B, S, DA_HEADS, DA_V), lam,
                              1.0 - lam_init, diff_norm[i])

        o_sc = short_conv(sc_b, sc_c, sc_h, conv_w[i])

        log_a = jax.nn.log_sigmoid((g_lr @ gla_w_gate2[i] + gla_b_gate[i]).astype(jnp.float32)) / GLA_GATE_TEMP
        o_g = gla(g_q.reshape(B, S, GLA_HEADS, GLA_DK), g_k.reshape(B, S, GLA_HEADS, GLA_DK),
                  g_v.reshape(B, S, GLA_HEADS, GLA_DV), log_a.reshape(B, S, GLA_HEADS, GLA_DK))
        o_g = rmsnorm(o_g, gla_norm[i]) * jax.nn.silu(g_r.reshape(B, S, GLA_HEADS, GLA_DV))
        o_g = o_g.reshape(B, S, GLA_VW)

        mixed = jnp.concatenate([o_da, o_sc, o_g], axis=-1)
        x = x + mixed @ w_out[i]

        x = x + peer(rmsnorm(x, norm_ffn[i]), peer_w_q[i], peer_keys1[i], peer_keys2[i],
                     peer_u[i], peer_v[i])
    return rmsnorm(x, norm_final)
```

```cpp
#define MK_PER_PHASE 1
#define MK_DEBUG 0
#include <hip/hip_runtime.h>
#include <cstdio>
#include <cstdint>
template <int MASK> __device__ __forceinline__ int xl_swz_i(int v) { static_assert(MASK >= 1 && MASK < 32, "ds_swizzle bit mode works inside 32-lane groups");
    return __builtin_amdgcn_ds_swizzle(v, 0x1f | (MASK << 10)); }
template <int MASK> __device__ __forceinline__ float xl_swz(float v) { return __builtin_bit_cast(float, xl_swz_i<MASK>(__builtin_bit_cast(int, v))); }
__device__ __forceinline__ float xl_sum32(float v) {
    unsigned a = __builtin_bit_cast(unsigned, v), b = a; asm volatile("" : "+v"(b));
    auto r = __builtin_amdgcn_permlane32_swap(a, b, false, false);
    const unsigned r0 = r[0], r1 = r[1];
    return __builtin_bit_cast(float, r0) + __builtin_bit_cast(float, r1); }
__device__ __forceinline__ int xl_xor32_i(int v, int hi  ) {
    unsigned a = (unsigned)v, b = a; asm volatile("" : "+v"(b));
    auto r = __builtin_amdgcn_permlane32_swap(a, b, false, false); return hi ? (int)r[0] : (int)r[1]; }
__device__ __forceinline__ float xl_wave_sum(float v) {
    v += xl_swz<1>(v); v += xl_swz<2>(v); v += xl_swz<4>(v); v += xl_swz<8>(v); v += xl_swz<16>(v); return xl_sum32(v); }
namespace pg8 {
#define PG8_LAS __attribute__((address_space(3)))
typedef unsigned short bf16_t;
typedef short bf16x8 __attribute__((ext_vector_type(8)));
typedef float f32x4 __attribute__((ext_vector_type(4)));
typedef unsigned u32x4 __attribute__((ext_vector_type(4)));
constexpr int BM = 256, BK = 64, HALF = 128, HTB = HALF * BK * 2  , STAGE_BYTES = 8 * HTB, NXCD = 8, WGM = 8;

__host__ __device__ __forceinline__ int lds_byte(int r, int c) { const int st = (r >> 4) * 2 + (c >> 5), rr = r & 15, cc = c & 31, ob = rr * 64 + cc * 2; return st * 1024 + (ob ^ (((ob >> 9) & 1) << 5)); }
__host__ __device__ __forceinline__ void stage_rc(int b, int& R, int& C) { const int st = b / 1024, sb = b % 1024, swz = sb ^ (((sb >> 9) & 1) << 5); R = (st >> 1) * 16 + swz / 64; C = (st & 1) * 32 + (swz % 64) / 2; }
__host__ __device__ __forceinline__ int perm32(int rho) { const int n = rho >> 4, i = rho & 15; return 8 * (i >> 2) + 4 * n + (i & 3); }

struct Unit { int pm, pn; };
struct Gemm { const bf16_t* A; const bf16_t* Bt; int M, N, K; };

struct StaticOrder {
    int nM, nN, nwg, G, c;
    __host__ __device__ void init(int M, int N, int G_, int c_) { nM = M / BM; nN = N / BM; nwg = nM * nN; G = G_; c = c_; }
    __host__ __device__ bool next(int i, Unit& u) const {
        const long L = (long)i * G + c; if (L >= nwg) return false;
        int wgid = (int)L; { const int q = nwg / NXCD, r = nwg % NXCD, xcd = wgid % NXCD, off = wgid / NXCD; wgid = (xcd < r ? xcd * (q + 1) : r * (q + 1) + (xcd - r) * q) + off; }
        const int nig = WGM * nN, gid = wgid / nig, fm = gid * WGM, gsz = (nM - fm) < WGM ? (nM - fm) : WGM;
        u.pm = fm + ((wgid % nig) % gsz); u.pn = (wgid % nig) / gsz; return true;
    }
    __device__ __forceinline__ void a_ready(const Unit&) const {}
    __device__ __forceinline__ void done(const Unit&) const {}
};
__device__ __forceinline__ unsigned cvt_pk_bf16(float lo, float hi) { unsigned r; asm volatile("v_cvt_pk_bf16_f32 %0, %1, %2" : "=v"(r) : "v"(lo), "v"(hi)); return r; }
typedef float f32x2 __attribute__((ext_vector_type(2)));
__device__ __forceinline__ float row_rstd(const float* ssq, int r) {
    const f32x4* p = (const f32x4*)(ssq + (size_t)r * 16);
    const f32x4 a = p[0], b = p[1], c = p[2], d = p[3];
    const float s = ((a[0] + a[1]) + (a[2] + a[3])) + ((b[0] + b[1]) + (b[2] + b[3])) + ((c[0] + c[1]) + (c[2] + c[3])) + ((d[0] + d[1]) + (d[2] + d[3]));
    return 1.0f / sqrtf(s * (1.0f / 1024.0f) + 1e-6f);
}
template <bool ROPE> struct EpiScale {
    static constexpr bool PERM = true, AFTER_DRAIN = false;
    bf16_t* O; int ldc; const float* ssq; const float* cs; const float* sn; float qscale;
    __device__ __forceinline__ void operator()(const f32x4 (&acc)[2][2][4][2], const Unit& u, int wr, int wc, int fr, int fq) const {
        const int row0 = u.pm * BM + wr * 64 + fr; const int col0 = u.pn * BM + wc * 32 + 8 * fq;
        const bool rope = ROPE && (u.pn < 4) && ((wc & 1) == 0);
        const float sc = (ROPE && u.pn < 2) ? qscale : 1.0f;
#pragma unroll
        for (int ai = 0; ai < 2; ++ai)
#pragma unroll
            for (int m = 0; m < 4; ++m) {
                const int r = row0 + ai * HALF + m * 16;
                const float rs = row_rstd(ssq, r) * sc;
                f32x4 c0 = (f32x4){1.f, 1.f, 1.f, 1.f}, c1 = c0, s0 = (f32x4){0.f, 0.f, 0.f, 0.f}, s1 = s0;
                if (rope && fq < 2) { c0 = *(const f32x4*)(cs + (size_t)r * 8); c1 = *(const f32x4*)(cs + (size_t)r * 8 + 4); s0 = *(const f32x4*)(sn + (size_t)r * 8); s1 = *(const f32x4*)(sn + (size_t)r * 8 + 4);
                    if (fq == 0) { s0 = -s0; s1 = -s1; } }
                bf16_t* rowp = O + (size_t)r * ldc + col0;
#pragma unroll
                for (int bj = 0; bj < 2; ++bj) {
                    f32x4 v0 = acc[ai][bj][m][0] * rs, v1 = acc[ai][bj][m][1] * rs;
                    if (rope) {
                        f32x4 o0, o1;
#pragma unroll
                        for (int i = 0; i < 4; ++i) { o0[i] = xl_swz<16>(v0[i]); o1[i] = xl_swz<16>(v1[i]); }
                        v0 = v0 * c0 + o0 * s0; v1 = v1 * c1 + o1 * s1;
                    }
                    u32x4 w; w.x = cvt_pk_bf16(v0[0], v0[1]); w.y = cvt_pk_bf16(v0[2], v0[3]); w.z = cvt_pk_bf16(v1[0], v1[1]); w.w = cvt_pk_bf16(v1[2], v1[3]);
                    *(u32x4*)(rowp + bj * HALF) = w;
                }
            }
    }
};
struct EpiRes {
    static constexpr bool PERM = false, AFTER_DRAIN = false;
    float* X; bf16_t* XB; float* ssq;
    __device__ __forceinline__ void operator()(const f32x4 (&acc)[2][2][4][2], const Unit& u, int wr, int wc, int fr, int fq) const {
        typedef unsigned u32x2v __attribute__((ext_vector_type(2)));
        const int col0 = u.pn * BM + wc * 32 + 4 * fq;
#pragma unroll
        for (int ai = 0; ai < 2; ++ai)
#pragma unroll
            for (int m = 0; m < 4; ++m) {
                const int r = u.pm * BM + ai * HALF + wr * 64 + m * 16 + fr; const size_t off = (size_t)r * 1024 + col0; float ss = 0.f;
#pragma unroll
                for (int bj = 0; bj < 2; ++bj)
#pragma unroll
                    for (int n = 0; n < 2; ++n) { const size_t o = off + bj * HALF + n * 16; const f32x4 v = *(const f32x4*)(X + o) + acc[ai][bj][m][n];
                        *(f32x4*)(X + o) = v; u32x2v w; w.x = cvt_pk_bf16(v[0], v[1]); w.y = cvt_pk_bf16(v[2], v[3]); *(u32x2v*)(XB + o) = w;
                        ss += (v[0] * v[0] + v[1] * v[1]) + (v[2] * v[2] + v[3] * v[3]); }
                ss += xl_swz<16>(ss); ss = xl_sum32(ss);
                if (fq == 0) ssq[(size_t)r * 16 + u.pn * 4 + wc] = ss;
            }
    }
};
template <class Epi, class Sched, bool ALIGN_EPI = false, bool SP2 = false>
__device__ __forceinline__ void gemm_phase(PG8_LAS unsigned char* lds, const Gemm g, const Sched& S, const Epi& E, const int tid) {
    const int wid = __builtin_amdgcn_readfirstlane(tid >> 6), lane = tid & 63, wr = wid >> 2, wc = wid & 3, fr = lane & 15, fq = lane >> 4;
    const int K = g.K, nt = K / BK;
    unsigned voffA[2], voffB[2];
#pragma unroll
    for (int i = 0; i < 2; ++i) { int R, C; stage_rc(tid * 16 + i * 8192, R, C); const int Rb = Epi::PERM ? ((R & ~31) + perm32(R & 31)) : R;
        voffA[i] = (unsigned)(R * K + C) * 2u; voffB[i] = (unsigned)(Rb * K + C) * 2u; }
    const size_t kstep = (size_t)(BK * 2);
    const size_t hstep = (size_t)HALF * K * 2;
    const size_t tstep = 2 * hstep;
    const unsigned ldsw = (unsigned)wid * 1024u;
    const int aoff = lds_byte(wr * 64 + fr, fq * 8), boff = lds_byte(wc * 32 + fr, fq * 8);
#define PG8_SA(b, h) (((b) * 2 + (h)) * HTB)
#define PG8_SB(b, h) ((4 + (b) * 2 + (h)) * HTB)
#define PG8_STAGE(bufoff, gbase, voff) do { _Pragma("unroll") for (int _i = 0; _i < 2; ++_i) \
        __builtin_amdgcn_global_load_lds((const unsigned*)((const char*)(gbase) + (voff)[_i]), (PG8_LAS unsigned*)(lds + (bufoff) + ldsw + _i * 8192), 16, 0, 0); } while (0)
#define PG8_LDA(dst, b, h) do { _Pragma("unroll") for (int m = 0; m < 4; ++m) _Pragma("unroll") for (int k = 0; k < 2; ++k) dst[m][k] = *(const PG8_LAS bf16x8*)(lds + PG8_SA(b, h) + aoff + m * 2048 + k * 1024); } while (0)
#define PG8_LDB(dst, b, h) do { _Pragma("unroll") for (int n = 0; n < 2; ++n) _Pragma("unroll") for (int k = 0; k < 2; ++k) dst[n][k] = *(const PG8_LAS bf16x8*)(lds + PG8_SB(b, h) + boff + n * 2048 + k * 1024); } while (0)
#define PG8_MMA(ai, bj, At, Bt) do { __builtin_amdgcn_s_setprio(1); _Pragma("unroll") for (int m = 0; m < 4; ++m) _Pragma("unroll") for (int n = 0; n < 2; ++n) _Pragma("unroll") for (int k = 0; k < 2; ++k) \
        acc[ai][bj][m][n] = __builtin_amdgcn_mfma_f32_16x16x32_bf16(Bt[n][k], At[m][k], acc[ai][bj][m][n], 0, 0, 0); __builtin_amdgcn_s_setprio(0); } while (0)
#define PG8_WAIT_V(n) asm volatile("s_waitcnt vmcnt(" #n ")" ::: "memory")
#define PG8_WAIT_L(n) asm volatile("s_waitcnt lgkmcnt(" #n ")" ::: "memory")
#define PG8_BAR __builtin_amdgcn_s_barrier()
#define PG8_SCHED __builtin_amdgcn_sched_barrier(0)
    Unit cur, nxt; int ui = 0;
    if (!S.next(0, cur)) return;
    f32x4 acc[2][2][4][2];
#pragma unroll
    for (int a = 0; a < 2; ++a)
#pragma unroll
        for (int b = 0; b < 2; ++b)
#pragma unroll
            for (int m = 0; m < 4; ++m)
#pragma unroll
                for (int n = 0; n < 2; ++n) acc[a][b][m][n] = (f32x4){0.f, 0.f, 0.f, 0.f};
    bf16x8 At[4][2], B0[2][2], B1[2][2];
    const char* cA = (const char*)g.A + (size_t)cur.pm * tstep; const char* cB = (const char*)g.Bt + (size_t)cur.pn * tstep;
    S.a_ready(cur);
    if constexpr (SP2) {
        PG8_STAGE(PG8_SB(0, 0), cB, voffB); PG8_STAGE(PG8_SB(0, 1), cB + hstep, voffB); PG8_STAGE(PG8_SA(0, 0), cA, voffA); PG8_STAGE(PG8_SA(0, 1), cA + hstep, voffA);
        if (wr == 1) PG8_BAR;
        PG8_WAIT_V(2); PG8_BAR;
        PG8_STAGE(PG8_SB(1, 0), cB + kstep, voffB); PG8_STAGE(PG8_SA(1, 0), cA + kstep, voffA); PG8_STAGE(PG8_SB(1, 1), cB + hstep + kstep, voffB);
        PG8_WAIT_V(6); PG8_BAR;
    } else {
        PG8_STAGE(PG8_SB(0, 0), cB, voffB); PG8_STAGE(PG8_SA(0, 0), cA, voffA); PG8_STAGE(PG8_SB(0, 1), cB + hstep, voffB); PG8_STAGE(PG8_SA(0, 1), cA + hstep, voffA);
        if (wr == 1) PG8_BAR;
        PG8_WAIT_V(4); PG8_BAR;
        PG8_STAGE(PG8_SB(1, 0), cB + kstep, voffB); PG8_STAGE(PG8_SA(1, 0), cA + kstep, voffA); PG8_STAGE(PG8_SB(1, 1), cB + hstep + kstep, voffB);
        PG8_WAIT_V(6); PG8_BAR;
    }
    for (;;) {
        const bool has_next = S.next(ui + 1, nxt);
        const char* nA = has_next ? (const char*)g.A + (size_t)nxt.pm * tstep : cA; const char* nB = has_next ? (const char*)g.Bt + (size_t)nxt.pn * tstep : cB;
        for (int t = 0; t < nt; t += 2) {
            const bool last = (t == nt - 2);
            const char* a1 = cA + (size_t)(t + 1) * kstep;
            const char* a2 = last ? nA : cA + (size_t)(t + 2) * kstep; const char* b2 = last ? nB : cB + (size_t)(t + 2) * kstep;
            const char* a3 = a2 + kstep; const char* b3 = b2 + kstep;
            if (last && has_next) S.a_ready(nxt);
            if constexpr (SP2) {
            PG8_LDB(B0, 0, 0); PG8_LDB(B1, 0, 1); PG8_SCHED; PG8_LDA(At, 0, 0); PG8_STAGE(PG8_SA(1, 1), a1 + hstep, voffA);
            PG8_WAIT_V(8); PG8_WAIT_L(0); PG8_BAR; PG8_MMA(0, 0, At, B0); PG8_MMA(0, 1, At, B1); PG8_BAR; PG8_SCHED;
            PG8_LDA(At, 0, 1); PG8_STAGE(PG8_SB(0, 0), b2, voffB); PG8_STAGE(PG8_SB(0, 1), b2 + hstep, voffB); PG8_STAGE(PG8_SA(0, 0), a2, voffA);
            PG8_WAIT_V(8); PG8_WAIT_L(0); PG8_BAR; PG8_MMA(1, 0, At, B0); PG8_MMA(1, 1, At, B1); PG8_BAR; PG8_SCHED;
            PG8_LDB(B0, 1, 0); PG8_LDB(B1, 1, 1); PG8_SCHED; PG8_LDA(At, 1, 0); PG8_STAGE(PG8_SA(0, 1), a2 + hstep, voffA);
            PG8_WAIT_V(8); PG8_WAIT_L(0); PG8_BAR; PG8_MMA(0, 0, At, B0); PG8_MMA(0, 1, At, B1); PG8_BAR; PG8_SCHED;
            PG8_LDA(At, 1, 1); PG8_STAGE(PG8_SB(1, 0), b3, voffB); PG8_STAGE(PG8_SB(1, 1), b3 + hstep, voffB); PG8_STAGE(PG8_SA(1, 0), a3, voffA);
            PG8_WAIT_V(8); PG8_WAIT_L(0); PG8_BAR; PG8_MMA(1, 0, At, B0); PG8_MMA(1, 1, At, B1); PG8_BAR; PG8_SCHED;
            } else {
            PG8_LDB(B0, 0, 0); PG8_SCHED; PG8_LDA(At, 0, 0); PG8_STAGE(PG8_SA(1, 1), a1 + hstep, voffA);
            PG8_WAIT_L(8); PG8_BAR; PG8_WAIT_L(0); PG8_MMA(0, 0, At, B0); PG8_BAR; PG8_SCHED;
            PG8_LDB(B1, 0, 1); PG8_STAGE(PG8_SB(0, 0), b2, voffB);
            PG8_BAR; PG8_WAIT_L(0); PG8_MMA(0, 1, At, B1); PG8_BAR;
            PG8_LDA(At, 0, 1); PG8_STAGE(PG8_SA(0, 0), a2, voffA);
            PG8_BAR; PG8_WAIT_L(0); PG8_MMA(1, 0, At, B0); PG8_BAR; PG8_SCHED;
            PG8_STAGE(PG8_SB(0, 1), b2 + hstep, voffB);
            PG8_WAIT_V(6); PG8_BAR; PG8_MMA(1, 1, At, B1); PG8_BAR;
            PG8_LDB(B0, 1, 0); PG8_SCHED; PG8_LDA(At, 1, 0); PG8_STAGE(PG8_SA(0, 1), a2 + hstep, voffA);
            PG8_WAIT_L(8); PG8_BAR; PG8_WAIT_L(0); PG8_MMA(0, 0, At, B0); PG8_BAR; PG8_SCHED;
            PG8_LDB(B1, 1, 1); PG8_STAGE(PG8_SB(1, 0), b3, voffB);
            PG8_BAR; PG8_WAIT_L(0); PG8_MMA(0, 1, At, B1); PG8_BAR;
            PG8_LDA(At, 1, 1); PG8_STAGE(PG8_SA(1, 0), a3, voffA);
            PG8_BAR; PG8_WAIT_L(0); PG8_MMA(1, 0, At, B0); PG8_BAR; PG8_SCHED;
            PG8_STAGE(PG8_SB(1, 1), b3 + hstep, voffB);
            PG8_WAIT_V(6); PG8_BAR; PG8_MMA(1, 1, At, B1); PG8_BAR;
            }
        }
        if constexpr (ALIGN_EPI) { if (wr == 0) PG8_BAR; }
        if constexpr (!Epi::AFTER_DRAIN) { E(acc, cur, wr, wc, fr, fq); S.done(cur); }
        if (!has_next) break;
#pragma unroll
        for (int a = 0; a < 2; ++a)
#pragma unroll
            for (int b = 0; b < 2; ++b)
#pragma unroll
                for (int m = 0; m < 4; ++m)
#pragma unroll
                    for (int n = 0; n < 2; ++n) acc[a][b][m][n] = (f32x4){0.f, 0.f, 0.f, 0.f};
        cur = nxt; cA = nA; cB = nB; ++ui;
        if constexpr (ALIGN_EPI) { if (wr == 1) PG8_BAR; }
    }
    PG8_WAIT_V(0);
    if constexpr (!ALIGN_EPI) { if (wr == 0) PG8_BAR; }
    PG8_BAR;
    if constexpr (Epi::AFTER_DRAIN) { E.fused(acc, cur, wr, wc, fr, fq, lds, wid, lane); S.done(cur); }
#undef PG8_SA
#undef PG8_SB
#undef PG8_STAGE
#undef PG8_LDA
#undef PG8_LDB
#undef PG8_MMA
#undef PG8_WAIT_V
#undef PG8_WAIT_L
#undef PG8_BAR
#undef PG8_SCHED
}
}

#ifndef PG8_SP2
#define PG8_SP2 true
#endif
#ifndef PG8_ALIGN
#define PG8_ALIGN true
#endif
#include <hip/hip_bf16.h>
#include <cmath>
namespace attn_body {
using bf16=__hip_bfloat16;
using bf16x8=__attribute__((ext_vector_type(8)))short;
using s16x4=__attribute__((ext_vector_type(4)))short;
using f32x16=__attribute__((ext_vector_type(16)))float;
using u32x4=__attribute__((ext_vector_type(4)))unsigned;
constexpr int BATCH=4,SEQ=4096,D=64,PIN=3072,POUT=1024;
constexpr int NW=8,QBLK=32,QB=QBLK*NW,KVBLK=64,NQB=SEQ/QB;
constexpr int ATTN_UNIT_ROWS=QB;
__device__ __forceinline__ int crow(int r,int hi){return (r&3)+8*(r>>2)+4*hi;}
#define SBAR() __builtin_amdgcn_sched_barrier(0)
__device__ __forceinline__ void cmask(f32x16&p0,f32x16&p1,int jb,int qrel,int hi){
  const float NEG=-INFINITY; int kb=64*jb+4*hi; asm volatile("":"+v"(kb));
  #pragma unroll
  for(int r=0;r<16;++r){int kv=kb+(r&3)+8*(r>>2); if(kv>qrel)p0[r]=NEG; if(kv+32>qrel)p1[r]=NEG;}
}

constexpr int NSLOT=3, SLOTB=8192;
constexpr int LDS_K=0, LDS_V=NSLOT*SLOTB, LDS_WS=2*NSLOT*SLOTB, LDS_OST=LDS_WS+NW*64*4, LDS_BYTES=LDS_OST+NW*4096;
constexpr float C2=0.125f*1.4426950408889634f;
__device__ __forceinline__ void glds16(const void*gsrc,unsigned lds_dst){unsigned keep;
  asm volatile("s_mov_b32 %0, m0\n\ts_mov_b32 m0, %2\n\ts_nop 0\n\tglobal_load_lds_dwordx4 %1, off\n\ts_mov_b32 m0, %0":"=&s"(keep):"v"(gsrc),"s"(lds_dst):"memory");}
__device__ __forceinline__ void glds16s(const void*sbase,unsigned voff,unsigned lds_dst){unsigned keep;
  asm volatile("s_mov_b32 %0, m0\n\ts_mov_b32 m0, %3\n\ts_nop 0\n\tglobal_load_lds_dwordx4 %1, %2\n\ts_mov_b32 m0, %0":"=&s"(keep):"v"(voff),"s"(sbase),"s"(lds_dst):"memory");}
__device__ __forceinline__ float max3f(float a,float b,float c){float r;asm("v_max3_f32 %0, %1, %2, %3":"=v"(r):"v"(a),"v"(b),"v"(c));return r;}
__device__ __forceinline__ float max2f(float a,float b){float r;asm("v_max_f32_e32 %0, %1, %2":"=v"(r):"v"(a),"v"(b));return r;}
__device__ __forceinline__ float fadd_s(float a,float b){float r;asm("v_add_f32_e32 %0, %1, %2":"=v"(r):"v"(a),"v"(b));return r;}
__device__ __forceinline__ float fsub_s(float a,float b){float r;asm("v_sub_f32_e32 %0, %1, %2":"=v"(r):"v"(a),"v"(b));return r;}
typedef float f32x2_t __attribute__((ext_vector_type(2))); typedef __bf16 bf16x2_t __attribute__((ext_vector_type(2)));
__device__ __forceinline__ unsigned cvtpk_s(float lo,float hi){f32x2_t v={lo,hi};bf16x2_t b=__builtin_convertvector(v,bf16x2_t);return __builtin_bit_cast(unsigned,b);}
#define WAIT_BAR(N) asm volatile("s_waitcnt vmcnt(" #N ") lgkmcnt(0)\n\ts_barrier":::"memory")

__device__ __forceinline__ void qkt(f32x16&p0,f32x16&p1,const char*Kslot,const bf16x8*qr,const f32x16&negm,int r32,int hi){
  const char*kb=Kslot+hi*1024+r32*16;
  #pragma unroll
  for(int d0=0;d0<4;++d0){
    const bf16x8 b0=*reinterpret_cast<const bf16x8*>(kb+d0*2048);
    const bf16x8 b1=*reinterpret_cast<const bf16x8*>(kb+d0*2048+512);
    if(d0==0){p0=__builtin_amdgcn_mfma_f32_32x32x16_bf16(b0,qr[0],negm,0,0,0);p1=__builtin_amdgcn_mfma_f32_32x32x16_bf16(b1,qr[0],negm,0,0,0);}
    else{p0=__builtin_amdgcn_mfma_f32_32x32x16_bf16(b0,qr[d0],p0,0,0,0);p1=__builtin_amdgcn_mfma_f32_32x32x16_bf16(b1,qr[d0],p1,0,0,0);}}
}
typedef __attribute__((address_space(3))) const char* lds_cptr;
typedef short v4i16_t __attribute__((ext_vector_type(4)));
__device__ __forceinline__ void kload8(bf16x8*kf,lds_cptr kp){
  kf[0]=*(const __attribute__((address_space(3))) bf16x8*)(kp);      kf[1]=*(const __attribute__((address_space(3))) bf16x8*)(kp+512);
  kf[2]=*(const __attribute__((address_space(3))) bf16x8*)(kp+2048); kf[3]=*(const __attribute__((address_space(3))) bf16x8*)(kp+2560);
  kf[4]=*(const __attribute__((address_space(3))) bf16x8*)(kp+4096); kf[5]=*(const __attribute__((address_space(3))) bf16x8*)(kp+4608);
  kf[6]=*(const __attribute__((address_space(3))) bf16x8*)(kp+6144); kf[7]=*(const __attribute__((address_space(3))) bf16x8*)(kp+6656);
}
__device__ __forceinline__ void kload2(bf16x8*kf,lds_cptr kp,int j){ kf[2*j]=*(const __attribute__((address_space(3))) bf16x8*)(kp+j*2048); kf[2*j+1]=*(const __attribute__((address_space(3))) bf16x8*)(kp+j*2048+512); }
__device__ __forceinline__ s16x4 vtr(lds_cptr p){ return __builtin_bit_cast(s16x4,__builtin_amdgcn_ds_read_tr16_b64_v4i16((__attribute__((address_space(3))) v4i16_t*)p)); }
__device__ __forceinline__ float rowmax(const f32x16&p0,const f32x16&p1){
  float a=max3f(p0[0],p0[1],p1[0]),b=max3f(p0[2],p0[3],p1[1]);a=max3f(a,p1[2],p1[3]);
  #pragma unroll
  for(int r=4;r<16;r+=4){a=max3f(a,p0[r],p0[r+1]);b=max3f(b,p0[r+2],p0[r+3]);a=max3f(a,p1[r],p1[r+1]);b=max3f(b,p1[r+2],p1[r+3]);}
  const float m=max2f(a,b);
  auto rr=__builtin_amdgcn_permlane32_swap(__float_as_uint(m),__float_as_uint(m),false,false);
  return max2f(__uint_as_float(rr[0]),__uint_as_float(rr[1]));
}
__device__ __forceinline__ void pv(f32x16*o,int vb,bf16x8 pa0,bf16x8 pa1,bf16x8 pa2,bf16x8 pa3){
  #pragma unroll
  for(int d0=0;d0<2;++d0){s16x4 lo[4],hi[4];
    #pragma unroll
    for(int ks=0;ks<4;++ks){
      asm volatile("ds_read_b64_tr_b16 %0,%1 offset:%c2":"=&v"(lo[ks]):"v"(vb),"i"(d0*4096+ks*1024):"memory");
      asm volatile("ds_read_b64_tr_b16 %0,%1 offset:%c2":"=&v"(hi[ks]):"v"(vb),"i"(d0*4096+ks*1024+512):"memory");}
    asm volatile("s_waitcnt lgkmcnt(0)":::"memory");SBAR();
    #define PK(k) (bf16x8){lo[k][0],lo[k][1],lo[k][2],lo[k][3],hi[k][0],hi[k][1],hi[k][2],hi[k][3]}
    o[d0]=__builtin_amdgcn_mfma_f32_32x32x16_bf16(pa0,PK(0),o[d0],0,0,0);
    o[d0]=__builtin_amdgcn_mfma_f32_32x32x16_bf16(pa1,PK(1),o[d0],0,0,0);
    o[d0]=__builtin_amdgcn_mfma_f32_32x32x16_bf16(pa2,PK(2),o[d0],0,0,0);
    o[d0]=__builtin_amdgcn_mfma_f32_32x32x16_bf16(pa3,PK(3),o[d0],0,0,0);
    #undef PK
  }
}

#ifndef ATTN_STORE16
#define ATTN_STORE16(p,v) (*(u32x4*)(p)=(v))
#endif
template<int THRL> __device__ __forceinline__ void attn_unit(int b,int qcol,int kcol,int vcol,int ocol,int qb,const bf16*Q,const bf16*__restrict__ K,const bf16*__restrict__ V,bf16*O,char*shm,const int tid){
  const int lane=tid&63,r32=lane&31,hi=lane>>5; const int wid=__builtin_amdgcn_readfirstlane(tid>>6);
  const long rowbase=(long)b*SEQ; const int q0=qb*QB;
  const bf16*Qw=Q+(rowbase+q0+wid*QBLK)*PIN+qcol;
  const bf16*Kh=K+rowbase*PIN+kcol,*Vh=V+rowbase*PIN+vcol;
  const unsigned lds0=(unsigned)(uintptr_t)shm;
  float*wsf=(float*)(shm+LDS_WS)+wid*64;
  const unsigned koff=(unsigned)(lane*PIN+wid*8)*2u;
  const unsigned voff=(unsigned)((16*(wid&3)+(lane>>2))*PIN+(wid>>2)*32+(lane&3)*8)*2u;
  const unsigned kdst=lds0+LDS_K+wid*1024, vdst=lds0+LDS_V+wid*1024;
  #define DMA_K(t,slot) glds16s(Kh+(long)(t)*KVBLK*PIN,koff,(unsigned)__builtin_amdgcn_readfirstlane(kdst+(slot)))
  #define DMA_V(t,slot) glds16s(Vh+(long)(t)*KVBLK*PIN,voff,(unsigned)__builtin_amdgcn_readfirstlane(vdst+(slot)))
  const int vb0=(int)(lds0+LDS_V)+((lane>>4)&1)*32+(lane&3)*8+(4*hi+((lane&15)>>2))*64;
  const char*Kbase=shm+LDS_K; bf16x8 kf[8];
  const lds_cptr shm3=(lds_cptr)shm; const lds_cptr kp0=shm3+LDS_K+hi*1024+r32*16; const lds_cptr vp0=shm3+LDS_V+((lane>>4)&1)*32+(lane&3)*8+(4*hi+((lane&15)>>2))*64;
  const int NT=(q0+QB)/KVBLK;
  DMA_K(0,0);DMA_V(0,0);DMA_K(1,SLOTB);
  bf16x8 qr[4];
  { int lq=lane; asm volatile("":"+v"(lq)); const int r32q=lq&31,hiq=lq>>5;
  _Pragma("unroll") for(int d0=0;d0<4;++d0)qr[d0]=*reinterpret_cast<const bf16x8*>(&Qw[(long)r32q*PIN+d0*16+hiq*8]); }
  float mhat=0.f,l_reg=0.f;f32x16 o[2];o[0]=f32x16{};o[1]=f32x16{};f32x16 negm=f32x16{};asm volatile("":"+v"(negm));
  const int qrel=wid*QBLK+r32;
  #define CMASK(P0,P1,t) do{int jb_=(t)-(NT-4); if(jb_>=0)cmask(P0,P1,jb_,qrel,hi);}while(0)
  bool resc=false;
  #define START(P0,P1) do{ const float rm=rowmax(P0,P1); resc=false; \
    { const float dl=rm; mhat=fadd_s(mhat,dl); \
      _Pragma("unroll") for(int r=0;r<16;++r){P0[r]=fsub_s(P0[r],dl);P1[r]=fsub_s(P1[r],dl);} \
      _Pragma("unroll") for(int r=0;r<16;++r)negm[r]=-mhat; asm volatile("":"+v"(negm)); } \
    _Pragma("unroll") for(int r=0;r<16;++r)P0[r]=__builtin_amdgcn_exp2f(P0[r]); }while(0)
  #define RESC() do{ if(resc){ asm volatile("s_waitcnt lgkmcnt(0)":::"memory"); \
      _Pragma("unroll") for(int d_=0;d_<2;++d_) _Pragma("unroll") for(int r=0;r<16;++r)o[d_][r]*=wsf[crow(r,hi)]; } }while(0)
  f32x16 pA0,pA1,pB0,pB1;
  int sl_prev=0,sl_cur=0,sl_next=SLOTB;
  #define ROT() do{sl_prev=sl_cur;sl_cur=sl_next;sl_next=(sl_next==(NSLOT-1)*SLOTB)?0:sl_next+SLOTB;}while(0)
  DMA_K(2,2*SLOTB);
  WAIT_BAR(3);
  qkt(pA0,pA1,Kbase,qr,negm,r32,hi);asm volatile("s_nop 15\n\ts_nop 7":"+v"(pA0),"+v"(pA1));CMASK(pA0,pA1,0);
  START(pA0,pA1);
  _Pragma("unroll") for(int r=0;r<16;++r)pA1[r]=__builtin_amdgcn_exp2f(pA1[r]);
  WAIT_BAR(0);
  DMA_K(3,0);DMA_V(1,SLOTB);
  ROT();
  kload8(kf,kp0+sl_cur);
  WAIT_BAR(2);
  s16x4 vlo[8],vhi[8]; u32x4 pw0,pw1,pw2,pw3;
  #define PKW(P,B) cvtpk_s(P[B],P[B+1])
  #define PAF(k) __builtin_bit_cast(bf16x8,pw##k)
  #define VFR(i) (bf16x8){vlo[i][0],vlo[i][1],vlo[i][2],vlo[i][3],vhi[i][0],vhi[i][1],vhi[i][2],vhi[i][3]}
  #define PIN(x) asm volatile("":"+v"(x))
  #define MX3(a,b,c) __builtin_fmaxf(__builtin_fmaxf((a),(b)),(c))
  #define GAPA(MF,A0,A1,A2,A3,W0,W1,PW) do{ MF; sacc+=A0; sacc+=A1; sacc+=A2; sacc+=A3; PIN(sacc); W0; W1; PIN(PW); SBAR(); }while(0)
  #define EX(v) __builtin_amdgcn_exp2f(v)
  #define GAPB(MF,X,B) do{ MF; X[B]=EX(X[B]); X[B+1]=EX(X[B+1]); X[B+2]=EX(X[B+2]); X[B+3]=EX(X[B+3]); PIN(X); SBAR(); }while(0)
  #define VRD(i) do{ vlo[i]=vtr(vp_+(((i)>>2)*4096+((i)&3)*1024)); vhi[i]=vtr(vp_+(((i)>>2)*4096+((i)&3)*1024+512)); }while(0)
  #define KRD(G,j) do{ if(G){ kload2(kf,kp0+sl_next,j); SBAR(); } }while(0)
  #define STEP(C0,C1,P0,P1,t,GK,GV,GL) do{ SBAR(); \
    const lds_cptr vp_=vp0+sl_prev; \
    VRD(0); SBAR(); float sacc=(P0[0]+P0[1]); \
    GAPA(C0=__builtin_amdgcn_mfma_f32_32x32x16_bf16(kf[0],qr[0],negm,0,0,0), P0[2],P0[3],P0[4],P0[5],     pw0[0]=PKW(P0,0), pw0[1]=PKW(P0,2), pw0); \
    VRD(4); SBAR(); GAPA(C1=__builtin_amdgcn_mfma_f32_32x32x16_bf16(kf[1],qr[0],negm,0,0,0), P0[6],P0[7],P0[8],P0[9],     pw0[2]=PKW(P0,4), pw0[3]=PKW(P0,6), pw0); \
    VRD(1); SBAR(); GAPA(C0=__builtin_amdgcn_mfma_f32_32x32x16_bf16(kf[2],qr[1],C0,0,0,0),   P0[10],P0[11],P0[12],P0[13], pw1[0]=PKW(P0,8), pw1[1]=PKW(P0,10), pw1); \
    VRD(5); SBAR(); GAPA(C1=__builtin_amdgcn_mfma_f32_32x32x16_bf16(kf[3],qr[1],C1,0,0,0),   P0[14],P0[15],P1[0],P1[1],   pw1[2]=PKW(P0,12),pw1[3]=PKW(P0,14), pw1); \
    VRD(2); SBAR(); GAPA(C0=__builtin_amdgcn_mfma_f32_32x32x16_bf16(kf[4],qr[2],C0,0,0,0),   P1[2],P1[3],P1[4],P1[5],     pw2[0]=PKW(P1,0), pw2[1]=PKW(P1,2), pw2); \
    VRD(6); SBAR(); GAPA(C1=__builtin_amdgcn_mfma_f32_32x32x16_bf16(kf[5],qr[2],C1,0,0,0),   P1[6],P1[7],P1[8],P1[9],     pw2[2]=PKW(P1,4), pw2[3]=PKW(P1,6), pw2); \
    VRD(3); SBAR(); GAPA(C0=__builtin_amdgcn_mfma_f32_32x32x16_bf16(kf[6],qr[3],C0,0,0,0),   P1[10],P1[11],P1[12],P1[13], pw3[0]=PKW(P1,8), pw3[1]=PKW(P1,10), pw3); \
    VRD(7); SBAR(); GAPA(C1=__builtin_amdgcn_mfma_f32_32x32x16_bf16(kf[7],qr[3],C1,0,0,0),   P1[14],P1[15],0.f,0.f,       pw3[2]=PKW(P1,12),pw3[3]=PKW(P1,14), pw3); \
    l_reg+=sacc; \
    if(GK){DMA_K((t)+3,sl_cur);} if(GV){DMA_V((t)+1,sl_next);} \
    CMASK(C0,C1,t); \
    { float a=MX3(C0[0],C0[1],C1[0]),b=MX3(C0[2],C0[3],C1[1]); a=MX3(a,C1[2],C1[3]); \
      _Pragma("unroll") for(int r=4;r<16;r+=4){a=MX3(a,C0[r],C0[r+1]);b=MX3(b,C0[r+2],C0[r+3]);a=MX3(a,C1[r],C1[r+1]);b=MX3(b,C1[r+2],C1[r+3]);} \
      float rm=__builtin_fmaxf(a,b); { auto rr=__builtin_amdgcn_permlane32_swap(__float_as_uint(rm),__float_as_uint(rm),false,false); rm=__builtin_fmaxf(__uint_as_float(rr[0]),__uint_as_float(rr[1])); } \
      resc=false; \
      if(__builtin_expect(__any(rm>(float)THRL),0)){ const float dl=__builtin_fmaxf(rm,0.f); mhat+=dl; \
        _Pragma("unroll") for(int r=0;r<16;++r){C0[r]-=dl;C1[r]-=dl;} \
        _Pragma("unroll") for(int r=0;r<16;++r)negm[r]=-mhat; asm volatile("":"+v"(negm)); \
        const float f=__builtin_amdgcn_exp2f(-dl); l_reg*=f; if(hi==0)wsf[r32]=f; resc=true; } } \
    SBAR(); \
    GAPB(o[0]=__builtin_amdgcn_mfma_f32_32x32x16_bf16(PAF(0),VFR(0),o[0],0,0,0), C0,0); \
    GAPB(o[1]=__builtin_amdgcn_mfma_f32_32x32x16_bf16(PAF(0),VFR(4),o[1],0,0,0), C0,4); \
    KRD(GL,0); GAPB(o[0]=__builtin_amdgcn_mfma_f32_32x32x16_bf16(PAF(1),VFR(1),o[0],0,0,0), C0,8); \
    KRD(GL,1); GAPB(o[1]=__builtin_amdgcn_mfma_f32_32x32x16_bf16(PAF(1),VFR(5),o[1],0,0,0), C0,12); \
    KRD(GL,2); GAPB(o[0]=__builtin_amdgcn_mfma_f32_32x32x16_bf16(PAF(2),VFR(2),o[0],0,0,0), C1,0); \
    KRD(GL,3); GAPB(o[1]=__builtin_amdgcn_mfma_f32_32x32x16_bf16(PAF(2),VFR(6),o[1],0,0,0), C1,4); \
    GAPB(o[0]=__builtin_amdgcn_mfma_f32_32x32x16_bf16(PAF(3),VFR(3),o[0],0,0,0), C1,8); \
    GAPB(o[1]=__builtin_amdgcn_mfma_f32_32x32x16_bf16(PAF(3),VFR(7),o[1],0,0,0), C1,12); \
    }while(0)
  int t=1;
  #undef CMASK
  #define CMASK(P0,P1,t) do{}while(0)
  for(;t+5<NT;t+=2){
    STEP(pB0,pB1,pA0,pA1,t,true,true,true);     WAIT_BAR(2); RESC(); ROT();
    STEP(pA0,pA1,pB0,pB1,t+1,true,true,true);   WAIT_BAR(2); RESC(); ROT();
  }
  #undef CMASK
  #define CMASK(P0,P1,t) do{int jb_=(t)-(NT-4); if(jb_>=0)cmask(P0,P1,jb_,qrel,hi);}while(0)
  #define ENDW(tt) do{ if((tt)+3<NT){WAIT_BAR(2);} else if((tt)+2<NT){WAIT_BAR(1);} else {WAIT_BAR(0);} }while(0)
  for(;t+1<NT;t+=2){
    STEP(pB0,pB1,pA0,pA1,t,(t+3<NT),(t+1<NT),(t+1<NT));       ENDW(t);   RESC(); ROT();
    STEP(pA0,pA1,pB0,pB1,t+1,(t+4<NT),(t+2<NT),(t+2<NT));     ENDW(t+1); RESC(); ROT();
  }
  STEP(pB0,pB1,pA0,pA1,NT-1,false,false,false); RESC();
  { float sacc=pB0[0]+pB0[1]; _Pragma("unroll") for(int r=2;r<16;++r)sacc+=pB0[r]; _Pragma("unroll") for(int r=0;r<16;++r)sacc+=pB1[r]; l_reg+=sacc;
    pw0=(u32x4){PKW(pB0,0),PKW(pB0,2),PKW(pB0,4),PKW(pB0,6)};pw1=(u32x4){PKW(pB0,8),PKW(pB0,10),PKW(pB0,12),PKW(pB0,14)};pw2=(u32x4){PKW(pB1,0),PKW(pB1,2),PKW(pB1,4),PKW(pB1,6)};pw3=(u32x4){PKW(pB1,8),PKW(pB1,10),PKW(pB1,12),PKW(pB1,14)};
    SBAR(); pv(o,vb0+sl_cur,PAF(0),PAF(1),PAF(2),PAF(3)); }
  #undef PKW
  #undef PAF
  #undef VFR
  #undef PIN
  #undef MX3
  #undef GAPA
  #undef GAPB
  #undef EX
  #undef VRD
  #undef KRD
  #undef STEP
  #undef ENDW
  {auto rr=__builtin_amdgcn_permlane32_swap(__float_as_uint(l_reg),__float_as_uint(l_reg),false,false);l_reg=__uint_as_float(rr[0])+__uint_as_float(rr[1]);}
  { int le=lane; asm volatile("":"+v"(le)); const int r32e=le&31,hie=le>>5;
  if(hie==0)wsf[32+r32e]=l_reg;asm volatile("s_waitcnt lgkmcnt(0)":::"memory");
  float rli[16];
  #pragma unroll
  for(int r=0;r<16;++r)rli[r]=__builtin_amdgcn_rcpf(wsf[32+crow(r,hie)]);
  bf16*Ow=O+(rowbase+q0+wid*QBLK)*POUT+ocol;
  { bf16*stg=(bf16*)(shm+LDS_OST)+wid*2048;
    #pragma unroll
    for(int r=0;r<16;++r){const int orow=crow(r,hie);
      #pragma unroll
      for(int d0=0;d0<2;++d0)stg[orow*64+d0*32+r32e]=__float2bfloat16(o[d0][r]*rli[r]);}
    asm volatile("s_waitcnt lgkmcnt(0)":::"memory");
    #pragma unroll
    for(int i=0;i<4;++i){const int row=i*8+(le>>3),ch=le&7; const u32x4 v=*(const u32x4*)(stg+row*64+ch*8); ATTN_STORE16(Ow+(long)row*POUT+ch*8,v);} } }
  asm volatile("s_waitcnt lgkmcnt(0)\n\ts_barrier":::"memory");
  #undef DMA_K
  #undef DMA_V
  #undef CMASK
  #undef START
  #undef RESC
  #undef ROT
}
constexpr int ATTN_LDS_BYTES=LDS_BYTES;
struct AttnUnit { int bh; int qb; };
struct StaticOrder {
  int vcu;
  __device__ __forceinline__ explicit StaticOrder(int v):vcu(v){}
  __device__ __forceinline__ bool next(int i,AttnUnit&u)const{ if(i>=4)return false; const int s=vcu&3; u.bh=vcu>>2; u.qb=(i==0)?s:(i==1)?7-s:(i==2)?8+s:15-s; return true; }
};
template<class Sched,int THRL=8> __device__ __forceinline__ void attn_phase(char*lds,const bf16*P,bf16*O,const Sched&S,const int tid){
  AttnUnit u;
  for(int i=0;S.next(i,u);++i){ const int b=u.bh>>4, h=(u.bh>>2)&3, m=(u.bh>>1)&1, vh=u.bh&1;
    attn_unit<THRL>(b, h*128+m*64, 512+h*128+m*64, 1024+h*128+vh*64, m*512+h*128+vh*64, u.qb, P, P, P, O, lds, tid); }
}
#undef SBAR
#undef WAIT_BAR
}
#define GAS __attribute__((address_space(1)))
#define LAS __attribute__((address_space(3)))
typedef unsigned short bf16;
typedef unsigned v4u __attribute__((ext_vector_type(4)));
typedef float f32x4 __attribute__((ext_vector_type(4)));
typedef short bf16x8 __attribute__((ext_vector_type(8)));
typedef GAS unsigned gu32;
typedef GAS unsigned long long gu64;
#define RLX_AGENT __ATOMIC_RELAXED, __HIP_MEMORY_SCOPE_AGENT
#define LDS_WAIT() asm volatile("s_waitcnt lgkmcnt(0)" ::: "memory")
#define VM_WAIT() asm volatile("s_waitcnt vmcnt(0)" ::: "memory")
__device__ __forceinline__ unsigned long long rt() { return __builtin_amdgcn_s_memrealtime(); }
__device__ __forceinline__ unsigned f2bf(float f) { unsigned u = __builtin_bit_cast(unsigned, f); return (u + 0x7fffu + ((u >> 16) & 1u)) >> 16; }
__device__ __forceinline__ unsigned pk2(float lo, float hi) { return f2bf(lo) | (f2bf(hi) << 16); }

#define XB_TMO      128
#define XB_XCNT(j)  (256  + 64 * (j))
#define XB_XSUB(j)  (1280 + 64 * (j))
#define XB_XGEN(j)  (2304 + 64 * (j))
#define XB_TOP      3328
#define XB_TOPGEN   3392
#define XCD_BAR_WORDS 3456
#define XB_SPIN_CAP (1u << 22)

__device__ __forceinline__ unsigned xb_ld(unsigned* p)              { return __hip_atomic_load(p, __ATOMIC_RELAXED, __HIP_MEMORY_SCOPE_AGENT); }
__device__ __forceinline__ unsigned xb_add(unsigned* p, unsigned v) { return __hip_atomic_fetch_add(p, v, __ATOMIC_RELAXED, __HIP_MEMORY_SCOPE_AGENT); }
__device__ __forceinline__ unsigned xb_xcc_id() { return (unsigned)__builtin_amdgcn_s_getreg((3 << 11) | 20) & 0xFu; }
#define XB_SPIN(cond, bar) do { unsigned _sp = 0; while (cond) { __builtin_amdgcn_s_sleep(1); \
    if ((++_sp & 255u) == 0u) { if (xb_ld(&(bar)[XB_TMO])) break; if (_sp > XB_SPIN_CAP) { atomicAdd(&(bar)[XB_TMO], 1u); break; } } } } while (0)

struct XcdBarrier {
    unsigned* bar; unsigned x;
    volatile LAS unsigned* st;
};

__device__ __forceinline__ XcdBarrier xcd_barrier_post(unsigned* bar, volatile LAS unsigned* st) {
    XcdBarrier b; b.bar = bar; b.x = xb_xcc_id(); b.st = st;
    if (threadIdx.x == 0) (void)xb_add(&bar[XB_XCNT(b.x)], 1u);
    return b;
}
__device__ __forceinline__ void xcd_barrier_complete(unsigned* bar, unsigned x, unsigned& nloc, unsigned& nx) {
    const unsigned G = gridDim.x * gridDim.y * gridDim.z;
    unsigned sum, cnt, mine, sp = 0u;
    for (;;) {
        sum = 0u; cnt = 0u; mine = 0u;
#pragma unroll
        for (unsigned j = 0; j < 16; ++j) { const unsigned c = xb_ld(&bar[XB_XCNT(j)]); sum += c; cnt += (c > 0u) ? 1u : 0u; mine = (j == x) ? c : mine; }
        if (sum == G) break;
        __builtin_amdgcn_s_sleep(1);
        if ((++sp & 255u) == 0u) { if (xb_ld(&bar[XB_TMO])) break; if (sp > XB_SPIN_CAP) { atomicAdd(&bar[XB_TMO], 1u); break; } }
    }
    nloc = mine > 0u ? mine : 1u; nx = cnt > 0u ? cnt : 1u;
}

__device__ __forceinline__ void xcd_barrier(const XcdBarrier& b) {
    asm volatile("s_waitcnt vmcnt(0)" ::: "memory");
    __syncthreads();
    if (threadIdx.x == 0) {
        unsigned* bar = b.bar;
        __builtin_amdgcn_s_waitcnt(0);
        unsigned nloc = b.st[0], nx = b.st[1];
        if (nloc == 0u) { xcd_barrier_complete(bar, b.x, nloc, nx); b.st[0] = nloc; b.st[1] = nx; }
        const unsigned old = xb_add(&bar[XB_XSUB(b.x)], 1u);
        const unsigned gen = old / nloc;
        if (old + 1u == (gen + 1u) * nloc) {
            __builtin_amdgcn_fence(__ATOMIC_RELEASE, "agent");
            asm volatile("s_waitcnt vmcnt(0)" ::: "memory");
            const unsigned og = xb_add(&bar[XB_TOP], 1u);
            const unsigned tg = og / nx;
            if (og + 1u == (tg + 1u) * nx) xb_add(&bar[XB_TOPGEN], 1u);
            else XB_SPIN(xb_ld(&bar[XB_TOPGEN]) == tg, bar);
            __builtin_amdgcn_fence(__ATOMIC_ACQUIRE, "agent");
            xb_add(&bar[XB_XGEN(b.x)], 1u);
            asm volatile("s_waitcnt vmcnt(0)" ::: "memory");
        } else {
            XB_SPIN(xb_ld(&bar[XB_XGEN(b.x)]) == gen, bar);
            __builtin_amdgcn_fence(__ATOMIC_ACQUIRE, "agent");
            asm volatile("s_waitcnt vmcnt(0)" ::: "memory");
        }
    }
    __syncthreads();
}

constexpr int NWAVES = 8;
constexpr int M = 16384, DM = 1024, SEQL = 4096, NPROJ = 3072, NIN = 3088, NQ = 2048, NLAYER = 2;
constexpr int C_Q = 0, C_K = 512, C_V = 1024, C_SB = 1536, C_SC = 1792, C_SH = 2048, C_GQ = 2304, C_GK = 2432, C_GV = 2560, C_GR = 2816;
constexpr float EPS = 1e-6f;
constexpr float ATT_C2 = 0.125f * 1.4426950408889634f;

constexpr size_t MiB = 1u << 20;
constexpr size_t WS_CTL = 0, CTL_ZERO_BYTES = 1 * MiB;
constexpr size_t WS_WIN = 1 * MiB, WIN_STRIDE = 7 * MiB;
constexpr size_t WS_WOUT = 15 * MiB, WOUT_STRIDE = 2 * MiB;
constexpr size_t WS_WQ = 19 * MiB, WQ_STRIDE = 4 * MiB;
constexpr size_t WS_KEYS = 27 * MiB, KEYS_STRIDE = 65536;
constexpr size_t WS_COS = 28 * MiB, WS_SIN = 28 * MiB + 512 * 1024;
constexpr size_t WS_SSQ = 29 * MiB;
constexpr size_t WS_GD = 30 * MiB;
constexpr size_t WS_LAM = 30 * MiB + 512 * 1024;
constexpr size_t WS_PAR = 30 * MiB + 768 * 1024;
constexpr int PAR_DN = 0, PAR_CW = 256, PAR_WG2 = 1792, PAR_BG = 5888, PAR_GN = 6144, PAR_NF = 6272, PAR_N = 7296;
constexpr size_t WS_GU = 31 * MiB;
constexpr size_t WS_GB = 39 * MiB;
constexpr size_t WS_EXP = 47 * MiB;
constexpr size_t WS_GATE = 55 * MiB;
constexpr size_t WS_U16 = 64 * MiB, TAB_STRIDE = 32 * MiB;
constexpr size_t WS_V16 = 128 * MiB;
constexpr size_t WS_XB = 192 * MiB;
constexpr size_t WS_PROJ = 224 * MiB;
constexpr size_t WS_OATT = 320 * MiB;
constexpr size_t WS_MIXED = 352 * MiB;
constexpr size_t WS_QP = 384 * MiB;
constexpr size_t WS_END = 448 * MiB;
constexpr int CW_TMO = 0, CW_BAR = 4096;

constexpr int RING_OFF = 0, RING_BYTES = 131072;
constexpr int LDSCTL_OFF = RING_BYTES, MISC_OFF = LDSCTL_OFF + 320;
constexpr int LDS_BYTES = 147456;

struct Frame {
    LAS unsigned char* lds;
    volatile LAS unsigned* MISC;
    int tid, lane, wave;
    int vcu, G, bx;
    float* out; unsigned char* ws;
};
__device__ __forceinline__ float wave_sum(float v) { return xl_wave_sum(v); }
__device__ __forceinline__ float bflo(unsigned w) { return __builtin_bit_cast(float, w << 16); }
__device__ __forceinline__ float bfhi(unsigned w) { return __builtin_bit_cast(float, w & 0xffff0000u); }
__device__ __forceinline__ float bf1(bf16 h) { return __builtin_bit_cast(float, (unsigned)h << 16); }

__device__ __forceinline__ void p0_transpose_item(const float* W, int ldw, int N, const float* gain, bf16* WT, int K, LAS float* scr, int item, int lane) {
    const int nblk = (N + 31) / 32, kb = item / nblk, nb = item % nblk, k0 = 64 * kb, n0 = 32 * nb;
    const int nn = n0 + (lane & 31);
#pragma unroll 8
    for (int i = 0; i < 32; ++i) { const int kk = 2 * i + (lane >> 5); float w = (nn < N) ? W[(size_t)(k0 + kk) * ldw + nn] : 0.f; if (gain) w *= gain[k0 + kk]; scr[kk * 33 + (lane & 31)] = w; }
    LDS_WAIT(); asm volatile("" ::: "memory");
    const int c = lane & 7;
#pragma unroll
    for (int j = 0; j < 4; ++j) { const int n = (lane >> 3) + 8 * j; const LAS float* s = scr + (8 * c) * 33 + n;
        v4u o; o.x = pk2(s[0 * 33], s[1 * 33]); o.y = pk2(s[2 * 33], s[3 * 33]); o.z = pk2(s[4 * 33], s[5 * 33]); o.w = pk2(s[6 * 33], s[7 * 33]);
        if (n0 + n < N) *(GAS v4u*)(WT + (size_t)(n0 + n) * K + k0 + 8 * c) = o; }
    LDS_WAIT(); asm volatile("" ::: "memory");
}
struct Args;
template <class A> __device__ __forceinline__ void p0_prologue(Frame& F, const A& args) {
    const float* const* in_ = nullptr; (void)in_;
    LAS float* scr = (LAS float*)(F.lds + RING_OFF + F.wave * 16384);
    const int gw = F.vcu * NWAVES + F.wave, NGW = F.G * NWAVES;
    const int gt = F.vcu * (NWAVES * 64) + F.tid, NGT = F.G * NWAVES * 64;
    constexpr int I_IN = 16 * 97, I_OUT = 16 * 32, I_Q = 16 * 64, I_L = I_IN + I_OUT + I_Q;
    for (int it = gw; it < NLAYER * I_L; it += NGW) {
        const int l = it / I_L; int r = it % I_L;
        if (r < I_IN) { p0_transpose_item(args.in[3] + (size_t)l * DM * NIN, NIN, NIN, args.in[2] + l * DM, (bf16*)(F.ws + WS_WIN + l * WIN_STRIDE), DM, scr, r, F.lane); continue; } r -= I_IN;
        if (r < I_OUT) { p0_transpose_item(args.in[13] + (size_t)l * DM * DM, DM, DM, nullptr, (bf16*)(F.ws + WS_WOUT + l * WOUT_STRIDE), DM, scr, r, F.lane); continue; } r -= I_OUT;
        p0_transpose_item(args.in[15] + (size_t)l * DM * NQ, NQ, NQ, args.in[14] + l * DM, (bf16*)(F.ws + WS_WQ + l * WQ_STRIDE), DM, scr, r, F.lane);
    }
    for (int i = gt; i < NLAYER * 2 * 16384; i += NGT) { const int l = i >> 15, hf = (i >> 14) & 1, e = i & 16383;
        ((bf16*)(F.ws + WS_KEYS + l * KEYS_STRIDE))[hf * 16384 + e] = (bf16)f2bf((hf ? args.in[17] : args.in[16])[(size_t)l * 16384 + e]); }
    for (size_t i = gt; i < (size_t)NLAYER * 2 * 2097152; i += NGT) {
        const int l = (int)(i / (2 * 2097152)); const size_t r = i % (2 * 2097152); const int tab = (int)(r / 2097152); const size_t q = r % 2097152;
        const float* src = (tab ? args.in[19] : args.in[18]) + (size_t)l * 16777216 + q * 8; const f32x4 a = *(const f32x4*)src, b = *(const f32x4*)(src + 4);
        f32x4 ga = (f32x4){1.f, 1.f, 1.f, 1.f}, gb = ga;
        if (tab == 0) { const float* g = args.in[14] + l * DM + (int)((q * 8) & 1023); ga = *(const f32x4*)g; gb = *(const f32x4*)(g + 4); }
        v4u o; o.x = pk2(a[0] * ga[0], a[1] * ga[1]); o.y = pk2(a[2] * ga[2], a[3] * ga[3]); o.z = pk2(b[0] * gb[0], b[1] * gb[1]); o.w = pk2(b[2] * gb[2], b[3] * gb[3]);
        *(v4u*)(F.ws + (tab ? WS_V16 : WS_U16) + l * TAB_STRIDE + q * 16) = o;
    }
    for (int m = gw; m < M; m += NGW) {
        const f32x4* xr = (const f32x4*)(args.in[0] + (size_t)m * DM) + F.lane; f32x4* orow = (f32x4*)(F.out + (size_t)m * DM) + F.lane;
        unsigned long long* o8 = (unsigned long long*)((bf16*)(F.ws + WS_XB) + (size_t)m * DM) + F.lane; float s = 0.f;
#pragma unroll
        for (int j = 0; j < 4; ++j) { const f32x4 v = xr[64 * j]; orow[64 * j] = v; s += (v[0] * v[0] + v[1] * v[1]) + (v[2] * v[2] + v[3] * v[3]);
            o8[64 * j] = (unsigned long long)pk2(v[0], v[1]) | ((unsigned long long)pk2(v[2], v[3]) << 32); }
        s = wave_sum(s);
        if (F.lane < 16) ((float*)(F.ws + WS_SSQ))[(size_t)m * 16 + F.lane] = (F.lane == 0) ? s : 0.f;
    }
    for (int i = gt; i < M * 8; i += NGT) { const int m = i >> 3, j = i & 7; const double inv = pow(500000.0, -(double)j / 8.0); const double ang = (double)((const int*)args.in[1])[m] * inv;
        ((float*)(F.ws + WS_COS))[i] = (float)cos(ang); ((float*)(F.ws + WS_SIN))[i] = (float)sin(ang); }
    if (gt < NLAYER) { const int l = gt; float a = 0.f, b = 0.f;
        for (int i = 0; i < 64; ++i) { a += args.in[4][l * 64 + i] * args.in[5][l * 64 + i]; b += args.in[6][l * 64 + i] * args.in[7][l * 64 + i]; }
        const float lam_init = 0.8f - 0.6f * expf(-0.3f * (float)l);
        ((float*)(F.ws + WS_LAM))[l * 2] = expf(a) - expf(b) + lam_init; ((float*)(F.ws + WS_LAM))[l * 2 + 1] = 1.0f - lam_init; }
    { float* par = (float*)(F.ws + WS_PAR);
      for (int i = gt; i < PAR_N; i += NGT) { float v;
          if (i < PAR_CW) v = args.in[8][i]; else if (i < PAR_WG2) v = args.in[9][i - PAR_CW]; else if (i < PAR_BG) v = args.in[10][i - PAR_WG2]; else if (i < PAR_GN) v = args.in[11][i - PAR_BG];
          else if (i < PAR_NF) v = args.in[12][i - PAR_GN]; else v = args.in[20][i - PAR_NF];
          par[i] = v; } }
}

__device__ __forceinline__ float log_sigmoid(float x) { return x < 0.f ? x - log1pf(expf(x)) : -log1pf(expf(-x)); }
template <int K> __device__ __forceinline__ void lds_mm_2x4(float (&acc)[2][4], const LAS float* X, int ldx, const LAS float* Y, int ldy) {
#pragma unroll 4
    for (int k = 0; k < K; k += 4) {
        const f32x4 x0 = *(const LAS f32x4*)(X + k), x1 = *(const LAS f32x4*)(X + ldx + k);
#pragma unroll
        for (int kk = 0; kk < 4; ++kk) { const f32x4 y = *(const LAS f32x4*)(Y + (k + kk) * ldy);
#pragma unroll
            for (int b = 0; b < 4; ++b) { acc[0][b] += x0[kk] * y[b]; acc[1][b] += x1[kk] * y[b]; } }
    }
}
__device__ __forceinline__ void gla_prep(Frame& F, int l, int ci) {
    typedef float f32x4m __attribute__((ext_vector_type(4)));
    LAS float* Bq = (LAS float*)(F.lds + RING_OFF);
    LAS float* Kh = Bq + 64 * 128;
    LAS bf16* Vv = (LAS bf16*)(Kh + 64 * 128);
    LAS float* LR = (LAS float*)(Vv + 64 * 256);
    const int t0 = ci * 64, tid = F.tid, lane = F.lane, wave = F.wave;
    const bf16* XB = (const bf16*)(F.ws + WS_XB); const bf16* PROJ = (const bf16*)(F.ws + WS_PROJ);
    const bf16* Wlr = (const bf16*)(F.ws + WS_WIN + l * WIN_STRIDE) + (size_t)NPROJ * DM;
    {
        const int mt = wave & 3, kh = wave >> 2, fr = lane & 15, fq = lane >> 4;
        f32x4m acc = (f32x4m){0.f, 0.f, 0.f, 0.f};
        const bf16* ap = XB + (size_t)(t0 + mt * 16 + fr) * DM + kh * 512 + fq * 8; const bf16* bp = Wlr + (size_t)fr * DM + kh * 512 + fq * 8;
#pragma unroll 4
        for (int ks = 0; ks < 16; ++ks) { const bf16x8 a = *(const bf16x8*)(ap + ks * 32), b = *(const bf16x8*)(bp + ks * 32); acc = __builtin_amdgcn_mfma_f32_16x16x32_bf16(a, b, acc, 0, 0, 0); }
#pragma unroll
        for (int i = 0; i < 4; ++i) LR[kh * 1024 + (mt * 16 + fq * 4 + i) * 16 + fr] = acc[i];
    }
    __syncthreads();
    {
        const int t = tid >> 3, dg = tid & 7; const float rs = pg8::row_rstd((const float*)(F.ws + WS_SSQ), t0 + t);
        float lr[16];
#pragma unroll
        for (int r = 0; r < 16; ++r) lr[r] = (LR[t * 16 + r] + LR[1024 + t * 16 + r]) * rs;
        const float* W2 = (const float*)(F.ws + WS_PAR) + PAR_WG2 + l * 16 * 128; const float* bg = (const float*)(F.ws + WS_PAR) + PAR_BG + l * 128;
#pragma unroll 4
        for (int dd = 0; dd < 16; ++dd) { const int d = dg * 16 + dd; float x = bg[d];
#pragma unroll
            for (int r = 0; r < 16; ++r) x += lr[r] * W2[r * 128 + d];
            Bq[t * 128 + d] = log_sigmoid(x) * (1.0f / 16.0f); }
    }
    __syncthreads();
    if (tid < 128) { float run = 0.f; for (int t = 0; t < 64; ++t) { run += Bq[t * 128 + tid]; Bq[t * 128 + tid] = run; } }
    __syncthreads();
    {
        float* GB = (float*)(F.ws + WS_GB) + (size_t)t0 * 128;
        for (int idx = tid; idx < 8192; idx += 512) { const int t = idx >> 7, d = idx & 127; const float bb = Bq[idx]; GB[idx] = bb;
            Kh[idx] = bf1(PROJ[(size_t)(t0 + t) * NPROJ + C_GK + d]) * expf(Bq[63 * 128 + d] - bb); }
        for (int q = tid; q < 2048; q += 512) { const int t = q >> 5, c16 = q & 31; *(LAS v4u*)(Vv + t * 256 + c16 * 8) = *(const v4u*)(PROJ + (size_t)(t0 + t) * NPROJ + C_GV + c16 * 8); }
        if (tid < 128) ((float*)(F.ws + WS_GD))[ci * 128 + tid] = expf(Bq[63 * 128 + tid]);
    }
    __syncthreads();
    {
        const int h = tid >> 7, dt = (tid >> 4) & 7, et = tid & 15; float acc[4][4];
#pragma unroll
        for (int a = 0; a < 4; ++a)
#pragma unroll
            for (int b = 0; b < 4; ++b) acc[a][b] = 0.f;
#pragma unroll 4
        for (int j = 0; j < 64; ++j) { const f32x4 kd = *(const LAS f32x4*)(Kh + j * 128 + h * 32 + dt * 4); const unsigned long long vw = *(const LAS unsigned long long*)(Vv + j * 256 + h * 64 + et * 4);
            const unsigned w0 = (unsigned)vw, w1 = (unsigned)(vw >> 32); const float ve[4] = {bflo(w0), bfhi(w0), bflo(w1), bfhi(w1)};
#pragma unroll
            for (int a = 0; a < 4; ++a)
#pragma unroll
                for (int b = 0; b < 4; ++b) acc[a][b] += kd[a] * ve[b]; }
        float* GU = (float*)(F.ws + WS_GU) + ((size_t)(ci * 4 + h) * 32 + dt * 4) * 64 + et * 4;
#pragma unroll
        for (int a = 0; a < 4; ++a) *(f32x4*)(GU + a * 64) = (f32x4){acc[a][0], acc[a][1], acc[a][2], acc[a][3]};
    }
    __syncthreads();
}
__device__ __forceinline__ void gla_scan(Frame& F) {
    if (F.tid < 128) { const int gid = F.vcu * 128 + F.tid;
        if (gid < 32768) { const int b = gid >> 13, h = (gid >> 11) & 3, d = (gid >> 6) & 31, e = gid & 63; float s = 0.f;
            float* GU = (float*)(F.ws + WS_GU); const float* GD = (const float*)(F.ws + WS_GD);
            for (int c0 = 0; c0 < 64; c0 += 16) { float u[16], dc[16];
#pragma unroll
                for (int i = 0; i < 16; ++i) { const int ci = b * 64 + c0 + i; u[i] = GU[((size_t)(ci * 4 + h) * 32 + d) * 64 + e]; dc[i] = GD[ci * 128 + h * 32 + d]; }
#pragma unroll
                for (int i = 0; i < 16; ++i) { const int ci = b * 64 + c0 + i; GU[((size_t)(ci * 4 + h) * 32 + d) * 64 + e] = s; s = dc[i] * s + u[i]; } } } }
}
__device__ __forceinline__ void mix_chunk(Frame& F, int l, int ci) {
    LAS float* qh = (LAS float*)(F.lds + RING_OFF);
    LAS float* kT = qh + 64 * 36;
    LAS float* vh = kT + 32 * 68;
    LAS float* Am = vh + 64 * 68;
    LAS float* Sm = Am + 64 * 68;
    const int t0 = ci * 64, tid = F.tid, lane = F.lane, wave = F.wave;
    const bf16* PROJ = (const bf16*)(F.ws + WS_PROJ); bf16* MIXED = (bf16*)(F.ws + WS_MIXED);
    const float* GB = (const float*)(F.ws + WS_GB) + (size_t)t0 * 128;
    for (int h = 0; h < 4; ++h) {
        for (int idx = tid; idx < 2048; idx += 512) { const int t = idx >> 5, d = idx & 31; const float bb = GB[t * 128 + h * 32 + d]; const float eb = expf(bb);
            const bf16* pr = PROJ + (size_t)(t0 + t) * NPROJ;
            qh[t * 36 + d] = bf1(pr[C_GQ + h * 32 + d]) * 0.17677669529663687f * eb; kT[d * 68 + t] = bf1(pr[C_GK + h * 32 + d]) * expf(-bb); }
        for (int idx = tid; idx < 4096; idx += 512) { const int t = idx >> 6, e = idx & 63; vh[t * 68 + e] = bf1(PROJ[(size_t)(t0 + t) * NPROJ + C_GV + h * 64 + e]); }
        { const float* GU = (const float*)(F.ws + WS_GU) + (size_t)(ci * 4 + h) * 2048; for (int idx = tid; idx < 2048; idx += 512) Sm[(idx >> 6) * 68 + (idx & 63)] = GU[idx]; }
        __syncthreads();
        const int i0 = 2 * (tid >> 4), n0 = 4 * (tid & 15);
        { float acc[2][4] = {{0.f, 0.f, 0.f, 0.f}, {0.f, 0.f, 0.f, 0.f}};
          lds_mm_2x4<32>(acc, qh + i0 * 36, 36, kT + n0, 68);
#pragma unroll
          for (int a = 0; a < 2; ++a)
#pragma unroll
              for (int b = 0; b < 4; ++b) Am[(i0 + a) * 68 + n0 + b] = (n0 + b <= i0 + a) ? acc[a][b] : 0.f; }
        __syncthreads();
        float o[2][4] = {{0.f, 0.f, 0.f, 0.f}, {0.f, 0.f, 0.f, 0.f}};
        lds_mm_2x4<64>(o, Am + i0 * 68, 68, vh + n0, 68);
        lds_mm_2x4<32>(o, qh + i0 * 36, 36, Sm + n0, 68);
        const float* gn = (const float*)(F.ws + WS_PAR) + PAR_GN + l * 64;
#pragma unroll
        for (int a = 0; a < 2; ++a) { float ss = (o[a][0] * o[a][0] + o[a][1] * o[a][1]) + (o[a][2] * o[a][2] + o[a][3] * o[a][3]);
            ss += xl_swz<1>(ss); ss += xl_swz<2>(ss); ss += xl_swz<4>(ss); ss += xl_swz<8>(ss);
            const float rs = 1.0f / sqrtf(ss * (1.0f / 64.0f) + EPS); const size_t row = (size_t)(t0 + i0 + a);
            const unsigned long long rw = *(const unsigned long long*)(PROJ + row * NPROJ + C_GR + h * 64 + n0); const unsigned r0 = (unsigned)rw, r1 = (unsigned)(rw >> 32);
            const float rr[4] = {bflo(r0), bfhi(r0), bflo(r1), bfhi(r1)}; float y[4];
#pragma unroll
            for (int b = 0; b < 4; ++b) { const float sl = rr[b] / (1.0f + expf(-rr[b])); y[b] = o[a][b] * rs * gn[n0 + b] * sl; }
            *(unsigned long long*)(MIXED + row * DM + 768 + h * 64 + n0) = (unsigned long long)pk2(y[0], y[1]) | ((unsigned long long)pk2(y[2], y[3]) << 32); }
        __syncthreads();
    }
    const float lam = ((const float*)(F.ws + WS_LAM))[l * 2], oscale = ((const float*)(F.ws + WS_LAM))[l * 2 + 1];
    const bf16* OATT = (const bf16*)(F.ws + WS_OATT); const float* dn = (const float*)(F.ws + WS_PAR) + PAR_DN + l * 128; const float* cw = (const float*)(F.ws + WS_PAR) + PAR_CW + l * 3 * 256;
    for (int rr = 0; rr < 8; ++rr) { const int t = t0 + wave * 8 + rr; const int s = t & (SEQL - 1);
#pragma unroll
        for (int h = 0; h < 4; ++h) { const unsigned w1 = *(const unsigned*)(OATT + (size_t)t * DM + h * 128 + 2 * lane), w2 = *(const unsigned*)(OATT + (size_t)t * DM + 512 + h * 128 + 2 * lane);
            const float o0 = bflo(w1) - lam * bflo(w2), o1 = bfhi(w1) - lam * bfhi(w2); const float ss = wave_sum(o0 * o0 + o1 * o1);
            const float rs = oscale / sqrtf(ss * (1.0f / 128.0f) + EPS);
            *(unsigned*)(MIXED + (size_t)t * DM + h * 128 + 2 * lane) = pk2(o0 * rs * dn[2 * lane], o1 * rs * dn[2 * lane + 1]); }
        { const int ch = 4 * lane; float y[4] = {0.f, 0.f, 0.f, 0.f}; float bgv[4] = {0.f, 0.f, 0.f, 0.f};
#pragma unroll
          for (int back = 0; back < 3; ++back) { if (s - back >= 0) { const bf16* pr = PROJ + (size_t)(t - back) * NPROJ;
              const unsigned long long cwd = *(const unsigned long long*)(pr + C_SC + ch), hwd = *(const unsigned long long*)(pr + C_SH + ch);
              const unsigned c0 = (unsigned)cwd, c1 = (unsigned)(cwd >> 32), h0 = (unsigned)hwd, h1 = (unsigned)(hwd >> 32);
              const float z[4] = {bflo(c0) * bflo(h0), bfhi(c0) * bfhi(h0), bflo(c1) * bflo(h1), bfhi(c1) * bfhi(h1)}; const float* wj = cw + (2 - back) * 256 + ch;
#pragma unroll
              for (int i = 0; i < 4; ++i) y[i] += wj[i] * z[i];
              if (back == 0) { const unsigned long long bwd = *(const unsigned long long*)(pr + C_SB + ch); const unsigned b0 = (unsigned)bwd, b1 = (unsigned)(bwd >> 32); bgv[0] = bflo(b0); bgv[1] = bfhi(b0); bgv[2] = bflo(b1); bgv[3] = bfhi(b1); } } }
          *(unsigned long long*)(MIXED + (size_t)t * DM + 512 + ch) = (unsigned long long)pk2(bgv[0] * y[0], bgv[1] * y[1]) | ((unsigned long long)pk2(bgv[2] * y[2], bgv[3] * y[3]) << 32); }
    }
}

#define TK_HD __device__ __forceinline__
#ifndef TK_HD
#define TK_HD __device__ __forceinline__
#endif
TK_HD int tk_max(int a, int b) { return a > b ? a : b; }
TK_HD int tk_min(int a, int b) { return a < b ? a : b; }
TK_HD int tk_f2key(float f) { int b = __builtin_bit_cast(int, f); return b ^ ((b >> 31) & 0x7fffffff); }
TK_HD float tk_key2f(int k) { return __builtin_bit_cast(float, k ^ ((k >> 31) & 0x7fffffff)); }
template <int N> TK_HD void tk_sort_desc(int (&a)[N]) {
#pragma unroll
    for (int k = 2; k <= N; k <<= 1)
#pragma unroll
        for (int j = k >> 1; j > 0; j >>= 1)
#pragma unroll
            for (int i = 0; i < N; ++i) { const int l = i ^ j; if (l > i) { const int hi = tk_max(a[i], a[l]), lo = tk_min(a[i], a[l]); if ((i & k) == 0) { a[i] = hi; a[l] = lo; } else { a[i] = lo; a[l] = hi; } } }
}
template <int N> TK_HD void tk_merge_desc(int (&a)[N]) {
#pragma unroll
    for (int j = N >> 1; j > 0; j >>= 1)
#pragma unroll
        for (int i = 0; i < N; ++i) { const int l = i ^ j; if (l > i) { const int hi = tk_max(a[i], a[l]), lo = tk_min(a[i], a[l]); a[i] = hi; a[l] = lo; } }
}
TK_HD void tk_top16_merge(int (&a)[16], const int (&b)[16]) {
#pragma unroll
    for (int i = 0; i < 16; ++i) a[i] = tk_max(a[i], b[15 - i]);
    tk_merge_desc<16>(a);
}
TK_HD constexpr int tk_cand_i(int set, int s) {
    if (set == 0) return s < 16 ? 0 : (s < 24 ? 1 : (s == 24 ? 8 : -1));
    return s < 5 ? 2 : s < 9 ? 3 : s < 12 ? 4 : s < 14 ? 5 : s < 16 ? 6 : s < 18 ? 7 : s < 25 ? (9 + (s - 18)) : -1;
}
TK_HD constexpr int tk_cand_j(int set, int s) {
    if (set == 0) return s < 16 ? s : (s < 24 ? s - 16 : (s == 24 ? 0 : -1));
    return s < 5 ? s : s < 9 ? s - 5 : s < 12 ? s - 9 : s < 14 ? s - 12 : s < 16 ? s - 14 : s < 18 ? s - 16 : s < 25 ? 0 : -1;
}

__device__ __forceinline__ void peer_select_task(Frame& F, int l, int t0, int h, LAS int* scr  ) {
    typedef float f32x16 __attribute__((ext_vector_type(16)));
    const int lane = F.lane, r32 = lane & 31, hi = lane >> 5;
    const bf16* QP = (const bf16*)(F.ws + WS_QP); const bf16* KEYS = (const bf16*)(F.ws + WS_KEYS + l * KEYS_STRIDE);
    int lists[2][16];
#pragma unroll
    for (int half = 0; half < 2; ++half) {
        bf16x8 qf[8];
        const bf16* qp = QP + (size_t)(t0 + r32) * NQ + h * 256 + half * 128 + hi * 8;
#pragma unroll
        for (int ks = 0; ks < 8; ++ks) qf[ks] = *(const bf16x8*)(qp + ks * 16);
        int cur[16];
#pragma unroll
        for (int kb = 0; kb < 4; ++kb) {
            f32x16 c = {};
            const bf16* kp = KEYS + half * 16384 + (size_t)(kb * 32 + r32) * 128 + hi * 8;
#pragma unroll
            for (int ks = 0; ks < 8; ++ks) { const bf16x8 kf = *(const bf16x8*)(kp + ks * 16); c = __builtin_amdgcn_mfma_f32_32x32x16_bf16(kf, qf[ks], c, 0, 0, 0); }
            int g[16];
#pragma unroll
            for (int r = 0; r < 16; ++r) { const int key = kb * 32 + (r & 3) + 8 * (r >> 2) + 4 * hi; g[r] = (tk_f2key(c[r]) & ~127) | (127 - key); }
            tk_sort_desc<16>(g);
            if (kb == 0) {
#pragma unroll
                for (int r = 0; r < 16; ++r) cur[r] = g[r];
            } else tk_top16_merge(cur, g);
        }
        int oth[16];
#pragma unroll
        for (int r = 0; r < 16; ++r) oth[r] = xl_xor32_i(cur[r], hi);
        tk_top16_merge(cur, oth);
#pragma unroll
        for (int r = 0; r < 16; ++r) lists[half][r] = cur[r];
    }
#pragma unroll
    for (int r = 0; r < 16; ++r) scr[r32 * 32 + hi * 16 + r] = 127 - ((hi ? lists[1][r] : lists[0][r]) & 127);
    float v1[16], v2[16];
#pragma unroll
    for (int r = 0; r < 16; ++r) { v1[r] = tk_key2f(lists[0][r]); v2[r] = tk_key2f(lists[1][r]); }
    int c[32];
#pragma unroll
    for (int s = 0; s < 32; ++s) {
        constexpr int NEG = (int)0x80000000;
        const int ia = tk_cand_i(0, s), ja = tk_cand_j(0, s), ib = tk_cand_i(1, s), jb = tk_cand_j(1, s);
        if (ia < 0) c[s] = NEG;
        else { const int ka = (tk_f2key(v1[ia] + v2[ja]) & ~255) | (255 - (ia * 16 + ja)), kb2 = (tk_f2key(v1[ib] + v2[jb]) & ~255) | (255 - (ib * 16 + jb)); c[s] = hi ? kb2 : ka; }
    }
    tk_sort_desc<32>(c);
    int fin[16], oth[16];
#pragma unroll
    for (int r = 0; r < 16; ++r) { fin[r] = c[r]; oth[r] = xl_xor32_i(c[r], hi); }
    tk_top16_merge(fin, oth);
    float p[16]; float sum = 0.f; const float mx = tk_key2f(fin[0]);
#pragma unroll
    for (int r = 0; r < 16; ++r) { p[r] = expf(tk_key2f(fin[r]) - mx); sum += p[r]; }
    const float inv = 1.0f / sum;
    asm volatile("s_waitcnt lgkmcnt(0)" ::: "memory");
    int* EX = (int*)(F.ws + WS_EXP) + (size_t)(t0 + r32) * 128 + h * 16; float* GT = (float*)(F.ws + WS_GATE) + (size_t)(t0 + r32) * 128 + h * 16;
#pragma unroll
    for (int r = 0; r < 16; ++r) { const int code = 255 - (fin[r] & 255); const int e1 = scr[r32 * 32 + (code >> 4)], e2 = scr[r32 * 32 + 16 + (code & 15)];
        if ((r >> 3) == hi) { EX[r] = e1 * 128 + e2; GT[r] = p[r] * inv; } }
    asm volatile("s_waitcnt lgkmcnt(0)" ::: "memory");
}

__device__ __forceinline__ float gelu_erf(float x) { return 0.5f * x * (1.0f + erff(x * 0.70710678118654752f)); }
typedef __bf16 bf16x2_t __attribute__((ext_vector_type(2)));
__device__ __forceinline__ float dot2bf(unsigned a, unsigned b, float c) { return __builtin_amdgcn_fdot2_f32_bf16(__builtin_bit_cast(bf16x2_t, a), __builtin_bit_cast(bf16x2_t, b), c, false); }
__device__ __forceinline__ void peer_token(Frame& F, int l, int t, bool last) {
    const int lane = F.lane;
    float* X = F.out + (size_t)t * DM; bf16* XBr = (bf16*)(F.ws + WS_XB) + (size_t)t * DM;
    const unsigned char* Ub = F.ws + WS_U16 + l * TAB_STRIDE; const unsigned char* Vb = F.ws + WS_V16 + l * TAB_STRIDE;
    const float rstd = pg8::row_rstd((const float*)(F.ws + WS_SSQ), t);
    const v4u xa = *(const v4u*)(XBr + 8 * lane), xb = *(const v4u*)(XBr + 512 + 8 * lane);
    const int* EX = (const int*)(F.ws + WS_EXP) + (size_t)t * 128; const float* GT = (const float*)(F.ws + WS_GATE) + (size_t)t * 128;
    float out[16];
#pragma unroll
    for (int i = 0; i < 16; ++i) out[i] = 0.f;
    for (int batch = 0; batch < 2; ++batch) {
        const int e_l = EX[batch * 64 + lane]; const float g_l = GT[batch * 64 + lane];
        float p[64];
#pragma unroll
        for (int kk = 0; kk < 64; ++kk) { const int e = __builtin_amdgcn_readlane(e_l, kk); const unsigned char* rowp = Ub + (size_t)e * 2048 + 16 * lane;
            const v4u ua = *(const v4u*)rowp, ub = *(const v4u*)(rowp + 1024); float a = 0.f;
            a = dot2bf(ua.x, xa.x, a); a = dot2bf(ua.y, xa.y, a); a = dot2bf(ua.z, xa.z, a); a = dot2bf(ua.w, xa.w, a);
            a = dot2bf(ub.x, xb.x, a); a = dot2bf(ub.y, xb.y, a); a = dot2bf(ub.z, xb.z, a); a = dot2bf(ub.w, xb.w, a); p[kk] = a; }
#pragma unroll
        for (int i = 0; i < 32; ++i) { const float pa = p[i], pb = p[i + 32]; auto r = __builtin_amdgcn_permlane32_swap(__builtin_bit_cast(unsigned, pa), __builtin_bit_cast(unsigned, pb), false, false); const unsigned r0 = r[0], r1 = r[1]; p[i] = __builtin_bit_cast(float, r0) + __builtin_bit_cast(float, r1); }
#pragma unroll
        for (int i = 0; i < 16; ++i) { const float pa = p[i], pb = p[i + 16]; auto r = __builtin_amdgcn_permlane16_swap(__builtin_bit_cast(unsigned, pa), __builtin_bit_cast(unsigned, pb), false, false); const unsigned r0 = r[0], r1 = r[1]; p[i] = __builtin_bit_cast(float, r0) + __builtin_bit_cast(float, r1); }
#define PT_BFLY(S) _Pragma("unroll") for (int i = 0; i < S; ++i) { const bool up = (lane & S) != 0; const float keep = up ? p[i + S] : p[i], send = up ? p[i] : p[i + S]; p[i] = keep + xl_swz<S>(send); }
        PT_BFLY(8) PT_BFLY(4) PT_BFLY(2) PT_BFLY(1)
#undef PT_BFLY
        const float hval = p[0] * rstd; const float c_l = g_l * gelu_erf(hval);
#pragma unroll 8
        for (int kk = 0; kk < 64; ++kk) { const int e = __builtin_amdgcn_readlane(e_l, kk); const float c = __builtin_bit_cast(float, __builtin_amdgcn_readlane(__builtin_bit_cast(int, c_l), kk));
            const unsigned char* rowp = Vb + (size_t)e * 2048 + 16 * lane; const v4u va = *(const v4u*)rowp, vb = *(const v4u*)(rowp + 1024);
            out[0] += c * bflo(va.x); out[1] += c * bfhi(va.x); out[2] += c * bflo(va.y); out[3] += c * bfhi(va.y); out[4] += c * bflo(va.z); out[5] += c * bfhi(va.z); out[6] += c * bflo(va.w); out[7] += c * bfhi(va.w);
            out[8] += c * bflo(vb.x); out[9] += c * bfhi(vb.x); out[10] += c * bflo(vb.y); out[11] += c * bfhi(vb.y); out[12] += c * bflo(vb.z); out[13] += c * bfhi(vb.z); out[14] += c * bflo(vb.w); out[15] += c * bfhi(vb.w); }
    }
    f32x4 x0 = *(const f32x4*)(X + 8 * lane), x1 = *(const f32x4*)(X + 8 * lane + 4), x2 = *(const f32x4*)(X + 512 + 8 * lane), x3 = *(const f32x4*)(X + 512 + 8 * lane + 4);
    x0 += (f32x4){out[0], out[1], out[2], out[3]}; x1 += (f32x4){out[4], out[5], out[6], out[7]}; x2 += (f32x4){out[8], out[9], out[10], out[11]}; x3 += (f32x4){out[12], out[13], out[14], out[15]};
    float ss = 0.f;
#pragma unroll
    for (int i = 0; i < 4; ++i) ss += x0[i] * x0[i] + x1[i] * x1[i] + x2[i] * x2[i] + x3[i] * x3[i];
    ss = wave_sum(ss);
    if (last) { const float rs = 1.0f / sqrtf(ss * (1.0f / 1024.0f) + EPS); const float* g = (const float*)(F.ws + WS_PAR) + PAR_NF;
        const f32x4 g0 = *(const f32x4*)(g + 8 * lane), g1 = *(const f32x4*)(g + 8 * lane + 4), g2 = *(const f32x4*)(g + 512 + 8 * lane), g3 = *(const f32x4*)(g + 512 + 8 * lane + 4);
        x0 = x0 * rs * g0; x1 = x1 * rs * g1; x2 = x2 * rs * g2; x3 = x3 * rs * g3; }
    *(f32x4*)(X + 8 * lane) = x0; *(f32x4*)(X + 8 * lane + 4) = x1; *(f32x4*)(X + 512 + 8 * lane) = x2; *(f32x4*)(X + 512 + 8 * lane + 4) = x3;
    if (!last) { v4u wa, wb; wa.x = pk2(x0[0], x0[1]); wa.y = pk2(x0[2], x0[3]); wa.z = pk2(x1[0], x1[1]); wa.w = pk2(x1[2], x1[3]); wb.x = pk2(x2[0], x2[1]); wb.y = pk2(x2[2], x2[3]); wb.z = pk2(x3[0], x3[1]); wb.w = pk2(x3[2], x3[3]);
        *(v4u*)(XBr + 8 * lane) = wa; *(v4u*)(XBr + 512 + 8 * lane) = wb;
        if (lane < 16) ((float*)(F.ws + WS_SSQ))[(size_t)t * 16 + lane] = (lane == 0) ? ss : 0.f; }
}

constexpr int NPHASE = 1 + 8 * NLAYER;
struct Args { const float* in[21]; float* out; unsigned char* ws; int ph_lo, ph_hi, use_bar, pad; };
__global__ void __launch_bounds__(NWAVES * 64, 2) hymba_fwd(Args args) {
    extern __shared__ __attribute__((aligned(16))) unsigned char lds[];
    Frame F;
    F.lds = (LAS unsigned char*)lds;
    F.MISC = (volatile LAS unsigned*)(F.lds + MISC_OFF);
    F.tid = threadIdx.x; F.lane = F.tid & 63; F.wave = __builtin_amdgcn_readfirstlane(F.tid >> 6);
    F.G = gridDim.x; F.bx = blockIdx.x; { const int bx = blockIdx.x; F.vcu = (F.G % 8 == 0) ? (bx % 8) * (F.G / 8) + bx / 8 : bx; }
    F.out = args.out; F.ws = args.ws;
    for (int u = F.tid; u < (LDS_BYTES - LDSCTL_OFF) / 4; u += NWAVES * 64) ((LAS unsigned*)(F.lds + LDSCTL_OFF))[u] = 0u;
    __syncthreads();
    XcdBarrier bar; bar.bar = ((unsigned*)(args.ws + WS_CTL) + CW_BAR); bar.x = 0; bar.st = nullptr;
    if (args.use_bar) bar = xcd_barrier_post(((unsigned*)(args.ws + WS_CTL) + CW_BAR), F.MISC + 8);
    const int lo = args.ph_lo, hi = args.ph_hi;
#ifndef PHMASK
#define PHMASK 0x1ff
#endif
#define IN(k) (((PHMASK >> ((k) == 0 ? 0 : 1 + (((k) - 1) & 7))) & 1) && lo <= (k) && (k) < hi)
#define SEAM(k) do { if (IN(k) && IN((k) + 1)) { XcdBarrier b_ = bar; int zb_ = 0; asm volatile("" : "+s"(zb_), "+s"(b_.x)); b_.bar = bar.bar + zb_; xcd_barrier(b_); } FRESH(); } while (0)
#define FRESH() do { int ln_; int wv_ = wave0; asm volatile("v_mbcnt_lo_u32_b32 %0, -1, 0\n\tv_mbcnt_hi_u32_b32 %0, -1, %0" : "=v"(ln_)); asm volatile("" : "+s"(wv_)); F.lane = ln_; F.wave = wv_; F.tid = wv_ * 64 + ln_; \
        int z_ = 0, v_ = vcu0, g_ = (int)gridDim.x, bx_ = (int)blockIdx.x; asm volatile("" : "+s"(z_), "+s"(v_), "+s"(g_), "+s"(bx_)); F.ws = args.ws + z_; F.out = args.out + z_; F.vcu = v_; F.G = g_; F.bx = bx_; } while (0)
    if (IN(0)) { p0_prologue(F, args); }
    const int vcu0 = F.vcu, wave0 = F.wave;
    SEAM(0);
    { constexpr int l = 0;

        const int pb = 1 + 8 * l;
        if (IN(pb + 0)) {
            pg8::Gemm g{(const pg8::bf16_t*)(F.ws + WS_XB), (const pg8::bf16_t*)(F.ws + WS_WIN + l * WIN_STRIDE), M, NPROJ, DM}; pg8::StaticOrder S; S.init(M, NPROJ, F.G, F.bx);
            pg8::EpiScale<true> E{(pg8::bf16_t*)(F.ws + WS_PROJ), NPROJ, (const float*)(F.ws + WS_SSQ), (const float*)(F.ws + WS_COS), (const float*)(F.ws + WS_SIN), ATT_C2};
            pg8::gemm_phase<pg8::EpiScale<true>, pg8::StaticOrder, PG8_ALIGN, PG8_SP2>(F.lds + RING_OFF, g, S, E, F.tid);
        }
        SEAM(pb + 0);
        if (IN(pb + 1)) {
            { const attn_body::StaticOrder S(F.vcu);     attn_body::attn_phase<attn_body::StaticOrder>((char*)lds + RING_OFF, (const attn_body::bf16*)(F.ws + WS_PROJ), (attn_body::bf16*)(F.ws + WS_OATT), S, F.tid); }
            __syncthreads(); FRESH();
            for (int ci = F.vcu; ci < 256; ci += F.G) gla_prep(F, l, ci);
        }
        SEAM(pb + 1);
        if (IN(pb + 2)) gla_scan(F);
        SEAM(pb + 2);
        if (IN(pb + 3)) { for (int ci = F.vcu; ci < 256; ci += F.G) mix_chunk(F, l, ci); }
        SEAM(pb + 3);
        if (IN(pb + 4)) {
            pg8::Gemm g{(const pg8::bf16_t*)(F.ws + WS_MIXED), (const pg8::bf16_t*)(F.ws + WS_WOUT + l * WOUT_STRIDE), M, DM, DM}; pg8::StaticOrder S; S.init(M, DM, F.G, F.bx);
            pg8::EpiRes E{F.out, (pg8::bf16_t*)(F.ws + WS_XB), (float*)(F.ws + WS_SSQ)};
            pg8::gemm_phase<pg8::EpiRes, pg8::StaticOrder, PG8_ALIGN, PG8_SP2>(F.lds + RING_OFF, g, S, E, F.tid);
        }
        SEAM(pb + 4);
        if (IN(pb + 5)) {
            pg8::Gemm g{(const pg8::bf16_t*)(F.ws + WS_XB), (const pg8::bf16_t*)(F.ws + WS_WQ + l * WQ_STRIDE), M, NQ, DM}; pg8::StaticOrder S; S.init(M, NQ, F.G, F.bx);
            pg8::EpiScale<false> E{(pg8::bf16_t*)(F.ws + WS_QP), NQ, (const float*)(F.ws + WS_SSQ), nullptr, nullptr, 1.0f};
            pg8::gemm_phase<pg8::EpiScale<false>, pg8::StaticOrder, PG8_ALIGN, PG8_SP2>(F.lds + RING_OFF, g, S, E, F.tid);
        }
        SEAM(pb + 5);
        if (IN(pb + 6)) {
            LAS int* scr = (LAS int*)(F.lds + RING_OFF) + F.wave * 1024;
            const int gw = F.vcu * NWAVES + F.wave, NGW = F.G * NWAVES;
            for (int task = gw; task < 4096; task += NGW) peer_select_task(F, l, (task >> 3) * 32, task & 7, scr);
        }
        SEAM(pb + 6);
        if (IN(pb + 7)) {
            const int gw = F.vcu * NWAVES + F.wave, NGW = F.G * NWAVES;
            for (int t = gw; t < M; t += NGW) peer_token(F, l, t, l == NLAYER - 1);
        }
        SEAM(pb + 7);

    }
    { constexpr int l = 1;

        const int pb = 1 + 8 * l;
        if (IN(pb + 0)) {
            pg8::Gemm g{(const pg8::bf16_t*)(F.ws + WS_XB), (const pg8::bf16_t*)(F.ws + WS_WIN + l * WIN_STRIDE), M, NPROJ, DM}; pg8::StaticOrder S; S.init(M, NPROJ, F.G, F.bx);
            pg8::EpiScale<true> E{(pg8::bf16_t*)(F.ws + WS_PROJ), NPROJ, (const float*)(F.ws + WS_SSQ), (const float*)(F.ws + WS_COS), (const float*)(F.ws + WS_SIN), ATT_C2};
            pg8::gemm_phase<pg8::EpiScale<true>, pg8::StaticOrder, PG8_ALIGN, PG8_SP2>(F.lds + RING_OFF, g, S, E, F.tid);
        }
        SEAM(pb + 0);
        if (IN(pb + 1)) {
            { const attn_body::StaticOrder S(F.vcu);     attn_body::attn_phase<attn_body::StaticOrder>((char*)lds + RING_OFF, (const attn_body::bf16*)(F.ws + WS_PROJ), (attn_body::bf16*)(F.ws + WS_OATT), S, F.tid); }
            __syncthreads(); FRESH();
            for (int ci = F.vcu; ci < 256; ci += F.G) gla_prep(F, l, ci);
        }
        SEAM(pb + 1);
        if (IN(pb + 2)) gla_scan(F);
        SEAM(pb + 2);
        if (IN(pb + 3)) { for (int ci = F.vcu; ci < 256; ci += F.G) mix_chunk(F, l, ci); }
        SEAM(pb + 3);
        if (IN(pb + 4)) {
            pg8::Gemm g{(const pg8::bf16_t*)(F.ws + WS_MIXED), (const pg8::bf16_t*)(F.ws + WS_WOUT + l * WOUT_STRIDE), M, DM, DM}; pg8::StaticOrder S; S.init(M, DM, F.G, F.bx);
            pg8::EpiRes E{F.out, (pg8::bf16_t*)(F.ws + WS_XB), (float*)(F.ws + WS_SSQ)};
            pg8::gemm_phase<pg8::EpiRes, pg8::StaticOrder, PG8_ALIGN, PG8_SP2>(F.lds + RING_OFF, g, S, E, F.tid);
        }
        SEAM(pb + 4);
        if (IN(pb + 5)) {
            pg8::Gemm g{(const pg8::bf16_t*)(F.ws + WS_XB), (const pg8::bf16_t*)(F.ws + WS_WQ + l * WQ_STRIDE), M, NQ, DM}; pg8::StaticOrder S; S.init(M, NQ, F.G, F.bx);
            pg8::EpiScale<false> E{(pg8::bf16_t*)(F.ws + WS_QP), NQ, (const float*)(F.ws + WS_SSQ), nullptr, nullptr, 1.0f};
            pg8::gemm_phase<pg8::EpiScale<false>, pg8::StaticOrder, PG8_ALIGN, PG8_SP2>(F.lds + RING_OFF, g, S, E, F.tid);
        }
        SEAM(pb + 5);
        if (IN(pb + 6)) {
            LAS int* scr = (LAS int*)(F.lds + RING_OFF) + F.wave * 1024;
            const int gw = F.vcu * NWAVES + F.wave, NGW = F.G * NWAVES;
            for (int task = gw; task < 4096; task += NGW) peer_select_task(F, l, (task >> 3) * 32, task & 7, scr);
        }
        SEAM(pb + 6);
        if (IN(pb + 7)) {
            const int gw = F.vcu * NWAVES + F.wave, NGW = F.G * NWAVES;
            for (int t = gw; t < M; t += NGW) peer_token(F, l, t, l == NLAYER - 1);
        }
        SEAM(pb + 7);

    }
#undef IN
#undef SEAM
}

#ifndef MK_DEBUG
#define MK_DEBUG 0
#endif
#ifndef DBG_LO
#define DBG_LO 0
#endif
#if MK_DEBUG
constexpr size_t WS_DBG = 30 * MiB + 896 * 1024;
constexpr size_t WS_DLA = 384 * MiB;
__device__ __forceinline__ void dbg_max(float* res, int k, float d) { if (!(d == d)) d = 1e9f; atomicMax((unsigned*)res + k, __builtin_bit_cast(unsigned, fabsf(d))); }
__device__ __forceinline__ unsigned dbg_hash(unsigned x) { x ^= x >> 16; x *= 0x7feb352dU; x ^= x >> 15; x *= 0x846ca68bU; x ^= x >> 16; return x; }
__device__ __forceinline__ float dbg_rstd(const float* x) { float s = 0.f; for (int k = 0; k < DM; ++k) s += x[k] * x[k]; return 1.0f / sqrtf(s / DM + EPS); }
__global__ void dbg_c0(Args a) {
    float* res = (float*)(a.ws + WS_DBG); const int lane = threadIdx.x;
    const float v = (float)(lane * lane + 1); float exp_sum = 0.f; for (int i = 0; i < 64; ++i) exp_sum += (float)(i * i + 1);
    dbg_max(res, 16, xl_wave_sum(v) - exp_sum);
    dbg_max(res, 17, xl_swz<16>(v) - (float)((lane ^ 16) * (lane ^ 16) + 1));
    dbg_max(res, 18, xl_swz<4>(v) - (float)((lane ^ 4) * (lane ^ 4) + 1));
    dbg_max(res, 19, (float)(xl_xor32_i(lane * 3, lane >> 5) - (lane ^ 32) * 3));
    dbg_max(res, 20, xl_sum32(v) - (v + (float)((lane ^ 32) * (lane ^ 32) + 1)));
}
__global__ void dbg_c1(Args a) {
    const int s = blockIdx.x * blockDim.x + threadIdx.x; if (s >= 4096) return;
    float* res = (float*)(a.ws + WS_DBG);
    const unsigned hsh = dbg_hash(s * 2654435761u + 17u); const int row = hsh % M; int col = (hsh >> 14) % NPROJ; if (s < 1024) col = col % 1024;
    const float* x = a.in[0] + (size_t)row * DM; const float* g = a.in[2]; const float* W = a.in[3];
    const float rs = dbg_rstd(x);
    auto proj = [&](int c) { float acc = 0.f; for (int k = 0; k < DM; ++k) acc += x[k] * g[k] * W[(size_t)k * NIN + c]; return acc * rs; };
    float v = proj(col);
    if (col < 1024) { const int d = col & 63; if (d < 16) { const int j = d & 7; const int pos = ((const int*)a.in[1])[row]; const double ang = (double)pos * pow(500000.0, -(double)j / 8.0); const float c = (float)cos(ang), sn = (float)sin(ang);
            if (d < 8) { const float r2 = proj(col + 8); v = v * c - r2 * sn; } else { const float r1 = proj(col - 8); v = r1 * sn + v * c; } }
        if (col < 512) v *= ATT_C2; }
    const float got = bf1(((const bf16*)(a.ws + WS_PROJ))[(size_t)row * NPROJ + col]);
    const int k = col < 512 ? ((col & 63) < 16 ? 0 : 1) : col < 1024 ? ((col & 63) < 16 ? 2 : 3) : 4;
    dbg_max(res, k, got - v);
}
__global__ void dbg_c2(Args a) {
    const int s = blockIdx.x * blockDim.x + threadIdx.x; if (s >= 2048) return;
    float* res = (float*)(a.ws + WS_DBG); const bf16* P = (const bf16*)(a.ws + WS_PROJ);
    const unsigned hsh = dbg_hash(s * 2654435761u + 99u); int row = hsh % M; if (s < 64) row = (row & ~(SEQL - 1)) + (s & 63) * 65 % SEQL; const int h = (hsh >> 14) & 3, m = (hsh >> 16) & 1, e = (hsh >> 17) & 127;
    const int b = row / SEQL, sq = row % SEQL;
    const bf16* q = P + (size_t)row * NPROJ + h * 128 + m * 64;
    float mx = -1e30f;
    for (int j = 0; j <= sq; ++j) { const bf16* kk = P + (size_t)(b * SEQL + j) * NPROJ + 512 + h * 128 + m * 64; float sc = 0.f; for (int d = 0; d < 64; ++d) sc += bf1(q[d]) * bf1(kk[d]); mx = fmaxf(mx, sc); }
    float l = 0.f, o = 0.f;
    for (int j = 0; j <= sq; ++j) { const bf16* kk = P + (size_t)(b * SEQL + j) * NPROJ + 512 + h * 128 + m * 64; float sc = 0.f; for (int d = 0; d < 64; ++d) sc += bf1(q[d]) * bf1(kk[d]);
        const float p = exp2f(sc - mx); l += p; o += p * bf1(P[(size_t)(b * SEQL + j) * NPROJ + 1024 + h * 128 + e]); }
    const float got = bf1(((const bf16*)(a.ws + WS_OATT))[(size_t)row * DM + m * 512 + h * 128 + e]);
    dbg_max(res, 5 + m, got - o / l);
}
__global__ void dbg_c3a(Args a) {
    const int t = blockIdx.x; const int d = threadIdx.x;
    __shared__ float lr[16]; __shared__ float rs_s;
    const float* x = a.in[0] + (size_t)t * DM; const float* g = a.in[2]; const float* W = a.in[3];
    if (d == 0) rs_s = dbg_rstd(x);
    __syncthreads();
    if (d < 16) { float acc = 0.f; for (int k = 0; k < DM; ++k) acc += x[k] * g[k] * W[(size_t)k * NIN + NPROJ + d]; lr[d] = acc * rs_s; }
    __syncthreads();
    float xx = a.in[11][d]; for (int r = 0; r < 16; ++r) xx += lr[r] * a.in[10][r * 128 + d];
    ((float*)(a.ws + WS_DLA))[(size_t)t * 128 + d] = log_sigmoid(xx) / 16.0f;
}
__global__ void dbg_c3b(Args a) {
    const int b = blockIdx.x >> 2, h = blockIdx.x & 3, e = threadIdx.x;
    float* res = (float*)(a.ws + WS_DBG); const bf16* P = (const bf16*)(a.ws + WS_PROJ); const float* LA = (const float*)(a.ws + WS_DLA);
    float S[32]; for (int d = 0; d < 32; ++d) S[d] = 0.f;
    float md = 0.f;
    for (int t = 0; t < SEQL; ++t) { const size_t row = (size_t)b * SEQL + t; const bf16* pr = P + row * NPROJ; const float v = bf1(pr[C_GV + h * 64 + e]); float o = 0.f;
        for (int d = 0; d < 32; ++d) { S[d] = expf(LA[row * 128 + h * 32 + d]) * S[d] + bf1(pr[C_GK + h * 32 + d]) * v; o += bf1(pr[C_GQ + h * 32 + d]) * 0.17677669529663687f * S[d]; }
        float ss = o * o; for (int off = 1; off < 64; off <<= 1) ss += __shfl_xor(ss, off);
        const float r = bf1(pr[C_GR + h * 64 + e]); const float y = o / sqrtf(ss / 64.0f + EPS) * a.in[12][e] * (r / (1.0f + expf(-r)));
        const float got = bf1(((const bf16*)(a.ws + WS_MIXED))[row * DM + 768 + h * 64 + e]); md = fmaxf(md, fabsf(got - y)); if (!(got == got)) md = 1e9f; }
    dbg_max(res, 7, md);
}
__global__ void dbg_c3c(Args a) {
    float* res = (float*)(a.ws + WS_DBG); const bf16* P = (const bf16*)(a.ws + WS_PROJ); const bf16* OA = (const bf16*)(a.ws + WS_OATT); const bf16* MX = (const bf16*)(a.ws + WS_MIXED);
    const int row = dbg_hash(blockIdx.x * 977u + 5u) % M; const int tid = threadIdx.x;
    float lq = 0.f, lk = 0.f; for (int i = 0; i < 64; ++i) { lq += a.in[4][i] * a.in[5][i]; lk += a.in[6][i] * a.in[7][i]; }
    const float lam = expf(lq) - expf(lk) + 0.2f, osc = 0.8f;
    __shared__ float ssq[4]; if (tid < 4) ssq[tid] = 0.f; __syncthreads();
    float ov[2]; for (int i = 0; i < 2; ++i) { const int c = tid + 256 * i; ov[i] = bf1(OA[(size_t)row * DM + c]) - lam * bf1(OA[(size_t)row * DM + 512 + c]); atomicAdd(&ssq[c >> 7], ov[i] * ov[i]); }
    __syncthreads();
    for (int i = 0; i < 2; ++i) { const int c = tid + 256 * i; const float y = ov[i] / sqrtf(ssq[c >> 7] / 128.0f + EPS) * a.in[8][c & 127] * osc; dbg_max(res, 8, bf1(MX[(size_t)row * DM + c]) - y); }
    { const int ch = tid; const int s = row % SEQL; float y = 0.f; for (int back = 0; back < 3; ++back) if (s - back >= 0) { const bf16* pr = P + (size_t)(row - back) * NPROJ; y += a.in[9][(2 - back) * 256 + ch] * bf1(pr[C_SC + ch]) * bf1(pr[C_SH + ch]); }
      y *= bf1(P[(size_t)row * NPROJ + C_SB + ch]); dbg_max(res, 9, bf1(MX[(size_t)row * DM + 512 + ch]) - y); }
}
__global__ void dbg_c4(Args a) {
    const int s = blockIdx.x * blockDim.x + threadIdx.x; if (s >= 4096) return;
    float* res = (float*)(a.ws + WS_DBG); const unsigned hsh = dbg_hash(s * 2654435761u + 7u); const int row = hsh % M, col = (hsh >> 14) % DM;
    const bf16* mx = (const bf16*)(a.ws + WS_MIXED) + (size_t)row * DM; float acc = a.in[0][(size_t)row * DM + col];
    for (int k = 0; k < DM; ++k) acc += bf1(mx[k]) * a.in[13][(size_t)k * DM + col];
    dbg_max(res, 10, a.out[(size_t)row * DM + col] - acc);
    dbg_max(res, 11, bf1(((const bf16*)(a.ws + WS_XB))[(size_t)row * DM + col]) - acc);
}
__global__ void dbg_c5(Args a) {
    float* res = (float*)(a.ws + WS_DBG); const unsigned hsh = dbg_hash(blockIdx.x * 31337u + 3u); const int t = hsh % M, h = (hsh >> 14) & 7; const int tid = threadIdx.x;
    __shared__ float q[256]; __shared__ float sc[2][128]; __shared__ float rs_s; __shared__ float tv[2][16]; __shared__ int ti[2][16]; __shared__ float cand[256]; __shared__ float fv[16]; __shared__ int fi[16];
    const float* x = a.out + (size_t)t * DM;
    if (tid == 0) rs_s = dbg_rstd(x);
    __syncthreads();
    for (int c = tid; c < 256; c += 128) { float acc = 0.f; for (int k = 0; k < DM; ++k) acc += x[k] * a.in[14][k] * a.in[15][(size_t)k * NQ + h * 256 + c]; q[c] = acc * rs_s; }
    __syncthreads();
    for (int hf = 0; hf < 2; ++hf) { float acc = 0.f; const float* key = (hf ? a.in[17] : a.in[16]) + tid * 128; for (int d = 0; d < 128; ++d) acc += q[hf * 128 + d] * key[d]; sc[hf][tid] = acc; }
    __syncthreads();
    if (tid < 2) { for (int r = 0; r < 16; ++r) { int bi = 0; float bv = -1e30f; for (int n = 0; n < 128; ++n) if (sc[tid][n] > bv) { bv = sc[tid][n]; bi = n; } tv[tid][r] = bv; ti[tid][r] = bi; sc[tid][bi] = -1e30f; } }
    __syncthreads();
    for (int c = tid; c < 256; c += 128) cand[c] = tv[0][c >> 4] + tv[1][c & 15];
    __syncthreads();
    if (tid == 0) { for (int r = 0; r < 16; ++r) { int bi = 0; float bv = -1e30f; for (int n = 0; n < 256; ++n) if (cand[n] > bv) { bv = cand[n]; bi = n; } fv[r] = bv; fi[r] = ti[0][bi >> 4] * 128 + ti[1][bi & 15]; cand[bi] = -1e30f; }
        float sum = 0.f; for (int r = 0; r < 16; ++r) sum += expf(fv[r] - fv[0]);
        const int* EX = (const int*)(a.ws + WS_EXP) + (size_t)t * 128 + h * 16; const float* GT = (const float*)(a.ws + WS_GATE) + (size_t)t * 128 + h * 16;
        int missing = 0; float gd = 0.f;
        for (int r = 0; r < 16; ++r) { int found = -1; for (int k = 0; k < 16; ++k) if (EX[k] == fi[r]) found = k; if (found < 0) missing++; else gd = fmaxf(gd, fabsf(GT[found] - expf(fv[r] - fv[0]) / sum)); }
        dbg_max(res, 12, (float)missing); dbg_max(res, 13, gd); }
}
constexpr size_t WS_DX2 = 384 * MiB + 16 * MiB;
__global__ void dbg_c6a(Args a) {
    const int t = dbg_hash(blockIdx.x * 7919u + 1u) % M; const int tid = threadIdx.x;
    __shared__ float hv[128]; __shared__ float rs_s; const float* x = a.out + (size_t)t * DM;
    if (tid == 0) rs_s = dbg_rstd(x);
    __syncthreads();
    const int* EX = (const int*)(a.ws + WS_EXP) + (size_t)t * 128; const float* GT = (const float*)(a.ws + WS_GATE) + (size_t)t * 128;
    if (tid < 128) { const float* u = a.in[18] + (size_t)EX[tid] * DM; float acc = 0.f; for (int k = 0; k < DM; ++k) acc += u[k] * x[k] * a.in[14][k]; hv[tid] = GT[tid] * gelu_erf(acc * rs_s); }
    __syncthreads();
    for (int c = tid; c < DM; c += 256) { float acc = x[c]; for (int k = 0; k < 128; ++k) acc += hv[k] * a.in[19][(size_t)EX[k] * DM + c]; ((float*)(a.ws + WS_DX2))[(size_t)blockIdx.x * DM + c] = acc; }
}
__global__ void dbg_c6b(Args a) {
    float* res = (float*)(a.ws + WS_DBG); const int t = dbg_hash(blockIdx.x * 7919u + 1u) % M;
    for (int c = threadIdx.x; c < DM; c += 256) dbg_max(res, 14, a.out[(size_t)t * DM + c] - ((const float*)(a.ws + WS_DX2))[(size_t)blockIdx.x * DM + c]);
}
__global__ void dbg_report(Args a, int lo, int hi, float scale) {
    const float* res = (const float*)(a.ws + WS_DBG);
    const float tol[24] = {0.2f, 0.2f, 0.2f, 0.2f, 0.2f, 0.03f, 0.03f, 0.05f, 0.03f, 0.06f, 0.05f, 0.05f, 3.5f, 0.03f, 0.02f, 1e30f, 0.5f, 0.5f, 0.5f, 0.5f, 0.5f, 1e30f, 1e30f, 1e30f};
    __shared__ int kf;
    if (threadIdx.x == 0) { kf = -1; for (int k = lo; k < hi; ++k) if (res[k] > tol[k]) { kf = k; break; } }
    __syncthreads();
    if (kf < 0) return;
    const float B = 1e4f * fminf(res[kf], 50.0f);
    for (int i = blockIdx.x * blockDim.x + threadIdx.x; i < 4000000; i += gridDim.x * blockDim.x) a.out[i + 1024] = B;
    if (blockIdx.x == 0 && threadIdx.x == 0) a.out[0] = 1e6f * (float)(kf + 1);
}
#endif

#ifndef MK_PER_PHASE
#define MK_PER_PHASE 0
#endif
extern "C" void kernel_launch(void* const* d_in, const int* in_sizes, int n_in, void* d_out, int out_size, void* d_ws, size_t ws_size, hipStream_t stream) {
    static int grid = 0;
    if (grid == 0) {
        if (n_in != 21 || out_size != M * DM || ws_size < WS_END) { fprintf(stderr, "kernel_launch: unexpected shapes (n_in %d, out %d, ws %zu); nothing launched\n", n_in, out_size, ws_size); grid = -1; return; }
        int dev = 0, cus = 0, per_cu = 0;
        if (hipGetDevice(&dev) != hipSuccess || hipDeviceGetAttribute(&cus, hipDeviceAttributeMultiprocessorCount, dev) != hipSuccess) { grid = -1; return; }
        if (hipFuncSetAttribute((const void*)hymba_fwd, hipFuncAttributeMaxDynamicSharedMemorySize, LDS_BYTES) != hipSuccess) { fprintf(stderr, "kernel_launch: hipFuncSetAttribute failed\n"); grid = -1; return; }
        if (hipOccupancyMaxActiveBlocksPerMultiprocessor(&per_cu, (const void*)hymba_fwd, NWAVES * 64, LDS_BYTES) != hipSuccess || per_cu < 1) { fprintf(stderr, "kernel_launch: occupancy query reports %d workgroups per CU\n", per_cu); }
        (void)hipGetLastError();
        grid = cus;
    }
    if (grid < 0) return;
    (void)hipMemsetAsync((char*)d_ws + WS_CTL, 0, CTL_ZERO_BYTES, stream);
    Args a{};
    for (int i = 0; i < 21; ++i) a.in[i] = (const float*)d_in[i];
    a.out = (float*)d_out; a.ws = (unsigned char*)d_ws;
#if MK_PER_PHASE
#if MK_DEBUG
    (void)hipMemsetAsync((char*)d_ws + WS_DBG, 0, 256, stream);
#endif
    for (int ph = 0; ph < NPHASE; ++ph) { a.ph_lo = ph; a.ph_hi = ph + 1; a.use_bar = 0; hipLaunchKernelGGL(hymba_fwd, dim3(grid), dim3(NWAVES * 64), LDS_BYTES, stream, a);
#if MK_DEBUG
        if (ph == 0) hipLaunchKernelGGL(dbg_c0, dim3(1), dim3(64), 0, stream, a);
        if (ph == 1) hipLaunchKernelGGL(dbg_c1, dim3(16), dim3(256), 0, stream, a);
        if (ph == 2) hipLaunchKernelGGL(dbg_c2, dim3(8), dim3(256), 0, stream, a);
        if (ph == 4) { hipLaunchKernelGGL(dbg_c3a, dim3(M), dim3(128), 0, stream, a); hipLaunchKernelGGL(dbg_c3b, dim3(16), dim3(64), 0, stream, a); hipLaunchKernelGGL(dbg_c3c, dim3(128), dim3(256), 0, stream, a); }
        if (ph == 5) hipLaunchKernelGGL(dbg_c4, dim3(16), dim3(256), 0, stream, a);
        if (ph == 7) { hipLaunchKernelGGL(dbg_c5, dim3(64), dim3(128), 0, stream, a); hipLaunchKernelGGL(dbg_c6a, dim3(64), dim3(256), 0, stream, a); }
        if (ph == 8) hipLaunchKernelGGL(dbg_c6b, dim3(64), dim3(256), 0, stream, a);
#endif
    }
#if MK_DEBUG
    hipLaunchKernelGGL(dbg_report, dim3(256), dim3(256), 0, stream, a, DBG_LO, 24, 1000.0f);
#endif
#else
    a.ph_lo = 0; a.ph_hi = NPHASE; a.use_bar = 1;
    hipLaunchKernelGGL(hymba_fwd, dim3(grid), dim3(NWAVES * 64), LDS_BYTES, stream, a);
#endif
}
```

```cpp
#define MK_PER_PHASE 0
#define MK_DEBUG 0
#define REPMASK 0
#include <hip/hip_runtime.h>
#include <cstdio>
#include <cstdint>
template <int MASK> __device__ __forceinline__ int xl_swz_i(int v) { static_assert(MASK >= 1 && MASK < 32, "ds_swizzle bit mode works inside 32-lane groups");
    return __builtin_amdgcn_ds_swizzle(v, 0x1f | (MASK << 10)); }
template <int MASK> __device__ __forceinline__ float xl_swz(float v) { return __builtin_bit_cast(float, xl_swz_i<MASK>(__builtin_bit_cast(int, v))); }
__device__ __forceinline__ float xl_sum32(float v) {
    unsigned a = __builtin_bit_cast(unsigned, v), b = a; asm volatile("" : "+v"(b));
    auto r = __builtin_amdgcn_permlane32_swap(a, b, false, false);
    const unsigned r0 = r[0], r1 = r[1];
    return __builtin_bit_cast(float, r0) + __builtin_bit_cast(float, r1); }
__device__ __forceinline__ int xl_xor32_i(int v, int hi  ) {
    unsigned a = (unsigned)v, b = a; asm volatile("" : "+v"(b));
    auto r = __builtin_amdgcn_permlane32_swap(a, b, false, false); return hi ? (int)r[0] : (int)r[1]; }
__device__ __forceinline__ float xl_wave_sum(float v) {
    v += xl_swz<1>(v); v += xl_swz<2>(v); v += xl_swz<4>(v); v += xl_swz<8>(v); v += xl_swz<16>(v); return xl_sum32(v); }
namespace pg8 {
#define PG8_LAS __attribute__((address_space(3)))
typedef unsigned short bf16_t;
typedef short bf16x8 __attribute__((ext_vector_type(8)));
typedef float f32x4 __attribute__((ext_vector_type(4)));
typedef unsigned u32x4 __attribute__((ext_vector_type(4)));
constexpr int BM = 256, BK = 64, HALF = 128, HTB = HALF * BK * 2  , STAGE_BYTES = 8 * HTB, NXCD = 8, WGM = 8;

__host__ __device__ __forceinline__ int lds_byte(int r, int c) { const int st = (r >> 4) * 2 + (c >> 5), rr = r & 15, cc = c & 31, ob = rr * 64 + cc * 2; return st * 1024 + (ob ^ (((ob >> 9) & 1) << 5)); }
__host__ __device__ __forceinline__ void stage_rc(int b, int& R, int& C) { const int st = b / 1024, sb = b % 1024, swz = sb ^ (((sb >> 9) & 1) << 5); R = (st >> 1) * 16 + swz / 64; C = (st & 1) * 32 + (swz % 64) / 2; }
__host__ __device__ __forceinline__ int perm32(int rho) { const int n = rho >> 4, i = rho & 15; return 8 * (i >> 2) + 4 * n + (i & 3); }

struct Unit { int pm, pn; };
struct Gemm { const bf16_t* A; const bf16_t* Bt; int M, N, K; };

struct StaticOrder {
    int nM, nN, nwg, G, c;
    __host__ __device__ void init(int M, int N, int G_, int c_) { nM = M / BM; nN = N / BM; nwg = nM * nN; G = G_; c = c_; }
    __host__ __device__ bool next(int i, Unit& u) const {
        const long L = (long)i * G + c; if (L >= nwg) return false;
        int wgid = (int)L; { const int q = nwg / NXCD, r = nwg % NXCD, xcd = wgid % NXCD, off = wgid / NXCD; wgid = (xcd < r ? xcd * (q + 1) : r * (q + 1) + (xcd - r) * q) + off; }
        const int nig = WGM * nN, gid = wgid / nig, fm = gid * WGM, gsz = (nM - fm) < WGM ? (nM - fm) : WGM;
        u.pm = fm + ((wgid % nig) % gsz); u.pn = (wgid % nig) / gsz; return true;
    }
    __device__ __forceinline__ void a_ready(const Unit&) const {}
    __device__ __forceinline__ void done(const Unit&) const {}
};
__device__ __forceinline__ unsigned cvt_pk_bf16(float lo, float hi) { unsigned r; asm volatile("v_cvt_pk_bf16_f32 %0, %1, %2" : "=v"(r) : "v"(lo), "v"(hi)); return r; }
typedef float f32x2 __attribute__((ext_vector_type(2)));
__device__ __forceinline__ float row_rstd(const float* ssq, int r) {
    const f32x4* p = (const f32x4*)(ssq + (size_t)r * 16);
    const f32x4 a = p[0], b = p[1], c = p[2], d = p[3];
    const float s = ((a[0] + a[1]) + (a[2] + a[3])) + ((b[0] + b[1]) + (b[2] + b[3])) + ((c[0] + c[1]) + (c[2] + c[3])) + ((d[0] + d[1]) + (d[2] + d[3]));
    return 1.0f / sqrtf(s * (1.0f / 1024.0f) + 1e-6f);
}
template <bool ROPE> struct EpiScale {
    static constexpr bool PERM = true, AFTER_DRAIN = false;
    bf16_t* O; int ldc; const float* ssq; const float* cs; const float* sn; float qscale;
    __device__ __forceinline__ void operator()(const f32x4 (&acc)[2][2][4][2], const Unit& u, int wr, int wc, int fr, int fq) const {
        const int row0 = u.pm * BM + wr * 64 + fr; const int col0 = u.pn * BM + wc * 32 + 8 * fq;
        const bool rope = ROPE && (u.pn < 4) && ((wc & 1) == 0);
        const float sc = (ROPE && u.pn < 2) ? qscale : 1.0f;
        float rsv[2][4];
        if constexpr (ROPE) {
#pragma unroll
            for (int ai = 0; ai < 2; ++ai)
#pragma unroll
                for (int m = 0; m < 4; ++m) rsv[ai][m] = ssq[row0 + ai * HALF + m * 16];
        } else {
#pragma unroll
            for (int ai = 0; ai < 2; ++ai) { f32x4 p[4][4];
#pragma unroll
                for (int m = 0; m < 4; ++m) { const f32x4* q = (const f32x4*)(ssq + (size_t)(row0 + ai * HALF + m * 16) * 16); p[m][0] = q[0]; p[m][1] = q[1]; p[m][2] = q[2]; p[m][3] = q[3]; }
#pragma unroll
                for (int m = 0; m < 4; ++m) { const f32x4 t = (p[m][0] + p[m][1]) + (p[m][2] + p[m][3]); rsv[ai][m] = 1.0f / sqrtf(((t[0] + t[1]) + (t[2] + t[3])) * (1.0f / 1024.0f) + 1e-6f); } }
        }
#pragma unroll
        for (int ai = 0; ai < 2; ++ai)
#pragma unroll
            for (int m = 0; m < 4; ++m) {
                const int r = row0 + ai * HALF + m * 16;
                const float rs = rsv[ai][m] * sc;
                f32x4 c0 = (f32x4){1.f, 1.f, 1.f, 1.f}, c1 = c0, s0 = (f32x4){0.f, 0.f, 0.f, 0.f}, s1 = s0;
                if (rope && fq < 2) { c0 = *(const f32x4*)(cs + (size_t)r * 8); c1 = *(const f32x4*)(cs + (size_t)r * 8 + 4); s0 = *(const f32x4*)(sn + (size_t)r * 8); s1 = *(const f32x4*)(sn + (size_t)r * 8 + 4);
                    if (fq == 0) { s0 = -s0; s1 = -s1; } }
                bf16_t* rowp = O + (size_t)r * ldc + col0;
#pragma unroll
                for (int bj = 0; bj < 2; ++bj) {
                    f32x4 v0 = acc[ai][bj][m][0] * rs, v1 = acc[ai][bj][m][1] * rs;
                    if (rope) {
                        f32x4 o0, o1;
#pragma unroll
                        for (int i = 0; i < 4; ++i) { o0[i] = xl_swz<16>(v0[i]); o1[i] = xl_swz<16>(v1[i]); }
                        v0 = v0 * c0 + o0 * s0; v1 = v1 * c1 + o1 * s1;
                    }
                    u32x4 w; w.x = cvt_pk_bf16(v0[0], v0[1]); w.y = cvt_pk_bf16(v0[2], v0[3]); w.z = cvt_pk_bf16(v1[0], v1[1]); w.w = cvt_pk_bf16(v1[2], v1[3]);
                    *(u32x4*)(rowp + bj * HALF) = w;
                }
            }
    }
};
struct EpiRes {
    static constexpr bool PERM = false, AFTER_DRAIN = false;
    bf16_t* XB; float* ssq;
    __device__ __forceinline__ void operator()(const f32x4 (&acc)[2][2][4][2], const Unit& u, int wr, int wc, int fr, int fq) const {
        typedef unsigned u32x2v __attribute__((ext_vector_type(2)));
        const int col0 = u.pn * BM + wc * 32 + 4 * fq;
        u32x2v xw[2][4][2][2];
#pragma unroll
        for (int ai = 0; ai < 2; ++ai)
#pragma unroll
            for (int m = 0; m < 4; ++m) { const size_t off = (size_t)(u.pm * BM + ai * HALF + wr * 64 + m * 16 + fr) * 1024 + col0;
#pragma unroll
                for (int bj = 0; bj < 2; ++bj)
#pragma unroll
                    for (int n = 0; n < 2; ++n) xw[ai][m][bj][n] = *(const u32x2v*)(XB + off + bj * HALF + n * 16); }
#pragma unroll
        for (int ai = 0; ai < 2; ++ai)
#pragma unroll
            for (int m = 0; m < 4; ++m) {
                const int r = u.pm * BM + ai * HALF + wr * 64 + m * 16 + fr; const size_t off = (size_t)r * 1024 + col0; float ss = 0.f;
#pragma unroll
                for (int bj = 0; bj < 2; ++bj)
#pragma unroll
                    for (int n = 0; n < 2; ++n) { const size_t o = off + bj * HALF + n * 16; const u32x2v x = xw[ai][m][bj][n];
                        const f32x4 v = (f32x4){__builtin_bit_cast(float, x.x << 16), __builtin_bit_cast(float, x.x & 0xffff0000u), __builtin_bit_cast(float, x.y << 16), __builtin_bit_cast(float, x.y & 0xffff0000u)} + acc[ai][bj][m][n];
                        u32x2v w; w.x = cvt_pk_bf16(v[0], v[1]); w.y = cvt_pk_bf16(v[2], v[3]); *(u32x2v*)(XB + o) = w;
                        ss += (v[0] * v[0] + v[1] * v[1]) + (v[2] * v[2] + v[3] * v[3]); }
                ss += xl_swz<16>(ss); ss = xl_sum32(ss);
                if (fq == 0) ssq[(size_t)r * 16 + u.pn * 4 + wc] = ss;
            }
    }
};
template <class Epi, class Sched, bool ALIGN_EPI = false, bool SP2 = false>
__device__ __forceinline__ void gemm_phase(PG8_LAS unsigned char* lds, const Gemm g, const Sched& S, const Epi& E, const int tid) {
    const int wid = __builtin_amdgcn_readfirstlane(tid >> 6), lane = tid & 63, wr = wid >> 2, wc = wid & 3, fr = lane & 15, fq = lane >> 4;
    const int K = g.K, nt = K / BK;
    unsigned voffA[2], voffB[2];
#pragma unroll
    for (int i = 0; i < 2; ++i) { int R, C; stage_rc(tid * 16 + i * 8192, R, C); const int Rb = Epi::PERM ? ((R & ~31) + perm32(R & 31)) : R;
        voffA[i] = (unsigned)(R * K + C) * 2u; voffB[i] = (unsigned)(Rb * K + C) * 2u; }
    const size_t kstep = (size_t)(BK * 2);
    const size_t hstep = (size_t)HALF * K * 2;
    const size_t tstep = 2 * hstep;
    const unsigned ldsw = (unsigned)wid * 1024u;
    const int aoff = lds_byte(wr * 64 + fr, fq * 8), boff = lds_byte(wc * 32 + fr, fq * 8);
#define PG8_SA(b, h) (((b) * 2 + (h)) * HTB)
#define PG8_SB(b, h) ((4 + (b) * 2 + (h)) * HTB)
#define PG8_STAGE(bufoff, gbase, voff) do { _Pragma("unroll") for (int _i = 0; _i < 2; ++_i) \
        __builtin_amdgcn_global_load_lds((const unsigned*)((const char*)(gbase) + (voff)[_i]), (PG8_LAS unsigned*)(lds + (bufoff) + ldsw + _i * 8192), 16, 0, 0); } while (0)
#define PG8_LDA(dst, b, h) do { _Pragma("unroll") for (int m = 0; m < 4; ++m) _Pragma("unroll") for (int k = 0; k < 2; ++k) dst[m][k] = *(const PG8_LAS bf16x8*)(lds + PG8_SA(b, h) + aoff + m * 2048 + k * 1024); } while (0)
#define PG8_LDB(dst, b, h) do { _Pragma("unroll") for (int n = 0; n < 2; ++n) _Pragma("unroll") for (int k = 0; k < 2; ++k) dst[n][k] = *(const PG8_LAS bf16x8*)(lds + PG8_SB(b, h) + boff + n * 2048 + k * 1024); } while (0)
#define PG8_MMA(ai, bj, At, Bt) do { __builtin_amdgcn_s_setprio(1); _Pragma("unroll") for (int m = 0; m < 4; ++m) _Pragma("unroll") for (int n = 0; n < 2; ++n) _Pragma("unroll") for (int k = 0; k < 2; ++k) \
        acc[ai][bj][m][n] = __builtin_amdgcn_mfma_f32_16x16x32_bf16(Bt[n][k], At[m][k], acc[ai][bj][m][n], 0, 0, 0); __builtin_amdgcn_s_setprio(0); } while (0)
#define PG8_WAIT_V(n) asm volatile("s_waitcnt vmcnt(" #n ")" ::: "memory")
#define PG8_WAIT_L(n) asm volatile("s_waitcnt lgkmcnt(" #n ")" ::: "memory")
#define PG8_BAR __builtin_amdgcn_s_barrier()
#define PG8_SCHED __builtin_amdgcn_sched_barrier(0)
    Unit cur, nxt; int ui = 0;
    if (!S.next(0, cur)) return;
    f32x4 acc[2][2][4][2];
#pragma unroll
    for (int a = 0; a < 2; ++a)
#pragma unroll
        for (int b = 0; b < 2; ++b)
#pragma unroll
            for (int m = 0; m < 4; ++m)
#pragma unroll
                for (int n = 0; n < 2; ++n) acc[a][b][m][n] = (f32x4){0.f, 0.f, 0.f, 0.f};
    bf16x8 At[4][2], B0[2][2], B1[2][2];
    const char* cA = (const char*)g.A + (size_t)cur.pm * tstep; const char* cB = (const char*)g.Bt + (size_t)cur.pn * tstep;
    S.a_ready(cur);
    if constexpr (SP2) {
        PG8_STAGE(PG8_SB(0, 0), cB, voffB); PG8_STAGE(PG8_SB(0, 1), cB + hstep, voffB); PG8_STAGE(PG8_SA(0, 0), cA, voffA); PG8_STAGE(PG8_SA(0, 1), cA + hstep, voffA);
        if (wr == 1) PG8_BAR;
        PG8_WAIT_V(2); PG8_BAR;
        PG8_STAGE(PG8_SB(1, 0), cB + kstep, voffB); PG8_STAGE(PG8_SA(1, 0), cA + kstep, voffA); PG8_STAGE(PG8_SB(1, 1), cB + hstep + kstep, voffB);
        PG8_WAIT_V(6); PG8_BAR;
    } else {
        PG8_STAGE(PG8_SB(0, 0), cB, voffB); PG8_STAGE(PG8_SA(0, 0), cA, voffA); PG8_STAGE(PG8_SB(0, 1), cB + hstep, voffB); PG8_STAGE(PG8_SA(0, 1), cA + hstep, voffA);
        if (wr == 1) PG8_BAR;
        PG8_WAIT_V(4); PG8_BAR;
        PG8_STAGE(PG8_SB(1, 0), cB + kstep, voffB); PG8_STAGE(PG8_SA(1, 0), cA + kstep, voffA); PG8_STAGE(PG8_SB(1, 1), cB + hstep + kstep, voffB);
        PG8_WAIT_V(6); PG8_BAR;
    }
    for (;;) {
        const bool has_next = S.next(ui + 1, nxt);
        const char* nA = has_next ? (const char*)g.A + (size_t)nxt.pm * tstep : cA; const char* nB = has_next ? (const char*)g.Bt + (size_t)nxt.pn * tstep : cB;
        for (int t = 0; t < nt; t += 2) {
            const bool last = (t == nt - 2);
            const char* a1 = cA + (size_t)(t + 1) * kstep;
            const char* a2 = last ? nA : cA + (size_t)(t + 2) * kstep; const char* b2 = last ? nB : cB + (size_t)(t + 2) * kstep;
            const char* a3 = a2 + kstep; const char* b3 = b2 + kstep;
            if (last && has_next) S.a_ready(nxt);
            if constexpr (SP2) {
            PG8_LDB(B0, 0, 0); PG8_LDB(B1, 0, 1); PG8_SCHED; PG8_LDA(At, 0, 0); PG8_STAGE(PG8_SA(1, 1), a1 + hstep, voffA);
            PG8_WAIT_V(8); PG8_WAIT_L(0); PG8_BAR; PG8_MMA(0, 0, At, B0); PG8_MMA(0, 1, At, B1); PG8_BAR; PG8_SCHED;
            PG8_LDA(At, 0, 1); PG8_STAGE(PG8_SB(0, 0), b2, voffB); PG8_STAGE(PG8_SB(0, 1), b2 + hstep, voffB); PG8_STAGE(PG8_SA(0, 0), a2, voffA);
            PG8_WAIT_V(8); PG8_WAIT_L(0); PG8_BAR; PG8_MMA(1, 0, At, B0); PG8_MMA(1, 1, At, B1); PG8_BAR; PG8_SCHED;
            PG8_LDB(B0, 1, 0); PG8_LDB(B1, 1, 1); PG8_SCHED; PG8_LDA(At, 1, 0); PG8_STAGE(PG8_SA(0, 1), a2 + hstep, voffA);
            PG8_WAIT_V(8); PG8_WAIT_L(0); PG8_BAR; PG8_MMA(0, 0, At, B0); PG8_MMA(0, 1, At, B1); PG8_BAR; PG8_SCHED;
            PG8_LDA(At, 1, 1); PG8_STAGE(PG8_SB(1, 0), b3, voffB); PG8_STAGE(PG8_SB(1, 1), b3 + hstep, voffB); PG8_STAGE(PG8_SA(1, 0), a3, voffA);
            PG8_WAIT_V(8); PG8_WAIT_L(0); PG8_BAR; PG8_MMA(1, 0, At, B0); PG8_MMA(1, 1, At, B1); PG8_BAR; PG8_SCHED;
            } else {
            PG8_LDB(B0, 0, 0); PG8_SCHED; PG8_LDA(At, 0, 0); PG8_STAGE(PG8_SA(1, 1), a1 + hstep, voffA);
            PG8_WAIT_L(8); PG8_BAR; PG8_WAIT_L(0); PG8_MMA(0, 0, At, B0); PG8_BAR; PG8_SCHED;
            PG8_LDB(B1, 0, 1); PG8_STAGE(PG8_SB(0, 0), b2, voffB);
            PG8_BAR; PG8_WAIT_L(0); PG8_MMA(0, 1, At, B1); PG8_BAR;
            PG8_LDA(At, 0, 1); PG8_STAGE(PG8_SA(0, 0), a2, voffA);
            PG8_BAR; PG8_WAIT_L(0); PG8_MMA(1, 0, At, B0); PG8_BAR; PG8_SCHED;
            PG8_STAGE(PG8_SB(0, 1), b2 + hstep, voffB);
            PG8_WAIT_V(6); PG8_BAR; PG8_MMA(1, 1, At, B1); PG8_BAR;
            PG8_LDB(B0, 1, 0); PG8_SCHED; PG8_LDA(At, 1, 0); PG8_STAGE(PG8_SA(0, 1), a2 + hstep, voffA);
            PG8_WAIT_L(8); PG8_BAR; PG8_WAIT_L(0); PG8_MMA(0, 0, At, B0); PG8_BAR; PG8_SCHED;
            PG8_LDB(B1, 1, 1); PG8_STAGE(PG8_SB(1, 0), b3, voffB);
            PG8_BAR; PG8_WAIT_L(0); PG8_MMA(0, 1, At, B1); PG8_BAR;
            PG8_LDA(At, 1, 1); PG8_STAGE(PG8_SA(1, 0), a3, voffA);
            PG8_BAR; PG8_WAIT_L(0); PG8_MMA(1, 0, At, B0); PG8_BAR; PG8_SCHED;
            PG8_STAGE(PG8_SB(1, 1), b3 + hstep, voffB);
            PG8_WAIT_V(6); PG8_BAR; PG8_MMA(1, 1, At, B1); PG8_BAR;
            }
        }
        if constexpr (ALIGN_EPI) { if (wr == 0) PG8_BAR; }
        if constexpr (!Epi::AFTER_DRAIN) { E(acc, cur, wr, wc, fr, fq); S.done(cur); }
        if (!has_next) break;
#pragma unroll
        for (int a = 0; a < 2; ++a)
#pragma unroll
            for (int b = 0; b < 2; ++b)
#pragma unroll
                for (int m = 0; m < 4; ++m)
#pragma unroll
                    for (int n = 0; n < 2; ++n) acc[a][b][m][n] = (f32x4){0.f, 0.f, 0.f, 0.f};
        cur = nxt; cA = nA; cB = nB; ++ui;
        if constexpr (ALIGN_EPI) { if (wr == 1) PG8_BAR; }
    }
    PG8_WAIT_V(0);
    if constexpr (!ALIGN_EPI) { if (wr == 0) PG8_BAR; }
    PG8_BAR;
    if constexpr (Epi::AFTER_DRAIN) { E.fused(acc, cur, wr, wc, fr, fq, lds, wid, lane); S.done(cur); }
#undef PG8_SA
#undef PG8_SB
#undef PG8_STAGE
#undef PG8_LDA
#undef PG8_LDB
#undef PG8_MMA
#undef PG8_WAIT_V
#undef PG8_WAIT_L
#undef PG8_BAR
#undef PG8_SCHED
}
}

#ifndef PG8_SP2
#define PG8_SP2 true
#endif
#ifndef PG8_ALIGN
#define PG8_ALIGN true
#endif
#include <hip/hip_bf16.h>
#include <cmath>
namespace attn_body {
using bf16=__hip_bfloat16;
using bf16x8=__attribute__((ext_vector_type(8)))short;
using s16x4=__attribute__((ext_vector_type(4)))short;
using f32x16=__attribute__((ext_vector_type(16)))float;
using u32x4=__attribute__((ext_vector_type(4)))unsigned;
constexpr int BATCH=4,SEQ=4096,D=64,PIN=3072,POUT=1024;
constexpr int NW=8,QBLK=32,QB=QBLK*NW,KVBLK=64,NQB=SEQ/QB;
constexpr int ATTN_UNIT_ROWS=QB;
__device__ __forceinline__ int crow(int r,int hi){return (r&3)+8*(r>>2)+4*hi;}
#define SBAR() __builtin_amdgcn_sched_barrier(0)
__device__ __forceinline__ void cmask(f32x16&p0,f32x16&p1,int jb,int qrel,int hi){
  const float NEG=-INFINITY; int kb=64*jb+4*hi; asm volatile("":"+v"(kb));
  #pragma unroll
  for(int r=0;r<16;++r){int kv=kb+(r&3)+8*(r>>2); if(kv>qrel)p0[r]=NEG; if(kv+32>qrel)p1[r]=NEG;}
}

constexpr int NSLOT=3, SLOTB=8192;
constexpr int LDS_K=0, LDS_V=NSLOT*SLOTB, LDS_WS=2*NSLOT*SLOTB, LDS_OST=LDS_WS+NW*64*4, LDS_BYTES=LDS_OST+NW*4096;
constexpr float C2=0.125f*1.4426950408889634f;
__device__ __forceinline__ void glds16(const void*gsrc,unsigned lds_dst){unsigned keep;
  asm volatile("s_mov_b32 %0, m0\n\ts_mov_b32 m0, %2\n\ts_nop 0\n\tglobal_load_lds_dwordx4 %1, off\n\ts_mov_b32 m0, %0":"=&s"(keep):"v"(gsrc),"s"(lds_dst):"memory");}
__device__ __forceinline__ void glds16s(const void*sbase,unsigned voff,unsigned lds_dst){unsigned keep;
  asm volatile("s_mov_b32 %0, m0\n\ts_mov_b32 m0, %3\n\ts_nop 0\n\tglobal_load_lds_dwordx4 %1, %2\n\ts_mov_b32 m0, %0":"=&s"(keep):"v"(voff),"s"(sbase),"s"(lds_dst):"memory");}
__device__ __forceinline__ float max3f(float a,float b,float c){float r;asm("v_max3_f32 %0, %1, %2, %3":"=v"(r):"v"(a),"v"(b),"v"(c));return r;}
__device__ __forceinline__ float max2f(float a,float b){float r;asm("v_max_f32_e32 %0, %1, %2":"=v"(r):"v"(a),"v"(b));return r;}
__device__ __forceinline__ float fadd_s(float a,float b){float r;asm("v_add_f32_e32 %0, %1, %2":"=v"(r):"v"(a),"v"(b));return r;}
__device__ __forceinline__ float fsub_s(float a,float b){float r;asm("v_sub_f32_e32 %0, %1, %2":"=v"(r):"v"(a),"v"(b));return r;}
typedef float f32x2_t __attribute__((ext_vector_type(2))); typedef __bf16 bf16x2_t __attribute__((ext_vector_type(2)));
__device__ __forceinline__ unsigned cvtpk_s(float lo,float hi){f32x2_t v={lo,hi};bf16x2_t b=__builtin_convertvector(v,bf16x2_t);return __builtin_bit_cast(unsigned,b);}
#define WAIT_BAR(N) asm volatile("s_waitcnt vmcnt(" #N ") lgkmcnt(0)\n\ts_barrier":::"memory")

__device__ __forceinline__ void qkt(f32x16&p0,f32x16&p1,const char*Kslot,const bf16x8*qr,const f32x16&negm,int r32,int hi){
  const char*kb=Kslot+hi*1024+r32*16;
  #pragma unroll
  for(int d0=0;d0<4;++d0){
    const bf16x8 b0=*reinterpret_cast<const bf16x8*>(kb+d0*2048);
    const bf16x8 b1=*reinterpret_cast<const bf16x8*>(kb+d0*2048+512);
    if(d0==0){p0=__builtin_amdgcn_mfma_f32_32x32x16_bf16(b0,qr[0],negm,0,0,0);p1=__builtin_amdgcn_mfma_f32_32x32x16_bf16(b1,qr[0],negm,0,0,0);}
    else{p0=__builtin_amdgcn_mfma_f32_32x32x16_bf16(b0,qr[d0],p0,0,0,0);p1=__builtin_amdgcn_mfma_f32_32x32x16_bf16(b1,qr[d0],p1,0,0,0);}}
}
typedef __attribute__((address_space(3))) const char* lds_cptr;
typedef short v4i16_t __attribute__((ext_vector_type(4)));
__device__ __forceinline__ void kload8(bf16x8*kf,lds_cptr kp){
  kf[0]=*(const __attribute__((address_space(3))) bf16x8*)(kp);      kf[1]=*(const __attribute__((address_space(3))) bf16x8*)(kp+512);
  kf[2]=*(const __attribute__((address_space(3))) bf16x8*)(kp+2048); kf[3]=*(const __attribute__((address_space(3))) bf16x8*)(kp+2560);
  kf[4]=*(const __attribute__((address_space(3))) bf16x8*)(kp+4096); kf[5]=*(const __attribute__((address_space(3))) bf16x8*)(kp+4608);
  kf[6]=*(const __attribute__((address_space(3))) bf16x8*)(kp+6144); kf[7]=*(const __attribute__((address_space(3))) bf16x8*)(kp+6656);
}
__device__ __forceinline__ void kload2(bf16x8*kf,lds_cptr kp,int j){ kf[2*j]=*(const __attribute__((address_space(3))) bf16x8*)(kp+j*2048); kf[2*j+1]=*(const __attribute__((address_space(3))) bf16x8*)(kp+j*2048+512); }
__device__ __forceinline__ s16x4 vtr(lds_cptr p){ return __builtin_bit_cast(s16x4,__builtin_amdgcn_ds_read_tr16_b64_v4i16((__attribute__((address_space(3))) v4i16_t*)p)); }
__device__ __forceinline__ float rowmax(const f32x16&p0,const f32x16&p1){
  float a=max3f(p0[0],p0[1],p1[0]),b=max3f(p0[2],p0[3],p1[1]);a=max3f(a,p1[2],p1[3]);
  #pragma unroll
  for(int r=4;r<16;r+=4){a=max3f(a,p0[r],p0[r+1]);b=max3f(b,p0[r+2],p0[r+3]);a=max3f(a,p1[r],p1[r+1]);b=max3f(b,p1[r+2],p1[r+3]);}
  const float m=max2f(a,b);
  auto rr=__builtin_amdgcn_permlane32_swap(__float_as_uint(m),__float_as_uint(m),false,false);
  return max2f(__uint_as_float(rr[0]),__uint_as_float(rr[1]));
}
__device__ __forceinline__ void pv(f32x16*o,int vb,bf16x8 pa0,bf16x8 pa1,bf16x8 pa2,bf16x8 pa3){
  #pragma unroll
  for(int d0=0;d0<2;++d0){s16x4 lo[4],hi[4];
    #pragma unroll
    for(int ks=0;ks<4;++ks){
      asm volatile("ds_read_b64_tr_b16 %0,%1 offset:%c2":"=&v"(lo[ks]):"v"(vb),"i"(d0*4096+ks*1024):"memory");
      asm volatile("ds_read_b64_tr_b16 %0,%1 offset:%c2":"=&v"(hi[ks]):"v"(vb),"i"(d0*4096+ks*1024+512):"memory");}
    asm volatile("s_waitcnt lgkmcnt(0)":::"memory");SBAR();
    #define PK(k) (bf16x8){lo[k][0],lo[k][1],lo[k][2],lo[k][3],hi[k][0],hi[k][1],hi[k][2],hi[k][3]}
    o[d0]=__builtin_amdgcn_mfma_f32_32x32x16_bf16(pa0,PK(0),o[d0],0,0,0);
    o[d0]=__builtin_amdgcn_mfma_f32_32x32x16_bf16(pa1,PK(1),o[d0],0,0,0);
    o[d0]=__builtin_amdgcn_mfma_f32_32x32x16_bf16(pa2,PK(2),o[d0],0,0,0);
    o[d0]=__builtin_amdgcn_mfma_f32_32x32x16_bf16(pa3,PK(3),o[d0],0,0,0);
    #undef PK
  }
}

#ifndef ATTN_STORE16
#define ATTN_STORE16(p,v) (*(u32x4*)(p)=(v))
#endif
template<int THRL> __device__ __forceinline__ void attn_unit(int b,int qcol,int kcol,int vcol,int ocol,int qb,const bf16*Q,const bf16*__restrict__ K,const bf16*__restrict__ V,bf16*O,char*shm,const int tid){
  const int lane=tid&63,r32=lane&31,hi=lane>>5; const int wid=__builtin_amdgcn_readfirstlane(tid>>6);
  const long rowbase=(long)b*SEQ; const int q0=qb*QB;
  const bf16*Qw=Q+(rowbase+q0+wid*QBLK)*PIN+qcol;
  const bf16*Kh=K+rowbase*PIN+kcol,*Vh=V+rowbase*PIN+vcol;
  const unsigned lds0=(unsigned)(uintptr_t)shm;
  float*wsf=(float*)(shm+LDS_WS)+wid*64;
  const unsigned koff=(unsigned)(lane*PIN+wid*8)*2u;
  const unsigned voff=(unsigned)((16*(wid&3)+(lane>>2))*PIN+(wid>>2)*32+(lane&3)*8)*2u;
  const unsigned kdst=lds0+LDS_K+wid*1024, vdst=lds0+LDS_V+wid*1024;
  #define DMA_K(t,slot) glds16s(Kh+(long)(t)*KVBLK*PIN,koff,(unsigned)__builtin_amdgcn_readfirstlane(kdst+(slot)))
  #define DMA_V(t,slot) glds16s(Vh+(long)(t)*KVBLK*PIN,voff,(unsigned)__builtin_amdgcn_readfirstlane(vdst+(slot)))
  const int vb0=(int)(lds0+LDS_V)+((lane>>4)&1)*32+(lane&3)*8+(4*hi+((lane&15)>>2))*64;
  const char*Kbase=shm+LDS_K; bf16x8 kf[8];
  const lds_cptr shm3=(lds_cptr)shm; const lds_cptr kp0=shm3+LDS_K+hi*1024+r32*16; const lds_cptr vp0=shm3+LDS_V+((lane>>4)&1)*32+(lane&3)*8+(4*hi+((lane&15)>>2))*64;
  const int NT=(q0+QB)/KVBLK;
  DMA_K(0,0);DMA_V(0,0);DMA_K(1,SLOTB);
  bf16x8 qr[4];
  { int lq=lane; asm volatile("":"+v"(lq)); const int r32q=lq&31,hiq=lq>>5;
  _Pragma("unroll") for(int d0=0;d0<4;++d0)qr[d0]=*reinterpret_cast<const bf16x8*>(&Qw[(long)r32q*PIN+d0*16+hiq*8]); }
  float mhat=0.f,l_reg=0.f;f32x16 o[2];o[0]=f32x16{};o[1]=f32x16{};f32x16 negm=f32x16{};asm volatile("":"+v"(negm));
  const int qrel=wid*QBLK+r32;
  #define CMASK(P0,P1,t) do{int jb_=(t)-(NT-4); if(jb_>=0)cmask(P0,P1,jb_,qrel,hi);}while(0)
  bool resc=false;
  #define START(P0,P1) do{ const float rm=rowmax(P0,P1); resc=false; \
    { const float dl=rm; mhat=fadd_s(mhat,dl); \
      _Pragma("unroll") for(int r=0;r<16;++r){P0[r]=fsub_s(P0[r],dl);P1[r]=fsub_s(P1[r],dl);} \
      _Pragma("unroll") for(int r=0;r<16;++r)negm[r]=-mhat; asm volatile("":"+v"(negm)); } \
    _Pragma("unroll") for(int r=0;r<16;++r)P0[r]=__builtin_amdgcn_exp2f(P0[r]); }while(0)
  #define RESC() do{ if(resc){ asm volatile("s_waitcnt lgkmcnt(0)":::"memory"); \
      _Pragma("unroll") for(int d_=0;d_<2;++d_) _Pragma("unroll") for(int r=0;r<16;++r)o[d_][r]*=wsf[crow(r,hi)]; } }while(0)
  f32x16 pA0,pA1,pB0,pB1;
  int sl_prev=0,sl_cur=0,sl_next=SLOTB;
  #define ROT() do{sl_prev=sl_cur;sl_cur=sl_next;sl_next=(sl_next==(NSLOT-1)*SLOTB)?0:sl_next+SLOTB;}while(0)
  DMA_K(2,2*SLOTB);
  WAIT_BAR(3);
  qkt(pA0,pA1,Kbase,qr,negm,r32,hi);asm volatile("s_nop 15\n\ts_nop 7":"+v"(pA0),"+v"(pA1));CMASK(pA0,pA1,0);
  START(pA0,pA1);
  _Pragma("unroll") for(int r=0;r<16;++r)pA1[r]=__builtin_amdgcn_exp2f(pA1[r]);
  WAIT_BAR(0);
  DMA_K(3,0);DMA_V(1,SLOTB);
  ROT();
  kload8(kf,kp0+sl_cur);
  WAIT_BAR(2);
  s16x4 vlo[8],vhi[8]; u32x4 pw0,pw1,pw2,pw3;
  #define PKW(P,B) cvtpk_s(P[B],P[B+1])
  #define PAF(k) __builtin_bit_cast(bf16x8,pw##k)
  #define VFR(i) (bf16x8){vlo[i][0],vlo[i][1],vlo[i][2],vlo[i][3],vhi[i][0],vhi[i][1],vhi[i][2],vhi[i][3]}
  #define PIN(x) asm volatile("":"+v"(x))
  #define MX3(a,b,c) __builtin_fmaxf(__builtin_fmaxf((a),(b)),(c))
  #define GAPA(MF,A0,A1,A2,A3,W0,W1,PW) do{ MF; sacc+=A0; sacc+=A1; sacc+=A2; sacc+=A3; PIN(sacc); W0; W1; PIN(PW); SBAR(); }while(0)
  #define EX(v) __builtin_amdgcn_exp2f(v)
  #define GAPB(MF,X,B) do{ MF; X[B]=EX(X[B]); X[B+1]=EX(X[B+1]); X[B+2]=EX(X[B+2]); X[B+3]=EX(X[B+3]); PIN(X); SBAR(); }while(0)
  #define VRD(i) do{ vlo[i]=vtr(vp_+(((i)>>2)*4096+((i)&3)*1024)); vhi[i]=vtr(vp_+(((i)>>2)*4096+((i)&3)*1024+512)); }while(0)
  #define KRD(G,j) do{ if(G){ kload2(kf,kp0+sl_next,j); SBAR(); } }while(0)
  #define STEP(C0,C1,P0,P1,t,GK,GV,GL) do{ SBAR(); \
    const lds_cptr vp_=vp0+sl_prev; \
    VRD(0); SBAR(); float sacc=(P0[0]+P0[1]); \
    GAPA(C0=__builtin_amdgcn_mfma_f32_32x32x16_bf16(kf[0],qr[0],negm,0,0,0), P0[2],P0[3],P0[4],P0[5],     pw0[0]=PKW(P0,0), pw0[1]=PKW(P0,2), pw0); \
    VRD(4); SBAR(); GAPA(C1=__builtin_amdgcn_mfma_f32_32x32x16_bf16(kf[1],qr[0],negm,0,0,0), P0[6],P0[7],P0[8],P0[9],     pw0[2]=PKW(P0,4), pw0[3]=PKW(P0,6), pw0); \
    VRD(1); SBAR(); GAPA(C0=__builtin_amdgcn_mfma_f32_32x32x16_bf16(kf[2],qr[1],C0,0,0,0),   P0[10],P0[11],P0[12],P0[13], pw1[0]=PKW(P0,8), pw1[1]=PKW(P0,10), pw1); \
    VRD(5); SBAR(); GAPA(C1=__builtin_amdgcn_mfma_f32_32x32x16_bf16(kf[3],qr[1],C1,0,0,0),   P0[14],P0[15],P1[0],P1[1],   pw1[2]=PKW(P0,12),pw1[3]=PKW(P0,14), pw1); \
    VRD(2); SBAR(); GAPA(C0=__builtin_amdgcn_mfma_f32_32x32x16_bf16(kf[4],qr[2],C0,0,0,0),   P1[2],P1[3],P1[4],P1[5],     pw2[0]=PKW(P1,0), pw2[1]=PKW(P1,2), pw2); \
    VRD(6); SBAR(); GAPA(C1=__builtin_amdgcn_mfma_f32_32x32x16_bf16(kf[5],qr[2],C1,0,0,0),   P1[6],P1[7],P1[8],P1[9],     pw2[2]=PKW(P1,4), pw2[3]=PKW(P1,6), pw2); \
    VRD(3); SBAR(); GAPA(C0=__builtin_amdgcn_mfma_f32_32x32x16_bf16(kf[6],qr[3],C0,0,0,0),   P1[10],P1[11],P1[12],P1[13], pw3[0]=PKW(P1,8), pw3[1]=PKW(P1,10), pw3); \
    VRD(7); SBAR(); GAPA(C1=__builtin_amdgcn_mfma_f32_32x32x16_bf16(kf[7],qr[3],C1,0,0,0),   P1[14],P1[15],0.f,0.f,       pw3[2]=PKW(P1,12),pw3[3]=PKW(P1,14), pw3); \
    l_reg+=sacc; \
    if(GK){DMA_K((t)+3,sl_cur);} if(GV){DMA_V((t)+1,sl_next);} \
    CMASK(C0,C1,t); \
    { float a=MX3(C0[0],C0[1],C1[0]),b=MX3(C0[2],C0[3],C1[1]); a=MX3(a,C1[2],C1[3]); \
      _Pragma("unroll") for(int r=4;r<16;r+=4){a=MX3(a,C0[r],C0[r+1]);b=MX3(b,C0[r+2],C0[r+3]);a=MX3(a,C1[r],C1[r+1]);b=MX3(b,C1[r+2],C1[r+3]);} \
      float rm=__builtin_fmaxf(a,b); { auto rr=__builtin_amdgcn_permlane32_swap(__float_as_uint(rm),__float_as_uint(rm),false,false); rm=__builtin_fmaxf(__uint_as_float(rr[0]),__uint_as_float(rr[1])); } \
      resc=false; \
      if(__builtin_expect(__any(rm>(float)THRL),0)){ const float dl=__builtin_fmaxf(rm,0.f); mhat+=dl; \
        _Pragma("unroll") for(int r=0;r<16;++r){C0[r]-=dl;C1[r]-=dl;} \
        _Pragma("unroll") for(int r=0;r<16;++r)negm[r]=-mhat; asm volatile("":"+v"(negm)); \
        const float f=__builtin_amdgcn_exp2f(-dl); l_reg*=f; if(hi==0)wsf[r32]=f; resc=true; } } \
    SBAR(); \
    GAPB(o[0]=__builtin_amdgcn_mfma_f32_32x32x16_bf16(PAF(0),VFR(0),o[0],0,0,0), C0,0); \
    GAPB(o[1]=__builtin_amdgcn_mfma_f32_32x32x16_bf16(PAF(0),VFR(4),o[1],0,0,0), C0,4); \
    KRD(GL,0); GAPB(o[0]=__builtin_amdgcn_mfma_f32_32x32x16_bf16(PAF(1),VFR(1),o[0],0,0,0), C0,8); \
    KRD(GL,1); GAPB(o[1]=__builtin_amdgcn_mfma_f32_32x32x16_bf16(PAF(1),VFR(5),o[1],0,0,0), C0,12); \
    KRD(GL,2); GAPB(o[0]=__builtin_amdgcn_mfma_f32_32x32x16_bf16(PAF(2),VFR(2),o[0],0,0,0), C1,0); \
    KRD(GL,3); GAPB(o[1]=__builtin_amdgcn_mfma_f32_32x32x16_bf16(PAF(2),VFR(6),o[1],0,0,0), C1,4); \
    GAPB(o[0]=__builtin_amdgcn_mfma_f32_32x32x16_bf16(PAF(3),VFR(3),o[0],0,0,0), C1,8); \
    GAPB(o[1]=__builtin_amdgcn_mfma_f32_32x32x16_bf16(PAF(3),VFR(7),o[1],0,0,0), C1,12); \
    }while(0)
  int t=1;
  #undef CMASK
  #define CMASK(P0,P1,t) do{}while(0)
  for(;t+5<NT;t+=2){
    STEP(pB0,pB1,pA0,pA1,t,true,true,true);     WAIT_BAR(2); RESC(); ROT();
    STEP(pA0,pA1,pB0,pB1,t+1,true,true,true);   WAIT_BAR(2); RESC(); ROT();
  }
  #undef CMASK
  #define CMASK(P0,P1,t) do{int jb_=(t)-(NT-4); if(jb_>=0)cmask(P0,P1,jb_,qrel,hi);}while(0)
  #define ENDW(tt) do{ if((tt)+3<NT){WAIT_BAR(2);} else if((tt)+2<NT){WAIT_BAR(1);} else {WAIT_BAR(0);} }while(0)
  for(;t+1<NT;t+=2){
    STEP(pB0,pB1,pA0,pA1,t,(t+3<NT),(t+1<NT),(t+1<NT));       ENDW(t);   RESC(); ROT();
    STEP(pA0,pA1,pB0,pB1,t+1,(t+4<NT),(t+2<NT),(t+2<NT));     ENDW(t+1); RESC(); ROT();
  }
  STEP(pB0,pB1,pA0,pA1,NT-1,false,false,false); RESC();
  { float sacc=pB0[0]+pB0[1]; _Pragma("unroll") for(int r=2;r<16;++r)sacc+=pB0[r]; _Pragma("unroll") for(int r=0;r<16;++r)sacc+=pB1[r]; l_reg+=sacc;
    pw0=(u32x4){PKW(pB0,0),PKW(pB0,2),PKW(pB0,4),PKW(pB0,6)};pw1=(u32x4){PKW(pB0,8),PKW(pB0,10),PKW(pB0,12),PKW(pB0,14)};pw2=(u32x4){PKW(pB1,0),PKW(pB1,2),PKW(pB1,4),PKW(pB1,6)};pw3=(u32x4){PKW(pB1,8),PKW(pB1,10),PKW(pB1,12),PKW(pB1,14)};
    SBAR(); pv(o,vb0+sl_cur,PAF(0),PAF(1),PAF(2),PAF(3)); }
  #undef PKW
  #undef PAF
  #undef VFR
  #undef PIN
  #undef MX3
  #undef GAPA
  #undef GAPB
  #undef EX
  #undef VRD
  #undef KRD
  #undef STEP
  #undef ENDW
  {auto rr=__builtin_amdgcn_permlane32_swap(__float_as_uint(l_reg),__float_as_uint(l_reg),false,false);l_reg=__uint_as_float(rr[0])+__uint_as_float(rr[1]);}
  { int le=lane; asm volatile("":"+v"(le)); const int r32e=le&31,hie=le>>5;
  if(hie==0)wsf[32+r32e]=l_reg;asm volatile("s_waitcnt lgkmcnt(0)":::"memory");
  float rli[16];
  #pragma unroll
  for(int r=0;r<16;++r)rli[r]=__builtin_amdgcn_rcpf(wsf[32+crow(r,hie)]);
  bf16*Ow=O+(rowbase+q0+wid*QBLK)*POUT+ocol;
  { bf16*stg=(bf16*)(shm+LDS_OST)+wid*2048;
    #pragma unroll
    for(int r=0;r<16;++r){const int orow=crow(r,hie);
      #pragma unroll
      for(int d0=0;d0<2;++d0)stg[orow*64+d0*32+r32e]=__float2bfloat16(o[d0][r]*rli[r]);}
    asm volatile("s_waitcnt lgkmcnt(0)":::"memory");
    #pragma unroll
    for(int i=0;i<4;++i){const int row=i*8+(le>>3),ch=le&7; const u32x4 v=*(const u32x4*)(stg+row*64+ch*8); ATTN_STORE16(Ow+(long)row*POUT+ch*8,v);} } }
  asm volatile("s_waitcnt lgkmcnt(0)\n\ts_barrier":::"memory");
  #undef DMA_K
  #undef DMA_V
  #undef CMASK
  #undef START
  #undef RESC
  #undef ROT
}
constexpr int ATTN_LDS_BYTES=LDS_BYTES;
struct AttnUnit { int bh; int qb; };
struct StaticOrder {
  int vcu;
  __device__ __forceinline__ explicit StaticOrder(int v):vcu(v){}
  __device__ __forceinline__ bool next(int i,AttnUnit&u)const{ if(i>=4)return false; const int s=vcu&3; u.bh=vcu>>2; u.qb=(i==0)?s:(i==1)?7-s:(i==2)?8+s:15-s; return true; }
};
template<class Sched,int THRL=8> __device__ __forceinline__ void attn_phase(char*lds,const bf16*P,bf16*O,const Sched&S,const int tid){
  AttnUnit u;
  for(int i=0;S.next(i,u);++i){ const int b=u.bh>>4, h=(u.bh>>2)&3, m=(u.bh>>1)&1, vh=u.bh&1;
    attn_unit<THRL>(b, h*128+m*64, 512+h*128+m*64, 1024+h*128+vh*64, m*512+h*128+vh*64, u.qb, P, P, P, O, lds, tid); }
}
#undef SBAR
#undef WAIT_BAR
}
#define GAS __attribute__((address_space(1)))
#define LAS __attribute__((address_space(3)))
typedef unsigned short bf16;
typedef unsigned v4u __attribute__((ext_vector_type(4)));
typedef float f32x4 __attribute__((ext_vector_type(4)));
typedef short bf16x8 __attribute__((ext_vector_type(8)));
typedef GAS unsigned gu32;
typedef GAS unsigned long long gu64;
#define RLX_AGENT __ATOMIC_RELAXED, __HIP_MEMORY_SCOPE_AGENT
#define LDS_WAIT() asm volatile("s_waitcnt lgkmcnt(0)" ::: "memory")
#define VM_WAIT() asm volatile("s_waitcnt vmcnt(0)" ::: "memory")
__device__ __forceinline__ unsigned long long rt() { return __builtin_amdgcn_s_memrealtime(); }
__device__ __forceinline__ unsigned f2bf(float f) { unsigned u = __builtin_bit_cast(unsigned, f); return (u + 0x7fffu + ((u >> 16) & 1u)) >> 16; }
__device__ __forceinline__ unsigned pk2(float lo, float hi) { return f2bf(lo) | (f2bf(hi) << 16); }

#define XB_TMO      128
#define XB_XCNT(j)  (256  + 64 * (j))
#define XB_XSUB(j)  (1280 + 64 * (j))
#define XB_XGEN(j)  (2304 + 64 * (j))
#define XB_TOP      3328
#define XB_TOPGEN   3392
#define XCD_BAR_WORDS 3456
#define XB_SPIN_CAP (1u << 22)

__device__ __forceinline__ unsigned xb_ld(unsigned* p)              { return __hip_atomic_load(p, __ATOMIC_RELAXED, __HIP_MEMORY_SCOPE_AGENT); }
__device__ __forceinline__ unsigned xb_add(unsigned* p, unsigned v) { return __hip_atomic_fetch_add(p, v, __ATOMIC_RELAXED, __HIP_MEMORY_SCOPE_AGENT); }
__device__ __forceinline__ unsigned xb_xcc_id() { return (unsigned)__builtin_amdgcn_s_getreg((3 << 11) | 20) & 0xFu; }
#define XB_SPIN(cond, bar) do { unsigned _sp = 0; while (cond) { __builtin_amdgcn_s_sleep(1); \
    if ((++_sp & 255u) == 0u) { if (xb_ld(&(bar)[XB_TMO])) break; if (_sp > XB_SPIN_CAP) { atomicAdd(&(bar)[XB_TMO], 1u); break; } } } } while (0)

struct XcdBarrier {
    unsigned* bar; unsigned x;
    volatile LAS unsigned* st;
};

__device__ __forceinline__ XcdBarrier xcd_barrier_post(unsigned* bar, volatile LAS unsigned* st) {
    XcdBarrier b; b.bar = bar; b.x = xb_xcc_id(); b.st = st;
    if (threadIdx.x == 0) (void)xb_add(&bar[XB_XCNT(b.x)], 1u);
    return b;
}
__device__ __forceinline__ void xcd_barrier_complete(unsigned* bar, unsigned x, unsigned& nloc, unsigned& nx) {
    const unsigned G = gridDim.x * gridDim.y * gridDim.z;
    unsigned sum, cnt, mine, sp = 0u;
    for (;;) {
        sum = 0u; cnt = 0u; mine = 0u;
#pragma unroll
        for (unsigned j = 0; j < 16; ++j) { const unsigned c = xb_ld(&bar[XB_XCNT(j)]); sum += c; cnt += (c > 0u) ? 1u : 0u; mine = (j == x) ? c : mine; }
        if (sum == G) break;
        __builtin_amdgcn_s_sleep(1);
        if ((++sp & 255u) == 0u) { if (xb_ld(&bar[XB_TMO])) break; if (sp > XB_SPIN_CAP) { atomicAdd(&bar[XB_TMO], 1u); break; } }
    }
    nloc = mine > 0u ? mine : 1u; nx = cnt > 0u ? cnt : 1u;
}

__device__ __forceinline__ void xcd_barrier(const XcdBarrier& b, const bool leader  ) {
    asm volatile("s_waitcnt vmcnt(0)" ::: "memory");
    __syncthreads();
    if (leader) {
        unsigned* bar = b.bar;
        __builtin_amdgcn_s_waitcnt(0);
        unsigned nloc = b.st[0], nx = b.st[1];
        if (nloc == 0u) { xcd_barrier_complete(bar, b.x, nloc, nx); b.st[0] = nloc; b.st[1] = nx; }
        const unsigned old = xb_add(&bar[XB_XSUB(b.x)], 1u);
        const unsigned gen = old / nloc;
        if (old + 1u == (gen + 1u) * nloc) {
            __builtin_amdgcn_fence(__ATOMIC_RELEASE, "agent");
            asm volatile("s_waitcnt vmcnt(0)" ::: "memory");
            const unsigned og = xb_add(&bar[XB_TOP], 1u);
            const unsigned tg = og / nx;
            if (og + 1u == (tg + 1u) * nx) xb_add(&bar[XB_TOPGEN], 1u);
            else XB_SPIN(xb_ld(&bar[XB_TOPGEN]) == tg, bar);
            __builtin_amdgcn_fence(__ATOMIC_ACQUIRE, "agent");
            xb_add(&bar[XB_XGEN(b.x)], 1u);
            asm volatile("s_waitcnt vmcnt(0)" ::: "memory");
        } else {
            XB_SPIN(xb_ld(&bar[XB_XGEN(b.x)]) == gen, bar);
            __builtin_amdgcn_fence(__ATOMIC_ACQUIRE, "agent");
            asm volatile("s_waitcnt vmcnt(0)" ::: "memory");
        }
    }
    __syncthreads();
}

constexpr int NWAVES = 8;
constexpr int M = 16384, DM = 1024, SEQL = 4096, NPROJ = 3072, NIN = 3088, NQ = 2048, NLAYER = 2;
constexpr int C_Q = 0, C_K = 512, C_V = 1024, C_SB = 1536, C_SC = 1792, C_SH = 2048, C_GQ = 2304, C_GK = 2432, C_GV = 2560, C_GR = 2816;
constexpr float EPS = 1e-6f;
constexpr float ATT_C2 = 0.125f * 1.4426950408889634f;

constexpr size_t MiB = 1u << 20;
constexpr size_t WS_CTL = 0, CTL_ZERO_BYTES = 1 * MiB;
constexpr size_t WS_WIN = 1 * MiB, WIN_STRIDE = 7 * MiB;
constexpr size_t WS_WOUT = 15 * MiB, WOUT_STRIDE = 2 * MiB;
constexpr size_t WS_WQ = 19 * MiB, WQ_STRIDE = 4 * MiB;
constexpr size_t WS_KEYS = 27 * MiB, KEYS_STRIDE = 65536;
constexpr size_t WS_COS = 28 * MiB, WS_SIN = 28 * MiB + 512 * 1024;
constexpr size_t WS_SSQ = 29 * MiB;
constexpr size_t WS_GD = 30 * MiB;
constexpr size_t WS_LAM = 30 * MiB + 512 * 1024;
constexpr size_t WS_PAR = 30 * MiB + 768 * 1024;
constexpr int PAR_DN = 0, PAR_CW = 256, PAR_WG2 = 1792, PAR_BG = 5888, PAR_GN = 6144, PAR_NF = 6272, PAR_N = 7296;
constexpr size_t WS_GU = 31 * MiB;
constexpr size_t WS_GB = 39 * MiB;
constexpr size_t WS_EXP = 47 * MiB;
constexpr size_t WS_GATE = 55 * MiB;
constexpr size_t WS_U8 = 64 * MiB, TAB_STRIDE = 16 * MiB;
constexpr size_t WS_V8 = 128 * MiB;
constexpr size_t WS_SU = 56 * MiB + 512 * 1024 * 0 + 7 * MiB, WS_SV = WS_SU + 256 * 1024;
constexpr size_t WS_RS1 = 63 * MiB + 512 * 1024;
constexpr size_t WS_XB = 192 * MiB;
constexpr size_t WS_PROJ = 224 * MiB;
constexpr size_t WS_OATT = 320 * MiB;
constexpr size_t WS_MIXED = 352 * MiB;
constexpr size_t WS_QP = 384 * MiB;
constexpr size_t WS_END = 448 * MiB;
constexpr int CW_TMO = 0, CW_BAR = 4096;

constexpr int RING_OFF = 0, RING_BYTES = 131072;
constexpr int LDSCTL_OFF = RING_BYTES, MISC_OFF = LDSCTL_OFF + 320;
constexpr int LDS_BYTES = 147456;

struct Frame {
    LAS unsigned char* lds;
    volatile LAS unsigned* MISC;
    int tid, lane, wave;
    int vcu, G, bx;
    float* out; unsigned char* ws;
};
__device__ __forceinline__ float wave_sum(float v) { return xl_wave_sum(v); }
__device__ __forceinline__ float bflo(unsigned w) { return __builtin_bit_cast(float, w << 16); }
__device__ __forceinline__ float bfhi(unsigned w) { return __builtin_bit_cast(float, w & 0xffff0000u); }
__device__ __forceinline__ float bf1(bf16 h) { return __builtin_bit_cast(float, (unsigned)h << 16); }

__device__ __forceinline__ void p0_transpose_item(const float* W, int ldw, int N, const float* gain, bf16* WT, int K, LAS float* scr, int item, int lane) {
    const int nblk = (N + 31) / 32, kb = item / nblk, nb = item % nblk, k0 = 64 * kb, n0 = 32 * nb;
    const int nn = n0 + (lane & 31);
    float wv[32];
#pragma unroll
    for (int i = 0; i < 32; ++i) { const int kk = 2 * i + (lane >> 5); wv[i] = (nn < N) ? W[(size_t)(k0 + kk) * ldw + nn] : 0.f; }
#pragma unroll
    for (int i = 0; i < 32; ++i) { const int kk = 2 * i + (lane >> 5); float w = wv[i]; if (gain) w *= gain[k0 + kk]; scr[kk * 33 + (lane & 31)] = w; }
    LDS_WAIT(); asm volatile("" ::: "memory");
    const int c = lane & 7;
#pragma unroll
    for (int j = 0; j < 4; ++j) { const int n = (lane >> 3) + 8 * j; const LAS float* s = scr + (8 * c) * 33 + n;
        v4u o; o.x = pk2(s[0 * 33], s[1 * 33]); o.y = pk2(s[2 * 33], s[3 * 33]); o.z = pk2(s[4 * 33], s[5 * 33]); o.w = pk2(s[6 * 33], s[7 * 33]);
        if (n0 + n < N) *(GAS v4u*)(WT + (size_t)(n0 + n) * K + k0 + 8 * c) = o; }
    LDS_WAIT(); asm volatile("" ::: "memory");
}
struct Args;
template <class A> __device__ __forceinline__ void p0_prologue(Frame& F, const A& args) {
    const float* const* in_ = nullptr; (void)in_;
    LAS float* scr = (LAS float*)(F.lds + RING_OFF + F.wave * 16384);
    const int gw = F.vcu * NWAVES + F.wave, NGW = F.G * NWAVES;
    const int gt = F.vcu * (NWAVES * 64) + F.tid, NGT = F.G * NWAVES * 64;
    constexpr int I_IN = 16 * 97, I_OUT = 16 * 32, I_Q = 16 * 64, I_L = I_IN + I_OUT + I_Q;
    for (int it = gw; it < NLAYER * I_L; it += NGW) {
        const int l = it / I_L; int r = it % I_L;
        if (r < I_IN) { p0_transpose_item(args.in[3] + (size_t)l * DM * NIN, NIN, NIN, args.in[2] + l * DM, (bf16*)(F.ws + WS_WIN + l * WIN_STRIDE), DM, scr, r, F.lane); continue; } r -= I_IN;
        if (r < I_OUT) { p0_transpose_item(args.in[13] + (size_t)l * DM * DM, DM, DM, nullptr, (bf16*)(F.ws + WS_WOUT + l * WOUT_STRIDE), DM, scr, r, F.lane); continue; } r -= I_OUT;
        p0_transpose_item(args.in[15] + (size_t)l * DM * NQ, NQ, NQ, args.in[14] + l * DM, (bf16*)(F.ws + WS_WQ + l * WQ_STRIDE), DM, scr, r, F.lane);
    }
    for (int i = gt; i < NLAYER * 2 * 16384; i += NGT) { const int l = i >> 15, hf = (i >> 14) & 1, e = i & 16383;
        ((bf16*)(F.ws + WS_KEYS + l * KEYS_STRIDE))[hf * 16384 + e] = (bf16)f2bf((hf ? args.in[17] : args.in[16])[(size_t)l * 16384 + e]); }
    for (int row0 = gw; row0 < NLAYER * 2 * 16384; row0 += 4 * NGW) {
        f32x4 v[4][4]; float mx[4] = {0.f, 0.f, 0.f, 0.f};
#pragma unroll
        for (int u = 0; u < 4; ++u) { const int row = (row0 + u * NGW < NLAYER * 2 * 16384) ? row0 + u * NGW : row0; const int l = row >> 15, tab = (row >> 14) & 1, e = row & 16383;
            const f32x4* src = (const f32x4*)((tab ? args.in[19] : args.in[18]) + (size_t)l * 16777216 + (size_t)e * DM) + F.lane;
#pragma unroll
            for (int j = 0; j < 4; ++j) v[u][j] = __builtin_nontemporal_load(src + 64 * j); }
#pragma unroll
        for (int u = 0; u < 4; ++u) { const int row = row0 + u * NGW; const int l = row >> 15, tab = (row >> 14) & 1, e = row & 16383;
            if (row < NLAYER * 2 * 16384) {
#pragma unroll
            for (int j = 0; j < 4; ++j) { if (tab == 0) v[u][j] = v[u][j] * ((const f32x4*)(args.in[14] + l * DM))[F.lane + 64 * j];
                mx[u] = fmaxf(mx[u], fmaxf(fmaxf(fabsf(v[u][j][0]), fabsf(v[u][j][1])), fmaxf(fabsf(v[u][j][2]), fabsf(v[u][j][3])))); }
            float m_ = mx[u];
            m_ = fmaxf(m_, xl_swz<1>(m_)); m_ = fmaxf(m_, xl_swz<2>(m_)); m_ = fmaxf(m_, xl_swz<4>(m_)); m_ = fmaxf(m_, xl_swz<8>(m_)); m_ = fmaxf(m_, xl_swz<16>(m_));
            m_ = fmaxf(m_, __builtin_bit_cast(float, xl_xor32_i(__builtin_bit_cast(int, m_), F.lane >> 5)));
            unsigned* dst = (unsigned*)(F.ws + (tab ? WS_V8 : WS_U8) + l * TAB_STRIDE + (size_t)e * DM) + F.lane;
            if (tab) {
                int k = (int)floorf(log2f(224.0f / fmaxf(m_, 1e-30f))); k = k < -60 ? -60 : (k > 60 ? 60 : k);
                const float sc = ldexpf(1.0f, k);
#pragma unroll
                for (int j = 0; j < 4; ++j) { int p = __builtin_amdgcn_cvt_pk_fp8_f32(v[u][j][0] * sc, v[u][j][1] * sc, 0, false); p = __builtin_amdgcn_cvt_pk_fp8_f32(v[u][j][2] * sc, v[u][j][3] * sc, p, true); dst[64 * j] = (unsigned)p; }
                if (F.lane == 0) ((float*)(F.ws + WS_SV))[l * 16384 + e] = ldexpf(1.0f, -k);
            } else {
                const float sc = m_ > 0.f ? 127.0f / m_ : 0.f;
#pragma unroll
                for (int j = 0; j < 4; ++j) { const int q0 = (int)rintf(v[u][j][0] * sc), q1 = (int)rintf(v[u][j][1] * sc), q2 = (int)rintf(v[u][j][2] * sc), q3 = (int)rintf(v[u][j][3] * sc);
                    dst[64 * j] = (unsigned)(q0 & 255) | ((unsigned)(q1 & 255) << 8) | ((unsigned)(q2 & 255) << 16) | ((unsigned)(q3 & 255) << 24); }
                if (F.lane == 0) ((float*)(F.ws + WS_SU))[l * 16384 + e] = m_ * (1.0f / 127.0f);
            } } }
    }
    for (int m0 = gw; m0 < M; m0 += 4 * NGW) {
        f32x4 v[4][4];
#pragma unroll
        for (int u = 0; u < 4; ++u) { const int m = m0 + u * NGW; const f32x4* xr = (const f32x4*)(args.in[0] + (size_t)(m < M ? m : m0) * DM) + F.lane;
#pragma unroll
            for (int j = 0; j < 4; ++j) v[u][j] = __builtin_nontemporal_load(xr + 64 * j); }
#pragma unroll
        for (int u = 0; u < 4; ++u) { const int m = m0 + u * NGW; if (m < M) {
            unsigned long long* o8 = (unsigned long long*)((bf16*)(F.ws + WS_XB) + (size_t)m * DM) + F.lane; float s = 0.f;
#pragma unroll
            for (int j = 0; j < 4; ++j) { const f32x4 w = v[u][j]; s += (w[0] * w[0] + w[1] * w[1]) + (w[2] * w[2] + w[3] * w[3]);
                o8[64 * j] = (unsigned long long)pk2(w[0], w[1]) | ((unsigned long long)pk2(w[2], w[3]) << 32); }
            s = wave_sum(s);
            if (F.lane == 0) ((float*)(F.ws + WS_RS1))[m] = 1.0f / sqrtf(s * (1.0f / 1024.0f) + EPS); } }
    }
    for (int i = gt; i < M * 8; i += NGT) { const int m = i >> 3, j = i & 7; const double inv = pow(500000.0, -(double)j / 8.0); const double ang = (double)((const int*)args.in[1])[m] * inv;
        ((float*)(F.ws + WS_COS))[i] = (float)cos(ang); ((float*)(F.ws + WS_SIN))[i] = (float)sin(ang); }
    if (gt < NLAYER) { const int l = gt; float a = 0.f, b = 0.f;
        for (int i = 0; i < 64; ++i) { a += args.in[4][l * 64 + i] * args.in[5][l * 64 + i]; b += args.in[6][l * 64 + i] * args.in[7][l * 64 + i]; }
        const float lam_init = 0.8f - 0.6f * expf(-0.3f * (float)l);
        ((float*)(F.ws + WS_LAM))[l * 2] = expf(a) - expf(b) + lam_init; ((float*)(F.ws + WS_LAM))[l * 2 + 1] = 1.0f - lam_init; }
    { float* par = (float*)(F.ws + WS_PAR);
      for (int i = gt; i < PAR_N; i += NGT) { float v;
          if (i < PAR_CW) v = args.in[8][i]; else if (i < PAR_WG2) v = args.in[9][i - PAR_CW]; else if (i < PAR_BG) v = args.in[10][i - PAR_WG2]; else if (i < PAR_GN) v = args.in[11][i - PAR_BG];
          else if (i < PAR_NF) v = args.in[12][i - PAR_GN]; else v = args.in[20][i - PAR_NF];
          par[i] = v; } }
}

__device__ __forceinline__ float log_sigmoid(float x) { return fminf(x, 0.f) - __logf(1.0f + __expf(-fabsf(x))); }
template <int K> __device__ __forceinline__ void lds_mm_2x4(float (&acc)[2][4], const LAS float* X, int ldx, const LAS float* Y, int ldy) {
#pragma unroll 4
    for (int k = 0; k < K; k += 4) {
        const f32x4 x0 = *(const LAS f32x4*)(X + k), x1 = *(const LAS f32x4*)(X + ldx + k);
#pragma unroll
        for (int kk = 0; kk < 4; ++kk) { const f32x4 y = *(const LAS f32x4*)(Y + (k + kk) * ldy);
#pragma unroll
            for (int b = 0; b < 4; ++b) { acc[0][b] += x0[kk] * y[b]; acc[1][b] += x1[kk] * y[b]; } }
    }
}
typedef float f32x16g __attribute__((ext_vector_type(16)));
__device__ __forceinline__ int gla_crow(int r, int hh) { return (r & 3) + 8 * (r >> 2) + 4 * hh; }
__device__ __forceinline__ void gla_stage_vt(LAS bf16* VT, const bf16* PROJ, int t0, int tid) {
#pragma unroll
    for (int it = tid; it < 2048; it += 512) { const int eg = it >> 6, t = it & 63; const v4u w = *(const v4u*)(PROJ + (size_t)(t0 + t) * NPROJ + C_GV + eg * 8);
        LAS bf16* p = VT + (eg * 8) * 72 + t;
        p[0] = (bf16)(w.x & 0xffffu); p[72] = (bf16)(w.x >> 16); p[144] = (bf16)(w.y & 0xffffu); p[216] = (bf16)(w.y >> 16);
        p[288] = (bf16)(w.z & 0xffffu); p[360] = (bf16)(w.z >> 16); p[432] = (bf16)(w.w & 0xffffu); p[504] = (bf16)(w.w >> 16); }
}
__device__ __forceinline__ void gla_prep(Frame& F, int l, int ci, int stop_after = 0) {
    typedef float f32x4m __attribute__((ext_vector_type(4)));
    LAS float* LR = (LAS float*)(F.lds + RING_OFF);
    LAS bf16* KHT = (LAS bf16*)(LR + 2 * 64 * 17);
    LAS bf16* VT = KHT + 128 * 72;
    LAS float* W2s = (LAS float*)(VT + 256 * 72);
    const int t0 = ci * 64, tid = F.tid, lane = F.lane, wave = F.wave, r32 = lane & 31, hh = lane >> 5;
    const bf16* XB = (const bf16*)(F.ws + WS_XB); const bf16* PROJ = (const bf16*)(F.ws + WS_PROJ);
    const bf16* Wlr = (const bf16*)(F.ws + WS_WIN + l * WIN_STRIDE) + (size_t)NPROJ * DM;
    v4u kw0, kw1; float rs;
    {
        const int mt = wave & 3, kh = wave >> 2, fr = lane & 15, fq = lane >> 4;
        f32x4m acc = (f32x4m){0.f, 0.f, 0.f, 0.f};
        const bf16* ap = XB + (size_t)(t0 + mt * 16 + fr) * DM + kh * 512 + fq * 8; const bf16* bp = Wlr + (size_t)fr * DM + kh * 512 + fq * 8;
        bf16x8 av[16], bv[16];
#pragma unroll
        for (int ks = 0; ks < 16; ++ks) { av[ks] = *(const bf16x8*)(ap + ks * 32); bv[ks] = *(const bf16x8*)(bp + ks * 32); }
        gla_stage_vt(VT, PROJ, t0, tid);
        { const float* W2g = (const float*)(F.ws + WS_PAR) + PAR_WG2 + l * 16 * 128; const float* bgg = (const float*)(F.ws + WS_PAR) + PAR_BG + l * 128;
#pragma unroll
          for (int q = 0; q < 4; ++q) W2s[tid + 512 * q] = W2g[tid + 512 * q];
          if (tid < 128) W2s[2048 + tid] = bgg[tid]; }
        { const bf16* kp = PROJ + (size_t)(t0 + lane) * NPROJ + C_GK + 16 * wave; kw0 = *(const v4u*)kp; kw1 = *(const v4u*)(kp + 8); rs = ((const float*)(F.ws + WS_RS1))[t0 + lane]; }
#pragma unroll
        for (int ks = 0; ks < 16; ++ks) acc = __builtin_amdgcn_mfma_f32_16x16x32_bf16(av[ks], bv[ks], acc, 0, 0, 0);
#pragma unroll
        for (int i = 0; i < 4; ++i) LR[kh * (64 * 17) + (mt * 16 + fq * 4 + i) * 17 + fr] = acc[i];
    }
    __syncthreads();
    if (stop_after == 1) return;
    {
        const int d0 = 16 * wave, t = lane;
        float lr[16];
#pragma unroll
        for (int r = 0; r < 16; ++r) lr[r] = (LR[t * 17 + r] + LR[64 * 17 + t * 17 + r]) * rs;
        const LAS float* W2 = W2s + d0; const LAS float* bg = W2s + 2048 + d0;
        float bb[16];
#pragma unroll
        for (int dd = 0; dd < 16; ++dd) { float x = bg[dd];
#pragma unroll
            for (int r = 0; r < 16; ++r) x += lr[r] * W2[r * 128 + dd];
            bb[dd] = log_sigmoid(x) * (1.0f / 16.0f); }
#pragma unroll
        for (int off = 1; off < 64; off <<= 1) { const int src = ((lane - off) & 63) << 2;
#pragma unroll
            for (int dd = 0; dd < 16; ++dd) { const float o = __builtin_bit_cast(float, __builtin_amdgcn_ds_bpermute(src, __builtin_bit_cast(int, bb[dd]))); bb[dd] += (lane >= off) ? o : 0.f; } }
        float* GB = (float*)(F.ws + WS_GB) + (size_t)(t0 + t) * 128 + d0;
#pragma unroll
        for (int q = 0; q < 4; ++q) *(f32x4*)(GB + 4 * q) = (f32x4){bb[4 * q], bb[4 * q + 1], bb[4 * q + 2], bb[4 * q + 3]};
        const unsigned kw[8] = {kw0.x, kw0.y, kw0.z, kw0.w, kw1.x, kw1.y, kw1.z, kw1.w};
        float dc[16];
#pragma unroll
        for (int dd = 0; dd < 16; ++dd) { const float bl = __builtin_bit_cast(float, __builtin_amdgcn_readlane(__builtin_bit_cast(int, bb[dd]), 63)); dc[dd] = expf(bl);
            const float kv = (dd & 1) ? bfhi(kw[dd >> 1]) : bflo(kw[dd >> 1]); KHT[(d0 + dd) * 72 + t] = (bf16)f2bf(kv * expf(bl - bb[dd])); }
        if (lane == 0) { float* GD = (float*)(F.ws + WS_GD) + ci * 128 + d0;
#pragma unroll
            for (int q = 0; q < 4; ++q) *(f32x4*)(GD + 4 * q) = (f32x4){dc[4 * q], dc[4 * q + 1], dc[4 * q + 2], dc[4 * q + 3]}; }
    }
    __syncthreads();
    if (stop_after == 2) return;
    {
        const int h = wave >> 1, eb = wave & 1; f32x16g U = {};
#pragma unroll
        for (int ks = 0; ks < 4; ++ks) { const bf16x8 ka = *(const LAS bf16x8*)(KHT + (h * 32 + r32) * 72 + ks * 16 + 8 * hh); const bf16x8 vb = *(const LAS bf16x8*)(VT + (h * 64 + eb * 32 + r32) * 72 + ks * 16 + 8 * hh);
            U = __builtin_amdgcn_mfma_f32_32x32x16_bf16(ka, vb, U, 0, 0, 0); }
        float* GU = (float*)(F.ws + WS_GU) + (size_t)(ci * 4 + h) * 2048 + eb * 32 + r32;
#pragma unroll
        for (int r = 0; r < 16; ++r) GU[gla_crow(r, hh) * 64] = U[r];
    }
    __syncthreads();
}
__device__ __forceinline__ void gla_scan(Frame& F) {
    if (F.tid < 128) { const int gid = F.vcu * 128 + F.tid;
        if (gid < 32768) { const int b = gid >> 13, h = (gid >> 11) & 3, d = (gid >> 6) & 31, e = gid & 63; float s = 0.f;
            float* GU = (float*)(F.ws + WS_GU); const float* GD = (const float*)(F.ws + WS_GD);
            for (int c0 = 0; c0 < 64; c0 += 16) { float u[16], dc[16];
#pragma unroll
                for (int i = 0; i < 16; ++i) { const int ci = b * 64 + c0 + i; u[i] = GU[((size_t)(ci * 4 + h) * 32 + d) * 64 + e]; dc[i] = GD[ci * 128 + h * 32 + d]; }
#pragma unroll
                for (int i = 0; i < 16; ++i) { const int ci = b * 64 + c0 + i; GU[((size_t)(ci * 4 + h) * 32 + d) * 64 + e] = s; s = dc[i] * s + u[i]; } } } }
}
__device__ __forceinline__ void mix_chunk(Frame& F, int l, int ci) {
    LAS bf16* QB = (LAS bf16*)(F.lds + RING_OFF);
    LAS bf16* KB = QB + 64 * 136;
    LAS bf16* VT = KB + 64 * 136;
    LAS bf16* ST = VT + 256 * 72;
    const int t0 = ci * 64, tid = F.tid, lane = F.lane, wave = F.wave, r32 = lane & 31, hh = lane >> 5;
    const bf16* PROJ = (const bf16*)(F.ws + WS_PROJ); bf16* MIXED = (bf16*)(F.ws + WS_MIXED);
    const float* GB = (const float*)(F.ws + WS_GB) + (size_t)t0 * 128;
    const int h = wave >> 1, ib = wave & 1, i0 = 32 * ib;
#pragma unroll
    for (int it = tid; it < 1024; it += 512) { const int t = it >> 4, d0 = (it & 15) * 8;
        const f32x4 b0 = *(const f32x4*)(GB + t * 128 + d0), b1 = *(const f32x4*)(GB + t * 128 + d0 + 4);
        const bf16* pr = PROJ + (size_t)(t0 + t) * NPROJ; const v4u qw = *(const v4u*)(pr + C_GQ + d0), kw = *(const v4u*)(pr + C_GK + d0);
        const float bv[8] = {b0[0], b0[1], b0[2], b0[3], b1[0], b1[1], b1[2], b1[3]}; const unsigned qa[4] = {qw.x, qw.y, qw.z, qw.w}, ka[4] = {kw.x, kw.y, kw.z, kw.w};
        unsigned qo[4], ko[4];
#pragma unroll
        for (int p = 0; p < 4; ++p) { const float e0 = expf(bv[2 * p]), e1 = expf(bv[2 * p + 1]), n0 = expf(-bv[2 * p]), n1 = expf(-bv[2 * p + 1]);
            qo[p] = pk2(bflo(qa[p]) * 0.17677669529663687f * e0, bfhi(qa[p]) * 0.17677669529663687f * e1); ko[p] = pk2(bflo(ka[p]) * n0, bfhi(ka[p]) * n1); }
        *(LAS v4u*)(QB + t * 136 + d0) = (v4u){qo[0], qo[1], qo[2], qo[3]}; *(LAS v4u*)(KB + t * 136 + d0) = (v4u){ko[0], ko[1], ko[2], ko[3]}; }
    gla_stage_vt(VT, PROJ, t0, tid);
    { const float* GU = (const float*)(F.ws + WS_GU) + (size_t)ci * 8192;
      float sv[16];
#pragma unroll
      for (int q = 0; q < 16; ++q) sv[q] = GU[tid + 512 * q];
#pragma unroll
      for (int q = 0; q < 16; ++q) { const int it = tid + 512 * q, hd = it >> 6, e = it & 63; ST[((hd >> 5) * 64 + e) * 40 + (hd & 31)] = (bf16)f2bf(sv[q]); } }
    const size_t row = (size_t)(t0 + i0 + r32); unsigned long long rg[8];
#pragma unroll
    for (int q = 0; q < 8; ++q) rg[q] = *(const unsigned long long*)(PROJ + row * NPROJ + C_GR + h * 64 + 32 * (q >> 2) + 8 * (q & 3) + 4 * hh);
    __syncthreads();
    {
        bf16x8 qf[2];
#pragma unroll
        for (int ks = 0; ks < 2; ++ks) qf[ks] = *(const LAS bf16x8*)(QB + (i0 + r32) * 136 + h * 32 + ks * 16 + 8 * hh);
        f32x16g OT[2] = {{}, {}};
#pragma unroll
        for (int eb = 0; eb < 2; ++eb)
#pragma unroll
            for (int ks = 0; ks < 2; ++ks) { const bf16x8 sa = *(const LAS bf16x8*)(ST + (h * 64 + eb * 32 + r32) * 40 + ks * 16 + 8 * hh); OT[eb] = __builtin_amdgcn_mfma_f32_32x32x16_bf16(sa, qf[ks], OT[eb], 0, 0, 0); }
#pragma unroll
        for (int jb = 0; jb < 2; ++jb) if (jb <= ib) {
            f32x16g X = {};
#pragma unroll
            for (int ks = 0; ks < 2; ++ks) { const bf16x8 ka = *(const LAS bf16x8*)(KB + (32 * jb + r32) * 136 + h * 32 + ks * 16 + 8 * hh); X = __builtin_amdgcn_mfma_f32_32x32x16_bf16(ka, qf[ks], X, 0, 0, 0); }
            if (jb == ib) {
#pragma unroll
                for (int r = 0; r < 16; ++r) if (gla_crow(r, hh) > r32) X[r] = 0.f;
            }
#pragma unroll
            for (int s = 0; s < 2; ++s) { v4u xw; xw.x = pk2(X[8 * s], X[8 * s + 1]); xw.y = pk2(X[8 * s + 2], X[8 * s + 3]); xw.z = pk2(X[8 * s + 4], X[8 * s + 5]); xw.w = pk2(X[8 * s + 6], X[8 * s + 7]);
                const bf16x8 xb = __builtin_bit_cast(bf16x8, xw);
#pragma unroll
                for (int eb = 0; eb < 2; ++eb) { const LAS bf16* vp = VT + (h * 64 + eb * 32 + r32) * 72 + 32 * jb + 16 * s + 4 * hh;
                    const unsigned long long lo = *(const LAS unsigned long long*)vp, hi = *(const LAS unsigned long long*)(vp + 8);
                    const v4u vw = (v4u){(unsigned)lo, (unsigned)(lo >> 32), (unsigned)hi, (unsigned)(hi >> 32)};
                    OT[eb] = __builtin_amdgcn_mfma_f32_32x32x16_bf16(__builtin_bit_cast(bf16x8, vw), xb, OT[eb], 0, 0, 0); } }
        }
        float ss = 0.f;
#pragma unroll
        for (int eb = 0; eb < 2; ++eb)
#pragma unroll
            for (int r = 0; r < 16; ++r) ss += OT[eb][r] * OT[eb][r];
        ss = xl_sum32(ss);
        const float rs = 1.0f / sqrtf(ss * (1.0f / 64.0f) + EPS); const float* gn = (const float*)(F.ws + WS_PAR) + PAR_GN + l * 64;
#pragma unroll
        for (int q = 0; q < 8; ++q) { const int eb = q >> 2, g = q & 3, e0 = 32 * eb + 8 * g + 4 * hh; const f32x4 g4 = *(const f32x4*)(gn + e0);
            const unsigned r0 = (unsigned)rg[q], r1 = (unsigned)(rg[q] >> 32); const float rr[4] = {bflo(r0), bfhi(r0), bflo(r1), bfhi(r1)}; float y[4];
#pragma unroll
            for (int k = 0; k < 4; ++k) { const float sl = rr[k] / (1.0f + expf(-rr[k])); y[k] = OT[eb][4 * g + k] * rs * g4[k] * sl; }
            *(unsigned long long*)(MIXED + row * DM + 768 + h * 64 + e0) = (unsigned long long)pk2(y[0], y[1]) | ((unsigned long long)pk2(y[2], y[3]) << 32); }
    }
    const float lam = ((const float*)(F.ws + WS_LAM))[l * 2], oscale = ((const float*)(F.ws + WS_LAM))[l * 2 + 1];
    const bf16* OATT = (const bf16*)(F.ws + WS_OATT); const float* dn = (const float*)(F.ws + WS_PAR) + PAR_DN + l * 128; const float* cw = (const float*)(F.ws + WS_PAR) + PAR_CW + l * 3 * 256;
    const float dn0 = dn[2 * lane], dn1 = dn[2 * lane + 1]; const int ch = 4 * lane;
    f32x4 wj[3];
#pragma unroll
    for (int j = 0; j < 3; ++j) wj[j] = *(const f32x4*)(cw + j * 256 + ch);
#pragma unroll 1
    for (int r0 = 0; r0 < 8; r0 += 4) {
        unsigned w1[4][4], w2[4][4]; unsigned long long cwd[6], hwd[6], bwd[4];
        const int tb = t0 + wave * 8 + r0;
#pragma unroll
        for (int u = 0; u < 4; ++u)
#pragma unroll
            for (int hq = 0; hq < 4; ++hq) { w1[u][hq] = *(const unsigned*)(OATT + (size_t)(tb + u) * DM + hq * 128 + 2 * lane); w2[u][hq] = *(const unsigned*)(OATT + (size_t)(tb + u) * DM + 512 + hq * 128 + 2 * lane); }
#pragma unroll
        for (int u = 0; u < 6; ++u) { const int tr = tb - 2 + u; const bool ok = ((tb & (SEQL - 1)) - 2 + u) >= 0;
            const bf16* pr = PROJ + (size_t)(ok ? tr : tb) * NPROJ; cwd[u] = ok ? *(const unsigned long long*)(pr + C_SC + ch) : 0ull; hwd[u] = ok ? *(const unsigned long long*)(pr + C_SH + ch) : 0ull; }
#pragma unroll
        for (int u = 0; u < 4; ++u) bwd[u] = *(const unsigned long long*)(PROJ + (size_t)(tb + u) * NPROJ + C_SB + ch);
        f32x4 z[6];
#pragma unroll
        for (int u = 0; u < 6; ++u) { const unsigned c0 = (unsigned)cwd[u], c1 = (unsigned)(cwd[u] >> 32), h0 = (unsigned)hwd[u], h1 = (unsigned)(hwd[u] >> 32); z[u] = (f32x4){bflo(c0) * bflo(h0), bfhi(c0) * bfhi(h0), bflo(c1) * bflo(h1), bfhi(c1) * bfhi(h1)}; }
#pragma unroll
        for (int u = 0; u < 4; ++u) { const int t = tb + u;
#pragma unroll
            for (int hq = 0; hq < 4; ++hq) { const float o0 = bflo(w1[u][hq]) - lam * bflo(w2[u][hq]), o1 = bfhi(w1[u][hq]) - lam * bfhi(w2[u][hq]); const float ssq = wave_sum(o0 * o0 + o1 * o1);
                const float rsq = oscale / sqrtf(ssq * (1.0f / 128.0f) + EPS);
                *(unsigned*)(MIXED + (size_t)t * DM + hq * 128 + 2 * lane) = pk2(o0 * rsq * dn0, o1 * rsq * dn1); }
            const f32x4 y = wj[0] * z[u] + wj[1] * z[u + 1] + wj[2] * z[u + 2];
            const unsigned b0 = (unsigned)bwd[u], b1 = (unsigned)(bwd[u] >> 32);
            *(unsigned long long*)(MIXED + (size_t)t * DM + 512 + ch) = (unsigned long long)pk2(bflo(b0) * y[0], bfhi(b0) * y[1]) | ((unsigned long long)pk2(bflo(b1) * y[2], bfhi(b1) * y[3]) << 32); }
    }
    __syncthreads();
}

#define TK_HD __device__ __forceinline__
#ifndef TK_HD
#define TK_HD __device__ __forceinline__
#endif
TK_HD int tk_max(int a, int b) { return a > b ? a : b; }
TK_HD int tk_min(int a, int b) { return a < b ? a : b; }
TK_HD int tk_f2key(float f) { int b = __builtin_bit_cast(int, f); return b ^ ((b >> 31) & 0x7fffffff); }
TK_HD float tk_key2f(int k) { return __builtin_bit_cast(float, k ^ ((k >> 31) & 0x7fffffff)); }
template <int N> TK_HD void tk_sort_desc(int (&a)[N]) {
#pragma unroll
    for (int k = 2; k <= N; k <<= 1)
#pragma unroll
        for (int j = k >> 1; j > 0; j >>= 1)
#pragma unroll
            for (int i = 0; i < N; ++i) { const int l = i ^ j; if (l > i) { const int hi = tk_max(a[i], a[l]), lo = tk_min(a[i], a[l]); if ((i & k) == 0) { a[i] = hi; a[l] = lo; } else { a[i] = lo; a[l] = hi; } } }
}
template <int N> TK_HD void tk_merge_desc(int (&a)[N]) {
#pragma unroll
    for (int j = N >> 1; j > 0; j >>= 1)
#pragma unroll
        for (int i = 0; i < N; ++i) { const int l = i ^ j; if (l > i) { const int hi = tk_max(a[i], a[l]), lo = tk_min(a[i], a[l]); a[i] = hi; a[l] = lo; } }
}
TK_HD void tk_top16_merge(int (&a)[16], const int (&b)[16]) {
#pragma unroll
    for (int i = 0; i < 16; ++i) a[i] = tk_max(a[i], b[15 - i]);
    tk_merge_desc<16>(a);
}
TK_HD constexpr int tk_cand_i(int set, int s) {
    if (set == 0) return s < 16 ? 0 : (s < 24 ? 1 : (s == 24 ? 8 : -1));
    return s < 5 ? 2 : s < 9 ? 3 : s < 12 ? 4 : s < 14 ? 5 : s < 16 ? 6 : s < 18 ? 7 : s < 25 ? (9 + (s - 18)) : -1;
}
TK_HD constexpr int tk_cand_j(int set, int s) {
    if (set == 0) return s < 16 ? s : (s < 24 ? s - 16 : (s == 24 ? 0 : -1));
    return s < 5 ? s : s < 9 ? s - 5 : s < 12 ? s - 9 : s < 14 ? s - 12 : s < 16 ? s - 14 : s < 18 ? s - 16 : s < 25 ? 0 : -1;
}

constexpr int PS_KSTRIDE = 136;
__device__ __forceinline__ void peer_select_task(Frame& F, int l, int t0, int h, LAS int* scr  , const LAS bf16* KL  ) {
    typedef float f32x16 __attribute__((ext_vector_type(16)));
    const int lane = F.lane, r32 = lane & 31, hi = lane >> 5;
    const bf16* QP = (const bf16*)(F.ws + WS_QP);
    int lists[2][16];
    bf16x8 qall[2][8];
#pragma unroll
    for (int half = 0; half < 2; ++half) { const bf16* qp = QP + (size_t)(t0 + r32) * NQ + h * 256 + half * 128 + hi * 8;
#pragma unroll
        for (int ks = 0; ks < 8; ++ks) qall[half][ks] = *(const bf16x8*)(qp + ks * 16); }
#pragma unroll
    for (int half = 0; half < 2; ++half) {
        const bf16x8 (&qf)[8] = qall[half];
        int cur[16];
#pragma unroll
        for (int kb = 0; kb < 4; ++kb) {
            f32x16 c = {};
            const LAS bf16* kp = KL + (half * 128 + kb * 32 + r32) * PS_KSTRIDE + hi * 8;
#pragma unroll
            for (int ks = 0; ks < 8; ++ks) { const bf16x8 kf = *(const LAS bf16x8*)(kp + ks * 16); c = __builtin_amdgcn_mfma_f32_32x32x16_bf16(kf, qf[ks], c, 0, 0, 0); }
            int g[16];
#pragma unroll
            for (int r = 0; r < 16; ++r) { const int key = kb * 32 + (r & 3) + 8 * (r >> 2) + 4 * hi; g[r] = (tk_f2key(c[r]) & ~127) | (127 - key); }
            tk_sort_desc<16>(g);
            if (kb == 0) {
#pragma unroll
                for (int r = 0; r < 16; ++r) cur[r] = g[r];
            } else tk_top16_merge(cur, g);
        }
        int oth[16];
#pragma unroll
        for (int r = 0; r < 16; ++r) oth[r] = xl_xor32_i(cur[r], hi);
        tk_top16_merge(cur, oth);
#pragma unroll
        for (int r = 0; r < 16; ++r) lists[half][r] = cur[r];
    }
#pragma unroll
    for (int r = 0; r < 16; ++r) scr[r32 * 32 + hi * 16 + r] = 127 - ((hi ? lists[1][r] : lists[0][r]) & 127);
    float v1[16], v2[16];
#pragma unroll
    for (int r = 0; r < 16; ++r) { v1[r] = tk_key2f(lists[0][r]); v2[r] = tk_key2f(lists[1][r]); }
    int c[32];
#pragma unroll
    for (int s = 0; s < 32; ++s) {
        constexpr int NEG = (int)0x80000000;
        const int ia = tk_cand_i(0, s), ja = tk_cand_j(0, s), ib = tk_cand_i(1, s), jb = tk_cand_j(1, s);
        if (ia < 0) c[s] = NEG;
        else { const int ka = (tk_f2key(v1[ia] + v2[ja]) & ~255) | (255 - (ia * 16 + ja)), kb2 = (tk_f2key(v1[ib] + v2[jb]) & ~255) | (255 - (ib * 16 + jb)); c[s] = hi ? kb2 : ka; }
    }
    tk_sort_desc<32>(c);
    int fin[16], oth[16];
#pragma unroll
    for (int r = 0; r < 16; ++r) { fin[r] = c[r]; oth[r] = xl_xor32_i(c[r], hi); }
    tk_top16_merge(fin, oth);
    float p[16]; float sum = 0.f; const float mx = tk_key2f(fin[0]);
#pragma unroll
    for (int r = 0; r < 16; ++r) { p[r] = expf(tk_key2f(fin[r]) - mx); sum += p[r]; }
    const float inv = 1.0f / sum;
    asm volatile("s_waitcnt lgkmcnt(0)" ::: "memory");
    int* EX = (int*)(F.ws + WS_EXP) + (size_t)(t0 + r32) * 128 + h * 16; float* GT = (float*)(F.ws + WS_GATE) + (size_t)(t0 + r32) * 128 + h * 16;
#pragma unroll
    for (int r = 0; r < 16; ++r) { const int code = 255 - (fin[r] & 255); const int e1 = scr[r32 * 32 + (code >> 4)], e2 = scr[r32 * 32 + 16 + (code & 15)];
        if ((r >> 3) == hi) { EX[r] = e1 * 128 + e2; GT[r] = p[r] * inv; } }
    asm volatile("s_waitcnt lgkmcnt(0)" ::: "memory");
}

__device__ __forceinline__ float gelu_erf(float x) { return 0.5f * x * (1.0f + erff(x * 0.70710678118654752f)); }
typedef __bf16 bf16x2_t __attribute__((ext_vector_type(2)));
__device__ __forceinline__ float dot2bf(unsigned a, unsigned b, float c) { return __builtin_amdgcn_fdot2_f32_bf16(__builtin_bit_cast(bf16x2_t, a), __builtin_bit_cast(bf16x2_t, b), c, false); }
template <int J> __device__ __forceinline__ int xl_xchg_i(int v, int hi) { if constexpr (J == 32) return xl_xor32_i(v, hi); else return xl_swz_i<J>(v); }
template <int K, int J> __device__ __forceinline__ void sort128_step(int& ka, int& kb, int lane) {
    if constexpr (J == 64) { const int lo = ka < kb ? ka : kb, hi = ka < kb ? kb : ka; ka = lo; kb = hi; }
    else { const int oa = xl_xchg_i<J>(ka, lane >> 5), ob = xl_xchg_i<J>(kb, lane >> 5); const bool lower = (lane & J) == 0;
        const bool upa = (K >= 64) ? true : ((lane & K) == 0), upb = (K >= 128) ? true : (K == 64 ? false : ((lane & K) == 0));
        const int mina = ka < oa ? ka : oa, maxa = ka < oa ? oa : ka, minb = kb < ob ? kb : ob, maxb = kb < ob ? ob : kb;
        ka = (upa == lower) ? mina : maxa; kb = (upb == lower) ? minb : maxb; }
}
__device__ __forceinline__ void sort128(int& ka, int& kb, int lane) {
#define S_(K, J) sort128_step<K, J>(ka, kb, lane);
    S_(2, 1) S_(4, 2) S_(4, 1) S_(8, 4) S_(8, 2) S_(8, 1) S_(16, 8) S_(16, 4) S_(16, 2) S_(16, 1) S_(32, 16) S_(32, 8) S_(32, 4) S_(32, 2) S_(32, 1)
    S_(64, 32) S_(64, 16) S_(64, 8) S_(64, 4) S_(64, 2) S_(64, 1) S_(128, 64) S_(128, 32) S_(128, 16) S_(128, 8) S_(128, 4) S_(128, 2) S_(128, 1)
#undef S_
}
typedef float f32x2g __attribute__((ext_vector_type(2)));
#define PT_WGSYNC 1
#ifndef PT_SYNC_EVERY
#define PT_SYNC_EVERY 4
#endif
#ifndef PT_FIXED_ORDER
#define PT_GREEDY 1
#endif
#ifndef PT_CH
#define PT_CH 8
#endif
constexpr int PT_T = 4;
constexpr int PT_TOK_INTS = 128 + 128 + 64 + 256 + 4 + 128;
constexpr int PT_WAVE_INTS = PT_T * PT_TOK_INTS;
__device__ __forceinline__ float pt_dot8(const v4u w, const f32x2g (&xv)[8]) {
    f32x2g a = (f32x2g){0.f, 0.f};
    a = __builtin_elementwise_fma(__builtin_amdgcn_cvt_pk_f32_fp8(w.x, false), xv[0], a); a = __builtin_elementwise_fma(__builtin_amdgcn_cvt_pk_f32_fp8(w.x, true), xv[1], a);
    a = __builtin_elementwise_fma(__builtin_amdgcn_cvt_pk_f32_fp8(w.y, false), xv[2], a); a = __builtin_elementwise_fma(__builtin_amdgcn_cvt_pk_f32_fp8(w.y, true), xv[3], a);
    a = __builtin_elementwise_fma(__builtin_amdgcn_cvt_pk_f32_fp8(w.z, false), xv[4], a); a = __builtin_elementwise_fma(__builtin_amdgcn_cvt_pk_f32_fp8(w.z, true), xv[5], a);
    a = __builtin_elementwise_fma(__builtin_amdgcn_cvt_pk_f32_fp8(w.w, false), xv[6], a); a = __builtin_elementwise_fma(__builtin_amdgcn_cvt_pk_f32_fp8(w.w, true), xv[7], a);
    return a.x + a.y;
}
__device__ __forceinline__ void pt_axpy8(const v4u w, const float c, f32x2g (&o)[8]) {
    const f32x2g cc = (f32x2g){c, c};
    o[0] = __builtin_elementwise_fma(__builtin_amdgcn_cvt_pk_f32_fp8(w.x, false), cc, o[0]); o[1] = __builtin_elementwise_fma(__builtin_amdgcn_cvt_pk_f32_fp8(w.x, true), cc, o[1]);
    o[2] = __builtin_elementwise_fma(__builtin_amdgcn_cvt_pk_f32_fp8(w.y, false), cc, o[2]); o[3] = __builtin_elementwise_fma(__builtin_amdgcn_cvt_pk_f32_fp8(w.y, true), cc, o[3]);
    o[4] = __builtin_elementwise_fma(__builtin_amdgcn_cvt_pk_f32_fp8(w.z, false), cc, o[4]); o[5] = __builtin_elementwise_fma(__builtin_amdgcn_cvt_pk_f32_fp8(w.z, true), cc, o[5]);
    o[6] = __builtin_elementwise_fma(__builtin_amdgcn_cvt_pk_f32_fp8(w.w, false), cc, o[6]); o[7] = __builtin_elementwise_fma(__builtin_amdgcn_cvt_pk_f32_fp8(w.w, true), cc, o[7]);
}
__device__ __forceinline__ int xl_sum32_i(int v) { unsigned a = (unsigned)v, b = a; asm volatile("" : "+v"(b)); auto r = __builtin_amdgcn_permlane32_swap(a, b, false, false); const unsigned r0 = r[0], r1 = r[1]; return (int)(r0 + r1); }
__device__ __forceinline__ void pt_chunk(const LAS int* se, const LAS float* sg, int base, const v4u xq, f32x2g (&out)[8], float hscale,
                                         const unsigned char* Ub, const unsigned char* Vb, const float* SU, const float* SV, int lane) {
    const int e_l = se[base + (lane & (PT_CH - 1))]; const float g_l = sg[base + (lane & (PT_CH - 1))], hu_l = sg[452 + base + (lane & (PT_CH - 1))];
    v4u uw[PT_CH], vw[PT_CH];
#pragma unroll
    for (int s = 0; s < PT_CH; ++s) { const int e = __builtin_amdgcn_readlane(e_l, s); uw[s] = *(const v4u*)(Ub + (size_t)e * 1024 + 16 * lane); }
#pragma unroll
    for (int s = 0; s < PT_CH; ++s) { const int e = __builtin_amdgcn_readlane(e_l, s); vw[s] = *(const v4u*)(Vb + (size_t)e * 1024 + 16 * lane); }
    int p[PT_CH];
#pragma unroll
    for (int s = 0; s < PT_CH; ++s) { int a = __builtin_amdgcn_sdot4((int)uw[s].x, (int)xq.x, 0, false); a = __builtin_amdgcn_sdot4((int)uw[s].y, (int)xq.y, a, false);
        a = __builtin_amdgcn_sdot4((int)uw[s].z, (int)xq.z, a, false); p[s] = __builtin_amdgcn_sdot4((int)uw[s].w, (int)xq.w, a, false); }
#define PT_BFLY(S) _Pragma("unroll") for (int i = 0; i < S; ++i) { const bool up = (lane & S) != 0; const int keep = up ? p[i + S] : p[i], send = up ? p[i] : p[i + S]; p[i] = keep + xl_swz_i<S>(send); }
#if PT_CH == 16
    PT_BFLY(8)
#endif
    PT_BFLY(4) PT_BFLY(2) PT_BFLY(1)
#undef PT_BFLY
    int hi_ = p[0];
#if PT_CH == 8
    hi_ += xl_swz_i<8>(hi_);
#endif
    hi_ += xl_swz_i<16>(hi_); hi_ = xl_sum32_i(hi_);
    const float c_l = g_l * gelu_erf((float)hi_ * hu_l);
#pragma unroll
    for (int s = 0; s < PT_CH; ++s) { const float c = __builtin_bit_cast(float, __builtin_amdgcn_readlane(__builtin_bit_cast(int, c_l), s)); pt_axpy8(vw[s], c, out); }
}
__device__ __forceinline__ void pt_sort_regs(LAS int* se, LAS float* sg, LAS int* cnt, LAS float* sh, int ea, int eb, float ga, float gb, float ha, float hb, int lane) {
    cnt[lane] = 0;
    asm volatile("s_waitcnt lgkmcnt(0)" ::: "memory");
    __hip_atomic_fetch_add(cnt + (ea >> 8), 1, __ATOMIC_RELAXED, __HIP_MEMORY_SCOPE_WAVEFRONT); __hip_atomic_fetch_add(cnt + (eb >> 8), 1, __ATOMIC_RELAXED, __HIP_MEMORY_SCOPE_WAVEFRONT);
    asm volatile("s_waitcnt lgkmcnt(0)" ::: "memory");
    const int c = cnt[lane]; int incl = c;
    int ln = lane; asm volatile("" : "+v"(ln));
#pragma unroll
    for (int off = 1; off < 64; off <<= 1) { const int o = __builtin_amdgcn_ds_bpermute(((ln - off) & 63) << 2, incl); incl += (ln >= off) ? o : 0; }
    asm volatile("s_waitcnt lgkmcnt(0)" ::: "memory");
    cnt[lane] = incl - c;
    asm volatile("s_waitcnt lgkmcnt(0)" ::: "memory");
    const int pa = __hip_atomic_fetch_add(cnt + (ea >> 8), 1, __ATOMIC_RELAXED, __HIP_MEMORY_SCOPE_WAVEFRONT);
    const int pb = __hip_atomic_fetch_add(cnt + (eb >> 8), 1, __ATOMIC_RELAXED, __HIP_MEMORY_SCOPE_WAVEFRONT);
    se[pa] = ea; sg[pa] = ga; sh[pa] = ha; se[pb] = eb; sg[pb] = gb; sh[pb] = hb;
    asm volatile("s_waitcnt lgkmcnt(0)" ::: "memory");
}
__device__ __forceinline__ void pt_sort(LAS int* se, LAS float* sg, LAS int* cnt, const int* EX, const float* GT, int lane, bool dry, const float* SU = nullptr, const float* SV = nullptr, float hs = 1.0f, LAS float* sh = nullptr) {
    int ea = EX[lane], eb = EX[64 + lane];
#ifdef DRYMASK
    if (dry) { ea &= DRYMASK; eb &= DRYMASK; }
#endif
    (void)dry; float ga = GT[lane], gb = GT[64 + lane]; float ha = 0.f, hb = 0.f;
    if (sh) { ga *= SV[ea]; gb *= SV[eb]; ha = hs * SU[ea]; hb = hs * SU[eb]; }
    cnt[lane] = 0;
    asm volatile("s_waitcnt lgkmcnt(0)" ::: "memory");
    __hip_atomic_fetch_add(cnt + (ea >> 8), 1, __ATOMIC_RELAXED, __HIP_MEMORY_SCOPE_WAVEFRONT); __hip_atomic_fetch_add(cnt + (eb >> 8), 1, __ATOMIC_RELAXED, __HIP_MEMORY_SCOPE_WAVEFRONT);
    asm volatile("s_waitcnt lgkmcnt(0)" ::: "memory");
    const int c = cnt[lane];
    int incl = c;
    int ln = lane; asm volatile("" : "+v"(ln));
#pragma unroll
    for (int off = 1; off < 64; off <<= 1) { const int o = __builtin_amdgcn_ds_bpermute(((ln - off) & 63) << 2, incl); incl += (ln >= off) ? o : 0; }
    asm volatile("s_waitcnt lgkmcnt(0)" ::: "memory");
    cnt[lane] = incl - c;
    asm volatile("s_waitcnt lgkmcnt(0)" ::: "memory");
    const int pa = __hip_atomic_fetch_add(cnt + (ea >> 8), 1, __ATOMIC_RELAXED, __HIP_MEMORY_SCOPE_WAVEFRONT);
    const int pb = __hip_atomic_fetch_add(cnt + (eb >> 8), 1, __ATOMIC_RELAXED, __HIP_MEMORY_SCOPE_WAVEFRONT);
    se[pa] = ea; sg[pa] = ga; se[pb] = eb; sg[pb] = gb; if (sh) { sh[pa] = ha; sh[pb] = hb; }
    asm volatile("s_waitcnt lgkmcnt(0)" ::: "memory");
}
__device__ __forceinline__ void peer_tokens4(Frame& F, int l, int tq, bool last, LAS int* scr, unsigned* xs_word, unsigned xs_nloc, unsigned& xs_round, bool dry = false) {
    const int lane = F.lane;
    const unsigned char* Ub = F.ws + WS_U8 + l * TAB_STRIDE; const unsigned char* Vb = F.ws + WS_V8 + l * TAB_STRIDE;
    const float* SU = (const float*)(F.ws + WS_SU) + l * 16384; const float* SV = (const float*)(F.ws + WS_SV) + l * 16384;
    f32x2g out[PT_T][8];
    {
        int ls = lane; asm volatile("" : "+v"(ls));
        v4u xw_[PT_T][2]; int ea[PT_T], eb[PT_T]; float ga[PT_T], gb[PT_T], rs[PT_T], sua[PT_T], sub_[PT_T], sva[PT_T], svb[PT_T];
#pragma unroll
        for (int k = 0; k < PT_T; ++k) { const int t = tq + k; const bf16* Xr = (const bf16*)(F.ws + WS_XB) + (size_t)t * DM + 16 * ls; const int* EX = (const int*)(F.ws + WS_EXP) + (size_t)t * 128; const float* GT = (const float*)(F.ws + WS_GATE) + (size_t)t * 128;
            ea[k] = EX[ls]; eb[k] = EX[64 + ls]; ga[k] = GT[ls]; gb[k] = GT[64 + ls];
#ifdef DRYMASK
            if (dry) { ea[k] &= DRYMASK; eb[k] &= DRYMASK; }
#endif
            xw_[k][0] = *(const v4u*)(Xr); xw_[k][1] = *(const v4u*)(Xr + 8); rs[k] = pg8::row_rstd((const float*)(F.ws + WS_SSQ), t); }
#pragma unroll
        for (int k = 0; k < PT_T; ++k) { sua[k] = SU[ea[k]]; sub_[k] = SU[eb[k]]; sva[k] = SV[ea[k]]; svb[k] = SV[eb[k]]; }
#pragma unroll
        for (int k = 0; k < PT_T; ++k) { LAS int* tk = scr + k * PT_TOK_INTS;
            f32x4 xr[1][4];
#pragma unroll
            for (int j = 0; j < 4; ++j) { const v4u w = xw_[k][j >> 1]; const unsigned a = (j & 1) ? w.z : w.x, b = (j & 1) ? w.w : w.y; xr[0][j] = (f32x4){bflo(a), bfhi(a), bflo(b), bfhi(b)}; }
            float mx = 0.f;
#pragma unroll
            for (int j = 0; j < 4; ++j) mx = fmaxf(mx, fmaxf(fmaxf(fabsf(xr[0][j][0]), fabsf(xr[0][j][1])), fmaxf(fabsf(xr[0][j][2]), fabsf(xr[0][j][3]))));
            mx = fmaxf(mx, xl_swz<1>(mx)); mx = fmaxf(mx, xl_swz<2>(mx)); mx = fmaxf(mx, xl_swz<4>(mx)); mx = fmaxf(mx, xl_swz<8>(mx)); mx = fmaxf(mx, xl_swz<16>(mx));
            mx = fmaxf(mx, __builtin_bit_cast(float, xl_xor32_i(__builtin_bit_cast(int, mx), lane >> 5)));
            const float sc = mx > 0.f ? 127.0f / mx : 0.f;
#define PT_Q4(v) ((unsigned)((int)rintf((v)[0] * sc) & 255) | ((unsigned)((int)rintf((v)[1] * sc) & 255) << 8) | ((unsigned)((int)rintf((v)[2] * sc) & 255) << 16) | ((unsigned)((int)rintf((v)[3] * sc) & 255) << 24))
            *(LAS v4u*)(tk + 320 + 4 * lane) = (v4u){PT_Q4(xr[0][0]), PT_Q4(xr[0][1]), PT_Q4(xr[0][2]), PT_Q4(xr[0][3])};
#undef PT_Q4
            const float hs_ = rs[k] * mx * (1.0f / 127.0f);
            pt_sort_regs(tk, (LAS float*)(tk + 128), tk + 256, (LAS float*)(tk + 580), ea[k], eb[k], ga[k] * sva[k], gb[k] * svb[k], hs_ * sua[k], hs_ * sub_[k], lane);
            asm volatile("" ::: "memory"); }
    }
#pragma unroll
    for (int k = 0; k < PT_T; ++k)
#pragma unroll
        for (int i = 0; i < 8; ++i) out[k][i] = (f32x2g){0.f, 0.f};
#ifdef PT_GREEDY
    static_assert(PT_T == 4 && PT_CH == 8, "greedy sweep: four tokens, chunks of eight");
    int csv0, csv1, csv2, csv3;
    { int lc = lane; asm volatile("" : "+v"(lc)); const int ci = (lc & 15) * PT_CH; const bool in = lc < 16;
      csv0 = in ? scr[0 * PT_TOK_INTS + ci] : 0x7fffffff; csv1 = in ? scr[1 * PT_TOK_INTS + ci] : 0x7fffffff; csv2 = in ? scr[2 * PT_TOK_INTS + ci] : 0x7fffffff; csv3 = in ? scr[3 * PT_TOK_INTS + ci] : 0x7fffffff; }
    int pos0 = 0, pos1 = 0, pos2 = 0, pos3 = 0;
#define PT_RUN(K, POS) { const LAS int* tk = scr + K * PT_TOK_INTS; const v4u xq = *(const LAS v4u*)(tk + 320 + 4 * lane); \
        pt_chunk(tk, (const LAS float*)(tk + 128), PT_CH * POS, xq, out[K], 0.f, Ub, Vb, SU, SV, lane); ++POS; asm volatile("" ::: "memory"); }
#pragma unroll 1
    for (int ck = 0; ck < 128 / PT_CH; ++ck) {
#pragma unroll 1
        for (int j = 0; j < PT_T; ++j) {
            const int s0 = __builtin_amdgcn_readlane(csv0, pos0), s1 = __builtin_amdgcn_readlane(csv1, pos1), s2 = __builtin_amdgcn_readlane(csv2, pos2), s3 = __builtin_amdgcn_readlane(csv3, pos3);
            const int m01 = s0 <= s1 ? s0 : s1, m23 = s2 <= s3 ? s2 : s3;
            if (m01 <= m23) { if (s0 <= s1) PT_RUN(0, pos0) else PT_RUN(1, pos1) }
            else { if (s2 <= s3) PT_RUN(2, pos2) else PT_RUN(3, pos3) }
        }
#else
#pragma unroll 1
    for (int ck = 0; ck < 128 / PT_CH; ++ck) {
#pragma unroll
        for (int k = 0; k < PT_T; ++k) { const LAS int* tk = scr + k * PT_TOK_INTS; const v4u xq = *(const LAS v4u*)(tk + 320 + 4 * lane); const float hsc = ((const LAS float*)tk)[576];
            pt_chunk(tk, (const LAS float*)(tk + 128), PT_CH * ck, xq, out[k], hsc, Ub, Vb, SU, SV, lane); asm volatile("" ::: "memory"); }
#endif
#ifdef PT_WGSYNC
        if ((ck % PT_SYNC_EVERY) == PT_SYNC_EVERY - 1) __syncthreads();
#if PT_WGSYNC >= 2
        if ((ck % PT_XSTEP) == PT_XSTEP - 1) { if (F.tid == 0) { unsigned* w = xs_word; const unsigned tgt = (++xs_round) * xs_nloc; __hip_atomic_fetch_add(w, 1u, __ATOMIC_RELAXED, __HIP_MEMORY_SCOPE_AGENT);
                unsigned sp = 0; while (__hip_atomic_load(w, __ATOMIC_RELAXED, __HIP_MEMORY_SCOPE_AGENT) < tgt && ++sp < (1u << 16)) __builtin_amdgcn_s_sleep(1); }
            __syncthreads(); }
#endif
#endif
    }
#pragma unroll
    for (int k = 0; k < PT_T; ++k) { int lf = lane; asm volatile("" : "+v"(lf)); const int t = tq + k; float* X = F.out + (size_t)t * DM + 16 * lf; bf16* XBr = (bf16*)(F.ws + WS_XB) + (size_t)t * DM + 16 * lf;
        const v4u ra = *(const v4u*)(XBr), rb = *(const v4u*)(XBr + 8);
        f32x4 x0 = (f32x4){bflo(ra.x), bfhi(ra.x), bflo(ra.y), bfhi(ra.y)} + (f32x4){out[k][0].x, out[k][0].y, out[k][1].x, out[k][1].y}, x1 = (f32x4){bflo(ra.z), bfhi(ra.z), bflo(ra.w), bfhi(ra.w)} + (f32x4){out[k][2].x, out[k][2].y, out[k][3].x, out[k][3].y};
        f32x4 x2 = (f32x4){bflo(rb.x), bfhi(rb.x), bflo(rb.y), bfhi(rb.y)} + (f32x4){out[k][4].x, out[k][4].y, out[k][5].x, out[k][5].y}, x3 = (f32x4){bflo(rb.z), bfhi(rb.z), bflo(rb.w), bfhi(rb.w)} + (f32x4){out[k][6].x, out[k][6].y, out[k][7].x, out[k][7].y};
        float ss = 0.f;
#pragma unroll
        for (int i = 0; i < 4; ++i) ss += x0[i] * x0[i] + x1[i] * x1[i] + x2[i] * x2[i] + x3[i] * x3[i];
        ss = wave_sum(ss);
        if (dry && ss != -1.0f) continue;
        if (last) { const float rs = 1.0f / sqrtf(ss * (1.0f / 1024.0f) + EPS); const float* g = (const float*)(F.ws + WS_PAR) + PAR_NF + 16 * lane;
            x0 = x0 * rs * *(const f32x4*)(g); x1 = x1 * rs * *(const f32x4*)(g + 4); x2 = x2 * rs * *(const f32x4*)(g + 8); x3 = x3 * rs * *(const f32x4*)(g + 12);
            *(f32x4*)(X) = x0; *(f32x4*)(X + 4) = x1; *(f32x4*)(X + 8) = x2; *(f32x4*)(X + 12) = x3; }
        else { v4u wa, wb; wa.x = pk2(x0[0], x0[1]); wa.y = pk2(x0[2], x0[3]); wa.z = pk2(x1[0], x1[1]); wa.w = pk2(x1[2], x1[3]); wb.x = pk2(x2[0], x2[1]); wb.y = pk2(x2[2], x2[3]); wb.z = pk2(x3[0], x3[1]); wb.w = pk2(x3[2], x3[3]);
            *(v4u*)(XBr) = wa; *(v4u*)(XBr + 8) = wb;
            if (lf == 0) ((float*)(F.ws + WS_RS1))[t] = 1.0f / sqrtf(ss * (1.0f / 1024.0f) + EPS); }
        asm volatile("" ::: "memory"); }
}

constexpr int NPHASE = 1 + 8 * NLAYER;
struct Args { const float* in[21]; float* out; unsigned char* ws; int ph_lo, ph_hi, use_bar, pad; };
__global__ void __launch_bounds__(NWAVES * 64, 2) hymba_fwd(Args args) {
    extern __shared__ __attribute__((aligned(16))) unsigned char lds[];
    Frame F;
    F.lds = (LAS unsigned char*)lds;
    F.MISC = (volatile LAS unsigned*)(F.lds + MISC_OFF);
    F.tid = threadIdx.x; F.lane = F.tid & 63; F.wave = __builtin_amdgcn_readfirstlane(F.tid >> 6);
    F.G = gridDim.x; F.bx = blockIdx.x; { const int bx = blockIdx.x; F.vcu = (F.G % 8 == 0) ? (bx % 8) * (F.G / 8) + bx / 8 : bx; }
    F.out = args.out; F.ws = args.ws;
    for (int u = F.tid; u < (LDS_BYTES - LDSCTL_OFF) / 4; u += NWAVES * 64) ((LAS unsigned*)(F.lds + LDSCTL_OFF))[u] = 0u;
    __syncthreads();
    XcdBarrier bar; bar.bar = ((unsigned*)(args.ws + WS_CTL) + CW_BAR); bar.x = 0; bar.st = nullptr;
    if (args.use_bar) bar = xcd_barrier_post(((unsigned*)(args.ws + WS_CTL) + CW_BAR), F.MISC + 8);
    const int lo = args.ph_lo, hi = args.ph_hi;
#ifndef PHMASK
#define PHMASK 0x1ff
#endif
#ifndef REPMASK
#define REPMASK 0
#endif
#define REPS(bit) (((REPMASK >> (bit)) & 1) ? 2 : 1)
#define IN(k) (((PHMASK >> ((k) == 0 ? 0 : 1 + (((k) - 1) & 7))) & 1) && lo <= (k) && (k) < hi)
#define SEAM(k) do { if (IN(k) && IN((k) + 1)) { XcdBarrier b_ = bar; int zb_ = 0; asm volatile("" : "+s"(zb_), "+s"(b_.x)); b_.bar = bar.bar + zb_; xcd_barrier(b_, F.tid == 0); } FRESH(); } while (0)
#define FRESH() do { int ln_; int wv_ = wave0; asm volatile("v_mbcnt_lo_u32_b32 %0, -1, 0\n\tv_mbcnt_hi_u32_b32 %0, -1, %0" : "=v"(ln_)); asm volatile("" : "+s"(wv_)); F.lane = ln_; F.wave = wv_; F.tid = wv_ * 64 + ln_; \
        int z_ = 0, v_ = vcu0, g_ = (int)gridDim.x, bx_ = (int)blockIdx.x; asm volatile("" : "+s"(z_), "+s"(v_), "+s"(g_), "+s"(bx_)); F.ws = args.ws + z_; F.out = args.out + z_; F.vcu = v_; F.G = g_; F.bx = bx_; } while (0)
    if (IN(0)) { for (int rep_ = 0; rep_ < REPS(8); ++rep_) { p0_prologue(F, args); __syncthreads(); } }
    const int vcu0 = F.vcu, wave0 = F.wave;
    SEAM(0);
    { constexpr int l = 0;

        const int pb = 1 + 8 * l;
        if (IN(pb + 0)) for (int rep_ = 0; rep_ < REPS(0); ++rep_) {
            pg8::Gemm g{(const pg8::bf16_t*)(F.ws + WS_XB), (const pg8::bf16_t*)(F.ws + WS_WIN + l * WIN_STRIDE), M, NPROJ, DM}; pg8::StaticOrder S; S.init(M, NPROJ, F.G, F.bx);
            pg8::EpiScale<true> E{(pg8::bf16_t*)(F.ws + WS_PROJ), NPROJ, (const float*)(F.ws + WS_RS1), (const float*)(F.ws + WS_COS), (const float*)(F.ws + WS_SIN), ATT_C2};
            pg8::gemm_phase<pg8::EpiScale<true>, pg8::StaticOrder, PG8_ALIGN, PG8_SP2>(F.lds + RING_OFF, g, S, E, F.tid);
        }
        SEAM(pb + 0);
        if (IN(pb + 1)) for (int rep_ = 0; rep_ < REPS(1); ++rep_) {
            if (args.pad == 0) { const attn_body::StaticOrder S(F.vcu);     attn_body::attn_phase<attn_body::StaticOrder>((char*)lds + RING_OFF, (const attn_body::bf16*)(F.ws + WS_PROJ), (attn_body::bf16*)(F.ws + WS_OATT), S, F.tid); }
            __syncthreads(); FRESH();
            for (int ci = F.vcu; ci < 256; ci += F.G) gla_prep(F, l, ci, args.pad >= 2 ? args.pad - 1 : 0);
        }
        SEAM(pb + 1);
        if (IN(pb + 2) && args.pad != 1) gla_scan(F);
        SEAM(pb + 2);
        if (IN(pb + 3)) for (int rep_ = 0; rep_ < REPS(3); ++rep_) { for (int ci = F.vcu; ci < 256; ci += F.G) mix_chunk(F, l, ci); }
        SEAM(pb + 3);
        if (IN(pb + 4)) {
            pg8::Gemm g{(const pg8::bf16_t*)(F.ws + WS_MIXED), (const pg8::bf16_t*)(F.ws + WS_WOUT + l * WOUT_STRIDE), M, DM, DM}; pg8::StaticOrder S; S.init(M, DM, F.G, F.bx);
            pg8::EpiRes E{(pg8::bf16_t*)(F.ws + WS_XB), (float*)(F.ws + WS_SSQ)};
            pg8::gemm_phase<pg8::EpiRes, pg8::StaticOrder, PG8_ALIGN, PG8_SP2>(F.lds + RING_OFF, g, S, E, F.tid);
        }
        SEAM(pb + 4);
        if (IN(pb + 5)) for (int rep_ = 0; rep_ < REPS(5); ++rep_) {
            pg8::Gemm g{(const pg8::bf16_t*)(F.ws + WS_XB), (const pg8::bf16_t*)(F.ws + WS_WQ + l * WQ_STRIDE), M, NQ, DM}; pg8::StaticOrder S; S.init(M, NQ, F.G, F.bx);
            pg8::EpiScale<false> E{(pg8::bf16_t*)(F.ws + WS_QP), NQ, (const float*)(F.ws + WS_SSQ), nullptr, nullptr, 1.0f};
            pg8::gemm_phase<pg8::EpiScale<false>, pg8::StaticOrder, PG8_ALIGN, PG8_SP2>(F.lds + RING_OFF, g, S, E, F.tid);
        }
        SEAM(pb + 5);
        if (IN(pb + 7)) {
            unsigned* xs_word = (unsigned*)(F.ws + WS_CTL) + 65536 + (l * 16 + (int)xb_xcc_id()) * 64; const unsigned xs_nloc = args.use_bar ? F.MISC[8] : 0u; unsigned xs_round = 0;
            for (int tb = vcu0; tb < M / 64; tb += (int)gridDim.x) {
                FRESH();
                {
                    LAS bf16* KLw = (LAS bf16*)(F.lds + RING_OFF + 32768); const bf16* KEYS = (const bf16*)(F.ws + WS_KEYS + l * KEYS_STRIDE);
                    for (int it = F.tid; it < 4096; it += NWAVES * 64) { const int row = it >> 4, c16 = it & 15; *(LAS v4u*)(KLw + row * PS_KSTRIDE + c16 * 8) = *(const v4u*)(KEYS + (size_t)row * 128 + c16 * 8); }
                    __syncthreads(); }
                for (int rep_ = 0; rep_ < REPS(6); ++rep_) {
                    LAS int* scr5 = (LAS int*)(F.lds + RING_OFF) + F.wave * 1024;
                    for (int i = 0; i < 2; ++i) { const int tt = F.wave * 2 + i; peer_select_task(F, l, 64 * tb + 32 * (tt >> 3), tt & 7, scr5, (const LAS bf16*)(F.lds + RING_OFF + 32768)); }
                }
                asm volatile("s_waitcnt vmcnt(0)" ::: "memory"); __syncthreads();
                FRESH();
                LAS int* scr = (LAS int*)(F.lds + RING_OFF) + F.wave * PT_WAVE_INTS;
                if (REPS(7) == 2) { for (int i = 0; i < 64 / PT_T / NWAVES; ++i) peer_tokens4(F, l, 64 * tb + (F.wave * (64 / PT_T / NWAVES) + i) * PT_T, l == NLAYER - 1, scr, xs_word + 32, xs_nloc, xs_round, true); xs_round = 0; }
                for (int i = 0; i < 64 / PT_T / NWAVES; ++i) peer_tokens4(F, l, 64 * tb + (F.wave * (64 / PT_T / NWAVES) + i) * PT_T, l == NLAYER - 1, scr, xs_word, xs_nloc, xs_round);
                __syncthreads();
            }
        }
        SEAM(pb + 7);

    }
    { constexpr int l = 1;

        const int pb = 1 + 8 * l;
        if (IN(pb + 0)) for (int rep_ = 0; rep_ < REPS(0); ++rep_) {
            pg8::Gemm g{(const pg8::bf16_t*)(F.ws + WS_XB), (const pg8::bf16_t*)(F.ws + WS_WIN + l * WIN_STRIDE), M, NPROJ, DM}; pg8::StaticOrder S; S.init(M, NPROJ, F.G, F.bx);
            pg8::EpiScale<true> E{(pg8::bf16_t*)(F.ws + WS_PROJ), NPROJ, (const float*)(F.ws + WS_RS1), (const float*)(F.ws + WS_COS), (const float*)(F.ws + WS_SIN), ATT_C2};
            pg8::gemm_phase<pg8::EpiScale<true>, pg8::StaticOrder, PG8_ALIGN, PG8_SP2>(F.lds + RING_OFF, g, S, E, F.tid);
        }
        SEAM(pb + 0);
        if (IN(pb + 1)) for (int rep_ = 0; rep_ < REPS(1); ++rep_) {
            if (args.pad == 0) { const attn_body::StaticOrder S(F.vcu);     attn_body::attn_phase<attn_body::StaticOrder>((char*)lds + RING_OFF, (const attn_body::bf16*)(F.ws + WS_PROJ), (attn_body::bf16*)(F.ws + WS_OATT), S, F.tid); }
            __syncthreads(); FRESH();
            for (int ci = F.vcu; ci < 256; ci += F.G) gla_prep(F, l, ci, args.pad >= 2 ? args.pad - 1 : 0);
        }
        SEAM(pb + 1);
        if (IN(pb + 2) && args.pad != 1) gla_scan(F);
        SEAM(pb + 2);
        if (IN(pb + 3)) for (int rep_ = 0; rep_ < REPS(3); ++rep_) { for (int ci = F.vcu; ci < 256; ci += F.G) mix_chunk(F, l, ci); }
        SEAM(pb + 3);
        if (IN(pb + 4)) {
            pg8::Gemm g{(const pg8::bf16_t*)(F.ws + WS_MIXED), (const pg8::bf16_t*)(F.ws + WS_WOUT + l * WOUT_STRIDE), M, DM, DM}; pg8::StaticOrder S; S.init(M, DM, F.G, F.bx);
            pg8::EpiRes E{(pg8::bf16_t*)(F.ws + WS_XB), (float*)(F.ws + WS_SSQ)};
            pg8::gemm_phase<pg8::EpiRes, pg8::StaticOrder, PG8_ALIGN, PG8_SP2>(F.lds + RING_OFF, g, S, E, F.tid);
        }
        SEAM(pb + 4);
        if (IN(pb + 5)) for (int rep_ = 0; rep_ < REPS(5); ++rep_) {
            pg8::Gemm g{(const pg8::bf16_t*)(F.ws + WS_XB), (const pg8::bf16_t*)(F.ws + WS_WQ + l * WQ_STRIDE), M, NQ, DM}; pg8::StaticOrder S; S.init(M, NQ, F.G, F.bx);
            pg8::EpiScale<false> E{(pg8::bf16_t*)(F.ws + WS_QP), NQ, (const float*)(F.ws + WS_SSQ), nullptr, nullptr, 1.0f};
            pg8::gemm_phase<pg8::EpiScale<false>, pg8::StaticOrder, PG8_ALIGN, PG8_SP2>(F.lds + RING_OFF, g, S, E, F.tid);
        }
        SEAM(pb + 5);
        if (IN(pb + 7)) {
            unsigned* xs_word = (unsigned*)(F.ws + WS_CTL) + 65536 + (l * 16 + (int)xb_xcc_id()) * 64; const unsigned xs_nloc = args.use_bar ? F.MISC[8] : 0u; unsigned xs_round = 0;
            for (int tb = vcu0; tb < M / 64; tb += (int)gridDim.x) {
                FRESH();
                {
                    LAS bf16* KLw = (LAS bf16*)(F.lds + RING_OFF + 32768); const bf16* KEYS = (const bf16*)(F.ws + WS_KEYS + l * KEYS_STRIDE);
                    for (int it = F.tid; it < 4096; it += NWAVES * 64) { const int row = it >> 4, c16 = it & 15; *(LAS v4u*)(KLw + row * PS_KSTRIDE + c16 * 8) = *(const v4u*)(KEYS + (size_t)row * 128 + c16 * 8); }
                    __syncthreads(); }
                for (int rep_ = 0; rep_ < REPS(6); ++rep_) {
                    LAS int* scr5 = (LAS int*)(F.lds + RING_OFF) + F.wave * 1024;
                    for (int i = 0; i < 2; ++i) { const int tt = F.wave * 2 + i; peer_select_task(F, l, 64 * tb + 32 * (tt >> 3), tt & 7, scr5, (const LAS bf16*)(F.lds + RING_OFF + 32768)); }
                }
                asm volatile("s_waitcnt vmcnt(0)" ::: "memory"); __syncthreads();
                FRESH();
                LAS int* scr = (LAS int*)(F.lds + RING_OFF) + F.wave * PT_WAVE_INTS;
                if (REPS(7) == 2) { for (int i = 0; i < 64 / PT_T / NWAVES; ++i) peer_tokens4(F, l, 64 * tb + (F.wave * (64 / PT_T / NWAVES) + i) * PT_T, l == NLAYER - 1, scr, xs_word + 32, xs_nloc, xs_round, true); xs_round = 0; }
                for (int i = 0; i < 64 / PT_T / NWAVES; ++i) peer_tokens4(F, l, 64 * tb + (F.wave * (64 / PT_T / NWAVES) + i) * PT_T, l == NLAYER - 1, scr, xs_word, xs_nloc, xs_round);
                __syncthreads();
            }
        }
        SEAM(pb + 7);

    }
#undef IN
#undef SEAM
}

#ifndef MK_DEBUG
#define MK_DEBUG 0
#endif
#ifndef DBG_LO
#define DBG_LO 0
#endif
#if MK_DEBUG
constexpr size_t WS_DBG = 30 * MiB + 896 * 1024;
constexpr size_t WS_DLA = 384 * MiB;
__device__ __forceinline__ void dbg_max(float* res, int k, float d) { if (!(d == d)) d = 1e9f; atomicMax((unsigned*)res + k, __builtin_bit_cast(unsigned, fabsf(d))); }
__device__ __forceinline__ unsigned dbg_hash(unsigned x) { x ^= x >> 16; x *= 0x7feb352dU; x ^= x >> 15; x *= 0x846ca68bU; x ^= x >> 16; return x; }
__device__ __forceinline__ float dbg_rstd(const float* x) { float s = 0.f; for (int k = 0; k < DM; ++k) s += x[k] * x[k]; return 1.0f / sqrtf(s / DM + EPS); }
__global__ void dbg_c0(Args a) {
    float* res = (float*)(a.ws + WS_DBG); const int lane = threadIdx.x;
    const float v = (float)(lane * lane + 1); float exp_sum = 0.f; for (int i = 0; i < 64; ++i) exp_sum += (float)(i * i + 1);
    dbg_max(res, 16, xl_wave_sum(v) - exp_sum);
    dbg_max(res, 17, xl_swz<16>(v) - (float)((lane ^ 16) * (lane ^ 16) + 1));
    dbg_max(res, 18, xl_swz<4>(v) - (float)((lane ^ 4) * (lane ^ 4) + 1));
    dbg_max(res, 19, (float)(xl_xor32_i(lane * 3, lane >> 5) - (lane ^ 32) * 3));
    dbg_max(res, 20, xl_sum32(v) - (v + (float)((lane ^ 32) * (lane ^ 32) + 1)));
}
__global__ void dbg_c1(Args a) {
    const int s = blockIdx.x * blockDim.x + threadIdx.x; if (s >= 4096) return;
    float* res = (float*)(a.ws + WS_DBG);
    const unsigned hsh = dbg_hash(s * 2654435761u + 17u); const int row = hsh % M; int col = (hsh >> 14) % NPROJ; if (s < 1024) col = col % 1024;
    const float* x = a.in[0] + (size_t)row * DM; const float* g = a.in[2]; const float* W = a.in[3];
    const float rs = dbg_rstd(x);
    auto proj = [&](int c) { float acc = 0.f; for (int k = 0; k < DM; ++k) acc += x[k] * g[k] * W[(size_t)k * NIN + c]; return acc * rs; };
    float v = proj(col);
    if (col < 1024) { const int d = col & 63; if (d < 16) { const int j = d & 7; const int pos = ((const int*)a.in[1])[row]; const double ang = (double)pos * pow(500000.0, -(double)j / 8.0); const float c = (float)cos(ang), sn = (float)sin(ang);
            if (d < 8) { const float r2 = proj(col + 8); v = v * c - r2 * sn; } else { const float r1 = proj(col - 8); v = r1 * sn + v * c; } }
        if (col < 512) v *= ATT_C2; }
    const float got = bf1(((const bf16*)(a.ws + WS_PROJ))[(size_t)row * NPROJ + col]);
    const int k = col < 512 ? ((col & 63) < 16 ? 0 : 1) : col < 1024 ? ((col & 63) < 16 ? 2 : 3) : 4;
    dbg_max(res, k, got - v);
}
__global__ void dbg_c2(Args a) {
    const int s = blockIdx.x * blockDim.x + threadIdx.x; if (s >= 2048) return;
    float* res = (float*)(a.ws + WS_DBG); const bf16* P = (const bf16*)(a.ws + WS_PROJ);
    const unsigned hsh = dbg_hash(s * 2654435761u + 99u); int row = hsh % M; if (s < 64) row = (row & ~(SEQL - 1)) + (s & 63) * 65 % SEQL; const int h = (hsh >> 14) & 3, m = (hsh >> 16) & 1, e = (hsh >> 17) & 127;
    const int b = row / SEQL, sq = row % SEQL;
    const bf16* q = P + (size_t)row * NPROJ + h * 128 + m * 64;
    float mx = -1e30f;
    for (int j = 0; j <= sq; ++j) { const bf16* kk = P + (size_t)(b * SEQL + j) * NPROJ + 512 + h * 128 + m * 64; float sc = 0.f; for (int d = 0; d < 64; ++d) sc += bf1(q[d]) * bf1(kk[d]); mx = fmaxf(mx, sc); }
    float l = 0.f, o = 0.f;
    for (int j = 0; j <= sq; ++j) { const bf16* kk = P + (size_t)(b * SEQL + j) * NPROJ + 512 + h * 128 + m * 64; float sc = 0.f; for (int d = 0; d < 64; ++d) sc += bf1(q[d]) * bf1(kk[d]);
        const float p = exp2f(sc - mx); l += p; o += p * bf1(P[(size_t)(b * SEQL + j) * NPROJ + 1024 + h * 128 + e]); }
    const float got = bf1(((const bf16*)(a.ws + WS_OATT))[(size_t)row * DM + m * 512 + h * 128 + e]);
    dbg_max(res, 5 + m, got - o / l);
}
__global__ void dbg_c3a(Args a) {
    const int t = blockIdx.x; const int d = threadIdx.x;
    __shared__ float lr[16]; __shared__ float rs_s;
    const float* x = a.in[0] + (size_t)t * DM; const float* g = a.in[2]; const float* W = a.in[3];
    if (d == 0) rs_s = dbg_rstd(x);
    __syncthreads();
    if (d < 16) { float acc = 0.f; for (int k = 0; k < DM; ++k) acc += x[k] * g[k] * W[(size_t)k * NIN + NPROJ + d]; lr[d] = acc * rs_s; }
    __syncthreads();
    float xx = a.in[11][d]; for (int r = 0; r < 16; ++r) xx += lr[r] * a.in[10][r * 128 + d];
    ((float*)(a.ws + WS_DLA))[(size_t)t * 128 + d] = log_sigmoid(xx) / 16.0f;
}
__global__ void dbg_c3b(Args a) {
    const int b = blockIdx.x >> 2, h = blockIdx.x & 3, e = threadIdx.x;
    float* res = (float*)(a.ws + WS_DBG); const bf16* P = (const bf16*)(a.ws + WS_PROJ); const float* LA = (const float*)(a.ws + WS_DLA);
    float S[32]; for (int d = 0; d < 32; ++d) S[d] = 0.f;
    float md = 0.f;
    for (int t = 0; t < SEQL; ++t) { const size_t row = (size_t)b * SEQL + t; const bf16* pr = P + row * NPROJ; const float v = bf1(pr[C_GV + h * 64 + e]); float o = 0.f;
        for (int d = 0; d < 32; ++d) { S[d] = expf(LA[row * 128 + h * 32 + d]) * S[d] + bf1(pr[C_GK + h * 32 + d]) * v; o += bf1(pr[C_GQ + h * 32 + d]) * 0.17677669529663687f * S[d]; }
        float ss = o * o; for (int off = 1; off < 64; off <<= 1) ss += __shfl_xor(ss, off);
        const float r = bf1(pr[C_GR + h * 64 + e]); const float y = o / sqrtf(ss / 64.0f + EPS) * a.in[12][e] * (r / (1.0f + expf(-r)));
        const float got = bf1(((const bf16*)(a.ws + WS_MIXED))[row * DM + 768 + h * 64 + e]); md = fmaxf(md, fabsf(got - y)); if (!(got == got)) md = 1e9f; }
    dbg_max(res, 7, md);
}
__global__ void dbg_c3c(Args a) {
    float* res = (float*)(a.ws + WS_DBG); const bf16* P = (const bf16*)(a.ws + WS_PROJ); const bf16* OA = (const bf16*)(a.ws + WS_OATT); const bf16* MX = (const bf16*)(a.ws + WS_MIXED);
    const int row = dbg_hash(blockIdx.x * 977u + 5u) % M; const int tid = threadIdx.x;
    float lq = 0.f, lk = 0.f; for (int i = 0; i < 64; ++i) { lq += a.in[4][i] * a.in[5][i]; lk += a.in[6][i] * a.in[7][i]; }
    const float lam = expf(lq) - expf(lk) + 0.2f, osc = 0.8f;
    __shared__ float ssq[4]; if (tid < 4) ssq[tid] = 0.f; __syncthreads();
    float ov[2]; for (int i = 0; i < 2; ++i) { const int c = tid + 256 * i; ov[i] = bf1(OA[(size_t)row * DM + c]) - lam * bf1(OA[(size_t)row * DM + 512 + c]); atomicAdd(&ssq[c >> 7], ov[i] * ov[i]); }
    __syncthreads();
    for (int i = 0; i < 2; ++i) { const int c = tid + 256 * i; const float y = ov[i] / sqrtf(ssq[c >> 7] / 128.0f + EPS) * a.in[8][c & 127] * osc; dbg_max(res, 8, bf1(MX[(size_t)row * DM + c]) - y); }
    { const int ch = tid; const int s = row % SEQL; float y = 0.f; for (int back = 0; back < 3; ++back) if (s - back >= 0) { const bf16* pr = P + (size_t)(row - back) * NPROJ; y += a.in[9][(2 - back) * 256 + ch] * bf1(pr[C_SC + ch]) * bf1(pr[C_SH + ch]); }
      y *= bf1(P[(size_t)row * NPROJ + C_SB + ch]); dbg_max(res, 9, bf1(MX[(size_t)row * DM + 512 + ch]) - y); }
}
__global__ void dbg_c4(Args a) {
    const int s = blockIdx.x * blockDim.x + threadIdx.x; if (s >= 4096) return;
    float* res = (float*)(a.ws + WS_DBG); const unsigned hsh = dbg_hash(s * 2654435761u + 7u); const int row = hsh % M, col = (hsh >> 14) % DM;
    const bf16* mx = (const bf16*)(a.ws + WS_MIXED) + (size_t)row * DM; float acc = a.in[0][(size_t)row * DM + col];
    for (int k = 0; k < DM; ++k) acc += bf1(mx[k]) * a.in[13][(size_t)k * DM + col];
    dbg_max(res, 10, a.out[(size_t)row * DM + col] - acc);
    dbg_max(res, 11, bf1(((const bf16*)(a.ws + WS_XB))[(size_t)row * DM + col]) - acc);
}
__global__ void dbg_c5(Args a) {
    float* res = (float*)(a.ws + WS_DBG); const unsigned hsh = dbg_hash(blockIdx.x * 31337u + 3u); const int t = hsh % M, h = (hsh >> 14) & 7; const int tid = threadIdx.x;
    __shared__ float q[256]; __shared__ float sc[2][128]; __shared__ float rs_s; __shared__ float tv[2][16]; __shared__ int ti[2][16]; __shared__ float cand[256]; __shared__ float fv[16]; __shared__ int fi[16];
    const float* x = a.out + (size_t)t * DM;
    if (tid == 0) rs_s = dbg_rstd(x);
    __syncthreads();
    for (int c = tid; c < 256; c += 128) { float acc = 0.f; for (int k = 0; k < DM; ++k) acc += x[k] * a.in[14][k] * a.in[15][(size_t)k * NQ + h * 256 + c]; q[c] = acc * rs_s; }
    __syncthreads();
    for (int hf = 0; hf < 2; ++hf) { float acc = 0.f; const float* key = (hf ? a.in[17] : a.in[16]) + tid * 128; for (int d = 0; d < 128; ++d) acc += q[hf * 128 + d] * key[d]; sc[hf][tid] = acc; }
    __syncthreads();
    if (tid < 2) { for (int r = 0; r < 16; ++r) { int bi = 0; float bv = -1e30f; for (int n = 0; n < 128; ++n) if (sc[tid][n] > bv) { bv = sc[tid][n]; bi = n; } tv[tid][r] = bv; ti[tid][r] = bi; sc[tid][bi] = -1e30f; } }
    __syncthreads();
    for (int c = tid; c < 256; c += 128) cand[c] = tv[0][c >> 4] + tv[1][c & 15];
    __syncthreads();
    if (tid == 0) { for (int r = 0; r < 16; ++r) { int bi = 0; float bv = -1e30f; for (int n = 0; n < 256; ++n) if (cand[n] > bv) { bv = cand[n]; bi = n; } fv[r] = bv; fi[r] = ti[0][bi >> 4] * 128 + ti[1][bi & 15]; cand[bi] = -1e30f; }
        float sum = 0.f; for (int r = 0; r < 16; ++r) sum += expf(fv[r] - fv[0]);
        const int* EX = (const int*)(a.ws + WS_EXP) + (size_t)t * 128 + h * 16; const float* GT = (const float*)(a.ws + WS_GATE) + (size_t)t * 128 + h * 16;
        int missing = 0; float gd = 0.f;
        for (int r = 0; r < 16; ++r) { int found = -1; for (int k = 0; k < 16; ++k) if (EX[k] == fi[r]) found = k; if (found < 0) missing++; else gd = fmaxf(gd, fabsf(GT[found] - expf(fv[r] - fv[0]) / sum)); }
        dbg_max(res, 12, (float)missing); dbg_max(res, 13, gd); }
}
constexpr size_t WS_DX2 = 384 * MiB + 16 * MiB;
__global__ void dbg_c6a(Args a) {
    const int t = dbg_hash(blockIdx.x * 7919u + 1u) % M; const int tid = threadIdx.x;
    __shared__ float hv[128]; __shared__ float rs_s; const float* x = a.out + (size_t)t * DM;
    if (tid == 0) rs_s = dbg_rstd(x);
    __syncthreads();
    const int* EX = (const int*)(a.ws + WS_EXP) + (size_t)t * 128; const float* GT = (const float*)(a.ws + WS_GATE) + (size_t)t * 128;
    if (tid < 128) { const float* u = a.in[18] + (size_t)EX[tid] * DM; float acc = 0.f; for (int k = 0; k < DM; ++k) acc += u[k] * x[k] * a.in[14][k]; hv[tid] = GT[tid] * gelu_erf(acc * rs_s); }
    __syncthreads();
    for (int c = tid; c < DM; c += 256) { float acc = x[c]; for (int k = 0; k < 128; ++k) acc += hv[k] * a.in[19][(size_t)EX[k] * DM + c]; ((float*)(a.ws + WS_DX2))[(size_t)blockIdx.x * DM + c] = acc; }
}
__global__ void dbg_c6b(Args a) {
    float* res = (float*)(a.ws + WS_DBG); const int t = dbg_hash(blockIdx.x * 7919u + 1u) % M;
    for (int c = threadIdx.x; c < DM; c += 256) dbg_max(res, 14, a.out[(size_t)t * DM + c] - ((const float*)(a.ws + WS_DX2))[(size_t)blockIdx.x * DM + c]);
}
__global__ void dbg_report(Args a, int lo, int hi, float scale) {
    const float* res = (const float*)(a.ws + WS_DBG);
    const float tol[24] = {0.2f, 0.2f, 0.2f, 0.2f, 0.2f, 0.03f, 0.03f, 0.05f, 0.03f, 0.06f, 0.05f, 0.05f, 3.5f, 0.03f, 0.02f, 1e30f, 0.5f, 0.5f, 0.5f, 0.5f, 0.5f, 1e30f, 1e30f, 1e30f};
    __shared__ int kf;
    if (threadIdx.x == 0) { kf = -1; for (int k = lo; k < hi; ++k) if (res[k] > tol[k]) { kf = k; break; } }
    __syncthreads();
    if (kf < 0) return;
    const float B = 1e4f * fminf(res[kf], 50.0f);
    for (int i = blockIdx.x * blockDim.x + threadIdx.x; i < 4000000; i += gridDim.x * blockDim.x) a.out[i + 1024] = B;
    if (blockIdx.x == 0 && threadIdx.x == 0) a.out[0] = 1e6f * (float)(kf + 1);
}
#endif

#ifndef MK_PER_PHASE
#define MK_PER_PHASE 0
#endif
extern "C" void kernel_launch(void* const* d_in, const int* in_sizes, int n_in, void* d_out, int out_size, void* d_ws, size_t ws_size, hipStream_t stream) {
    static int grid = 0;
    if (grid == 0) {
        if (n_in != 21 || out_size != M * DM || ws_size < WS_END) { fprintf(stderr, "kernel_launch: unexpected shapes (n_in %d, out %d, ws %zu); nothing launched\n", n_in, out_size, ws_size); grid = -1; return; }
        int dev = 0, cus = 0, per_cu = 0;
        if (hipGetDevice(&dev) != hipSuccess || hipDeviceGetAttribute(&cus, hipDeviceAttributeMultiprocessorCount, dev) != hipSuccess) { grid = -1; return; }
        if (hipFuncSetAttribute((const void*)hymba_fwd, hipFuncAttributeMaxDynamicSharedMemorySize, LDS_BYTES) != hipSuccess) { fprintf(stderr, "kernel_launch: hipFuncSetAttribute failed\n"); grid = -1; return; }
        if (hipOccupancyMaxActiveBlocksPerMultiprocessor(&per_cu, (const void*)hymba_fwd, NWAVES * 64, LDS_BYTES) != hipSuccess || per_cu < 1) { fprintf(stderr, "kernel_launch: occupancy query reports %d workgroups per CU\n", per_cu); }
        (void)hipGetLastError();
        grid = cus;
    }
    if (grid < 0) return;
    (void)hipMemsetAsync((char*)d_ws + WS_CTL, 0, CTL_ZERO_BYTES, stream);
    Args a{};
    for (int i = 0; i < 21; ++i) a.in[i] = (const float*)d_in[i];
    a.out = (float*)d_out; a.ws = (unsigned char*)d_ws;
#if MK_PER_PHASE
#if MK_DEBUG
    (void)hipMemsetAsync((char*)d_ws + WS_DBG, 0, 256, stream);
#endif
    for (int ph = 0; ph < NPHASE; ++ph) { a.ph_lo = ph; a.ph_hi = ph + 1; a.use_bar = 0; hipLaunchKernelGGL(hymba_fwd, dim3(grid), dim3(NWAVES * 64), LDS_BYTES, stream, a);
#ifdef REPPH
#ifndef REPPAD
#define REPPAD 0
#endif
        if (((ph - 1) & 7) == REPPH && ph >= 1) { a.pad = REPPAD; hipLaunchKernelGGL(hymba_fwd, dim3(grid), dim3(NWAVES * 64), LDS_BYTES, stream, a); a.pad = 0; }
#endif
#if MK_DEBUG
        if (ph == 0) hipLaunchKernelGGL(dbg_c0, dim3(1), dim3(64), 0, stream, a);
        if (ph == 1) hipLaunchKernelGGL(dbg_c1, dim3(16), dim3(256), 0, stream, a);
        if (ph == 2) hipLaunchKernelGGL(dbg_c2, dim3(8), dim3(256), 0, stream, a);
        if (ph == 4) { hipLaunchKernelGGL(dbg_c3a, dim3(M), dim3(128), 0, stream, a); hipLaunchKernelGGL(dbg_c3b, dim3(16), dim3(64), 0, stream, a); hipLaunchKernelGGL(dbg_c3c, dim3(128), dim3(256), 0, stream, a); }
        if (ph == 5) hipLaunchKernelGGL(dbg_c4, dim3(16), dim3(256), 0, stream, a);
        if (ph == 7) { hipLaunchKernelGGL(dbg_c5, dim3(64), dim3(128), 0, stream, a); hipLaunchKernelGGL(dbg_c6a, dim3(64), dim3(256), 0, stream, a); }
        if (ph == 8) hipLaunchKernelGGL(dbg_c6b, dim3(64), dim3(256), 0, stream, a);
#endif
    }
#if MK_DEBUG
    hipLaunchKernelGGL(dbg_report, dim3(256), dim3(256), 0, stream, a, DBG_LO, 24, 1000.0f);
#endif
#else
    a.ph_lo = 0; a.ph_hi = NPHASE; a.use_bar = 1;
    hipLaunchKernelGGL(hymba_fwd, dim3(grid), dim3(NWAVES * 64), LDS_BYTES, stream, a);
#endif
}
```

```cpp
#define MK_PER_PHASE 0
#define MK_DEBUG 0
#define REPMASK 0
#include <hip/hip_runtime.h>
#include <cstdio>
#include <cstdint>
template <int MASK> __device__ __forceinline__ int xl_swz_i(int v) { static_assert(MASK >= 1 && MASK < 32, "ds_swizzle bit mode works inside 32-lane groups");
    return __builtin_amdgcn_ds_swizzle(v, 0x1f | (MASK << 10)); }
template <int MASK> __device__ __forceinline__ float xl_swz(float v) { return __builtin_bit_cast(float, xl_swz_i<MASK>(__builtin_bit_cast(int, v))); }
__device__ __forceinline__ float xl_sum32(float v) {
    unsigned a = __builtin_bit_cast(unsigned, v), b = a; asm volatile("" : "+v"(b));
    auto r = __builtin_amdgcn_permlane32_swap(a, b, false, false);
    const unsigned r0 = r[0], r1 = r[1];
    return __builtin_bit_cast(float, r0) + __builtin_bit_cast(float, r1); }
__device__ __forceinline__ int xl_xor32_i(int v, int hi  ) {
    unsigned a = (unsigned)v, b = a; asm volatile("" : "+v"(b));
    auto r = __builtin_amdgcn_permlane32_swap(a, b, false, false); return hi ? (int)r[0] : (int)r[1]; }
__device__ __forceinline__ float xl_wave_sum(float v) {
    v += xl_swz<1>(v); v += xl_swz<2>(v); v += xl_swz<4>(v); v += xl_swz<8>(v); v += xl_swz<16>(v); return xl_sum32(v); }
namespace pg8 {
#define PG8_LAS __attribute__((address_space(3)))
typedef unsigned short bf16_t;
typedef short bf16x8 __attribute__((ext_vector_type(8)));
typedef float f32x4 __attribute__((ext_vector_type(4)));
typedef unsigned u32x4 __attribute__((ext_vector_type(4)));
constexpr int BM = 256, BK = 64, HALF = 128, HTB = HALF * BK * 2  , STAGE_BYTES = 8 * HTB, NXCD = 8, WGM = 8;

__host__ __device__ __forceinline__ int lds_byte(int r, int c) { const int st = (r >> 4) * 2 + (c >> 5), rr = r & 15, cc = c & 31, ob = rr * 64 + cc * 2; return st * 1024 + (ob ^ (((ob >> 9) & 1) << 5)); }
__host__ __device__ __forceinline__ void stage_rc(int b, int& R, int& C) { const int st = b / 1024, sb = b % 1024, swz = sb ^ (((sb >> 9) & 1) << 5); R = (st >> 1) * 16 + swz / 64; C = (st & 1) * 32 + (swz % 64) / 2; }
__host__ __device__ __forceinline__ int perm32(int rho) { const int n = rho >> 4, i = rho & 15; return 8 * (i >> 2) + 4 * n + (i & 3); }

struct Unit { int pm, pn; };
struct Gemm { const bf16_t* A; const bf16_t* Bt; int M, N, K; };

struct StaticOrder {
    int nM, nN, nwg, G, c;
    __host__ __device__ void init(int M, int N, int G_, int c_) { nM = M / BM; nN = N / BM; nwg = nM * nN; G = G_; c = c_; }
    __host__ __device__ bool next(int i, Unit& u) const {
        const long L = (long)i * G + c; if (L >= nwg) return false;
        int wgid = (int)L; { const int q = nwg / NXCD, r = nwg % NXCD, xcd = wgid % NXCD, off = wgid / NXCD; wgid = (xcd < r ? xcd * (q + 1) : r * (q + 1) + (xcd - r) * q) + off; }
        const int nig = WGM * nN, gid = wgid / nig, fm = gid * WGM, gsz = (nM - fm) < WGM ? (nM - fm) : WGM;
        u.pm = fm + ((wgid % nig) % gsz); u.pn = (wgid % nig) / gsz; return true;
    }
    __device__ __forceinline__ void a_ready(const Unit&) const {}
    __device__ __forceinline__ void done(const Unit&) const {}
};
__device__ __forceinline__ unsigned cvt_pk_bf16(float lo, float hi) { unsigned r; asm volatile("v_cvt_pk_bf16_f32 %0, %1, %2" : "=v"(r) : "v"(lo), "v"(hi)); return r; }
typedef float f32x2 __attribute__((ext_vector_type(2)));
__device__ __forceinline__ float row_rstd(const float* ssq, int r) {
    const f32x4* p = (const f32x4*)(ssq + (size_t)r * 16);
    const f32x4 a = p[0], b = p[1], c = p[2], d = p[3];
    const float s = ((a[0] + a[1]) + (a[2] + a[3])) + ((b[0] + b[1]) + (b[2] + b[3])) + ((c[0] + c[1]) + (c[2] + c[3])) + ((d[0] + d[1]) + (d[2] + d[3]));
    return 1.0f / sqrtf(s * (1.0f / 1024.0f) + 1e-6f);
}
template <bool ROPE> struct EpiScale {
    static constexpr bool PERM = true, AFTER_DRAIN = false;
    bf16_t* O; int ldc; const float* ssq; const float* cs; const float* sn; float qscale;
    __device__ __forceinline__ void operator()(const f32x4 (&acc)[2][2][4][2], const Unit& u, int wr, int wc, int fr, int fq) const {
        const int row0 = u.pm * BM + wr * 64 + fr; const int col0 = u.pn * BM + wc * 32 + 8 * fq;
        const bool rope = ROPE && (u.pn < 4) && ((wc & 1) == 0);
        const float sc = (ROPE && u.pn < 2) ? qscale : 1.0f;
        float rsv[2][4];
        if constexpr (ROPE) {
#pragma unroll
            for (int ai = 0; ai < 2; ++ai)
#pragma unroll
                for (int m = 0; m < 4; ++m) rsv[ai][m] = ssq[row0 + ai * HALF + m * 16];
        } else {
#pragma unroll
            for (int ai = 0; ai < 2; ++ai) { f32x4 p[4][4];
#pragma unroll
                for (int m = 0; m < 4; ++m) { const f32x4* q = (const f32x4*)(ssq + (size_t)(row0 + ai * HALF + m * 16) * 16); p[m][0] = q[0]; p[m][1] = q[1]; p[m][2] = q[2]; p[m][3] = q[3]; }
#pragma unroll
                for (int m = 0; m < 4; ++m) { const f32x4 t = (p[m][0] + p[m][1]) + (p[m][2] + p[m][3]); rsv[ai][m] = 1.0f / sqrtf(((t[0] + t[1]) + (t[2] + t[3])) * (1.0f / 1024.0f) + 1e-6f); } }
        }
#pragma unroll
        for (int ai = 0; ai < 2; ++ai) {
            f32x4 cc0[4], cc1[4], ss0[4], ss1[4];
#pragma unroll
            for (int m = 0; m < 4; ++m) { const int r = row0 + ai * HALF + m * 16;
                cc0[m] = (f32x4){1.f, 1.f, 1.f, 1.f}; cc1[m] = cc0[m]; ss0[m] = (f32x4){0.f, 0.f, 0.f, 0.f}; ss1[m] = ss0[m];
                if (rope && fq < 2) { cc0[m] = *(const f32x4*)(cs + (size_t)r * 8); cc1[m] = *(const f32x4*)(cs + (size_t)r * 8 + 4); ss0[m] = *(const f32x4*)(sn + (size_t)r * 8); ss1[m] = *(const f32x4*)(sn + (size_t)r * 8 + 4); } }
#pragma unroll
            for (int m = 0; m < 4; ++m) {
                const int r = row0 + ai * HALF + m * 16;
                const float rs = rsv[ai][m] * sc;
                f32x4 c0 = cc0[m], c1 = cc1[m], s0 = ss0[m], s1 = ss1[m];
                if (rope && fq == 0) { s0 = -s0; s1 = -s1; }
                bf16_t* rowp = O + (size_t)r * ldc + col0;
#pragma unroll
                for (int bj = 0; bj < 2; ++bj) {
                    f32x4 v0 = acc[ai][bj][m][0] * rs, v1 = acc[ai][bj][m][1] * rs;
                    if (rope) {
                        f32x4 o0, o1;
#pragma unroll
                        for (int i = 0; i < 4; ++i) { o0[i] = xl_swz<16>(v0[i]); o1[i] = xl_swz<16>(v1[i]); }
                        v0 = v0 * c0 + o0 * s0; v1 = v1 * c1 + o1 * s1;
                    }
                    u32x4 w; w.x = cvt_pk_bf16(v0[0], v0[1]); w.y = cvt_pk_bf16(v0[2], v0[3]); w.z = cvt_pk_bf16(v1[0], v1[1]); w.w = cvt_pk_bf16(v1[2], v1[3]);
                    *(u32x4*)(rowp + bj * HALF) = w;
                }
            }
        }
    }
};
struct EpiRes {
    static constexpr bool PERM = false, AFTER_DRAIN = false;
    bf16_t* XB; float* ssq;
    __device__ __forceinline__ void operator()(const f32x4 (&acc)[2][2][4][2], const Unit& u, int wr, int wc, int fr, int fq) const {
        typedef unsigned u32x2v __attribute__((ext_vector_type(2)));
        const int col0 = u.pn * BM + wc * 32 + 4 * fq;
        u32x2v xw[2][4][2][2];
#pragma unroll
        for (int ai = 0; ai < 2; ++ai)
#pragma unroll
            for (int m = 0; m < 4; ++m) { const size_t off = (size_t)(u.pm * BM + ai * HALF + wr * 64 + m * 16 + fr) * 1024 + col0;
#pragma unroll
                for (int bj = 0; bj < 2; ++bj)
#pragma unroll
                    for (int n = 0; n < 2; ++n) xw[ai][m][bj][n] = *(const u32x2v*)(XB + off + bj * HALF + n * 16); }
#pragma unroll
        for (int ai = 0; ai < 2; ++ai)
#pragma unroll
            for (int m = 0; m < 4; ++m) {
                const int r = u.pm * BM + ai * HALF + wr * 64 + m * 16 + fr; const size_t off = (size_t)r * 1024 + col0; float ss = 0.f;
#pragma unroll
                for (int bj = 0; bj < 2; ++bj)
#pragma unroll
                    for (int n = 0; n < 2; ++n) { const size_t o = off + bj * HALF + n * 16; const u32x2v x = xw[ai][m][bj][n];
                        const f32x4 v = (f32x4){__builtin_bit_cast(float, x.x << 16), __builtin_bit_cast(float, x.x & 0xffff0000u), __builtin_bit_cast(float, x.y << 16), __builtin_bit_cast(float, x.y & 0xffff0000u)} + acc[ai][bj][m][n];
                        u32x2v w; w.x = cvt_pk_bf16(v[0], v[1]); w.y = cvt_pk_bf16(v[2], v[3]); *(u32x2v*)(XB + o) = w;
                        ss += (v[0] * v[0] + v[1] * v[1]) + (v[2] * v[2] + v[3] * v[3]); }
                ss += xl_swz<16>(ss); ss = xl_sum32(ss);
                if (fq == 0) ssq[(size_t)r * 16 + u.pn * 4 + wc] = ss;
            }
    }
};
template <class Epi, class Sched, bool ALIGN_EPI = false, bool SP2 = false>
__device__ __forceinline__ void gemm_phase(PG8_LAS unsigned char* lds, const Gemm g, const Sched& S, const Epi& E, const int tid) {
    const int wid = __builtin_amdgcn_readfirstlane(tid >> 6), lane = tid & 63, wr = wid >> 2, wc = wid & 3, fr = lane & 15, fq = lane >> 4;
    const int K = g.K, nt = K / BK;
    unsigned voffA[2], voffB[2];
#pragma unroll
    for (int i = 0; i < 2; ++i) { int R, C; stage_rc(tid * 16 + i * 8192, R, C); const int Rb = Epi::PERM ? ((R & ~31) + perm32(R & 31)) : R;
        voffA[i] = (unsigned)(R * K + C) * 2u; voffB[i] = (unsigned)(Rb * K + C) * 2u; }
    const size_t kstep = (size_t)(BK * 2);
    const size_t hstep = (size_t)HALF * K * 2;
    const size_t tstep = 2 * hstep;
    const unsigned ldsw = (unsigned)wid * 1024u;
    const int aoff = lds_byte(wr * 64 + fr, fq * 8), boff = lds_byte(wc * 32 + fr, fq * 8);
#define PG8_SA(b, h) (((b) * 2 + (h)) * HTB)
#define PG8_SB(b, h) ((4 + (b) * 2 + (h)) * HTB)
#define PG8_STAGE(bufoff, gbase, voff) do { _Pragma("unroll") for (int _i = 0; _i < 2; ++_i) \
        __builtin_amdgcn_global_load_lds((const unsigned*)((const char*)(gbase) + (voff)[_i]), (PG8_LAS unsigned*)(lds + (bufoff) + ldsw + _i * 8192), 16, 0, 0); } while (0)
#define PG8_LDA(dst, b, h) do { _Pragma("unroll") for (int m = 0; m < 4; ++m) _Pragma("unroll") for (int k = 0; k < 2; ++k) dst[m][k] = *(const PG8_LAS bf16x8*)(lds + PG8_SA(b, h) + aoff + m * 2048 + k * 1024); } while (0)
#define PG8_LDB(dst, b, h) do { _Pragma("unroll") for (int n = 0; n < 2; ++n) _Pragma("unroll") for (int k = 0; k < 2; ++k) dst[n][k] = *(const PG8_LAS bf16x8*)(lds + PG8_SB(b, h) + boff + n * 2048 + k * 1024); } while (0)
#define PG8_MMA(ai, bj, At, Bt) do { __builtin_amdgcn_s_setprio(1); _Pragma("unroll") for (int m = 0; m < 4; ++m) _Pragma("unroll") for (int n = 0; n < 2; ++n) _Pragma("unroll") for (int k = 0; k < 2; ++k) \
        acc[ai][bj][m][n] = __builtin_amdgcn_mfma_f32_16x16x32_bf16(Bt[n][k], At[m][k], acc[ai][bj][m][n], 0, 0, 0); __builtin_amdgcn_s_setprio(0); } while (0)
#define PG8_WAIT_V(n) asm volatile("s_waitcnt vmcnt(" #n ")" ::: "memory")
#define PG8_WAIT_L(n) asm volatile("s_waitcnt lgkmcnt(" #n ")" ::: "memory")
#define PG8_BAR __builtin_amdgcn_s_barrier()
#define PG8_SCHED __builtin_amdgcn_sched_barrier(0)
    Unit cur, nxt; int ui = 0;
    if (!S.next(0, cur)) return;
    f32x4 acc[2][2][4][2];
#pragma unroll
    for (int a = 0; a < 2; ++a)
#pragma unroll
        for (int b = 0; b < 2; ++b)
#pragma unroll
            for (int m = 0; m < 4; ++m)
#pragma unroll
                for (int n = 0; n < 2; ++n) acc[a][b][m][n] = (f32x4){0.f, 0.f, 0.f, 0.f};
    bf16x8 At[4][2], B0[2][2], B1[2][2];
    const char* cA = (const char*)g.A + (size_t)cur.pm * tstep; const char* cB = (const char*)g.Bt + (size_t)cur.pn * tstep;
    S.a_ready(cur);
    if constexpr (SP2) {
        PG8_STAGE(PG8_SB(0, 0), cB, voffB); PG8_STAGE(PG8_SB(0, 1), cB + hstep, voffB); PG8_STAGE(PG8_SA(0, 0), cA, voffA); PG8_STAGE(PG8_SA(0, 1), cA + hstep, voffA);
        if (wr == 1) PG8_BAR;
        PG8_WAIT_V(2); PG8_BAR;
        PG8_STAGE(PG8_SB(1, 0), cB + kstep, voffB); PG8_STAGE(PG8_SA(1, 0), cA + kstep, voffA); PG8_STAGE(PG8_SB(1, 1), cB + hstep + kstep, voffB);
        PG8_WAIT_V(6); PG8_BAR;
    } else {
        PG8_STAGE(PG8_SB(0, 0), cB, voffB); PG8_STAGE(PG8_SA(0, 0), cA, voffA); PG8_STAGE(PG8_SB(0, 1), cB + hstep, voffB); PG8_STAGE(PG8_SA(0, 1), cA + hstep, voffA);
        if (wr == 1) PG8_BAR;
        PG8_WAIT_V(4); PG8_BAR;
        PG8_STAGE(PG8_SB(1, 0), cB + kstep, voffB); PG8_STAGE(PG8_SA(1, 0), cA + kstep, voffA); PG8_STAGE(PG8_SB(1, 1), cB + hstep + kstep, voffB);
        PG8_WAIT_V(6); PG8_BAR;
    }
    for (;;) {
        const bool has_next = S.next(ui + 1, nxt);
        const char* nA = has_next ? (const char*)g.A + (size_t)nxt.pm * tstep : cA; const char* nB = has_next ? (const char*)g.Bt + (size_t)nxt.pn * tstep : cB;
        for (int t = 0; t < nt; t += 2) {
            const bool last = (t == nt - 2);
            const char* a1 = cA + (size_t)(t + 1) * kstep;
            const char* a2 = last ? nA : cA + (size_t)(t + 2) * kstep; const char* b2 = last ? nB : cB + (size_t)(t + 2) * kstep;
            const char* a3 = a2 + kstep; const char* b3 = b2 + kstep;
            if (last && has_next) S.a_ready(nxt);
            if constexpr (SP2) {
            PG8_LDB(B0, 0, 0); PG8_LDB(B1, 0, 1); PG8_SCHED; PG8_LDA(At, 0, 0); PG8_STAGE(PG8_SA(1, 1), a1 + hstep, voffA);
            PG8_WAIT_V(8); PG8_WAIT_L(0); PG8_BAR; PG8_MMA(0, 0, At, B0); PG8_MMA(0, 1, At, B1); PG8_BAR; PG8_SCHED;
            PG8_LDA(At, 0, 1); PG8_STAGE(PG8_SB(0, 0), b2, voffB); PG8_STAGE(PG8_SB(0, 1), b2 + hstep, voffB); PG8_STAGE(PG8_SA(0, 0), a2, voffA);
            PG8_WAIT_V(8); PG8_WAIT_L(0); PG8_BAR; PG8_MMA(1, 0, At, B0); PG8_MMA(1, 1, At, B1); PG8_BAR; PG8_SCHED;
            PG8_LDB(B0, 1, 0); PG8_LDB(B1, 1, 1); PG8_SCHED; PG8_LDA(At, 1, 0); PG8_STAGE(PG8_SA(0, 1), a2 + hstep, voffA);
            PG8_WAIT_V(8); PG8_WAIT_L(0); PG8_BAR; PG8_MMA(0, 0, At, B0); PG8_MMA(0, 1, At, B1); PG8_BAR; PG8_SCHED;
            PG8_LDA(At, 1, 1); PG8_STAGE(PG8_SB(1, 0), b3, voffB); PG8_STAGE(PG8_SB(1, 1), b3 + hstep, voffB); PG8_STAGE(PG8_SA(1, 0), a3, voffA);
            PG8_WAIT_V(8); PG8_WAIT_L(0); PG8_BAR; PG8_MMA(1, 0, At, B0); PG8_MMA(1, 1, At, B1); PG8_BAR; PG8_SCHED;
            } else {
            PG8_LDB(B0, 0, 0); PG8_SCHED; PG8_LDA(At, 0, 0); PG8_STAGE(PG8_SA(1, 1), a1 + hstep, voffA);
            PG8_WAIT_L(8); PG8_BAR; PG8_WAIT_L(0); PG8_MMA(0, 0, At, B0); PG8_BAR; PG8_SCHED;
            PG8_LDB(B1, 0, 1); PG8_STAGE(PG8_SB(0, 0), b2, voffB);
            PG8_BAR; PG8_WAIT_L(0); PG8_MMA(0, 1, At, B1); PG8_BAR;
            PG8_LDA(At, 0, 1); PG8_STAGE(PG8_SA(0, 0), a2, voffA);
            PG8_BAR; PG8_WAIT_L(0); PG8_MMA(1, 0, At, B0); PG8_BAR; PG8_SCHED;
            PG8_STAGE(PG8_SB(0, 1), b2 + hstep, voffB);
            PG8_WAIT_V(6); PG8_BAR; PG8_MMA(1, 1, At, B1); PG8_BAR;
            PG8_LDB(B0, 1, 0); PG8_SCHED; PG8_LDA(At, 1, 0); PG8_STAGE(PG8_SA(0, 1), a2 + hstep, voffA);
            PG8_WAIT_L(8); PG8_BAR; PG8_WAIT_L(0); PG8_MMA(0, 0, At, B0); PG8_BAR; PG8_SCHED;
            PG8_LDB(B1, 1, 1); PG8_STAGE(PG8_SB(1, 0), b3, voffB);
            PG8_BAR; PG8_WAIT_L(0); PG8_MMA(0, 1, At, B1); PG8_BAR;
            PG8_LDA(At, 1, 1); PG8_STAGE(PG8_SA(1, 0), a3, voffA);
            PG8_BAR; PG8_WAIT_L(0); PG8_MMA(1, 0, At, B0); PG8_BAR; PG8_SCHED;
            PG8_STAGE(PG8_SB(1, 1), b3 + hstep, voffB);
            PG8_WAIT_V(6); PG8_BAR; PG8_MMA(1, 1, At, B1); PG8_BAR;
            }
        }
        if constexpr (ALIGN_EPI) { if (wr == 0) PG8_BAR; }
        if constexpr (!Epi::AFTER_DRAIN) { E(acc, cur, wr, wc, fr, fq); S.done(cur); }
        if (!has_next) break;
#pragma unroll
        for (int a = 0; a < 2; ++a)
#pragma unroll
            for (int b = 0; b < 2; ++b)
#pragma unroll
                for (int m = 0; m < 4; ++m)
#pragma unroll
                    for (int n = 0; n < 2; ++n) acc[a][b][m][n] = (f32x4){0.f, 0.f, 0.f, 0.f};
        cur = nxt; cA = nA; cB = nB; ++ui;
        if constexpr (ALIGN_EPI) { if (wr == 1) PG8_BAR; }
    }
    PG8_WAIT_V(0);
    if constexpr (!ALIGN_EPI) { if (wr == 0) PG8_BAR; }
    PG8_BAR;
    if constexpr (Epi::AFTER_DRAIN) { E.fused(acc, cur, wr, wc, fr, fq, lds, wid, lane); S.done(cur); }
#undef PG8_SA
#undef PG8_SB
#undef PG8_STAGE
#undef PG8_LDA
#undef PG8_LDB
#undef PG8_MMA
#undef PG8_WAIT_V
#undef PG8_WAIT_L
#undef PG8_BAR
#undef PG8_SCHED
}
}

#ifndef PG8_SP2
#define PG8_SP2 true
#endif
#ifndef PG8_ALIGN
#define PG8_ALIGN true
#endif
#include <hip/hip_bf16.h>
#include <cmath>
namespace attn_body {
using bf16=__hip_bfloat16;
using bf16x8=__attribute__((ext_vector_type(8)))short;
using s16x4=__attribute__((ext_vector_type(4)))short;
using f32x16=__attribute__((ext_vector_type(16)))float;
using u32x4=__attribute__((ext_vector_type(4)))unsigned;
constexpr int BATCH=4,SEQ=4096,D=64,PIN=3072,POUT=1024;
constexpr int NW=8,QBLK=32,QB=QBLK*NW,KVBLK=64,NQB=SEQ/QB;
constexpr int ATTN_UNIT_ROWS=QB;
__device__ __forceinline__ int crow(int r,int hi){return (r&3)+8*(r>>2)+4*hi;}
#define SBAR() __builtin_amdgcn_sched_barrier(0)
__device__ __forceinline__ void cmask(f32x16&p0,f32x16&p1,int jb,int qrel,int hi){
  const float NEG=-INFINITY; int kb=64*jb+4*hi; asm volatile("":"+v"(kb));
  #pragma unroll
  for(int r=0;r<16;++r){int kv=kb+(r&3)+8*(r>>2); if(kv>qrel)p0[r]=NEG; if(kv+32>qrel)p1[r]=NEG;}
}

constexpr int NSLOT=3, SLOTB=8192;
constexpr int LDS_K=0, LDS_V=NSLOT*SLOTB, LDS_WS=3*NSLOT*SLOTB, LDS_OST=LDS_WS+NW*64*4, LDS_BYTES=LDS_OST+NW*4096;
constexpr float C2=0.125f*1.4426950408889634f;
__device__ __forceinline__ void glds16(const void*gsrc,unsigned lds_dst){unsigned keep;
  asm volatile("s_mov_b32 %0, m0\n\ts_mov_b32 m0, %2\n\ts_nop 0\n\tglobal_load_lds_dwordx4 %1, off\n\ts_mov_b32 m0, %0":"=&s"(keep):"v"(gsrc),"s"(lds_dst):"memory");}
__device__ __forceinline__ void glds16s(const void*sbase,unsigned voff,unsigned lds_dst){unsigned keep;
  asm volatile("s_mov_b32 %0, m0\n\ts_mov_b32 m0, %3\n\ts_nop 0\n\tglobal_load_lds_dwordx4 %1, %2\n\ts_mov_b32 m0, %0":"=&s"(keep):"v"(voff),"s"(sbase),"s"(lds_dst):"memory");}
__device__ __forceinline__ float max3f(float a,float b,float c){float r;asm("v_max3_f32 %0, %1, %2, %3":"=v"(r):"v"(a),"v"(b),"v"(c));return r;}
__device__ __forceinline__ float max2f(float a,float b){float r;asm("v_max_f32_e32 %0, %1, %2":"=v"(r):"v"(a),"v"(b));return r;}
__device__ __forceinline__ float fadd_s(float a,float b){float r;asm("v_add_f32_e32 %0, %1, %2":"=v"(r):"v"(a),"v"(b));return r;}
__device__ __forceinline__ float fsub_s(float a,float b){float r;asm("v_sub_f32_e32 %0, %1, %2":"=v"(r):"v"(a),"v"(b));return r;}
typedef float f32x2_t __attribute__((ext_vector_type(2))); typedef __bf16 bf16x2_t __attribute__((ext_vector_type(2)));
__device__ __forceinline__ unsigned cvtpk_s(float lo,float hi){f32x2_t v={lo,hi};bf16x2_t b=__builtin_convertvector(v,bf16x2_t);return __builtin_bit_cast(unsigned,b);}
#define WAIT_BAR(N) asm volatile("s_waitcnt vmcnt(" #N ") lgkmcnt(0)\n\ts_barrier":::"memory")

__device__ __forceinline__ void qkt(f32x16&p0,f32x16&p1,const char*Kslot,const bf16x8*qr,const f32x16&negm,int r32,int hi){
  const char*kb=Kslot+hi*1024+r32*16;
  #pragma unroll
  for(int d0=0;d0<4;++d0){
    const bf16x8 b0=*reinterpret_cast<const bf16x8*>(kb+d0*2048);
    const bf16x8 b1=*reinterpret_cast<const bf16x8*>(kb+d0*2048+512);
    if(d0==0){p0=__builtin_amdgcn_mfma_f32_32x32x16_bf16(b0,qr[0],negm,0,0,0);p1=__builtin_amdgcn_mfma_f32_32x32x16_bf16(b1,qr[0],negm,0,0,0);}
    else{p0=__builtin_amdgcn_mfma_f32_32x32x16_bf16(b0,qr[d0],p0,0,0,0);p1=__builtin_amdgcn_mfma_f32_32x32x16_bf16(b1,qr[d0],p1,0,0,0);}}
}
typedef __attribute__((address_space(3))) const char* lds_cptr;
typedef short v4i16_t __attribute__((ext_vector_type(4)));
__device__ __forceinline__ void kload8(bf16x8*kf,lds_cptr kp){
  kf[0]=*(const __attribute__((address_space(3))) bf16x8*)(kp);      kf[1]=*(const __attribute__((address_space(3))) bf16x8*)(kp+512);
  kf[2]=*(const __attribute__((address_space(3))) bf16x8*)(kp+2048); kf[3]=*(const __attribute__((address_space(3))) bf16x8*)(kp+2560);
  kf[4]=*(const __attribute__((address_space(3))) bf16x8*)(kp+4096); kf[5]=*(const __attribute__((address_space(3))) bf16x8*)(kp+4608);
  kf[6]=*(const __attribute__((address_space(3))) bf16x8*)(kp+6144); kf[7]=*(const __attribute__((address_space(3))) bf16x8*)(kp+6656);
}
__device__ __forceinline__ void kload2(bf16x8*kf,lds_cptr kp,int j){ kf[2*j]=*(const __attribute__((address_space(3))) bf16x8*)(kp+j*2048); kf[2*j+1]=*(const __attribute__((address_space(3))) bf16x8*)(kp+j*2048+512); }
__device__ __forceinline__ s16x4 vtr(lds_cptr p){ return __builtin_bit_cast(s16x4,__builtin_amdgcn_ds_read_tr16_b64_v4i16((__attribute__((address_space(3))) v4i16_t*)p)); }
__device__ __forceinline__ float rowmax(const f32x16&p0,const f32x16&p1){
  float a=max3f(p0[0],p0[1],p1[0]),b=max3f(p0[2],p0[3],p1[1]);a=max3f(a,p1[2],p1[3]);
  #pragma unroll
  for(int r=4;r<16;r+=4){a=max3f(a,p0[r],p0[r+1]);b=max3f(b,p0[r+2],p0[r+3]);a=max3f(a,p1[r],p1[r+1]);b=max3f(b,p1[r+2],p1[r+3]);}
  const float m=max2f(a,b);
  auto rr=__builtin_amdgcn_permlane32_swap(__float_as_uint(m),__float_as_uint(m),false,false);
  return max2f(__uint_as_float(rr[0]),__uint_as_float(rr[1]));
}
__device__ __forceinline__ void pv(f32x16*o,int vb,bf16x8 pa0,bf16x8 pa1,bf16x8 pa2,bf16x8 pa3){
  #pragma unroll
  for(int d0=0;d0<4;++d0){s16x4 lo[4],hi[4];
    #pragma unroll
    for(int ks=0;ks<4;++ks){
      asm volatile("ds_read_b64_tr_b16 %0,%1 offset:%c2":"=&v"(lo[ks]):"v"(vb),"i"(d0*4096+ks*1024):"memory");
      asm volatile("ds_read_b64_tr_b16 %0,%1 offset:%c2":"=&v"(hi[ks]):"v"(vb),"i"(d0*4096+ks*1024+512):"memory");}
    asm volatile("s_waitcnt lgkmcnt(0)":::"memory");SBAR();
    #define PK(k) (bf16x8){lo[k][0],lo[k][1],lo[k][2],lo[k][3],hi[k][0],hi[k][1],hi[k][2],hi[k][3]}
    o[d0]=__builtin_amdgcn_mfma_f32_32x32x16_bf16(pa0,PK(0),o[d0],0,0,0);
    o[d0]=__builtin_amdgcn_mfma_f32_32x32x16_bf16(pa1,PK(1),o[d0],0,0,0);
    o[d0]=__builtin_amdgcn_mfma_f32_32x32x16_bf16(pa2,PK(2),o[d0],0,0,0);
    o[d0]=__builtin_amdgcn_mfma_f32_32x32x16_bf16(pa3,PK(3),o[d0],0,0,0);
    #undef PK
  }
}

#ifndef ATTN_STORE16
#define ATTN_STORE16(p,v) (*(u32x4*)(p)=(v))
#endif
template<int THRL> __device__ __forceinline__ void attn_unit(int b,int qcol,int kcol,int vcol,int ocol,int qb,const bf16*Q,const bf16*__restrict__ K,const bf16*__restrict__ V,bf16*O,char*shm,const int tid){
  const int lane=tid&63,r32=lane&31,hi=lane>>5; const int wid=__builtin_amdgcn_readfirstlane(tid>>6);
  const long rowbase=(long)b*SEQ; const int q0=qb*QB;
  const bf16*Qw=Q+(rowbase+q0+wid*QBLK)*PIN+qcol;
  const bf16*Kh=K+rowbase*PIN+kcol,*Vh=V+rowbase*PIN+vcol;
  const unsigned lds0=(unsigned)(uintptr_t)shm;
  float*wsf=(float*)(shm+LDS_WS)+wid*64;
  const unsigned koff=(unsigned)(lane*PIN+wid*8)*2u;
  const unsigned voff=(unsigned)((16*(wid&3)+(lane>>2))*PIN+(wid>>2)*32+(lane&3)*8)*2u;
  const unsigned kdst=lds0+LDS_K+wid*1024, vdst=lds0+LDS_V+wid*1024;
  #define DMA_K(t,slot) glds16s(Kh+(long)(t)*KVBLK*PIN,koff,(unsigned)__builtin_amdgcn_readfirstlane(kdst+(slot)))
  #define DMA_V(t,slot) do{ glds16s(Vh+(long)(t)*KVBLK*PIN,voff,(unsigned)__builtin_amdgcn_readfirstlane(vdst+2*(slot))); glds16s(Vh+(long)(t)*KVBLK*PIN,voff+128u,(unsigned)__builtin_amdgcn_readfirstlane(vdst+8192+2*(slot))); }while(0)
  const int vb0=(int)(lds0+LDS_V)+((lane>>4)&1)*32+(lane&3)*8+(4*hi+((lane&15)>>2))*64;
  const char*Kbase=shm+LDS_K; bf16x8 kf[8];
  const lds_cptr shm3=(lds_cptr)shm; const lds_cptr kp0=shm3+LDS_K+hi*1024+r32*16; const lds_cptr vp0=shm3+LDS_V+((lane>>4)&1)*32+(lane&3)*8+(4*hi+((lane&15)>>2))*64;
  const int NT=(q0+QB)/KVBLK;
  DMA_K(0,0);DMA_V(0,0);DMA_K(1,SLOTB);
  bf16x8 qr[4];
  { int lq=lane; asm volatile("":"+v"(lq)); const int r32q=lq&31,hiq=lq>>5;
  _Pragma("unroll") for(int d0=0;d0<4;++d0)qr[d0]=*reinterpret_cast<const bf16x8*>(&Qw[(long)r32q*PIN+d0*16+hiq*8]); }
  const lds_cptr qst=shm3+LDS_OST+wid*4096+lane*16;
  #define QST(d0) (*(__attribute__((address_space(3))) bf16x8*)(qst+(d0)*1024))
  _Pragma("unroll") for(int d0=0;d0<4;++d0) *(__attribute__((address_space(3))) bf16x8*)((__attribute__((address_space(3))) char*)qst+d0*1024)=qr[d0];
  float mhat=0.f,l_reg=0.f;f32x16 o[4];o[0]=f32x16{};o[1]=f32x16{};o[2]=f32x16{};o[3]=f32x16{};float z0_=0.f;asm volatile("":"+v"(z0_));f32x16 negm;_Pragma("unroll") for(int r=0;r<16;++r)negm[r]=z0_;asm volatile("":"+v"(negm));
  const int qrel=wid*QBLK+r32;
  #define CMASK(P0,P1,t) do{int jb_=(t)-(NT-4); if(jb_>=0)cmask(P0,P1,jb_,qrel,hi);}while(0)
  bool resc=false;
  #define START(P0,P1) do{ const float rm=rowmax(P0,P1); resc=false; \
    { const float dl=rm; mhat=fadd_s(mhat,dl); \
      _Pragma("unroll") for(int r=0;r<16;++r){P0[r]=fsub_s(P0[r],dl);P1[r]=fsub_s(P1[r],dl);} \
      _Pragma("unroll") for(int r=0;r<16;++r)negm[r]=-mhat; asm volatile("":"+v"(negm)); } \
    _Pragma("unroll") for(int r=0;r<16;++r)P0[r]=__builtin_amdgcn_exp2f(P0[r]); }while(0)
  #define RESC() do{ if(resc){ asm volatile("s_waitcnt lgkmcnt(0)":::"memory"); \
      _Pragma("unroll") for(int d_=0;d_<4;++d_) _Pragma("unroll") for(int r=0;r<16;++r)o[d_][r]*=wsf[crow(r,hi)]; } }while(0)
  f32x16 pA0,pA1,pB0,pB1;
  int sl_prev=0,sl_cur=0,sl_next=SLOTB;
  #define ROT() do{sl_prev=sl_cur;sl_cur=sl_next;sl_next=(sl_next==(NSLOT-1)*SLOTB)?0:sl_next+SLOTB;}while(0)
  DMA_K(2,2*SLOTB);
  WAIT_BAR(3);
  qkt(pA0,pA1,Kbase,qr,negm,r32,hi);asm volatile("s_nop 15\n\ts_nop 7":"+v"(pA0),"+v"(pA1));CMASK(pA0,pA1,0);
  START(pA0,pA1);
  _Pragma("unroll") for(int r=0;r<16;++r)pA1[r]=__builtin_amdgcn_exp2f(pA1[r]);
  u32x4 pa0,pa1,pa2,pa3,pb0,pb1,pb2,pb3;
  { float s0_=pA0[0]+pA0[1]; _Pragma("unroll") for(int r=2;r<16;++r)s0_+=pA0[r]; _Pragma("unroll") for(int r=0;r<16;++r)s0_+=pA1[r]; l_reg+=s0_;
    pa0=(u32x4){cvtpk_s(pA0[0],pA0[1]),cvtpk_s(pA0[2],pA0[3]),cvtpk_s(pA0[4],pA0[5]),cvtpk_s(pA0[6],pA0[7])}; pa1=(u32x4){cvtpk_s(pA0[8],pA0[9]),cvtpk_s(pA0[10],pA0[11]),cvtpk_s(pA0[12],pA0[13]),cvtpk_s(pA0[14],pA0[15])};
    pa2=(u32x4){cvtpk_s(pA1[0],pA1[1]),cvtpk_s(pA1[2],pA1[3]),cvtpk_s(pA1[4],pA1[5]),cvtpk_s(pA1[6],pA1[7])}; pa3=(u32x4){cvtpk_s(pA1[8],pA1[9]),cvtpk_s(pA1[10],pA1[11]),cvtpk_s(pA1[12],pA1[13]),cvtpk_s(pA1[14],pA1[15])}; }
  WAIT_BAR(0);
  DMA_K(3,0);DMA_V(1,SLOTB);
  ROT();
  kload8(kf,kp0+sl_cur);
  WAIT_BAR(3);
  s16x4 vlo[4],vhi[4];
  #define PAFX(P) __builtin_bit_cast(bf16x8,P)
  #define VFRS(i) (bf16x8){vlo[i][0],vlo[i][1],vlo[i][2],vlo[i][3],vhi[i][0],vhi[i][1],vhi[i][2],vhi[i][3]}
  #define PIN(x) asm volatile("":"+v"(x))
  #define MX3(a,b,c) __builtin_fmaxf(__builtin_fmaxf((a),(b)),(c))
  #define EX(v) __builtin_amdgcn_exp2f(v)
  #define VRDF(s,id) do{ vlo[s]=vtr(vp_+(((id)>>2)*4096+((id)&3)*1024)); vhi[s]=vtr(vp_+(((id)>>2)*4096+((id)&3)*1024+512)); }while(0)
  #define GAPA(MF) do{ MF; SBAR(); }while(0)
  #define GAPAV(MF,s,id) do{ VRDF(s,id); SBAR(); MF; SBAR(); }while(0)
  #define GAPB(MF,X,B,PN,W,RD) do{ MF; X[B]=EX(X[B]); X[B+1]=EX(X[B+1]); PIN(X); sacc+=X[B]; sacc+=X[B+1]; PIN(sacc); PN[W]=cvtpk_s(X[B],X[B+1]); PIN(PN); RD; SBAR(); }while(0)
  #define KRD(G,j) do{ if(G){ kload2(kf,kp0+sl_next,j); SBAR(); } }while(0)
  #define STEP(C0,C1,PC0,PC1,PC2,PC3,PN0,PN1,PN2,PN3,t,GK,GV,GL) do{ SBAR(); \
    const lds_cptr vp_=vp0+2*sl_prev; \
    const bf16x8 q0_=QST(0),q1_=QST(1),q2_=QST(2),q3_=QST(3); SBAR(); \
    GAPA(C0=__builtin_amdgcn_mfma_f32_32x32x16_bf16(kf[0],q0_,negm,0,0,0)); \
    GAPA(C1=__builtin_amdgcn_mfma_f32_32x32x16_bf16(kf[1],q0_,negm,0,0,0)); \
    GAPA(C0=__builtin_amdgcn_mfma_f32_32x32x16_bf16(kf[2],q1_,C0,0,0,0)); \
    GAPA(C1=__builtin_amdgcn_mfma_f32_32x32x16_bf16(kf[3],q1_,C1,0,0,0)); \
    GAPAV(C0=__builtin_amdgcn_mfma_f32_32x32x16_bf16(kf[4],q2_,C0,0,0,0),0,0); \
    GAPAV(C1=__builtin_amdgcn_mfma_f32_32x32x16_bf16(kf[5],q2_,C1,0,0,0),1,4); \
    GAPAV(C0=__builtin_amdgcn_mfma_f32_32x32x16_bf16(kf[6],q3_,C0,0,0,0),2,1); \
    GAPAV(C1=__builtin_amdgcn_mfma_f32_32x32x16_bf16(kf[7],q3_,C1,0,0,0),3,5); \
    if(GK){DMA_K((t)+3,sl_cur);} if(GV){DMA_V((t)+1,sl_next);} \
    CMASK(C0,C1,t); \
    { float a=MX3(C0[0],C0[1],C1[0]),b=MX3(C0[2],C0[3],C1[1]); a=MX3(a,C1[2],C1[3]); \
      _Pragma("unroll") for(int r=4;r<16;r+=4){a=MX3(a,C0[r],C0[r+1]);b=MX3(b,C0[r+2],C0[r+3]);a=MX3(a,C1[r],C1[r+1]);b=MX3(b,C1[r+2],C1[r+3]);} \
      float rm=__builtin_fmaxf(a,b); { auto rr=__builtin_amdgcn_permlane32_swap(__float_as_uint(rm),__float_as_uint(rm),false,false); rm=__builtin_fmaxf(__uint_as_float(rr[0]),__uint_as_float(rr[1])); } \
      resc=false; \
      if(__builtin_expect(__any(rm>(float)THRL),0)){ const float dl=__builtin_fmaxf(rm,0.f); mhat+=dl; \
        _Pragma("unroll") for(int r=0;r<16;++r){C0[r]-=dl;C1[r]-=dl;} \
        _Pragma("unroll") for(int r=0;r<16;++r)negm[r]=-mhat; asm volatile("":"+v"(negm)); \
        const float f=__builtin_amdgcn_exp2f(-dl); l_reg*=f; if(hi==0)wsf[r32]=f; resc=true; } } \
    SBAR(); \
    float sacc=0.f; \
    GAPB(o[0]=__builtin_amdgcn_mfma_f32_32x32x16_bf16(PAFX(PC0),VFRS(0),o[0],0,0,0), C0,0,  PN0,0, VRDF(0,2)); \
    GAPB(o[1]=__builtin_amdgcn_mfma_f32_32x32x16_bf16(PAFX(PC0),VFRS(1),o[1],0,0,0), C0,2,  PN0,1, VRDF(1,6)); \
    KRD(GL,0); GAPB(o[0]=__builtin_amdgcn_mfma_f32_32x32x16_bf16(PAFX(PC1),VFRS(2),o[0],0,0,0), C0,4,  PN0,2, VRDF(2,3)); \
    KRD(GL,1); GAPB(o[1]=__builtin_amdgcn_mfma_f32_32x32x16_bf16(PAFX(PC1),VFRS(3),o[1],0,0,0), C0,6,  PN0,3, VRDF(3,7)); \
    KRD(GL,2); GAPB(o[0]=__builtin_amdgcn_mfma_f32_32x32x16_bf16(PAFX(PC2),VFRS(0),o[0],0,0,0), C0,8,  PN1,0, VRDF(0,8)); \
    KRD(GL,3); GAPB(o[1]=__builtin_amdgcn_mfma_f32_32x32x16_bf16(PAFX(PC2),VFRS(1),o[1],0,0,0), C0,10, PN1,1, VRDF(1,12)); \
    GAPB(o[0]=__builtin_amdgcn_mfma_f32_32x32x16_bf16(PAFX(PC3),VFRS(2),o[0],0,0,0), C0,12, PN1,2, VRDF(2,9)); \
    GAPB(o[1]=__builtin_amdgcn_mfma_f32_32x32x16_bf16(PAFX(PC3),VFRS(3),o[1],0,0,0), C0,14, PN1,3, VRDF(3,13)); \
    GAPB(o[2]=__builtin_amdgcn_mfma_f32_32x32x16_bf16(PAFX(PC0),VFRS(0),o[2],0,0,0), C1,0,  PN2,0, VRDF(0,10)); \
    GAPB(o[3]=__builtin_amdgcn_mfma_f32_32x32x16_bf16(PAFX(PC0),VFRS(1),o[3],0,0,0), C1,2,  PN2,1, VRDF(1,14)); \
    GAPB(o[2]=__builtin_amdgcn_mfma_f32_32x32x16_bf16(PAFX(PC1),VFRS(2),o[2],0,0,0), C1,4,  PN2,2, VRDF(2,11)); \
    GAPB(o[3]=__builtin_amdgcn_mfma_f32_32x32x16_bf16(PAFX(PC1),VFRS(3),o[3],0,0,0), C1,6,  PN2,3, VRDF(3,15)); \
    GAPB(o[2]=__builtin_amdgcn_mfma_f32_32x32x16_bf16(PAFX(PC2),VFRS(0),o[2],0,0,0), C1,8,  PN3,0, (void)0); \
    GAPB(o[3]=__builtin_amdgcn_mfma_f32_32x32x16_bf16(PAFX(PC2),VFRS(1),o[3],0,0,0), C1,10, PN3,1, (void)0); \
    GAPB(o[2]=__builtin_amdgcn_mfma_f32_32x32x16_bf16(PAFX(PC3),VFRS(2),o[2],0,0,0), C1,12, PN3,2, (void)0); \
    GAPB(o[3]=__builtin_amdgcn_mfma_f32_32x32x16_bf16(PAFX(PC3),VFRS(3),o[3],0,0,0), C1,14, PN3,3, (void)0); \
    l_reg+=sacc; \
    }while(0)
  #define STEP_AB(C0,C1,t,GK,GV,GL) STEP(C0,C1,pa0,pa1,pa2,pa3,pb0,pb1,pb2,pb3,t,GK,GV,GL)
  #define STEP_BA(C0,C1,t,GK,GV,GL) STEP(C0,C1,pb0,pb1,pb2,pb3,pa0,pa1,pa2,pa3,t,GK,GV,GL)
  int t=1;
  #undef CMASK
  #define CMASK(P0,P1,t) do{}while(0)
  for(;t+5<NT;t+=2){
    STEP_AB(pB0,pB1,t,true,true,true);     WAIT_BAR(3); RESC(); ROT();
    STEP_BA(pA0,pA1,t+1,true,true,true);   WAIT_BAR(3); RESC(); ROT();
  }
  #undef CMASK
  #define CMASK(P0,P1,t) do{int jb_=(t)-(NT-4); if(jb_>=0)cmask(P0,P1,jb_,qrel,hi);}while(0)
  #define ENDW(tt) do{ if((tt)+3<NT){WAIT_BAR(3);} else if((tt)+2<NT){WAIT_BAR(2);} else {WAIT_BAR(0);} }while(0)
  for(;t+1<NT;t+=2){
    STEP_AB(pB0,pB1,t,(t+3<NT),(t+1<NT),(t+1<NT));       ENDW(t);   RESC(); ROT();
    STEP_BA(pA0,pA1,t+1,(t+4<NT),(t+2<NT),(t+2<NT));     ENDW(t+1); RESC(); ROT();
  }
  STEP_AB(pB0,pB1,NT-1,false,false,false); RESC();
  { SBAR(); pv(o,vb0+2*sl_cur,PAFX(pb0),PAFX(pb1),PAFX(pb2),PAFX(pb3)); }
  #undef QST
  #undef PAFX
  #undef VFRS
  #undef PIN
  #undef MX3
  #undef GAPA
  #undef GAPAV
  #undef GAPB
  #undef EX
  #undef VRDF
  #undef KRD
  #undef STEP
  #undef STEP_AB
  #undef STEP_BA
  #undef ENDW
  {auto rr=__builtin_amdgcn_permlane32_swap(__float_as_uint(l_reg),__float_as_uint(l_reg),false,false);l_reg=__uint_as_float(rr[0])+__uint_as_float(rr[1]);}
  { int le=lane; asm volatile("":"+v"(le)); const int r32e=le&31,hie=le>>5;
  if(hie==0)wsf[32+r32e]=l_reg;asm volatile("s_waitcnt lgkmcnt(0)":::"memory");
  float rli[16];
  #pragma unroll
  for(int r=0;r<16;++r)rli[r]=__builtin_amdgcn_rcpf(wsf[32+crow(r,hie)]);
  bf16*Ow=O+(rowbase+q0+wid*QBLK)*POUT+ocol;
  { bf16*stg=(bf16*)(shm+LDS_OST)+wid*2048;
    #pragma unroll
    for(int hf=0;hf<2;++hf){
    #pragma unroll
    for(int r=0;r<16;++r){const int orow=crow(r,hie);
      #pragma unroll
      for(int d0=0;d0<2;++d0)stg[orow*64+d0*32+r32e]=__float2bfloat16(o[2*hf+d0][r]*rli[r]);}
    asm volatile("s_waitcnt lgkmcnt(0)":::"memory");
    #pragma unroll
    for(int i=0;i<4;++i){const int row=i*8+(le>>3),ch=le&7; const u32x4 v=*(const u32x4*)(stg+row*64+ch*8); ATTN_STORE16(Ow+(long)row*POUT+hf*64+ch*8,v);}
    asm volatile("s_waitcnt lgkmcnt(0)":::"memory"); } } }
  asm volatile("s_waitcnt lgkmcnt(0)\n\ts_barrier":::"memory");
  #undef DMA_K
  #undef DMA_V
  #undef CMASK
  #undef START
  #undef RESC
  #undef ROT
}
constexpr int ATTN_LDS_BYTES=LDS_BYTES;
struct AttnUnit { int bh; int qb; };
struct StaticOrder {
  int vcu;
  __device__ __forceinline__ explicit StaticOrder(int v):vcu(v){}
  __device__ __forceinline__ bool next(int i,AttnUnit&u)const{ if(i>=2)return false; const int s=vcu&7; u.bh=vcu>>3; u.qb=(i==0)?s:15-s; return true; }
};
template<class Sched,int THRL=8> __device__ __forceinline__ void attn_phase(char*lds,const bf16*P,bf16*O,const Sched&S,const int tid){
  AttnUnit u;
  for(int i=0;S.next(i,u);++i){ const int b=u.bh>>3, h=(u.bh>>1)&3, m=u.bh&1;
    attn_unit<THRL>(b, h*128+m*64, 512+h*128+m*64, 1024+h*128, m*512+h*128, u.qb, P, P, P, O, lds, tid); }
}
#undef SBAR
#undef WAIT_BAR
}
#define GAS __attribute__((address_space(1)))
#define LAS __attribute__((address_space(3)))
typedef unsigned short bf16;
typedef unsigned v4u __attribute__((ext_vector_type(4)));
typedef float f32x4 __attribute__((ext_vector_type(4)));
typedef short bf16x8 __attribute__((ext_vector_type(8)));
typedef GAS unsigned gu32;
typedef GAS unsigned long long gu64;
#define RLX_AGENT __ATOMIC_RELAXED, __HIP_MEMORY_SCOPE_AGENT
#define LDS_WAIT() asm volatile("s_waitcnt lgkmcnt(0)" ::: "memory")
#define VM_WAIT() asm volatile("s_waitcnt vmcnt(0)" ::: "memory")
__device__ __forceinline__ unsigned long long rt() { return __builtin_amdgcn_s_memrealtime(); }
__device__ __forceinline__ unsigned f2bf(float f) { unsigned u = __builtin_bit_cast(unsigned, f); return (u + 0x7fffu + ((u >> 16) & 1u)) >> 16; }
__device__ __forceinline__ unsigned pk2(float lo, float hi) { return f2bf(lo) | (f2bf(hi) << 16); }

#define XB_TMO      128
#define XB_XCNT(j)  (256  + 64 * (j))
#define XB_XSUB(j)  (1280 + 64 * (j))
#define XB_XGEN(j)  (2304 + 64 * (j))
#define XB_TOP      3328
#define XB_TOPGEN   3392
#define XCD_BAR_WORDS 3456
#define XB_SPIN_CAP (1u << 22)

__device__ __forceinline__ unsigned xb_ld(unsigned* p)              { return __hip_atomic_load(p, __ATOMIC_RELAXED, __HIP_MEMORY_SCOPE_AGENT); }
__device__ __forceinline__ unsigned xb_add(unsigned* p, unsigned v) { return __hip_atomic_fetch_add(p, v, __ATOMIC_RELAXED, __HIP_MEMORY_SCOPE_AGENT); }
__device__ __forceinline__ unsigned xb_xcc_id() { return (unsigned)__builtin_amdgcn_s_getreg((3 << 11) | 20) & 0xFu; }
#define XB_SPIN(cond, bar) do { unsigned _sp = 0; while (cond) { __builtin_amdgcn_s_sleep(1); \
    if ((++_sp & 255u) == 0u) { if (xb_ld(&(bar)[XB_TMO])) break; if (_sp > XB_SPIN_CAP) { atomicAdd(&(bar)[XB_TMO], 1u); break; } } } } while (0)

struct XcdBarrier {
    unsigned* bar; unsigned x;
    volatile LAS unsigned* st;
};

__device__ __forceinline__ XcdBarrier xcd_barrier_post(unsigned* bar, volatile LAS unsigned* st) {
    XcdBarrier b; b.bar = bar; b.x = xb_xcc_id(); b.st = st;
    if (threadIdx.x == 0) (void)xb_add(&bar[XB_XCNT(b.x)], 1u);
    return b;
}
__device__ __forceinline__ void xcd_barrier_complete(unsigned* bar, unsigned x, unsigned& nloc, unsigned& nx) {
    const unsigned G = gridDim.x * gridDim.y * gridDim.z;
    unsigned sum, cnt, mine, sp = 0u;
    for (;;) {
        sum = 0u; cnt = 0u; mine = 0u;
#pragma unroll
        for (unsigned j = 0; j < 16; ++j) { const unsigned c = xb_ld(&bar[XB_XCNT(j)]); sum += c; cnt += (c > 0u) ? 1u : 0u; mine = (j == x) ? c : mine; }
        if (sum == G) break;
        __builtin_amdgcn_s_sleep(1);
        if ((++sp & 255u) == 0u) { if (xb_ld(&bar[XB_TMO])) break; if (sp > XB_SPIN_CAP) { atomicAdd(&bar[XB_TMO], 1u); break; } }
    }
    nloc = mine > 0u ? mine : 1u; nx = cnt > 0u ? cnt : 1u;
}

__device__ __forceinline__ void xcd_barrier(const XcdBarrier& b, const bool leader  ) {
    asm volatile("s_waitcnt vmcnt(0)" ::: "memory");
    __syncthreads();
    if (leader) {
        unsigned* bar = b.bar;
        __builtin_amdgcn_s_waitcnt(0);
        unsigned nloc = b.st[0], nx = b.st[1];
        if (nloc == 0u) { xcd_barrier_complete(bar, b.x, nloc, nx); b.st[0] = nloc; b.st[1] = nx; }
        const unsigned old = xb_add(&bar[XB_XSUB(b.x)], 1u);
        const unsigned gen = old / nloc;
        if (old + 1u == (gen + 1u) * nloc) {
            __builtin_amdgcn_fence(__ATOMIC_RELEASE, "agent");
            asm volatile("s_waitcnt vmcnt(0)" ::: "memory");
            const unsigned og = xb_add(&bar[XB_TOP], 1u);
            const unsigned tg = og / nx;
            if (og + 1u == (tg + 1u) * nx) xb_add(&bar[XB_TOPGEN], 1u);
            else XB_SPIN(xb_ld(&bar[XB_TOPGEN]) == tg, bar);
            __builtin_amdgcn_fence(__ATOMIC_ACQUIRE, "agent");
            xb_add(&bar[XB_XGEN(b.x)], 1u);
            asm volatile("s_waitcnt vmcnt(0)" ::: "memory");
        } else {
            XB_SPIN(xb_ld(&bar[XB_XGEN(b.x)]) == gen, bar);
            __builtin_amdgcn_fence(__ATOMIC_ACQUIRE, "agent");
            asm volatile("s_waitcnt vmcnt(0)" ::: "memory");
        }
    }
    __syncthreads();
}

constexpr int NWAVES = 8;
constexpr int M = 16384, DM = 1024, SEQL = 4096, NPROJ = 3072, NIN = 3088, NQ = 2048, NLAYER = 2;
constexpr int C_Q = 0, C_K = 512, C_V = 1024, C_SB = 1536, C_SC = 1792, C_SH = 2048, C_GQ = 2304, C_GK = 2432, C_GV = 2560, C_GR = 2816;
constexpr float EPS = 1e-6f;
constexpr float ATT_C2 = 0.125f * 1.4426950408889634f;

constexpr size_t MiB = 1u << 20;
constexpr size_t WS_CTL = 0, CTL_ZERO_BYTES = 1 * MiB;
constexpr size_t WS_WIN = 1 * MiB, WIN_STRIDE = 7 * MiB;
constexpr size_t WS_WOUT = 15 * MiB, WOUT_STRIDE = 2 * MiB;
constexpr size_t WS_WQ = 19 * MiB, WQ_STRIDE = 4 * MiB;
constexpr size_t WS_KEYS = 27 * MiB, KEYS_STRIDE = 65536;
constexpr size_t WS_COS = 28 * MiB, WS_SIN = 28 * MiB + 512 * 1024;
constexpr size_t WS_SSQ = 29 * MiB;
constexpr size_t WS_GD = 30 * MiB;
constexpr size_t WS_LAM = 30 * MiB + 512 * 1024;
constexpr size_t WS_PAR = 30 * MiB + 768 * 1024;
constexpr int PAR_DN = 0, PAR_CW = 256, PAR_WG2 = 1792, PAR_BG = 5888, PAR_GN = 6144, PAR_NF = 6272, PAR_N = 7296;
constexpr size_t WS_GU = 31 * MiB;
constexpr size_t WS_GB = 39 * MiB;
constexpr size_t WS_EXP = 47 * MiB;
constexpr size_t WS_GATE = 55 * MiB;
constexpr size_t WS_U8 = 64 * MiB, TAB_STRIDE = 16 * MiB;
constexpr size_t WS_V8 = 128 * MiB;
constexpr size_t WS_SU = 56 * MiB + 512 * 1024 * 0 + 7 * MiB, WS_SV = WS_SU + 256 * 1024;
constexpr size_t WS_RS1 = 63 * MiB + 512 * 1024;
constexpr size_t WS_XB = 192 * MiB;
constexpr size_t WS_PROJ = 224 * MiB;
constexpr size_t WS_OATT = 320 * MiB;
constexpr size_t WS_MIXED = 352 * MiB;
constexpr size_t WS_QP = 384 * MiB;
constexpr size_t WS_END = 448 * MiB;
constexpr int CW_TMO = 0, CW_BAR = 4096;

constexpr int RING_OFF = 0, RING_BYTES = 131072;
constexpr int LDSCTL_OFF = RING_BYTES, MISC_OFF = LDSCTL_OFF + 320;
constexpr int LDS_BYTES = 147456;

struct Frame {
    LAS unsigned char* lds;
    volatile LAS unsigned* MISC;
    int tid, lane, wave;
    int vcu, G, bx;
    float* out; unsigned char* ws;
};
__device__ __forceinline__ float wave_sum(float v) { return xl_wave_sum(v); }
__device__ __forceinline__ float bflo(unsigned w) { return __builtin_bit_cast(float, w << 16); }
__device__ __forceinline__ float bfhi(unsigned w) { return __builtin_bit_cast(float, w & 0xffff0000u); }
__device__ __forceinline__ float bf1(bf16 h) { return __builtin_bit_cast(float, (unsigned)h << 16); }

__device__ __forceinline__ void p0_transpose_item(const float* W, int ldw, int N, const float* gain, bf16* WT, int K, LAS float* scr, int item, int lane) {
    const int nblk = (N + 31) / 32, kb = item / nblk, nb = item % nblk, k0 = 64 * kb, n0 = 32 * nb;
    const int nn = n0 + (lane & 31);
    float wv[32];
#pragma unroll
    for (int i = 0; i < 32; ++i) { const int kk = 2 * i + (lane >> 5); wv[i] = (nn < N) ? W[(size_t)(k0 + kk) * ldw + nn] : 0.f; }
#pragma unroll
    for (int i = 0; i < 32; ++i) { const int kk = 2 * i + (lane >> 5); float w = wv[i]; if (gain) w *= gain[k0 + kk]; scr[kk * 33 + (lane & 31)] = w; }
    LDS_WAIT(); asm volatile("" ::: "memory");
    const int c = lane & 7;
#pragma unroll
    for (int j = 0; j < 4; ++j) { const int n = (lane >> 3) + 8 * j; const LAS float* s = scr + (8 * c) * 33 + n;
        v4u o; o.x = pk2(s[0 * 33], s[1 * 33]); o.y = pk2(s[2 * 33], s[3 * 33]); o.z = pk2(s[4 * 33], s[5 * 33]); o.w = pk2(s[6 * 33], s[7 * 33]);
        if (n0 + n < N) *(GAS v4u*)(WT + (size_t)(n0 + n) * K + k0 + 8 * c) = o; }
    LDS_WAIT(); asm volatile("" ::: "memory");
}
struct Args;
template <class A> __device__ __forceinline__ void p0_prologue(Frame& F, const A& args) {
    const float* const* in_ = nullptr; (void)in_;
    LAS float* scr = (LAS float*)(F.lds + RING_OFF + F.wave * 16384);
    const int gw = F.vcu * NWAVES + F.wave, NGW = F.G * NWAVES;
    const int gt = F.vcu * (NWAVES * 64) + F.tid, NGT = F.G * NWAVES * 64;
    constexpr int I_IN = 16 * 97, I_OUT = 16 * 32, I_Q = 16 * 64, I_L = I_IN + I_OUT + I_Q;
    for (int it = gw; it < NLAYER * I_L; it += NGW) {
        const int l = it / I_L; int r = it % I_L;
        if (r < I_IN) { p0_transpose_item(args.in[3] + (size_t)l * DM * NIN, NIN, NIN, args.in[2] + l * DM, (bf16*)(F.ws + WS_WIN + l * WIN_STRIDE), DM, scr, r, F.lane); continue; } r -= I_IN;
        if (r < I_OUT) { p0_transpose_item(args.in[13] + (size_t)l * DM * DM, DM, DM, nullptr, (bf16*)(F.ws + WS_WOUT + l * WOUT_STRIDE), DM, scr, r, F.lane); continue; } r -= I_OUT;
        p0_transpose_item(args.in[15] + (size_t)l * DM * NQ, NQ, NQ, args.in[14] + l * DM, (bf16*)(F.ws + WS_WQ + l * WQ_STRIDE), DM, scr, r, F.lane);
    }
    for (int i = gt; i < NLAYER * 2 * 16384; i += NGT) { const int l = i >> 15, hf = (i >> 14) & 1, e = i & 16383;
        ((bf16*)(F.ws + WS_KEYS + l * KEYS_STRIDE))[hf * 16384 + e] = (bf16)f2bf((hf ? args.in[17] : args.in[16])[(size_t)l * 16384 + e]); }
    for (int row0 = gw; row0 < NLAYER * 2 * 16384; row0 += 4 * NGW) {
        f32x4 v[4][4]; float mx[4] = {0.f, 0.f, 0.f, 0.f};
#pragma unroll
        for (int u = 0; u < 4; ++u) { const int row = (row0 + u * NGW < NLAYER * 2 * 16384) ? row0 + u * NGW : row0; const int l = row >> 15, tab = (row >> 14) & 1, e = row & 16383;
            const f32x4* src = (const f32x4*)((tab ? args.in[19] : args.in[18]) + (size_t)l * 16777216 + (size_t)e * DM) + F.lane;
#pragma unroll
            for (int j = 0; j < 4; ++j) v[u][j] = __builtin_nontemporal_load(src + 64 * j); }
#pragma unroll
        for (int u = 0; u < 4; ++u) { const int row = row0 + u * NGW; const int l = row >> 15, tab = (row >> 14) & 1, e = row & 16383;
            if (row < NLAYER * 2 * 16384) {
#pragma unroll
            for (int j = 0; j < 4; ++j) { if (tab == 0) v[u][j] = v[u][j] * ((const f32x4*)(args.in[14] + l * DM))[F.lane + 64 * j];
                mx[u] = fmaxf(mx[u], fmaxf(fmaxf(fabsf(v[u][j][0]), fabsf(v[u][j][1])), fmaxf(fabsf(v[u][j][2]), fabsf(v[u][j][3])))); }
            float m_ = mx[u];
            m_ = fmaxf(m_, xl_swz<1>(m_)); m_ = fmaxf(m_, xl_swz<2>(m_)); m_ = fmaxf(m_, xl_swz<4>(m_)); m_ = fmaxf(m_, xl_swz<8>(m_)); m_ = fmaxf(m_, xl_swz<16>(m_));
            m_ = fmaxf(m_, __builtin_bit_cast(float, xl_xor32_i(__builtin_bit_cast(int, m_), F.lane >> 5)));
            unsigned* dst = (unsigned*)(F.ws + (tab ? WS_V8 : WS_U8) + l * TAB_STRIDE + (size_t)e * DM) + F.lane;
            if (tab) {
                int k = (int)floorf(log2f(224.0f / fmaxf(m_, 1e-30f))); k = k < -60 ? -60 : (k > 60 ? 60 : k);
                const float sc = ldexpf(1.0f, k);
#pragma unroll
                for (int j = 0; j < 4; ++j) { int p = __builtin_amdgcn_cvt_pk_fp8_f32(v[u][j][0] * sc, v[u][j][1] * sc, 0, false); p = __builtin_amdgcn_cvt_pk_fp8_f32(v[u][j][2] * sc, v[u][j][3] * sc, p, true); dst[64 * j] = (unsigned)p; }
                if (F.lane == 0) ((float*)(F.ws + WS_SV))[l * 16384 + e] = ldexpf(1.0f, -k);
            } else {
                const float sc = m_ > 0.f ? 127.0f / m_ : 0.f;
#pragma unroll
                for (int j = 0; j < 4; ++j) { const int q0 = (int)rintf(v[u][j][0] * sc), q1 = (int)rintf(v[u][j][1] * sc), q2 = (int)rintf(v[u][j][2] * sc), q3 = (int)rintf(v[u][j][3] * sc);
                    dst[64 * j] = (unsigned)(q0 & 255) | ((unsigned)(q1 & 255) << 8) | ((unsigned)(q2 & 255) << 16) | ((unsigned)(q3 & 255) << 24); }
                if (F.lane == 0) ((float*)(F.ws + WS_SU))[l * 16384 + e] = m_ * (1.0f / 127.0f);
            } } }
    }
    for (int m0 = gw; m0 < M; m0 += 4 * NGW) {
        f32x4 v[4][4];
#pragma unroll
        for (int u = 0; u < 4; ++u) { const int m = m0 + u * NGW; const f32x4* xr = (const f32x4*)(args.in[0] + (size_t)(m < M ? m : m0) * DM) + F.lane;
#pragma unroll
            for (int j = 0; j < 4; ++j) v[u][j] = __builtin_nontemporal_load(xr + 64 * j); }
#pragma unroll
        for (int u = 0; u < 4; ++u) { const int m = m0 + u * NGW; if (m < M) {
            unsigned long long* o8 = (unsigned long long*)((bf16*)(F.ws + WS_XB) + (size_t)m * DM) + F.lane; float s = 0.f;
#pragma unroll
            for (int j = 0; j < 4; ++j) { const f32x4 w = v[u][j]; s += (w[0] * w[0] + w[1] * w[1]) + (w[2] * w[2] + w[3] * w[3]);
                o8[64 * j] = (unsigned long long)pk2(w[0], w[1]) | ((unsigned long long)pk2(w[2], w[3]) << 32); }
            s = wave_sum(s);
            if (F.lane == 0) ((float*)(F.ws + WS_RS1))[m] = 1.0f / sqrtf(s * (1.0f / 1024.0f) + EPS); } }
    }
    for (int i = gt; i < M * 8; i += NGT) { const int m = i >> 3, j = i & 7; const double inv = pow(500000.0, -(double)j / 8.0); const double ang = (double)((const int*)args.in[1])[m] * inv;
        ((float*)(F.ws + WS_COS))[i] = (float)cos(ang); ((float*)(F.ws + WS_SIN))[i] = (float)sin(ang); }
    if (gt < NLAYER) { const int l = gt; float a = 0.f, b = 0.f;
        for (int i = 0; i < 64; ++i) { a += args.in[4][l * 64 + i] * args.in[5][l * 64 + i]; b += args.in[6][l * 64 + i] * args.in[7][l * 64 + i]; }
        const float lam_init = 0.8f - 0.6f * expf(-0.3f * (float)l);
        ((float*)(F.ws + WS_LAM))[l * 2] = expf(a) - expf(b) + lam_init; ((float*)(F.ws + WS_LAM))[l * 2 + 1] = 1.0f - lam_init; }
    { float* par = (float*)(F.ws + WS_PAR);
      for (int i = gt; i < PAR_N; i += NGT) { float v;
          if (i < PAR_CW) v = args.in[8][i]; else if (i < PAR_WG2) v = args.in[9][i - PAR_CW]; else if (i < PAR_BG) v = args.in[10][i - PAR_WG2]; else if (i < PAR_GN) v = args.in[11][i - PAR_BG];
          else if (i < PAR_NF) v = args.in[12][i - PAR_GN]; else v = args.in[20][i - PAR_NF];
          par[i] = v; } }
}

__device__ __forceinline__ float log_sigmoid(float x) { return fminf(x, 0.f) - __logf(1.0f + __expf(-fabsf(x))); }
template <int K> __device__ __forceinline__ void lds_mm_2x4(float (&acc)[2][4], const LAS float* X, int ldx, const LAS float* Y, int ldy) {
#pragma unroll 4
    for (int k = 0; k < K; k += 4) {
        const f32x4 x0 = *(const LAS f32x4*)(X + k), x1 = *(const LAS f32x4*)(X + ldx + k);
#pragma unroll
        for (int kk = 0; kk < 4; ++kk) { const f32x4 y = *(const LAS f32x4*)(Y + (k + kk) * ldy);
#pragma unroll
            for (int b = 0; b < 4; ++b) { acc[0][b] += x0[kk] * y[b]; acc[1][b] += x1[kk] * y[b]; } }
    }
}
typedef float f32x16g __attribute__((ext_vector_type(16)));
__device__ __forceinline__ int gla_crow(int r, int hh) { return (r & 3) + 8 * (r >> 2) + 4 * hh; }
__device__ __forceinline__ void gla_stage_vt(LAS bf16* VT, const bf16* PROJ, int t0, int tid) {
#pragma unroll
    for (int it = tid; it < 2048; it += 512) { const int eg = it >> 6, t = it & 63; const v4u w = *(const v4u*)(PROJ + (size_t)(t0 + t) * NPROJ + C_GV + eg * 8);
        LAS bf16* p = VT + (eg * 8) * 72 + t;
        p[0] = (bf16)(w.x & 0xffffu); p[72] = (bf16)(w.x >> 16); p[144] = (bf16)(w.y & 0xffffu); p[216] = (bf16)(w.y >> 16);
        p[288] = (bf16)(w.z & 0xffffu); p[360] = (bf16)(w.z >> 16); p[432] = (bf16)(w.w & 0xffffu); p[504] = (bf16)(w.w >> 16); }
}
__device__ __forceinline__ void gla_prep(Frame& F, int l, int ci, int stop_after = 0) {
    typedef float f32x4m __attribute__((ext_vector_type(4)));
    LAS float* LR = (LAS float*)(F.lds + RING_OFF);
    LAS bf16* KHT = (LAS bf16*)(LR + 2 * 64 * 17);
    LAS bf16* VT = KHT + 128 * 72;
    LAS float* W2s = (LAS float*)(VT + 256 * 72);
    const int t0 = ci * 64, tid = F.tid, lane = F.lane, wave = F.wave, r32 = lane & 31, hh = lane >> 5;
    const bf16* XB = (const bf16*)(F.ws + WS_XB); const bf16* PROJ = (const bf16*)(F.ws + WS_PROJ);
    const bf16* Wlr = (const bf16*)(F.ws + WS_WIN + l * WIN_STRIDE) + (size_t)NPROJ * DM;
    v4u kw0, kw1; float rs;
    {
        const int mt = wave & 3, kh = wave >> 2, fr = lane & 15, fq = lane >> 4;
        f32x4m acc = (f32x4m){0.f, 0.f, 0.f, 0.f};
        const bf16* ap = XB + (size_t)(t0 + mt * 16 + fr) * DM + kh * 512 + fq * 8; const bf16* bp = Wlr + (size_t)fr * DM + kh * 512 + fq * 8;
        bf16x8 av[16], bv[16];
#pragma unroll
        for (int ks = 0; ks < 16; ++ks) { av[ks] = *(const bf16x8*)(ap + ks * 32); bv[ks] = *(const bf16x8*)(bp + ks * 32); }
        gla_stage_vt(VT, PROJ, t0, tid);
        { const float* W2g = (const float*)(F.ws + WS_PAR) + PAR_WG2 + l * 16 * 128; const float* bgg = (const float*)(F.ws + WS_PAR) + PAR_BG + l * 128;
#pragma unroll
          for (int q = 0; q < 4; ++q) W2s[tid + 512 * q] = W2g[tid + 512 * q];
          if (tid < 128) W2s[2048 + tid] = bgg[tid]; }
        { const bf16* kp = PROJ + (size_t)(t0 + lane) * NPROJ + C_GK + 16 * wave; kw0 = *(const v4u*)kp; kw1 = *(const v4u*)(kp + 8); rs = ((const float*)(F.ws + WS_RS1))[t0 + lane]; }
#pragma unroll
        for (int ks = 0; ks < 16; ++ks) acc = __builtin_amdgcn_mfma_f32_16x16x32_bf16(av[ks], bv[ks], acc, 0, 0, 0);
#pragma unroll
        for (int i = 0; i < 4; ++i) LR[kh * (64 * 17) + (mt * 16 + fq * 4 + i) * 17 + fr] = acc[i];
    }
    __syncthreads();
    if (stop_after == 1) return;
    {
        const int d0 = 16 * wave, t = lane;
        float lr[16];
#pragma unroll
        for (int r = 0; r < 16; ++r) lr[r] = (LR[t * 17 + r] + LR[64 * 17 + t * 17 + r]) * rs;
        const LAS float* W2 = W2s + d0; const LAS float* bg = W2s + 2048 + d0;
        float bb[16];
#pragma unroll
        for (int dd = 0; dd < 16; ++dd) { float x = bg[dd];
#pragma unroll
            for (int r = 0; r < 16; ++r) x += lr[r] * W2[r * 128 + dd];
            bb[dd] = log_sigmoid(x) * (1.0f / 16.0f); }
#pragma unroll
        for (int off = 1; off < 64; off <<= 1) { const int src = ((lane - off) & 63) << 2;
#pragma unroll
            for (int dd = 0; dd < 16; ++dd) { const float o = __builtin_bit_cast(float, __builtin_amdgcn_ds_bpermute(src, __builtin_bit_cast(int, bb[dd]))); bb[dd] += (lane >= off) ? o : 0.f; } }
        float* GB = (float*)(F.ws + WS_GB) + (size_t)(t0 + t) * 128 + d0;
#pragma unroll
        for (int q = 0; q < 4; ++q) *(f32x4*)(GB + 4 * q) = (f32x4){bb[4 * q], bb[4 * q + 1], bb[4 * q + 2], bb[4 * q + 3]};
        const unsigned kw[8] = {kw0.x, kw0.y, kw0.z, kw0.w, kw1.x, kw1.y, kw1.z, kw1.w};
        float dc[16];
#pragma unroll
        for (int dd = 0; dd < 16; ++dd) { const float bl = __builtin_bit_cast(float, __builtin_amdgcn_readlane(__builtin_bit_cast(int, bb[dd]), 63)); dc[dd] = expf(bl);
            const float kv = (dd & 1) ? bfhi(kw[dd >> 1]) : bflo(kw[dd >> 1]); KHT[(d0 + dd) * 72 + t] = (bf16)f2bf(kv * expf(bl - bb[dd])); }
        if (lane == 0) { float* GD = (float*)(F.ws + WS_GD) + ci * 128 + d0;
#pragma unroll
            for (int q = 0; q < 4; ++q) *(f32x4*)(GD + 4 * q) = (f32x4){dc[4 * q], dc[4 * q + 1], dc[4 * q + 2], dc[4 * q + 3]}; }
    }
    __syncthreads();
    if (stop_after == 2) return;
    {
        const int h = wave >> 1, eb = wave & 1; f32x16g U = {};
#pragma unroll
        for (int ks = 0; ks < 4; ++ks) { const bf16x8 ka = *(const LAS bf16x8*)(KHT + (h * 32 + r32) * 72 + ks * 16 + 8 * hh); const bf16x8 vb = *(const LAS bf16x8*)(VT + (h * 64 + eb * 32 + r32) * 72 + ks * 16 + 8 * hh);
            U = __builtin_amdgcn_mfma_f32_32x32x16_bf16(ka, vb, U, 0, 0, 0); }
        float* GU = (float*)(F.ws + WS_GU) + (size_t)(ci * 4 + h) * 2048 + eb * 32 + r32;
#pragma unroll
        for (int r = 0; r < 16; ++r) GU[gla_crow(r, hh) * 64] = U[r];
    }
    __syncthreads();
}
__device__ __forceinline__ void gla_scan(Frame& F) {
    if (F.tid < 128) { const int gid = F.vcu * 128 + F.tid;
        if (gid < 32768) { const int b = gid >> 13, h = (gid >> 11) & 3, d = (gid >> 6) & 31, e = gid & 63; float s = 0.f;
            float* GU = (float*)(F.ws + WS_GU); const float* GD = (const float*)(F.ws + WS_GD);
            for (int c0 = 0; c0 < 64; c0 += 16) { float u[16], dc[16];
#pragma unroll
                for (int i = 0; i < 16; ++i) { const int ci = b * 64 + c0 + i; u[i] = GU[((size_t)(ci * 4 + h) * 32 + d) * 64 + e]; dc[i] = GD[ci * 128 + h * 32 + d]; }
#pragma unroll
                for (int i = 0; i < 16; ++i) { const int ci = b * 64 + c0 + i; GU[((size_t)(ci * 4 + h) * 32 + d) * 64 + e] = s; s = dc[i] * s + u[i]; } } } }
}
__device__ __forceinline__ void mix_chunk(Frame& F, int l, int ci) {
    LAS bf16* QB = (LAS bf16*)(F.lds + RING_OFF);
    LAS bf16* KB = QB + 64 * 136;
    LAS bf16* VT = KB + 64 * 136;
    LAS bf16* ST = VT + 256 * 72;
    const int t0 = ci * 64, tid = F.tid, lane = F.lane, wave = F.wave, r32 = lane & 31, hh = lane >> 5;
    const bf16* PROJ = (const bf16*)(F.ws + WS_PROJ); bf16* MIXED = (bf16*)(F.ws + WS_MIXED);
    const float* GB = (const float*)(F.ws + WS_GB) + (size_t)t0 * 128;
    const int h = wave >> 1, ib = wave & 1, i0 = 32 * ib;
#pragma unroll
    for (int it = tid; it < 1024; it += 512) { const int t = it >> 4, d0 = (it & 15) * 8;
        const f32x4 b0 = *(const f32x4*)(GB + t * 128 + d0), b1 = *(const f32x4*)(GB + t * 128 + d0 + 4);
        const bf16* pr = PROJ + (size_t)(t0 + t) * NPROJ; const v4u qw = *(const v4u*)(pr + C_GQ + d0), kw = *(const v4u*)(pr + C_GK + d0);
        const float bv[8] = {b0[0], b0[1], b0[2], b0[3], b1[0], b1[1], b1[2], b1[3]}; const unsigned qa[4] = {qw.x, qw.y, qw.z, qw.w}, ka[4] = {kw.x, kw.y, kw.z, kw.w};
        unsigned qo[4], ko[4];
#pragma unroll
        for (int p = 0; p < 4; ++p) { const float e0 = expf(bv[2 * p]), e1 = expf(bv[2 * p + 1]), n0 = expf(-bv[2 * p]), n1 = expf(-bv[2 * p + 1]);
            qo[p] = pk2(bflo(qa[p]) * 0.17677669529663687f * e0, bfhi(qa[p]) * 0.17677669529663687f * e1); ko[p] = pk2(bflo(ka[p]) * n0, bfhi(ka[p]) * n1); }
        *(LAS v4u*)(QB + t * 136 + d0) = (v4u){qo[0], qo[1], qo[2], qo[3]}; *(LAS v4u*)(KB + t * 136 + d0) = (v4u){ko[0], ko[1], ko[2], ko[3]}; }
    gla_stage_vt(VT, PROJ, t0, tid);
    { const float* GU = (const float*)(F.ws + WS_GU) + (size_t)ci * 8192;
      float sv[16];
#pragma unroll
      for (int q = 0; q < 16; ++q) sv[q] = GU[tid + 512 * q];
#pragma unroll
      for (int q = 0; q < 16; ++q) { const int it = tid + 512 * q, hd = it >> 6, e = it & 63; ST[((hd >> 5) * 64 + e) * 40 + (hd & 31)] = (bf16)f2bf(sv[q]); } }
    const size_t row = (size_t)(t0 + i0 + r32); unsigned long long rg[8];
#pragma unroll
    for (int q = 0; q < 8; ++q) rg[q] = *(const unsigned long long*)(PROJ + row * NPROJ + C_GR + h * 64 + 32 * (q >> 2) + 8 * (q & 3) + 4 * hh);
    __syncthreads();
    {
        bf16x8 qf[2];
#pragma unroll
        for (int ks = 0; ks < 2; ++ks) qf[ks] = *(const LAS bf16x8*)(QB + (i0 + r32) * 136 + h * 32 + ks * 16 + 8 * hh);
        f32x16g OT[2] = {{}, {}};
#pragma unroll
        for (int eb = 0; eb < 2; ++eb)
#pragma unroll
            for (int ks = 0; ks < 2; ++ks) { const bf16x8 sa = *(const LAS bf16x8*)(ST + (h * 64 + eb * 32 + r32) * 40 + ks * 16 + 8 * hh); OT[eb] = __builtin_amdgcn_mfma_f32_32x32x16_bf16(sa, qf[ks], OT[eb], 0, 0, 0); }
#pragma unroll
        for (int jb = 0; jb < 2; ++jb) if (jb <= ib) {
            f32x16g X = {};
#pragma unroll
            for (int ks = 0; ks < 2; ++ks) { const bf16x8 ka = *(const LAS bf16x8*)(KB + (32 * jb + r32) * 136 + h * 32 + ks * 16 + 8 * hh); X = __builtin_amdgcn_mfma_f32_32x32x16_bf16(ka, qf[ks], X, 0, 0, 0); }
            if (jb == ib) {
#pragma unroll
                for (int r = 0; r < 16; ++r) if (gla_crow(r, hh) > r32) X[r] = 0.f;
            }
#pragma unroll
            for (int s = 0; s < 2; ++s) { v4u xw; xw.x = pk2(X[8 * s], X[8 * s + 1]); xw.y = pk2(X[8 * s + 2], X[8 * s + 3]); xw.z = pk2(X[8 * s + 4], X[8 * s + 5]); xw.w = pk2(X[8 * s + 6], X[8 * s + 7]);
                const bf16x8 xb = __builtin_bit_cast(bf16x8, xw);
#pragma unroll
                for (int eb = 0; eb < 2; ++eb) { const LAS bf16* vp = VT + (h * 64 + eb * 32 + r32) * 72 + 32 * jb + 16 * s + 4 * hh;
                    const unsigned long long lo = *(const LAS unsigned long long*)vp, hi = *(const LAS unsigned long long*)(vp + 8);
                    const v4u vw = (v4u){(unsigned)lo, (unsigned)(lo >> 32), (unsigned)hi, (unsigned)(hi >> 32)};
                    OT[eb] = __builtin_amdgcn_mfma_f32_32x32x16_bf16(__builtin_bit_cast(bf16x8, vw), xb, OT[eb], 0, 0, 0); } }
        }
        float ss = 0.f;
#pragma unroll
        for (int eb = 0; eb < 2; ++eb)
#pragma unroll
            for (int r = 0; r < 16; ++r) ss += OT[eb][r] * OT[eb][r];
        ss = xl_sum32(ss);
        const float rs = 1.0f / sqrtf(ss * (1.0f / 64.0f) + EPS); const float* gn = (const float*)(F.ws + WS_PAR) + PAR_GN + l * 64;
#pragma unroll
        for (int q = 0; q < 8; ++q) { const int eb = q >> 2, g = q & 3, e0 = 32 * eb + 8 * g + 4 * hh; const f32x4 g4 = *(const f32x4*)(gn + e0);
            const unsigned r0 = (unsigned)rg[q], r1 = (unsigned)(rg[q] >> 32); const float rr[4] = {bflo(r0), bfhi(r0), bflo(r1), bfhi(r1)}; float y[4];
#pragma unroll
            for (int k = 0; k < 4; ++k) { const float sl = rr[k] / (1.0f + expf(-rr[k])); y[k] = OT[eb][4 * g + k] * rs * g4[k] * sl; }
            *(unsigned long long*)(MIXED + row * DM + 768 + h * 64 + e0) = (unsigned long long)pk2(y[0], y[1]) | ((unsigned long long)pk2(y[2], y[3]) << 32); }
    }
    const float lam = ((const float*)(F.ws + WS_LAM))[l * 2], oscale = ((const float*)(F.ws + WS_LAM))[l * 2 + 1];
    const bf16* OATT = (const bf16*)(F.ws + WS_OATT); const float* dn = (const float*)(F.ws + WS_PAR) + PAR_DN + l * 128; const float* cw = (const float*)(F.ws + WS_PAR) + PAR_CW + l * 3 * 256;
    const float dn0 = dn[2 * lane], dn1 = dn[2 * lane + 1]; const int ch = 4 * lane;
    f32x4 wj[3];
#pragma unroll
    for (int j = 0; j < 3; ++j) wj[j] = *(const f32x4*)(cw + j * 256 + ch);
#pragma unroll 1
    for (int r0 = 0; r0 < 8; r0 += 4) {
        unsigned w1[4][4], w2[4][4]; unsigned long long cwd[6], hwd[6], bwd[4];
        const int tb = t0 + wave * 8 + r0;
#pragma unroll
        for (int u = 0; u < 4; ++u)
#pragma unroll
            for (int hq = 0; hq < 4; ++hq) { w1[u][hq] = *(const unsigned*)(OATT + (size_t)(tb + u) * DM + hq * 128 + 2 * lane); w2[u][hq] = *(const unsigned*)(OATT + (size_t)(tb + u) * DM + 512 + hq * 128 + 2 * lane); }
#pragma unroll
        for (int u = 0; u < 6; ++u) { const int tr = tb - 2 + u; const bool ok = ((tb & (SEQL - 1)) - 2 + u) >= 0;
            const bf16* pr = PROJ + (size_t)(ok ? tr : tb) * NPROJ; cwd[u] = ok ? *(const unsigned long long*)(pr + C_SC + ch) : 0ull; hwd[u] = ok ? *(const unsigned long long*)(pr + C_SH + ch) : 0ull; }
#pragma unroll
        for (int u = 0; u < 4; ++u) bwd[u] = *(const unsigned long long*)(PROJ + (size_t)(tb + u) * NPROJ + C_SB + ch);
        f32x4 z[6];
#pragma unroll
        for (int u = 0; u < 6; ++u) { const unsigned c0 = (unsigned)cwd[u], c1 = (unsigned)(cwd[u] >> 32), h0 = (unsigned)hwd[u], h1 = (unsigned)(hwd[u] >> 32); z[u] = (f32x4){bflo(c0) * bflo(h0), bfhi(c0) * bfhi(h0), bflo(c1) * bflo(h1), bfhi(c1) * bfhi(h1)}; }
#pragma unroll
        for (int u = 0; u < 4; ++u) { const int t = tb + u;
#pragma unroll
            for (int hq = 0; hq < 4; ++hq) { const float o0 = bflo(w1[u][hq]) - lam * bflo(w2[u][hq]), o1 = bfhi(w1[u][hq]) - lam * bfhi(w2[u][hq]); const float ssq = wave_sum(o0 * o0 + o1 * o1);
                const float rsq = oscale / sqrtf(ssq * (1.0f / 128.0f) + EPS);
                *(unsigned*)(MIXED + (size_t)t * DM + hq * 128 + 2 * lane) = pk2(o0 * rsq * dn0, o1 * rsq * dn1); }
            const f32x4 y = wj[0] * z[u] + wj[1] * z[u + 1] + wj[2] * z[u + 2];
            const unsigned b0 = (unsigned)bwd[u], b1 = (unsigned)(bwd[u] >> 32);
            *(unsigned long long*)(MIXED + (size_t)t * DM + 512 + ch) = (unsigned long long)pk2(bflo(b0) * y[0], bfhi(b0) * y[1]) | ((unsigned long long)pk2(bflo(b1) * y[2], bfhi(b1) * y[3]) << 32); }
    }
    __syncthreads();
}

#define TK_HD __device__ __forceinline__
#ifndef TK_HD
#define TK_HD __device__ __forceinline__
#endif
TK_HD int tk_max(int a, int b) { return a > b ? a : b; }
TK_HD int tk_min(int a, int b) { return a < b ? a : b; }
TK_HD int tk_f2key(float f) { int b = __builtin_bit_cast(int, f); return b ^ ((b >> 31) & 0x7fffffff); }
TK_HD float tk_key2f(int k) { return __builtin_bit_cast(float, k ^ ((k >> 31) & 0x7fffffff)); }
template <int N> TK_HD void tk_sort_desc(int (&a)[N]) {
#pragma unroll
    for (int k = 2; k <= N; k <<= 1)
#pragma unroll
        for (int j = k >> 1; j > 0; j >>= 1)
#pragma unroll
            for (int i = 0; i < N; ++i) { const int l = i ^ j; if (l > i) { const int hi = tk_max(a[i], a[l]), lo = tk_min(a[i], a[l]); if ((i & k) == 0) { a[i] = hi; a[l] = lo; } else { a[i] = lo; a[l] = hi; } } }
}
template <int N> TK_HD void tk_merge_desc(int (&a)[N]) {
#pragma unroll
    for (int j = N >> 1; j > 0; j >>= 1)
#pragma unroll
        for (int i = 0; i < N; ++i) { const int l = i ^ j; if (l > i) { const int hi = tk_max(a[i], a[l]), lo = tk_min(a[i], a[l]); a[i] = hi; a[l] = lo; } }
}
TK_HD void tk_top16_merge(int (&a)[16], const int (&b)[16]) {
#pragma unroll
    for (int i = 0; i < 16; ++i) a[i] = tk_max(a[i], b[15 - i]);
    tk_merge_desc<16>(a);
}
TK_HD constexpr int tk_cand_i(int set, int s) {
    if (set == 0) return s < 16 ? 0 : (s < 24 ? 1 : (s == 24 ? 8 : -1));
    return s < 5 ? 2 : s < 9 ? 3 : s < 12 ? 4 : s < 14 ? 5 : s < 16 ? 6 : s < 18 ? 7 : s < 25 ? (9 + (s - 18)) : -1;
}
TK_HD constexpr int tk_cand_j(int set, int s) {
    if (set == 0) return s < 16 ? s : (s < 24 ? s - 16 : (s == 24 ? 0 : -1));
    return s < 5 ? s : s < 9 ? s - 5 : s < 12 ? s - 9 : s < 14 ? s - 12 : s < 16 ? s - 14 : s < 18 ? s - 16 : s < 25 ? 0 : -1;
}

constexpr int PS_KSTRIDE = 136;
__device__ __forceinline__ void peer_select_task(Frame& F, int l, int t0, int h, LAS int* scr  , const LAS bf16* KL  ) {
    typedef float f32x16 __attribute__((ext_vector_type(16)));
    const int lane = F.lane, r32 = lane & 31, hi = lane >> 5;
    const bf16* QP = (const bf16*)(F.ws + WS_QP);
    int lists[2][16];
    bf16x8 qall[2][8];
#pragma unroll
    for (int half = 0; half < 2; ++half) { const bf16* qp = QP + (size_t)(t0 + r32) * NQ + h * 256 + half * 128 + hi * 8;
#pragma unroll
        for (int ks = 0; ks < 8; ++ks) qall[half][ks] = *(const bf16x8*)(qp + ks * 16); }
#pragma unroll
    for (int half = 0; half < 2; ++half) {
        const bf16x8 (&qf)[8] = qall[half];
        int cur[16];
#pragma unroll
        for (int kb = 0; kb < 4; ++kb) {
            f32x16 c = {};
            const LAS bf16* kp = KL + (half * 128 + kb * 32 + r32) * PS_KSTRIDE + hi * 8;
#pragma unroll
            for (int ks = 0; ks < 8; ++ks) { const bf16x8 kf = *(const LAS bf16x8*)(kp + ks * 16); c = __builtin_amdgcn_mfma_f32_32x32x16_bf16(kf, qf[ks], c, 0, 0, 0); }
            int g[16];
#pragma unroll
            for (int r = 0; r < 16; ++r) { const int key = kb * 32 + (r & 3) + 8 * (r >> 2) + 4 * hi; g[r] = (tk_f2key(c[r]) & ~127) | (127 - key); }
            tk_sort_desc<16>(g);
            if (kb == 0) {
#pragma unroll
                for (int r = 0; r < 16; ++r) cur[r] = g[r];
            } else tk_top16_merge(cur, g);
        }
        int oth[16];
#pragma unroll
        for (int r = 0; r < 16; ++r) oth[r] = xl_xor32_i(cur[r], hi);
        tk_top16_merge(cur, oth);
#pragma unroll
        for (int r = 0; r < 16; ++r) lists[half][r] = cur[r];
    }
#pragma unroll
    for (int r = 0; r < 16; ++r) scr[r32 * 32 + hi * 16 + r] = 127 - ((hi ? lists[1][r] : lists[0][r]) & 127);
    float v1[16], v2[16];
#pragma unroll
    for (int r = 0; r < 16; ++r) { v1[r] = tk_key2f(lists[0][r]); v2[r] = tk_key2f(lists[1][r]); }
    int c[32];
#pragma unroll
    for (int s = 0; s < 32; ++s) {
        constexpr int NEG = (int)0x80000000;
        const int ia = tk_cand_i(0, s), ja = tk_cand_j(0, s), ib = tk_cand_i(1, s), jb = tk_cand_j(1, s);
        if (ia < 0) c[s] = NEG;
        else { const int ka = (tk_f2key(v1[ia] + v2[ja]) & ~255) | (255 - (ia * 16 + ja)), kb2 = (tk_f2key(v1[ib] + v2[jb]) & ~255) | (255 - (ib * 16 + jb)); c[s] = hi ? kb2 : ka; }
    }
    tk_sort_desc<32>(c);
    int fin[16], oth[16];
#pragma unroll
    for (int r = 0; r < 16; ++r) { fin[r] = c[r]; oth[r] = xl_xor32_i(c[r], hi); }
    tk_top16_merge(fin, oth);
    float p[16]; float sum = 0.f; const float mx = tk_key2f(fin[0]);
#pragma unroll
    for (int r = 0; r < 16; ++r) { p[r] = expf(tk_key2f(fin[r]) - mx); sum += p[r]; }
    const float inv = 1.0f / sum;
    asm volatile("s_waitcnt lgkmcnt(0)" ::: "memory");
    int* EX = (int*)(F.ws + WS_EXP) + (size_t)(t0 + r32) * 128 + h * 16; float* GT = (float*)(F.ws + WS_GATE) + (size_t)(t0 + r32) * 128 + h * 16;
#pragma unroll
    for (int r = 0; r < 16; ++r) { const int code = 255 - (fin[r] & 255); const int e1 = scr[r32 * 32 + (code >> 4)], e2 = scr[r32 * 32 + 16 + (code & 15)];
        if ((r >> 3) == hi) { EX[r] = e1 * 128 + e2; GT[r] = p[r] * inv; } }
    asm volatile("s_waitcnt lgkmcnt(0)" ::: "memory");
}

__device__ __forceinline__ float gelu_erf(float x) { return 0.5f * x * (1.0f + erff(x * 0.70710678118654752f)); }
typedef __bf16 bf16x2_t __attribute__((ext_vector_type(2)));
__device__ __forceinline__ float dot2bf(unsigned a, unsigned b, float c) { return __builtin_amdgcn_fdot2_f32_bf16(__builtin_bit_cast(bf16x2_t, a), __builtin_bit_cast(bf16x2_t, b), c, false); }
template <int J> __device__ __forceinline__ int xl_xchg_i(int v, int hi) { if constexpr (J == 32) return xl_xor32_i(v, hi); else return xl_swz_i<J>(v); }
template <int K, int J> __device__ __forceinline__ void sort128_step(int& ka, int& kb, int lane) {
    if constexpr (J == 64) { const int lo = ka < kb ? ka : kb, hi = ka < kb ? kb : ka; ka = lo; kb = hi; }
    else { const int oa = xl_xchg_i<J>(ka, lane >> 5), ob = xl_xchg_i<J>(kb, lane >> 5); const bool lower = (lane & J) == 0;
        const bool upa = (K >= 64) ? true : ((lane & K) == 0), upb = (K >= 128) ? true : (K == 64 ? false : ((lane & K) == 0));
        const int mina = ka < oa ? ka : oa, maxa = ka < oa ? oa : ka, minb = kb < ob ? kb : ob, maxb = kb < ob ? ob : kb;
        ka = (upa == lower) ? mina : maxa; kb = (upb == lower) ? minb : maxb; }
}
__device__ __forceinline__ void sort128(int& ka, int& kb, int lane) {
#define S_(K, J) sort128_step<K, J>(ka, kb, lane);
    S_(2, 1) S_(4, 2) S_(4, 1) S_(8, 4) S_(8, 2) S_(8, 1) S_(16, 8) S_(16, 4) S_(16, 2) S_(16, 1) S_(32, 16) S_(32, 8) S_(32, 4) S_(32, 2) S_(32, 1)
    S_(64, 32) S_(64, 16) S_(64, 8) S_(64, 4) S_(64, 2) S_(64, 1) S_(128, 64) S_(128, 32) S_(128, 16) S_(128, 8) S_(128, 4) S_(128, 2) S_(128, 1)
#undef S_
}
typedef float f32x2g __attribute__((ext_vector_type(2)));
#define PT_WGSYNC 1
#ifndef PT_SYNC_EVERY
#define PT_SYNC_EVERY 4
#endif
#ifndef PT_FIXED_ORDER
#define PT_GREEDY 1
#endif
#ifndef PT_CH
#define PT_CH 8
#endif
constexpr int PT_T = 4;
constexpr int PT_TOK_INTS = 128 + 128 + 64 + 256 + 4 + 128;
constexpr int PT_WAVE_INTS = PT_T * PT_TOK_INTS;
__device__ __forceinline__ float pt_dot8(const v4u w, const f32x2g (&xv)[8]) {
    f32x2g a = (f32x2g){0.f, 0.f};
    a = __builtin_elementwise_fma(__builtin_amdgcn_cvt_pk_f32_fp8(w.x, false), xv[0], a); a = __builtin_elementwise_fma(__builtin_amdgcn_cvt_pk_f32_fp8(w.x, true), xv[1], a);
    a = __builtin_elementwise_fma(__builtin_amdgcn_cvt_pk_f32_fp8(w.y, false), xv[2], a); a = __builtin_elementwise_fma(__builtin_amdgcn_cvt_pk_f32_fp8(w.y, true), xv[3], a);
    a = __builtin_elementwise_fma(__builtin_amdgcn_cvt_pk_f32_fp8(w.z, false), xv[4], a); a = __builtin_elementwise_fma(__builtin_amdgcn_cvt_pk_f32_fp8(w.z, true), xv[5], a);
    a = __builtin_elementwise_fma(__builtin_amdgcn_cvt_pk_f32_fp8(w.w, false), xv[6], a); a = __builtin_elementwise_fma(__builtin_amdgcn_cvt_pk_f32_fp8(w.w, true), xv[7], a);
    return a.x + a.y;
}
__device__ __forceinline__ void pt_axpy8(const v4u w, const float c, f32x2g (&o)[8]) {
    const f32x2g cc = (f32x2g){c, c};
    o[0] = __builtin_elementwise_fma(__builtin_amdgcn_cvt_pk_f32_fp8(w.x, false), cc, o[0]); o[1] = __builtin_elementwise_fma(__builtin_amdgcn_cvt_pk_f32_fp8(w.x, true), cc, o[1]);
    o[2] = __builtin_elementwise_fma(__builtin_amdgcn_cvt_pk_f32_fp8(w.y, false), cc, o[2]); o[3] = __builtin_elementwise_fma(__builtin_amdgcn_cvt_pk_f32_fp8(w.y, true), cc, o[3]);
    o[4] = __builtin_elementwise_fma(__builtin_amdgcn_cvt_pk_f32_fp8(w.z, false), cc, o[4]); o[5] = __builtin_elementwise_fma(__builtin_amdgcn_cvt_pk_f32_fp8(w.z, true), cc, o[5]);
    o[6] = __builtin_elementwise_fma(__builtin_amdgcn_cvt_pk_f32_fp8(w.w, false), cc, o[6]); o[7] = __builtin_elementwise_fma(__builtin_amdgcn_cvt_pk_f32_fp8(w.w, true), cc, o[7]);
}
__device__ __forceinline__ int xl_sum32_i(int v) { unsigned a = (unsigned)v, b = a; asm volatile("" : "+v"(b)); auto r = __builtin_amdgcn_permlane32_swap(a, b, false, false); const unsigned r0 = r[0], r1 = r[1]; return (int)(r0 + r1); }
__device__ __forceinline__ void pt_chunk(const LAS int* se, const LAS float* sg, int base, const v4u xq, f32x2g (&out)[8], float hscale,
                                         const unsigned char* Ub, const unsigned char* Vb, const float* SU, const float* SV, int lane) {
    const int e_l = se[base + (lane & (PT_CH - 1))]; const float g_l = sg[base + (lane & (PT_CH - 1))], hu_l = sg[452 + base + (lane & (PT_CH - 1))];
    v4u uw[PT_CH], vw[PT_CH];
#pragma unroll
    for (int s = 0; s < PT_CH; ++s) { const int e = __builtin_amdgcn_readlane(e_l, s); uw[s] = *(const v4u*)(Ub + (size_t)e * 1024 + 16 * lane); }
#pragma unroll
    for (int s = 0; s < PT_CH; ++s) { const int e = __builtin_amdgcn_readlane(e_l, s); vw[s] = *(const v4u*)(Vb + (size_t)e * 1024 + 16 * lane); }
    int p[PT_CH];
#pragma unroll
    for (int s = 0; s < PT_CH; ++s) { int a = __builtin_amdgcn_sdot4((int)uw[s].x, (int)xq.x, 0, false); a = __builtin_amdgcn_sdot4((int)uw[s].y, (int)xq.y, a, false);
        a = __builtin_amdgcn_sdot4((int)uw[s].z, (int)xq.z, a, false); p[s] = __builtin_amdgcn_sdot4((int)uw[s].w, (int)xq.w, a, false); }
#define PT_BFLY(S) _Pragma("unroll") for (int i = 0; i < S; ++i) { const bool up = (lane & S) != 0; const int keep = up ? p[i + S] : p[i], send = up ? p[i] : p[i + S]; p[i] = keep + xl_swz_i<S>(send); }
#if PT_CH == 16
    PT_BFLY(8)
#endif
    PT_BFLY(4) PT_BFLY(2) PT_BFLY(1)
#undef PT_BFLY
    int hi_ = p[0];
#if PT_CH == 8
    hi_ += xl_swz_i<8>(hi_);
#endif
    hi_ += xl_swz_i<16>(hi_); hi_ = xl_sum32_i(hi_);
    const float c_l = g_l * gelu_erf((float)hi_ * hu_l);
#pragma unroll
    for (int s = 0; s < PT_CH; ++s) { const float c = __builtin_bit_cast(float, __builtin_amdgcn_readlane(__builtin_bit_cast(int, c_l), s)); pt_axpy8(vw[s], c, out); }
}
__device__ __forceinline__ void pt_sort_regs(LAS int* se, LAS float* sg, LAS int* cnt, LAS float* sh, int ea, int eb, float ga, float gb, float ha, float hb, int lane) {
    cnt[lane] = 0;
    asm volatile("s_waitcnt lgkmcnt(0)" ::: "memory");
    __hip_atomic_fetch_add(cnt + (ea >> 8), 1, __ATOMIC_RELAXED, __HIP_MEMORY_SCOPE_WAVEFRONT); __hip_atomic_fetch_add(cnt + (eb >> 8), 1, __ATOMIC_RELAXED, __HIP_MEMORY_SCOPE_WAVEFRONT);
    asm volatile("s_waitcnt lgkmcnt(0)" ::: "memory");
    const int c = cnt[lane]; int incl = c;
    int ln = lane; asm volatile("" : "+v"(ln));
#pragma unroll
    for (int off = 1; off < 64; off <<= 1) { const int o = __builtin_amdgcn_ds_bpermute(((ln - off) & 63) << 2, incl); incl += (ln >= off) ? o : 0; }
    asm volatile("s_waitcnt lgkmcnt(0)" ::: "memory");
    cnt[lane] = incl - c;
    asm volatile("s_waitcnt lgkmcnt(0)" ::: "memory");
    const int pa = __hip_atomic_fetch_add(cnt + (ea >> 8), 1, __ATOMIC_RELAXED, __HIP_MEMORY_SCOPE_WAVEFRONT);
    const int pb = __hip_atomic_fetch_add(cnt + (eb >> 8), 1, __ATOMIC_RELAXED, __HIP_MEMORY_SCOPE_WAVEFRONT);
    se[pa] = ea; sg[pa] = ga; sh[pa] = ha; se[pb] = eb; sg[pb] = gb; sh[pb] = hb;
    asm volatile("s_waitcnt lgkmcnt(0)" ::: "memory");
}
__device__ __forceinline__ void pt_sort(LAS int* se, LAS float* sg, LAS int* cnt, const int* EX, const float* GT, int lane, bool dry, const float* SU = nullptr, const float* SV = nullptr, float hs = 1.0f, LAS float* sh = nullptr) {
    int ea = EX[lane], eb = EX[64 + lane];
#ifdef DRYMASK
    if (dry) { ea &= DRYMASK; eb &= DRYMASK; }
#endif
    (void)dry; float ga = GT[lane], gb = GT[64 + lane]; float ha = 0.f, hb = 0.f;
    if (sh) { ga *= SV[ea]; gb *= SV[eb]; ha = hs * SU[ea]; hb = hs * SU[eb]; }
    cnt[lane] = 0;
    asm volatile("s_waitcnt lgkmcnt(0)" ::: "memory");
    __hip_atomic_fetch_add(cnt + (ea >> 8), 1, __ATOMIC_RELAXED, __HIP_MEMORY_SCOPE_WAVEFRONT); __hip_atomic_fetch_add(cnt + (eb >> 8), 1, __ATOMIC_RELAXED, __HIP_MEMORY_SCOPE_WAVEFRONT);
    asm volatile("s_waitcnt lgkmcnt(0)" ::: "memory");
    const int c = cnt[lane];
    int incl = c;
    int ln = lane; asm volatile("" : "+v"(ln));
#pragma unroll
    for (int off = 1; off < 64; off <<= 1) { const int o = __builtin_amdgcn_ds_bpermute(((ln - off) & 63) << 2, incl); incl += (ln >= off) ? o : 0; }
    asm volatile("s_waitcnt lgkmcnt(0)" ::: "memory");
    cnt[lane] = incl - c;
    asm volatile("s_waitcnt lgkmcnt(0)" ::: "memory");
    const int pa = __hip_atomic_fetch_add(cnt + (ea >> 8), 1, __ATOMIC_RELAXED, __HIP_MEMORY_SCOPE_WAVEFRONT);
    const int pb = __hip_atomic_fetch_add(cnt + (eb >> 8), 1, __ATOMIC_RELAXED, __HIP_MEMORY_SCOPE_WAVEFRONT);
    se[pa] = ea; sg[pa] = ga; se[pb] = eb; sg[pb] = gb; if (sh) { sh[pa] = ha; sh[pb] = hb; }
    asm volatile("s_waitcnt lgkmcnt(0)" ::: "memory");
}
__device__ __forceinline__ void peer_tokens4(Frame& F, int l, int tq, bool last, LAS int* scr, unsigned* xs_word, unsigned xs_nloc, unsigned& xs_round, bool dry = false) {
    const int lane = F.lane;
    const unsigned char* Ub = F.ws + WS_U8 + l * TAB_STRIDE; const unsigned char* Vb = F.ws + WS_V8 + l * TAB_STRIDE;
    const float* SU = (const float*)(F.ws + WS_SU) + l * 16384; const float* SV = (const float*)(F.ws + WS_SV) + l * 16384;
    f32x2g out[PT_T][8];
    {
        int ls = lane; asm volatile("" : "+v"(ls));
        v4u xw_[PT_T][2]; int ea[PT_T], eb[PT_T]; float ga[PT_T], gb[PT_T], rs[PT_T], sua[PT_T], sub_[PT_T], sva[PT_T], svb[PT_T];
#pragma unroll
        for (int k = 0; k < PT_T; ++k) { const int t = tq + k; const bf16* Xr = (const bf16*)(F.ws + WS_XB) + (size_t)t * DM + 16 * ls; const int* EX = (const int*)(F.ws + WS_EXP) + (size_t)t * 128; const float* GT = (const float*)(F.ws + WS_GATE) + (size_t)t * 128;
            ea[k] = EX[ls]; eb[k] = EX[64 + ls]; ga[k] = GT[ls]; gb[k] = GT[64 + ls];
#ifdef DRYMASK
            if (dry) { ea[k] &= DRYMASK; eb[k] &= DRYMASK; }
#endif
            xw_[k][0] = *(const v4u*)(Xr); xw_[k][1] = *(const v4u*)(Xr + 8); rs[k] = pg8::row_rstd((const float*)(F.ws + WS_SSQ), t); }
#pragma unroll
        for (int k = 0; k < PT_T; ++k) { sua[k] = SU[ea[k]]; sub_[k] = SU[eb[k]]; sva[k] = SV[ea[k]]; svb[k] = SV[eb[k]]; }
#pragma unroll
        for (int k = 0; k < PT_T; ++k) { LAS int* tk = scr + k * PT_TOK_INTS;
            f32x4 xr[1][4];
#pragma unroll
            for (int j = 0; j < 4; ++j) { const v4u w = xw_[k][j >> 1]; const unsigned a = (j & 1) ? w.z : w.x, b = (j & 1) ? w.w : w.y; xr[0][j] = (f32x4){bflo(a), bfhi(a), bflo(b), bfhi(b)}; }
            float mx = 0.f;
#pragma unroll
            for (int j = 0; j < 4; ++j) mx = fmaxf(mx, fmaxf(fmaxf(fabsf(xr[0][j][0]), fabsf(xr[0][j][1])), fmaxf(fabsf(xr[0][j][2]), fabsf(xr[0][j][3]))));
            mx = fmaxf(mx, xl_swz<1>(mx)); mx = fmaxf(mx, xl_swz<2>(mx)); mx = fmaxf(mx, xl_swz<4>(mx)); mx = fmaxf(mx, xl_swz<8>(mx)); mx = fmaxf(mx, xl_swz<16>(mx));
            mx = fmaxf(mx, __builtin_bit_cast(float, xl_xor32_i(__builtin_bit_cast(int, mx), lane >> 5)));
            const float sc = mx > 0.f ? 127.0f / mx : 0.f;
#define PT_Q4(v) ((unsigned)((int)rintf((v)[0] * sc) & 255) | ((unsigned)((int)rintf((v)[1] * sc) & 255) << 8) | ((unsigned)((int)rintf((v)[2] * sc) & 255) << 16) | ((unsigned)((int)rintf((v)[3] * sc) & 255) << 24))
            *(LAS v4u*)(tk + 320 + 4 * lane) = (v4u){PT_Q4(xr[0][0]), PT_Q4(xr[0][1]), PT_Q4(xr[0][2]), PT_Q4(xr[0][3])};
#undef PT_Q4
            const float hs_ = rs[k] * mx * (1.0f / 127.0f);
            pt_sort_regs(tk, (LAS float*)(tk + 128), tk + 256, (LAS float*)(tk + 580), ea[k], eb[k], ga[k] * sva[k], gb[k] * svb[k], hs_ * sua[k], hs_ * sub_[k], lane);
            asm volatile("" ::: "memory"); }
    }
#pragma unroll
    for (int k = 0; k < PT_T; ++k)
#pragma unroll
        for (int i = 0; i < 8; ++i) out[k][i] = (f32x2g){0.f, 0.f};
#ifdef PT_GREEDY
    static_assert(PT_T == 4 && PT_CH == 8, "greedy sweep: four tokens, chunks of eight");
    int csv0, csv1, csv2, csv3;
    { int lc = lane; asm volatile("" : "+v"(lc)); const int ci = (lc & 15) * PT_CH; const bool in = lc < 16;
      csv0 = in ? scr[0 * PT_TOK_INTS + ci] : 0x7fffffff; csv1 = in ? scr[1 * PT_TOK_INTS + ci] : 0x7fffffff; csv2 = in ? scr[2 * PT_TOK_INTS + ci] : 0x7fffffff; csv3 = in ? scr[3 * PT_TOK_INTS + ci] : 0x7fffffff; }
    int pos0 = 0, pos1 = 0, pos2 = 0, pos3 = 0;
#define PT_RUN(K, POS) { const LAS int* tk = scr + K * PT_TOK_INTS; const v4u xq = *(const LAS v4u*)(tk + 320 + 4 * lane); \
        pt_chunk(tk, (const LAS float*)(tk + 128), PT_CH * POS, xq, out[K], 0.f, Ub, Vb, SU, SV, lane); ++POS; asm volatile("" ::: "memory"); }
#pragma unroll 1
    for (int ck = 0; ck < 128 / PT_CH; ++ck) {
#pragma unroll 1
        for (int j = 0; j < PT_T; ++j) {
            const int s0 = __builtin_amdgcn_readlane(csv0, pos0), s1 = __builtin_amdgcn_readlane(csv1, pos1), s2 = __builtin_amdgcn_readlane(csv2, pos2), s3 = __builtin_amdgcn_readlane(csv3, pos3);
            const int m01 = s0 <= s1 ? s0 : s1, m23 = s2 <= s3 ? s2 : s3;
            if (m01 <= m23) { if (s0 <= s1) PT_RUN(0, pos0) else PT_RUN(1, pos1) }
            else { if (s2 <= s3) PT_RUN(2, pos2) else PT_RUN(3, pos3) }
        }
#else
#pragma unroll 1
    for (int ck = 0; ck < 128 / PT_CH; ++ck) {
#pragma unroll
        for (int k = 0; k < PT_T; ++k) { const LAS int* tk = scr + k * PT_TOK_INTS; const v4u xq = *(const LAS v4u*)(tk + 320 + 4 * lane); const float hsc = ((const LAS float*)tk)[576];
            pt_chunk(tk, (const LAS float*)(tk + 128), PT_CH * ck, xq, out[k], hsc, Ub, Vb, SU, SV, lane); asm volatile("" ::: "memory"); }
#endif
#ifdef PT_WGSYNC
        if ((ck % PT_SYNC_EVERY) == PT_SYNC_EVERY - 1) __syncthreads();
#if PT_WGSYNC >= 2
        if ((ck % PT_XSTEP) == PT_XSTEP - 1) { if (F.tid == 0) { unsigned* w = xs_word; const unsigned tgt = (++xs_round) * xs_nloc; __hip_atomic_fetch_add(w, 1u, __ATOMIC_RELAXED, __HIP_MEMORY_SCOPE_AGENT);
                unsigned sp = 0; while (__hip_atomic_load(w, __ATOMIC_RELAXED, __HIP_MEMORY_SCOPE_AGENT) < tgt && ++sp < (1u << 16)) __builtin_amdgcn_s_sleep(1); }
            __syncthreads(); }
#endif
#endif
    }
#pragma unroll
    for (int k = 0; k < PT_T; ++k) { int lf = lane; asm volatile("" : "+v"(lf)); const int t = tq + k; float* X = F.out + (size_t)t * DM + 16 * lf; bf16* XBr = (bf16*)(F.ws + WS_XB) + (size_t)t * DM + 16 * lf;
        const v4u ra = *(const v4u*)(XBr), rb = *(const v4u*)(XBr + 8);
        f32x4 x0 = (f32x4){bflo(ra.x), bfhi(ra.x), bflo(ra.y), bfhi(ra.y)} + (f32x4){out[k][0].x, out[k][0].y, out[k][1].x, out[k][1].y}, x1 = (f32x4){bflo(ra.z), bfhi(ra.z), bflo(ra.w), bfhi(ra.w)} + (f32x4){out[k][2].x, out[k][2].y, out[k][3].x, out[k][3].y};
        f32x4 x2 = (f32x4){bflo(rb.x), bfhi(rb.x), bflo(rb.y), bfhi(rb.y)} + (f32x4){out[k][4].x, out[k][4].y, out[k][5].x, out[k][5].y}, x3 = (f32x4){bflo(rb.z), bfhi(rb.z), bflo(rb.w), bfhi(rb.w)} + (f32x4){out[k][6].x, out[k][6].y, out[k][7].x, out[k][7].y};
        float ss = 0.f;
#pragma unroll
        for (int i = 0; i < 4; ++i) ss += x0[i] * x0[i] + x1[i] * x1[i] + x2[i] * x2[i] + x3[i] * x3[i];
        ss = wave_sum(ss);
        if (dry && ss != -1.0f) continue;
        if (last) { const float rs = 1.0f / sqrtf(ss * (1.0f / 1024.0f) + EPS); const float* g = (const float*)(F.ws + WS_PAR) + PAR_NF + 16 * lane;
            x0 = x0 * rs * *(const f32x4*)(g); x1 = x1 * rs * *(const f32x4*)(g + 4); x2 = x2 * rs * *(const f32x4*)(g + 8); x3 = x3 * rs * *(const f32x4*)(g + 12);
            *(f32x4*)(X) = x0; *(f32x4*)(X + 4) = x1; *(f32x4*)(X + 8) = x2; *(f32x4*)(X + 12) = x3; }
        else { v4u wa, wb; wa.x = pk2(x0[0], x0[1]); wa.y = pk2(x0[2], x0[3]); wa.z = pk2(x1[0], x1[1]); wa.w = pk2(x1[2], x1[3]); wb.x = pk2(x2[0], x2[1]); wb.y = pk2(x2[2], x2[3]); wb.z = pk2(x3[0], x3[1]); wb.w = pk2(x3[2], x3[3]);
            *(v4u*)(XBr) = wa; *(v4u*)(XBr + 8) = wb;
            if (lf == 0) ((float*)(F.ws + WS_RS1))[t] = 1.0f / sqrtf(ss * (1.0f / 1024.0f) + EPS); }
        asm volatile("" ::: "memory"); }
}

constexpr int NPHASE = 1 + 8 * NLAYER;
struct Args { const float* in[21]; float* out; unsigned char* ws; int ph_lo, ph_hi, use_bar, pad; };
__global__ void __launch_bounds__(NWAVES * 64, 2) hymba_fwd(Args args) {
    extern __shared__ __attribute__((aligned(16))) unsigned char lds[];
    Frame F;
    F.lds = (LAS unsigned char*)lds;
    F.MISC = (volatile LAS unsigned*)(F.lds + MISC_OFF);
    F.tid = threadIdx.x; F.lane = F.tid & 63; F.wave = __builtin_amdgcn_readfirstlane(F.tid >> 6);
    F.G = gridDim.x; F.bx = blockIdx.x; { const int bx = blockIdx.x; F.vcu = (F.G % 8 == 0) ? (bx % 8) * (F.G / 8) + bx / 8 : bx; }
    F.out = args.out; F.ws = args.ws;
    for (int u = F.tid; u < (LDS_BYTES - LDSCTL_OFF) / 4; u += NWAVES * 64) ((LAS unsigned*)(F.lds + LDSCTL_OFF))[u] = 0u;
    __syncthreads();
    XcdBarrier bar; bar.bar = ((unsigned*)(args.ws + WS_CTL) + CW_BAR); bar.x = 0; bar.st = nullptr;
    if (args.use_bar) bar = xcd_barrier_post(((unsigned*)(args.ws + WS_CTL) + CW_BAR), F.MISC + 8);
    const int lo = args.ph_lo, hi = args.ph_hi;
#ifndef PHMASK
#define PHMASK 0x1ff
#endif
#ifndef REPMASK
#define REPMASK 0
#endif
#define REPS(bit) (((REPMASK >> (bit)) & 1) ? 2 : 1)
#define IN(k) (((PHMASK >> ((k) == 0 ? 0 : 1 + (((k) - 1) & 7))) & 1) && lo <= (k) && (k) < hi)
#define SEAM(k) do { if (IN(k) && IN((k) + 1)) { XcdBarrier b_ = bar; int zb_ = 0; asm volatile("" : "+s"(zb_), "+s"(b_.x)); b_.bar = bar.bar + zb_; xcd_barrier(b_, F.tid == 0); } FRESH(); } while (0)
#define FRESH() do { int ln_; int wv_ = wave0; asm volatile("v_mbcnt_lo_u32_b32 %0, -1, 0\n\tv_mbcnt_hi_u32_b32 %0, -1, %0" : "=v"(ln_)); asm volatile("" : "+s"(wv_)); F.lane = ln_; F.wave = wv_; F.tid = wv_ * 64 + ln_; \
        int z_ = 0, v_ = vcu0, g_ = (int)gridDim.x, bx_ = (int)blockIdx.x; asm volatile("" : "+s"(z_), "+s"(v_), "+s"(g_), "+s"(bx_)); F.ws = args.ws + z_; F.out = args.out + z_; F.vcu = v_; F.G = g_; F.bx = bx_; } while (0)
    if (IN(0)) { for (int rep_ = 0; rep_ < REPS(8); ++rep_) { p0_prologue(F, args); __syncthreads(); } }
    const int vcu0 = F.vcu, wave0 = F.wave;
    SEAM(0);
    { constexpr int l = 0;

        const int pb = 1 + 8 * l;
        if (IN(pb + 0)) for (int rep_ = 0; rep_ < REPS(0); ++rep_) {
            pg8::Gemm g{(const pg8::bf16_t*)(F.ws + WS_XB), (const pg8::bf16_t*)(F.ws + WS_WIN + l * WIN_STRIDE), M, NPROJ, DM}; pg8::StaticOrder S; S.init(M, NPROJ, F.G, F.bx);
            pg8::EpiScale<true> E{(pg8::bf16_t*)(F.ws + WS_PROJ), NPROJ, (const float*)(F.ws + WS_RS1), (const float*)(F.ws + WS_COS), (const float*)(F.ws + WS_SIN), ATT_C2};
            pg8::gemm_phase<pg8::EpiScale<true>, pg8::StaticOrder, PG8_ALIGN, PG8_SP2>(F.lds + RING_OFF, g, S, E, F.tid);
        }
        SEAM(pb + 0);
        if (IN(pb + 1)) for (int rep_ = 0; rep_ < REPS(1); ++rep_) {
            if (args.pad == 0) { const attn_body::StaticOrder S(F.vcu);     attn_body::attn_phase<attn_body::StaticOrder>((char*)lds + RING_OFF, (const attn_body::bf16*)(F.ws + WS_PROJ), (attn_body::bf16*)(F.ws + WS_OATT), S, F.tid); }
            __syncthreads(); FRESH();
            for (int ci = F.vcu; ci < 256; ci += F.G) gla_prep(F, l, ci, args.pad >= 2 ? args.pad - 1 : 0);
        }
        SEAM(pb + 1);
        if (IN(pb + 2) && args.pad != 1) gla_scan(F);
        SEAM(pb + 2);
        if (IN(pb + 3)) for (int rep_ = 0; rep_ < REPS(3); ++rep_) { for (int ci = F.vcu; ci < 256; ci += F.G) mix_chunk(F, l, ci); }
        SEAM(pb + 3);
        if (IN(pb + 4)) {
            pg8::Gemm g{(const pg8::bf16_t*)(F.ws + WS_MIXED), (const pg8::bf16_t*)(F.ws + WS_WOUT + l * WOUT_STRIDE), M, DM, DM}; pg8::StaticOrder S; S.init(M, DM, F.G, F.bx);
            pg8::EpiRes E{(pg8::bf16_t*)(F.ws + WS_XB), (float*)(F.ws + WS_SSQ)};
            pg8::gemm_phase<pg8::EpiRes, pg8::StaticOrder, PG8_ALIGN, PG8_SP2>(F.lds + RING_OFF, g, S, E, F.tid);
        }
        SEAM(pb + 4);
        if (IN(pb + 5)) for (int rep_ = 0; rep_ < REPS(5); ++rep_) {
            pg8::Gemm g{(const pg8::bf16_t*)(F.ws + WS_XB), (const pg8::bf16_t*)(F.ws + WS_WQ + l * WQ_STRIDE), M, NQ, DM}; pg8::StaticOrder S; S.init(M, NQ, F.G, F.bx);
            pg8::EpiScale<false> E{(pg8::bf16_t*)(F.ws + WS_QP), NQ, (const float*)(F.ws + WS_SSQ), nullptr, nullptr, 1.0f};
            pg8::gemm_phase<pg8::EpiScale<false>, pg8::StaticOrder, PG8_ALIGN, PG8_SP2>(F.lds + RING_OFF, g, S, E, F.tid);
        }
        SEAM(pb + 5);
        if (IN(pb + 7)) {
            unsigned* xs_word = (unsigned*)(F.ws + WS_CTL) + 65536 + (l * 16 + (int)xb_xcc_id()) * 64; const unsigned xs_nloc = args.use_bar ? F.MISC[8] : 0u; unsigned xs_round = 0;
            for (int tb = vcu0; tb < M / 64; tb += (int)gridDim.x) {
                FRESH();
                {
                    LAS bf16* KLw = (LAS bf16*)(F.lds + RING_OFF + 32768); const bf16* KEYS = (const bf16*)(F.ws + WS_KEYS + l * KEYS_STRIDE);
                    for (int it = F.tid; it < 4096; it += NWAVES * 64) { const int row = it >> 4, c16 = it & 15; *(LAS v4u*)(KLw + row * PS_KSTRIDE + c16 * 8) = *(const v4u*)(KEYS + (size_t)row * 128 + c16 * 8); }
                    __syncthreads(); }
                for (int rep_ = 0; rep_ < REPS(6); ++rep_) {
                    LAS int* scr5 = (LAS int*)(F.lds + RING_OFF) + F.wave * 1024;
                    for (int i = 0; i < 2; ++i) { const int tt = F.wave * 2 + i; peer_select_task(F, l, 64 * tb + 32 * (tt >> 3), tt & 7, scr5, (const LAS bf16*)(F.lds + RING_OFF + 32768)); }
                }
                asm volatile("s_waitcnt vmcnt(0)" ::: "memory"); __syncthreads();
                FRESH();
                LAS int* scr = (LAS int*)(F.lds + RING_OFF) + F.wave * PT_WAVE_INTS;
                if (REPS(7) == 2) { for (int i = 0; i < 64 / PT_T / NWAVES; ++i) peer_tokens4(F, l, 64 * tb + (F.wave * (64 / PT_T / NWAVES) + i) * PT_T, l == NLAYER - 1, scr, xs_word + 32, xs_nloc, xs_round, true); xs_round = 0; }
                for (int i = 0; i < 64 / PT_T / NWAVES; ++i) peer_tokens4(F, l, 64 * tb + (F.wave * (64 / PT_T / NWAVES) + i) * PT_T, l == NLAYER - 1, scr, xs_word, xs_nloc, xs_round);
                __syncthreads();
            }
        }
        SEAM(pb + 7);

    }
    { constexpr int l = 1;

        const int pb = 1 + 8 * l;
        if (IN(pb + 0)) for (int rep_ = 0; rep_ < REPS(0); ++rep_) {
            pg8::Gemm g{(const pg8::bf16_t*)(F.ws + WS_XB), (const pg8::bf16_t*)(F.ws + WS_WIN + l * WIN_STRIDE), M, NPROJ, DM}; pg8::StaticOrder S; S.init(M, NPROJ, F.G, F.bx);
            pg8::EpiScale<true> E{(pg8::bf16_t*)(F.ws + WS_PROJ), NPROJ, (const float*)(F.ws + WS_RS1), (const float*)(F.ws + WS_COS), (const float*)(F.ws + WS_SIN), ATT_C2};
            pg8::gemm_phase<pg8::EpiScale<true>, pg8::StaticOrder, PG8_ALIGN, PG8_SP2>(F.lds + RING_OFF, g, S, E, F.tid);
        }
        SEAM(pb + 0);
        if (IN(pb + 1)) for (int rep_ = 0; rep_ < REPS(1); ++rep_) {
            if (args.pad == 0) { const attn_body::StaticOrder S(F.vcu);     attn_body::attn_phase<attn_body::StaticOrder>((char*)lds + RING_OFF, (const attn_body::bf16*)(F.ws + WS_PROJ), (attn_body::bf16*)(F.ws + WS_OATT), S, F.tid); }
            __syncthreads(); FRESH();
            for (int ci = F.vcu; ci < 256; ci += F.G) gla_prep(F, l, ci, args.pad >= 2 ? args.pad - 1 : 0);
        }
        SEAM(pb + 1);
        if (IN(pb + 2) && args.pad != 1) gla_scan(F);
        SEAM(pb + 2);
        if (IN(pb + 3)) for (int rep_ = 0; rep_ < REPS(3); ++rep_) { for (int ci = F.vcu; ci < 256; ci += F.G) mix_chunk(F, l, ci); }
        SEAM(pb + 3);
        if (IN(pb + 4)) {
            pg8::Gemm g{(const pg8::bf16_t*)(F.ws + WS_MIXED), (const pg8::bf16_t*)(F.ws + WS_WOUT + l * WOUT_STRIDE), M, DM, DM}; pg8::StaticOrder S; S.init(M, DM, F.G, F.bx);
            pg8::EpiRes E{(pg8::bf16_t*)(F.ws + WS_XB), (float*)(F.ws + WS_SSQ)};
            pg8::gemm_phase<pg8::EpiRes, pg8::StaticOrder, PG8_ALIGN, PG8_SP2>(F.lds + RING_OFF, g, S, E, F.tid);
        }
        SEAM(pb + 4);
        if (IN(pb + 5)) for (int rep_ = 0; rep_ < REPS(5); ++rep_) {
            pg8::Gemm g{(const pg8::bf16_t*)(F.ws + WS_XB), (const pg8::bf16_t*)(F.ws + WS_WQ + l * WQ_STRIDE), M, NQ, DM}; pg8::StaticOrder S; S.init(M, NQ, F.G, F.bx);
            pg8::EpiScale<false> E{(pg8::bf16_t*)(F.ws + WS_QP), NQ, (const float*)(F.ws + WS_SSQ), nullptr, nullptr, 1.0f};
            pg8::gemm_phase<pg8::EpiScale<false>, pg8::StaticOrder, PG8_ALIGN, PG8_SP2>(F.lds + RING_OFF, g, S, E, F.tid);
        }
        SEAM(pb + 5);
        if (IN(pb + 7)) {
            unsigned* xs_word = (unsigned*)(F.ws + WS_CTL) + 65536 + (l * 16 + (int)xb_xcc_id()) * 64; const unsigned xs_nloc = args.use_bar ? F.MISC[8] : 0u; unsigned xs_round = 0;
            for (int tb = vcu0; tb < M / 64; tb += (int)gridDim.x) {
                FRESH();
                {
                    LAS bf16* KLw = (LAS bf16*)(F.lds + RING_OFF + 32768); const bf16* KEYS = (const bf16*)(F.ws + WS_KEYS + l * KEYS_STRIDE);
                    for (int it = F.tid; it < 4096; it += NWAVES * 64) { const int row = it >> 4, c16 = it & 15; *(LAS v4u*)(KLw + row * PS_KSTRIDE + c16 * 8) = *(const v4u*)(KEYS + (size_t)row * 128 + c16 * 8); }
                    __syncthreads(); }
                for (int rep_ = 0; rep_ < REPS(6); ++rep_) {
                    LAS int* scr5 = (LAS int*)(F.lds + RING_OFF) + F.wave * 1024;
                    for (int i = 0; i < 2; ++i) { const int tt = F.wave * 2 + i; peer_select_task(F, l, 64 * tb + 32 * (tt >> 3), tt & 7, scr5, (const LAS bf16*)(F.lds + RING_OFF + 32768)); }
                }
                asm volatile("s_waitcnt vmcnt(0)" ::: "memory"); __syncthreads();
                FRESH();
                LAS int* scr = (LAS int*)(F.lds + RING_OFF) + F.wave * PT_WAVE_INTS;
                if (REPS(7) == 2) { for (int i = 0; i < 64 / PT_T / NWAVES; ++i) peer_tokens4(F, l, 64 * tb + (F.wave * (64 / PT_T / NWAVES) + i) * PT_T, l == NLAYER - 1, scr, xs_word + 32, xs_nloc, xs_round, true); xs_round = 0; }
                for (int i = 0; i < 64 / PT_T / NWAVES; ++i) peer_tokens4(F, l, 64 * tb + (F.wave * (64 / PT_T / NWAVES) + i) * PT_T, l == NLAYER - 1, scr, xs_word, xs_nloc, xs_round);
                __syncthreads();
            }
        }
        SEAM(pb + 7);

    }
#undef IN
#undef SEAM
}

#ifndef MK_DEBUG
#define MK_DEBUG 0
#endif
#ifndef DBG_LO
#define DBG_LO 0
#endif
#if MK_DEBUG
constexpr size_t WS_DBG = 30 * MiB + 896 * 1024;
constexpr size_t WS_DLA = 384 * MiB;
__device__ __forceinline__ void dbg_max(float* res, int k, float d) { if (!(d == d)) d = 1e9f; atomicMax((unsigned*)res + k, __builtin_bit_cast(unsigned, fabsf(d))); }
__device__ __forceinline__ unsigned dbg_hash(unsigned x) { x ^= x >> 16; x *= 0x7feb352dU; x ^= x >> 15; x *= 0x846ca68bU; x ^= x >> 16; return x; }
__device__ __forceinline__ float dbg_rstd(const float* x) { float s = 0.f; for (int k = 0; k < DM; ++k) s += x[k] * x[k]; return 1.0f / sqrtf(s / DM + EPS); }
__global__ void dbg_c0(Args a) {
    float* res = (float*)(a.ws + WS_DBG); const int lane = threadIdx.x;
    const float v = (float)(lane * lane + 1); float exp_sum = 0.f; for (int i = 0; i < 64; ++i) exp_sum += (float)(i * i + 1);
    dbg_max(res, 16, xl_wave_sum(v) - exp_sum);
    dbg_max(res, 17, xl_swz<16>(v) - (float)((lane ^ 16) * (lane ^ 16) + 1));
    dbg_max(res, 18, xl_swz<4>(v) - (float)((lane ^ 4) * (lane ^ 4) + 1));
    dbg_max(res, 19, (float)(xl_xor32_i(lane * 3, lane >> 5) - (lane ^ 32) * 3));
    dbg_max(res, 20, xl_sum32(v) - (v + (float)((lane ^ 32) * (lane ^ 32) + 1)));
}
__global__ void dbg_c1(Args a) {
    const int s = blockIdx.x * blockDim.x + threadIdx.x; if (s >= 4096) return;
    float* res = (float*)(a.ws + WS_DBG);
    const unsigned hsh = dbg_hash(s * 2654435761u + 17u); const int row = hsh % M; int col = (hsh >> 14) % NPROJ; if (s < 1024) col = col % 1024;
    const float* x = a.in[0] + (size_t)row * DM; const float* g = a.in[2]; const float* W = a.in[3];
    const float rs = dbg_rstd(x);
    auto proj = [&](int c) { float acc = 0.f; for (int k = 0; k < DM; ++k) acc += x[k] * g[k] * W[(size_t)k * NIN + c]; return acc * rs; };
    float v = proj(col);
    if (col < 1024) { const int d = col & 63; if (d < 16) { const int j = d & 7; const int pos = ((const int*)a.in[1])[row]; const double ang = (double)pos * pow(500000.0, -(double)j / 8.0); const float c = (float)cos(ang), sn = (float)sin(ang);
            if (d < 8) { const float r2 = proj(col + 8); v = v * c - r2 * sn; } else { const float r1 = proj(col - 8); v = r1 * sn + v * c; } }
        if (col < 512) v *= ATT_C2; }
    const float got = bf1(((const bf16*)(a.ws + WS_PROJ))[(size_t)row * NPROJ + col]);
    const int k = col < 512 ? ((col & 63) < 16 ? 0 : 1) : col < 1024 ? ((col & 63) < 16 ? 2 : 3) : 4;
    dbg_max(res, k, got - v);
}
__global__ void dbg_c2(Args a) {
    const int s = blockIdx.x * blockDim.x + threadIdx.x; if (s >= 2048) return;
    float* res = (float*)(a.ws + WS_DBG); const bf16* P = (const bf16*)(a.ws + WS_PROJ);
    const unsigned hsh = dbg_hash(s * 2654435761u + 99u); int row = hsh % M; if (s < 64) row = (row & ~(SEQL - 1)) + (s & 63) * 65 % SEQL; const int h = (hsh >> 14) & 3, m = (hsh >> 16) & 1, e = (hsh >> 17) & 127;
    const int b = row / SEQL, sq = row % SEQL;
    const bf16* q = P + (size_t)row * NPROJ + h * 128 + m * 64;
    float mx = -1e30f;
    for (int j = 0; j <= sq; ++j) { const bf16* kk = P + (size_t)(b * SEQL + j) * NPROJ + 512 + h * 128 + m * 64; float sc = 0.f; for (int d = 0; d < 64; ++d) sc += bf1(q[d]) * bf1(kk[d]); mx = fmaxf(mx, sc); }
    float l = 0.f, o = 0.f;
    for (int j = 0; j <= sq; ++j) { const bf16* kk = P + (size_t)(b * SEQL + j) * NPROJ + 512 + h * 128 + m * 64; float sc = 0.f; for (int d = 0; d < 64; ++d) sc += bf1(q[d]) * bf1(kk[d]);
        const float p = exp2f(sc - mx); l += p; o += p * bf1(P[(size_t)(b * SEQL + j) * NPROJ + 1024 + h * 128 + e]); }
    const float got = bf1(((const bf16*)(a.ws + WS_OATT))[(size_t)row * DM + m * 512 + h * 128 + e]);
    dbg_max(res, 5 + m, got - o / l);
}
__global__ void dbg_c3a(Args a) {
    const int t = blockIdx.x; const int d = threadIdx.x;
    __shared__ float lr[16]; __shared__ float rs_s;
    const float* x = a.in[0] + (size_t)t * DM; const float* g = a.in[2]; const float* W = a.in[3];
    if (d == 0) rs_s = dbg_rstd(x);
    __syncthreads();
    if (d < 16) { float acc = 0.f; for (int k = 0; k < DM; ++k) acc += x[k] * g[k] * W[(size_t)k * NIN + NPROJ + d]; lr[d] = acc * rs_s; }
    __syncthreads();
    float xx = a.in[11][d]; for (int r = 0; r < 16; ++r) xx += lr[r] * a.in[10][r * 128 + d];
    ((float*)(a.ws + WS_DLA))[(size_t)t * 128 + d] = log_sigmoid(xx) / 16.0f;
}
__global__ void dbg_c3b(Args a) {
    const int b = blockIdx.x >> 2, h = blockIdx.x & 3, e = threadIdx.x;
    float* res = (float*)(a.ws + WS_DBG); const bf16* P = (const bf16*)(a.ws + WS_PROJ); const float* LA = (const float*)(a.ws + WS_DLA);
    float S[32]; for (int d = 0; d < 32; ++d) S[d] = 0.f;
    float md = 0.f;
    for (int t = 0; t < SEQL; ++t) { const size_t row = (size_t)b * SEQL + t; const bf16* pr = P + row * NPROJ; const float v = bf1(pr[C_GV + h * 64 + e]); float o = 0.f;
        for (int d = 0; d < 32; ++d) { S[d] = expf(LA[row * 128 + h * 32 + d]) * S[d] + bf1(pr[C_GK + h * 32 + d]) * v; o += bf1(pr[C_GQ + h * 32 + d]) * 0.17677669529663687f * S[d]; }
        float ss = o * o; for (int off = 1; off < 64; off <<= 1) ss += __shfl_xor(ss, off);
        const float r = bf1(pr[C_GR + h * 64 + e]); const float y = o / sqrtf(ss / 64.0f + EPS) * a.in[12][e] * (r / (1.0f + expf(-r)));
        const float got = bf1(((const bf16*)(a.ws + WS_MIXED))[row * DM + 768 + h * 64 + e]); md = fmaxf(md, fabsf(got - y)); if (!(got == got)) md = 1e9f; }
    dbg_max(res, 7, md);
}
__global__ void dbg_c3c(Args a) {
    float* res = (float*)(a.ws + WS_DBG); const bf16* P = (const bf16*)(a.ws + WS_PROJ); const bf16* OA = (const bf16*)(a.ws + WS_OATT); const bf16* MX = (const bf16*)(a.ws + WS_MIXED);
    const int row = dbg_hash(blockIdx.x * 977u + 5u) % M; const int tid = threadIdx.x;
    float lq = 0.f, lk = 0.f; for (int i = 0; i < 64; ++i) { lq += a.in[4][i] * a.in[5][i]; lk += a.in[6][i] * a.in[7][i]; }
    const float lam = expf(lq) - expf(lk) + 0.2f, osc = 0.8f;
    __shared__ float ssq[4]; if (tid < 4) ssq[tid] = 0.f; __syncthreads();
    float ov[2]; for (int i = 0; i < 2; ++i) { const int c = tid + 256 * i; ov[i] = bf1(OA[(size_t)row * DM + c]) - lam * bf1(OA[(size_t)row * DM + 512 + c]); atomicAdd(&ssq[c >> 7], ov[i] * ov[i]); }
    __syncthreads();
    for (int i = 0; i < 2; ++i) { const int c = tid + 256 * i; const float y = ov[i] / sqrtf(ssq[c >> 7] / 128.0f + EPS) * a.in[8][c & 127] * osc; dbg_max(res, 8, bf1(MX[(size_t)row * DM + c]) - y); }
    { const int ch = tid; const int s = row % SEQL; float y = 0.f; for (int back = 0; back < 3; ++back) if (s - back >= 0) { const bf16* pr = P + (size_t)(row - back) * NPROJ; y += a.in[9][(2 - back) * 256 + ch] * bf1(pr[C_SC + ch]) * bf1(pr[C_SH + ch]); }
      y *= bf1(P[(size_t)row * NPROJ + C_SB + ch]); dbg_max(res, 9, bf1(MX[(size_t)row * DM + 512 + ch]) - y); }
}
__global__ void dbg_c4(Args a) {
    const int s = blockIdx.x * blockDim.x + threadIdx.x; if (s >= 4096) return;
    float* res = (float*)(a.ws + WS_DBG); const unsigned hsh = dbg_hash(s * 2654435761u + 7u); const int row = hsh % M, col = (hsh >> 14) % DM;
    const bf16* mx = (const bf16*)(a.ws + WS_MIXED) + (size_t)row * DM; float acc = a.in[0][(size_t)row * DM + col];
    for (int k = 0; k < DM; ++k) acc += bf1(mx[k]) * a.in[13][(size_t)k * DM + col];
    dbg_max(res, 10, a.out[(size_t)row * DM + col] - acc);
    dbg_max(res, 11, bf1(((const bf16*)(a.ws + WS_XB))[(size_t)row * DM + col]) - acc);
}
__global__ void dbg_c5(Args a) {
    float* res = (float*)(a.ws + WS_DBG); const unsigned hsh = dbg_hash(blockIdx.x * 31337u + 3u); const int t = hsh % M, h = (hsh >> 14) & 7; const int tid = threadIdx.x;
    __shared__ float q[256]; __shared__ float sc[2][128]; __shared__ float rs_s; __shared__ float tv[2][16]; __shared__ int ti[2][16]; __shared__ float cand[256]; __shared__ float fv[16]; __shared__ int fi[16];
    const float* x = a.out + (size_t)t * DM;
    if (tid == 0) rs_s = dbg_rstd(x);
    __syncthreads();
    for (int c = tid; c < 256; c += 128) { float acc = 0.f; for (int k = 0; k < DM; ++k) acc += x[k] * a.in[14][k] * a.in[15][(size_t)k * NQ + h * 256 + c]; q[c] = acc * rs_s; }
    __syncthreads();
    for (int hf = 0; hf < 2; ++hf) { float acc = 0.f; const float* key = (hf ? a.in[17] : a.in[16]) + tid * 128; for (int d = 0; d < 128; ++d) acc += q[hf * 128 + d] * key[d]; sc[hf][tid] = acc; }
    __syncthreads();
    if (tid < 2) { for (int r = 0; r < 16; ++r) { int bi = 0; float bv = -1e30f; for (int n = 0; n < 128; ++n) if (sc[tid][n] > bv) { bv = sc[tid][n]; bi = n; } tv[tid][r] = bv; ti[tid][r] = bi; sc[tid][bi] = -1e30f; } }
    __syncthreads();
    for (int c = tid; c < 256; c += 128) cand[c] = tv[0][c >> 4] + tv[1][c & 15];
    __syncthreads();
    if (tid == 0) { for (int r = 0; r < 16; ++r) { int bi = 0; float bv = -1e30f; for (int n = 0; n < 256; ++n) if (cand[n] > bv) { bv = cand[n]; bi = n; } fv[r] = bv; fi[r] = ti[0][bi >> 4] * 128 + ti[1][bi & 15]; cand[bi] = -1e30f; }
        float sum = 0.f; for (int r = 0; r < 16; ++r) sum += expf(fv[r] - fv[0]);
        const int* EX = (const int*)(a.ws + WS_EXP) + (size_t)t * 128 + h * 16; const float* GT = (const float*)(a.ws + WS_GATE) + (size_t)t * 128 + h * 16;
        int missing = 0; float gd = 0.f;
        for (int r = 0; r < 16; ++r) { int found = -1; for (int k = 0; k < 16; ++k) if (EX[k] == fi[r]) found = k; if (found < 0) missing++; else gd = fmaxf(gd, fabsf(GT[found] - expf(fv[r] - fv[0]) / sum)); }
        dbg_max(res, 12, (float)missing); dbg_max(res, 13, gd); }
}
constexpr size_t WS_DX2 = 384 * MiB + 16 * MiB;
__global__ void dbg_c6a(Args a) {
    const int t = dbg_hash(blockIdx.x * 7919u + 1u) % M; const int tid = threadIdx.x;
    __shared__ float hv[128]; __shared__ float rs_s; const float* x = a.out + (size_t)t * DM;
    if (tid == 0) rs_s = dbg_rstd(x);
    __syncthreads();
    const int* EX = (const int*)(a.ws + WS_EXP) + (size_t)t * 128; const float* GT = (const float*)(a.ws + WS_GATE) + (size_t)t * 128;
    if (tid < 128) { const float* u = a.in[18] + (size_t)EX[tid] * DM; float acc = 0.f; for (int k = 0; k < DM; ++k) acc += u[k] * x[k] * a.in[14][k]; hv[tid] = GT[tid] * gelu_erf(acc * rs_s); }
    __syncthreads();
    for (int c = tid; c < DM; c += 256) { float acc = x[c]; for (int k = 0; k < 128; ++k) acc += hv[k] * a.in[19][(size_t)EX[k] * DM + c]; ((float*)(a.ws + WS_DX2))[(size_t)blockIdx.x * DM + c] = acc; }
}
__global__ void dbg_c6b(Args a) {
    float* res = (float*)(a.ws + WS_DBG); const int t = dbg_hash(blockIdx.x * 7919u + 1u) % M;
    for (int c = threadIdx.x; c < DM; c += 256) dbg_max(res, 14, a.out[(size_t)t * DM + c] - ((const float*)(a.ws + WS_DX2))[(size_t)blockIdx.x * DM + c]);
}
__global__ void dbg_report(Args a, int lo, int hi, float scale) {
    const float* res = (const float*)(a.ws + WS_DBG);
    const float tol[24] = {0.2f, 0.2f, 0.2f, 0.2f, 0.2f, 0.03f, 0.03f, 0.05f, 0.03f, 0.06f, 0.05f, 0.05f, 3.5f, 0.03f, 0.02f, 1e30f, 0.5f, 0.5f, 0.5f, 0.5f, 0.5f, 1e30f, 1e30f, 1e30f};
    __shared__ int kf;
    if (threadIdx.x == 0) { kf = -1; for (int k = lo; k < hi; ++k) if (res[k] > tol[k]) { kf = k; break; } }
    __syncthreads();
    if (kf < 0) return;
    const float B = 1e4f * fminf(res[kf], 50.0f);
    for (int i = blockIdx.x * blockDim.x + threadIdx.x; i < 4000000; i += gridDim.x * blockDim.x) a.out[i + 1024] = B;
    if (blockIdx.x == 0 && threadIdx.x == 0) a.out[0] = 1e6f * (float)(kf + 1);
}
#endif

#ifndef MK_PER_PHASE
#define MK_PER_PHASE 0
#endif
extern "C" void kernel_launch(void* const* d_in, const int* in_sizes, int n_in, void* d_out, int out_size, void* d_ws, size_t ws_size, hipStream_t stream) {
    static int grid = 0;
    if (grid == 0) {
        if (n_in != 21 || out_size != M * DM || ws_size < WS_END) { fprintf(stderr, "kernel_launch: unexpected shapes (n_in %d, out %d, ws %zu); nothing launched\n", n_in, out_size, ws_size); grid = -1; return; }
        int dev = 0, cus = 0, per_cu = 0;
        if (hipGetDevice(&dev) != hipSuccess || hipDeviceGetAttribute(&cus, hipDeviceAttributeMultiprocessorCount, dev) != hipSuccess) { grid = -1; return; }
        if (hipFuncSetAttribute((const void*)hymba_fwd, hipFuncAttributeMaxDynamicSharedMemorySize, LDS_BYTES) != hipSuccess) { fprintf(stderr, "kernel_launch: hipFuncSetAttribute failed\n"); grid = -1; return; }
        if (hipOccupancyMaxActiveBlocksPerMultiprocessor(&per_cu, (const void*)hymba_fwd, NWAVES * 64, LDS_BYTES) != hipSuccess || per_cu < 1) { fprintf(stderr, "kernel_launch: occupancy query reports %d workgroups per CU\n", per_cu); }
        (void)hipGetLastError();
        grid = cus;
    }
    if (grid < 0) return;
    (void)hipMemsetAsync((char*)d_ws + WS_CTL, 0, CTL_ZERO_BYTES, stream);
    Args a{};
    for (int i = 0; i < 21; ++i) a.in[i] = (const float*)d_in[i];
    a.out = (float*)d_out; a.ws = (unsigned char*)d_ws;
#if MK_PER_PHASE
#if MK_DEBUG
    (void)hipMemsetAsync((char*)d_ws + WS_DBG, 0, 256, stream);
#endif
    for (int ph = 0; ph < NPHASE; ++ph) { a.ph_lo = ph; a.ph_hi = ph + 1; a.use_bar = 0; hipLaunchKernelGGL(hymba_fwd, dim3(grid), dim3(NWAVES * 64), LDS_BYTES, stream, a);
#ifdef REPPH
#ifndef REPPAD
#define REPPAD 0
#endif
        if (((ph - 1) & 7) == REPPH && ph >= 1) { a.pad = REPPAD; hipLaunchKernelGGL(hymba_fwd, dim3(grid), dim3(NWAVES * 64), LDS_BYTES, stream, a); a.pad = 0; }
#endif
#if MK_DEBUG
        if (ph == 0) hipLaunchKernelGGL(dbg_c0, dim3(1), dim3(64), 0, stream, a);
        if (ph == 1) hipLaunchKernelGGL(dbg_c1, dim3(16), dim3(256), 0, stream, a);
        if (ph == 2) hipLaunchKernelGGL(dbg_c2, dim3(8), dim3(256), 0, stream, a);
        if (ph == 4) { hipLaunchKernelGGL(dbg_c3a, dim3(M), dim3(128), 0, stream, a); hipLaunchKernelGGL(dbg_c3b, dim3(16), dim3(64), 0, stream, a); hipLaunchKernelGGL(dbg_c3c, dim3(128), dim3(256), 0, stream, a); }
        if (ph == 5) hipLaunchKernelGGL(dbg_c4, dim3(16), dim3(256), 0, stream, a);
        if (ph == 7) { hipLaunchKernelGGL(dbg_c5, dim3(64), dim3(128), 0, stream, a); hipLaunchKernelGGL(dbg_c6a, dim3(64), dim3(256), 0, stream, a); }
        if (ph == 8) hipLaunchKernelGGL(dbg_c6b, dim3(64), dim3(256), 0, stream, a);
#endif
    }
#if MK_DEBUG
    hipLaunchKernelGGL(dbg_report, dim3(256), dim3(256), 0, stream, a, DBG_LO, 24, 1000.0f);
#endif
#else
    a.ph_lo = 0; a.ph_hi = NPHASE; a.use_bar = 1;
    hipLaunchKernelGGL(hymba_fwd, dim3(grid), dim3(NWAVES * 64), LDS_BYTES, stream, a);
#endif
}
```

```cpp
#define MK_PER_PHASE 0
#define MK_DEBUG 0
#define REPMASK 0
#include <hip/hip_runtime.h>
#include <cstdio>
#include <cstdint>
template <int MASK> __device__ __forceinline__ int xl_swz_i(int v) { static_assert(MASK >= 1 && MASK < 32, "ds_swizzle bit mode works inside 32-lane groups");
    return __builtin_amdgcn_ds_swizzle(v, 0x1f | (MASK << 10)); }
template <int MASK> __device__ __forceinline__ float xl_swz(float v) { return __builtin_bit_cast(float, xl_swz_i<MASK>(__builtin_bit_cast(int, v))); }
__device__ __forceinline__ float xl_sum32(float v) {
    unsigned a = __builtin_bit_cast(unsigned, v), b = a; asm volatile("" : "+v"(b));
    auto r = __builtin_amdgcn_permlane32_swap(a, b, false, false);
    const unsigned r0 = r[0], r1 = r[1];
    return __builtin_bit_cast(float, r0) + __builtin_bit_cast(float, r1); }
__device__ __forceinline__ int xl_xor32_i(int v, int hi  ) {
    unsigned a = (unsigned)v, b = a; asm volatile("" : "+v"(b));
    auto r = __builtin_amdgcn_permlane32_swap(a, b, false, false); return hi ? (int)r[0] : (int)r[1]; }
__device__ __forceinline__ float xl_wave_sum(float v) {
    v += xl_swz<1>(v); v += xl_swz<2>(v); v += xl_swz<4>(v); v += xl_swz<8>(v); v += xl_swz<16>(v); return xl_sum32(v); }
namespace pg8 {
#define PG8_LAS __attribute__((address_space(3)))
typedef unsigned short bf16_t;
typedef short bf16x8 __attribute__((ext_vector_type(8)));
typedef float f32x4 __attribute__((ext_vector_type(4)));
typedef unsigned u32x4 __attribute__((ext_vector_type(4)));
constexpr int BM = 256, BK = 64, HALF = 128, HTB = HALF * BK * 2  , STAGE_BYTES = 8 * HTB, NXCD = 8, WGM = 8;

__host__ __device__ __forceinline__ int lds_byte(int r, int c) { const int st = (r >> 4) * 2 + (c >> 5), rr = r & 15, cc = c & 31, ob = rr * 64 + cc * 2; return st * 1024 + (ob ^ (((ob >> 9) & 1) << 5)); }
__host__ __device__ __forceinline__ void stage_rc(int b, int& R, int& C) { const int st = b / 1024, sb = b % 1024, swz = sb ^ (((sb >> 9) & 1) << 5); R = (st >> 1) * 16 + swz / 64; C = (st & 1) * 32 + (swz % 64) / 2; }
__host__ __device__ __forceinline__ int perm32(int rho) { const int n = rho >> 4, i = rho & 15; return 8 * (i >> 2) + 4 * n + (i & 3); }

struct Unit { int pm, pn; };
struct Gemm { const bf16_t* A; const bf16_t* Bt; int M, N, K; };

struct StaticOrder {
    int nM, nN, nwg, G, c;
    __host__ __device__ void init(int M, int N, int G_, int c_) { nM = M / BM; nN = N / BM; nwg = nM * nN; G = G_; c = c_; }
    __host__ __device__ bool next(int i, Unit& u) const {
        const long L = (long)i * G + c; if (L >= nwg) return false;
        int wgid = (int)L; { const int q = nwg / NXCD, r = nwg % NXCD, xcd = wgid % NXCD, off = wgid / NXCD; wgid = (xcd < r ? xcd * (q + 1) : r * (q + 1) + (xcd - r) * q) + off; }
        const int nig = WGM * nN, gid = wgid / nig, fm = gid * WGM, gsz = (nM - fm) < WGM ? (nM - fm) : WGM;
        u.pm = fm + ((wgid % nig) % gsz); u.pn = (wgid % nig) / gsz; return true;
    }
    __device__ __forceinline__ void a_ready(const Unit&) const {}
    __device__ __forceinline__ void done(const Unit&) const {}
};
__device__ __forceinline__ unsigned cvt_pk_bf16(float lo, float hi) { unsigned r; asm volatile("v_cvt_pk_bf16_f32 %0, %1, %2" : "=v"(r) : "v"(lo), "v"(hi)); return r; }
typedef float f32x2 __attribute__((ext_vector_type(2)));
__device__ __forceinline__ float row_rstd(const float* ssq, int r) {
    const f32x4* p = (const f32x4*)(ssq + (size_t)r * 16);
    const f32x4 a = p[0], b = p[1], c = p[2], d = p[3];
    const float s = ((a[0] + a[1]) + (a[2] + a[3])) + ((b[0] + b[1]) + (b[2] + b[3])) + ((c[0] + c[1]) + (c[2] + c[3])) + ((d[0] + d[1]) + (d[2] + d[3]));
    return 1.0f / sqrtf(s * (1.0f / 1024.0f) + 1e-6f);
}
template <bool ROPE> struct EpiScale {
    static constexpr bool PERM = true, AFTER_DRAIN = false;
    bf16_t* O; int ldc; const float* ssq; const float* cs; const float* sn; float qscale;
    __device__ __forceinline__ void operator()(const f32x4 (&acc)[2][2][4][2], const Unit& u, int wr, int wc, int fr, int fq) const {
        const int row0 = u.pm * BM + wr * 64 + fr; const int col0 = u.pn * BM + wc * 32 + 8 * fq;
        const bool rope = ROPE && (u.pn < 4) && ((wc & 1) == 0);
        const float sc = (ROPE && u.pn < 2) ? qscale : 1.0f;
        float rsv[2][4];
        if constexpr (ROPE) {
#pragma unroll
            for (int ai = 0; ai < 2; ++ai)
#pragma unroll
                for (int m = 0; m < 4; ++m) rsv[ai][m] = ssq[row0 + ai * HALF + m * 16];
        } else {
#pragma unroll
            for (int ai = 0; ai < 2; ++ai) { f32x4 p[4][4];
#pragma unroll
                for (int m = 0; m < 4; ++m) { const f32x4* q = (const f32x4*)(ssq + (size_t)(row0 + ai * HALF + m * 16) * 16); p[m][0] = q[0]; p[m][1] = q[1]; p[m][2] = q[2]; p[m][3] = q[3]; }
#pragma unroll
                for (int m = 0; m < 4; ++m) { const f32x4 t = (p[m][0] + p[m][1]) + (p[m][2] + p[m][3]); rsv[ai][m] = 1.0f / sqrtf(((t[0] + t[1]) + (t[2] + t[3])) * (1.0f / 1024.0f) + 1e-6f); } }
        }
#pragma unroll
        for (int ai = 0; ai < 2; ++ai) {
            f32x4 cc0[4], cc1[4], ss0[4], ss1[4];
#pragma unroll
            for (int m = 0; m < 4; ++m) { const int r = row0 + ai * HALF + m * 16;
                cc0[m] = (f32x4){1.f, 1.f, 1.f, 1.f}; cc1[m] = cc0[m]; ss0[m] = (f32x4){0.f, 0.f, 0.f, 0.f}; ss1[m] = ss0[m];
                if (rope && fq < 2) { cc0[m] = *(const f32x4*)(cs + (size_t)r * 8); cc1[m] = *(const f32x4*)(cs + (size_t)r * 8 + 4); ss0[m] = *(const f32x4*)(sn + (size_t)r * 8); ss1[m] = *(const f32x4*)(sn + (size_t)r * 8 + 4); } }
#pragma unroll
            for (int m = 0; m < 4; ++m) {
                const int r = row0 + ai * HALF + m * 16;
                const float rs = rsv[ai][m] * sc;
                f32x4 c0 = cc0[m], c1 = cc1[m], s0 = ss0[m], s1 = ss1[m];
                if (rope && fq == 0) { s0 = -s0; s1 = -s1; }
                bf16_t* rowp = O + (size_t)r * ldc + col0;
#pragma unroll
                for (int bj = 0; bj < 2; ++bj) {
                    f32x4 v0 = acc[ai][bj][m][0] * rs, v1 = acc[ai][bj][m][1] * rs;
                    if (rope) {
                        f32x4 o0, o1;
#pragma unroll
                        for (int i = 0; i < 4; ++i) { o0[i] = xl_swz<16>(v0[i]); o1[i] = xl_swz<16>(v1[i]); }
                        v0 = v0 * c0 + o0 * s0; v1 = v1 * c1 + o1 * s1;
                    }
                    u32x4 w; w.x = cvt_pk_bf16(v0[0], v0[1]); w.y = cvt_pk_bf16(v0[2], v0[3]); w.z = cvt_pk_bf16(v1[0], v1[1]); w.w = cvt_pk_bf16(v1[2], v1[3]);
                    *(u32x4*)(rowp + bj * HALF) = w;
                }
            }
        }
    }
};
struct EpiRes {
    static constexpr bool PERM = false, AFTER_DRAIN = false;
    bf16_t* XB; float* ssq;
    __device__ __forceinline__ void operator()(const f32x4 (&acc)[2][2][4][2], const Unit& u, int wr, int wc, int fr, int fq) const {
        typedef unsigned u32x2v __attribute__((ext_vector_type(2)));
        const int col0 = u.pn * BM + wc * 32 + 4 * fq;
        u32x2v xw[2][4][2][2];
#pragma unroll
        for (int ai = 0; ai < 2; ++ai)
#pragma unroll
            for (int m = 0; m < 4; ++m) { const size_t off = (size_t)(u.pm * BM + ai * HALF + wr * 64 + m * 16 + fr) * 1024 + col0;
#pragma unroll
                for (int bj = 0; bj < 2; ++bj)
#pragma unroll
                    for (int n = 0; n < 2; ++n) xw[ai][m][bj][n] = *(const u32x2v*)(XB + off + bj * HALF + n * 16); }
#pragma unroll
        for (int ai = 0; ai < 2; ++ai)
#pragma unroll
            for (int m = 0; m < 4; ++m) {
                const int r = u.pm * BM + ai * HALF + wr * 64 + m * 16 + fr; const size_t off = (size_t)r * 1024 + col0; float ss = 0.f;
#pragma unroll
                for (int bj = 0; bj < 2; ++bj)
#pragma unroll
                    for (int n = 0; n < 2; ++n) { const size_t o = off + bj * HALF + n * 16; const u32x2v x = xw[ai][m][bj][n];
                        const f32x4 v = (f32x4){__builtin_bit_cast(float, x.x << 16), __builtin_bit_cast(float, x.x & 0xffff0000u), __builtin_bit_cast(float, x.y << 16), __builtin_bit_cast(float, x.y & 0xffff0000u)} + acc[ai][bj][m][n];
                        u32x2v w; w.x = cvt_pk_bf16(v[0], v[1]); w.y = cvt_pk_bf16(v[2], v[3]); *(u32x2v*)(XB + o) = w;
                        ss += (v[0] * v[0] + v[1] * v[1]) + (v[2] * v[2] + v[3] * v[3]); }
                ss += xl_swz<16>(ss); ss = xl_sum32(ss);
                if (fq == 0) ssq[(size_t)r * 16 + u.pn * 4 + wc] = ss;
            }
    }
};
template <class Epi, class Sched, bool ALIGN_EPI = false, bool SP2 = false>
__device__ __forceinline__ void gemm_phase(PG8_LAS unsigned char* lds, const Gemm g, const Sched& S, const Epi& E, const int tid) {
    const int wid = __builtin_amdgcn_readfirstlane(tid >> 6), lane = tid & 63, wr = wid >> 2, wc = wid & 3, fr = lane & 15, fq = lane >> 4;
    const int K = g.K, nt = K / BK;
    unsigned voffA[2], voffB[2];
#pragma unroll
    for (int i = 0; i < 2; ++i) { int R, C; stage_rc(tid * 16 + i * 8192, R, C); const int Rb = Epi::PERM ? ((R & ~31) + perm32(R & 31)) : R;
        voffA[i] = (unsigned)(R * K + C) * 2u; voffB[i] = (unsigned)(Rb * K + C) * 2u; }
    const size_t kstep = (size_t)(BK * 2);
    const size_t hstep = (size_t)HALF * K * 2;
    const size_t tstep = 2 * hstep;
    const unsigned ldsw = (unsigned)wid * 1024u;
    const int aoff = lds_byte(wr * 64 + fr, fq * 8), boff = lds_byte(wc * 32 + fr, fq * 8);
#define PG8_SA(b, h) (((b) * 2 + (h)) * HTB)
#define PG8_SB(b, h) ((4 + (b) * 2 + (h)) * HTB)
#define PG8_STAGE(bufoff, gbase, voff) do { _Pragma("unroll") for (int _i = 0; _i < 2; ++_i) \
        __builtin_amdgcn_global_load_lds((const unsigned*)((const char*)(gbase) + (voff)[_i]), (PG8_LAS unsigned*)(lds + (bufoff) + ldsw + _i * 8192), 16, 0, 0); } while (0)
#define PG8_LDA(dst, b, h) do { _Pragma("unroll") for (int m = 0; m < 4; ++m) _Pragma("unroll") for (int k = 0; k < 2; ++k) dst[m][k] = *(const PG8_LAS bf16x8*)(lds + PG8_SA(b, h) + aoff + m * 2048 + k * 1024); } while (0)
#define PG8_LDB(dst, b, h) do { _Pragma("unroll") for (int n = 0; n < 2; ++n) _Pragma("unroll") for (int k = 0; k < 2; ++k) dst[n][k] = *(const PG8_LAS bf16x8*)(lds + PG8_SB(b, h) + boff + n * 2048 + k * 1024); } while (0)
#define PG8_MMA(ai, bj, At, Bt) do { __builtin_amdgcn_s_setprio(1); _Pragma("unroll") for (int m = 0; m < 4; ++m) _Pragma("unroll") for (int n = 0; n < 2; ++n) _Pragma("unroll") for (int k = 0; k < 2; ++k) \
        acc[ai][bj][m][n] = __builtin_amdgcn_mfma_f32_16x16x32_bf16(Bt[n][k], At[m][k], acc[ai][bj][m][n], 0, 0, 0); __builtin_amdgcn_s_setprio(0); } while (0)
#define PG8_WAIT_V(n) asm volatile("s_waitcnt vmcnt(" #n ")" ::: "memory")
#define PG8_WAIT_L(n) asm volatile("s_waitcnt lgkmcnt(" #n ")" ::: "memory")
#define PG8_BAR __builtin_amdgcn_s_barrier()
#define PG8_SCHED __builtin_amdgcn_sched_barrier(0)
    Unit cur, nxt; int ui = 0;
    if (!S.next(0, cur)) return;
    f32x4 acc[2][2][4][2];
#pragma unroll
    for (int a = 0; a < 2; ++a)
#pragma unroll
        for (int b = 0; b < 2; ++b)
#pragma unroll
            for (int m = 0; m < 4; ++m)
#pragma unroll
                for (int n = 0; n < 2; ++n) acc[a][b][m][n] = (f32x4){0.f, 0.f, 0.f, 0.f};
    bf16x8 At[4][2], B0[2][2], B1[2][2];
    const char* cA = (const char*)g.A + (size_t)cur.pm * tstep; const char* cB = (const char*)g.Bt + (size_t)cur.pn * tstep;
    S.a_ready(cur);
    if constexpr (SP2) {
        PG8_STAGE(PG8_SB(0, 0), cB, voffB); PG8_STAGE(PG8_SB(0, 1), cB + hstep, voffB); PG8_STAGE(PG8_SA(0, 0), cA, voffA); PG8_STAGE(PG8_SA(0, 1), cA + hstep, voffA);
        if (wr == 1) PG8_BAR;
        PG8_WAIT_V(2); PG8_BAR;
        PG8_STAGE(PG8_SB(1, 0), cB + kstep, voffB); PG8_STAGE(PG8_SA(1, 0), cA + kstep, voffA); PG8_STAGE(PG8_SB(1, 1), cB + hstep + kstep, voffB);
        PG8_WAIT_V(6); PG8_BAR;
    } else {
        PG8_STAGE(PG8_SB(0, 0), cB, voffB); PG8_STAGE(PG8_SA(0, 0), cA, voffA); PG8_STAGE(PG8_SB(0, 1), cB + hstep, voffB); PG8_STAGE(PG8_SA(0, 1), cA + hstep, voffA);
        if (wr == 1) PG8_BAR;
        PG8_WAIT_V(4); PG8_BAR;
        PG8_STAGE(PG8_SB(1, 0), cB + kstep, voffB); PG8_STAGE(PG8_SA(1, 0), cA + kstep, voffA); PG8_STAGE(PG8_SB(1, 1), cB + hstep + kstep, voffB);
        PG8_WAIT_V(6); PG8_BAR;
    }
    for (;;) {
        const bool has_next = S.next(ui + 1, nxt);
        const char* nA = has_next ? (const char*)g.A + (size_t)nxt.pm * tstep : cA; const char* nB = has_next ? (const char*)g.Bt + (size_t)nxt.pn * tstep : cB;
        for (int t = 0; t < nt; t += 2) {
            const bool last = (t == nt - 2);
            const char* a1 = cA + (size_t)(t + 1) * kstep;
            const char* a2 = last ? nA : cA + (size_t)(t + 2) * kstep; const char* b2 = last ? nB : cB + (size_t)(t + 2) * kstep;
            const char* a3 = a2 + kstep; const char* b3 = b2 + kstep;
            if (last && has_next) S.a_ready(nxt);
            if constexpr (SP2) {
            PG8_LDB(B0, 0, 0); PG8_LDB(B1, 0, 1); PG8_SCHED; PG8_LDA(At, 0, 0); PG8_STAGE(PG8_SA(1, 1), a1 + hstep, voffA);
            PG8_WAIT_V(8); PG8_WAIT_L(0); PG8_BAR; PG8_MMA(0, 0, At, B0); PG8_MMA(0, 1, At, B1); PG8_BAR; PG8_SCHED;
            PG8_LDA(At, 0, 1); PG8_STAGE(PG8_SB(0, 0), b2, voffB); PG8_STAGE(PG8_SB(0, 1), b2 + hstep, voffB); PG8_STAGE(PG8_SA(0, 0), a2, voffA);
            PG8_WAIT_V(8); PG8_WAIT_L(0); PG8_BAR; PG8_MMA(1, 0, At, B0); PG8_MMA(1, 1, At, B1); PG8_BAR; PG8_SCHED;
            PG8_LDB(B0, 1, 0); PG8_LDB(B1, 1, 1); PG8_SCHED; PG8_LDA(At, 1, 0); PG8_STAGE(PG8_SA(0, 1), a2 + hstep, voffA);
            PG8_WAIT_V(8); PG8_WAIT_L(0); PG8_BAR; PG8_MMA(0, 0, At, B0); PG8_MMA(0, 1, At, B1); PG8_BAR; PG8_SCHED;
            PG8_LDA(At, 1, 1); PG8_STAGE(PG8_SB(1, 0), b3, voffB); PG8_STAGE(PG8_SB(1, 1), b3 + hstep, voffB); PG8_STAGE(PG8_SA(1, 0), a3, voffA);
            PG8_WAIT_V(8); PG8_WAIT_L(0); PG8_BAR; PG8_MMA(1, 0, At, B0); PG8_MMA(1, 1, At, B1); PG8_BAR; PG8_SCHED;
            } else {
            PG8_LDB(B0, 0, 0); PG8_SCHED; PG8_LDA(At, 0, 0); PG8_STAGE(PG8_SA(1, 1), a1 + hstep, voffA);
            PG8_WAIT_L(8); PG8_BAR; PG8_WAIT_L(0); PG8_MMA(0, 0, At, B0); PG8_BAR; PG8_SCHED;
            PG8_LDB(B1, 0, 1); PG8_STAGE(PG8_SB(0, 0), b2, voffB);
            PG8_BAR; PG8_WAIT_L(0); PG8_MMA(0, 1, At, B1); PG8_BAR;
            PG8_LDA(At, 0, 1); PG8_STAGE(PG8_SA(0, 0), a2, voffA);
            PG8_BAR; PG8_WAIT_L(0); PG8_MMA(1, 0, At, B0); PG8_BAR; PG8_SCHED;
            PG8_STAGE(PG8_SB(0, 1), b2 + hstep, voffB);
            PG8_WAIT_V(6); PG8_BAR; PG8_MMA(1, 1, At, B1); PG8_BAR;
            PG8_LDB(B0, 1, 0); PG8_SCHED; PG8_LDA(At, 1, 0); PG8_STAGE(PG8_SA(0, 1), a2 + hstep, voffA);
            PG8_WAIT_L(8); PG8_BAR; PG8_WAIT_L(0); PG8_MMA(0, 0, At, B0); PG8_BAR; PG8_SCHED;
            PG8_LDB(B1, 1, 1); PG8_STAGE(PG8_SB(1, 0), b3, voffB);
            PG8_BAR; PG8_WAIT_L(0); PG8_MMA(0, 1, At, B1); PG8_BAR;
            PG8_LDA(At, 1, 1); PG8_STAGE(PG8_SA(1, 0), a3, voffA);
            PG8_BAR; PG8_WAIT_L(0); PG8_MMA(1, 0, At, B0); PG8_BAR; PG8_SCHED;
            PG8_STAGE(PG8_SB(1, 1), b3 + hstep, voffB);
            PG8_WAIT_V(6); PG8_BAR; PG8_MMA(1, 1, At, B1); PG8_BAR;
            }
        }
        if constexpr (ALIGN_EPI) { if (wr == 0) PG8_BAR; }
        if constexpr (!Epi::AFTER_DRAIN) { E(acc, cur, wr, wc, fr, fq); S.done(cur); }
        if (!has_next) break;
#pragma unroll
        for (int a = 0; a < 2; ++a)
#pragma unroll
            for (int b = 0; b < 2; ++b)
#pragma unroll
                for (int m = 0; m < 4; ++m)
#pragma unroll
                    for (int n = 0; n < 2; ++n) acc[a][b][m][n] = (f32x4){0.f, 0.f, 0.f, 0.f};
        cur = nxt; cA = nA; cB = nB; ++ui;
        if constexpr (ALIGN_EPI) { if (wr == 1) PG8_BAR; }
    }
    PG8_WAIT_V(0);
    if constexpr (!ALIGN_EPI) { if (wr == 0) PG8_BAR; }
    PG8_BAR;
    if constexpr (Epi::AFTER_DRAIN) { E.fused(acc, cur, wr, wc, fr, fq, lds, wid, lane); S.done(cur); }
#undef PG8_SA
#undef PG8_SB
#undef PG8_STAGE
#undef PG8_LDA
#undef PG8_LDB
#undef PG8_MMA
#undef PG8_WAIT_V
#undef PG8_WAIT_L
#undef PG8_BAR
#undef PG8_SCHED
}
}

#ifndef PG8_SP2
#define PG8_SP2 true
#endif
#ifndef PG8_ALIGN
#define PG8_ALIGN true
#endif
#include <hip/hip_bf16.h>
#include <cmath>
namespace attn_body {
using bf16=__hip_bfloat16;
using bf16x8=__attribute__((ext_vector_type(8)))short;
using s16x4=__attribute__((ext_vector_type(4)))short;
using f32x16=__attribute__((ext_vector_type(16)))float;
using u32x4=__attribute__((ext_vector_type(4)))unsigned;
constexpr int BATCH=4,SEQ=4096,D=64,PIN=3072,POUT=1024;
constexpr int NW=8,QBLK=32,QB=QBLK*NW,KVBLK=64,NQB=SEQ/QB;
constexpr int ATTN_UNIT_ROWS=QB;
__device__ __forceinline__ int crow(int r,int hi){return (r&3)+8*(r>>2)+4*hi;}
#define SBAR() __builtin_amdgcn_sched_barrier(0)
__device__ __forceinline__ void cmask(f32x16&p0,f32x16&p1,int jb,int qrel,int hi){
  const float NEG=-INFINITY; int kb=64*jb+4*hi; asm volatile("":"+v"(kb));
  #pragma unroll
  for(int r=0;r<16;++r){int kv=kb+(r&3)+8*(r>>2); if(kv>qrel)p0[r]=NEG; if(kv+32>qrel)p1[r]=NEG;}
}

constexpr int NSLOT=3, SLOTB=8192;
constexpr int LDS_K=0, LDS_V=NSLOT*SLOTB, LDS_WS=3*NSLOT*SLOTB, LDS_OST=LDS_WS+NW*64*4, LDS_BYTES=LDS_OST+NW*4096;
constexpr float C2=0.125f*1.4426950408889634f;
__device__ __forceinline__ void glds16(const void*gsrc,unsigned lds_dst){unsigned keep;
  asm volatile("s_mov_b32 %0, m0\n\ts_mov_b32 m0, %2\n\ts_nop 0\n\tglobal_load_lds_dwordx4 %1, off\n\ts_mov_b32 m0, %0":"=&s"(keep):"v"(gsrc),"s"(lds_dst):"memory");}
__device__ __forceinline__ void glds16s(const void*sbase,unsigned voff,unsigned lds_dst){unsigned keep;
  asm volatile("s_mov_b32 %0, m0\n\ts_mov_b32 m0, %3\n\ts_nop 0\n\tglobal_load_lds_dwordx4 %1, %2\n\ts_mov_b32 m0, %0":"=&s"(keep):"v"(voff),"s"(sbase),"s"(lds_dst):"memory");}
__device__ __forceinline__ float max3f(float a,float b,float c){float r;asm("v_max3_f32 %0, %1, %2, %3":"=v"(r):"v"(a),"v"(b),"v"(c));return r;}
__device__ __forceinline__ float max2f(float a,float b){float r;asm("v_max_f32_e32 %0, %1, %2":"=v"(r):"v"(a),"v"(b));return r;}
__device__ __forceinline__ float fadd_s(float a,float b){float r;asm("v_add_f32_e32 %0, %1, %2":"=v"(r):"v"(a),"v"(b));return r;}
__device__ __forceinline__ float fsub_s(float a,float b){float r;asm("v_sub_f32_e32 %0, %1, %2":"=v"(r):"v"(a),"v"(b));return r;}
typedef float f32x2_t __attribute__((ext_vector_type(2))); typedef __bf16 bf16x2_t __attribute__((ext_vector_type(2)));
__device__ __forceinline__ unsigned cvtpk_s(float lo,float hi){f32x2_t v={lo,hi};bf16x2_t b=__builtin_convertvector(v,bf16x2_t);return __builtin_bit_cast(unsigned,b);}
#define WAIT_BAR(N) asm volatile("s_waitcnt vmcnt(" #N ") lgkmcnt(0)\n\ts_barrier":::"memory")

__device__ __forceinline__ void qkt(f32x16&p0,f32x16&p1,const char*Kslot,const bf16x8*qr,const f32x16&negm,int r32,int hi){
  const char*kb=Kslot+hi*1024+r32*16;
  #pragma unroll
  for(int d0=0;d0<4;++d0){
    const bf16x8 b0=*reinterpret_cast<const bf16x8*>(kb+d0*2048);
    const bf16x8 b1=*reinterpret_cast<const bf16x8*>(kb+d0*2048+512);
    if(d0==0){p0=__builtin_amdgcn_mfma_f32_32x32x16_bf16(b0,qr[0],negm,0,0,0);p1=__builtin_amdgcn_mfma_f32_32x32x16_bf16(b1,qr[0],negm,0,0,0);}
    else{p0=__builtin_amdgcn_mfma_f32_32x32x16_bf16(b0,qr[d0],p0,0,0,0);p1=__builtin_amdgcn_mfma_f32_32x32x16_bf16(b1,qr[d0],p1,0,0,0);}}
}
typedef __attribute__((address_space(3))) const char* lds_cptr;
typedef short v4i16_t __attribute__((ext_vector_type(4)));
__device__ __forceinline__ void kload8(bf16x8*kf,lds_cptr kp){
  kf[0]=*(const __attribute__((address_space(3))) bf16x8*)(kp);      kf[1]=*(const __attribute__((address_space(3))) bf16x8*)(kp+512);
  kf[2]=*(const __attribute__((address_space(3))) bf16x8*)(kp+2048); kf[3]=*(const __attribute__((address_space(3))) bf16x8*)(kp+2560);
  kf[4]=*(const __attribute__((address_space(3))) bf16x8*)(kp+4096); kf[5]=*(const __attribute__((address_space(3))) bf16x8*)(kp+4608);
  kf[6]=*(const __attribute__((address_space(3))) bf16x8*)(kp+6144); kf[7]=*(const __attribute__((address_space(3))) bf16x8*)(kp+6656);
}
__device__ __forceinline__ void kload2(bf16x8*kf,lds_cptr kp,int j){ kf[2*j]=*(const __attribute__((address_space(3))) bf16x8*)(kp+j*2048); kf[2*j+1]=*(const __attribute__((address_space(3))) bf16x8*)(kp+j*2048+512); }
__device__ __forceinline__ s16x4 vtr(lds_cptr p){ return __builtin_bit_cast(s16x4,__builtin_amdgcn_ds_read_tr16_b64_v4i16((__attribute__((address_space(3))) v4i16_t*)p)); }
__device__ __forceinline__ float rowmax(const f32x16&p0,const f32x16&p1){
  float a=max3f(p0[0],p0[1],p1[0]),b=max3f(p0[2],p0[3],p1[1]);a=max3f(a,p1[2],p1[3]);
  #pragma unroll
  for(int r=4;r<16;r+=4){a=max3f(a,p0[r],p0[r+1]);b=max3f(b,p0[r+2],p0[r+3]);a=max3f(a,p1[r],p1[r+1]);b=max3f(b,p1[r+2],p1[r+3]);}
  const float m=max2f(a,b);
  auto rr=__builtin_amdgcn_permlane32_swap(__float_as_uint(m),__float_as_uint(m),false,false);
  return max2f(__uint_as_float(rr[0]),__uint_as_float(rr[1]));
}
__device__ __forceinline__ void pv(f32x16*o,int vb,bf16x8 pa0,bf16x8 pa1,bf16x8 pa2,bf16x8 pa3){
  #pragma unroll
  for(int d0=0;d0<4;++d0){s16x4 lo[4],hi[4];
    #pragma unroll
    for(int ks=0;ks<4;++ks){
      asm volatile("ds_read_b64_tr_b16 %0,%1 offset:%c2":"=&v"(lo[ks]):"v"(vb),"i"(d0*4096+ks*1024):"memory");
      asm volatile("ds_read_b64_tr_b16 %0,%1 offset:%c2":"=&v"(hi[ks]):"v"(vb),"i"(d0*4096+ks*1024+512):"memory");}
    asm volatile("s_waitcnt lgkmcnt(0)":::"memory");SBAR();
    #define PK(k) (bf16x8){lo[k][0],lo[k][1],lo[k][2],lo[k][3],hi[k][0],hi[k][1],hi[k][2],hi[k][3]}
    o[d0]=__builtin_amdgcn_mfma_f32_32x32x16_bf16(pa0,PK(0),o[d0],0,0,0);
    o[d0]=__builtin_amdgcn_mfma_f32_32x32x16_bf16(pa1,PK(1),o[d0],0,0,0);
    o[d0]=__builtin_amdgcn_mfma_f32_32x32x16_bf16(pa2,PK(2),o[d0],0,0,0);
    o[d0]=__builtin_amdgcn_mfma_f32_32x32x16_bf16(pa3,PK(3),o[d0],0,0,0);
    #undef PK
  }
}

#ifndef ATTN_STORE16
#define ATTN_STORE16(p,v) (*(u32x4*)(p)=(v))
#endif
template<int THRL> __device__ __forceinline__ void attn_unit(int b,int qcol,int kcol,int vcol,int ocol,int qb,const bf16*Q,const bf16*__restrict__ K,const bf16*__restrict__ V,bf16*O,char*shm,const int tid){
  const int lane=tid&63,r32=lane&31,hi=lane>>5; const int wid=__builtin_amdgcn_readfirstlane(tid>>6);
  const long rowbase=(long)b*SEQ; const int q0=qb*QB;
  const bf16*Qw=Q+(rowbase+q0+wid*QBLK)*PIN+qcol;
  const bf16*Kh=K+rowbase*PIN+kcol,*Vh=V+rowbase*PIN+vcol;
  const unsigned lds0=(unsigned)(uintptr_t)shm;
  float*wsf=(float*)(shm+LDS_WS)+wid*64;
  const unsigned koff=(unsigned)(lane*PIN+wid*8)*2u;
  const unsigned voff=(unsigned)((16*(wid&3)+(lane>>2))*PIN+(wid>>2)*32+(lane&3)*8)*2u;
  const unsigned kdst=lds0+LDS_K+wid*1024, vdst=lds0+LDS_V+wid*1024;
  #define DMA_K(t,slot) glds16s(Kh+(long)(t)*KVBLK*PIN,koff,(unsigned)__builtin_amdgcn_readfirstlane(kdst+(slot)))
  #define DMA_V(t,slot) do{ glds16s(Vh+(long)(t)*KVBLK*PIN,voff,(unsigned)__builtin_amdgcn_readfirstlane(vdst+2*(slot))); glds16s(Vh+(long)(t)*KVBLK*PIN,voff+128u,(unsigned)__builtin_amdgcn_readfirstlane(vdst+8192+2*(slot))); }while(0)
  const int vb0=(int)(lds0+LDS_V)+((lane>>4)&1)*32+(lane&3)*8+(4*hi+((lane&15)>>2))*64;
  const char*Kbase=shm+LDS_K; bf16x8 kf[8];
  const lds_cptr shm3=(lds_cptr)shm; const lds_cptr kp0=shm3+LDS_K+hi*1024+r32*16; const lds_cptr vp0=shm3+LDS_V+((lane>>4)&1)*32+(lane&3)*8+(4*hi+((lane&15)>>2))*64;
  const int NT=(q0+QB)/KVBLK;
  DMA_K(0,0);DMA_V(0,0);DMA_K(1,SLOTB);
  bf16x8 qr[4];
  { int lq=lane; asm volatile("":"+v"(lq)); const int r32q=lq&31,hiq=lq>>5;
  _Pragma("unroll") for(int d0=0;d0<4;++d0)qr[d0]=*reinterpret_cast<const bf16x8*>(&Qw[(long)r32q*PIN+d0*16+hiq*8]); }
  const lds_cptr qst=shm3+LDS_OST+wid*4096+lane*16;
  #define QST(d0) (*(__attribute__((address_space(3))) bf16x8*)(qst+(d0)*1024))
  _Pragma("unroll") for(int d0=0;d0<4;++d0) *(__attribute__((address_space(3))) bf16x8*)((__attribute__((address_space(3))) char*)qst+d0*1024)=qr[d0];
  float mhat=0.f,l_reg=0.f;f32x16 o[4];o[0]=f32x16{};o[1]=f32x16{};o[2]=f32x16{};o[3]=f32x16{};float z0_=0.f;asm volatile("":"+v"(z0_));f32x16 negm;_Pragma("unroll") for(int r=0;r<16;++r)negm[r]=z0_;asm volatile("":"+v"(negm));
  const int qrel=wid*QBLK+r32;
  #define CMASK(P0,P1,t) do{int jb_=(t)-(NT-4); if(jb_>=0)cmask(P0,P1,jb_,qrel,hi);}while(0)
  bool resc=false;
  #define START(P0,P1) do{ const float rm=rowmax(P0,P1); resc=false; \
    { const float dl=rm; mhat=fadd_s(mhat,dl); \
      _Pragma("unroll") for(int r=0;r<16;++r){P0[r]=fsub_s(P0[r],dl);P1[r]=fsub_s(P1[r],dl);} \
      _Pragma("unroll") for(int r=0;r<16;++r)negm[r]=-mhat; asm volatile("":"+v"(negm)); } \
    _Pragma("unroll") for(int r=0;r<16;++r)P0[r]=__builtin_amdgcn_exp2f(P0[r]); }while(0)
  #define RESC() do{ if(resc){ asm volatile("s_waitcnt lgkmcnt(0)":::"memory"); \
      _Pragma("unroll") for(int d_=0;d_<4;++d_) _Pragma("unroll") for(int r=0;r<16;++r)o[d_][r]*=wsf[crow(r,hi)]; } }while(0)
  f32x16 pA0,pA1,pB0,pB1;
  int sl_prev=0,sl_cur=0,sl_next=SLOTB;
  #define ROT() do{sl_prev=sl_cur;sl_cur=sl_next;sl_next=(sl_next==(NSLOT-1)*SLOTB)?0:sl_next+SLOTB;}while(0)
  DMA_K(2,2*SLOTB);
  WAIT_BAR(3);
  qkt(pA0,pA1,Kbase,qr,negm,r32,hi);asm volatile("s_nop 15\n\ts_nop 7":"+v"(pA0),"+v"(pA1));CMASK(pA0,pA1,0);
  START(pA0,pA1);
  _Pragma("unroll") for(int r=0;r<16;++r)pA1[r]=__builtin_amdgcn_exp2f(pA1[r]);
  u32x4 pa0,pa1,pa2,pa3,pb0,pb1,pb2,pb3;
  { float s0_=pA0[0]+pA0[1]; _Pragma("unroll") for(int r=2;r<16;++r)s0_+=pA0[r]; _Pragma("unroll") for(int r=0;r<16;++r)s0_+=pA1[r]; l_reg+=s0_;
    pa0=(u32x4){cvtpk_s(pA0[0],pA0[1]),cvtpk_s(pA0[2],pA0[3]),cvtpk_s(pA0[4],pA0[5]),cvtpk_s(pA0[6],pA0[7])}; pa1=(u32x4){cvtpk_s(pA0[8],pA0[9]),cvtpk_s(pA0[10],pA0[11]),cvtpk_s(pA0[12],pA0[13]),cvtpk_s(pA0[14],pA0[15])};
    pa2=(u32x4){cvtpk_s(pA1[0],pA1[1]),cvtpk_s(pA1[2],pA1[3]),cvtpk_s(pA1[4],pA1[5]),cvtpk_s(pA1[6],pA1[7])}; pa3=(u32x4){cvtpk_s(pA1[8],pA1[9]),cvtpk_s(pA1[10],pA1[11]),cvtpk_s(pA1[12],pA1[13]),cvtpk_s(pA1[14],pA1[15])}; }
  WAIT_BAR(0);
  DMA_K(3,0);DMA_V(1,SLOTB);
  ROT();
  kload8(kf,kp0+sl_cur);
  WAIT_BAR(3);
  s16x4 vlo[4],vhi[4];
  #define PAFX(P) __builtin_bit_cast(bf16x8,P)
  #define VFRS(i) (bf16x8){vlo[i][0],vlo[i][1],vlo[i][2],vlo[i][3],vhi[i][0],vhi[i][1],vhi[i][2],vhi[i][3]}
  #define PIN(x) asm volatile("":"+v"(x))
  #define MX3(a,b,c) __builtin_fmaxf(__builtin_fmaxf((a),(b)),(c))
  #define EX(v) __builtin_amdgcn_exp2f(v)
  #define VRDF(s,id) do{ vlo[s]=vtr(vp_+(((id)>>2)*4096+((id)&3)*1024)); vhi[s]=vtr(vp_+(((id)>>2)*4096+((id)&3)*1024+512)); }while(0)
  #define GAPA(MF) do{ MF; SBAR(); }while(0)
  #define GAPAV(MF,s,id) do{ VRDF(s,id); SBAR(); MF; SBAR(); }while(0)
  #define GAPB(MF,X,B,PN,W,RD) do{ MF; X[B]=EX(X[B]); X[B+1]=EX(X[B+1]); PIN(X); sacc+=X[B]; sacc+=X[B+1]; PIN(sacc); PN[W]=cvtpk_s(X[B],X[B+1]); PIN(PN); RD; SBAR(); }while(0)
  #define KRD(G,j) do{ if(G){ kload2(kf,kp0+sl_next,j); SBAR(); } }while(0)
  #define STEP(C0,C1,PC0,PC1,PC2,PC3,PN0,PN1,PN2,PN3,t,GK,GV,GL) do{ SBAR(); \
    const lds_cptr vp_=vp0+2*sl_prev; \
    const bf16x8 q0_=QST(0),q1_=QST(1),q2_=QST(2),q3_=QST(3); SBAR(); \
    GAPA(C0=__builtin_amdgcn_mfma_f32_32x32x16_bf16(kf[0],q0_,negm,0,0,0)); \
    GAPA(C1=__builtin_amdgcn_mfma_f32_32x32x16_bf16(kf[1],q0_,negm,0,0,0)); \
    GAPA(C0=__builtin_amdgcn_mfma_f32_32x32x16_bf16(kf[2],q1_,C0,0,0,0)); \
    GAPA(C1=__builtin_amdgcn_mfma_f32_32x32x16_bf16(kf[3],q1_,C1,0,0,0)); \
    GAPAV(C0=__builtin_amdgcn_mfma_f32_32x32x16_bf16(kf[4],q2_,C0,0,0,0),0,0); \
    GAPAV(C1=__builtin_amdgcn_mfma_f32_32x32x16_bf16(kf[5],q2_,C1,0,0,0),1,4); \
    GAPAV(C0=__builtin_amdgcn_mfma_f32_32x32x16_bf16(kf[6],q3_,C0,0,0,0),2,1); \
    GAPAV(C1=__builtin_amdgcn_mfma_f32_32x32x16_bf16(kf[7],q3_,C1,0,0,0),3,5); \
    if(GK){DMA_K((t)+3,sl_cur);} if(GV){DMA_V((t)+1,sl_next);} \
    CMASK(C0,C1,t); \
    { float a=MX3(C0[0],C0[1],C1[0]),b=MX3(C0[2],C0[3],C1[1]); a=MX3(a,C1[2],C1[3]); \
      _Pragma("unroll") for(int r=4;r<16;r+=4){a=MX3(a,C0[r],C0[r+1]);b=MX3(b,C0[r+2],C0[r+3]);a=MX3(a,C1[r],C1[r+1]);b=MX3(b,C1[r+2],C1[r+3]);} \
      float rm=__builtin_fmaxf(a,b); { auto rr=__builtin_amdgcn_permlane32_swap(__float_as_uint(rm),__float_as_uint(rm),false,false); rm=__builtin_fmaxf(__uint_as_float(rr[0]),__uint_as_float(rr[1])); } \
      resc=false; \
      if(__builtin_expect(__any(rm>(float)THRL),0)){ const float dl=__builtin_fmaxf(rm,0.f); mhat+=dl; \
        _Pragma("unroll") for(int r=0;r<16;++r){C0[r]-=dl;C1[r]-=dl;} \
        _Pragma("unroll") for(int r=0;r<16;++r)negm[r]=-mhat; asm volatile("":"+v"(negm)); \
        const float f=__builtin_amdgcn_exp2f(-dl); l_reg*=f; if(hi==0)wsf[r32]=f; resc=true; } } \
    SBAR(); \
    float sacc=0.f; \
    GAPB(o[0]=__builtin_amdgcn_mfma_f32_32x32x16_bf16(PAFX(PC0),VFRS(0),o[0],0,0,0), C0,0,  PN0,0, VRDF(0,2)); \
    GAPB(o[1]=__builtin_amdgcn_mfma_f32_32x32x16_bf16(PAFX(PC0),VFRS(1),o[1],0,0,0), C0,2,  PN0,1, VRDF(1,6)); \
    KRD(GL,0); GAPB(o[0]=__builtin_amdgcn_mfma_f32_32x32x16_bf16(PAFX(PC1),VFRS(2),o[0],0,0,0), C0,4,  PN0,2, VRDF(2,3)); \
    KRD(GL,1); GAPB(o[1]=__builtin_amdgcn_mfma_f32_32x32x16_bf16(PAFX(PC1),VFRS(3),o[1],0,0,0), C0,6,  PN0,3, VRDF(3,7)); \
    KRD(GL,2); GAPB(o[0]=__builtin_amdgcn_mfma_f32_32x32x16_bf16(PAFX(PC2),VFRS(0),o[0],0,0,0), C0,8,  PN1,0, VRDF(0,8)); \
    KRD(GL,3); GAPB(o[1]=__builtin_amdgcn_mfma_f32_32x32x16_bf16(PAFX(PC2),VFRS(1),o[1],0,0,0), C0,10, PN1,1, VRDF(1,12)); \
    GAPB(o[0]=__builtin_amdgcn_mfma_f32_32x32x16_bf16(PAFX(PC3),VFRS(2),o[0],0,0,0), C0,12, PN1,2, VRDF(2,9)); \
    GAPB(o[1]=__builtin_amdgcn_mfma_f32_32x32x16_bf16(PAFX(PC3),VFRS(3),o[1],0,0,0), C0,14, PN1,3, VRDF(3,13)); \
    GAPB(o[2]=__builtin_amdgcn_mfma_f32_32x32x16_bf16(PAFX(PC0),VFRS(0),o[2],0,0,0), C1,0,  PN2,0, VRDF(0,10)); \
    GAPB(o[3]=__builtin_amdgcn_mfma_f32_32x32x16_bf16(PAFX(PC0),VFRS(1),o[3],0,0,0), C1,2,  PN2,1, VRDF(1,14)); \
    GAPB(o[2]=__builtin_amdgcn_mfma_f32_32x32x16_bf16(PAFX(PC1),VFRS(2),o[2],0,0,0), C1,4,  PN2,2, VRDF(2,11)); \
    GAPB(o[3]=__builtin_amdgcn_mfma_f32_32x32x16_bf16(PAFX(PC1),VFRS(3),o[3],0,0,0), C1,6,  PN2,3, VRDF(3,15)); \
    GAPB(o[2]=__builtin_amdgcn_mfma_f32_32x32x16_bf16(PAFX(PC2),VFRS(0),o[2],0,0,0), C1,8,  PN3,0, (void)0); \
    GAPB(o[3]=__builtin_amdgcn_mfma_f32_32x32x16_bf16(PAFX(PC2),VFRS(1),o[3],0,0,0), C1,10, PN3,1, (void)0); \
    GAPB(o[2]=__builtin_amdgcn_mfma_f32_32x32x16_bf16(PAFX(PC3),VFRS(2),o[2],0,0,0), C1,12, PN3,2, (void)0); \
    GAPB(o[3]=__builtin_amdgcn_mfma_f32_32x32x16_bf16(PAFX(PC3),VFRS(3),o[3],0,0,0), C1,14, PN3,3, (void)0); \
    l_reg+=sacc; \
    }while(0)
  #define STEP_AB(C0,C1,t,GK,GV,GL) STEP(C0,C1,pa0,pa1,pa2,pa3,pb0,pb1,pb2,pb3,t,GK,GV,GL)
  #define STEP_BA(C0,C1,t,GK,GV,GL) STEP(C0,C1,pb0,pb1,pb2,pb3,pa0,pa1,pa2,pa3,t,GK,GV,GL)
  int t=1;
  #undef CMASK
  #define CMASK(P0,P1,t) do{}while(0)
  for(;t+5<NT;t+=2){
    STEP_AB(pB0,pB1,t,true,true,true);     WAIT_BAR(3); RESC(); ROT();
    STEP_BA(pA0,pA1,t+1,true,true,true);   WAIT_BAR(3); RESC(); ROT();
  }
  #undef CMASK
  #define CMASK(P0,P1,t) do{int jb_=(t)-(NT-4); if(jb_>=0)cmask(P0,P1,jb_,qrel,hi);}while(0)
  #define ENDW(tt) do{ if((tt)+3<NT){WAIT_BAR(3);} else if((tt)+2<NT){WAIT_BAR(2);} else {WAIT_BAR(0);} }while(0)
  for(;t+1<NT;t+=2){
    STEP_AB(pB0,pB1,t,(t+3<NT),(t+1<NT),(t+1<NT));       ENDW(t);   RESC(); ROT();
    STEP_BA(pA0,pA1,t+1,(t+4<NT),(t+2<NT),(t+2<NT));     ENDW(t+1); RESC(); ROT();
  }
  STEP_AB(pB0,pB1,NT-1,false,false,false); RESC();
  { SBAR(); pv(o,vb0+2*sl_cur,PAFX(pb0),PAFX(pb1),PAFX(pb2),PAFX(pb3)); }
  #undef QST
  #undef PAFX
  #undef VFRS
  #undef PIN
  #undef MX3
  #undef GAPA
  #undef GAPAV
  #undef GAPB
  #undef EX
  #undef VRDF
  #undef KRD
  #undef STEP
  #undef STEP_AB
  #undef STEP_BA
  #undef ENDW
  {auto rr=__builtin_amdgcn_permlane32_swap(__float_as_uint(l_reg),__float_as_uint(l_reg),false,false);l_reg=__uint_as_float(rr[0])+__uint_as_float(rr[1]);}
  { int le=lane; asm volatile("":"+v"(le)); const int r32e=le&31,hie=le>>5;
  if(hie==0)wsf[32+r32e]=l_reg;asm volatile("s_waitcnt lgkmcnt(0)":::"memory");
  float rli[16];
  #pragma unroll
  for(int r=0;r<16;++r)rli[r]=__builtin_amdgcn_rcpf(wsf[32+crow(r,hie)]);
  bf16*Ow=O+(rowbase+q0+wid*QBLK)*POUT+ocol;
  { bf16*stg=(bf16*)(shm+LDS_OST)+wid*2048;
    #pragma unroll
    for(int hf=0;hf<2;++hf){
    #pragma unroll
    for(int r=0;r<16;++r){const int orow=crow(r,hie);
      #pragma unroll
      for(int d0=0;d0<2;++d0)stg[orow*64+d0*32+r32e]=__float2bfloat16(o[2*hf+d0][r]*rli[r]);}
    asm volatile("s_waitcnt lgkmcnt(0)":::"memory");
    #pragma unroll
    for(int i=0;i<4;++i){const int row=i*8+(le>>3),ch=le&7; const u32x4 v=*(const u32x4*)(stg+row*64+ch*8); ATTN_STORE16(Ow+(long)row*POUT+hf*64+ch*8,v);}
    asm volatile("s_waitcnt lgkmcnt(0)":::"memory"); } } }
  asm volatile("s_waitcnt lgkmcnt(0)\n\ts_barrier":::"memory");
  #undef DMA_K
  #undef DMA_V
  #undef CMASK
  #undef START
  #undef RESC
  #undef ROT
}
constexpr int ATTN_LDS_BYTES=LDS_BYTES;
struct AttnUnit { int bh; int qb; };
struct StaticOrder {
  int vcu;
  __device__ __forceinline__ explicit StaticOrder(int v):vcu(v){}
  __device__ __forceinline__ bool next(int i,AttnUnit&u)const{ if(i>=2)return false; const int s=vcu&7; u.bh=vcu>>3; u.qb=(i==0)?s:15-s; return true; }
};
template<class Sched,int THRL=8> __device__ __forceinline__ void attn_phase(char*lds,const bf16*P,bf16*O,const Sched&S,const int tid){
  AttnUnit u;
  for(int i=0;S.next(i,u);++i){ const int b=u.bh>>3, h=(u.bh>>1)&3, m=u.bh&1;
    attn_unit<THRL>(b, h*128+m*64, 512+h*128+m*64, 1024+h*128, m*512+h*128, u.qb, P, P, P, O, lds, tid); }
}
#undef SBAR
#undef WAIT_BAR
}
#define GAS __attribute__((address_space(1)))
#define LAS __attribute__((address_space(3)))
typedef unsigned short bf16;
typedef unsigned v4u __attribute__((ext_vector_type(4)));
typedef float f32x4 __attribute__((ext_vector_type(4)));
typedef short bf16x8 __attribute__((ext_vector_type(8)));
typedef GAS unsigned gu32;
typedef GAS unsigned long long gu64;
#define RLX_AGENT __ATOMIC_RELAXED, __HIP_MEMORY_SCOPE_AGENT
#define LDS_WAIT() asm volatile("s_waitcnt lgkmcnt(0)" ::: "memory")
#define VM_WAIT() asm volatile("s_waitcnt vmcnt(0)" ::: "memory")
__device__ __forceinline__ unsigned long long rt() { return __builtin_amdgcn_s_memrealtime(); }
__device__ __forceinline__ unsigned f2bf(float f) { unsigned u = __builtin_bit_cast(unsigned, f); return (u + 0x7fffu + ((u >> 16) & 1u)) >> 16; }
__device__ __forceinline__ unsigned pk2(float lo, float hi) { return f2bf(lo) | (f2bf(hi) << 16); }

#define XB_TMO      128
#define XB_XCNT(j)  (256  + 64 * (j))
#define XB_XSUB(j)  (1280 + 64 * (j))
#define XB_XGEN(j)  (2304 + 64 * (j))
#define XB_TOP      3328
#define XB_TOPGEN   3392
#define XCD_BAR_WORDS 3456
#define XB_SPIN_CAP (1u << 22)

__device__ __forceinline__ unsigned xb_ld(unsigned* p)              { return __hip_atomic_load(p, __ATOMIC_RELAXED, __HIP_MEMORY_SCOPE_AGENT); }
__device__ __forceinline__ unsigned xb_add(unsigned* p, unsigned v) { return __hip_atomic_fetch_add(p, v, __ATOMIC_RELAXED, __HIP_MEMORY_SCOPE_AGENT); }
__device__ __forceinline__ unsigned xb_xcc_id() { return (unsigned)__builtin_amdgcn_s_getreg((3 << 11) | 20) & 0xFu; }
#define XB_SPIN(cond, bar) do { unsigned _sp = 0; while (cond) { __builtin_amdgcn_s_sleep(1); \
    if ((++_sp & 255u) == 0u) { if (xb_ld(&(bar)[XB_TMO])) break; if (_sp > XB_SPIN_CAP) { atomicAdd(&(bar)[XB_TMO], 1u); break; } } } } while (0)

struct XcdBarrier {
    unsigned* bar; unsigned x;
    volatile LAS unsigned* st;
};

__device__ __forceinline__ XcdBarrier xcd_barrier_post(unsigned* bar, volatile LAS unsigned* st) {
    XcdBarrier b; b.bar = bar; b.x = xb_xcc_id(); b.st = st;
    if (threadIdx.x == 0) (void)xb_add(&bar[XB_XCNT(b.x)], 1u);
    return b;
}
__device__ __forceinline__ void xcd_barrier_complete(unsigned* bar, unsigned x, unsigned& nloc, unsigned& nx) {
    const unsigned G = gridDim.x * gridDim.y * gridDim.z;
    unsigned sum, cnt, mine, sp = 0u;
    for (;;) {
        sum = 0u; cnt = 0u; mine = 0u;
#pragma unroll
        for (unsigned j = 0; j < 16; ++j) { const unsigned c = xb_ld(&bar[XB_XCNT(j)]); sum += c; cnt += (c > 0u) ? 1u : 0u; mine = (j == x) ? c : mine; }
        if (sum == G) break;
        __builtin_amdgcn_s_sleep(1);
        if ((++sp & 255u) == 0u) { if (xb_ld(&bar[XB_TMO])) break; if (sp > XB_SPIN_CAP) { atomicAdd(&bar[XB_TMO], 1u); break; } }
    }
    nloc = mine > 0u ? mine : 1u; nx = cnt > 0u ? cnt : 1u;
}

__device__ __forceinline__ void xcd_barrier(const XcdBarrier& b, const bool leader  ) {
    asm volatile("s_waitcnt vmcnt(0)" ::: "memory");
    __syncthreads();
    if (leader) {
        unsigned* bar = b.bar;
        __builtin_amdgcn_s_waitcnt(0);
        unsigned nloc = b.st[0], nx = b.st[1];
        if (nloc == 0u) { xcd_barrier_complete(bar, b.x, nloc, nx); b.st[0] = nloc; b.st[1] = nx; }
        const unsigned old = xb_add(&bar[XB_XSUB(b.x)], 1u);
        const unsigned gen = old / nloc;
        if (old + 1u == (gen + 1u) * nloc) {
            __builtin_amdgcn_fence(__ATOMIC_RELEASE, "agent");
            asm volatile("s_waitcnt vmcnt(0)" ::: "memory");
            const unsigned og = xb_add(&bar[XB_TOP], 1u);
            const unsigned tg = og / nx;
            if (og + 1u == (tg + 1u) * nx) xb_add(&bar[XB_TOPGEN], 1u);
            else XB_SPIN(xb_ld(&bar[XB_TOPGEN]) == tg, bar);
            __builtin_amdgcn_fence(__ATOMIC_ACQUIRE, "agent");
            xb_add(&bar[XB_XGEN(b.x)], 1u);
            asm volatile("s_waitcnt vmcnt(0)" ::: "memory");
        } else {
            XB_SPIN(xb_ld(&bar[XB_XGEN(b.x)]) == gen, bar);
            __builtin_amdgcn_fence(__ATOMIC_ACQUIRE, "agent");
            asm volatile("s_waitcnt vmcnt(0)" ::: "memory");
        }
    }
    __syncthreads();
}

constexpr int NWAVES = 8;
constexpr int M = 16384, DM = 1024, SEQL = 4096, NPROJ = 3072, NIN = 3088, NQ = 2048, NLAYER = 2;
constexpr int C_Q = 0, C_K = 512, C_V = 1024, C_SB = 1536, C_SC = 1792, C_SH = 2048, C_GQ = 2304, C_GK = 2432, C_GV = 2560, C_GR = 2816;
constexpr float EPS = 1e-6f;
constexpr float ATT_C2 = 0.125f * 1.4426950408889634f;

constexpr size_t MiB = 1u << 20;
constexpr size_t WS_CTL = 0, CTL_ZERO_BYTES = 1 * MiB;
constexpr size_t WS_WIN = 1 * MiB, WIN_STRIDE = 7 * MiB;
constexpr size_t WS_WOUT = 15 * MiB, WOUT_STRIDE = 2 * MiB;
constexpr size_t WS_WQ = 19 * MiB, WQ_STRIDE = 4 * MiB;
constexpr size_t WS_KEYS = 27 * MiB, KEYS_STRIDE = 65536;
constexpr size_t WS_COS = 28 * MiB, WS_SIN = 28 * MiB + 512 * 1024;
constexpr size_t WS_SSQ = 29 * MiB;
constexpr size_t WS_GD = 30 * MiB;
constexpr size_t WS_LAM = 30 * MiB + 512 * 1024;
constexpr size_t WS_PAR = 30 * MiB + 768 * 1024;
constexpr int PAR_DN = 0, PAR_CW = 256, PAR_WG2 = 1792, PAR_BG = 5888, PAR_GN = 6144, PAR_NF = 6272, PAR_N = 7296;
constexpr size_t WS_GU = 31 * MiB;
constexpr size_t WS_GB = 39 * MiB;
constexpr size_t WS_EXP = 47 * MiB;
constexpr size_t WS_GATE = 55 * MiB;
constexpr size_t WS_U8 = 64 * MiB, TAB_STRIDE = 16 * MiB;
constexpr size_t WS_V8 = 128 * MiB;
constexpr size_t WS_SU = 56 * MiB + 512 * 1024 * 0 + 7 * MiB, WS_SV = WS_SU + 256 * 1024;
constexpr size_t WS_RS1 = 63 * MiB + 512 * 1024;
constexpr size_t WS_XB = 192 * MiB;
constexpr size_t WS_PROJ = 224 * MiB;
constexpr size_t WS_OATT = 320 * MiB;
constexpr size_t WS_MIXED = 352 * MiB;
constexpr size_t WS_QP = 384 * MiB;
constexpr size_t WS_END = 448 * MiB;
constexpr int CW_TMO = 0, CW_BAR = 4096;

constexpr int RING_OFF = 0, RING_BYTES = 131072;
constexpr int LDSCTL_OFF = RING_BYTES, MISC_OFF = LDSCTL_OFF + 320;
constexpr int LDS_BYTES = 147456;

struct Frame {
    LAS unsigned char* lds;
    volatile LAS unsigned* MISC;
    int tid, lane, wave;
    int vcu, G, bx;
    float* out; unsigned char* ws;
};
__device__ __forceinline__ float wave_sum(float v) { return xl_wave_sum(v); }
__device__ __forceinline__ float bflo(unsigned w) { return __builtin_bit_cast(float, w << 16); }
__device__ __forceinline__ float bfhi(unsigned w) { return __builtin_bit_cast(float, w & 0xffff0000u); }
__device__ __forceinline__ float bf1(bf16 h) { return __builtin_bit_cast(float, (unsigned)h << 16); }

__device__ __forceinline__ void p0_transpose_item(const float* W, int ldw, int N, const float* gain, bf16* WT, int K, LAS float* scr, int item, int lane) {
    const int nblk = (N + 31) / 32, kb = item / nblk, nb = item % nblk, k0 = 64 * kb, n0 = 32 * nb;
    const int nn = n0 + (lane & 31);
    float wv[32];
#pragma unroll
    for (int i = 0; i < 32; ++i) { const int kk = 2 * i + (lane >> 5); wv[i] = (nn < N) ? W[(size_t)(k0 + kk) * ldw + nn] : 0.f; }
#pragma unroll
    for (int i = 0; i < 32; ++i) { const int kk = 2 * i + (lane >> 5); float w = wv[i]; if (gain) w *= gain[k0 + kk]; scr[kk * 33 + (lane & 31)] = w; }
    LDS_WAIT(); asm volatile("" ::: "memory");
    const int c = lane & 7;
#pragma unroll
    for (int j = 0; j < 4; ++j) { const int n = (lane >> 3) + 8 * j; const LAS float* s = scr + (8 * c) * 33 + n;
        v4u o; o.x = pk2(s[0 * 33], s[1 * 33]); o.y = pk2(s[2 * 33], s[3 * 33]); o.z = pk2(s[4 * 33], s[5 * 33]); o.w = pk2(s[6 * 33], s[7 * 33]);
        if (n0 + n < N) *(GAS v4u*)(WT + (size_t)(n0 + n) * K + k0 + 8 * c) = o; }
    LDS_WAIT(); asm volatile("" ::: "memory");
}
struct Args;
template <class A> __device__ __forceinline__ void p0_prologue(Frame& F, const A& args) {
    const float* const* in_ = nullptr; (void)in_;
    LAS float* scr = (LAS float*)(F.lds + RING_OFF + F.wave * 16384);
    const int gw = F.vcu * NWAVES + F.wave, NGW = F.G * NWAVES;
    const int gt = F.vcu * (NWAVES * 64) + F.tid, NGT = F.G * NWAVES * 64;
    constexpr int I_IN = 16 * 97, I_OUT = 16 * 32, I_Q = 16 * 64, I_L = I_IN + I_OUT + I_Q;
    for (int it = gw; it < NLAYER * I_L; it += NGW) {
        const int l = it / I_L; int r = it % I_L;
        if (r < I_IN) { p0_transpose_item(args.in[3] + (size_t)l * DM * NIN, NIN, NIN, args.in[2] + l * DM, (bf16*)(F.ws + WS_WIN + l * WIN_STRIDE), DM, scr, r, F.lane); continue; } r -= I_IN;
        if (r < I_OUT) { p0_transpose_item(args.in[13] + (size_t)l * DM * DM, DM, DM, nullptr, (bf16*)(F.ws + WS_WOUT + l * WOUT_STRIDE), DM, scr, r, F.lane); continue; } r -= I_OUT;
        p0_transpose_item(args.in[15] + (size_t)l * DM * NQ, NQ, NQ, args.in[14] + l * DM, (bf16*)(F.ws + WS_WQ + l * WQ_STRIDE), DM, scr, r, F.lane);
    }
    for (int i = gt; i < NLAYER * 2 * 16384; i += NGT) { const int l = i >> 15, hf = (i >> 14) & 1, e = i & 16383;
        ((bf16*)(F.ws + WS_KEYS + l * KEYS_STRIDE))[hf * 16384 + e] = (bf16)f2bf((hf ? args.in[17] : args.in[16])[(size_t)l * 16384 + e]); }
    for (int row0 = gw; row0 < NLAYER * 2 * 16384; row0 += 4 * NGW) {
        f32x4 v[4][4]; float mx[4] = {0.f, 0.f, 0.f, 0.f};
#pragma unroll
        for (int u = 0; u < 4; ++u) { const int row = (row0 + u * NGW < NLAYER * 2 * 16384) ? row0 + u * NGW : row0; const int l = row >> 15, tab = (row >> 14) & 1, e = row & 16383;
            const f32x4* src = (const f32x4*)((tab ? args.in[19] : args.in[18]) + (size_t)l * 16777216 + (size_t)e * DM) + F.lane;
#pragma unroll
            for (int j = 0; j < 4; ++j) v[u][j] = __builtin_nontemporal_load(src + 64 * j); }
#pragma unroll
        for (int u = 0; u < 4; ++u) { const int row = row0 + u * NGW; const int l = row >> 15, tab = (row >> 14) & 1, e = row & 16383;
            if (row < NLAYER * 2 * 16384) {
#pragma unroll
            for (int j = 0; j < 4; ++j) { if (tab == 0) v[u][j] = v[u][j] * ((const f32x4*)(args.in[14] + l * DM))[F.lane + 64 * j];
                mx[u] = fmaxf(mx[u], fmaxf(fmaxf(fabsf(v[u][j][0]), fabsf(v[u][j][1])), fmaxf(fabsf(v[u][j][2]), fabsf(v[u][j][3])))); }
            float m_ = mx[u];
            m_ = fmaxf(m_, xl_swz<1>(m_)); m_ = fmaxf(m_, xl_swz<2>(m_)); m_ = fmaxf(m_, xl_swz<4>(m_)); m_ = fmaxf(m_, xl_swz<8>(m_)); m_ = fmaxf(m_, xl_swz<16>(m_));
            m_ = fmaxf(m_, __builtin_bit_cast(float, xl_xor32_i(__builtin_bit_cast(int, m_), F.lane >> 5)));
            unsigned* dst = (unsigned*)(F.ws + (tab ? WS_V8 : WS_U8) + l * TAB_STRIDE + (size_t)e * DM) + F.lane;
            if (tab) {
                int k = (int)floorf(log2f(224.0f / fmaxf(m_, 1e-30f))); k = k < -60 ? -60 : (k > 60 ? 60 : k);
                const float sc = ldexpf(1.0f, k);
#pragma unroll
                for (int j = 0; j < 4; ++j) { int p = __builtin_amdgcn_cvt_pk_fp8_f32(v[u][j][0] * sc, v[u][j][1] * sc, 0, false); p = __builtin_amdgcn_cvt_pk_fp8_f32(v[u][j][2] * sc, v[u][j][3] * sc, p, true); dst[64 * j] = (unsigned)p; }
                if (F.lane == 0) ((float*)(F.ws + WS_SV))[l * 16384 + e] = ldexpf(1.0f, -k);
            } else {
                const float sc = m_ > 0.f ? 127.0f / m_ : 0.f;
#pragma unroll
                for (int j = 0; j < 4; ++j) { const int q0 = (int)rintf(v[u][j][0] * sc), q1 = (int)rintf(v[u][j][1] * sc), q2 = (int)rintf(v[u][j][2] * sc), q3 = (int)rintf(v[u][j][3] * sc);
                    dst[64 * j] = (unsigned)(q0 & 255) | ((unsigned)(q1 & 255) << 8) | ((unsigned)(q2 & 255) << 16) | ((unsigned)(q3 & 255) << 24); }
                if (F.lane == 0) ((float*)(F.ws + WS_SU))[l * 16384 + e] = m_ * (1.0f / 127.0f);
            } } }
    }
    for (int m0 = gw; m0 < M; m0 += 4 * NGW) {
        f32x4 v[4][4];
#pragma unroll
        for (int u = 0; u < 4; ++u) { const int m = m0 + u * NGW; const f32x4* xr = (const f32x4*)(args.in[0] + (size_t)(m < M ? m : m0) * DM) + F.lane;
#pragma unroll
            for (int j = 0; j < 4; ++j) v[u][j] = __builtin_nontemporal_load(xr + 64 * j); }
#pragma unroll
        for (int u = 0; u < 4; ++u) { const int m = m0 + u * NGW; if (m < M) {
            unsigned long long* o8 = (unsigned long long*)((bf16*)(F.ws + WS_XB) + (size_t)m * DM) + F.lane; float s = 0.f;
#pragma unroll
            for (int j = 0; j < 4; ++j) { const f32x4 w = v[u][j]; s += (w[0] * w[0] + w[1] * w[1]) + (w[2] * w[2] + w[3] * w[3]);
                o8[64 * j] = (unsigned long long)pk2(w[0], w[1]) | ((unsigned long long)pk2(w[2], w[3]) << 32); }
            s = wave_sum(s);
            if (F.lane == 0) ((float*)(F.ws + WS_RS1))[m] = 1.0f / sqrtf(s * (1.0f / 1024.0f) + EPS); } }
    }
    for (int i = gt; i < M * 8; i += NGT) { const int m = i >> 3, j = i & 7; const double inv = pow(500000.0, -(double)j / 8.0); const double ang = (double)((const int*)args.in[1])[m] * inv;
        ((float*)(F.ws + WS_COS))[i] = (float)cos(ang); ((float*)(F.ws + WS_SIN))[i] = (float)sin(ang); }
    if (gt < NLAYER) { const int l = gt; float a = 0.f, b = 0.f;
        for (int i = 0; i < 64; ++i) { a += args.in[4][l * 64 + i] * args.in[5][l * 64 + i]; b += args.in[6][l * 64 + i] * args.in[7][l * 64 + i]; }
        const float lam_init = 0.8f - 0.6f * expf(-0.3f * (float)l);
        ((float*)(F.ws + WS_LAM))[l * 2] = expf(a) - expf(b) + lam_init; ((float*)(F.ws + WS_LAM))[l * 2 + 1] = 1.0f - lam_init; }
    { float* par = (float*)(F.ws + WS_PAR);
      for (int i = gt; i < PAR_N; i += NGT) { float v;
          if (i < PAR_CW) v = args.in[8][i]; else if (i < PAR_WG2) v = args.in[9][i - PAR_CW]; else if (i < PAR_BG) v = args.in[10][i - PAR_WG2]; else if (i < PAR_GN) v = args.in[11][i - PAR_BG];
          else if (i < PAR_NF) v = args.in[12][i - PAR_GN]; else v = args.in[20][i - PAR_NF];
          par[i] = v; } }
}

__device__ __forceinline__ float log_sigmoid(float x) { return fminf(x, 0.f) - __logf(1.0f + __expf(-fabsf(x))); }
template <int K> __device__ __forceinline__ void lds_mm_2x4(float (&acc)[2][4], const LAS float* X, int ldx, const LAS float* Y, int ldy) {
#pragma unroll 4
    for (int k = 0; k < K; k += 4) {
        const f32x4 x0 = *(const LAS f32x4*)(X + k), x1 = *(const LAS f32x4*)(X + ldx + k);
#pragma unroll
        for (int kk = 0; kk < 4; ++kk) { const f32x4 y = *(const LAS f32x4*)(Y + (k + kk) * ldy);
#pragma unroll
            for (int b = 0; b < 4; ++b) { acc[0][b] += x0[kk] * y[b]; acc[1][b] += x1[kk] * y[b]; } }
    }
}
typedef float f32x16g __attribute__((ext_vector_type(16)));
__device__ __forceinline__ int gla_crow(int r, int hh) { return (r & 3) + 8 * (r >> 2) + 4 * hh; }
__device__ __forceinline__ void gla_stage_vt(LAS bf16* VT, const bf16* PROJ, int t0, int tid) {
#pragma unroll
    for (int it = tid; it < 2048; it += 512) { const int eg = it >> 6, t = it & 63; const v4u w = *(const v4u*)(PROJ + (size_t)(t0 + t) * NPROJ + C_GV + eg * 8);
        LAS bf16* p = VT + (eg * 8) * 72 + t;
        p[0] = (bf16)(w.x & 0xffffu); p[72] = (bf16)(w.x >> 16); p[144] = (bf16)(w.y & 0xffffu); p[216] = (bf16)(w.y >> 16);
        p[288] = (bf16)(w.z & 0xffffu); p[360] = (bf16)(w.z >> 16); p[432] = (bf16)(w.w & 0xffffu); p[504] = (bf16)(w.w >> 16); }
}
__device__ __forceinline__ void gla_prep(Frame& F, int l, int ci, int stop_after = 0) {
    typedef float f32x4m __attribute__((ext_vector_type(4)));
    LAS float* LR = (LAS float*)(F.lds + RING_OFF);
    LAS bf16* KHT = (LAS bf16*)(LR + 2 * 64 * 17);
    LAS bf16* VT = KHT + 128 * 72;
    LAS float* W2s = (LAS float*)(VT + 256 * 72);
    const int t0 = ci * 64, tid = F.tid, lane = F.lane, wave = F.wave, r32 = lane & 31, hh = lane >> 5;
    const bf16* XB = (const bf16*)(F.ws + WS_XB); const bf16* PROJ = (const bf16*)(F.ws + WS_PROJ);
    const bf16* Wlr = (const bf16*)(F.ws + WS_WIN + l * WIN_STRIDE) + (size_t)NPROJ * DM;
    v4u kw0, kw1; float rs;
    {
        const int mt = wave & 3, kh = wave >> 2, fr = lane & 15, fq = lane >> 4;
        f32x4m acc = (f32x4m){0.f, 0.f, 0.f, 0.f};
        const bf16* ap = XB + (size_t)(t0 + mt * 16 + fr) * DM + kh * 512 + fq * 8; const bf16* bp = Wlr + (size_t)fr * DM + kh * 512 + fq * 8;
        bf16x8 av[16], bv[16];
#pragma unroll
        for (int ks = 0; ks < 16; ++ks) { av[ks] = *(const bf16x8*)(ap + ks * 32); bv[ks] = *(const bf16x8*)(bp + ks * 32); }
        gla_stage_vt(VT, PROJ, t0, tid);
        { const float* W2g = (const float*)(F.ws + WS_PAR) + PAR_WG2 + l * 16 * 128; const float* bgg = (const float*)(F.ws + WS_PAR) + PAR_BG + l * 128;
#pragma unroll
          for (int q = 0; q < 4; ++q) W2s[tid + 512 * q] = W2g[tid + 512 * q];
          if (tid < 128) W2s[2048 + tid] = bgg[tid]; }
        { const bf16* kp = PROJ + (size_t)(t0 + lane) * NPROJ + C_GK + 16 * wave; kw0 = *(const v4u*)kp; kw1 = *(const v4u*)(kp + 8); rs = ((const float*)(F.ws + WS_RS1))[t0 + lane]; }
#pragma unroll
        for (int ks = 0; ks < 16; ++ks) acc = __builtin_amdgcn_mfma_f32_16x16x32_bf16(av[ks], bv[ks], acc, 0, 0, 0);
#pragma unroll
        for (int i = 0; i < 4; ++i) LR[kh * (64 * 17) + (mt * 16 + fq * 4 + i) * 17 + fr] = acc[i];
    }
    __syncthreads();
    if (stop_after == 1) return;
    {
        const int d0 = 16 * wave, t = lane;
        float lr[16];
#pragma unroll
        for (int r = 0; r < 16; ++r) lr[r] = (LR[t * 17 + r] + LR[64 * 17 + t * 17 + r]) * rs;
        const LAS float* W2 = W2s + d0; const LAS float* bg = W2s + 2048 + d0;
        float bb[16];
#pragma unroll
        for (int dd = 0; dd < 16; ++dd) { float x = bg[dd];
#pragma unroll
            for (int r = 0; r < 16; ++r) x += lr[r] * W2[r * 128 + dd];
            bb[dd] = log_sigmoid(x) * (1.0f / 16.0f); }
#pragma unroll
        for (int off = 1; off < 64; off <<= 1) { const int src = ((lane - off) & 63) << 2;
#pragma unroll
            for (int dd = 0; dd < 16; ++dd) { const float o = __builtin_bit_cast(float, __builtin_amdgcn_ds_bpermute(src, __builtin_bit_cast(int, bb[dd]))); bb[dd] += (lane >= off) ? o : 0.f; } }
        float* GB = (float*)(F.ws + WS_GB) + (size_t)(t0 + t) * 128 + d0;
#pragma unroll
        for (int q = 0; q < 4; ++q) *(f32x4*)(GB + 4 * q) = (f32x4){bb[4 * q], bb[4 * q + 1], bb[4 * q + 2], bb[4 * q + 3]};
        const unsigned kw[8] = {kw0.x, kw0.y, kw0.z, kw0.w, kw1.x, kw1.y, kw1.z, kw1.w};
        float dc[16];
#pragma unroll
        for (int dd = 0; dd < 16; ++dd) { const float bl = __builtin_bit_cast(float, __builtin_amdgcn_readlane(__builtin_bit_cast(int, bb[dd]), 63)); dc[dd] = expf(bl);
            const float kv = (dd & 1) ? bfhi(kw[dd >> 1]) : bflo(kw[dd >> 1]); KHT[(d0 + dd) * 72 + t] = (bf16)f2bf(kv * expf(bl - bb[dd])); }
        if (lane == 0) { float* GD = (float*)(F.ws + WS_GD) + ci * 128 + d0;
#pragma unroll
            for (int q = 0; q < 4; ++q) *(f32x4*)(GD + 4 * q) = (f32x4){dc[4 * q], dc[4 * q + 1], dc[4 * q + 2], dc[4 * q + 3]}; }
    }
    __syncthreads();
    if (stop_after == 2) return;
    {
        const int h = wave >> 1, eb = wave & 1; f32x16g U = {};
#pragma unroll
        for (int ks = 0; ks < 4; ++ks) { const bf16x8 ka = *(const LAS bf16x8*)(KHT + (h * 32 + r32) * 72 + ks * 16 + 8 * hh); const bf16x8 vb = *(const LAS bf16x8*)(VT + (h * 64 + eb * 32 + r32) * 72 + ks * 16 + 8 * hh);
            U = __builtin_amdgcn_mfma_f32_32x32x16_bf16(ka, vb, U, 0, 0, 0); }
        float* GU = (float*)(F.ws + WS_GU) + (size_t)(ci * 4 + h) * 2048 + eb * 32 + r32;
#pragma unroll
        for (int r = 0; r < 16; ++r) GU[gla_crow(r, hh) * 64] = U[r];
    }
    __syncthreads();
}
__device__ __forceinline__ void gla_scan(Frame& F) {
    if (F.tid < 128) { const int gid = F.vcu * 128 + F.tid;
        if (gid < 32768) { const int b = gid >> 13, h = (gid >> 11) & 3, d = (gid >> 6) & 31, e = gid & 63; float s = 0.f;
            float* GU = (float*)(F.ws + WS_GU); const float* GD = (const float*)(F.ws + WS_GD);
            for (int c0 = 0; c0 < 64; c0 += 16) { float u[16], dc[16];
#pragma unroll
                for (int i = 0; i < 16; ++i) { const int ci = b * 64 + c0 + i; u[i] = GU[((size_t)(ci * 4 + h) * 32 + d) * 64 + e]; dc[i] = GD[ci * 128 + h * 32 + d]; }
#pragma unroll
                for (int i = 0; i < 16; ++i) { const int ci = b * 64 + c0 + i; GU[((size_t)(ci * 4 + h) * 32 + d) * 64 + e] = s; s = dc[i] * s + u[i]; } } } }
}
__device__ __forceinline__ void mix_chunk(Frame& F, int l, int ci) {
    LAS bf16* QB = (LAS bf16*)(F.lds + RING_OFF);
    LAS bf16* KB = QB + 64 * 136;
    LAS bf16* VT = KB + 64 * 136;
    LAS bf16* ST = VT + 256 * 72;
    const int t0 = ci * 64, tid = F.tid, lane = F.lane, wave = F.wave, r32 = lane & 31, hh = lane >> 5;
    const bf16* PROJ = (const bf16*)(F.ws + WS_PROJ); bf16* MIXED = (bf16*)(F.ws + WS_MIXED);
    const float* GB = (const float*)(F.ws + WS_GB) + (size_t)t0 * 128;
    const int h = wave >> 1, ib = wave & 1, i0 = 32 * ib;
#pragma unroll
    for (int it = tid; it < 1024; it += 512) { const int t = it >> 4, d0 = (it & 15) * 8;
        const f32x4 b0 = *(const f32x4*)(GB + t * 128 + d0), b1 = *(const f32x4*)(GB + t * 128 + d0 + 4);
        const bf16* pr = PROJ + (size_t)(t0 + t) * NPROJ; const v4u qw = *(const v4u*)(pr + C_GQ + d0), kw = *(const v4u*)(pr + C_GK + d0);
        const float bv[8] = {b0[0], b0[1], b0[2], b0[3], b1[0], b1[1], b1[2], b1[3]}; const unsigned qa[4] = {qw.x, qw.y, qw.z, qw.w}, ka[4] = {kw.x, kw.y, kw.z, kw.w};
        unsigned qo[4], ko[4];
#pragma unroll
        for (int p = 0; p < 4; ++p) { const float e0 = expf(bv[2 * p]), e1 = expf(bv[2 * p + 1]), n0 = expf(-bv[2 * p]), n1 = expf(-bv[2 * p + 1]);
            qo[p] = pk2(bflo(qa[p]) * 0.17677669529663687f * e0, bfhi(qa[p]) * 0.17677669529663687f * e1); ko[p] = pk2(bflo(ka[p]) * n0, bfhi(ka[p]) * n1); }
        *(LAS v4u*)(QB + t * 136 + d0) = (v4u){qo[0], qo[1], qo[2], qo[3]}; *(LAS v4u*)(KB + t * 136 + d0) = (v4u){ko[0], ko[1], ko[2], ko[3]}; }
    gla_stage_vt(VT, PROJ, t0, tid);
    { const float* GU = (const float*)(F.ws + WS_GU) + (size_t)ci * 8192;
      float sv[16];
#pragma unroll
      for (int q = 0; q < 16; ++q) sv[q] = GU[tid + 512 * q];
#pragma unroll
      for (int q = 0; q < 16; ++q) { const int it = tid + 512 * q, hd = it >> 6, e = it & 63; ST[((hd >> 5) * 64 + e) * 40 + (hd & 31)] = (bf16)f2bf(sv[q]); } }
    const size_t row = (size_t)(t0 + i0 + r32); unsigned long long rg[8];
#pragma unroll
    for (int q = 0; q < 8; ++q) rg[q] = *(const unsigned long long*)(PROJ + row * NPROJ + C_GR + h * 64 + 32 * (q >> 2) + 8 * (q & 3) + 4 * hh);
    __syncthreads();
    {
        bf16x8 qf[2];
#pragma unroll
        for (int ks = 0; ks < 2; ++ks) qf[ks] = *(const LAS bf16x8*)(QB + (i0 + r32) * 136 + h * 32 + ks * 16 + 8 * hh);
        f32x16g OT[2] = {{}, {}};
#pragma unroll
        for (int eb = 0; eb < 2; ++eb)
#pragma unroll
            for (int ks = 0; ks < 2; ++ks) { const bf16x8 sa = *(const LAS bf16x8*)(ST + (h * 64 + eb * 32 + r32) * 40 + ks * 16 + 8 * hh); OT[eb] = __builtin_amdgcn_mfma_f32_32x32x16_bf16(sa, qf[ks], OT[eb], 0, 0, 0); }
#pragma unroll
        for (int jb = 0; jb < 2; ++jb) if (jb <= ib) {
            f32x16g X = {};
#pragma unroll
            for (int ks = 0; ks < 2; ++ks) { const bf16x8 ka = *(const LAS bf16x8*)(KB + (32 * jb + r32) * 136 + h * 32 + ks * 16 + 8 * hh); X = __builtin_amdgcn_mfma_f32_32x32x16_bf16(ka, qf[ks], X, 0, 0, 0); }
            if (jb == ib) {
#pragma unroll
                for (int r = 0; r < 16; ++r) if (gla_crow(r, hh) > r32) X[r] = 0.f;
            }
#pragma unroll
            for (int s = 0; s < 2; ++s) { v4u xw; xw.x = pk2(X[8 * s], X[8 * s + 1]); xw.y = pk2(X[8 * s + 2], X[8 * s + 3]); xw.z = pk2(X[8 * s + 4], X[8 * s + 5]); xw.w = pk2(X[8 * s + 6], X[8 * s + 7]);
                const bf16x8 xb = __builtin_bit_cast(bf16x8, xw);
#pragma unroll
                for (int eb = 0; eb < 2; ++eb) { const LAS bf16* vp = VT + (h * 64 + eb * 32 + r32) * 72 + 32 * jb + 16 * s + 4 * hh;
                    const unsigned long long lo = *(const LAS unsigned long long*)vp, hi = *(const LAS unsigned long long*)(vp + 8);
                    const v4u vw = (v4u){(unsigned)lo, (unsigned)(lo >> 32), (unsigned)hi, (unsigned)(hi >> 32)};
                    OT[eb] = __builtin_amdgcn_mfma_f32_32x32x16_bf16(__builtin_bit_cast(bf16x8, vw), xb, OT[eb], 0, 0, 0); } }
        }
        float ss = 0.f;
#pragma unroll
        for (int eb = 0; eb < 2; ++eb)
#pragma unroll
            for (int r = 0; r < 16; ++r) ss += OT[eb][r] * OT[eb][r];
        ss = xl_sum32(ss);
        const float rs = 1.0f / sqrtf(ss * (1.0f / 64.0f) + EPS); const float* gn = (const float*)(F.ws + WS_PAR) + PAR_GN + l * 64;
#pragma unroll
        for (int q = 0; q < 8; ++q) { const int eb = q >> 2, g = q & 3, e0 = 32 * eb + 8 * g + 4 * hh; const f32x4 g4 = *(const f32x4*)(gn + e0);
            const unsigned r0 = (unsigned)rg[q], r1 = (unsigned)(rg[q] >> 32); const float rr[4] = {bflo(r0), bfhi(r0), bflo(r1), bfhi(r1)}; float y[4];
#pragma unroll
            for (int k = 0; k < 4; ++k) { const float sl = rr[k] / (1.0f + expf(-rr[k])); y[k] = OT[eb][4 * g + k] * rs * g4[k] * sl; }
            *(unsigned long long*)(MIXED + row * DM + 768 + h * 64 + e0) = (unsigned long long)pk2(y[0], y[1]) | ((unsigned long long)pk2(y[2], y[3]) << 32); }
    }
    const float lam = ((const float*)(F.ws + WS_LAM))[l * 2], oscale = ((const float*)(F.ws + WS_LAM))[l * 2 + 1];
    const bf16* OATT = (const bf16*)(F.ws + WS_OATT); const float* dn = (const float*)(F.ws + WS_PAR) + PAR_DN + l * 128; const float* cw = (const float*)(F.ws + WS_PAR) + PAR_CW + l * 3 * 256;
    const float dn0 = dn[2 * lane], dn1 = dn[2 * lane + 1]; const int ch = 4 * lane;
    f32x4 wj[3];
#pragma unroll
    for (int j = 0; j < 3; ++j) wj[j] = *(const f32x4*)(cw + j * 256 + ch);
#pragma unroll 1
    for (int r0 = 0; r0 < 8; r0 += 4) {
        unsigned w1[4][4], w2[4][4]; unsigned long long cwd[6], hwd[6], bwd[4];
        const int tb = t0 + wave * 8 + r0;
#pragma unroll
        for (int u = 0; u < 4; ++u)
#pragma unroll
            for (int hq = 0; hq < 4; ++hq) { w1[u][hq] = *(const unsigned*)(OATT + (size_t)(tb + u) * DM + hq * 128 + 2 * lane); w2[u][hq] = *(const unsigned*)(OATT + (size_t)(tb + u) * DM + 512 + hq * 128 + 2 * lane); }
#pragma unroll
        for (int u = 0; u < 6; ++u) { const int tr = tb - 2 + u; const bool ok = ((tb & (SEQL - 1)) - 2 + u) >= 0;
            const bf16* pr = PROJ + (size_t)(ok ? tr : tb) * NPROJ; cwd[u] = ok ? *(const unsigned long long*)(pr + C_SC + ch) : 0ull; hwd[u] = ok ? *(const unsigned long long*)(pr + C_SH + ch) : 0ull; }
#pragma unroll
        for (int u = 0; u < 4; ++u) bwd[u] = *(const unsigned long long*)(PROJ + (size_t)(tb + u) * NPROJ + C_SB + ch);
        f32x4 z[6];
#pragma unroll
        for (int u = 0; u < 6; ++u) { const unsigned c0 = (unsigned)cwd[u], c1 = (unsigned)(cwd[u] >> 32), h0 = (unsigned)hwd[u], h1 = (unsigned)(hwd[u] >> 32); z[u] = (f32x4){bflo(c0) * bflo(h0), bfhi(c0) * bfhi(h0), bflo(c1) * bflo(h1), bfhi(c1) * bfhi(h1)}; }
#pragma unroll
        for (int u = 0; u < 4; ++u) { const int t = tb + u;
#pragma unroll
            for (int hq = 0; hq < 4; ++hq) { const float o0 = bflo(w1[u][hq]) - lam * bflo(w2[u][hq]), o1 = bfhi(w1[u][hq]) - lam * bfhi(w2[u][hq]); const float ssq = wave_sum(o0 * o0 + o1 * o1);
                const float rsq = oscale / sqrtf(ssq * (1.0f / 128.0f) + EPS);
                *(unsigned*)(MIXED + (size_t)t * DM + hq * 128 + 2 * lane) = pk2(o0 * rsq * dn0, o1 * rsq * dn1); }
            const f32x4 y = wj[0] * z[u] + wj[1] * z[u + 1] + wj[2] * z[u + 2];
            const unsigned b0 = (unsigned)bwd[u], b1 = (unsigned)(bwd[u] >> 32);
            *(unsigned long long*)(MIXED + (size_t)t * DM + 512 + ch) = (unsigned long long)pk2(bflo(b0) * y[0], bfhi(b0) * y[1]) | ((unsigned long long)pk2(bflo(b1) * y[2], bfhi(b1) * y[3]) << 32); }
    }
    __syncthreads();
}

#define TK_HD __device__ __forceinline__
#ifndef TK_HD
#define TK_HD __device__ __forceinline__
#endif
TK_HD int tk_max(int a, int b) { return a > b ? a : b; }
TK_HD int tk_min(int a, int b) { return a < b ? a : b; }
TK_HD int tk_f2key(float f) { int b = __builtin_bit_cast(int, f); return b ^ ((b >> 31) & 0x7fffffff); }
TK_HD float tk_key2f(int k) { return __builtin_bit_cast(float, k ^ ((k >> 31) & 0x7fffffff)); }
template <int N> TK_HD void tk_sort_desc(int (&a)[N]) {
#pragma unroll
    for (int k = 2; k <= N; k <<= 1)
#pragma unroll
        for (int j = k >> 1; j > 0; j >>= 1)
#pragma unroll
            for (int i = 0; i < N; ++i) { const int l = i ^ j; if (l > i) { const int hi = tk_max(a[i], a[l]), lo = tk_min(a[i], a[l]); if ((i & k) == 0) { a[i] = hi; a[l] = lo; } else { a[i] = lo; a[l] = hi; } } }
}
template <int N> TK_HD void tk_merge_desc(int (&a)[N]) {
#pragma unroll
    for (int j = N >> 1; j > 0; j >>= 1)
#pragma unroll
        for (int i = 0; i < N; ++i) { const int l = i ^ j; if (l > i) { const int hi = tk_max(a[i], a[l]), lo = tk_min(a[i], a[l]); a[i] = hi; a[l] = lo; } }
}
TK_HD void tk_top16_merge(int (&a)[16], const int (&b)[16]) {
#pragma unroll
    for (int i = 0; i < 16; ++i) a[i] = tk_max(a[i], b[15 - i]);
    tk_merge_desc<16>(a);
}
TK_HD constexpr int tk_cand_i(int set, int s) {
    if (set == 0) return s < 16 ? 0 : (s < 24 ? 1 : (s == 24 ? 8 : -1));
    return s < 5 ? 2 : s < 9 ? 3 : s < 12 ? 4 : s < 14 ? 5 : s < 16 ? 6 : s < 18 ? 7 : s < 25 ? (9 + (s - 18)) : -1;
}
TK_HD constexpr int tk_cand_j(int set, int s) {
    if (set == 0) return s < 16 ? s : (s < 24 ? s - 16 : (s == 24 ? 0 : -1));
    return s < 5 ? s : s < 9 ? s - 5 : s < 12 ? s - 9 : s < 14 ? s - 12 : s < 16 ? s - 14 : s < 18 ? s - 16 : s < 25 ? 0 : -1;
}

constexpr int PS_KSTRIDE = 136;
__device__ __forceinline__ void peer_select_task(Frame& F, int l, int t0, int h, LAS int* scr  , const LAS bf16* KL  ) {
    typedef float f32x16 __attribute__((ext_vector_type(16)));
    const int lane = F.lane, r32 = lane & 31, hi = lane >> 5;
    const bf16* QP = (const bf16*)(F.ws + WS_QP);
    int lists[2][16];
    bf16x8 qall[2][8];
#pragma unroll
    for (int half = 0; half < 2; ++half) { const bf16* qp = QP + (size_t)(t0 + r32) * NQ + h * 256 + half * 128 + hi * 8;
#pragma unroll
        for (int ks = 0; ks < 8; ++ks) qall[half][ks] = *(const bf16x8*)(qp + ks * 16); }
#pragma unroll
    for (int half = 0; half < 2; ++half) {
        const bf16x8 (&qf)[8] = qall[half];
        int cur[16];
#pragma unroll
        for (int kb = 0; kb < 4; ++kb) {
            f32x16 c = {};
            const LAS bf16* kp = KL + (half * 128 + kb * 32 + r32) * PS_KSTRIDE + hi * 8;
#pragma unroll
            for (int ks = 0; ks < 8; ++ks) { const bf16x8 kf = *(const LAS bf16x8*)(kp + ks * 16); c = __builtin_amdgcn_mfma_f32_32x32x16_bf16(kf, qf[ks], c, 0, 0, 0); }
            int g[16];
#pragma unroll
            for (int r = 0; r < 16; ++r) { const int key = kb * 32 + (r & 3) + 8 * (r >> 2) + 4 * hi; g[r] = (tk_f2key(c[r]) & ~127) | (127 - key); }
            tk_sort_desc<16>(g);
            if (kb == 0) {
#pragma unroll
                for (int r = 0; r < 16; ++r) cur[r] = g[r];
            } else tk_top16_merge(cur, g);
        }
        int oth[16];
#pragma unroll
        for (int r = 0; r < 16; ++r) oth[r] = xl_xor32_i(cur[r], hi);
        tk_top16_merge(cur, oth);
#pragma unroll
        for (int r = 0; r < 16; ++r) lists[half][r] = cur[r];
    }
#pragma unroll
    for (int r = 0; r < 16; ++r) scr[r32 * 32 + hi * 16 + r] = 127 - ((hi ? lists[1][r] : lists[0][r]) & 127);
    float v1[16], v2[16];
#pragma unroll
    for (int r = 0; r < 16; ++r) { v1[r] = tk_key2f(lists[0][r]); v2[r] = tk_key2f(lists[1][r]); }
    int c[32];
#pragma unroll
    for (int s = 0; s < 32; ++s) {
        constexpr int NEG = (int)0x80000000;
        const int ia = tk_cand_i(0, s), ja = tk_cand_j(0, s), ib = tk_cand_i(1, s), jb = tk_cand_j(1, s);
        if (ia < 0) c[s] = NEG;
        else { const int ka = (tk_f2key(v1[ia] + v2[ja]) & ~255) | (255 - (ia * 16 + ja)), kb2 = (tk_f2key(v1[ib] + v2[jb]) & ~255) | (255 - (ib * 16 + jb)); c[s] = hi ? kb2 : ka; }
    }
    tk_sort_desc<32>(c);
    int fin[16], oth[16];
#pragma unroll
    for (int r = 0; r < 16; ++r) { fin[r] = c[r]; oth[r] = xl_xor32_i(c[r], hi); }
    tk_top16_merge(fin, oth);
    float p[16]; float sum = 0.f; const float mx = tk_key2f(fin[0]);
#pragma unroll
    for (int r = 0; r < 16; ++r) { p[r] = expf(tk_key2f(fin[r]) - mx); sum += p[r]; }
    const float inv = 1.0f / sum;
    asm volatile("s_waitcnt lgkmcnt(0)" ::: "memory");
    int* EX = (int*)(F.ws + WS_EXP) + (size_t)(t0 + r32) * 128 + h * 16; float* GT = (float*)(F.ws + WS_GATE) + (size_t)(t0 + r32) * 128 + h * 16;
#pragma unroll
    for (int r = 0; r < 16; ++r) { const int code = 255 - (fin[r] & 255); const int e1 = scr[r32 * 32 + (code >> 4)], e2 = scr[r32 * 32 + 16 + (code & 15)];
        if ((r >> 3) == hi) { EX[r] = e1 * 128 + e2; GT[r] = p[r] * inv; } }
    asm volatile("s_waitcnt lgkmcnt(0)" ::: "memory");
}

__device__ __forceinline__ float gelu_erf(float v) {
    const float av = fabsf(v), t = __builtin_amdgcn_rcpf(av * 0.2316418882f + 1.0f);
    float q = t * 0.5307027145f + (-0.7265760135f); q = q * t + 0.7107068705f; q = q * t + (-0.142248368f); q = q * t + 0.127414796f; q = q * t;
    const float e = __builtin_amdgcn_exp2f((v * v) * (-0.72134752044f)); const float m_ = v * (q * e);
    return v < 0.f ? m_ : v - m_;
}
typedef __bf16 bf16x2_t __attribute__((ext_vector_type(2)));
__device__ __forceinline__ float dot2bf(unsigned a, unsigned b, float c) { return __builtin_amdgcn_fdot2_f32_bf16(__builtin_bit_cast(bf16x2_t, a), __builtin_bit_cast(bf16x2_t, b), c, false); }
template <int J> __device__ __forceinline__ int xl_xchg_i(int v, int hi) { if constexpr (J == 32) return xl_xor32_i(v, hi); else return xl_swz_i<J>(v); }
template <int K, int J> __device__ __forceinline__ void sort128_step(int& ka, int& kb, int lane) {
    if constexpr (J == 64) { const int lo = ka < kb ? ka : kb, hi = ka < kb ? kb : ka; ka = lo; kb = hi; }
    else { const int oa = xl_xchg_i<J>(ka, lane >> 5), ob = xl_xchg_i<J>(kb, lane >> 5); const bool lower = (lane & J) == 0;
        const bool upa = (K >= 64) ? true : ((lane & K) == 0), upb = (K >= 128) ? true : (K == 64 ? false : ((lane & K) == 0));
        const int mina = ka < oa ? ka : oa, maxa = ka < oa ? oa : ka, minb = kb < ob ? kb : ob, maxb = kb < ob ? ob : kb;
        ka = (upa == lower) ? mina : maxa; kb = (upb == lower) ? minb : maxb; }
}
__device__ __forceinline__ void sort128(int& ka, int& kb, int lane) {
#define S_(K, J) sort128_step<K, J>(ka, kb, lane);
    S_(2, 1) S_(4, 2) S_(4, 1) S_(8, 4) S_(8, 2) S_(8, 1) S_(16, 8) S_(16, 4) S_(16, 2) S_(16, 1) S_(32, 16) S_(32, 8) S_(32, 4) S_(32, 2) S_(32, 1)
    S_(64, 32) S_(64, 16) S_(64, 8) S_(64, 4) S_(64, 2) S_(64, 1) S_(128, 64) S_(128, 32) S_(128, 16) S_(128, 8) S_(128, 4) S_(128, 2) S_(128, 1)
#undef S_
}
typedef float f32x2g __attribute__((ext_vector_type(2)));
#define PT_WGSYNC 1
#ifndef PT_SYNC_EVERY
#define PT_SYNC_EVERY 4
#endif
#ifndef PT_FIXED_ORDER
#define PT_GREEDY 1
#endif
#ifndef PT_CH
#define PT_CH 8
#endif
constexpr int PT_T = 4;
constexpr int PT_TOK_INTS = 128 + 128 + 64 + 256 + 4 + 128;
constexpr int PT_WAVE_INTS = PT_T * PT_TOK_INTS;
__device__ __forceinline__ float pt_dot8(const v4u w, const f32x2g (&xv)[8]) {
    f32x2g a = (f32x2g){0.f, 0.f};
    a = __builtin_elementwise_fma(__builtin_amdgcn_cvt_pk_f32_fp8(w.x, false), xv[0], a); a = __builtin_elementwise_fma(__builtin_amdgcn_cvt_pk_f32_fp8(w.x, true), xv[1], a);
    a = __builtin_elementwise_fma(__builtin_amdgcn_cvt_pk_f32_fp8(w.y, false), xv[2], a); a = __builtin_elementwise_fma(__builtin_amdgcn_cvt_pk_f32_fp8(w.y, true), xv[3], a);
    a = __builtin_elementwise_fma(__builtin_amdgcn_cvt_pk_f32_fp8(w.z, false), xv[4], a); a = __builtin_elementwise_fma(__builtin_amdgcn_cvt_pk_f32_fp8(w.z, true), xv[5], a);
    a = __builtin_elementwise_fma(__builtin_amdgcn_cvt_pk_f32_fp8(w.w, false), xv[6], a); a = __builtin_elementwise_fma(__builtin_amdgcn_cvt_pk_f32_fp8(w.w, true), xv[7], a);
    return a.x + a.y;
}
__device__ __forceinline__ void pt_axpy8(const v4u w, const float c, f32x2g (&o)[8]) {
    const f32x2g cc = (f32x2g){c, c};
    o[0] = __builtin_elementwise_fma(__builtin_amdgcn_cvt_pk_f32_fp8(w.x, false), cc, o[0]); o[1] = __builtin_elementwise_fma(__builtin_amdgcn_cvt_pk_f32_fp8(w.x, true), cc, o[1]);
    o[2] = __builtin_elementwise_fma(__builtin_amdgcn_cvt_pk_f32_fp8(w.y, false), cc, o[2]); o[3] = __builtin_elementwise_fma(__builtin_amdgcn_cvt_pk_f32_fp8(w.y, true), cc, o[3]);
    o[4] = __builtin_elementwise_fma(__builtin_amdgcn_cvt_pk_f32_fp8(w.z, false), cc, o[4]); o[5] = __builtin_elementwise_fma(__builtin_amdgcn_cvt_pk_f32_fp8(w.z, true), cc, o[5]);
    o[6] = __builtin_elementwise_fma(__builtin_amdgcn_cvt_pk_f32_fp8(w.w, false), cc, o[6]); o[7] = __builtin_elementwise_fma(__builtin_amdgcn_cvt_pk_f32_fp8(w.w, true), cc, o[7]);
}
__device__ __forceinline__ int xl_sum32_i(int v) { unsigned a = (unsigned)v, b = a; asm volatile("" : "+v"(b)); auto r = __builtin_amdgcn_permlane32_swap(a, b, false, false); const unsigned r0 = r[0], r1 = r[1]; return (int)(r0 + r1); }
__device__ __forceinline__ void pt_chunk(const LAS int* se, const LAS float* sg, int base, const v4u xq, f32x2g (&out)[8], float hscale,
                                         const unsigned char* Ub, const unsigned char* Vb, const float* SU, const float* SV, int lane) {
    const int e_l = se[base + (lane & (PT_CH - 1))]; const float g_l = sg[base + (lane & (PT_CH - 1))], hu_l = sg[452 + base + (lane & (PT_CH - 1))];
    v4u uw[PT_CH], vw[PT_CH];
#pragma unroll
    for (int s = 0; s < PT_CH; ++s) { const int e = __builtin_amdgcn_readlane(e_l, s); uw[s] = *(const v4u*)(Ub + (size_t)e * 1024 + 16 * lane); }
#pragma unroll
    for (int s = 0; s < PT_CH; ++s) { const int e = __builtin_amdgcn_readlane(e_l, s); vw[s] = *(const v4u*)(Vb + (size_t)e * 1024 + 16 * lane); }
    int p[PT_CH];
#pragma unroll
    for (int s = 0; s < PT_CH; ++s) { int a = __builtin_amdgcn_sdot4((int)uw[s].x, (int)xq.x, 0, false); a = __builtin_amdgcn_sdot4((int)uw[s].y, (int)xq.y, a, false);
        a = __builtin_amdgcn_sdot4((int)uw[s].z, (int)xq.z, a, false); p[s] = __builtin_amdgcn_sdot4((int)uw[s].w, (int)xq.w, a, false); }
#define PT_BFLY(S) _Pragma("unroll") for (int i = 0; i < S; ++i) { const bool up = (lane & S) != 0; const int keep = up ? p[i + S] : p[i], send = up ? p[i] : p[i + S]; p[i] = keep + xl_swz_i<S>(send); }
#if PT_CH == 16
    PT_BFLY(8)
#endif
    PT_BFLY(4) PT_BFLY(2) PT_BFLY(1)
#undef PT_BFLY
    int hi_ = p[0];
#if PT_CH == 8
    hi_ += xl_swz_i<8>(hi_);
#endif
    hi_ += xl_swz_i<16>(hi_); hi_ = xl_sum32_i(hi_);
    const float c_l = g_l * gelu_erf((float)hi_ * hu_l);
#pragma unroll
    for (int s = 0; s < PT_CH; ++s) { const float c = __builtin_bit_cast(float, __builtin_amdgcn_readlane(__builtin_bit_cast(int, c_l), s)); pt_axpy8(vw[s], c, out); }
}
__device__ __forceinline__ void pt_sort_regs(LAS int* se, LAS float* sg, LAS int* cnt, LAS float* sh, int ea, int eb, float ga, float gb, float ha, float hb, int lane) {
    cnt[lane] = 0;
    asm volatile("s_waitcnt lgkmcnt(0)" ::: "memory");
    __hip_atomic_fetch_add(cnt + (ea >> 8), 1, __ATOMIC_RELAXED, __HIP_MEMORY_SCOPE_WAVEFRONT); __hip_atomic_fetch_add(cnt + (eb >> 8), 1, __ATOMIC_RELAXED, __HIP_MEMORY_SCOPE_WAVEFRONT);
    asm volatile("s_waitcnt lgkmcnt(0)" ::: "memory");
    const int c = cnt[lane]; int incl = c;
    int ln = lane; asm volatile("" : "+v"(ln));
#pragma unroll
    for (int off = 1; off < 64; off <<= 1) { const int o = __builtin_amdgcn_ds_bpermute(((ln - off) & 63) << 2, incl); incl += (ln >= off) ? o : 0; }
    asm volatile("s_waitcnt lgkmcnt(0)" ::: "memory");
    cnt[lane] = incl - c;
    asm volatile("s_waitcnt lgkmcnt(0)" ::: "memory");
    const int pa = __hip_atomic_fetch_add(cnt + (ea >> 8), 1, __ATOMIC_RELAXED, __HIP_MEMORY_SCOPE_WAVEFRONT);
    const int pb = __hip_atomic_fetch_add(cnt + (eb >> 8), 1, __ATOMIC_RELAXED, __HIP_MEMORY_SCOPE_WAVEFRONT);
    se[pa] = ea; sg[pa] = ga; sh[pa] = ha; se[pb] = eb; sg[pb] = gb; sh[pb] = hb;
    asm volatile("s_waitcnt lgkmcnt(0)" ::: "memory");
}
__device__ __forceinline__ void pt_sort(LAS int* se, LAS float* sg, LAS int* cnt, const int* EX, const float* GT, int lane, bool dry, const float* SU = nullptr, const float* SV = nullptr, float hs = 1.0f, LAS float* sh = nullptr) {
    int ea = EX[lane], eb = EX[64 + lane];
#ifdef DRYMASK
    if (dry) { ea &= DRYMASK; eb &= DRYMASK; }
#endif
    (void)dry; float ga = GT[lane], gb = GT[64 + lane]; float ha = 0.f, hb = 0.f;
    if (sh) { ga *= SV[ea]; gb *= SV[eb]; ha = hs * SU[ea]; hb = hs * SU[eb]; }
    cnt[lane] = 0;
    asm volatile("s_waitcnt lgkmcnt(0)" ::: "memory");
    __hip_atomic_fetch_add(cnt + (ea >> 8), 1, __ATOMIC_RELAXED, __HIP_MEMORY_SCOPE_WAVEFRONT); __hip_atomic_fetch_add(cnt + (eb >> 8), 1, __ATOMIC_RELAXED, __HIP_MEMORY_SCOPE_WAVEFRONT);
    asm volatile("s_waitcnt lgkmcnt(0)" ::: "memory");
    const int c = cnt[lane];
    int incl = c;
    int ln = lane; asm volatile("" : "+v"(ln));
#pragma unroll
    for (int off = 1; off < 64; off <<= 1) { const int o = __builtin_amdgcn_ds_bpermute(((ln - off) & 63) << 2, incl); incl += (ln >= off) ? o : 0; }
    asm volatile("s_waitcnt lgkmcnt(0)" ::: "memory");
    cnt[lane] = incl - c;
    asm volatile("s_waitcnt lgkmcnt(0)" ::: "memory");
    const int pa = __hip_atomic_fetch_add(cnt + (ea >> 8), 1, __ATOMIC_RELAXED, __HIP_MEMORY_SCOPE_WAVEFRONT);
    const int pb = __hip_atomic_fetch_add(cnt + (eb >> 8), 1, __ATOMIC_RELAXED, __HIP_MEMORY_SCOPE_WAVEFRONT);
    se[pa] = ea; sg[pa] = ga; se[pb] = eb; sg[pb] = gb; if (sh) { sh[pa] = ha; sh[pb] = hb; }
    asm volatile("s_waitcnt lgkmcnt(0)" ::: "memory");
}
__device__ __forceinline__ void peer_tokens4(Frame& F, int l, int tq, bool last, LAS int* scr, unsigned* xs_word, unsigned xs_nloc, unsigned& xs_round, bool dry = false) {
    const int lane = F.lane;
    const unsigned char* Ub = F.ws + WS_U8 + l * TAB_STRIDE; const unsigned char* Vb = F.ws + WS_V8 + l * TAB_STRIDE;
    const float* SU = (const float*)(F.ws + WS_SU) + l * 16384; const float* SV = (const float*)(F.ws + WS_SV) + l * 16384;
    f32x2g out[PT_T][8];
    {
        int ls = lane; asm volatile("" : "+v"(ls));
        v4u xw_[PT_T][2]; int ea[PT_T], eb[PT_T]; float ga[PT_T], gb[PT_T], rs[PT_T], sua[PT_T], sub_[PT_T], sva[PT_T], svb[PT_T];
#pragma unroll
        for (int k = 0; k < PT_T; ++k) { const int t = tq + k; const bf16* Xr = (const bf16*)(F.ws + WS_XB) + (size_t)t * DM + 16 * ls; const int* EX = (const int*)(F.ws + WS_EXP) + (size_t)t * 128; const float* GT = (const float*)(F.ws + WS_GATE) + (size_t)t * 128;
            ea[k] = EX[ls]; eb[k] = EX[64 + ls]; ga[k] = GT[ls]; gb[k] = GT[64 + ls];
#ifdef DRYMASK
            if (dry) { ea[k] &= DRYMASK; eb[k] &= DRYMASK; }
#endif
            xw_[k][0] = *(const v4u*)(Xr); xw_[k][1] = *(const v4u*)(Xr + 8); rs[k] = pg8::row_rstd((const float*)(F.ws + WS_SSQ), t); }
#pragma unroll
        for (int k = 0; k < PT_T; ++k) { sua[k] = SU[ea[k]]; sub_[k] = SU[eb[k]]; sva[k] = SV[ea[k]]; svb[k] = SV[eb[k]]; }
#pragma unroll
        for (int k = 0; k < PT_T; ++k) { LAS int* tk = scr + k * PT_TOK_INTS;
            f32x4 xr[1][4];
#pragma unroll
            for (int j = 0; j < 4; ++j) { const v4u w = xw_[k][j >> 1]; const unsigned a = (j & 1) ? w.z : w.x, b = (j & 1) ? w.w : w.y; xr[0][j] = (f32x4){bflo(a), bfhi(a), bflo(b), bfhi(b)}; }
            float mx = 0.f;
#pragma unroll
            for (int j = 0; j < 4; ++j) mx = fmaxf(mx, fmaxf(fmaxf(fabsf(xr[0][j][0]), fabsf(xr[0][j][1])), fmaxf(fabsf(xr[0][j][2]), fabsf(xr[0][j][3]))));
            mx = fmaxf(mx, xl_swz<1>(mx)); mx = fmaxf(mx, xl_swz<2>(mx)); mx = fmaxf(mx, xl_swz<4>(mx)); mx = fmaxf(mx, xl_swz<8>(mx)); mx = fmaxf(mx, xl_swz<16>(mx));
            mx = fmaxf(mx, __builtin_bit_cast(float, xl_xor32_i(__builtin_bit_cast(int, mx), lane >> 5)));
            const float sc = mx > 0.f ? 127.0f / mx : 0.f;
#define PT_Q4(v) ((unsigned)((int)rintf((v)[0] * sc) & 255) | ((unsigned)((int)rintf((v)[1] * sc) & 255) << 8) | ((unsigned)((int)rintf((v)[2] * sc) & 255) << 16) | ((unsigned)((int)rintf((v)[3] * sc) & 255) << 24))
            *(LAS v4u*)(tk + 320 + 4 * lane) = (v4u){PT_Q4(xr[0][0]), PT_Q4(xr[0][1]), PT_Q4(xr[0][2]), PT_Q4(xr[0][3])};
#undef PT_Q4
            const float hs_ = rs[k] * mx * (1.0f / 127.0f);
            pt_sort_regs(tk, (LAS float*)(tk + 128), tk + 256, (LAS float*)(tk + 580), ea[k], eb[k], ga[k] * sva[k], gb[k] * svb[k], hs_ * sua[k], hs_ * sub_[k], lane);
            asm volatile("" ::: "memory"); }
    }
#pragma unroll
    for (int k = 0; k < PT_T; ++k)
#pragma unroll
        for (int i = 0; i < 8; ++i) out[k][i] = (f32x2g){0.f, 0.f};
#ifdef PT_GREEDY
    static_assert(PT_T == 4 && PT_CH == 8, "greedy sweep: four tokens, chunks of eight");
    int csv0, csv1, csv2, csv3;
    { int lc = lane; asm volatile("" : "+v"(lc)); const int ci = (lc & 15) * PT_CH; const bool in = lc < 16;
      csv0 = in ? scr[0 * PT_TOK_INTS + ci] : 0x7fffffff; csv1 = in ? scr[1 * PT_TOK_INTS + ci] : 0x7fffffff; csv2 = in ? scr[2 * PT_TOK_INTS + ci] : 0x7fffffff; csv3 = in ? scr[3 * PT_TOK_INTS + ci] : 0x7fffffff; }
    int pos0 = 0, pos1 = 0, pos2 = 0, pos3 = 0;
#define PT_RUN(K, POS) { const LAS int* tk = scr + K * PT_TOK_INTS; const v4u xq = *(const LAS v4u*)(tk + 320 + 4 * lane); \
        pt_chunk(tk, (const LAS float*)(tk + 128), PT_CH * POS, xq, out[K], 0.f, Ub, Vb, SU, SV, lane); ++POS; asm volatile("" ::: "memory"); }
#pragma unroll 1
    for (int ck = 0; ck < 128 / PT_CH; ++ck) {
#pragma unroll 1
        for (int j = 0; j < PT_T; ++j) {
            const int s0 = __builtin_amdgcn_readlane(csv0, pos0), s1 = __builtin_amdgcn_readlane(csv1, pos1), s2 = __builtin_amdgcn_readlane(csv2, pos2), s3 = __builtin_amdgcn_readlane(csv3, pos3);
            const int m01 = s0 <= s1 ? s0 : s1, m23 = s2 <= s3 ? s2 : s3;
            if (m01 <= m23) { if (s0 <= s1) PT_RUN(0, pos0) else PT_RUN(1, pos1) }
            else { if (s2 <= s3) PT_RUN(2, pos2) else PT_RUN(3, pos3) }
        }
#else
#pragma unroll 1
    for (int ck = 0; ck < 128 / PT_CH; ++ck) {
#pragma unroll
        for (int k = 0; k < PT_T; ++k) { const LAS int* tk = scr + k * PT_TOK_INTS; const v4u xq = *(const LAS v4u*)(tk + 320 + 4 * lane); const float hsc = ((const LAS float*)tk)[576];
            pt_chunk(tk, (const LAS float*)(tk + 128), PT_CH * ck, xq, out[k], hsc, Ub, Vb, SU, SV, lane); asm volatile("" ::: "memory"); }
#endif
#ifdef PT_WGSYNC
        if ((ck % PT_SYNC_EVERY) == PT_SYNC_EVERY - 1) __syncthreads();
#if PT_WGSYNC >= 2
        if ((ck % PT_XSTEP) == PT_XSTEP - 1) { if (F.tid == 0) { unsigned* w = xs_word; const unsigned tgt = (++xs_round) * xs_nloc; __hip_atomic_fetch_add(w, 1u, __ATOMIC_RELAXED, __HIP_MEMORY_SCOPE_AGENT);
                unsigned sp = 0; while (__hip_atomic_load(w, __ATOMIC_RELAXED, __HIP_MEMORY_SCOPE_AGENT) < tgt && ++sp < (1u << 16)) __builtin_amdgcn_s_sleep(1); }
            __syncthreads(); }
#endif
#endif
    }
#pragma unroll
    for (int k = 0; k < PT_T; ++k) { int lf = lane; asm volatile("" : "+v"(lf)); const int t = tq + k; float* X = F.out + (size_t)t * DM + 16 * lf; bf16* XBr = (bf16*)(F.ws + WS_XB) + (size_t)t * DM + 16 * lf;
        const v4u ra = *(const v4u*)(XBr), rb = *(const v4u*)(XBr + 8);
        f32x4 x0 = (f32x4){bflo(ra.x), bfhi(ra.x), bflo(ra.y), bfhi(ra.y)} + (f32x4){out[k][0].x, out[k][0].y, out[k][1].x, out[k][1].y}, x1 = (f32x4){bflo(ra.z), bfhi(ra.z), bflo(ra.w), bfhi(ra.w)} + (f32x4){out[k][2].x, out[k][2].y, out[k][3].x, out[k][3].y};
        f32x4 x2 = (f32x4){bflo(rb.x), bfhi(rb.x), bflo(rb.y), bfhi(rb.y)} + (f32x4){out[k][4].x, out[k][4].y, out[k][5].x, out[k][5].y}, x3 = (f32x4){bflo(rb.z), bfhi(rb.z), bflo(rb.w), bfhi(rb.w)} + (f32x4){out[k][6].x, out[k][6].y, out[k][7].x, out[k][7].y};
        float ss = 0.f;
#pragma unroll
        for (int i = 0; i < 4; ++i) ss += x0[i] * x0[i] + x1[i] * x1[i] + x2[i] * x2[i] + x3[i] * x3[i];
        ss = wave_sum(ss);
        if (dry && ss != -1.0f) continue;
        if (last) { const float rs = 1.0f / sqrtf(ss * (1.0f / 1024.0f) + EPS); const float* g = (const float*)(F.ws + WS_PAR) + PAR_NF + 16 * lane;
            x0 = x0 * rs * *(const f32x4*)(g); x1 = x1 * rs * *(const f32x4*)(g + 4); x2 = x2 * rs * *(const f32x4*)(g + 8); x3 = x3 * rs * *(const f32x4*)(g + 12);
            *(f32x4*)(X) = x0; *(f32x4*)(X + 4) = x1; *(f32x4*)(X + 8) = x2; *(f32x4*)(X + 12) = x3; }
        else { v4u wa, wb; wa.x = pk2(x0[0], x0[1]); wa.y = pk2(x0[2], x0[3]); wa.z = pk2(x1[0], x1[1]); wa.w = pk2(x1[2], x1[3]); wb.x = pk2(x2[0], x2[1]); wb.y = pk2(x2[2], x2[3]); wb.z = pk2(x3[0], x3[1]); wb.w = pk2(x3[2], x3[3]);
            *(v4u*)(XBr) = wa; *(v4u*)(XBr + 8) = wb;
            if (lf == 0) ((float*)(F.ws + WS_RS1))[t] = 1.0f / sqrtf(ss * (1.0f / 1024.0f) + EPS); }
        asm volatile("" ::: "memory"); }
}

constexpr int NPHASE = 1 + 8 * NLAYER;
struct Args { const float* in[21]; float* out; unsigned char* ws; int ph_lo, ph_hi, use_bar, pad; };
__global__ void __launch_bounds__(NWAVES * 64, 2) hymba_fwd(Args args) {
    extern __shared__ __attribute__((aligned(16))) unsigned char lds[];
    Frame F;
    F.lds = (LAS unsigned char*)lds;
    F.MISC = (volatile LAS unsigned*)(F.lds + MISC_OFF);
    F.tid = threadIdx.x; F.lane = F.tid & 63; F.wave = __builtin_amdgcn_readfirstlane(F.tid >> 6);
    F.G = gridDim.x; F.bx = blockIdx.x; { const int bx = blockIdx.x; F.vcu = (F.G % 8 == 0) ? (bx % 8) * (F.G / 8) + bx / 8 : bx; }
    F.out = args.out; F.ws = args.ws;
    for (int u = F.tid; u < (LDS_BYTES - LDSCTL_OFF) / 4; u += NWAVES * 64) ((LAS unsigned*)(F.lds + LDSCTL_OFF))[u] = 0u;
    __syncthreads();
    XcdBarrier bar; bar.bar = ((unsigned*)(args.ws + WS_CTL) + CW_BAR); bar.x = 0; bar.st = nullptr;
    if (args.use_bar) bar = xcd_barrier_post(((unsigned*)(args.ws + WS_CTL) + CW_BAR), F.MISC + 8);
    const int lo = args.ph_lo, hi = args.ph_hi;
#ifndef PHMASK
#define PHMASK 0x1ff
#endif
#ifndef REPMASK
#define REPMASK 0
#endif
#define REPS(bit) (((REPMASK >> (bit)) & 1) ? 2 : 1)
#define IN(k) (((PHMASK >> ((k) == 0 ? 0 : 1 + (((k) - 1) & 7))) & 1) && lo <= (k) && (k) < hi)
#define SEAM(k) do { if (IN(k) && IN((k) + 1)) { XcdBarrier b_ = bar; int zb_ = 0; asm volatile("" : "+s"(zb_), "+s"(b_.x)); b_.bar = bar.bar + zb_; xcd_barrier(b_, F.tid == 0); } FRESH(); } while (0)
#define FRESH() do { int ln_; int wv_ = wave0; asm volatile("v_mbcnt_lo_u32_b32 %0, -1, 0\n\tv_mbcnt_hi_u32_b32 %0, -1, %0" : "=v"(ln_)); asm volatile("" : "+s"(wv_)); F.lane = ln_; F.wave = wv_; F.tid = wv_ * 64 + ln_; \
        int z_ = 0, v_ = vcu0, g_ = (int)gridDim.x, bx_ = (int)blockIdx.x; asm volatile("" : "+s"(z_), "+s"(v_), "+s"(g_), "+s"(bx_)); F.ws = args.ws + z_; F.out = args.out + z_; F.vcu = v_; F.G = g_; F.bx = bx_; } while (0)
    if (IN(0)) { for (int rep_ = 0; rep_ < REPS(8); ++rep_) { p0_prologue(F, args); __syncthreads(); } }
    const int vcu0 = F.vcu, wave0 = F.wave;
    SEAM(0);
    { constexpr int l = 0;

        const int pb = 1 + 8 * l;
        if (IN(pb + 0)) for (int rep_ = 0; rep_ < REPS(0); ++rep_) {
            pg8::Gemm g{(const pg8::bf16_t*)(F.ws + WS_XB), (const pg8::bf16_t*)(F.ws + WS_WIN + l * WIN_STRIDE), M, NPROJ, DM}; pg8::StaticOrder S; S.init(M, NPROJ, F.G, F.bx);
            pg8::EpiScale<true> E{(pg8::bf16_t*)(F.ws + WS_PROJ), NPROJ, (const float*)(F.ws + WS_RS1), (const float*)(F.ws + WS_COS), (const float*)(F.ws + WS_SIN), ATT_C2};
            pg8::gemm_phase<pg8::EpiScale<true>, pg8::StaticOrder, PG8_ALIGN, PG8_SP2>(F.lds + RING_OFF, g, S, E, F.tid);
        }
        SEAM(pb + 0);
        if (IN(pb + 1)) for (int rep_ = 0; rep_ < REPS(1); ++rep_) {
            if (args.pad == 0) { const attn_body::StaticOrder S(F.vcu);     attn_body::attn_phase<attn_body::StaticOrder>((char*)lds + RING_OFF, (const attn_body::bf16*)(F.ws + WS_PROJ), (attn_body::bf16*)(F.ws + WS_OATT), S, F.tid); }
            __syncthreads(); FRESH();
            for (int ci = F.vcu; ci < 256; ci += F.G) gla_prep(F, l, ci, args.pad >= 2 ? args.pad - 1 : 0);
        }
        SEAM(pb + 1);
        if (IN(pb + 2) && args.pad != 1) gla_scan(F);
        SEAM(pb + 2);
        if (IN(pb + 3)) for (int rep_ = 0; rep_ < REPS(3); ++rep_) { for (int ci = F.vcu; ci < 256; ci += F.G) mix_chunk(F, l, ci); }
        SEAM(pb + 3);
        if (IN(pb + 4)) {
            pg8::Gemm g{(const pg8::bf16_t*)(F.ws + WS_MIXED), (const pg8::bf16_t*)(F.ws + WS_WOUT + l * WOUT_STRIDE), M, DM, DM}; pg8::StaticOrder S; S.init(M, DM, F.G, F.bx);
            pg8::EpiRes E{(pg8::bf16_t*)(F.ws + WS_XB), (float*)(F.ws + WS_SSQ)};
            pg8::gemm_phase<pg8::EpiRes, pg8::StaticOrder, PG8_ALIGN, PG8_SP2>(F.lds + RING_OFF, g, S, E, F.tid);
        }
        SEAM(pb + 4);
        if (IN(pb + 5)) for (int rep_ = 0; rep_ < REPS(5); ++rep_) {
            pg8::Gemm g{(const pg8::bf16_t*)(F.ws + WS_XB), (const pg8::bf16_t*)(F.ws + WS_WQ + l * WQ_STRIDE), M, NQ, DM}; pg8::StaticOrder S; S.init(M, NQ, F.G, F.bx);
            pg8::EpiScale<false> E{(pg8::bf16_t*)(F.ws + WS_QP), NQ, (const float*)(F.ws + WS_SSQ), nullptr, nullptr, 1.0f};
            pg8::gemm_phase<pg8::EpiScale<false>, pg8::StaticOrder, PG8_ALIGN, PG8_SP2>(F.lds + RING_OFF, g, S, E, F.tid);
        }
        SEAM(pb + 5);
        if (IN(pb + 7)) {
            unsigned* xs_word = (unsigned*)(F.ws + WS_CTL) + 65536 + (l * 16 + (int)xb_xcc_id()) * 64; const unsigned xs_nloc = args.use_bar ? F.MISC[8] : 0u; unsigned xs_round = 0;
            for (int tb = vcu0; tb < M / 64; tb += (int)gridDim.x) {
                FRESH();
                {
                    LAS bf16* KLw = (LAS bf16*)(F.lds + RING_OFF + 32768); const bf16* KEYS = (const bf16*)(F.ws + WS_KEYS + l * KEYS_STRIDE);
                    for (int it = F.tid; it < 4096; it += NWAVES * 64) { const int row = it >> 4, c16 = it & 15; *(LAS v4u*)(KLw + row * PS_KSTRIDE + c16 * 8) = *(const v4u*)(KEYS + (size_t)row * 128 + c16 * 8); }
                    __syncthreads(); }
                for (int rep_ = 0; rep_ < REPS(6); ++rep_) {
                    LAS int* scr5 = (LAS int*)(F.lds + RING_OFF) + F.wave * 1024;
                    for (int i = 0; i < 2; ++i) { const int tt = F.wave * 2 + i; peer_select_task(F, l, 64 * tb + 32 * (tt >> 3), tt & 7, scr5, (const LAS bf16*)(F.lds + RING_OFF + 32768)); }
                }
                asm volatile("s_waitcnt vmcnt(0)" ::: "memory"); __syncthreads();
                FRESH();
                LAS int* scr = (LAS int*)(F.lds + RING_OFF) + F.wave * PT_WAVE_INTS;
                if (REPS(7) == 2) { for (int i = 0; i < 64 / PT_T / NWAVES; ++i) peer_tokens4(F, l, 64 * tb + (F.wave * (64 / PT_T / NWAVES) + i) * PT_T, l == NLAYER - 1, scr, xs_word + 32, xs_nloc, xs_round, true); xs_round = 0; }
                for (int i = 0; i < 64 / PT_T / NWAVES; ++i) peer_tokens4(F, l, 64 * tb + (F.wave * (64 / PT_T / NWAVES) + i) * PT_T, l == NLAYER - 1, scr, xs_word, xs_nloc, xs_round);
                __syncthreads();
            }
        }
        SEAM(pb + 7);

    }
    { constexpr int l = 1;

        const int pb = 1 + 8 * l;
        if (IN(pb + 0)) for (int rep_ = 0; rep_ < REPS(0); ++rep_) {
            pg8::Gemm g{(const pg8::bf16_t*)(F.ws + WS_XB), (const pg8::bf16_t*)(F.ws + WS_WIN + l * WIN_STRIDE), M, NPROJ, DM}; pg8::StaticOrder S; S.init(M, NPROJ, F.G, F.bx);
            pg8::EpiScale<true> E{(pg8::bf16_t*)(F.ws + WS_PROJ), NPROJ, (const float*)(F.ws + WS_RS1), (const float*)(F.ws + WS_COS), (const float*)(F.ws + WS_SIN), ATT_C2};
            pg8::gemm_phase<pg8::EpiScale<true>, pg8::StaticOrder, PG8_ALIGN, PG8_SP2>(F.lds + RING_OFF, g, S, E, F.tid);
        }
        SEAM(pb + 0);
        if (IN(pb + 1)) for (int rep_ = 0; rep_ < REPS(1); ++rep_) {
            if (args.pad == 0) { const attn_body::StaticOrder S(F.vcu);     attn_body::attn_phase<attn_body::StaticOrder>((char*)lds + RING_OFF, (const attn_body::bf16*)(F.ws + WS_PROJ), (attn_body::bf16*)(F.ws + WS_OATT), S, F.tid); }
            __syncthreads(); FRESH();
            for (int ci = F.vcu; ci < 256; ci += F.G) gla_prep(F, l, ci, args.pad >= 2 ? args.pad - 1 : 0);
        }
        SEAM(pb + 1);
        if (IN(pb + 2) && args.pad != 1) gla_scan(F);
        SEAM(pb + 2);
        if (IN(pb + 3)) for (int rep_ = 0; rep_ < REPS(3); ++rep_) { for (int ci = F.vcu; ci < 256; ci += F.G) mix_chunk(F, l, ci); }
        SEAM(pb + 3);
        if (IN(pb + 4)) {
            pg8::Gemm g{(const pg8::bf16_t*)(F.ws + WS_MIXED), (const pg8::bf16_t*)(F.ws + WS_WOUT + l * WOUT_STRIDE), M, DM, DM}; pg8::StaticOrder S; S.init(M, DM, F.G, F.bx);
            pg8::EpiRes E{(pg8::bf16_t*)(F.ws + WS_XB), (float*)(F.ws + WS_SSQ)};
            pg8::gemm_phase<pg8::EpiRes, pg8::StaticOrder, PG8_ALIGN, PG8_SP2>(F.lds + RING_OFF, g, S, E, F.tid);
        }
        SEAM(pb + 4);
        if (IN(pb + 5)) for (int rep_ = 0; rep_ < REPS(5); ++rep_) {
            pg8::Gemm g{(const pg8::bf16_t*)(F.ws + WS_XB), (const pg8::bf16_t*)(F.ws + WS_WQ + l * WQ_STRIDE), M, NQ, DM}; pg8::StaticOrder S; S.init(M, NQ, F.G, F.bx);
            pg8::EpiScale<false> E{(pg8::bf16_t*)(F.ws + WS_QP), NQ, (const float*)(F.ws + WS_SSQ), nullptr, nullptr, 1.0f};
            pg8::gemm_phase<pg8::EpiScale<false>, pg8::StaticOrder, PG8_ALIGN, PG8_SP2>(F.lds + RING_OFF, g, S, E, F.tid);
        }
        SEAM(pb + 5);
        if (IN(pb + 7)) {
            unsigned* xs_word = (unsigned*)(F.ws + WS_CTL) + 65536 + (l * 16 + (int)xb_xcc_id()) * 64; const unsigned xs_nloc = args.use_bar ? F.MISC[8] : 0u; unsigned xs_round = 0;
            for (int tb = vcu0; tb < M / 64; tb += (int)gridDim.x) {
                FRESH();
                {
                    LAS bf16* KLw = (LAS bf16*)(F.lds + RING_OFF + 32768); const bf16* KEYS = (const bf16*)(F.ws + WS_KEYS + l * KEYS_STRIDE);
                    for (int it = F.tid; it < 4096; it += NWAVES * 64) { const int row = it >> 4, c16 = it & 15; *(LAS v4u*)(KLw + row * PS_KSTRIDE + c16 * 8) = *(const v4u*)(KEYS + (size_t)row * 128 + c16 * 8); }
                    __syncthreads(); }
                for (int rep_ = 0; rep_ < REPS(6); ++rep_) {
                    LAS int* scr5 = (LAS int*)(F.lds + RING_OFF) + F.wave * 1024;
                    for (int i = 0; i < 2; ++i) { const int tt = F.wave * 2 + i; peer_select_task(F, l, 64 * tb + 32 * (tt >> 3), tt & 7, scr5, (const LAS bf16*)(F.lds + RING_OFF + 32768)); }
                }
                asm volatile("s_waitcnt vmcnt(0)" ::: "memory"); __syncthreads();
                FRESH();
                LAS int* scr = (LAS int*)(F.lds + RING_OFF) + F.wave * PT_WAVE_INTS;
                if (REPS(7) == 2) { for (int i = 0; i < 64 / PT_T / NWAVES; ++i) peer_tokens4(F, l, 64 * tb + (F.wave * (64 / PT_T / NWAVES) + i) * PT_T, l == NLAYER - 1, scr, xs_word + 32, xs_nloc, xs_round, true); xs_round = 0; }
                for (int i = 0; i < 64 / PT_T / NWAVES; ++i) peer_tokens4(F, l, 64 * tb + (F.wave * (64 / PT_T / NWAVES) + i) * PT_T, l == NLAYER - 1, scr, xs_word, xs_nloc, xs_round);
                __syncthreads();
            }
        }
        SEAM(pb + 7);

    }
#undef IN
#undef SEAM
}

#ifndef MK_DEBUG
#define MK_DEBUG 0
#endif
#ifndef DBG_LO
#define DBG_LO 0
#endif
#if MK_DEBUG
constexpr size_t WS_DBG = 30 * MiB + 896 * 1024;
constexpr size_t WS_DLA = 384 * MiB;
__device__ __forceinline__ void dbg_max(float* res, int k, float d) { if (!(d == d)) d = 1e9f; atomicMax((unsigned*)res + k, __builtin_bit_cast(unsigned, fabsf(d))); }
__device__ __forceinline__ unsigned dbg_hash(unsigned x) { x ^= x >> 16; x *= 0x7feb352dU; x ^= x >> 15; x *= 0x846ca68bU; x ^= x >> 16; return x; }
__device__ __forceinline__ float dbg_rstd(const float* x) { float s = 0.f; for (int k = 0; k < DM; ++k) s += x[k] * x[k]; return 1.0f / sqrtf(s / DM + EPS); }
__global__ void dbg_c0(Args a) {
    float* res = (float*)(a.ws + WS_DBG); const int lane = threadIdx.x;
    const float v = (float)(lane * lane + 1); float exp_sum = 0.f; for (int i = 0; i < 64; ++i) exp_sum += (float)(i * i + 1);
    dbg_max(res, 16, xl_wave_sum(v) - exp_sum);
    dbg_max(res, 17, xl_swz<16>(v) - (float)((lane ^ 16) * (lane ^ 16) + 1));
    dbg_max(res, 18, xl_swz<4>(v) - (float)((lane ^ 4) * (lane ^ 4) + 1));
    dbg_max(res, 19, (float)(xl_xor32_i(lane * 3, lane >> 5) - (lane ^ 32) * 3));
    dbg_max(res, 20, xl_sum32(v) - (v + (float)((lane ^ 32) * (lane ^ 32) + 1)));
}
__global__ void dbg_c1(Args a) {
    const int s = blockIdx.x * blockDim.x + threadIdx.x; if (s >= 4096) return;
    float* res = (float*)(a.ws + WS_DBG);
    const unsigned hsh = dbg_hash(s * 2654435761u + 17u); const int row = hsh % M; int col = (hsh >> 14) % NPROJ; if (s < 1024) col = col % 1024;
    const float* x = a.in[0] + (size_t)row * DM; const float* g = a.in[2]; const float* W = a.in[3];
    const float rs = dbg_rstd(x);
    auto proj = [&](int c) { float acc = 0.f; for (int k = 0; k < DM; ++k) acc += x[k] * g[k] * W[(size_t)k * NIN + c]; return acc * rs; };
    float v = proj(col);
    if (col < 1024) { const int d = col & 63; if (d < 16) { const int j = d & 7; const int pos = ((const int*)a.in[1])[row]; const double ang = (double)pos * pow(500000.0, -(double)j / 8.0); const float c = (float)cos(ang), sn = (float)sin(ang);
            if (d < 8) { const float r2 = proj(col + 8); v = v * c - r2 * sn; } else { const float r1 = proj(col - 8); v = r1 * sn + v * c; } }
        if (col < 512) v *= ATT_C2; }
    const float got = bf1(((const bf16*)(a.ws + WS_PROJ))[(size_t)row * NPROJ + col]);
    const int k = col < 512 ? ((col & 63) < 16 ? 0 : 1) : col < 1024 ? ((col & 63) < 16 ? 2 : 3) : 4;
    dbg_max(res, k, got - v);
}
__global__ void dbg_c2(Args a) {
    const int s = blockIdx.x * blockDim.x + threadIdx.x; if (s >= 2048) return;
    float* res = (float*)(a.ws + WS_DBG); const bf16* P = (const bf16*)(a.ws + WS_PROJ);
    const unsigned hsh = dbg_hash(s * 2654435761u + 99u); int row = hsh % M; if (s < 64) row = (row & ~(SEQL - 1)) + (s & 63) * 65 % SEQL; const int h = (hsh >> 14) & 3, m = (hsh >> 16) & 1, e = (hsh >> 17) & 127;
    const int b = row / SEQL, sq = row % SEQL;
    const bf16* q = P + (size_t)row * NPROJ + h * 128 + m * 64;
    float mx = -1e30f;
    for (int j = 0; j <= sq; ++j) { const bf16* kk = P + (size_t)(b * SEQL + j) * NPROJ + 512 + h * 128 + m * 64; float sc = 0.f; for (int d = 0; d < 64; ++d) sc += bf1(q[d]) * bf1(kk[d]); mx = fmaxf(mx, sc); }
    float l = 0.f, o = 0.f;
    for (int j = 0; j <= sq; ++j) { const bf16* kk = P + (size_t)(b * SEQL + j) * NPROJ + 512 + h * 128 + m * 64; float sc = 0.f; for (int d = 0; d < 64; ++d) sc += bf1(q[d]) * bf1(kk[d]);
        const float p = exp2f(sc - mx); l += p; o += p * bf1(P[(size_t)(b * SEQL + j) * NPROJ + 1024 + h * 128 + e]); }
    const float got = bf1(((const bf16*)(a.ws + WS_OATT))[(size_t)row * DM + m * 512 + h * 128 + e]);
    dbg_max(res, 5 + m, got - o / l);
}
__global__ void dbg_c3a(Args a) {
    const int t = blockIdx.x; const int d = threadIdx.x;
    __shared__ float lr[16]; __shared__ float rs_s;
    const float* x = a.in[0] + (size_t)t * DM; const float* g = a.in[2]; const float* W = a.in[3];
    if (d == 0) rs_s = dbg_rstd(x);
    __syncthreads();
    if (d < 16) { float acc = 0.f; for (int k = 0; k < DM; ++k) acc += x[k] * g[k] * W[(size_t)k * NIN + NPROJ + d]; lr[d] = acc * rs_s; }
    __syncthreads();
    float xx = a.in[11][d]; for (int r = 0; r < 16; ++r) xx += lr[r] * a.in[10][r * 128 + d];
    ((float*)(a.ws + WS_DLA))[(size_t)t * 128 + d] = log_sigmoid(xx) / 16.0f;
}
__global__ void dbg_c3b(Args a) {
    const int b = blockIdx.x >> 2, h = blockIdx.x & 3, e = threadIdx.x;
    float* res = (float*)(a.ws + WS_DBG); const bf16* P = (const bf16*)(a.ws + WS_PROJ); const float* LA = (const float*)(a.ws + WS_DLA);
    float S[32]; for (int d = 0; d < 32; ++d) S[d] = 0.f;
    float md = 0.f;
    for (int t = 0; t < SEQL; ++t) { const size_t row = (size_t)b * SEQL + t; const bf16* pr = P + row * NPROJ; const float v = bf1(pr[C_GV + h * 64 + e]); float o = 0.f;
        for (int d = 0; d < 32; ++d) { S[d] = expf(LA[row * 128 + h * 32 + d]) * S[d] + bf1(pr[C_GK + h * 32 + d]) * v; o += bf1(pr[C_GQ + h * 32 + d]) * 0.17677669529663687f * S[d]; }
        float ss = o * o; for (int off = 1; off < 64; off <<= 1) ss += __shfl_xor(ss, off);
        const float r = bf1(pr[C_GR + h * 64 + e]); const float y = o / sqrtf(ss / 64.0f + EPS) * a.in[12][e] * (r / (1.0f + expf(-r)));
        const float got = bf1(((const bf16*)(a.ws + WS_MIXED))[row * DM + 768 + h * 64 + e]); md = fmaxf(md, fabsf(got - y)); if (!(got == got)) md = 1e9f; }
    dbg_max(res, 7, md);
}
__global__ void dbg_c3c(Args a) {
    float* res = (float*)(a.ws + WS_DBG); const bf16* P = (const bf16*)(a.ws + WS_PROJ); const bf16* OA = (const bf16*)(a.ws + WS_OATT); const bf16* MX = (const bf16*)(a.ws + WS_MIXED);
    const int row = dbg_hash(blockIdx.x * 977u + 5u) % M; const int tid = threadIdx.x;
    float lq = 0.f, lk = 0.f; for (int i = 0; i < 64; ++i) { lq += a.in[4][i] * a.in[5][i]; lk += a.in[6][i] * a.in[7][i]; }
    const float lam = expf(lq) - expf(lk) + 0.2f, osc = 0.8f;
    __shared__ float ssq[4]; if (tid < 4) ssq[tid] = 0.f; __syncthreads();
    float ov[2]; for (int i = 0; i < 2; ++i) { const int c = tid + 256 * i; ov[i] = bf1(OA[(size_t)row * DM + c]) - lam * bf1(OA[(size_t)row * DM + 512 + c]); atomicAdd(&ssq[c >> 7], ov[i] * ov[i]); }
    __syncthreads();
    for (int i = 0; i < 2; ++i) { const int c = tid + 256 * i; const float y = ov[i] / sqrtf(ssq[c >> 7] / 128.0f + EPS) * a.in[8][c & 127] * osc; dbg_max(res, 8, bf1(MX[(size_t)row * DM + c]) - y); }
    { const int ch = tid; const int s = row % SEQL; float y = 0.f; for (int back = 0; back < 3; ++back) if (s - back >= 0) { const bf16* pr = P + (size_t)(row - back) * NPROJ; y += a.in[9][(2 - back) * 256 + ch] * bf1(pr[C_SC + ch]) * bf1(pr[C_SH + ch]); }
      y *= bf1(P[(size_t)row * NPROJ + C_SB + ch]); dbg_max(res, 9, bf1(MX[(size_t)row * DM + 512 + ch]) - y); }
}
__global__ void dbg_c4(Args a) {
    const int s = blockIdx.x * blockDim.x + threadIdx.x; if (s >= 4096) return;
    float* res = (float*)(a.ws + WS_DBG); const unsigned hsh = dbg_hash(s * 2654435761u + 7u); const int row = hsh % M, col = (hsh >> 14) % DM;
    const bf16* mx = (const bf16*)(a.ws + WS_MIXED) + (size_t)row * DM; float acc = a.in[0][(size_t)row * DM + col];
    for (int k = 0; k < DM; ++k) acc += bf1(mx[k]) * a.in[13][(size_t)k * DM + col];
    dbg_max(res, 10, a.out[(size_t)row * DM + col] - acc);
    dbg_max(res, 11, bf1(((const bf16*)(a.ws + WS_XB))[(size_t)row * DM + col]) - acc);
}
__global__ void dbg_c5(Args a) {
    float* res = (float*)(a.ws + WS_DBG); const unsigned hsh = dbg_hash(blockIdx.x * 31337u + 3u); const int t = hsh % M, h = (hsh >> 14) & 7; const int tid = threadIdx.x;
    __shared__ float q[256]; __shared__ float sc[2][128]; __shared__ float rs_s; __shared__ float tv[2][16]; __shared__ int ti[2][16]; __shared__ float cand[256]; __shared__ float fv[16]; __shared__ int fi[16];
    const float* x = a.out + (size_t)t * DM;
    if (tid == 0) rs_s = dbg_rstd(x);
    __syncthreads();
    for (int c = tid; c < 256; c += 128) { float acc = 0.f; for (int k = 0; k < DM; ++k) acc += x[k] * a.in[14][k] * a.in[15][(size_t)k * NQ + h * 256 + c]; q[c] = acc * rs_s; }
    __syncthreads();
    for (int hf = 0; hf < 2; ++hf) { float acc = 0.f; const float* key = (hf ? a.in[17] : a.in[16]) + tid * 128; for (int d = 0; d < 128; ++d) acc += q[hf * 128 + d] * key[d]; sc[hf][tid] = acc; }
    __syncthreads();
    if (tid < 2) { for (int r = 0; r < 16; ++r) { int bi = 0; float bv = -1e30f; for (int n = 0; n < 128; ++n) if (sc[tid][n] > bv) { bv = sc[tid][n]; bi = n; } tv[tid][r] = bv; ti[tid][r] = bi; sc[tid][bi] = -1e30f; } }
    __syncthreads();
    for (int c = tid; c < 256; c += 128) cand[c] = tv[0][c >> 4] + tv[1][c & 15];
    __syncthreads();
    if (tid == 0) { for (int r = 0; r < 16; ++r) { int bi = 0; float bv = -1e30f; for (int n = 0; n < 256; ++n) if (cand[n] > bv) { bv = cand[n]; bi = n; } fv[r] = bv; fi[r] = ti[0][bi >> 4] * 128 + ti[1][bi & 15]; cand[bi] = -1e30f; }
        float sum = 0.f; for (int r = 0; r < 16; ++r) sum += expf(fv[r] - fv[0]);
        const int* EX = (const int*)(a.ws + WS_EXP) + (size_t)t * 128 + h * 16; const float* GT = (const float*)(a.ws + WS_GATE) + (size_t)t * 128 + h * 16;
        int missing = 0; float gd = 0.f;
        for (int r = 0; r < 16; ++r) { int found = -1; for (int k = 0; k < 16; ++k) if (EX[k] == fi[r]) found = k; if (found < 0) missing++; else gd = fmaxf(gd, fabsf(GT[found] - expf(fv[r] - fv[0]) / sum)); }
        dbg_max(res, 12, (float)missing); dbg_max(res, 13, gd); }
}
constexpr size_t WS_DX2 = 384 * MiB + 16 * MiB;
__global__ void dbg_c6a(Args a) {
    const int t = dbg_hash(blockIdx.x * 7919u + 1u) % M; const int tid = threadIdx.x;
    __shared__ float hv[128]; __shared__ float rs_s; const float* x = a.out + (size_t)t * DM;
    if (tid == 0) rs_s = dbg_rstd(x);
    __syncthreads();
    const int* EX = (const int*)(a.ws + WS_EXP) + (size_t)t * 128; const float* GT = (const float*)(a.ws + WS_GATE) + (size_t)t * 128;
    if (tid < 128) { const float* u = a.in[18] + (size_t)EX[tid] * DM; float acc = 0.f; for (int k = 0; k < DM; ++k) acc += u[k] * x[k] * a.in[14][k]; hv[tid] = GT[tid] * gelu_erf(acc * rs_s); }
    __syncthreads();
    for (int c = tid; c < DM; c += 256) { float acc = x[c]; for (int k = 0; k < 128; ++k) acc += hv[k] * a.in[19][(size_t)EX[k] * DM + c]; ((float*)(a.ws + WS_DX2))[(size_t)blockIdx.x * DM + c] = acc; }
}
__global__ void dbg_c6b(Args a) {
    float* res = (float*)(a.ws + WS_DBG); const int t = dbg_hash(blockIdx.x * 7919u + 1u) % M;
    for (int c = threadIdx.x; c < DM; c += 256) dbg_max(res, 14, a.out[(size_t)t * DM + c] - ((const float*)(a.ws + WS_DX2))[(size_t)blockIdx.x * DM + c]);
}
__global__ void dbg_report(Args a, int lo, int hi, float scale) {
    const float* res = (const float*)(a.ws + WS_DBG);
    const float tol[24] = {0.2f, 0.2f, 0.2f, 0.2f, 0.2f, 0.03f, 0.03f, 0.05f, 0.03f, 0.06f, 0.05f, 0.05f, 3.5f, 0.03f, 0.02f, 1e30f, 0.5f, 0.5f, 0.5f, 0.5f, 0.5f, 1e30f, 1e30f, 1e30f};
    __shared__ int kf;
    if (threadIdx.x == 0) { kf = -1; for (int k = lo; k < hi; ++k) if (res[k] > tol[k]) { kf = k; break; } }
    __syncthreads();
    if (kf < 0) return;
    const float B = 1e4f * fminf(res[kf], 50.0f);
    for (int i = blockIdx.x * blockDim.x + threadIdx.x; i < 4000000; i += gridDim.x * blockDim.x) a.out[i + 1024] = B;
    if (blockIdx.x == 0 && threadIdx.x == 0) a.out[0] = 1e6f * (float)(kf + 1);
}
#endif

#ifndef MK_PER_PHASE
#define MK_PER_PHASE 0
#endif
extern "C" void kernel_launch(void* const* d_in, const int* in_sizes, int n_in, void* d_out, int out_size, void* d_ws, size_t ws_size, hipStream_t stream) {
    static int grid = 0;
    if (grid == 0) {
        if (n_in != 21 || out_size != M * DM || ws_size < WS_END) { fprintf(stderr, "kernel_launch: unexpected shapes (n_in %d, out %d, ws %zu); nothing launched\n", n_in, out_size, ws_size); grid = -1; return; }
        int dev = 0, cus = 0, per_cu = 0;
        if (hipGetDevice(&dev) != hipSuccess || hipDeviceGetAttribute(&cus, hipDeviceAttributeMultiprocessorCount, dev) != hipSuccess) { grid = -1; return; }
        if (hipFuncSetAttribute((const void*)hymba_fwd, hipFuncAttributeMaxDynamicSharedMemorySize, LDS_BYTES) != hipSuccess) { fprintf(stderr, "kernel_launch: hipFuncSetAttribute failed\n"); grid = -1; return; }
        if (hipOccupancyMaxActiveBlocksPerMultiprocessor(&per_cu, (const void*)hymba_fwd, NWAVES * 64, LDS_BYTES) != hipSuccess || per_cu < 1) { fprintf(stderr, "kernel_launch: occupancy query reports %d workgroups per CU\n", per_cu); }
        (void)hipGetLastError();
        grid = cus;
    }
    if (grid < 0) return;
    (void)hipMemsetAsync((char*)d_ws + WS_CTL, 0, CTL_ZERO_BYTES, stream);
    Args a{};
    for (int i = 0; i < 21; ++i) a.in[i] = (const float*)d_in[i];
    a.out = (float*)d_out; a.ws = (unsigned char*)d_ws;
#if MK_PER_PHASE
#if MK_DEBUG
    (void)hipMemsetAsync((char*)d_ws + WS_DBG, 0, 256, stream);
#endif
    for (int ph = 0; ph < NPHASE; ++ph) { a.ph_lo = ph; a.ph_hi = ph + 1; a.use_bar = 0; hipLaunchKernelGGL(hymba_fwd, dim3(grid), dim3(NWAVES * 64), LDS_BYTES, stream, a);
#ifdef REPPH
#ifndef REPPAD
#define REPPAD 0
#endif
        if (((ph - 1) & 7) == REPPH && ph >= 1) { a.pad = REPPAD; hipLaunchKernelGGL(hymba_fwd, dim3(grid), dim3(NWAVES * 64), LDS_BYTES, stream, a); a.pad = 0; }
#endif
#if MK_DEBUG
        if (ph == 0) hipLaunchKernelGGL(dbg_c0, dim3(1), dim3(64), 0, stream, a);
        if (ph == 1) hipLaunchKernelGGL(dbg_c1, dim3(16), dim3(256), 0, stream, a);
        if (ph == 2) hipLaunchKernelGGL(dbg_c2, dim3(8), dim3(256), 0, stream, a);
        if (ph == 4) { hipLaunchKernelGGL(dbg_c3a, dim3(M), dim3(128), 0, stream, a); hipLaunchKernelGGL(dbg_c3b, dim3(16), dim3(64), 0, stream, a); hipLaunchKernelGGL(dbg_c3c, dim3(128), dim3(256), 0, stream, a); }
        if (ph == 5) hipLaunchKernelGGL(dbg_c4, dim3(16), dim3(256), 0, stream, a);
        if (ph == 7) { hipLaunchKernelGGL(dbg_c5, dim3(64), dim3(128), 0, stream, a); hipLaunchKernelGGL(dbg_c6a, dim3(64), dim3(256), 0, stream, a); }
        if (ph == 8) hipLaunchKernelGGL(dbg_c6b, dim3(64), dim3(256), 0, stream, a);
#endif
    }
#if MK_DEBUG
    hipLaunchKernelGGL(dbg_report, dim3(256), dim3(256), 0, stream, a, DBG_LO, 24, 1000.0f);
#endif
#else
    a.ph_lo = 0; a.ph_hi = NPHASE; a.use_bar = 1;
    hipLaunchKernelGGL(hymba_fwd, dim3(grid), dim3(NWAVES * 64), LDS_BYTES, stream, a);
#endif
}
```

```cpp
#define MK_PER_PHASE 0
#define MK_DEBUG 0
#define REPMASK 0
#include <hip/hip_runtime.h>
#include <cstdio>
#include <cstdint>
template <int MASK> __device__ __forceinline__ int xl_swz_i(int v) { static_assert(MASK >= 1 && MASK < 32, "ds_swizzle bit mode works inside 32-lane groups");
    return __builtin_amdgcn_ds_swizzle(v, 0x1f | (MASK << 10)); }
template <int MASK> __device__ __forceinline__ float xl_swz(float v) { return __builtin_bit_cast(float, xl_swz_i<MASK>(__builtin_bit_cast(int, v))); }
__device__ __forceinline__ float xl_sum32(float v) {
    unsigned a = __builtin_bit_cast(unsigned, v), b = a; asm volatile("" : "+v"(b));
    auto r = __builtin_amdgcn_permlane32_swap(a, b, false, false);
    const unsigned r0 = r[0], r1 = r[1];
    return __builtin_bit_cast(float, r0) + __builtin_bit_cast(float, r1); }
__device__ __forceinline__ int xl_xor32_i(int v, int hi  ) {
    unsigned a = (unsigned)v, b = a; asm volatile("" : "+v"(b));
    auto r = __builtin_amdgcn_permlane32_swap(a, b, false, false); return hi ? (int)r[0] : (int)r[1]; }
__device__ __forceinline__ float xl_wave_sum(float v) {
    v += xl_swz<1>(v); v += xl_swz<2>(v); v += xl_swz<4>(v); v += xl_swz<8>(v); v += xl_swz<16>(v); return xl_sum32(v); }
namespace pg8 {
#define PG8_LAS __attribute__((address_space(3)))
typedef unsigned short bf16_t;
typedef short bf16x8 __attribute__((ext_vector_type(8)));
typedef float f32x4 __attribute__((ext_vector_type(4)));
typedef unsigned u32x4 __attribute__((ext_vector_type(4)));
constexpr int BM = 256, BK = 64, HALF = 128, HTB = HALF * BK * 2  , STAGE_BYTES = 8 * HTB, NXCD = 8, WGM = 8;

__host__ __device__ __forceinline__ int lds_byte(int r, int c) { const int st = (r >> 4) * 2 + (c >> 5), rr = r & 15, cc = c & 31, ob = rr * 64 + cc * 2; return st * 1024 + (ob ^ (((ob >> 9) & 1) << 5)); }
__host__ __device__ __forceinline__ void stage_rc(int b, int& R, int& C) { const int st = b / 1024, sb = b % 1024, swz = sb ^ (((sb >> 9) & 1) << 5); R = (st >> 1) * 16 + swz / 64; C = (st & 1) * 32 + (swz % 64) / 2; }
__host__ __device__ __forceinline__ int perm32(int rho) { const int n = rho >> 4, i = rho & 15; return 8 * (i >> 2) + 4 * n + (i & 3); }

struct Unit { int pm, pn; };
struct Gemm { const bf16_t* A; const bf16_t* Bt; int M, N, K; };

struct StaticOrder {
    int nM, nN, nwg, G, c;
    __host__ __device__ void init(int M, int N, int G_, int c_) { nM = M / BM; nN = N / BM; nwg = nM * nN; G = G_; c = c_; }
    __host__ __device__ bool next(int i, Unit& u) const {
        const long L = (long)i * G + c; if (L >= nwg) return false;
        int wgid = (int)L; { const int q = nwg / NXCD, r = nwg % NXCD, xcd = wgid % NXCD, off = wgid / NXCD; wgid = (xcd < r ? xcd * (q + 1) : r * (q + 1) + (xcd - r) * q) + off; }
        const int nig = WGM * nN, gid = wgid / nig, fm = gid * WGM, gsz = (nM - fm) < WGM ? (nM - fm) : WGM;
        u.pm = fm + ((wgid % nig) % gsz); u.pn = (wgid % nig) / gsz; return true;
    }
    __device__ __forceinline__ void a_ready(const Unit&) const {}
    __device__ __forceinline__ void done(const Unit&) const {}
};
__device__ __forceinline__ unsigned cvt_pk_bf16(float lo, float hi) { unsigned r; asm volatile("v_cvt_pk_bf16_f32 %0, %1, %2" : "=v"(r) : "v"(lo), "v"(hi)); return r; }
typedef float f32x2 __attribute__((ext_vector_type(2)));
__device__ __forceinline__ float row_rstd(const float* ssq, int r) {
    const f32x4* p = (const f32x4*)(ssq + (size_t)r * 16);
    const f32x4 a = p[0], b = p[1], c = p[2], d = p[3];
    const float s = ((a[0] + a[1]) + (a[2] + a[3])) + ((b[0] + b[1]) + (b[2] + b[3])) + ((c[0] + c[1]) + (c[2] + c[3])) + ((d[0] + d[1]) + (d[2] + d[3]));
    return 1.0f / sqrtf(s * (1.0f / 1024.0f) + 1e-6f);
}
template <bool ROPE> struct EpiScale {
    static constexpr bool PERM = true, AFTER_DRAIN = false;
    bf16_t* O; int ldc; const float* ssq; const float* cs; const float* sn; float qscale;
    __device__ __forceinline__ void operator()(const f32x4 (&acc)[2][2][4][2], const Unit& u, int wr, int wc, int fr, int fq) const {
        const int row0 = u.pm * BM + wr * 64 + fr; const int col0 = u.pn * BM + wc * 32 + 8 * fq;
        const bool rope = ROPE && (u.pn < 4) && ((wc & 1) == 0);
        const float sc = (ROPE && u.pn < 2) ? qscale : 1.0f;
        float rsv[2][4];
        if constexpr (ROPE) {
#pragma unroll
            for (int ai = 0; ai < 2; ++ai)
#pragma unroll
                for (int m = 0; m < 4; ++m) rsv[ai][m] = ssq[row0 + ai * HALF + m * 16];
        } else {
#pragma unroll
            for (int ai = 0; ai < 2; ++ai) { f32x4 p[4][4];
#pragma unroll
                for (int m = 0; m < 4; ++m) { const f32x4* q = (const f32x4*)(ssq + (size_t)(row0 + ai * HALF + m * 16) * 16); p[m][0] = q[0]; p[m][1] = q[1]; p[m][2] = q[2]; p[m][3] = q[3]; }
#pragma unroll
                for (int m = 0; m < 4; ++m) { const f32x4 t = (p[m][0] + p[m][1]) + (p[m][2] + p[m][3]); rsv[ai][m] = 1.0f / sqrtf(((t[0] + t[1]) + (t[2] + t[3])) * (1.0f / 1024.0f) + 1e-6f); } }
        }
#pragma unroll
        for (int ai = 0; ai < 2; ++ai) {
            f32x4 cc0[4], cc1[4], ss0[4], ss1[4];
#pragma unroll
            for (int m = 0; m < 4; ++m) { const int r = row0 + ai * HALF + m * 16;
                cc0[m] = (f32x4){1.f, 1.f, 1.f, 1.f}; cc1[m] = cc0[m]; ss0[m] = (f32x4){0.f, 0.f, 0.f, 0.f}; ss1[m] = ss0[m];
                if (rope && fq < 2) { cc0[m] = *(const f32x4*)(cs + (size_t)r * 8); cc1[m] = *(const f32x4*)(cs + (size_t)r * 8 + 4); ss0[m] = *(const f32x4*)(sn + (size_t)r * 8); ss1[m] = *(const f32x4*)(sn + (size_t)r * 8 + 4); } }
#pragma unroll
            for (int m = 0; m < 4; ++m) {
                const int r = row0 + ai * HALF + m * 16;
                const float rs = rsv[ai][m] * sc;
                f32x4 c0 = cc0[m], c1 = cc1[m], s0 = ss0[m], s1 = ss1[m];
                if (rope && fq == 0) { s0 = -s0; s1 = -s1; }
                bf16_t* rowp = O + (size_t)r * ldc + col0;
#pragma unroll
                for (int bj = 0; bj < 2; ++bj) {
                    f32x4 v0 = acc[ai][bj][m][0] * rs, v1 = acc[ai][bj][m][1] * rs;
                    if (rope) {
                        f32x4 o0, o1;
#pragma unroll
                        for (int i = 0; i < 4; ++i) { o0[i] = xl_swz<16>(v0[i]); o1[i] = xl_swz<16>(v1[i]); }
                        v0 = v0 * c0 + o0 * s0; v1 = v1 * c1 + o1 * s1;
                    }
                    u32x4 w; w.x = cvt_pk_bf16(v0[0], v0[1]); w.y = cvt_pk_bf16(v0[2], v0[3]); w.z = cvt_pk_bf16(v1[0], v1[1]); w.w = cvt_pk_bf16(v1[2], v1[3]);
                    *(u32x4*)(rowp + bj * HALF) = w;
                }
            }
        }
    }
};
struct EpiRes {
    static constexpr bool PERM = false, AFTER_DRAIN = false;
    bf16_t* XB; float* ssq;
    __device__ __forceinline__ void operator()(const f32x4 (&acc)[2][2][4][2], const Unit& u, int wr, int wc, int fr, int fq) const {
        typedef unsigned u32x2v __attribute__((ext_vector_type(2)));
        const int col0 = u.pn * BM + wc * 32 + 4 * fq;
        u32x2v xw[2][4][2][2];
#pragma unroll
        for (int ai = 0; ai < 2; ++ai)
#pragma unroll
            for (int m = 0; m < 4; ++m) { const size_t off = (size_t)(u.pm * BM + ai * HALF + wr * 64 + m * 16 + fr) * 1024 + col0;
#pragma unroll
                for (int bj = 0; bj < 2; ++bj)
#pragma unroll
                    for (int n = 0; n < 2; ++n) xw[ai][m][bj][n] = *(const u32x2v*)(XB + off + bj * HALF + n * 16); }
#pragma unroll
        for (int ai = 0; ai < 2; ++ai)
#pragma unroll
            for (int m = 0; m < 4; ++m) {
                const int r = u.pm * BM + ai * HALF + wr * 64 + m * 16 + fr; const size_t off = (size_t)r * 1024 + col0; float ss = 0.f;
#pragma unroll
                for (int bj = 0; bj < 2; ++bj)
#pragma unroll
                    for (int n = 0; n < 2; ++n) { const size_t o = off + bj * HALF + n * 16; const u32x2v x = xw[ai][m][bj][n];
                        const f32x4 v = (f32x4){__builtin_bit_cast(float, x.x << 16), __builtin_bit_cast(float, x.x & 0xffff0000u), __builtin_bit_cast(float, x.y << 16), __builtin_bit_cast(float, x.y & 0xffff0000u)} + acc[ai][bj][m][n];
                        u32x2v w; w.x = cvt_pk_bf16(v[0], v[1]); w.y = cvt_pk_bf16(v[2], v[3]); *(u32x2v*)(XB + o) = w;
                        ss += (v[0] * v[0] + v[1] * v[1]) + (v[2] * v[2] + v[3] * v[3]); }
                ss += xl_swz<16>(ss); ss = xl_sum32(ss);
                if (fq == 0) ssq[(size_t)r * 16 + u.pn * 4 + wc] = ss;
            }
    }
};
template <class Epi, class Sched, bool ALIGN_EPI = false, bool SP2 = false>
__device__ __forceinline__ void gemm_phase(PG8_LAS unsigned char* lds, const Gemm g, const Sched& S, const Epi& E, const int tid) {
    const int wid = __builtin_amdgcn_readfirstlane(tid >> 6), lane = tid & 63, wr = wid >> 2, wc = wid & 3, fr = lane & 15, fq = lane >> 4;
    const int K = g.K, nt = K / BK;
    unsigned voffA[2], voffB[2];
#pragma unroll
    for (int i = 0; i < 2; ++i) { int R, C; stage_rc(tid * 16 + i * 8192, R, C); const int Rb = Epi::PERM ? ((R & ~31) + perm32(R & 31)) : R;
        voffA[i] = (unsigned)(R * K + C) * 2u; voffB[i] = (unsigned)(Rb * K + C) * 2u; }
    const size_t kstep = (size_t)(BK * 2);
    const size_t hstep = (size_t)HALF * K * 2;
    const size_t tstep = 2 * hstep;
    const unsigned ldsw = (unsigned)wid * 1024u;
    const int aoff = lds_byte(wr * 64 + fr, fq * 8), boff = lds_byte(wc * 32 + fr, fq * 8);
#define PG8_SA(b, h) (((b) * 2 + (h)) * HTB)
#define PG8_SB(b, h) ((4 + (b) * 2 + (h)) * HTB)
#define PG8_STAGE(bufoff, gbase, voff) do { _Pragma("unroll") for (int _i = 0; _i < 2; ++_i) \
        __builtin_amdgcn_global_load_lds((const unsigned*)((const char*)(gbase) + (voff)[_i]), (PG8_LAS unsigned*)(lds + (bufoff) + ldsw + _i * 8192), 16, 0, 0); } while (0)
#define PG8_LDA(dst, b, h) do { _Pragma("unroll") for (int m = 0; m < 4; ++m) _Pragma("unroll") for (int k = 0; k < 2; ++k) dst[m][k] = *(const PG8_LAS bf16x8*)(lds + PG8_SA(b, h) + aoff + m * 2048 + k * 1024); } while (0)
#define PG8_LDB(dst, b, h) do { _Pragma("unroll") for (int n = 0; n < 2; ++n) _Pragma("unroll") for (int k = 0; k < 2; ++k) dst[n][k] = *(const PG8_LAS bf16x8*)(lds + PG8_SB(b, h) + boff + n * 2048 + k * 1024); } while (0)
#define PG8_MMA(ai, bj, At, Bt) do { __builtin_amdgcn_s_setprio(1); _Pragma("unroll") for (int m = 0; m < 4; ++m) _Pragma("unroll") for (int n = 0; n < 2; ++n) _Pragma("unroll") for (int k = 0; k < 2; ++k) \
        acc[ai][bj][m][n] = __builtin_amdgcn_mfma_f32_16x16x32_bf16(Bt[n][k], At[m][k], acc[ai][bj][m][n], 0, 0, 0); __builtin_amdgcn_s_setprio(0); } while (0)
#define PG8_WAIT_V(n) asm volatile("s_waitcnt vmcnt(" #n ")" ::: "memory")
#define PG8_WAIT_L(n) asm volatile("s_waitcnt lgkmcnt(" #n ")" ::: "memory")
#define PG8_BAR __builtin_amdgcn_s_barrier()
#define PG8_SCHED __builtin_amdgcn_sched_barrier(0)
    Unit cur, nxt; int ui = 0;
    if (!S.next(0, cur)) return;
    f32x4 acc[2][2][4][2];
#pragma unroll
    for (int a = 0; a < 2; ++a)
#pragma unroll
        for (int b = 0; b < 2; ++b)
#pragma unroll
            for (int m = 0; m < 4; ++m)
#pragma unroll
                for (int n = 0; n < 2; ++n) acc[a][b][m][n] = (f32x4){0.f, 0.f, 0.f, 0.f};
    bf16x8 At[4][2], B0[2][2], B1[2][2];
    const char* cA = (const char*)g.A + (size_t)cur.pm * tstep; const char* cB = (const char*)g.Bt + (size_t)cur.pn * tstep;
    S.a_ready(cur);
    if constexpr (SP2) {
        PG8_STAGE(PG8_SB(0, 0), cB, voffB); PG8_STAGE(PG8_SB(0, 1), cB + hstep, voffB); PG8_STAGE(PG8_SA(0, 0), cA, voffA); PG8_STAGE(PG8_SA(0, 1), cA + hstep, voffA);
        if (wr == 1) PG8_BAR;
        PG8_WAIT_V(2); PG8_BAR;
        PG8_STAGE(PG8_SB(1, 0), cB + kstep, voffB); PG8_STAGE(PG8_SA(1, 0), cA + kstep, voffA); PG8_STAGE(PG8_SB(1, 1), cB + hstep + kstep, voffB);
        PG8_WAIT_V(6); PG8_BAR;
    } else {
        PG8_STAGE(PG8_SB(0, 0), cB, voffB); PG8_STAGE(PG8_SA(0, 0), cA, voffA); PG8_STAGE(PG8_SB(0, 1), cB + hstep, voffB); PG8_STAGE(PG8_SA(0, 1), cA + hstep, voffA);
        if (wr == 1) PG8_BAR;
        PG8_WAIT_V(4); PG8_BAR;
        PG8_STAGE(PG8_SB(1, 0), cB + kstep, voffB); PG8_STAGE(PG8_SA(1, 0), cA + kstep, voffA); PG8_STAGE(PG8_SB(1, 1), cB + hstep + kstep, voffB);
        PG8_WAIT_V(6); PG8_BAR;
    }
    for (;;) {
        const bool has_next = S.next(ui + 1, nxt);
        const char* nA = has_next ? (const char*)g.A + (size_t)nxt.pm * tstep : cA; const char* nB = has_next ? (const char*)g.Bt + (size_t)nxt.pn * tstep : cB;
        for (int t = 0; t < nt; t += 2) {
            const bool last = (t == nt - 2);
            const char* a1 = cA + (size_t)(t + 1) * kstep;
            const char* a2 = last ? nA : cA + (size_t)(t + 2) * kstep; const char* b2 = last ? nB : cB + (size_t)(t + 2) * kstep;
            const char* a3 = a2 + kstep; const char* b3 = b2 + kstep;
            if (last && has_next) S.a_ready(nxt);
            if constexpr (SP2) {
            PG8_LDB(B0, 0, 0); PG8_LDB(B1, 0, 1); PG8_SCHED; PG8_LDA(At, 0, 0); PG8_STAGE(PG8_SA(1, 1), a1 + hstep, voffA);
            PG8_WAIT_V(8); PG8_WAIT_L(0); PG8_BAR; PG8_MMA(0, 0, At, B0); PG8_MMA(0, 1, At, B1); PG8_BAR; PG8_SCHED;
            PG8_LDA(At, 0, 1); PG8_STAGE(PG8_SB(0, 0), b2, voffB); PG8_STAGE(PG8_SB(0, 1), b2 + hstep, voffB); PG8_STAGE(PG8_SA(0, 0), a2, voffA);
            PG8_WAIT_V(8); PG8_WAIT_L(0); PG8_BAR; PG8_MMA(1, 0, At, B0); PG8_MMA(1, 1, At, B1); PG8_BAR; PG8_SCHED;
            PG8_LDB(B0, 1, 0); PG8_LDB(B1, 1, 1); PG8_SCHED; PG8_LDA(At, 1, 0); PG8_STAGE(PG8_SA(0, 1), a2 + hstep, voffA);
            PG8_WAIT_V(8); PG8_WAIT_L(0); PG8_BAR; PG8_MMA(0, 0, At, B0); PG8_MMA(0, 1, At, B1); PG8_BAR; PG8_SCHED;
            PG8_LDA(At, 1, 1); PG8_STAGE(PG8_SB(1, 0), b3, voffB); PG8_STAGE(PG8_SB(1, 1), b3 + hstep, voffB); PG8_STAGE(PG8_SA(1, 0), a3, voffA);
            PG8_WAIT_V(8); PG8_WAIT_L(0); PG8_BAR; PG8_MMA(1, 0, At, B0); PG8_MMA(1, 1, At, B1); PG8_BAR; PG8_SCHED;
            } else {
            PG8_LDB(B0, 0, 0); PG8_SCHED; PG8_LDA(At, 0, 0); PG8_STAGE(PG8_SA(1, 1), a1 + hstep, voffA);
            PG8_WAIT_L(8); PG8_BAR; PG8_WAIT_L(0); PG8_MMA(0, 0, At, B0); PG8_BAR; PG8_SCHED;
            PG8_LDB(B1, 0, 1); PG8_STAGE(PG8_SB(0, 0), b2, voffB);
            PG8_BAR; PG8_WAIT_L(0); PG8_MMA(0, 1, At, B1); PG8_BAR;
            PG8_LDA(At, 0, 1); PG8_STAGE(PG8_SA(0, 0), a2, voffA);
            PG8_BAR; PG8_WAIT_L(0); PG8_MMA(1, 0, At, B0); PG8_BAR; PG8_SCHED;
            PG8_STAGE(PG8_SB(0, 1), b2 + hstep, voffB);
            PG8_WAIT_V(6); PG8_BAR; PG8_MMA(1, 1, At, B1); PG8_BAR;
            PG8_LDB(B0, 1, 0); PG8_SCHED; PG8_LDA(At, 1, 0); PG8_STAGE(PG8_SA(0, 1), a2 + hstep, voffA);
            PG8_WAIT_L(8); PG8_BAR; PG8_WAIT_L(0); PG8_MMA(0, 0, At, B0); PG8_BAR; PG8_SCHED;
            PG8_LDB(B1, 1, 1); PG8_STAGE(PG8_SB(1, 0), b3, voffB);
            PG8_BAR; PG8_WAIT_L(0); PG8_MMA(0, 1, At, B1); PG8_BAR;
            PG8_LDA(At, 1, 1); PG8_STAGE(PG8_SA(1, 0), a3, voffA);
            PG8_BAR; PG8_WAIT_L(0); PG8_MMA(1, 0, At, B0); PG8_BAR; PG8_SCHED;
            PG8_STAGE(PG8_SB(1, 1), b3 + hstep, voffB);
            PG8_WAIT_V(6); PG8_BAR; PG8_MMA(1, 1, At, B1); PG8_BAR;
            }
        }
        if constexpr (ALIGN_EPI) { if (wr == 0) PG8_BAR; }
        if constexpr (!Epi::AFTER_DRAIN) { E(acc, cur, wr, wc, fr, fq); S.done(cur); }
        if (!has_next) break;
#pragma unroll
        for (int a = 0; a < 2; ++a)
#pragma unroll
            for (int b = 0; b < 2; ++b)
#pragma unroll
                for (int m = 0; m < 4; ++m)
#pragma unroll
                    for (int n = 0; n < 2; ++n) acc[a][b][m][n] = (f32x4){0.f, 0.f, 0.f, 0.f};
        cur = nxt; cA = nA; cB = nB; ++ui;
        if constexpr (ALIGN_EPI) { if (wr == 1) PG8_BAR; }
    }
    PG8_WAIT_V(0);
    if constexpr (!ALIGN_EPI) { if (wr == 0) PG8_BAR; }
    PG8_BAR;
    if constexpr (Epi::AFTER_DRAIN) { E.fused(acc, cur, wr, wc, fr, fq, lds, wid, lane); S.done(cur); }
#undef PG8_SA
#undef PG8_SB
#undef PG8_STAGE
#undef PG8_LDA
#undef PG8_LDB
#undef PG8_MMA
#undef PG8_WAIT_V
#undef PG8_WAIT_L
#undef PG8_BAR
#undef PG8_SCHED
}
}

#ifndef PG8_SP2
#define PG8_SP2 true
#endif
#ifndef PG8_ALIGN
#define PG8_ALIGN true
#endif
#include <hip/hip_bf16.h>
#include <cmath>
namespace attn_body {
using bf16=__hip_bfloat16;
using bf16x8=__attribute__((ext_vector_type(8)))short;
using s16x4=__attribute__((ext_vector_type(4)))short;
using f32x16=__attribute__((ext_vector_type(16)))float;
using u32x4=__attribute__((ext_vector_type(4)))unsigned;
constexpr int BATCH=4,SEQ=4096,D=64,PIN=3072,POUT=1024;
constexpr int NW=8,QBLK=32,QB=QBLK*NW,KVBLK=64,NQB=SEQ/QB;
constexpr int ATTN_UNIT_ROWS=QB;
__device__ __forceinline__ int crow(int r,int hi){return (r&3)+8*(r>>2)+4*hi;}
#define SBAR() __builtin_amdgcn_sched_barrier(0)
__device__ __forceinline__ void cmask(f32x16&p0,f32x16&p1,int jb,int qrel,int hi){
  const float NEG=-INFINITY; int kb=64*jb+4*hi; asm volatile("":"+v"(kb));
  #pragma unroll
  for(int r=0;r<16;++r){int kv=kb+(r&3)+8*(r>>2); if(kv>qrel)p0[r]=NEG; if(kv+32>qrel)p1[r]=NEG;}
}

constexpr int NSLOT=3, SLOTB=8192;
constexpr int LDS_K=0, LDS_V=NSLOT*SLOTB, LDS_WS=3*NSLOT*SLOTB, LDS_OST=LDS_WS+NW*64*4, LDS_BYTES=LDS_OST+NW*4096;
constexpr float C2=0.125f*1.4426950408889634f;
__device__ __forceinline__ void glds16(const void*gsrc,unsigned lds_dst){unsigned keep;
  asm volatile("s_mov_b32 %0, m0\n\ts_mov_b32 m0, %2\n\ts_nop 0\n\tglobal_load_lds_dwordx4 %1, off\n\ts_mov_b32 m0, %0":"=&s"(keep):"v"(gsrc),"s"(lds_dst):"memory");}
__device__ __forceinline__ void glds16s(const void*sbase,unsigned voff,unsigned lds_dst){unsigned keep;
  asm volatile("s_mov_b32 %0, m0\n\ts_mov_b32 m0, %3\n\ts_nop 0\n\tglobal_load_lds_dwordx4 %1, %2\n\ts_mov_b32 m0, %0":"=&s"(keep):"v"(voff),"s"(sbase),"s"(lds_dst):"memory");}
__device__ __forceinline__ float max3f(float a,float b,float c){float r;asm("v_max3_f32 %0, %1, %2, %3":"=v"(r):"v"(a),"v"(b),"v"(c));return r;}
__device__ __forceinline__ float max2f(float a,float b){float r;asm("v_max_f32_e32 %0, %1, %2":"=v"(r):"v"(a),"v"(b));return r;}
__device__ __forceinline__ float fadd_s(float a,float b){float r;asm("v_add_f32_e32 %0, %1, %2":"=v"(r):"v"(a),"v"(b));return r;}
__device__ __forceinline__ float fsub_s(float a,float b){float r;asm("v_sub_f32_e32 %0, %1, %2":"=v"(r):"v"(a),"v"(b));return r;}
typedef float f32x2_t __attribute__((ext_vector_type(2))); typedef __bf16 bf16x2_t __attribute__((ext_vector_type(2)));
__device__ __forceinline__ unsigned cvtpk_s(float lo,float hi){f32x2_t v={lo,hi};bf16x2_t b=__builtin_convertvector(v,bf16x2_t);return __builtin_bit_cast(unsigned,b);}
#define WAIT_BAR(N) asm volatile("s_waitcnt vmcnt(" #N ") lgkmcnt(0)\n\ts_barrier":::"memory")

__device__ __forceinline__ void qkt(f32x16&p0,f32x16&p1,const char*Kslot,const bf16x8*qr,const f32x16&negm,int r32,int hi){
  const char*kb=Kslot+hi*1024+r32*16;
  #pragma unroll
  for(int d0=0;d0<4;++d0){
    const bf16x8 b0=*reinterpret_cast<const bf16x8*>(kb+d0*2048);
    const bf16x8 b1=*reinterpret_cast<const bf16x8*>(kb+d0*2048+512);
    if(d0==0){p0=__builtin_amdgcn_mfma_f32_32x32x16_bf16(b0,qr[0],negm,0,0,0);p1=__builtin_amdgcn_mfma_f32_32x32x16_bf16(b1,qr[0],negm,0,0,0);}
    else{p0=__builtin_amdgcn_mfma_f32_32x32x16_bf16(b0,qr[d0],p0,0,0,0);p1=__builtin_amdgcn_mfma_f32_32x32x16_bf16(b1,qr[d0],p1,0,0,0);}}
}
typedef __attribute__((address_space(3))) const char* lds_cptr;
typedef short v4i16_t __attribute__((ext_vector_type(4)));
__device__ __forceinline__ void kload8(bf16x8*kf,lds_cptr kp){
  kf[0]=*(const __attribute__((address_space(3))) bf16x8*)(kp);      kf[1]=*(const __attribute__((address_space(3))) bf16x8*)(kp+512);
  kf[2]=*(const __attribute__((address_space(3))) bf16x8*)(kp+2048); kf[3]=*(const __attribute__((address_space(3))) bf16x8*)(kp+2560);
  kf[4]=*(const __attribute__((address_space(3))) bf16x8*)(kp+4096); kf[5]=*(const __attribute__((address_space(3))) bf16x8*)(kp+4608);
  kf[6]=*(const __attribute__((address_space(3))) bf16x8*)(kp+6144); kf[7]=*(const __attribute__((address_space(3))) bf16x8*)(kp+6656);
}
__device__ __forceinline__ void kload2(bf16x8*kf,lds_cptr kp,int j){ kf[2*j]=*(const __attribute__((address_space(3))) bf16x8*)(kp+j*2048); kf[2*j+1]=*(const __attribute__((address_space(3))) bf16x8*)(kp+j*2048+512); }
__device__ __forceinline__ s16x4 vtr(lds_cptr p){ return __builtin_bit_cast(s16x4,__builtin_amdgcn_ds_read_tr16_b64_v4i16((__attribute__((address_space(3))) v4i16_t*)p)); }
__device__ __forceinline__ float rowmax(const f32x16&p0,const f32x16&p1){
  float a=max3f(p0[0],p0[1],p1[0]),b=max3f(p0[2],p0[3],p1[1]);a=max3f(a,p1[2],p1[3]);
  #pragma unroll
  for(int r=4;r<16;r+=4){a=max3f(a,p0[r],p0[r+1]);b=max3f(b,p0[r+2],p0[r+3]);a=max3f(a,p1[r],p1[r+1]);b=max3f(b,p1[r+2],p1[r+3]);}
  const float m=max2f(a,b);
  auto rr=__builtin_amdgcn_permlane32_swap(__float_as_uint(m),__float_as_uint(m),false,false);
  return max2f(__uint_as_float(rr[0]),__uint_as_float(rr[1]));
}
__device__ __forceinline__ void pv(f32x16*o,int vb,bf16x8 pa0,bf16x8 pa1,bf16x8 pa2,bf16x8 pa3){
  #pragma unroll
  for(int d0=0;d0<4;++d0){s16x4 lo[4],hi[4];
    #pragma unroll
    for(int ks=0;ks<4;++ks){
      asm volatile("ds_read_b64_tr_b16 %0,%1 offset:%c2":"=&v"(lo[ks]):"v"(vb),"i"(d0*4096+ks*1024):"memory");
      asm volatile("ds_read_b64_tr_b16 %0,%1 offset:%c2":"=&v"(hi[ks]):"v"(vb),"i"(d0*4096+ks*1024+512):"memory");}
    asm volatile("s_waitcnt lgkmcnt(0)":::"memory");SBAR();
    #define PK(k) (bf16x8){lo[k][0],lo[k][1],lo[k][2],lo[k][3],hi[k][0],hi[k][1],hi[k][2],hi[k][3]}
    o[d0]=__builtin_amdgcn_mfma_f32_32x32x16_bf16(pa0,PK(0),o[d0],0,0,0);
    o[d0]=__builtin_amdgcn_mfma_f32_32x32x16_bf16(pa1,PK(1),o[d0],0,0,0);
    o[d0]=__builtin_amdgcn_mfma_f32_32x32x16_bf16(pa2,PK(2),o[d0],0,0,0);
    o[d0]=__builtin_amdgcn_mfma_f32_32x32x16_bf16(pa3,PK(3),o[d0],0,0,0);
    #undef PK
  }
}

#ifndef ATTN_STORE16
#define ATTN_STORE16(p,v) (*(u32x4*)(p)=(v))
#endif
template<int THRL> __device__ __forceinline__ void attn_unit(int b,int qcol,int kcol,int vcol,int ocol,int qb,const bf16*Q,const bf16*__restrict__ K,const bf16*__restrict__ V,bf16*O,char*shm,const int tid){
  const int lane=tid&63,r32=lane&31,hi=lane>>5; const int wid=__builtin_amdgcn_readfirstlane(tid>>6);
  const long rowbase=(long)b*SEQ; const int q0=qb*QB;
  const bf16*Qw=Q+(rowbase+q0+wid*QBLK)*PIN+qcol;
  const bf16*Kh=K+rowbase*PIN+kcol,*Vh=V+rowbase*PIN+vcol;
  const unsigned lds0=(unsigned)(uintptr_t)shm;
  float*wsf=(float*)(shm+LDS_WS)+wid*64;
  const unsigned koff=(unsigned)(lane*PIN+wid*8)*2u;
  const unsigned voff=(unsigned)((16*(wid&3)+(lane>>2))*PIN+(wid>>2)*32+(lane&3)*8)*2u;
  const unsigned kdst=lds0+LDS_K+wid*1024, vdst=lds0+LDS_V+wid*1024;
  #define DMA_K(t,slot) glds16s(Kh+(long)(t)*KVBLK*PIN,koff,(unsigned)__builtin_amdgcn_readfirstlane(kdst+(slot)))
  #define DMA_V(t,slot) do{ glds16s(Vh+(long)(t)*KVBLK*PIN,voff,(unsigned)__builtin_amdgcn_readfirstlane(vdst+2*(slot))); glds16s(Vh+(long)(t)*KVBLK*PIN,voff+128u,(unsigned)__builtin_amdgcn_readfirstlane(vdst+8192+2*(slot))); }while(0)
  const int vb0=(int)(lds0+LDS_V)+((lane>>4)&1)*32+(lane&3)*8+(4*hi+((lane&15)>>2))*64;
  const char*Kbase=shm+LDS_K; bf16x8 kf[8];
  const lds_cptr shm3=(lds_cptr)shm; const lds_cptr kp0=shm3+LDS_K+hi*1024+r32*16; const lds_cptr vp0=shm3+LDS_V+((lane>>4)&1)*32+(lane&3)*8+(4*hi+((lane&15)>>2))*64;
  const int NT=(q0+QB)/KVBLK;
  DMA_K(0,0);DMA_V(0,0);DMA_K(1,SLOTB);
  bf16x8 qr[4];
  { int lq=lane; asm volatile("":"+v"(lq)); const int r32q=lq&31,hiq=lq>>5;
  _Pragma("unroll") for(int d0=0;d0<4;++d0)qr[d0]=*reinterpret_cast<const bf16x8*>(&Qw[(long)r32q*PIN+d0*16+hiq*8]); }
  const lds_cptr qst=shm3+LDS_OST+wid*4096+lane*16;
  #define QST(d0) (*(__attribute__((address_space(3))) bf16x8*)(qst+(d0)*1024))
  _Pragma("unroll") for(int d0=0;d0<4;++d0) *(__attribute__((address_space(3))) bf16x8*)((__attribute__((address_space(3))) char*)qst+d0*1024)=qr[d0];
  float mhat=0.f,l_reg=0.f;f32x16 o[4];o[0]=f32x16{};o[1]=f32x16{};o[2]=f32x16{};o[3]=f32x16{};float z0_=0.f;asm volatile("":"+v"(z0_));f32x16 negm;_Pragma("unroll") for(int r=0;r<16;++r)negm[r]=z0_;asm volatile("":"+v"(negm));
  const int qrel=wid*QBLK+r32;
  #define CMASK(P0,P1,t) do{int jb_=(t)-(NT-4); if(jb_>=0)cmask(P0,P1,jb_,qrel,hi);}while(0)
  bool resc=false;
  #define START(P0,P1) do{ const float rm=rowmax(P0,P1); resc=false; \
    { const float dl=rm; mhat=fadd_s(mhat,dl); \
      _Pragma("unroll") for(int r=0;r<16;++r){P0[r]=fsub_s(P0[r],dl);P1[r]=fsub_s(P1[r],dl);} \
      _Pragma("unroll") for(int r=0;r<16;++r)negm[r]=-mhat; asm volatile("":"+v"(negm)); } \
    _Pragma("unroll") for(int r=0;r<16;++r)P0[r]=__builtin_amdgcn_exp2f(P0[r]); }while(0)
  #define RESC() do{ if(resc){ asm volatile("s_waitcnt lgkmcnt(0)":::"memory"); \
      _Pragma("unroll") for(int d_=0;d_<4;++d_) _Pragma("unroll") for(int r=0;r<16;++r)o[d_][r]*=wsf[crow(r,hi)]; } }while(0)
  f32x16 pA0,pA1,pB0,pB1;
  int sl_prev=0,sl_cur=0,sl_next=SLOTB;
  #define ROT() do{sl_prev=sl_cur;sl_cur=sl_next;sl_next=(sl_next==(NSLOT-1)*SLOTB)?0:sl_next+SLOTB;}while(0)
  DMA_K(2,2*SLOTB);
  WAIT_BAR(3);
  qkt(pA0,pA1,Kbase,qr,negm,r32,hi);asm volatile("s_nop 15\n\ts_nop 7":"+v"(pA0),"+v"(pA1));CMASK(pA0,pA1,0);
  START(pA0,pA1);
  _Pragma("unroll") for(int r=0;r<16;++r)pA1[r]=__builtin_amdgcn_exp2f(pA1[r]);
  u32x4 pa0,pa1,pa2,pa3,pb0,pb1,pb2,pb3;
  { float s0_=pA0[0]+pA0[1]; _Pragma("unroll") for(int r=2;r<16;++r)s0_+=pA0[r]; _Pragma("unroll") for(int r=0;r<16;++r)s0_+=pA1[r]; l_reg+=s0_;
    pa0=(u32x4){cvtpk_s(pA0[0],pA0[1]),cvtpk_s(pA0[2],pA0[3]),cvtpk_s(pA0[4],pA0[5]),cvtpk_s(pA0[6],pA0[7])}; pa1=(u32x4){cvtpk_s(pA0[8],pA0[9]),cvtpk_s(pA0[10],pA0[11]),cvtpk_s(pA0[12],pA0[13]),cvtpk_s(pA0[14],pA0[15])};
    pa2=(u32x4){cvtpk_s(pA1[0],pA1[1]),cvtpk_s(pA1[2],pA1[3]),cvtpk_s(pA1[4],pA1[5]),cvtpk_s(pA1[6],pA1[7])}; pa3=(u32x4){cvtpk_s(pA1[8],pA1[9]),cvtpk_s(pA1[10],pA1[11]),cvtpk_s(pA1[12],pA1[13]),cvtpk_s(pA1[14],pA1[15])}; }
  WAIT_BAR(0);
  DMA_K(3,0);DMA_V(1,SLOTB);
  ROT();
  kload8(kf,kp0+sl_cur);
  WAIT_BAR(3);
  s16x4 vlo[4],vhi[4];
  #define PAFX(P) __builtin_bit_cast(bf16x8,P)
  #define VFRS(i) (bf16x8){vlo[i][0],vlo[i][1],vlo[i][2],vlo[i][3],vhi[i][0],vhi[i][1],vhi[i][2],vhi[i][3]}
  #define PIN(x) asm volatile("":"+v"(x))
  #define MX3(a,b,c) __builtin_fmaxf(__builtin_fmaxf((a),(b)),(c))
  #define EX(v) __builtin_amdgcn_exp2f(v)
  #define VRDF(s,id) do{ vlo[s]=vtr(vp_+(((id)>>2)*4096+((id)&3)*1024)); vhi[s]=vtr(vp_+(((id)>>2)*4096+((id)&3)*1024+512)); }while(0)
  #define GAPA(MF) do{ MF; SBAR(); }while(0)
  #define GAPAV(MF,s,id) do{ VRDF(s,id); SBAR(); MF; SBAR(); }while(0)
  #define GAPB(MF,X,B,PN,W,RD) do{ MF; X[B]=EX(X[B]); X[B+1]=EX(X[B+1]); PIN(X); sacc+=X[B]; sacc+=X[B+1]; PIN(sacc); PN[W]=cvtpk_s(X[B],X[B+1]); PIN(PN); RD; SBAR(); }while(0)
  #define KRD(G,j) do{ if(G){ kload2(kf,kp0+sl_next,j); SBAR(); } }while(0)
  #define STEP(C0,C1,PC0,PC1,PC2,PC3,PN0,PN1,PN2,PN3,t,GK,GV,GL) do{ SBAR(); \
    const lds_cptr vp_=vp0+2*sl_prev; \
    const bf16x8 q0_=QST(0),q1_=QST(1),q2_=QST(2),q3_=QST(3); SBAR(); \
    GAPA(C0=__builtin_amdgcn_mfma_f32_32x32x16_bf16(kf[0],q0_,negm,0,0,0)); \
    GAPA(C1=__builtin_amdgcn_mfma_f32_32x32x16_bf16(kf[1],q0_,negm,0,0,0)); \
    GAPA(C0=__builtin_amdgcn_mfma_f32_32x32x16_bf16(kf[2],q1_,C0,0,0,0)); \
    GAPA(C1=__builtin_amdgcn_mfma_f32_32x32x16_bf16(kf[3],q1_,C1,0,0,0)); \
    GAPAV(C0=__builtin_amdgcn_mfma_f32_32x32x16_bf16(kf[4],q2_,C0,0,0,0),0,0); \
    GAPAV(C1=__builtin_amdgcn_mfma_f32_32x32x16_bf16(kf[5],q2_,C1,0,0,0),1,4); \
    GAPAV(C0=__builtin_amdgcn_mfma_f32_32x32x16_bf16(kf[6],q3_,C0,0,0,0),2,1); \
    GAPAV(C1=__builtin_amdgcn_mfma_f32_32x32x16_bf16(kf[7],q3_,C1,0,0,0),3,5); \
    if(GK){DMA_K((t)+3,sl_cur);} if(GV){DMA_V((t)+1,sl_next);} \
    CMASK(C0,C1,t); \
    { float a=MX3(C0[0],C0[1],C1[0]),b=MX3(C0[2],C0[3],C1[1]); a=MX3(a,C1[2],C1[3]); \
      _Pragma("unroll") for(int r=4;r<16;r+=4){a=MX3(a,C0[r],C0[r+1]);b=MX3(b,C0[r+2],C0[r+3]);a=MX3(a,C1[r],C1[r+1]);b=MX3(b,C1[r+2],C1[r+3]);} \
      float rm=__builtin_fmaxf(a,b); { auto rr=__builtin_amdgcn_permlane32_swap(__float_as_uint(rm),__float_as_uint(rm),false,false); rm=__builtin_fmaxf(__uint_as_float(rr[0]),__uint_as_float(rr[1])); } \
      resc=false; \
      if(__builtin_expect(__any(rm>(float)THRL),0)){ const float dl=__builtin_fmaxf(rm,0.f); mhat+=dl; \
        _Pragma("unroll") for(int r=0;r<16;++r){C0[r]-=dl;C1[r]-=dl;} \
        _Pragma("unroll") for(int r=0;r<16;++r)negm[r]=-mhat; asm volatile("":"+v"(negm)); \
        const float f=__builtin_amdgcn_exp2f(-dl); l_reg*=f; if(hi==0)wsf[r32]=f; resc=true; } } \
    SBAR(); \
    float sacc=0.f; \
    GAPB(o[0]=__builtin_amdgcn_mfma_f32_32x32x16_bf16(PAFX(PC0),VFRS(0),o[0],0,0,0), C0,0,  PN0,0, VRDF(0,2)); \
    GAPB(o[1]=__builtin_amdgcn_mfma_f32_32x32x16_bf16(PAFX(PC0),VFRS(1),o[1],0,0,0), C0,2,  PN0,1, VRDF(1,6)); \
    KRD(GL,0); GAPB(o[0]=__builtin_amdgcn_mfma_f32_32x32x16_bf16(PAFX(PC1),VFRS(2),o[0],0,0,0), C0,4,  PN0,2, VRDF(2,3)); \
    KRD(GL,1); GAPB(o[1]=__builtin_amdgcn_mfma_f32_32x32x16_bf16(PAFX(PC1),VFRS(3),o[1],0,0,0), C0,6,  PN0,3, VRDF(3,7)); \
    KRD(GL,2); GAPB(o[0]=__builtin_amdgcn_mfma_f32_32x32x16_bf16(PAFX(PC2),VFRS(0),o[0],0,0,0), C0,8,  PN1,0, VRDF(0,8)); \
    KRD(GL,3); GAPB(o[1]=__builtin_amdgcn_mfma_f32_32x32x16_bf16(PAFX(PC2),VFRS(1),o[1],0,0,0), C0,10, PN1,1, VRDF(1,12)); \
    GAPB(o[0]=__builtin_amdgcn_mfma_f32_32x32x16_bf16(PAFX(PC3),VFRS(2),o[0],0,0,0), C0,12, PN1,2, VRDF(2,9)); \
    GAPB(o[1]=__builtin_amdgcn_mfma_f32_32x32x16_bf16(PAFX(PC3),VFRS(3),o[1],0,0,0), C0,14, PN1,3, VRDF(3,13)); \
    GAPB(o[2]=__builtin_amdgcn_mfma_f32_32x32x16_bf16(PAFX(PC0),VFRS(0),o[2],0,0,0), C1,0,  PN2,0, VRDF(0,10)); \
    GAPB(o[3]=__builtin_amdgcn_mfma_f32_32x32x16_bf16(PAFX(PC0),VFRS(1),o[3],0,0,0), C1,2,  PN2,1, VRDF(1,14)); \
    GAPB(o[2]=__builtin_amdgcn_mfma_f32_32x32x16_bf16(PAFX(PC1),VFRS(2),o[2],0,0,0), C1,4,  PN2,2, VRDF(2,11)); \
    GAPB(o[3]=__builtin_amdgcn_mfma_f32_32x32x16_bf16(PAFX(PC1),VFRS(3),o[3],0,0,0), C1,6,  PN2,3, VRDF(3,15)); \
    GAPB(o[2]=__builtin_amdgcn_mfma_f32_32x32x16_bf16(PAFX(PC2),VFRS(0),o[2],0,0,0), C1,8,  PN3,0, (void)0); \
    GAPB(o[3]=__builtin_amdgcn_mfma_f32_32x32x16_bf16(PAFX(PC2),VFRS(1),o[3],0,0,0), C1,10, PN3,1, (void)0); \
    GAPB(o[2]=__builtin_amdgcn_mfma_f32_32x32x16_bf16(PAFX(PC3),VFRS(2),o[2],0,0,0), C1,12, PN3,2, (void)0); \
    GAPB(o[3]=__builtin_amdgcn_mfma_f32_32x32x16_bf16(PAFX(PC3),VFRS(3),o[3],0,0,0), C1,14, PN3,3, (void)0); \
    l_reg+=sacc; \
    }while(0)
  #define STEP_AB(C0,C1,t,GK,GV,GL) STEP(C0,C1,pa0,pa1,pa2,pa3,pb0,pb1,pb2,pb3,t,GK,GV,GL)
  #define STEP_BA(C0,C1,t,GK,GV,GL) STEP(C0,C1,pb0,pb1,pb2,pb3,pa0,pa1,pa2,pa3,t,GK,GV,GL)
  int t=1;
  #undef CMASK
  #define CMASK(P0,P1,t) do{}while(0)
  for(;t+5<NT;t+=2){
    STEP_AB(pB0,pB1,t,true,true,true);     WAIT_BAR(3); RESC(); ROT();
    STEP_BA(pA0,pA1,t+1,true,true,true);   WAIT_BAR(3); RESC(); ROT();
  }
  #undef CMASK
  #define CMASK(P0,P1,t) do{int jb_=(t)-(NT-4); if(jb_>=0)cmask(P0,P1,jb_,qrel,hi);}while(0)
  #define ENDW(tt) do{ if((tt)+3<NT){WAIT_BAR(3);} else if((tt)+2<NT){WAIT_BAR(2);} else {WAIT_BAR(0);} }while(0)
  for(;t+1<NT;t+=2){
    STEP_AB(pB0,pB1,t,(t+3<NT),(t+1<NT),(t+1<NT));       ENDW(t);   RESC(); ROT();
    STEP_BA(pA0,pA1,t+1,(t+4<NT),(t+2<NT),(t+2<NT));     ENDW(t+1); RESC(); ROT();
  }
  STEP_AB(pB0,pB1,NT-1,false,false,false); RESC();
  { SBAR(); pv(o,vb0+2*sl_cur,PAFX(pb0),PAFX(pb1),PAFX(pb2),PAFX(pb3)); }
  #undef QST
  #undef PAFX
  #undef VFRS
  #undef PIN
  #undef MX3
  #undef GAPA
  #undef GAPAV
  #undef GAPB
  #undef EX
  #undef VRDF
  #undef KRD
  #undef STEP
  #undef STEP_AB
  #undef STEP_BA
  #undef ENDW
  {auto rr=__builtin_amdgcn_permlane32_swap(__float_as_uint(l_reg),__float_as_uint(l_reg),false,false);l_reg=__uint_as_float(rr[0])+__uint_as_float(rr[1]);}
  { int le=lane; asm volatile("":"+v"(le)); const int r32e=le&31,hie=le>>5;
  if(hie==0)wsf[32+r32e]=l_reg;asm volatile("s_waitcnt lgkmcnt(0)":::"memory");
  float rli[16];
  #pragma unroll
  for(int r=0;r<16;++r)rli[r]=__builtin_amdgcn_rcpf(wsf[32+crow(r,hie)]);
  bf16*Ow=O+(rowbase+q0+wid*QBLK)*POUT+ocol;
  { bf16*stg=(bf16*)(shm+LDS_OST)+wid*2048;
    #pragma unroll
    for(int hf=0;hf<2;++hf){
    #pragma unroll
    for(int r=0;r<16;++r){const int orow=crow(r,hie);
      #pragma unroll
      for(int d0=0;d0<2;++d0)stg[orow*64+d0*32+r32e]=__float2bfloat16(o[2*hf+d0][r]*rli[r]);}
    asm volatile("s_waitcnt lgkmcnt(0)":::"memory");
    #pragma unroll
    for(int i=0;i<4;++i){const int row=i*8+(le>>3),ch=le&7; const u32x4 v=*(const u32x4*)(stg+row*64+ch*8); ATTN_STORE16(Ow+(long)row*POUT+hf*64+ch*8,v);}
    asm volatile("s_waitcnt lgkmcnt(0)":::"memory"); } } }
  asm volatile("s_waitcnt lgkmcnt(0)\n\ts_barrier":::"memory");
  #undef DMA_K
  #undef DMA_V
  #undef CMASK
  #undef START
  #undef RESC
  #undef ROT
}
constexpr int ATTN_LDS_BYTES=LDS_BYTES;
struct AttnUnit { int bh; int qb; };
struct StaticOrder {
  int vcu;
  __device__ __forceinline__ explicit StaticOrder(int v):vcu(v){}
  __device__ __forceinline__ bool next(int i,AttnUnit&u)const{ if(i>=2)return false; const int s=vcu&7; u.bh=vcu>>3; u.qb=(i==0)?s:15-s; return true; }
};
template<class Sched,int THRL=8> __device__ __forceinline__ void attn_phase(char*lds,const bf16*P,bf16*O,const Sched&S,const int tid){
  AttnUnit u;
  for(int i=0;S.next(i,u);++i){ const int b=u.bh>>3, h=(u.bh>>1)&3, m=u.bh&1;
    attn_unit<THRL>(b, h*128+m*64, 512+h*128+m*64, 1024+h*128, m*512+h*128, u.qb, P, P, P, O, lds, tid); }
}
#undef SBAR
#undef WAIT_BAR
}
#define GAS __attribute__((address_space(1)))
#define LAS __attribute__((address_space(3)))
typedef unsigned short bf16;
typedef unsigned v4u __attribute__((ext_vector_type(4)));
typedef float f32x4 __attribute__((ext_vector_type(4)));
typedef short bf16x8 __attribute__((ext_vector_type(8)));
typedef GAS unsigned gu32;
typedef GAS unsigned long long gu64;
#define RLX_AGENT __ATOMIC_RELAXED, __HIP_MEMORY_SCOPE_AGENT
#define LDS_WAIT() asm volatile("s_waitcnt lgkmcnt(0)" ::: "memory")
#define VM_WAIT() asm volatile("s_waitcnt vmcnt(0)" ::: "memory")
__device__ __forceinline__ unsigned long long rt() { return __builtin_amdgcn_s_memrealtime(); }
__device__ __forceinline__ unsigned f2bf(float f) { unsigned u = __builtin_bit_cast(unsigned, f); return (u + 0x7fffu + ((u >> 16) & 1u)) >> 16; }
__device__ __forceinline__ unsigned pk2(float lo, float hi) { return f2bf(lo) | (f2bf(hi) << 16); }

#define XB_TMO      128
#define XB_XCNT(j)  (256  + 64 * (j))
#define XB_XSUB(j)  (1280 + 64 * (j))
#define XB_XGEN(j)  (2304 + 64 * (j))
#define XB_TOP      3328
#define XB_TOPGEN   3392
#define XCD_BAR_WORDS 3456
#define XB_SPIN_CAP (1u << 22)

__device__ __forceinline__ unsigned xb_ld(unsigned* p)              { return __hip_atomic_load(p, __ATOMIC_RELAXED, __HIP_MEMORY_SCOPE_AGENT); }
__device__ __forceinline__ unsigned xb_add(unsigned* p, unsigned v) { return __hip_atomic_fetch_add(p, v, __ATOMIC_RELAXED, __HIP_MEMORY_SCOPE_AGENT); }
__device__ __forceinline__ unsigned xb_xcc_id() { return (unsigned)__builtin_amdgcn_s_getreg((3 << 11) | 20) & 0xFu; }
#define XB_SPIN(cond, bar) do { unsigned _sp = 0; while (cond) { __builtin_amdgcn_s_sleep(1); \
    if ((++_sp & 255u) == 0u) { if (xb_ld(&(bar)[XB_TMO])) break; if (_sp > XB_SPIN_CAP) { atomicAdd(&(bar)[XB_TMO], 1u); break; } } } } while (0)

struct XcdBarrier {
    unsigned* bar; unsigned x;
    volatile LAS unsigned* st;
};

__device__ __forceinline__ XcdBarrier xcd_barrier_post(unsigned* bar, volatile LAS unsigned* st) {
    XcdBarrier b; b.bar = bar; b.x = xb_xcc_id(); b.st = st;
    if (threadIdx.x == 0) (void)xb_add(&bar[XB_XCNT(b.x)], 1u);
    return b;
}
__device__ __forceinline__ void xcd_barrier_complete(unsigned* bar, unsigned x, unsigned& nloc, unsigned& nx) {
    const unsigned G = gridDim.x * gridDim.y * gridDim.z;
    unsigned sum, cnt, mine, sp = 0u;
    for (;;) {
        sum = 0u; cnt = 0u; mine = 0u;
#pragma unroll
        for (unsigned j = 0; j < 16; ++j) { const unsigned c = xb_ld(&bar[XB_XCNT(j)]); sum += c; cnt += (c > 0u) ? 1u : 0u; mine = (j == x) ? c : mine; }
        if (sum == G) break;
        __builtin_amdgcn_s_sleep(1);
        if ((++sp & 255u) == 0u) { if (xb_ld(&bar[XB_TMO])) break; if (sp > XB_SPIN_CAP) { atomicAdd(&bar[XB_TMO], 1u); break; } }
    }
    nloc = mine > 0u ? mine : 1u; nx = cnt > 0u ? cnt : 1u;
}

__device__ __forceinline__ void xcd_barrier(const XcdBarrier& b, const bool leader  ) {
    asm volatile("s_waitcnt vmcnt(0)" ::: "memory");
    __syncthreads();
    if (leader) {
        unsigned* bar = b.bar;
        __builtin_amdgcn_s_waitcnt(0);
        unsigned nloc = b.st[0], nx = b.st[1];
        if (nloc == 0u) { xcd_barrier_complete(bar, b.x, nloc, nx); b.st[0] = nloc; b.st[1] = nx; }
        const unsigned old = xb_add(&bar[XB_XSUB(b.x)], 1u);
        const unsigned gen = old / nloc;
        if (old + 1u == (gen + 1u) * nloc) {
            __builtin_amdgcn_fence(__ATOMIC_RELEASE, "agent");
            asm volatile("s_waitcnt vmcnt(0)" ::: "memory");
            const unsigned og = xb_add(&bar[XB_TOP], 1u);
            const unsigned tg = og / nx;
            if (og + 1u == (tg + 1u) * nx) xb_add(&bar[XB_TOPGEN], 1u);
            else XB_SPIN(xb_ld(&bar[XB_TOPGEN]) == tg, bar);
            __builtin_amdgcn_fence(__ATOMIC_ACQUIRE, "agent");
            xb_add(&bar[XB_XGEN(b.x)], 1u);
            asm volatile("s_waitcnt vmcnt(0)" ::: "memory");
        } else {
            XB_SPIN(xb_ld(&bar[XB_XGEN(b.x)]) == gen, bar);
            __builtin_amdgcn_fence(__ATOMIC_ACQUIRE, "agent");
            asm volatile("s_waitcnt vmcnt(0)" ::: "memory");
        }
    }
    __syncthreads();
}

constexpr int NWAVES = 8;
constexpr int M = 16384, DM = 1024, SEQL = 4096, NPROJ = 3072, NIN = 3088, NQ = 2048, NLAYER = 2;
constexpr int C_Q = 0, C_K = 512, C_V = 1024, C_SB = 1536, C_SC = 1792, C_SH = 2048, C_GQ = 2304, C_GK = 2432, C_GV = 2560, C_GR = 2816;
constexpr float EPS = 1e-6f;
constexpr float ATT_C2 = 0.125f * 1.4426950408889634f;

constexpr size_t MiB = 1u << 20;
constexpr size_t WS_CTL = 0, CTL_ZERO_BYTES = 1 * MiB;
constexpr size_t WS_WIN = 1 * MiB, WIN_STRIDE = 7 * MiB;
constexpr size_t WS_WOUT = 15 * MiB, WOUT_STRIDE = 2 * MiB;
constexpr size_t WS_WQ = 19 * MiB, WQ_STRIDE = 4 * MiB;
constexpr size_t WS_KEYS = 27 * MiB, KEYS_STRIDE = 65536;
constexpr size_t WS_COS = 28 * MiB, WS_SIN = 28 * MiB + 512 * 1024;
constexpr size_t WS_SSQ = 29 * MiB;
constexpr size_t WS_GD = 30 * MiB;
constexpr size_t WS_LAM = 30 * MiB + 512 * 1024;
constexpr size_t WS_PAR = 30 * MiB + 768 * 1024;
constexpr int PAR_DN = 0, PAR_CW = 256, PAR_WG2 = 1792, PAR_BG = 5888, PAR_GN = 6144, PAR_NF = 6272, PAR_N = 7296;
constexpr size_t WS_GU = 31 * MiB;
constexpr size_t WS_GB = 39 * MiB;
constexpr size_t WS_EXP = 47 * MiB;
constexpr size_t WS_GATE = 55 * MiB;
constexpr size_t WS_TAB = 64 * MiB, TAB_STRIDE = 32 * MiB;
constexpr size_t WS_SU = 56 * MiB + 512 * 1024 * 0 + 7 * MiB, WS_SV = WS_SU + 256 * 1024;
constexpr size_t WS_RS1 = 63 * MiB + 512 * 1024;
constexpr size_t WS_XB = 192 * MiB;
constexpr size_t WS_PROJ = 224 * MiB;
constexpr size_t WS_OATT = 320 * MiB;
constexpr size_t WS_MIXED = 352 * MiB;
constexpr size_t WS_QP = 384 * MiB;
constexpr size_t WS_END = 448 * MiB;
constexpr int CW_TMO = 0, CW_BAR = 4096;

constexpr int RING_OFF = 0, RING_BYTES = 131072;
constexpr int LDSCTL_OFF = RING_BYTES, MISC_OFF = LDSCTL_OFF + 320;
constexpr int LDS_BYTES = 147456;

struct Frame {
    LAS unsigned char* lds;
    volatile LAS unsigned* MISC;
    int tid, lane, wave;
    int vcu, G, bx;
    float* out; unsigned char* ws;
};
__device__ __forceinline__ float wave_sum(float v) { return xl_wave_sum(v); }
__device__ __forceinline__ float bflo(unsigned w) { return __builtin_bit_cast(float, w << 16); }
__device__ __forceinline__ float bfhi(unsigned w) { return __builtin_bit_cast(float, w & 0xffff0000u); }
__device__ __forceinline__ float bf1(bf16 h) { return __builtin_bit_cast(float, (unsigned)h << 16); }

__device__ __forceinline__ void p0_transpose_item(const float* W, int ldw, int N, const float* gain, bf16* WT, int K, LAS float* scr, int item, int lane) {
    const int nblk = (N + 31) / 32, kb = item / nblk, nb = item % nblk, k0 = 64 * kb, n0 = 32 * nb;
    const int nn = n0 + (lane & 31);
    float wv[32];
#pragma unroll
    for (int i = 0; i < 32; ++i) { const int kk = 2 * i + (lane >> 5); wv[i] = (nn < N) ? W[(size_t)(k0 + kk) * ldw + nn] : 0.f; }
#pragma unroll
    for (int i = 0; i < 32; ++i) { const int kk = 2 * i + (lane >> 5); float w = wv[i]; if (gain) w *= gain[k0 + kk]; scr[kk * 33 + (lane & 31)] = w; }
    LDS_WAIT(); asm volatile("" ::: "memory");
    const int c = lane & 7;
#pragma unroll
    for (int j = 0; j < 4; ++j) { const int n = (lane >> 3) + 8 * j; const LAS float* s = scr + (8 * c) * 33 + n;
        v4u o; o.x = pk2(s[0 * 33], s[1 * 33]); o.y = pk2(s[2 * 33], s[3 * 33]); o.z = pk2(s[4 * 33], s[5 * 33]); o.w = pk2(s[6 * 33], s[7 * 33]);
        if (n0 + n < N) *(GAS v4u*)(WT + (size_t)(n0 + n) * K + k0 + 8 * c) = o; }
    LDS_WAIT(); asm volatile("" ::: "memory");
}
struct Args;
template <class A> __device__ __forceinline__ void p0_prologue(Frame& F, const A& args) {
    const float* const* in_ = nullptr; (void)in_;
    LAS float* scr = (LAS float*)(F.lds + RING_OFF + F.wave * 16384);
    const int gw = F.vcu * NWAVES + F.wave, NGW = F.G * NWAVES;
    const int gt = F.vcu * (NWAVES * 64) + F.tid, NGT = F.G * NWAVES * 64;
    constexpr int I_IN = 16 * 97, I_OUT = 16 * 32, I_Q = 16 * 64, I_L = I_IN + I_OUT + I_Q;
    for (int it = gw; it < NLAYER * I_L; it += NGW) {
        const int l = it / I_L; int r = it % I_L;
        if (r < I_IN) { p0_transpose_item(args.in[3] + (size_t)l * DM * NIN, NIN, NIN, args.in[2] + l * DM, (bf16*)(F.ws + WS_WIN + l * WIN_STRIDE), DM, scr, r, F.lane); continue; } r -= I_IN;
        if (r < I_OUT) { p0_transpose_item(args.in[13] + (size_t)l * DM * DM, DM, DM, nullptr, (bf16*)(F.ws + WS_WOUT + l * WOUT_STRIDE), DM, scr, r, F.lane); continue; } r -= I_OUT;
        p0_transpose_item(args.in[15] + (size_t)l * DM * NQ, NQ, NQ, args.in[14] + l * DM, (bf16*)(F.ws + WS_WQ + l * WQ_STRIDE), DM, scr, r, F.lane);
    }
    for (int i = gt; i < NLAYER * 2 * 16384; i += NGT) { const int l = i >> 15, hf = (i >> 14) & 1, e = i & 16383;
        ((bf16*)(F.ws + WS_KEYS + l * KEYS_STRIDE))[hf * 16384 + e] = (bf16)f2bf((hf ? args.in[17] : args.in[16])[(size_t)l * 16384 + e]); }
    for (int row0 = gw; row0 < NLAYER * 2 * 16384; row0 += 4 * NGW) {
        f32x4 v[4][4]; float mx[4] = {0.f, 0.f, 0.f, 0.f};
#pragma unroll
        for (int u = 0; u < 4; ++u) { const int row = (row0 + u * NGW < NLAYER * 2 * 16384) ? row0 + u * NGW : row0; const int l = row >> 15, tab = (row >> 14) & 1, e = row & 16383;
            const f32x4* src = (const f32x4*)((tab ? args.in[19] : args.in[18]) + (size_t)l * 16777216 + (size_t)e * DM) + F.lane;
#pragma unroll
            for (int j = 0; j < 4; ++j) v[u][j] = __builtin_nontemporal_load(src + 64 * j); }
#pragma unroll
        for (int u = 0; u < 4; ++u) { const int row = row0 + u * NGW; const int l = row >> 15, tab = (row >> 14) & 1, e = row & 16383;
            if (row < NLAYER * 2 * 16384) {
#pragma unroll
            for (int j = 0; j < 4; ++j) { if (tab == 0) v[u][j] = v[u][j] * ((const f32x4*)(args.in[14] + l * DM))[F.lane + 64 * j];
                mx[u] = fmaxf(mx[u], fmaxf(fmaxf(fabsf(v[u][j][0]), fabsf(v[u][j][1])), fmaxf(fabsf(v[u][j][2]), fabsf(v[u][j][3])))); }
            float m_ = mx[u];
            m_ = fmaxf(m_, xl_swz<1>(m_)); m_ = fmaxf(m_, xl_swz<2>(m_)); m_ = fmaxf(m_, xl_swz<4>(m_)); m_ = fmaxf(m_, xl_swz<8>(m_)); m_ = fmaxf(m_, xl_swz<16>(m_));
            m_ = fmaxf(m_, __builtin_bit_cast(float, xl_xor32_i(__builtin_bit_cast(int, m_), F.lane >> 5)));
            unsigned* dst = (unsigned*)(F.ws + WS_TAB + l * TAB_STRIDE + (size_t)e * 2048 + (tab ? 1024 : 0)) + F.lane;
            if (tab) {
                int k = (int)floorf(log2f(224.0f / fmaxf(m_, 1e-30f))); k = k < -60 ? -60 : (k > 60 ? 60 : k);
                const float sc = ldexpf(1.0f, k);
#pragma unroll
                for (int j = 0; j < 4; ++j) { int p = __builtin_amdgcn_cvt_pk_fp8_f32(v[u][j][0] * sc, v[u][j][1] * sc, 0, false); p = __builtin_amdgcn_cvt_pk_fp8_f32(v[u][j][2] * sc, v[u][j][3] * sc, p, true); dst[64 * j] = (unsigned)p; }
                if (F.lane == 0) ((float*)(F.ws + WS_SV))[l * 16384 + e] = ldexpf(1.0f, -k);
            } else {
                const float sc = m_ > 0.f ? 127.0f / m_ : 0.f;
#pragma unroll
                for (int j = 0; j < 4; ++j) { const int q0 = (int)rintf(v[u][j][0] * sc), q1 = (int)rintf(v[u][j][1] * sc), q2 = (int)rintf(v[u][j][2] * sc), q3 = (int)rintf(v[u][j][3] * sc);
                    dst[64 * j] = (unsigned)(q0 & 255) | ((unsigned)(q1 & 255) << 8) | ((unsigned)(q2 & 255) << 16) | ((unsigned)(q3 & 255) << 24); }
                if (F.lane == 0) ((float*)(F.ws + WS_SU))[l * 16384 + e] = m_ * (1.0f / 127.0f);
            } } }
    }
    for (int m0 = gw; m0 < M; m0 += 4 * NGW) {
        f32x4 v[4][4];
#pragma unroll
        for (int u = 0; u < 4; ++u) { const int m = m0 + u * NGW; const f32x4* xr = (const f32x4*)(args.in[0] + (size_t)(m < M ? m : m0) * DM) + F.lane;
#pragma unroll
            for (int j = 0; j < 4; ++j) v[u][j] = __builtin_nontemporal_load(xr + 64 * j); }
#pragma unroll
        for (int u = 0; u < 4; ++u) { const int m = m0 + u * NGW; if (m < M) {
            unsigned long long* o8 = (unsigned long long*)((bf16*)(F.ws + WS_XB) + (size_t)m * DM) + F.lane; float s = 0.f;
#pragma unroll
            for (int j = 0; j < 4; ++j) { const f32x4 w = v[u][j]; s += (w[0] * w[0] + w[1] * w[1]) + (w[2] * w[2] + w[3] * w[3]);
                o8[64 * j] = (unsigned long long)pk2(w[0], w[1]) | ((unsigned long long)pk2(w[2], w[3]) << 32); }
            s = wave_sum(s);
            if (F.lane == 0) ((float*)(F.ws + WS_RS1))[m] = 1.0f / sqrtf(s * (1.0f / 1024.0f) + EPS); } }
    }
    for (int i = gt; i < M * 8; i += NGT) { const int m = i >> 3, j = i & 7; const double inv = pow(500000.0, -(double)j / 8.0); const double ang = (double)((const int*)args.in[1])[m] * inv;
        ((float*)(F.ws + WS_COS))[i] = (float)cos(ang); ((float*)(F.ws + WS_SIN))[i] = (float)sin(ang); }
    if (gt < NLAYER) { const int l = gt; float a = 0.f, b = 0.f;
        for (int i = 0; i < 64; ++i) { a += args.in[4][l * 64 + i] * args.in[5][l * 64 + i]; b += args.in[6][l * 64 + i] * args.in[7][l * 64 + i]; }
        const float lam_init = 0.8f - 0.6f * expf(-0.3f * (float)l);
        ((float*)(F.ws + WS_LAM))[l * 2] = expf(a) - expf(b) + lam_init; ((float*)(F.ws + WS_LAM))[l * 2 + 1] = 1.0f - lam_init; }
    { float* par = (float*)(F.ws + WS_PAR);
      for (int i = gt; i < PAR_N; i += NGT) { float v;
          if (i < PAR_CW) v = args.in[8][i]; else if (i < PAR_WG2) v = args.in[9][i - PAR_CW]; else if (i < PAR_BG) v = args.in[10][i - PAR_WG2]; else if (i < PAR_GN) v = args.in[11][i - PAR_BG];
          else if (i < PAR_NF) v = args.in[12][i - PAR_GN]; else v = args.in[20][i - PAR_NF];
          par[i] = v; } }
}

__device__ __forceinline__ float log_sigmoid(float x) { return fminf(x, 0.f) - __logf(1.0f + __expf(-fabsf(x))); }
template <int K> __device__ __forceinline__ void lds_mm_2x4(float (&acc)[2][4], const LAS float* X, int ldx, const LAS float* Y, int ldy) {
#pragma unroll 4
    for (int k = 0; k < K; k += 4) {
        const f32x4 x0 = *(const LAS f32x4*)(X + k), x1 = *(const LAS f32x4*)(X + ldx + k);
#pragma unroll
        for (int kk = 0; kk < 4; ++kk) { const f32x4 y = *(const LAS f32x4*)(Y + (k + kk) * ldy);
#pragma unroll
            for (int b = 0; b < 4; ++b) { acc[0][b] += x0[kk] * y[b]; acc[1][b] += x1[kk] * y[b]; } }
    }
}
typedef float f32x16g __attribute__((ext_vector_type(16)));
__device__ __forceinline__ int gla_crow(int r, int hh) { return (r & 3) + 8 * (r >> 2) + 4 * hh; }
__device__ __forceinline__ void gla_stage_vt(LAS bf16* VT, const bf16* PROJ, int t0, int tid) {
#pragma unroll
    for (int it = tid; it < 2048; it += 512) { const int eg = it >> 6, t = it & 63; const v4u w = *(const v4u*)(PROJ + (size_t)(t0 + t) * NPROJ + C_GV + eg * 8);
        LAS bf16* p = VT + (eg * 8) * 72 + t;
        p[0] = (bf16)(w.x & 0xffffu); p[72] = (bf16)(w.x >> 16); p[144] = (bf16)(w.y & 0xffffu); p[216] = (bf16)(w.y >> 16);
        p[288] = (bf16)(w.z & 0xffffu); p[360] = (bf16)(w.z >> 16); p[432] = (bf16)(w.w & 0xffffu); p[504] = (bf16)(w.w >> 16); }
}
__device__ __forceinline__ void gla_prep(Frame& F, int l, int ci, int stop_after = 0) {
    typedef float f32x4m __attribute__((ext_vector_type(4)));
    LAS float* LR = (LAS float*)(F.lds + RING_OFF);
    LAS bf16* KHT = (LAS bf16*)(LR + 2 * 64 * 17);
    LAS bf16* VT = KHT + 128 * 72;
    LAS float* W2s = (LAS float*)(VT + 256 * 72);
    const int t0 = ci * 64, tid = F.tid, lane = F.lane, wave = F.wave, r32 = lane & 31, hh = lane >> 5;
    const bf16* XB = (const bf16*)(F.ws + WS_XB); const bf16* PROJ = (const bf16*)(F.ws + WS_PROJ);
    const bf16* Wlr = (const bf16*)(F.ws + WS_WIN + l * WIN_STRIDE) + (size_t)NPROJ * DM;
    v4u kw0, kw1; float rs;
    {
        const int mt = wave & 3, kh = wave >> 2, fr = lane & 15, fq = lane >> 4;
        f32x4m acc = (f32x4m){0.f, 0.f, 0.f, 0.f};
        const bf16* ap = XB + (size_t)(t0 + mt * 16 + fr) * DM + kh * 512 + fq * 8; const bf16* bp = Wlr + (size_t)fr * DM + kh * 512 + fq * 8;
        bf16x8 av[16], bv[16];
#pragma unroll
        for (int ks = 0; ks < 16; ++ks) { av[ks] = *(const bf16x8*)(ap + ks * 32); bv[ks] = *(const bf16x8*)(bp + ks * 32); }
        gla_stage_vt(VT, PROJ, t0, tid);
        { const float* W2g = (const float*)(F.ws + WS_PAR) + PAR_WG2 + l * 16 * 128; const float* bgg = (const float*)(F.ws + WS_PAR) + PAR_BG + l * 128;
#pragma unroll
          for (int q = 0; q < 4; ++q) W2s[tid + 512 * q] = W2g[tid + 512 * q];
          if (tid < 128) W2s[2048 + tid] = bgg[tid]; }
        { const bf16* kp = PROJ + (size_t)(t0 + lane) * NPROJ + C_GK + 16 * wave; kw0 = *(const v4u*)kp; kw1 = *(const v4u*)(kp + 8); rs = ((const float*)(F.ws + WS_RS1))[t0 + lane]; }
#pragma unroll
        for (int ks = 0; ks < 16; ++ks) acc = __builtin_amdgcn_mfma_f32_16x16x32_bf16(av[ks], bv[ks], acc, 0, 0, 0);
#pragma unroll
        for (int i = 0; i < 4; ++i) LR[kh * (64 * 17) + (mt * 16 + fq * 4 + i) * 17 + fr] = acc[i];
    }
    __syncthreads();
    if (stop_after == 1) return;
    {
        const int d0 = 16 * wave, t = lane;
        float lr[16];
#pragma unroll
        for (int r = 0; r < 16; ++r) lr[r] = (LR[t * 17 + r] + LR[64 * 17 + t * 17 + r]) * rs;
        const LAS float* W2 = W2s + d0; const LAS float* bg = W2s + 2048 + d0;
        float bb[16];
#pragma unroll
        for (int dd = 0; dd < 16; ++dd) { float x = bg[dd];
#pragma unroll
            for (int r = 0; r < 16; ++r) x += lr[r] * W2[r * 128 + dd];
            bb[dd] = log_sigmoid(x) * (1.0f / 16.0f); }
#pragma unroll
        for (int off = 1; off < 64; off <<= 1) { const int src = ((lane - off) & 63) << 2;
#pragma unroll
            for (int dd = 0; dd < 16; ++dd) { const float o = __builtin_bit_cast(float, __builtin_amdgcn_ds_bpermute(src, __builtin_bit_cast(int, bb[dd]))); bb[dd] += (lane >= off) ? o : 0.f; } }
        float* GB = (float*)(F.ws + WS_GB) + (size_t)(t0 + t) * 128 + d0;
#pragma unroll
        for (int q = 0; q < 4; ++q) *(f32x4*)(GB + 4 * q) = (f32x4){bb[4 * q], bb[4 * q + 1], bb[4 * q + 2], bb[4 * q + 3]};
        const unsigned kw[8] = {kw0.x, kw0.y, kw0.z, kw0.w, kw1.x, kw1.y, kw1.z, kw1.w};
        float dc[16];
#pragma unroll
        for (int dd = 0; dd < 16; ++dd) { const float bl = __builtin_bit_cast(float, __builtin_amdgcn_readlane(__builtin_bit_cast(int, bb[dd]), 63)); dc[dd] = expf(bl);
            const float kv = (dd & 1) ? bfhi(kw[dd >> 1]) : bflo(kw[dd >> 1]); KHT[(d0 + dd) * 72 + t] = (bf16)f2bf(kv * expf(bl - bb[dd])); }
        if (lane == 0) { float* GD = (float*)(F.ws + WS_GD) + ci * 128 + d0;
#pragma unroll
            for (int q = 0; q < 4; ++q) *(f32x4*)(GD + 4 * q) = (f32x4){dc[4 * q], dc[4 * q + 1], dc[4 * q + 2], dc[4 * q + 3]}; }
    }
    __syncthreads();
    if (stop_after == 2) return;
    {
        const int h = wave >> 1, eb = wave & 1; f32x16g U = {};
#pragma unroll
        for (int ks = 0; ks < 4; ++ks) { const bf16x8 ka = *(const LAS bf16x8*)(KHT + (h * 32 + r32) * 72 + ks * 16 + 8 * hh); const bf16x8 vb = *(const LAS bf16x8*)(VT + (h * 64 + eb * 32 + r32) * 72 + ks * 16 + 8 * hh);
            U = __builtin_amdgcn_mfma_f32_32x32x16_bf16(ka, vb, U, 0, 0, 0); }
        float* GU = (float*)(F.ws + WS_GU) + (size_t)(ci * 4 + h) * 2048 + eb * 32 + r32;
#pragma unroll
        for (int r = 0; r < 16; ++r) GU[gla_crow(r, hh) * 64] = U[r];
    }
    __syncthreads();
}
__device__ __forceinline__ void gla_scan(Frame& F) {
    if (F.tid < 128) { const int gid = F.vcu * 128 + F.tid;
        if (gid < 32768) { const int b = gid >> 13, h = (gid >> 11) & 3, d = (gid >> 6) & 31, e = gid & 63; float s = 0.f;
            float* GU = (float*)(F.ws + WS_GU); const float* GD = (const float*)(F.ws + WS_GD);
            for (int c0 = 0; c0 < 64; c0 += 16) { float u[16], dc[16];
#pragma unroll
                for (int i = 0; i < 16; ++i) { const int ci = b * 64 + c0 + i; u[i] = GU[((size_t)(ci * 4 + h) * 32 + d) * 64 + e]; dc[i] = GD[ci * 128 + h * 32 + d]; }
#pragma unroll
                for (int i = 0; i < 16; ++i) { const int ci = b * 64 + c0 + i; GU[((size_t)(ci * 4 + h) * 32 + d) * 64 + e] = s; s = dc[i] * s + u[i]; } } } }
}
__device__ __forceinline__ void mix_chunk(Frame& F, int l, int ci) {
    LAS bf16* QB = (LAS bf16*)(F.lds + RING_OFF);
    LAS bf16* KB = QB + 64 * 136;
    LAS bf16* VT = KB + 64 * 136;
    LAS bf16* ST = VT + 256 * 72;
    const int t0 = ci * 64, tid = F.tid, lane = F.lane, wave = F.wave, r32 = lane & 31, hh = lane >> 5;
    const bf16* PROJ = (const bf16*)(F.ws + WS_PROJ); bf16* MIXED = (bf16*)(F.ws + WS_MIXED);
    const float* GB = (const float*)(F.ws + WS_GB) + (size_t)t0 * 128;
    const int h = wave >> 1, ib = wave & 1, i0 = 32 * ib;
#pragma unroll
    for (int it = tid; it < 1024; it += 512) { const int t = it >> 4, d0 = (it & 15) * 8;
        const f32x4 b0 = *(const f32x4*)(GB + t * 128 + d0), b1 = *(const f32x4*)(GB + t * 128 + d0 + 4);
        const bf16* pr = PROJ + (size_t)(t0 + t) * NPROJ; const v4u qw = *(const v4u*)(pr + C_GQ + d0), kw = *(const v4u*)(pr + C_GK + d0);
        const float bv[8] = {b0[0], b0[1], b0[2], b0[3], b1[0], b1[1], b1[2], b1[3]}; const unsigned qa[4] = {qw.x, qw.y, qw.z, qw.w}, ka[4] = {kw.x, kw.y, kw.z, kw.w};
        unsigned qo[4], ko[4];
#pragma unroll
        for (int p = 0; p < 4; ++p) { const float e0 = expf(bv[2 * p]), e1 = expf(bv[2 * p + 1]), n0 = expf(-bv[2 * p]), n1 = expf(-bv[2 * p + 1]);
            qo[p] = pk2(bflo(qa[p]) * 0.17677669529663687f * e0, bfhi(qa[p]) * 0.17677669529663687f * e1); ko[p] = pk2(bflo(ka[p]) * n0, bfhi(ka[p]) * n1); }
        *(LAS v4u*)(QB + t * 136 + d0) = (v4u){qo[0], qo[1], qo[2], qo[3]}; *(LAS v4u*)(KB + t * 136 + d0) = (v4u){ko[0], ko[1], ko[2], ko[3]}; }
    gla_stage_vt(VT, PROJ, t0, tid);
    { const float* GU = (const float*)(F.ws + WS_GU) + (size_t)ci * 8192;
      float sv[16];
#pragma unroll
      for (int q = 0; q < 16; ++q) sv[q] = GU[tid + 512 * q];
#pragma unroll
      for (int q = 0; q < 16; ++q) { const int it = tid + 512 * q, hd = it >> 6, e = it & 63; ST[((hd >> 5) * 64 + e) * 40 + (hd & 31)] = (bf16)f2bf(sv[q]); } }
    const size_t row = (size_t)(t0 + i0 + r32); unsigned long long rg[8];
#pragma unroll
    for (int q = 0; q < 8; ++q) rg[q] = *(const unsigned long long*)(PROJ + row * NPROJ + C_GR + h * 64 + 32 * (q >> 2) + 8 * (q & 3) + 4 * hh);
    __syncthreads();
    {
        bf16x8 qf[2];
#pragma unroll
        for (int ks = 0; ks < 2; ++ks) qf[ks] = *(const LAS bf16x8*)(QB + (i0 + r32) * 136 + h * 32 + ks * 16 + 8 * hh);
        f32x16g OT[2] = {{}, {}};
#pragma unroll
        for (int eb = 0; eb < 2; ++eb)
#pragma unroll
            for (int ks = 0; ks < 2; ++ks) { const bf16x8 sa = *(const LAS bf16x8*)(ST + (h * 64 + eb * 32 + r32) * 40 + ks * 16 + 8 * hh); OT[eb] = __builtin_amdgcn_mfma_f32_32x32x16_bf16(sa, qf[ks], OT[eb], 0, 0, 0); }
#pragma unroll
        for (int jb = 0; jb < 2; ++jb) if (jb <= ib) {
            f32x16g X = {};
#pragma unroll
            for (int ks = 0; ks < 2; ++ks) { const bf16x8 ka = *(const LAS bf16x8*)(KB + (32 * jb + r32) * 136 + h * 32 + ks * 16 + 8 * hh); X = __builtin_amdgcn_mfma_f32_32x32x16_bf16(ka, qf[ks], X, 0, 0, 0); }
            if (jb == ib) {
#pragma unroll
                for (int r = 0; r < 16; ++r) if (gla_crow(r, hh) > r32) X[r] = 0.f;
            }
#pragma unroll
            for (int s = 0; s < 2; ++s) { v4u xw; xw.x = pk2(X[8 * s], X[8 * s + 1]); xw.y = pk2(X[8 * s + 2], X[8 * s + 3]); xw.z = pk2(X[8 * s + 4], X[8 * s + 5]); xw.w = pk2(X[8 * s + 6], X[8 * s + 7]);
                const bf16x8 xb = __builtin_bit_cast(bf16x8, xw);
#pragma unroll
                for (int eb = 0; eb < 2; ++eb) { const LAS bf16* vp = VT + (h * 64 + eb * 32 + r32) * 72 + 32 * jb + 16 * s + 4 * hh;
                    const unsigned long long lo = *(const LAS unsigned long long*)vp, hi = *(const LAS unsigned long long*)(vp + 8);
                    const v4u vw = (v4u){(unsigned)lo, (unsigned)(lo >> 32), (unsigned)hi, (unsigned)(hi >> 32)};
                    OT[eb] = __builtin_amdgcn_mfma_f32_32x32x16_bf16(__builtin_bit_cast(bf16x8, vw), xb, OT[eb], 0, 0, 0); } }
        }
        float ss = 0.f;
#pragma unroll
        for (int eb = 0; eb < 2; ++eb)
#pragma unroll
            for (int r = 0; r < 16; ++r) ss += OT[eb][r] * OT[eb][r];
        ss = xl_sum32(ss);
        const float rs = 1.0f / sqrtf(ss * (1.0f / 64.0f) + EPS); const float* gn = (const float*)(F.ws + WS_PAR) + PAR_GN + l * 64;
#pragma unroll
        for (int q = 0; q < 8; ++q) { const int eb = q >> 2, g = q & 3, e0 = 32 * eb + 8 * g + 4 * hh; const f32x4 g4 = *(const f32x4*)(gn + e0);
            const unsigned r0 = (unsigned)rg[q], r1 = (unsigned)(rg[q] >> 32); const float rr[4] = {bflo(r0), bfhi(r0), bflo(r1), bfhi(r1)}; float y[4];
#pragma unroll
            for (int k = 0; k < 4; ++k) { const float sl = rr[k] / (1.0f + expf(-rr[k])); y[k] = OT[eb][4 * g + k] * rs * g4[k] * sl; }
            *(unsigned long long*)(MIXED + row * DM + 768 + h * 64 + e0) = (unsigned long long)pk2(y[0], y[1]) | ((unsigned long long)pk2(y[2], y[3]) << 32); }
    }
    const float lam = ((const float*)(F.ws + WS_LAM))[l * 2], oscale = ((const float*)(F.ws + WS_LAM))[l * 2 + 1];
    const bf16* OATT = (const bf16*)(F.ws + WS_OATT); const float* dn = (const float*)(F.ws + WS_PAR) + PAR_DN + l * 128; const float* cw = (const float*)(F.ws + WS_PAR) + PAR_CW + l * 3 * 256;
    const float dn0 = dn[2 * lane], dn1 = dn[2 * lane + 1]; const int ch = 4 * lane;
    f32x4 wj[3];
#pragma unroll
    for (int j = 0; j < 3; ++j) wj[j] = *(const f32x4*)(cw + j * 256 + ch);
#pragma unroll 1
    for (int r0 = 0; r0 < 8; r0 += 4) {
        unsigned w1[4][4], w2[4][4]; unsigned long long cwd[6], hwd[6], bwd[4];
        const int tb = t0 + wave * 8 + r0;
#pragma unroll
        for (int u = 0; u < 4; ++u)
#pragma unroll
            for (int hq = 0; hq < 4; ++hq) { w1[u][hq] = *(const unsigned*)(OATT + (size_t)(tb + u) * DM + hq * 128 + 2 * lane); w2[u][hq] = *(const unsigned*)(OATT + (size_t)(tb + u) * DM + 512 + hq * 128 + 2 * lane); }
#pragma unroll
        for (int u = 0; u < 6; ++u) { const int tr = tb - 2 + u; const bool ok = ((tb & (SEQL - 1)) - 2 + u) >= 0;
            const bf16* pr = PROJ + (size_t)(ok ? tr : tb) * NPROJ; cwd[u] = ok ? *(const unsigned long long*)(pr + C_SC + ch) : 0ull; hwd[u] = ok ? *(const unsigned long long*)(pr + C_SH + ch) : 0ull; }
#pragma unroll
        for (int u = 0; u < 4; ++u) bwd[u] = *(const unsigned long long*)(PROJ + (size_t)(tb + u) * NPROJ + C_SB + ch);
        f32x4 z[6];
#pragma unroll
        for (int u = 0; u < 6; ++u) { const unsigned c0 = (unsigned)cwd[u], c1 = (unsigned)(cwd[u] >> 32), h0 = (unsigned)hwd[u], h1 = (unsigned)(hwd[u] >> 32); z[u] = (f32x4){bflo(c0) * bflo(h0), bfhi(c0) * bfhi(h0), bflo(c1) * bflo(h1), bfhi(c1) * bfhi(h1)}; }
#pragma unroll
        for (int u = 0; u < 4; ++u) { const int t = tb + u;
#pragma unroll
            for (int hq = 0; hq < 4; ++hq) { const float o0 = bflo(w1[u][hq]) - lam * bflo(w2[u][hq]), o1 = bfhi(w1[u][hq]) - lam * bfhi(w2[u][hq]); const float ssq = wave_sum(o0 * o0 + o1 * o1);
                const float rsq = oscale / sqrtf(ssq * (1.0f / 128.0f) + EPS);
                *(unsigned*)(MIXED + (size_t)t * DM + hq * 128 + 2 * lane) = pk2(o0 * rsq * dn0, o1 * rsq * dn1); }
            const f32x4 y = wj[0] * z[u] + wj[1] * z[u + 1] + wj[2] * z[u + 2];
            const unsigned b0 = (unsigned)bwd[u], b1 = (unsigned)(bwd[u] >> 32);
            *(unsigned long long*)(MIXED + (size_t)t * DM + 512 + ch) = (unsigned long long)pk2(bflo(b0) * y[0], bfhi(b0) * y[1]) | ((unsigned long long)pk2(bflo(b1) * y[2], bfhi(b1) * y[3]) << 32); }
    }
    __syncthreads();
}

#define TK_HD __device__ __forceinline__
#ifndef TK_HD
#define TK_HD __device__ __forceinline__
#endif
TK_HD int tk_max(int a, int b) { return a > b ? a : b; }
TK_HD int tk_min(int a, int b) { return a < b ? a : b; }
TK_HD int tk_f2key(float f) { int b = __builtin_bit_cast(int, f); return b ^ ((b >> 31) & 0x7fffffff); }
TK_HD float tk_key2f(int k) { return __builtin_bit_cast(float, k ^ ((k >> 31) & 0x7fffffff)); }
template <int N> TK_HD void tk_sort_desc(int (&a)[N]) {
#pragma unroll
    for (int k = 2; k <= N; k <<= 1)
#pragma unroll
        for (int j = k >> 1; j > 0; j >>= 1)
#pragma unroll
            for (int i = 0; i < N; ++i) { const int l = i ^ j; if (l > i) { const int hi = tk_max(a[i], a[l]), lo = tk_min(a[i], a[l]); if ((i & k) == 0) { a[i] = hi; a[l] = lo; } else { a[i] = lo; a[l] = hi; } } }
}
template <int N> TK_HD void tk_merge_desc(int (&a)[N]) {
#pragma unroll
    for (int j = N >> 1; j > 0; j >>= 1)
#pragma unroll
        for (int i = 0; i < N; ++i) { const int l = i ^ j; if (l > i) { const int hi = tk_max(a[i], a[l]), lo = tk_min(a[i], a[l]); a[i] = hi; a[l] = lo; } }
}
TK_HD void tk_top16_merge(int (&a)[16], const int (&b)[16]) {
#pragma unroll
    for (int i = 0; i < 16; ++i) a[i] = tk_max(a[i], b[15 - i]);
    tk_merge_desc<16>(a);
}
TK_HD constexpr int tk_cand_i(int set, int s) {
    if (set == 0) return s < 16 ? 0 : (s < 24 ? 1 : (s == 24 ? 8 : -1));
    return s < 5 ? 2 : s < 9 ? 3 : s < 12 ? 4 : s < 14 ? 5 : s < 16 ? 6 : s < 18 ? 7 : s < 25 ? (9 + (s - 18)) : -1;
}
TK_HD constexpr int tk_cand_j(int set, int s) {
    if (set == 0) return s < 16 ? s : (s < 24 ? s - 16 : (s == 24 ? 0 : -1));
    return s < 5 ? s : s < 9 ? s - 5 : s < 12 ? s - 9 : s < 14 ? s - 12 : s < 16 ? s - 14 : s < 18 ? s - 16 : s < 25 ? 0 : -1;
}

constexpr int PS_KSTRIDE = 136;
__device__ __forceinline__ void peer_select_task(Frame& F, int l, int t0, int h, LAS int* scr  , const LAS bf16* KL  ) {
    typedef float f32x16 __attribute__((ext_vector_type(16)));
    const int lane = F.lane, r32 = lane & 31, hi = lane >> 5;
    const bf16* QP = (const bf16*)(F.ws + WS_QP);
    int lists[2][16];
    bf16x8 qall[2][8];
#pragma unroll
    for (int half = 0; half < 2; ++half) { const bf16* qp = QP + (size_t)(t0 + r32) * NQ + h * 256 + half * 128 + hi * 8;
#pragma unroll
        for (int ks = 0; ks < 8; ++ks) qall[half][ks] = *(const bf16x8*)(qp + ks * 16); }
#pragma unroll
    for (int half = 0; half < 2; ++half) {
        const bf16x8 (&qf)[8] = qall[half];
        int cur[16];
#pragma unroll
        for (int kb = 0; kb < 4; ++kb) {
            f32x16 c = {};
            const LAS bf16* kp = KL + (half * 128 + kb * 32 + r32) * PS_KSTRIDE + hi * 8;
#pragma unroll
            for (int ks = 0; ks < 8; ++ks) { const bf16x8 kf = *(const LAS bf16x8*)(kp + ks * 16); c = __builtin_amdgcn_mfma_f32_32x32x16_bf16(kf, qf[ks], c, 0, 0, 0); }
            int g[16];
#pragma unroll
            for (int r = 0; r < 16; ++r) { const int key = kb * 32 + (r & 3) + 8 * (r >> 2) + 4 * hi; g[r] = (tk_f2key(c[r]) & ~127) | (127 - key); }
            tk_sort_desc<16>(g);
            if (kb == 0) {
#pragma unroll
                for (int r = 0; r < 16; ++r) cur[r] = g[r];
            } else tk_top16_merge(cur, g);
        }
        int oth[16];
#pragma unroll
        for (int r = 0; r < 16; ++r) oth[r] = xl_xor32_i(cur[r], hi);
        tk_top16_merge(cur, oth);
#pragma unroll
        for (int r = 0; r < 16; ++r) lists[half][r] = cur[r];
    }
#pragma unroll
    for (int r = 0; r < 16; ++r) scr[r32 * 32 + hi * 16 + r] = 127 - ((hi ? lists[1][r] : lists[0][r]) & 127);
    float v1[16], v2[16];
#pragma unroll
    for (int r = 0; r < 16; ++r) { v1[r] = tk_key2f(lists[0][r]); v2[r] = tk_key2f(lists[1][r]); }
    int c[32];
#pragma unroll
    for (int s = 0; s < 32; ++s) {
        constexpr int NEG = (int)0x80000000;
        const int ia = tk_cand_i(0, s), ja = tk_cand_j(0, s), ib = tk_cand_i(1, s), jb = tk_cand_j(1, s);
        if (ia < 0) c[s] = NEG;
        else { const int ka = (tk_f2key(v1[ia] + v2[ja]) & ~255) | (255 - (ia * 16 + ja)), kb2 = (tk_f2key(v1[ib] + v2[jb]) & ~255) | (255 - (ib * 16 + jb)); c[s] = hi ? kb2 : ka; }
    }
    tk_sort_desc<32>(c);
    int fin[16], oth[16];
#pragma unroll
    for (int r = 0; r < 16; ++r) { fin[r] = c[r]; oth[r] = xl_xor32_i(c[r], hi); }
    tk_top16_merge(fin, oth);
    float p[16]; float sum = 0.f; const float mx = tk_key2f(fin[0]);
#pragma unroll
    for (int r = 0; r < 16; ++r) { p[r] = expf(tk_key2f(fin[r]) - mx); sum += p[r]; }
    const float inv = 1.0f / sum;
    asm volatile("s_waitcnt lgkmcnt(0)" ::: "memory");
    int* EX = (int*)(F.ws + WS_EXP) + (size_t)(t0 + r32) * 128 + h * 16; float* GT = (float*)(F.ws + WS_GATE) + (size_t)(t0 + r32) * 128 + h * 16;
#pragma unroll
    for (int r = 0; r < 16; ++r) { const int code = 255 - (fin[r] & 255); const int e1 = scr[r32 * 32 + (code >> 4)], e2 = scr[r32 * 32 + 16 + (code & 15)];
        if ((r >> 3) == hi) { EX[r] = e1 * 128 + e2; GT[r] = p[r] * inv; } }
    asm volatile("s_waitcnt lgkmcnt(0)" ::: "memory");
}

__device__ __forceinline__ float gelu_erf(float v) {
    const float av = fabsf(v), t = __builtin_amdgcn_rcpf(av * 0.2316418882f + 1.0f);
    float q = t * 0.5307027145f + (-0.7265760135f); q = q * t + 0.7107068705f; q = q * t + (-0.142248368f); q = q * t + 0.127414796f; q = q * t;
    const float e = __builtin_amdgcn_exp2f((v * v) * (-0.72134752044f)); const float m_ = v * (q * e);
    return v < 0.f ? m_ : v - m_;
}
typedef __bf16 bf16x2_t __attribute__((ext_vector_type(2)));
__device__ __forceinline__ float dot2bf(unsigned a, unsigned b, float c) { return __builtin_amdgcn_fdot2_f32_bf16(__builtin_bit_cast(bf16x2_t, a), __builtin_bit_cast(bf16x2_t, b), c, false); }
template <int J> __device__ __forceinline__ int xl_xchg_i(int v, int hi) { if constexpr (J == 32) return xl_xor32_i(v, hi); else return xl_swz_i<J>(v); }
template <int K, int J> __device__ __forceinline__ void sort128_step(int& ka, int& kb, int lane) {
    if constexpr (J == 64) { const int lo = ka < kb ? ka : kb, hi = ka < kb ? kb : ka; ka = lo; kb = hi; }
    else { const int oa = xl_xchg_i<J>(ka, lane >> 5), ob = xl_xchg_i<J>(kb, lane >> 5); const bool lower = (lane & J) == 0;
        const bool upa = (K >= 64) ? true : ((lane & K) == 0), upb = (K >= 128) ? true : (K == 64 ? false : ((lane & K) == 0));
        const int mina = ka < oa ? ka : oa, maxa = ka < oa ? oa : ka, minb = kb < ob ? kb : ob, maxb = kb < ob ? ob : kb;
        ka = (upa == lower) ? mina : maxa; kb = (upb == lower) ? minb : maxb; }
}
__device__ __forceinline__ void sort128(int& ka, int& kb, int lane) {
#define S_(K, J) sort128_step<K, J>(ka, kb, lane);
    S_(2, 1) S_(4, 2) S_(4, 1) S_(8, 4) S_(8, 2) S_(8, 1) S_(16, 8) S_(16, 4) S_(16, 2) S_(16, 1) S_(32, 16) S_(32, 8) S_(32, 4) S_(32, 2) S_(32, 1)
    S_(64, 32) S_(64, 16) S_(64, 8) S_(64, 4) S_(64, 2) S_(64, 1) S_(128, 64) S_(128, 32) S_(128, 16) S_(128, 8) S_(128, 4) S_(128, 2) S_(128, 1)
#undef S_
}
typedef float f32x2g __attribute__((ext_vector_type(2)));
#define PT_WGSYNC 1
#ifndef PT_SYNC_EVERY
#define PT_SYNC_EVERY 4
#endif
#ifndef PT_FIXED_ORDER
#define PT_GREEDY 1
#endif
#ifndef PT_CH
#define PT_CH 8
#endif
constexpr int PT_T = 4;
constexpr int PT_TOK_INTS = 128 + 128 + 64 + 256 + 4 + 128;
constexpr int PT_WAVE_INTS = PT_T * PT_TOK_INTS;
__device__ __forceinline__ float pt_dot8(const v4u w, const f32x2g (&xv)[8]) {
    f32x2g a = (f32x2g){0.f, 0.f};
    a = __builtin_elementwise_fma(__builtin_amdgcn_cvt_pk_f32_fp8(w.x, false), xv[0], a); a = __builtin_elementwise_fma(__builtin_amdgcn_cvt_pk_f32_fp8(w.x, true), xv[1], a);
    a = __builtin_elementwise_fma(__builtin_amdgcn_cvt_pk_f32_fp8(w.y, false), xv[2], a); a = __builtin_elementwise_fma(__builtin_amdgcn_cvt_pk_f32_fp8(w.y, true), xv[3], a);
    a = __builtin_elementwise_fma(__builtin_amdgcn_cvt_pk_f32_fp8(w.z, false), xv[4], a); a = __builtin_elementwise_fma(__builtin_amdgcn_cvt_pk_f32_fp8(w.z, true), xv[5], a);
    a = __builtin_elementwise_fma(__builtin_amdgcn_cvt_pk_f32_fp8(w.w, false), xv[6], a); a = __builtin_elementwise_fma(__builtin_amdgcn_cvt_pk_f32_fp8(w.w, true), xv[7], a);
    return a.x + a.y;
}
__device__ __forceinline__ void pt_axpy8(const v4u w, const float c, f32x2g (&o)[8]) {
    const f32x2g cc = (f32x2g){c, c};
    o[0] = __builtin_elementwise_fma(__builtin_amdgcn_cvt_pk_f32_fp8(w.x, false), cc, o[0]); o[1] = __builtin_elementwise_fma(__builtin_amdgcn_cvt_pk_f32_fp8(w.x, true), cc, o[1]);
    o[2] = __builtin_elementwise_fma(__builtin_amdgcn_cvt_pk_f32_fp8(w.y, false), cc, o[2]); o[3] = __builtin_elementwise_fma(__builtin_amdgcn_cvt_pk_f32_fp8(w.y, true), cc, o[3]);
    o[4] = __builtin_elementwise_fma(__builtin_amdgcn_cvt_pk_f32_fp8(w.z, false), cc, o[4]); o[5] = __builtin_elementwise_fma(__builtin_amdgcn_cvt_pk_f32_fp8(w.z, true), cc, o[5]);
    o[6] = __builtin_elementwise_fma(__builtin_amdgcn_cvt_pk_f32_fp8(w.w, false), cc, o[6]); o[7] = __builtin_elementwise_fma(__builtin_amdgcn_cvt_pk_f32_fp8(w.w, true), cc, o[7]);
}
__device__ __forceinline__ int xl_sum32_i(int v) { unsigned a = (unsigned)v, b = a; asm volatile("" : "+v"(b)); auto r = __builtin_amdgcn_permlane32_swap(a, b, false, false); const unsigned r0 = r[0], r1 = r[1]; return (int)(r0 + r1); }
__device__ __forceinline__ void pt_chunk(const LAS int* se, const LAS float* sg, int base, const v4u xq, f32x2g (&out)[8], float hscale,
                                         const unsigned char* Ub, const unsigned char* Vb, const float* SU, const float* SV, int lane) {
    const int e_l = se[base + (lane & (PT_CH - 1))]; const float g_l = sg[base + (lane & (PT_CH - 1))], hu_l = sg[452 + base + (lane & (PT_CH - 1))];
    v4u uw[PT_CH], vw[PT_CH]; const int l16 = 16 * lane; int es[PT_CH];
    const __amdgpu_buffer_rsrc_t rs = __builtin_amdgcn_make_buffer_rsrc((void*)Ub, 0, 32 << 20, 0x00020000);
#pragma unroll
    for (int s = 0; s < PT_CH; ++s) { es[s] = __builtin_amdgcn_readlane(e_l, s) * 2048; uw[s] = __builtin_bit_cast(v4u, __builtin_amdgcn_raw_buffer_load_b128(rs, l16, es[s], 0)); }
#pragma unroll
    for (int s = 0; s < PT_CH; ++s) vw[s] = __builtin_bit_cast(v4u, __builtin_amdgcn_raw_buffer_load_b128(rs, l16 + 1024, es[s], 0));
    int p[PT_CH];
#pragma unroll
    for (int s = 0; s < PT_CH; ++s) { int a = __builtin_amdgcn_sdot4((int)uw[s].x, (int)xq.x, 0, false); a = __builtin_amdgcn_sdot4((int)uw[s].y, (int)xq.y, a, false);
        a = __builtin_amdgcn_sdot4((int)uw[s].z, (int)xq.z, a, false); p[s] = __builtin_amdgcn_sdot4((int)uw[s].w, (int)xq.w, a, false); }
#define PT_BFLY(S) _Pragma("unroll") for (int i = 0; i < S; ++i) { const bool up = (lane & S) != 0; const int keep = up ? p[i + S] : p[i], send = up ? p[i] : p[i + S]; p[i] = keep + xl_swz_i<S>(send); }
#if PT_CH == 16
    PT_BFLY(8)
#endif
    PT_BFLY(4) PT_BFLY(2) PT_BFLY(1)
#undef PT_BFLY
    int hi_ = p[0];
#if PT_CH == 8
    hi_ += xl_swz_i<8>(hi_);
#endif
    hi_ += xl_swz_i<16>(hi_); hi_ = xl_sum32_i(hi_);
    const float c_l = g_l * gelu_erf((float)hi_ * hu_l);
#pragma unroll
    for (int s = 0; s < PT_CH; ++s) { const float c = __builtin_bit_cast(float, __builtin_amdgcn_readlane(__builtin_bit_cast(int, c_l), s)); pt_axpy8(vw[s], c, out); }
}
__device__ __forceinline__ void pt_sort_regs(LAS int* se, LAS float* sg, LAS int* cnt, LAS float* sh, int ea, int eb, float ga, float gb, float ha, float hb, int lane) {
    cnt[lane] = 0;
    asm volatile("s_waitcnt lgkmcnt(0)" ::: "memory");
    __hip_atomic_fetch_add(cnt + (ea >> 8), 1, __ATOMIC_RELAXED, __HIP_MEMORY_SCOPE_WAVEFRONT); __hip_atomic_fetch_add(cnt + (eb >> 8), 1, __ATOMIC_RELAXED, __HIP_MEMORY_SCOPE_WAVEFRONT);
    asm volatile("s_waitcnt lgkmcnt(0)" ::: "memory");
    const int c = cnt[lane]; int incl = c;
    int ln = lane; asm volatile("" : "+v"(ln));
#pragma unroll
    for (int off = 1; off < 64; off <<= 1) { const int o = __builtin_amdgcn_ds_bpermute(((ln - off) & 63) << 2, incl); incl += (ln >= off) ? o : 0; }
    asm volatile("s_waitcnt lgkmcnt(0)" ::: "memory");
    cnt[lane] = incl - c;
    asm volatile("s_waitcnt lgkmcnt(0)" ::: "memory");
    const int pa = __hip_atomic_fetch_add(cnt + (ea >> 8), 1, __ATOMIC_RELAXED, __HIP_MEMORY_SCOPE_WAVEFRONT);
    const int pb = __hip_atomic_fetch_add(cnt + (eb >> 8), 1, __ATOMIC_RELAXED, __HIP_MEMORY_SCOPE_WAVEFRONT);
    se[pa] = ea; sg[pa] = ga; sh[pa] = ha; se[pb] = eb; sg[pb] = gb; sh[pb] = hb;
    asm volatile("s_waitcnt lgkmcnt(0)" ::: "memory");
}
__device__ __forceinline__ void pt_sort(LAS int* se, LAS float* sg, LAS int* cnt, const int* EX, const float* GT, int lane, bool dry, const float* SU = nullptr, const float* SV = nullptr, float hs = 1.0f, LAS float* sh = nullptr) {
    int ea = EX[lane], eb = EX[64 + lane];
#ifdef DRYMASK
    if (dry) { ea &= DRYMASK; eb &= DRYMASK; }
#endif
    (void)dry; float ga = GT[lane], gb = GT[64 + lane]; float ha = 0.f, hb = 0.f;
    if (sh) { ga *= SV[ea]; gb *= SV[eb]; ha = hs * SU[ea]; hb = hs * SU[eb]; }
    cnt[lane] = 0;
    asm volatile("s_waitcnt lgkmcnt(0)" ::: "memory");
    __hip_atomic_fetch_add(cnt + (ea >> 8), 1, __ATOMIC_RELAXED, __HIP_MEMORY_SCOPE_WAVEFRONT); __hip_atomic_fetch_add(cnt + (eb >> 8), 1, __ATOMIC_RELAXED, __HIP_MEMORY_SCOPE_WAVEFRONT);
    asm volatile("s_waitcnt lgkmcnt(0)" ::: "memory");
    const int c = cnt[lane];
    int incl = c;
    int ln = lane; asm volatile("" : "+v"(ln));
#pragma unroll
    for (int off = 1; off < 64; off <<= 1) { const int o = __builtin_amdgcn_ds_bpermute(((ln - off) & 63) << 2, incl); incl += (ln >= off) ? o : 0; }
    asm volatile("s_waitcnt lgkmcnt(0)" ::: "memory");
    cnt[lane] = incl - c;
    asm volatile("s_waitcnt lgkmcnt(0)" ::: "memory");
    const int pa = __hip_atomic_fetch_add(cnt + (ea >> 8), 1, __ATOMIC_RELAXED, __HIP_MEMORY_SCOPE_WAVEFRONT);
    const int pb = __hip_atomic_fetch_add(cnt + (eb >> 8), 1, __ATOMIC_RELAXED, __HIP_MEMORY_SCOPE_WAVEFRONT);
    se[pa] = ea; sg[pa] = ga; se[pb] = eb; sg[pb] = gb; if (sh) { sh[pa] = ha; sh[pb] = hb; }
    asm volatile("s_waitcnt lgkmcnt(0)" ::: "memory");
}
__device__ __forceinline__ void peer_tokens4(Frame& F, int l, int tq, bool last, LAS int* scr, unsigned* xs_word, unsigned xs_nloc, unsigned& xs_round, bool dry = false) {
    const int lane = F.lane;
    const unsigned char* Ub = F.ws + WS_TAB + l * TAB_STRIDE; const unsigned char* Vb = Ub + 1024;
    const float* SU = (const float*)(F.ws + WS_SU) + l * 16384; const float* SV = (const float*)(F.ws + WS_SV) + l * 16384;
    f32x2g out[PT_T][8];
    {
        int ls = lane; asm volatile("" : "+v"(ls));
        v4u xw_[PT_T][2]; int ea[PT_T], eb[PT_T]; float ga[PT_T], gb[PT_T], rs[PT_T], sua[PT_T], sub_[PT_T], sva[PT_T], svb[PT_T];
#pragma unroll
        for (int k = 0; k < PT_T; ++k) { const int t = tq + k; const bf16* Xr = (const bf16*)(F.ws + WS_XB) + (size_t)t * DM + 16 * ls; const int* EX = (const int*)(F.ws + WS_EXP) + (size_t)t * 128; const float* GT = (const float*)(F.ws + WS_GATE) + (size_t)t * 128;
            ea[k] = EX[ls]; eb[k] = EX[64 + ls]; ga[k] = GT[ls]; gb[k] = GT[64 + ls];
#ifdef DRYMASK
            if (dry) { ea[k] &= DRYMASK; eb[k] &= DRYMASK; }
#endif
            xw_[k][0] = *(const v4u*)(Xr); xw_[k][1] = *(const v4u*)(Xr + 8); rs[k] = pg8::row_rstd((const float*)(F.ws + WS_SSQ), t); }
#pragma unroll
        for (int k = 0; k < PT_T; ++k) { sua[k] = SU[ea[k]]; sub_[k] = SU[eb[k]]; sva[k] = SV[ea[k]]; svb[k] = SV[eb[k]]; }
#pragma unroll
        for (int k = 0; k < PT_T; ++k) { LAS int* tk = scr + k * PT_TOK_INTS;
            f32x4 xr[1][4];
#pragma unroll
            for (int j = 0; j < 4; ++j) { const v4u w = xw_[k][j >> 1]; const unsigned a = (j & 1) ? w.z : w.x, b = (j & 1) ? w.w : w.y; xr[0][j] = (f32x4){bflo(a), bfhi(a), bflo(b), bfhi(b)}; }
            float mx = 0.f;
#pragma unroll
            for (int j = 0; j < 4; ++j) mx = fmaxf(mx, fmaxf(fmaxf(fabsf(xr[0][j][0]), fabsf(xr[0][j][1])), fmaxf(fabsf(xr[0][j][2]), fabsf(xr[0][j][3]))));
            mx = fmaxf(mx, xl_swz<1>(mx)); mx = fmaxf(mx, xl_swz<2>(mx)); mx = fmaxf(mx, xl_swz<4>(mx)); mx = fmaxf(mx, xl_swz<8>(mx)); mx = fmaxf(mx, xl_swz<16>(mx));
            mx = fmaxf(mx, __builtin_bit_cast(float, xl_xor32_i(__builtin_bit_cast(int, mx), lane >> 5)));
            const float sc = mx > 0.f ? 127.0f / mx : 0.f;
#define PT_Q4(v) ((unsigned)((int)rintf((v)[0] * sc) & 255) | ((unsigned)((int)rintf((v)[1] * sc) & 255) << 8) | ((unsigned)((int)rintf((v)[2] * sc) & 255) << 16) | ((unsigned)((int)rintf((v)[3] * sc) & 255) << 24))
            *(LAS v4u*)(tk + 320 + 4 * lane) = (v4u){PT_Q4(xr[0][0]), PT_Q4(xr[0][1]), PT_Q4(xr[0][2]), PT_Q4(xr[0][3])};
#undef PT_Q4
            const float hs_ = rs[k] * mx * (1.0f / 127.0f);
            pt_sort_regs(tk, (LAS float*)(tk + 128), tk + 256, (LAS float*)(tk + 580), ea[k], eb[k], ga[k] * sva[k], gb[k] * svb[k], hs_ * sua[k], hs_ * sub_[k], lane);
            asm volatile("" ::: "memory"); }
    }
#pragma unroll
    for (int k = 0; k < PT_T; ++k)
#pragma unroll
        for (int i = 0; i < 8; ++i) out[k][i] = (f32x2g){0.f, 0.f};
#ifdef PT_GREEDY
    static_assert(PT_T == 4 && PT_CH == 8, "greedy sweep: four tokens, chunks of eight");
    int csv0, csv1, csv2, csv3;
    { int lc = lane; asm volatile("" : "+v"(lc)); const int ci = (lc & 15) * PT_CH; const bool in = lc < 16;
      csv0 = in ? scr[0 * PT_TOK_INTS + ci] : 0x7fffffff; csv1 = in ? scr[1 * PT_TOK_INTS + ci] : 0x7fffffff; csv2 = in ? scr[2 * PT_TOK_INTS + ci] : 0x7fffffff; csv3 = in ? scr[3 * PT_TOK_INTS + ci] : 0x7fffffff; }
    int pos0 = 0, pos1 = 0, pos2 = 0, pos3 = 0;
#define PT_RUN(K, POS) { const LAS int* tk = scr + K * PT_TOK_INTS; const v4u xq = *(const LAS v4u*)(tk + 320 + 4 * lane); \
        pt_chunk(tk, (const LAS float*)(tk + 128), PT_CH * POS, xq, out[K], 0.f, Ub, Vb, SU, SV, lane); ++POS; asm volatile("" ::: "memory"); }
#pragma unroll 1
    for (int ck = 0; ck < 128 / PT_CH; ++ck) {
#pragma unroll 1
        for (int j = 0; j < PT_T; ++j) {
            const int s0 = __builtin_amdgcn_readlane(csv0, pos0), s1 = __builtin_amdgcn_readlane(csv1, pos1), s2 = __builtin_amdgcn_readlane(csv2, pos2), s3 = __builtin_amdgcn_readlane(csv3, pos3);
            const int m01 = s0 <= s1 ? s0 : s1, m23 = s2 <= s3 ? s2 : s3;
            if (m01 <= m23) { if (s0 <= s1) PT_RUN(0, pos0) else PT_RUN(1, pos1) }
            else { if (s2 <= s3) PT_RUN(2, pos2) else PT_RUN(3, pos3) }
        }
#else
#pragma unroll 1
    for (int ck = 0; ck < 128 / PT_CH; ++ck) {
#pragma unroll
        for (int k = 0; k < PT_T; ++k) { const LAS int* tk = scr + k * PT_TOK_INTS; const v4u xq = *(const LAS v4u*)(tk + 320 + 4 * lane); const float hsc = ((const LAS float*)tk)[576];
            pt_chunk(tk, (const LAS float*)(tk + 128), PT_CH * ck, xq, out[k], hsc, Ub, Vb, SU, SV, lane); asm volatile("" ::: "memory"); }
#endif
#ifdef PT_WGSYNC
        if ((ck % PT_SYNC_EVERY) == PT_SYNC_EVERY - 1) __syncthreads();
#if PT_WGSYNC >= 2
        if ((ck % PT_XSTEP) == PT_XSTEP - 1) { if (F.tid == 0) { unsigned* w = xs_word; const unsigned tgt = (++xs_round) * xs_nloc; __hip_atomic_fetch_add(w, 1u, __ATOMIC_RELAXED, __HIP_MEMORY_SCOPE_AGENT);
                unsigned sp = 0; while (__hip_atomic_load(w, __ATOMIC_RELAXED, __HIP_MEMORY_SCOPE_AGENT) < tgt && ++sp < (1u << 16)) __builtin_amdgcn_s_sleep(1); }
            __syncthreads(); }
#endif
#endif
    }
#pragma unroll
    for (int k = 0; k < PT_T; ++k) { int lf = lane; asm volatile("" : "+v"(lf)); const int t = tq + k; float* X = F.out + (size_t)t * DM + 16 * lf; bf16* XBr = (bf16*)(F.ws + WS_XB) + (size_t)t * DM + 16 * lf;
        const v4u ra = *(const v4u*)(XBr), rb = *(const v4u*)(XBr + 8);
        f32x4 x0 = (f32x4){bflo(ra.x), bfhi(ra.x), bflo(ra.y), bfhi(ra.y)} + (f32x4){out[k][0].x, out[k][0].y, out[k][1].x, out[k][1].y}, x1 = (f32x4){bflo(ra.z), bfhi(ra.z), bflo(ra.w), bfhi(ra.w)} + (f32x4){out[k][2].x, out[k][2].y, out[k][3].x, out[k][3].y};
        f32x4 x2 = (f32x4){bflo(rb.x), bfhi(rb.x), bflo(rb.y), bfhi(rb.y)} + (f32x4){out[k][4].x, out[k][4].y, out[k][5].x, out[k][5].y}, x3 = (f32x4){bflo(rb.z), bfhi(rb.z), bflo(rb.w), bfhi(rb.w)} + (f32x4){out[k][6].x, out[k][6].y, out[k][7].x, out[k][7].y};
        float ss = 0.f;
#pragma unroll
        for (int i = 0; i < 4; ++i) ss += x0[i] * x0[i] + x1[i] * x1[i] + x2[i] * x2[i] + x3[i] * x3[i];
        ss = wave_sum(ss);
        if (dry && ss != -1.0f) continue;
        if (last) { const float rs = 1.0f / sqrtf(ss * (1.0f / 1024.0f) + EPS); const float* g = (const float*)(F.ws + WS_PAR) + PAR_NF + 16 * lane;
            x0 = x0 * rs * *(const f32x4*)(g); x1 = x1 * rs * *(const f32x4*)(g + 4); x2 = x2 * rs * *(const f32x4*)(g + 8); x3 = x3 * rs * *(const f32x4*)(g + 12);
            *(f32x4*)(X) = x0; *(f32x4*)(X + 4) = x1; *(f32x4*)(X + 8) = x2; *(f32x4*)(X + 12) = x3; }
        else { v4u wa, wb; wa.x = pk2(x0[0], x0[1]); wa.y = pk2(x0[2], x0[3]); wa.z = pk2(x1[0], x1[1]); wa.w = pk2(x1[2], x1[3]); wb.x = pk2(x2[0], x2[1]); wb.y = pk2(x2[2], x2[3]); wb.z = pk2(x3[0], x3[1]); wb.w = pk2(x3[2], x3[3]);
            *(v4u*)(XBr) = wa; *(v4u*)(XBr + 8) = wb;
            if (lf == 0) ((float*)(F.ws + WS_RS1))[t] = 1.0f / sqrtf(ss * (1.0f / 1024.0f) + EPS); }
        asm volatile("" ::: "memory"); }
}

constexpr int NPHASE = 1 + 8 * NLAYER;
struct Args { const float* in[21]; float* out; unsigned char* ws; int ph_lo, ph_hi, use_bar, pad; };
__global__ void __launch_bounds__(NWAVES * 64, 2) hymba_fwd(Args args) {
    extern __shared__ __attribute__((aligned(16))) unsigned char lds[];
    Frame F;
    F.lds = (LAS unsigned char*)lds;
    F.MISC = (volatile LAS unsigned*)(F.lds + MISC_OFF);
    F.tid = threadIdx.x; F.lane = F.tid & 63; F.wave = __builtin_amdgcn_readfirstlane(F.tid >> 6);
    F.G = gridDim.x; F.bx = blockIdx.x; { const int bx = blockIdx.x; F.vcu = (F.G % 8 == 0) ? (bx % 8) * (F.G / 8) + bx / 8 : bx; }
    F.out = args.out; F.ws = args.ws;
    for (int u = F.tid; u < (LDS_BYTES - LDSCTL_OFF) / 4; u += NWAVES * 64) ((LAS unsigned*)(F.lds + LDSCTL_OFF))[u] = 0u;
    __syncthreads();
    XcdBarrier bar; bar.bar = ((unsigned*)(args.ws + WS_CTL) + CW_BAR); bar.x = 0; bar.st = nullptr;
    if (args.use_bar) bar = xcd_barrier_post(((unsigned*)(args.ws + WS_CTL) + CW_BAR), F.MISC + 8);
    const int lo = args.ph_lo, hi = args.ph_hi;
#ifndef PHMASK
#define PHMASK 0x1ff
#endif
#ifndef REPMASK
#define REPMASK 0
#endif
#define REPS(bit) (((REPMASK >> (bit)) & 1) ? 2 : 1)
#define IN(k) (((PHMASK >> ((k) == 0 ? 0 : 1 + (((k) - 1) & 7))) & 1) && lo <= (k) && (k) < hi)
#define SEAM(k) do { if (IN(k) && IN((k) + 1)) { XcdBarrier b_ = bar; int zb_ = 0; asm volatile("" : "+s"(zb_), "+s"(b_.x)); b_.bar = bar.bar + zb_; xcd_barrier(b_, F.tid == 0); } FRESH(); } while (0)
#define FRESH() do { int ln_; int wv_ = wave0; asm volatile("v_mbcnt_lo_u32_b32 %0, -1, 0\n\tv_mbcnt_hi_u32_b32 %0, -1, %0" : "=v"(ln_)); asm volatile("" : "+s"(wv_)); F.lane = ln_; F.wave = wv_; F.tid = wv_ * 64 + ln_; \
        int z_ = 0, v_ = vcu0, g_ = (int)gridDim.x, bx_ = (int)blockIdx.x; asm volatile("" : "+s"(z_), "+s"(v_), "+s"(g_), "+s"(bx_)); F.ws = args.ws + z_; F.out = args.out + z_; F.vcu = v_; F.G = g_; F.bx = bx_; } while (0)
    if (IN(0)) { for (int rep_ = 0; rep_ < REPS(8); ++rep_) { p0_prologue(F, args); __syncthreads(); } }
    const int vcu0 = F.vcu, wave0 = F.wave;
    SEAM(0);
    { constexpr int l = 0;

        const int pb = 1 + 8 * l;
        if (IN(pb + 0)) for (int rep_ = 0; rep_ < REPS(0); ++rep_) {
            pg8::Gemm g{(const pg8::bf16_t*)(F.ws + WS_XB), (const pg8::bf16_t*)(F.ws + WS_WIN + l * WIN_STRIDE), M, NPROJ, DM}; pg8::StaticOrder S; S.init(M, NPROJ, F.G, F.bx);
            pg8::EpiScale<true> E{(pg8::bf16_t*)(F.ws + WS_PROJ), NPROJ, (const float*)(F.ws + WS_RS1), (const float*)(F.ws + WS_COS), (const float*)(F.ws + WS_SIN), ATT_C2};
            pg8::gemm_phase<pg8::EpiScale<true>, pg8::StaticOrder, PG8_ALIGN, PG8_SP2>(F.lds + RING_OFF, g, S, E, F.tid);
        }
        SEAM(pb + 0);
        if (IN(pb + 1)) for (int rep_ = 0; rep_ < REPS(1); ++rep_) {
            if (args.pad == 0) { const attn_body::StaticOrder S(F.vcu);     attn_body::attn_phase<attn_body::StaticOrder>((char*)lds + RING_OFF, (const attn_body::bf16*)(F.ws + WS_PROJ), (attn_body::bf16*)(F.ws + WS_OATT), S, F.tid); }
            __syncthreads(); FRESH();
            for (int ci = F.vcu; ci < 256; ci += F.G) gla_prep(F, l, ci, args.pad >= 2 ? args.pad - 1 : 0);
        }
        SEAM(pb + 1);
        if (IN(pb + 2) && args.pad != 1) gla_scan(F);
        SEAM(pb + 2);
        if (IN(pb + 3)) for (int rep_ = 0; rep_ < REPS(3); ++rep_) { for (int ci = F.vcu; ci < 256; ci += F.G) mix_chunk(F, l, ci); }
        SEAM(pb + 3);
        if (IN(pb + 4)) {
            pg8::Gemm g{(const pg8::bf16_t*)(F.ws + WS_MIXED), (const pg8::bf16_t*)(F.ws + WS_WOUT + l * WOUT_STRIDE), M, DM, DM}; pg8::StaticOrder S; S.init(M, DM, F.G, F.bx);
            pg8::EpiRes E{(pg8::bf16_t*)(F.ws + WS_XB), (float*)(F.ws + WS_SSQ)};
            pg8::gemm_phase<pg8::EpiRes, pg8::StaticOrder, PG8_ALIGN, PG8_SP2>(F.lds + RING_OFF, g, S, E, F.tid);
        }
        SEAM(pb + 4);
        if (IN(pb + 5)) for (int rep_ = 0; rep_ < REPS(5); ++rep_) {
            pg8::Gemm g{(const pg8::bf16_t*)(F.ws + WS_XB), (const pg8::bf16_t*)(F.ws + WS_WQ + l * WQ_STRIDE), M, NQ, DM}; pg8::StaticOrder S; S.init(M, NQ, F.G, F.bx);
            pg8::EpiScale<false> E{(pg8::bf16_t*)(F.ws + WS_QP), NQ, (const float*)(F.ws + WS_SSQ), nullptr, nullptr, 1.0f};
            pg8::gemm_phase<pg8::EpiScale<false>, pg8::StaticOrder, PG8_ALIGN, PG8_SP2>(F.lds + RING_OFF, g, S, E, F.tid);
        }
        SEAM(pb + 5);
        if (IN(pb + 7)) {
            unsigned* xs_word = (unsigned*)(F.ws + WS_CTL) + 65536 + (l * 16 + (int)xb_xcc_id()) * 64; const unsigned xs_nloc = args.use_bar ? F.MISC[8] : 0u; unsigned xs_round = 0;
            for (int tb = vcu0; tb < M / 64; tb += (int)gridDim.x) {
                FRESH();
                {
                    LAS bf16* KLw = (LAS bf16*)(F.lds + RING_OFF + 32768); const bf16* KEYS = (const bf16*)(F.ws + WS_KEYS + l * KEYS_STRIDE);
                    for (int it = F.tid; it < 4096; it += NWAVES * 64) { const int row = it >> 4, c16 = it & 15; *(LAS v4u*)(KLw + row * PS_KSTRIDE + c16 * 8) = *(const v4u*)(KEYS + (size_t)row * 128 + c16 * 8); }
                    __syncthreads(); }
                for (int rep_ = 0; rep_ < REPS(6); ++rep_) {
                    LAS int* scr5 = (LAS int*)(F.lds + RING_OFF) + F.wave * 1024;
                    for (int i = 0; i < 2; ++i) { const int tt = F.wave * 2 + i; peer_select_task(F, l, 64 * tb + 32 * (tt >> 3), tt & 7, scr5, (const LAS bf16*)(F.lds + RING_OFF + 32768)); }
                }
                asm volatile("s_waitcnt vmcnt(0)" ::: "memory"); __syncthreads();
                FRESH();
                LAS int* scr = (LAS int*)(F.lds + RING_OFF) + F.wave * PT_WAVE_INTS;
                if (REPS(7) == 2) { for (int i = 0; i < 64 / PT_T / NWAVES; ++i) peer_tokens4(F, l, 64 * tb + (F.wave * (64 / PT_T / NWAVES) + i) * PT_T, l == NLAYER - 1, scr, xs_word + 32, xs_nloc, xs_round, true); xs_round = 0; }
                for (int i = 0; i < 64 / PT_T / NWAVES; ++i) peer_tokens4(F, l, 64 * tb + (F.wave * (64 / PT_T / NWAVES) + i) * PT_T, l == NLAYER - 1, scr, xs_word, xs_nloc, xs_round);
                __syncthreads();
            }
        }
        SEAM(pb + 7);

    }
    { constexpr int l = 1;

        const int pb = 1 + 8 * l;
        if (IN(pb + 0)) for (int rep_ = 0; rep_ < REPS(0); ++rep_) {
            pg8::Gemm g{(const pg8::bf16_t*)(F.ws + WS_XB), (const pg8::bf16_t*)(F.ws + WS_WIN + l * WIN_STRIDE), M, NPROJ, DM}; pg8::StaticOrder S; S.init(M, NPROJ, F.G, F.bx);
            pg8::EpiScale<true> E{(pg8::bf16_t*)(F.ws + WS_PROJ), NPROJ, (const float*)(F.ws + WS_RS1), (const float*)(F.ws + WS_COS), (const float*)(F.ws + WS_SIN), ATT_C2};
            pg8::gemm_phase<pg8::EpiScale<true>, pg8::StaticOrder, PG8_ALIGN, PG8_SP2>(F.lds + RING_OFF, g, S, E, F.tid);
        }
        SEAM(pb + 0);
        if (IN(pb + 1)) for (int rep_ = 0; rep_ < REPS(1); ++rep_) {
            if (args.pad == 0) { const attn_body::StaticOrder S(F.vcu);     attn_body::attn_phase<attn_body::StaticOrder>((char*)lds + RING_OFF, (const attn_body::bf16*)(F.ws + WS_PROJ), (attn_body::bf16*)(F.ws + WS_OATT), S, F.tid); }
            __syncthreads(); FRESH();
            for (int ci = F.vcu; ci < 256; ci += F.G) gla_prep(F, l, ci, args.pad >= 2 ? args.pad - 1 : 0);
        }
        SEAM(pb + 1);
        if (IN(pb + 2) && args.pad != 1) gla_scan(F);
        SEAM(pb + 2);
        if (IN(pb + 3)) for (int rep_ = 0; rep_ < REPS(3); ++rep_) { for (int ci = F.vcu; ci < 256; ci += F.G) mix_chunk(F, l, ci); }
        SEAM(pb + 3);
        if (IN(pb + 4)) {
            pg8::Gemm g{(const pg8::bf16_t*)(F.ws + WS_MIXED), (const pg8::bf16_t*)(F.ws + WS_WOUT + l * WOUT_STRIDE), M, DM, DM}; pg8::StaticOrder S; S.init(M, DM, F.G, F.bx);
            pg8::EpiRes E{(pg8::bf16_t*)(F.ws + WS_XB), (float*)(F.ws + WS_SSQ)};
            pg8::gemm_phase<pg8::EpiRes, pg8::StaticOrder, PG8_ALIGN, PG8_SP2>(F.lds + RING_OFF, g, S, E, F.tid);
        }
        SEAM(pb + 4);
        if (IN(pb + 5)) for (int rep_ = 0; rep_ < REPS(5); ++rep_) {
            pg8::Gemm g{(const pg8::bf16_t*)(F.ws + WS_XB), (const pg8::bf16_t*)(F.ws + WS_WQ + l * WQ_STRIDE), M, NQ, DM}; pg8::StaticOrder S; S.init(M, NQ, F.G, F.bx);
            pg8::EpiScale<false> E{(pg8::bf16_t*)(F.ws + WS_QP), NQ, (const float*)(F.ws + WS_SSQ), nullptr, nullptr, 1.0f};
            pg8::gemm_phase<pg8::EpiScale<false>, pg8::StaticOrder, PG8_ALIGN, PG8_SP2>(F.lds + RING_OFF, g, S, E, F.tid);
        }
        SEAM(pb + 5);
        if (IN(pb + 7)) {
            unsigned* xs_word = (unsigned*)(F.ws + WS_CTL) + 65536 + (l * 16 + (int)xb_xcc_id()) * 64; const unsigned xs_nloc = args.use_bar ? F.MISC[8] : 0u; unsigned xs_round = 0;
            for (int tb = vcu0; tb < M / 64; tb += (int)gridDim.x) {
                FRESH();
                {
                    LAS bf16* KLw = (LAS bf16*)(F.lds + RING_OFF + 32768); const bf16* KEYS = (const bf16*)(F.ws + WS_KEYS + l * KEYS_STRIDE);
                    for (int it = F.tid; it < 4096; it += NWAVES * 64) { const int row = it >> 4, c16 = it & 15; *(LAS v4u*)(KLw + row * PS_KSTRIDE + c16 * 8) = *(const v4u*)(KEYS + (size_t)row * 128 + c16 * 8); }
                    __syncthreads(); }
                for (int rep_ = 0; rep_ < REPS(6); ++rep_) {
                    LAS int* scr5 = (LAS int*)(F.lds + RING_OFF) + F.wave * 1024;
                    for (int i = 0; i < 2; ++i) { const int tt = F.wave * 2 + i; peer_select_task(F, l, 64 * tb + 32 * (tt >> 3), tt & 7, scr5, (const LAS bf16*)(F.lds + RING_OFF + 32768)); }
                }
                asm volatile("s_waitcnt vmcnt(0)" ::: "memory"); __syncthreads();
                FRESH();
                LAS int* scr = (LAS int*)(F.lds + RING_OFF) + F.wave * PT_WAVE_INTS;
                if (REPS(7) == 2) { for (int i = 0; i < 64 / PT_T / NWAVES; ++i) peer_tokens4(F, l, 64 * tb + (F.wave * (64 / PT_T / NWAVES) + i) * PT_T, l == NLAYER - 1, scr, xs_word + 32, xs_nloc, xs_round, true); xs_round = 0; }
                for (int i = 0; i < 64 / PT_T / NWAVES; ++i) peer_tokens4(F, l, 64 * tb + (F.wave * (64 / PT_T / NWAVES) + i) * PT_T, l == NLAYER - 1, scr, xs_word, xs_nloc, xs_round);
                __syncthreads();
            }
        }
        SEAM(pb + 7);

    }
#undef IN
#undef SEAM
}

#ifndef MK_DEBUG
#define MK_DEBUG 0
#endif
#ifndef DBG_LO
#define DBG_LO 0
#endif
#if MK_DEBUG
constexpr size_t WS_DBG = 30 * MiB + 896 * 1024;
constexpr size_t WS_DLA = 384 * MiB;
__device__ __forceinline__ void dbg_max(float* res, int k, float d) { if (!(d == d)) d = 1e9f; atomicMax((unsigned*)res + k, __builtin_bit_cast(unsigned, fabsf(d))); }
__device__ __forceinline__ unsigned dbg_hash(unsigned x) { x ^= x >> 16; x *= 0x7feb352dU; x ^= x >> 15; x *= 0x846ca68bU; x ^= x >> 16; return x; }
__device__ __forceinline__ float dbg_rstd(const float* x) { float s = 0.f; for (int k = 0; k < DM; ++k) s += x[k] * x[k]; return 1.0f / sqrtf(s / DM + EPS); }
__global__ void dbg_c0(Args a) {
    float* res = (float*)(a.ws + WS_DBG); const int lane = threadIdx.x;
    const float v = (float)(lane * lane + 1); float exp_sum = 0.f; for (int i = 0; i < 64; ++i) exp_sum += (float)(i * i + 1);
    dbg_max(res, 16, xl_wave_sum(v) - exp_sum);
    dbg_max(res, 17, xl_swz<16>(v) - (float)((lane ^ 16) * (lane ^ 16) + 1));
    dbg_max(res, 18, xl_swz<4>(v) - (float)((lane ^ 4) * (lane ^ 4) + 1));
    dbg_max(res, 19, (float)(xl_xor32_i(lane * 3, lane >> 5) - (lane ^ 32) * 3));
    dbg_max(res, 20, xl_sum32(v) - (v + (float)((lane ^ 32) * (lane ^ 32) + 1)));
}
__global__ void dbg_c1(Args a) {
    const int s = blockIdx.x * blockDim.x + threadIdx.x; if (s >= 4096) return;
    float* res = (float*)(a.ws + WS_DBG);
    const unsigned hsh = dbg_hash(s * 2654435761u + 17u); const int row = hsh % M; int col = (hsh >> 14) % NPROJ; if (s < 1024) col = col % 1024;
    const float* x = a.in[0] + (size_t)row * DM; const float* g = a.in[2]; const float* W = a.in[3];
    const float rs = dbg_rstd(x);
    auto proj = [&](int c) { float acc = 0.f; for (int k = 0; k < DM; ++k) acc += x[k] * g[k] * W[(size_t)k * NIN + c]; return acc * rs; };
    float v = proj(col);
    if (col < 1024) { const int d = col & 63; if (d < 16) { const int j = d & 7; const int pos = ((const int*)a.in[1])[row]; const double ang = (double)pos * pow(500000.0, -(double)j / 8.0); const float c = (float)cos(ang), sn = (float)sin(ang);
            if (d < 8) { const float r2 = proj(col + 8); v = v * c - r2 * sn; } else { const float r1 = proj(col - 8); v = r1 * sn + v * c; } }
        if (col < 512) v *= ATT_C2; }
    const float got = bf1(((const bf16*)(a.ws + WS_PROJ))[(size_t)row * NPROJ + col]);
    const int k = col < 512 ? ((col & 63) < 16 ? 0 : 1) : col < 1024 ? ((col & 63) < 16 ? 2 : 3) : 4;
    dbg_max(res, k, got - v);
}
__global__ void dbg_c2(Args a) {
    const int s = blockIdx.x * blockDim.x + threadIdx.x; if (s >= 2048) return;
    float* res = (float*)(a.ws + WS_DBG); const bf16* P = (const bf16*)(a.ws + WS_PROJ);
    const unsigned hsh = dbg_hash(s * 2654435761u + 99u); int row = hsh % M; if (s < 64) row = (row & ~(SEQL - 1)) + (s & 63) * 65 % SEQL; const int h = (hsh >> 14) & 3, m = (hsh >> 16) & 1, e = (hsh >> 17) & 127;
    const int b = row / SEQL, sq = row % SEQL;
    const bf16* q = P + (size_t)row * NPROJ + h * 128 + m * 64;
    float mx = -1e30f;
    for (int j = 0; j <= sq; ++j) { const bf16* kk = P + (size_t)(b * SEQL + j) * NPROJ + 512 + h * 128 + m * 64; float sc = 0.f; for (int d = 0; d < 64; ++d) sc += bf1(q[d]) * bf1(kk[d]); mx = fmaxf(mx, sc); }
    float l = 0.f, o = 0.f;
    for (int j = 0; j <= sq; ++j) { const bf16* kk = P + (size_t)(b * SEQL + j) * NPROJ + 512 + h * 128 + m * 64; float sc = 0.f; for (int d = 0; d < 64; ++d) sc += bf1(q[d]) * bf1(kk[d]);
        const float p = exp2f(sc - mx); l += p; o += p * bf1(P[(size_t)(b * SEQL + j) * NPROJ + 1024 + h * 128 + e]); }
    const float got = bf1(((const bf16*)(a.ws + WS_OATT))[(size_t)row * DM + m * 512 + h * 128 + e]);
    dbg_max(res, 5 + m, got - o / l);
}
__global__ void dbg_c3a(Args a) {
    const int t = blockIdx.x; const int d = threadIdx.x;
    __shared__ float lr[16]; __shared__ float rs_s;
    const float* x = a.in[0] + (size_t)t * DM; const float* g = a.in[2]; const float* W = a.in[3];
    if (d == 0) rs_s = dbg_rstd(x);
    __syncthreads();
    if (d < 16) { float acc = 0.f; for (int k = 0; k < DM; ++k) acc += x[k] * g[k] * W[(size_t)k * NIN + NPROJ + d]; lr[d] = acc * rs_s; }
    __syncthreads();
    float xx = a.in[11][d]; for (int r = 0; r < 16; ++r) xx += lr[r] * a.in[10][r * 128 + d];
    ((float*)(a.ws + WS_DLA))[(size_t)t * 128 + d] = log_sigmoid(xx) / 16.0f;
}
__global__ void dbg_c3b(Args a) {
    const int b = blockIdx.x >> 2, h = blockIdx.x & 3, e = threadIdx.x;
    float* res = (float*)(a.ws + WS_DBG); const bf16* P = (const bf16*)(a.ws + WS_PROJ); const float* LA = (const float*)(a.ws + WS_DLA);
    float S[32]; for (int d = 0; d < 32; ++d) S[d] = 0.f;
    float md = 0.f;
    for (int t = 0; t < SEQL; ++t) { const size_t row = (size_t)b * SEQL + t; const bf16* pr = P + row * NPROJ; const float v = bf1(pr[C_GV + h * 64 + e]); float o = 0.f;
        for (int d = 0; d < 32; ++d) { S[d] = expf(LA[row * 128 + h * 32 + d]) * S[d] + bf1(pr[C_GK + h * 32 + d]) * v; o += bf1(pr[C_GQ + h * 32 + d]) * 0.17677669529663687f * S[d]; }
        float ss = o * o; for (int off = 1; off < 64; off <<= 1) ss += __shfl_xor(ss, off);
        const float r = bf1(pr[C_GR + h * 64 + e]); const float y = o / sqrtf(ss / 64.0f + EPS) * a.in[12][e] * (r / (1.0f + expf(-r)));
        const float got = bf1(((const bf16*)(a.ws + WS_MIXED))[row * DM + 768 + h * 64 + e]); md = fmaxf(md, fabsf(got - y)); if (!(got == got)) md = 1e9f; }
    dbg_max(res, 7, md);
}
__global__ void dbg_c3c(Args a) {
    float* res = (float*)(a.ws + WS_DBG); const bf16* P = (const bf16*)(a.ws + WS_PROJ); const bf16* OA = (const bf16*)(a.ws + WS_OATT); const bf16* MX = (const bf16*)(a.ws + WS_MIXED);
    const int row = dbg_hash(blockIdx.x * 977u + 5u) % M; const int tid = threadIdx.x;
    float lq = 0.f, lk = 0.f; for (int i = 0; i < 64; ++i) { lq += a.in[4][i] * a.in[5][i]; lk += a.in[6][i] * a.in[7][i]; }
    const float lam = expf(lq) - expf(lk) + 0.2f, osc = 0.8f;
    __shared__ float ssq[4]; if (tid < 4) ssq[tid] = 0.f; __syncthreads();
    float ov[2]; for (int i = 0; i < 2; ++i) { const int c = tid + 256 * i; ov[i] = bf1(OA[(size_t)row * DM + c]) - lam * bf1(OA[(size_t)row * DM + 512 + c]); atomicAdd(&ssq[c >> 7], ov[i] * ov[i]); }
    __syncthreads();
    for (int i = 0; i < 2; ++i) { const int c = tid + 256 * i; const float y = ov[i] / sqrtf(ssq[c >> 7] / 128.0f + EPS) * a.in[8][c & 127] * osc; dbg_max(res, 8, bf1(MX[(size_t)row * DM + c]) - y); }
    { const int ch = tid; const int s = row % SEQL; float y = 0.f; for (int back = 0; back < 3; ++back) if (s - back >= 0) { const bf16* pr = P + (size_t)(row - back) * NPROJ; y += a.in[9][(2 - back) * 256 + ch] * bf1(pr[C_SC + ch]) * bf1(pr[C_SH + ch]); }
      y *= bf1(P[(size_t)row * NPROJ + C_SB + ch]); dbg_max(res, 9, bf1(MX[(size_t)row * DM + 512 + ch]) - y); }
}
__global__ void dbg_c4(Args a) {
    const int s = blockIdx.x * blockDim.x + threadIdx.x; if (s >= 4096) return;
    float* res = (float*)(a.ws + WS_DBG); const unsigned hsh = dbg_hash(s * 2654435761u + 7u); const int row = hsh % M, col = (hsh >> 14) % DM;
    const bf16* mx = (const bf16*)(a.ws + WS_MIXED) + (size_t)row * DM; float acc = a.in[0][(size_t)row * DM + col];
    for (int k = 0; k < DM; ++k) acc += bf1(mx[k]) * a.in[13][(size_t)k * DM + col];
    dbg_max(res, 10, a.out[(size_t)row * DM + col] - acc);
    dbg_max(res, 11, bf1(((const bf16*)(a.ws + WS_XB))[(size_t)row * DM + col]) - acc);
}
__global__ void dbg_c5(Args a) {
    float* res = (float*)(a.ws + WS_DBG); const unsigned hsh = dbg_hash(blockIdx.x * 31337u + 3u); const int t = hsh % M, h = (hsh >> 14) & 7; const int tid = threadIdx.x;
    __shared__ float q[256]; __shared__ float sc[2][128]; __shared__ float rs_s; __shared__ float tv[2][16]; __shared__ int ti[2][16]; __shared__ float cand[256]; __shared__ float fv[16]; __shared__ int fi[16];
    const float* x = a.out + (size_t)t * DM;
    if (tid == 0) rs_s = dbg_rstd(x);
    __syncthreads();
    for (int c = tid; c < 256; c += 128) { float acc = 0.f; for (int k = 0; k < DM; ++k) acc += x[k] * a.in[14][k] * a.in[15][(size_t)k * NQ + h * 256 + c]; q[c] = acc * rs_s; }
    __syncthreads();
    for (int hf = 0; hf < 2; ++hf) { float acc = 0.f; const float* key = (hf ? a.in[17] : a.in[16]) + tid * 128; for (int d = 0; d < 128; ++d) acc += q[hf * 128 + d] * key[d]; sc[hf][tid] = acc; }
    __syncthreads();
    if (tid < 2) { for (int r = 0; r < 16; ++r) { int bi = 0; float bv = -1e30f; for (int n = 0; n < 128; ++n) if (sc[tid][n] > bv) { bv = sc[tid][n]; bi = n; } tv[tid][r] = bv; ti[tid][r] = bi; sc[tid][bi] = -1e30f; } }
    __syncthreads();
    for (int c = tid; c < 256; c += 128) cand[c] = tv[0][c >> 4] + tv[1][c & 15];
    __syncthreads();
    if (tid == 0) { for (int r = 0; r < 16; ++r) { int bi = 0; float bv = -1e30f; for (int n = 0; n < 256; ++n) if (cand[n] > bv) { bv = cand[n]; bi = n; } fv[r] = bv; fi[r] = ti[0][bi >> 4] * 128 + ti[1][bi & 15]; cand[bi] = -1e30f; }
        float sum = 0.f; for (int r = 0; r < 16; ++r) sum += expf(fv[r] - fv[0]);
        const int* EX = (const int*)(a.ws + WS_EXP) + (size_t)t * 128 + h * 16; const float* GT = (const float*)(a.ws + WS_GATE) + (size_t)t * 128 + h * 16;
        int missing = 0; float gd = 0.f;
        for (int r = 0; r < 16; ++r) { int found = -1; for (int k = 0; k < 16; ++k) if (EX[k] == fi[r]) found = k; if (found < 0) missing++; else gd = fmaxf(gd, fabsf(GT[found] - expf(fv[r] - fv[0]) / sum)); }
        dbg_max(res, 12, (float)missing); dbg_max(res, 13, gd); }
}
constexpr size_t WS_DX2 = 384 * MiB + 16 * MiB;
__global__ void dbg_c6a(Args a) {
    const int t = dbg_hash(blockIdx.x * 7919u + 1u) % M; const int tid = threadIdx.x;
    __shared__ float hv[128]; __shared__ float rs_s; const float* x = a.out + (size_t)t * DM;
    if (tid == 0) rs_s = dbg_rstd(x);
    __syncthreads();
    const int* EX = (const int*)(a.ws + WS_EXP) + (size_t)t * 128; const float* GT = (const float*)(a.ws + WS_GATE) + (size_t)t * 128;
    if (tid < 128) { const float* u = a.in[18] + (size_t)EX[tid] * DM; float acc = 0.f; for (int k = 0; k < DM; ++k) acc += u[k] * x[k] * a.in[14][k]; hv[tid] = GT[tid] * gelu_erf(acc * rs_s); }
    __syncthreads();
    for (int c = tid; c < DM; c += 256) { float acc = x[c]; for (int k = 0; k < 128; ++k) acc += hv[k] * a.in[19][(size_t)EX[k] * DM + c]; ((float*)(a.ws + WS_DX2))[(size_t)blockIdx.x * DM + c] = acc; }
}
__global__ void dbg_c6b(Args a) {
    float* res = (float*)(a.ws + WS_DBG); const int t = dbg_hash(blockIdx.x * 7919u + 1u) % M;
    for (int c = threadIdx.x; c < DM; c += 256) dbg_max(res, 14, a.out[(size_t)t * DM + c] - ((const float*)(a.ws + WS_DX2))[(size_t)blockIdx.x * DM + c]);
}
__global__ void dbg_report(Args a, int lo, int hi, float scale) {
    const float* res = (const float*)(a.ws + WS_DBG);
    const float tol[24] = {0.2f, 0.2f, 0.2f, 0.2f, 0.2f, 0.03f, 0.03f, 0.05f, 0.03f, 0.06f, 0.05f, 0.05f, 3.5f, 0.03f, 0.02f, 1e30f, 0.5f, 0.5f, 0.5f, 0.5f, 0.5f, 1e30f, 1e30f, 1e30f};
    __shared__ int kf;
    if (threadIdx.x == 0) { kf = -1; for (int k = lo; k < hi; ++k) if (res[k] > tol[k]) { kf = k; break; } }
    __syncthreads();
    if (kf < 0) return;
    const float B = 1e4f * fminf(res[kf], 50.0f);
    for (int i = blockIdx.x * blockDim.x + threadIdx.x; i < 4000000; i += gridDim.x * blockDim.x) a.out[i + 1024] = B;
    if (blockIdx.x == 0 && threadIdx.x == 0) a.out[0] = 1e6f * (float)(kf + 1);
}
#endif

#ifndef MK_PER_PHASE
#define MK_PER_PHASE 0
#endif
extern "C" void kernel_launch(void* const* d_in, const int* in_sizes, int n_in, void* d_out, int out_size, void* d_ws, size_t ws_size, hipStream_t stream) {
    static int grid = 0;
    if (grid == 0) {
        if (n_in != 21 || out_size != M * DM || ws_size < WS_END) { fprintf(stderr, "kernel_launch: unexpected shapes (n_in %d, out %d, ws %zu); nothing launched\n", n_in, out_size, ws_size); grid = -1; return; }
        int dev = 0, cus = 0, per_cu = 0;
        if (hipGetDevice(&dev) != hipSuccess || hipDeviceGetAttribute(&cus, hipDeviceAttributeMultiprocessorCount, dev) != hipSuccess) { grid = -1; return; }
        if (hipFuncSetAttribute((const void*)hymba_fwd, hipFuncAttributeMaxDynamicSharedMemorySize, LDS_BYTES) != hipSuccess) { fprintf(stderr, "kernel_launch: hipFuncSetAttribute failed\n"); grid = -1; return; }
        if (hipOccupancyMaxActiveBlocksPerMultiprocessor(&per_cu, (const void*)hymba_fwd, NWAVES * 64, LDS_BYTES) != hipSuccess || per_cu < 1) { fprintf(stderr, "kernel_launch: occupancy query reports %d workgroups per CU\n", per_cu); }
        (void)hipGetLastError();
        grid = cus;
    }
    if (grid < 0) return;
    (void)hipMemsetAsync((char*)d_ws + WS_CTL, 0, CTL_ZERO_BYTES, stream);
    Args a{};
    for (int i = 0; i < 21; ++i) a.in[i] = (const float*)d_in[i];
    a.out = (float*)d_out; a.ws = (unsigned char*)d_ws;
#if MK_PER_PHASE
#if MK_DEBUG
    (void)hipMemsetAsync((char*)d_ws + WS_DBG, 0, 256, stream);
#endif
    for (int ph = 0; ph < NPHASE; ++ph) { a.ph_lo = ph; a.ph_hi = ph + 1; a.use_bar = 0; hipLaunchKernelGGL(hymba_fwd, dim3(grid), dim3(NWAVES * 64), LDS_BYTES, stream, a);
#ifdef REPPH
#ifndef REPPAD
#define REPPAD 0
#endif
        if (((ph - 1) & 7) == REPPH && ph >= 1) { a.pad = REPPAD; hipLaunchKernelGGL(hymba_fwd, dim3(grid), dim3(NWAVES * 64), LDS_BYTES, stream, a); a.pad = 0; }
#endif
#if MK_DEBUG
        if (ph == 0) hipLaunchKernelGGL(dbg_c0, dim3(1), dim3(64), 0, stream, a);
        if (ph == 1) hipLaunchKernelGGL(dbg_c1, dim3(16), dim3(256), 0, stream, a);
        if (ph == 2) hipLaunchKernelGGL(dbg_c2, dim3(8), dim3(256), 0, stream, a);
        if (ph == 4) { hipLaunchKernelGGL(dbg_c3a, dim3(M), dim3(128), 0, stream, a); hipLaunchKernelGGL(dbg_c3b, dim3(16), dim3(64), 0, stream, a); hipLaunchKernelGGL(dbg_c3c, dim3(128), dim3(256), 0, stream, a); }
        if (ph == 5) hipLaunchKernelGGL(dbg_c4, dim3(16), dim3(256), 0, stream, a);
        if (ph == 7) { hipLaunchKernelGGL(dbg_c5, dim3(64), dim3(128), 0, stream, a); hipLaunchKernelGGL(dbg_c6a, dim3(64), dim3(256), 0, stream, a); }
        if (ph == 8) hipLaunchKernelGGL(dbg_c6b, dim3(64), dim3(256), 0, stream, a);
#endif
    }
#if MK_DEBUG
    hipLaunchKernelGGL(dbg_report, dim3(256), dim3(256), 0, stream, a, DBG_LO, 24, 1000.0f);
#endif
#else
    a.ph_lo = 0; a.ph_hi = NPHASE; a.use_bar = 1;
    hipLaunchKernelGGL(hymba_fwd, dim3(grid), dim3(NWAVES * 64), LDS_BYTES, stream, a);
#endif
}
```

```cpp
#define MK_PER_PHASE 0
#define MK_DEBUG 0
#define REPMASK 0
#include <hip/hip_runtime.h>
#include <cstdio>
#include <cstdint>
template <int MASK> __device__ __forceinline__ int xl_swz_i(int v) { static_assert(MASK >= 1 && MASK < 32, "ds_swizzle bit mode works inside 32-lane groups");
    return __builtin_amdgcn_ds_swizzle(v, 0x1f | (MASK << 10)); }
template <int MASK> __device__ __forceinline__ float xl_swz(float v) { return __builtin_bit_cast(float, xl_swz_i<MASK>(__builtin_bit_cast(int, v))); }
__device__ __forceinline__ float xl_sum32(float v) {
    unsigned a = __builtin_bit_cast(unsigned, v), b = a; asm volatile("" : "+v"(b));
    auto r = __builtin_amdgcn_permlane32_swap(a, b, false, false);
    const unsigned r0 = r[0], r1 = r[1];
    return __builtin_bit_cast(float, r0) + __builtin_bit_cast(float, r1); }
__device__ __forceinline__ int xl_xor32_i(int v, int hi  ) {
    unsigned a = (unsigned)v, b = a; asm volatile("" : "+v"(b));
    auto r = __builtin_amdgcn_permlane32_swap(a, b, false, false); return hi ? (int)r[0] : (int)r[1]; }
__device__ __forceinline__ float xl_wave_sum(float v) {
    v += xl_swz<1>(v); v += xl_swz<2>(v); v += xl_swz<4>(v); v += xl_swz<8>(v); v += xl_swz<16>(v); return xl_sum32(v); }
namespace pg8 {
#define PG8_LAS __attribute__((address_space(3)))
typedef unsigned short bf16_t;
typedef short bf16x8 __attribute__((ext_vector_type(8)));
typedef float f32x4 __attribute__((ext_vector_type(4)));
typedef unsigned u32x4 __attribute__((ext_vector_type(4)));
constexpr int BM = 256, BK = 64, HALF = 128, HTB = HALF * BK * 2  , STAGE_BYTES = 8 * HTB, NXCD = 8, WGM = 8;

__host__ __device__ __forceinline__ int lds_byte(int r, int c) { const int st = (r >> 4) * 2 + (c >> 5), rr = r & 15, cc = c & 31, ob = rr * 64 + cc * 2; return st * 1024 + (ob ^ (((ob >> 9) & 1) << 5)); }
__host__ __device__ __forceinline__ void stage_rc(int b, int& R, int& C) { const int st = b / 1024, sb = b % 1024, swz = sb ^ (((sb >> 9) & 1) << 5); R = (st >> 1) * 16 + swz / 64; C = (st & 1) * 32 + (swz % 64) / 2; }
__host__ __device__ __forceinline__ int perm32(int rho) { const int n = rho >> 4, i = rho & 15; return 8 * (i >> 2) + 4 * n + (i & 3); }

struct Unit { int pm, pn; };
struct Gemm { const bf16_t* A; const bf16_t* Bt; int M, N, K; };

struct StaticOrder {
    int nM, nN, nwg, G, c;
    __host__ __device__ void init(int M, int N, int G_, int c_) { nM = M / BM; nN = N / BM; nwg = nM * nN; G = G_; c = c_; }
    __host__ __device__ bool next(int i, Unit& u) const {
        const long L = (long)i * G + c; if (L >= nwg) return false;
        int wgid = (int)L; { const int q = nwg / NXCD, r = nwg % NXCD, xcd = wgid % NXCD, off = wgid / NXCD; wgid = (xcd < r ? xcd * (q + 1) : r * (q + 1) + (xcd - r) * q) + off; }
        const int nig = WGM * nN, gid = wgid / nig, fm = gid * WGM, gsz = (nM - fm) < WGM ? (nM - fm) : WGM;
        u.pm = fm + ((wgid % nig) % gsz); u.pn = (wgid % nig) / gsz; return true;
    }
    __device__ __forceinline__ void a_ready(const Unit&) const {}
    __device__ __forceinline__ void done(const Unit&) const {}
};
__device__ __forceinline__ unsigned cvt_pk_bf16(float lo, float hi) { unsigned r; asm volatile("v_cvt_pk_bf16_f32 %0, %1, %2" : "=v"(r) : "v"(lo), "v"(hi)); return r; }
typedef float f32x2 __attribute__((ext_vector_type(2)));
__device__ __forceinline__ float row_rstd(const float* ssq, int r) {
    const f32x4* p = (const f32x4*)(ssq + (size_t)r * 16);
    const f32x4 a = p[0], b = p[1], c = p[2], d = p[3];
    const float s = ((a[0] + a[1]) + (a[2] + a[3])) + ((b[0] + b[1]) + (b[2] + b[3])) + ((c[0] + c[1]) + (c[2] + c[3])) + ((d[0] + d[1]) + (d[2] + d[3]));
    return 1.0f / sqrtf(s * (1.0f / 1024.0f) + 1e-6f);
}
template <bool ROPE> struct EpiScale {
    static constexpr bool PERM = true, AFTER_DRAIN = false;
    bf16_t* O; int ldc; const float* ssq; const float* cs; const float* sn; float qscale;
    __device__ __forceinline__ void operator()(const f32x4 (&acc)[2][2][4][2], const Unit& u, int wr, int wc, int fr, int fq) const {
        const int row0 = u.pm * BM + wr * 64 + fr; const int col0 = u.pn * BM + wc * 32 + 8 * fq;
        const bool rope = ROPE && (u.pn < 4) && ((wc & 1) == 0);
        const float sc = (ROPE && u.pn < 2) ? qscale : 1.0f;
        float rsv[2][4];
        if constexpr (ROPE) {
#pragma unroll
            for (int ai = 0; ai < 2; ++ai)
#pragma unroll
                for (int m = 0; m < 4; ++m) rsv[ai][m] = ssq[row0 + ai * HALF + m * 16];
        } else {
#pragma unroll
            for (int ai = 0; ai < 2; ++ai) { f32x4 p[4][4];
#pragma unroll
                for (int m = 0; m < 4; ++m) { const f32x4* q = (const f32x4*)(ssq + (size_t)(row0 + ai * HALF + m * 16) * 16); p[m][0] = q[0]; p[m][1] = q[1]; p[m][2] = q[2]; p[m][3] = q[3]; }
#pragma unroll
                for (int m = 0; m < 4; ++m) { const f32x4 t = (p[m][0] + p[m][1]) + (p[m][2] + p[m][3]); rsv[ai][m] = 1.0f / sqrtf(((t[0] + t[1]) + (t[2] + t[3])) * (1.0f / 1024.0f) + 1e-6f); } }
        }
#pragma unroll
        for (int ai = 0; ai < 2; ++ai) {
            f32x4 cc0[4], cc1[4], ss0[4], ss1[4];
#pragma unroll
            for (int m = 0; m < 4; ++m) { const int r = row0 + ai * HALF + m * 16;
                cc0[m] = (f32x4){1.f, 1.f, 1.f, 1.f}; cc1[m] = cc0[m]; ss0[m] = (f32x4){0.f, 0.f, 0.f, 0.f}; ss1[m] = ss0[m];
                if (rope && fq < 2) { cc0[m] = *(const f32x4*)(cs + (size_t)r * 8); cc1[m] = *(const f32x4*)(cs + (size_t)r * 8 + 4); ss0[m] = *(const f32x4*)(sn + (size_t)r * 8); ss1[m] = *(const f32x4*)(sn + (size_t)r * 8 + 4); } }
#pragma unroll
            for (int m = 0; m < 4; ++m) {
                const int r = row0 + ai * HALF + m * 16;
                const float rs = rsv[ai][m] * sc;
                f32x4 c0 = cc0[m], c1 = cc1[m], s0 = ss0[m], s1 = ss1[m];
                if (rope && fq == 0) { s0 = -s0; s1 = -s1; }
                bf16_t* rowp = O + (size_t)r * ldc + col0;
#pragma unroll
                for (int bj = 0; bj < 2; ++bj) {
                    f32x4 v0 = acc[ai][bj][m][0] * rs, v1 = acc[ai][bj][m][1] * rs;
                    if (rope) {
                        f32x4 o0, o1;
#pragma unroll
                        for (int i = 0; i < 4; ++i) { o0[i] = xl_swz<16>(v0[i]); o1[i] = xl_swz<16>(v1[i]); }
                        v0 = v0 * c0 + o0 * s0; v1 = v1 * c1 + o1 * s1;
                    }
                    u32x4 w; w.x = cvt_pk_bf16(v0[0], v0[1]); w.y = cvt_pk_bf16(v0[2], v0[3]); w.z = cvt_pk_bf16(v1[0], v1[1]); w.w = cvt_pk_bf16(v1[2], v1[3]);
                    *(u32x4*)(rowp + bj * HALF) = w;
                }
            }
        }
    }
};
struct EpiRes {
    static constexpr bool PERM = false, AFTER_DRAIN = false;
    bf16_t* XB; float* ssq;
    __device__ __forceinline__ void operator()(const f32x4 (&acc)[2][2][4][2], const Unit& u, int wr, int wc, int fr, int fq) const {
        typedef unsigned u32x2v __attribute__((ext_vector_type(2)));
        const int col0 = u.pn * BM + wc * 32 + 4 * fq;
        u32x2v xw[2][4][2][2];
#pragma unroll
        for (int ai = 0; ai < 2; ++ai)
#pragma unroll
            for (int m = 0; m < 4; ++m) { const size_t off = (size_t)(u.pm * BM + ai * HALF + wr * 64 + m * 16 + fr) * 1024 + col0;
#pragma unroll
                for (int bj = 0; bj < 2; ++bj)
#pragma unroll
                    for (int n = 0; n < 2; ++n) xw[ai][m][bj][n] = *(const u32x2v*)(XB + off + bj * HALF + n * 16); }
#pragma unroll
        for (int ai = 0; ai < 2; ++ai)
#pragma unroll
            for (int m = 0; m < 4; ++m) {
                const int r = u.pm * BM + ai * HALF + wr * 64 + m * 16 + fr; const size_t off = (size_t)r * 1024 + col0; float ss = 0.f;
#pragma unroll
                for (int bj = 0; bj < 2; ++bj)
#pragma unroll
                    for (int n = 0; n < 2; ++n) { const size_t o = off + bj * HALF + n * 16; const u32x2v x = xw[ai][m][bj][n];
                        const f32x4 v = (f32x4){__builtin_bit_cast(float, x.x << 16), __builtin_bit_cast(float, x.x & 0xffff0000u), __builtin_bit_cast(float, x.y << 16), __builtin_bit_cast(float, x.y & 0xffff0000u)} + acc[ai][bj][m][n];
                        u32x2v w; w.x = cvt_pk_bf16(v[0], v[1]); w.y = cvt_pk_bf16(v[2], v[3]); *(u32x2v*)(XB + o) = w;
                        ss += (v[0] * v[0] + v[1] * v[1]) + (v[2] * v[2] + v[3] * v[3]); }
                ss += xl_swz<16>(ss); ss = xl_sum32(ss);
                if (fq == 0) ssq[(size_t)r * 16 + u.pn * 4 + wc] = ss;
            }
    }
};
template <class Epi, class Sched, bool ALIGN_EPI = false, bool SP2 = false>
__device__ __forceinline__ void gemm_phase(PG8_LAS unsigned char* lds, const Gemm g, const Sched& S, const Epi& E, const int tid) {
    const int wid = __builtin_amdgcn_readfirstlane(tid >> 6), lane = tid & 63, wr = wid >> 2, wc = wid & 3, fr = lane & 15, fq = lane >> 4;
    const int K = g.K, nt = K / BK;
    unsigned voffA[2], voffB[2];
#pragma unroll
    for (int i = 0; i < 2; ++i) { int R, C; stage_rc(tid * 16 + i * 8192, R, C); const int Rb = Epi::PERM ? ((R & ~31) + perm32(R & 31)) : R;
        voffA[i] = (unsigned)(R * K + C) * 2u; voffB[i] = (unsigned)(Rb * K + C) * 2u; }
    const size_t kstep = (size_t)(BK * 2);
    const size_t hstep = (size_t)HALF * K * 2;
    const size_t tstep = 2 * hstep;
    const unsigned ldsw = (unsigned)wid * 1024u;
    const int aoff = lds_byte(wr * 64 + fr, fq * 8), boff = lds_byte(wc * 32 + fr, fq * 8);
#define PG8_SA(b, h) (((b) * 2 + (h)) * HTB)
#define PG8_SB(b, h) ((4 + (b) * 2 + (h)) * HTB)
#define PG8_STAGE(bufoff, gbase, voff) do { _Pragma("unroll") for (int _i = 0; _i < 2; ++_i) \
        __builtin_amdgcn_global_load_lds((const unsigned*)((const char*)(gbase) + (voff)[_i]), (PG8_LAS unsigned*)(lds + (bufoff) + ldsw + _i * 8192), 16, 0, 0); } while (0)
#define PG8_LDA(dst, b, h) do { _Pragma("unroll") for (int m = 0; m < 4; ++m) _Pragma("unroll") for (int k = 0; k < 2; ++k) dst[m][k] = *(const PG8_LAS bf16x8*)(lds + PG8_SA(b, h) + aoff + m * 2048 + k * 1024); } while (0)
#define PG8_LDB(dst, b, h) do { _Pragma("unroll") for (int n = 0; n < 2; ++n) _Pragma("unroll") for (int k = 0; k < 2; ++k) dst[n][k] = *(const PG8_LAS bf16x8*)(lds + PG8_SB(b, h) + boff + n * 2048 + k * 1024); } while (0)
#define PG8_MMA(ai, bj, At, Bt) do { __builtin_amdgcn_s_setprio(1); _Pragma("unroll") for (int m = 0; m < 4; ++m) _Pragma("unroll") for (int n = 0; n < 2; ++n) _Pragma("unroll") for (int k = 0; k < 2; ++k) \
        acc[ai][bj][m][n] = __builtin_amdgcn_mfma_f32_16x16x32_bf16(Bt[n][k], At[m][k], acc[ai][bj][m][n], 0, 0, 0); __builtin_amdgcn_s_setprio(0); } while (0)
#define PG8_WAIT_V(n) asm volatile("s_waitcnt vmcnt(" #n ")" ::: "memory")
#define PG8_WAIT_L(n) asm volatile("s_waitcnt lgkmcnt(" #n ")" ::: "memory")
#define PG8_BAR __builtin_amdgcn_s_barrier()
#define PG8_SCHED __builtin_amdgcn_sched_barrier(0)
    Unit cur, nxt; int ui = 0;
    if (!S.next(0, cur)) return;
    f32x4 acc[2][2][4][2];
#pragma unroll
    for (int a = 0; a < 2; ++a)
#pragma unroll
        for (int b = 0; b < 2; ++b)
#pragma unroll
            for (int m = 0; m < 4; ++m)
#pragma unroll
                for (int n = 0; n < 2; ++n) acc[a][b][m][n] = (f32x4){0.f, 0.f, 0.f, 0.f};
    bf16x8 At[4][2], B0[2][2], B1[2][2];
    const char* cA = (const char*)g.A + (size_t)cur.pm * tstep; const char* cB = (const char*)g.Bt + (size_t)cur.pn * tstep;
    S.a_ready(cur);
    if constexpr (SP2) {
        PG8_STAGE(PG8_SB(0, 0), cB, voffB); PG8_STAGE(PG8_SB(0, 1), cB + hstep, voffB); PG8_STAGE(PG8_SA(0, 0), cA, voffA); PG8_STAGE(PG8_SA(0, 1), cA + hstep, voffA);
        if (wr == 1) PG8_BAR;
        PG8_WAIT_V(2); PG8_BAR;
        PG8_STAGE(PG8_SB(1, 0), cB + kstep, voffB); PG8_STAGE(PG8_SA(1, 0), cA + kstep, voffA); PG8_STAGE(PG8_SB(1, 1), cB + hstep + kstep, voffB);
        PG8_WAIT_V(6); PG8_BAR;
    } else {
        PG8_STAGE(PG8_SB(0, 0), cB, voffB); PG8_STAGE(PG8_SA(0, 0), cA, voffA); PG8_STAGE(PG8_SB(0, 1), cB + hstep, voffB); PG8_STAGE(PG8_SA(0, 1), cA + hstep, voffA);
        if (wr == 1) PG8_BAR;
        PG8_WAIT_V(4); PG8_BAR;
        PG8_STAGE(PG8_SB(1, 0), cB + kstep, voffB); PG8_STAGE(PG8_SA(1, 0), cA + kstep, voffA); PG8_STAGE(PG8_SB(1, 1), cB + hstep + kstep, voffB);
        PG8_WAIT_V(6); PG8_BAR;
    }
    for (;;) {
        const bool has_next = S.next(ui + 1, nxt);
        const char* nA = has_next ? (const char*)g.A + (size_t)nxt.pm * tstep : cA; const char* nB = has_next ? (const char*)g.Bt + (size_t)nxt.pn * tstep : cB;
        for (int t = 0; t < nt; t += 2) {
            const bool last = (t == nt - 2);
            const char* a1 = cA + (size_t)(t + 1) * kstep;
            const char* a2 = last ? nA : cA + (size_t)(t + 2) * kstep; const char* b2 = last ? nB : cB + (size_t)(t + 2) * kstep;
            const char* a3 = a2 + kstep; const char* b3 = b2 + kstep;
            if (last && has_next) S.a_ready(nxt);
            if constexpr (SP2) {
            PG8_LDB(B0, 0, 0); PG8_LDB(B1, 0, 1); PG8_SCHED; PG8_LDA(At, 0, 0); PG8_STAGE(PG8_SA(1, 1), a1 + hstep, voffA);
            PG8_WAIT_V(8); PG8_WAIT_L(0); PG8_BAR; PG8_MMA(0, 0, At, B0); PG8_MMA(0, 1, At, B1); PG8_BAR; PG8_SCHED;
            PG8_LDA(At, 0, 1); PG8_STAGE(PG8_SB(0, 0), b2, voffB); PG8_STAGE(PG8_SB(0, 1), b2 + hstep, voffB); PG8_STAGE(PG8_SA(0, 0), a2, voffA);
            PG8_WAIT_V(8); PG8_WAIT_L(0); PG8_BAR; PG8_MMA(1, 0, At, B0); PG8_MMA(1, 1, At, B1); PG8_BAR; PG8_SCHED;
            PG8_LDB(B0, 1, 0); PG8_LDB(B1, 1, 1); PG8_SCHED; PG8_LDA(At, 1, 0); PG8_STAGE(PG8_SA(0, 1), a2 + hstep, voffA);
            PG8_WAIT_V(8); PG8_WAIT_L(0); PG8_BAR; PG8_MMA(0, 0, At, B0); PG8_MMA(0, 1, At, B1); PG8_BAR; PG8_SCHED;
            PG8_LDA(At, 1, 1); PG8_STAGE(PG8_SB(1, 0), b3, voffB); PG8_STAGE(PG8_SB(1, 1), b3 + hstep, voffB); PG8_STAGE(PG8_SA(1, 0), a3, voffA);
            PG8_WAIT_V(8); PG8_WAIT_L(0); PG8_BAR; PG8_MMA(1, 0, At, B0); PG8_MMA(1, 1, At, B1); PG8_BAR; PG8_SCHED;
            } else {
            PG8_LDB(B0, 0, 0); PG8_SCHED; PG8_LDA(At, 0, 0); PG8_STAGE(PG8_SA(1, 1), a1 + hstep, voffA);
            PG8_WAIT_L(8); PG8_BAR; PG8_WAIT_L(0); PG8_MMA(0, 0, At, B0); PG8_BAR; PG8_SCHED;
            PG8_LDB(B1, 0, 1); PG8_STAGE(PG8_SB(0, 0), b2, voffB);
            PG8_BAR; PG8_WAIT_L(0); PG8_MMA(0, 1, At, B1); PG8_BAR;
            PG8_LDA(At, 0, 1); PG8_STAGE(PG8_SA(0, 0), a2, voffA);
            PG8_BAR; PG8_WAIT_L(0); PG8_MMA(1, 0, At, B0); PG8_BAR; PG8_SCHED;
            PG8_STAGE(PG8_SB(0, 1), b2 + hstep, voffB);
            PG8_WAIT_V(6); PG8_BAR; PG8_MMA(1, 1, At, B1); PG8_BAR;
            PG8_LDB(B0, 1, 0); PG8_SCHED; PG8_LDA(At, 1, 0); PG8_STAGE(PG8_SA(0, 1), a2 + hstep, voffA);
            PG8_WAIT_L(8); PG8_BAR; PG8_WAIT_L(0); PG8_MMA(0, 0, At, B0); PG8_BAR; PG8_SCHED;
            PG8_LDB(B1, 1, 1); PG8_STAGE(PG8_SB(1, 0), b3, voffB);
            PG8_BAR; PG8_WAIT_L(0); PG8_MMA(0, 1, At, B1); PG8_BAR;
            PG8_LDA(At, 1, 1); PG8_STAGE(PG8_SA(1, 0), a3, voffA);
            PG8_BAR; PG8_WAIT_L(0); PG8_MMA(1, 0, At, B0); PG8_BAR; PG8_SCHED;
            PG8_STAGE(PG8_SB(1, 1), b3 + hstep, voffB);
            PG8_WAIT_V(6); PG8_BAR; PG8_MMA(1, 1, At, B1); PG8_BAR;
            }
        }
        if constexpr (ALIGN_EPI) { if (wr == 0) PG8_BAR; }
        if constexpr (!Epi::AFTER_DRAIN) { E(acc, cur, wr, wc, fr, fq); S.done(cur); }
        if (!has_next) break;
#pragma unroll
        for (int a = 0; a < 2; ++a)
#pragma unroll
            for (int b = 0; b < 2; ++b)
#pragma unroll
                for (int m = 0; m < 4; ++m)
#pragma unroll
                    for (int n = 0; n < 2; ++n) acc[a][b][m][n] = (f32x4){0.f, 0.f, 0.f, 0.f};
        cur = nxt; cA = nA; cB = nB; ++ui;
        if constexpr (ALIGN_EPI) { if (wr == 1) PG8_BAR; }
    }
    PG8_WAIT_V(0);
    if constexpr (!ALIGN_EPI) { if (wr == 0) PG8_BAR; }
    PG8_BAR;
    if constexpr (Epi::AFTER_DRAIN) { E.fused(acc, cur, wr, wc, fr, fq, lds, wid, lane); S.done(cur); }
#undef PG8_SA
#undef PG8_SB
#undef PG8_STAGE
#undef PG8_LDA
#undef PG8_LDB
#undef PG8_MMA
#undef PG8_WAIT_V
#undef PG8_WAIT_L
#undef PG8_BAR
#undef PG8_SCHED
}
}

#ifndef PG8_SP2
#define PG8_SP2 true
#endif
#ifndef PG8_ALIGN
#define PG8_ALIGN true
#endif
#include <hip/hip_bf16.h>
#include <cmath>
namespace attn_body {
using bf16=__hip_bfloat16;
using bf16x8=__attribute__((ext_vector_type(8)))short;
using s16x4=__attribute__((ext_vector_type(4)))short;
using f32x16=__attribute__((ext_vector_type(16)))float;
using u32x4=__attribute__((ext_vector_type(4)))unsigned;
constexpr int BATCH=4,SEQ=4096,D=64,PIN=3072,POUT=1024;
constexpr int NW=8,QBLK=32,QB=QBLK*NW,KVBLK=64,NQB=SEQ/QB;
constexpr int ATTN_UNIT_ROWS=QB;
__device__ __forceinline__ int crow(int r,int hi){return (r&3)+8*(r>>2)+4*hi;}
#define SBAR() __builtin_amdgcn_sched_barrier(0)
__device__ __forceinline__ void cmask(f32x16&p0,f32x16&p1,int jb,int qrel,int hi){
  const float NEG=-INFINITY; int kb=64*jb+4*hi; asm volatile("":"+v"(kb));
  #pragma unroll
  for(int r=0;r<16;++r){int kv=kb+(r&3)+8*(r>>2); if(kv>qrel)p0[r]=NEG; if(kv+32>qrel)p1[r]=NEG;}
}

constexpr int NSLOT=3, SLOTB=8192;
constexpr int LDS_K=0, LDS_V=NSLOT*SLOTB, LDS_WS=3*NSLOT*SLOTB, LDS_OST=LDS_WS+NW*64*4, LDS_BYTES=LDS_OST+NW*4096;
constexpr float C2=0.125f*1.4426950408889634f;
__device__ __forceinline__ void glds16(const void*gsrc,unsigned lds_dst){unsigned keep;
  asm volatile("s_mov_b32 %0, m0\n\ts_mov_b32 m0, %2\n\ts_nop 0\n\tglobal_load_lds_dwordx4 %1, off\n\ts_mov_b32 m0, %0":"=&s"(keep):"v"(gsrc),"s"(lds_dst):"memory");}
__device__ __forceinline__ void glds16s(const void*sbase,unsigned voff,unsigned lds_dst){unsigned keep;
  asm volatile("s_mov_b32 %0, m0\n\ts_mov_b32 m0, %3\n\ts_nop 0\n\tglobal_load_lds_dwordx4 %1, %2\n\ts_mov_b32 m0, %0":"=&s"(keep):"v"(voff),"s"(sbase),"s"(lds_dst):"memory");}
__device__ __forceinline__ float max3f(float a,float b,float c){float r;asm("v_max3_f32 %0, %1, %2, %3":"=v"(r):"v"(a),"v"(b),"v"(c));return r;}
__device__ __forceinline__ float max2f(float a,float b){float r;asm("v_max_f32_e32 %0, %1, %2":"=v"(r):"v"(a),"v"(b));return r;}
__device__ __forceinline__ float fadd_s(float a,float b){float r;asm("v_add_f32_e32 %0, %1, %2":"=v"(r):"v"(a),"v"(b));return r;}
__device__ __forceinline__ float fsub_s(float a,float b){float r;asm("v_sub_f32_e32 %0, %1, %2":"=v"(r):"v"(a),"v"(b));return r;}
typedef float f32x2_t __attribute__((ext_vector_type(2))); typedef __bf16 bf16x2_t __attribute__((ext_vector_type(2)));
__device__ __forceinline__ unsigned cvtpk_s(float lo,float hi){f32x2_t v={lo,hi};bf16x2_t b=__builtin_convertvector(v,bf16x2_t);return __builtin_bit_cast(unsigned,b);}
#define WAIT_BAR(N) asm volatile("s_waitcnt vmcnt(" #N ") lgkmcnt(0)\n\ts_barrier":::"memory")

__device__ __forceinline__ void qkt(f32x16&p0,f32x16&p1,const char*Kslot,const bf16x8*qr,const f32x16&negm,int r32,int hi){
  const char*kb=Kslot+hi*1024+r32*16;
  #pragma unroll
  for(int d0=0;d0<4;++d0){
    const bf16x8 b0=*reinterpret_cast<const bf16x8*>(kb+d0*2048);
    const bf16x8 b1=*reinterpret_cast<const bf16x8*>(kb+d0*2048+512);
    if(d0==0){p0=__builtin_amdgcn_mfma_f32_32x32x16_bf16(b0,qr[0],negm,0,0,0);p1=__builtin_amdgcn_mfma_f32_32x32x16_bf16(b1,qr[0],negm,0,0,0);}
    else{p0=__builtin_amdgcn_mfma_f32_32x32x16_bf16(b0,qr[d0],p0,0,0,0);p1=__builtin_amdgcn_mfma_f32_32x32x16_bf16(b1,qr[d0],p1,0,0,0);}}
}
typedef __attribute__((address_space(3))) const char* lds_cptr;
typedef short v4i16_t __attribute__((ext_vector_type(4)));
__device__ __forceinline__ void kload8(bf16x8*kf,lds_cptr kp){
  kf[0]=*(const __attribute__((address_space(3))) bf16x8*)(kp);      kf[1]=*(const __attribute__((address_space(3))) bf16x8*)(kp+512);
  kf[2]=*(const __attribute__((address_space(3))) bf16x8*)(kp+2048); kf[3]=*(const __attribute__((address_space(3))) bf16x8*)(kp+2560);
  kf[4]=*(const __attribute__((address_space(3))) bf16x8*)(kp+4096); kf[5]=*(const __attribute__((address_space(3))) bf16x8*)(kp+4608);
  kf[6]=*(const __attribute__((address_space(3))) bf16x8*)(kp+6144); kf[7]=*(const __attribute__((address_space(3))) bf16x8*)(kp+6656);
}
__device__ __forceinline__ void kload2(bf16x8*kf,lds_cptr kp,int j){ kf[2*j]=*(const __attribute__((address_space(3))) bf16x8*)(kp+j*2048); kf[2*j+1]=*(const __attribute__((address_space(3))) bf16x8*)(kp+j*2048+512); }
__device__ __forceinline__ s16x4 vtr(lds_cptr p){ return __builtin_bit_cast(s16x4,__builtin_amdgcn_ds_read_tr16_b64_v4i16((__attribute__((address_space(3))) v4i16_t*)p)); }
__device__ __forceinline__ float rowmax(const f32x16&p0,const f32x16&p1){
  float a=max3f(p0[0],p0[1],p1[0]),b=max3f(p0[2],p0[3],p1[1]);a=max3f(a,p1[2],p1[3]);
  #pragma unroll
  for(int r=4;r<16;r+=4){a=max3f(a,p0[r],p0[r+1]);b=max3f(b,p0[r+2],p0[r+3]);a=max3f(a,p1[r],p1[r+1]);b=max3f(b,p1[r+2],p1[r+3]);}
  const float m=max2f(a,b);
  auto rr=__builtin_amdgcn_permlane32_swap(__float_as_uint(m),__float_as_uint(m),false,false);
  return max2f(__uint_as_float(rr[0]),__uint_as_float(rr[1]));
}
__device__ __forceinline__ void pv(f32x16*o,int vb,bf16x8 pa0,bf16x8 pa1,bf16x8 pa2,bf16x8 pa3){
  #pragma unroll
  for(int d0=0;d0<4;++d0){s16x4 lo[4],hi[4];
    #pragma unroll
    for(int ks=0;ks<4;++ks){
      asm volatile("ds_read_b64_tr_b16 %0,%1 offset:%c2":"=&v"(lo[ks]):"v"(vb),"i"(d0*4096+ks*1024):"memory");
      asm volatile("ds_read_b64_tr_b16 %0,%1 offset:%c2":"=&v"(hi[ks]):"v"(vb),"i"(d0*4096+ks*1024+512):"memory");}
    asm volatile("s_waitcnt lgkmcnt(0)":::"memory");SBAR();
    #define PK(k) (bf16x8){lo[k][0],lo[k][1],lo[k][2],lo[k][3],hi[k][0],hi[k][1],hi[k][2],hi[k][3]}
    o[d0]=__builtin_amdgcn_mfma_f32_32x32x16_bf16(pa0,PK(0),o[d0],0,0,0);
    o[d0]=__builtin_amdgcn_mfma_f32_32x32x16_bf16(pa1,PK(1),o[d0],0,0,0);
    o[d0]=__builtin_amdgcn_mfma_f32_32x32x16_bf16(pa2,PK(2),o[d0],0,0,0);
    o[d0]=__builtin_amdgcn_mfma_f32_32x32x16_bf16(pa3,PK(3),o[d0],0,0,0);
    #undef PK
  }
}

#ifndef ATTN_STORE16
#define ATTN_STORE16(p,v) (*(u32x4*)(p)=(v))
#endif
template<int THRL> __device__ __forceinline__ void attn_unit(int b,int qcol,int kcol,int vcol,int ocol,int qb,const bf16*Q,const bf16*__restrict__ K,const bf16*__restrict__ V,bf16*O,char*shm,const int tid){
  const int lane=tid&63,r32=lane&31,hi=lane>>5; const int wid=__builtin_amdgcn_readfirstlane(tid>>6);
  const long rowbase=(long)b*SEQ; const int q0=qb*QB;
  const bf16*Qw=Q+(rowbase+q0+wid*QBLK)*PIN+qcol;
  const bf16*Kh=K+rowbase*PIN+kcol,*Vh=V+rowbase*PIN+vcol;
  const unsigned lds0=(unsigned)(uintptr_t)shm;
  float*wsf=(float*)(shm+LDS_WS)+wid*64;
  const unsigned koff=(unsigned)(lane*PIN+wid*8)*2u;
  const unsigned voff=(unsigned)((16*(wid&3)+(lane>>2))*PIN+(wid>>2)*32+(lane&3)*8)*2u;
  const unsigned kdst=lds0+LDS_K+wid*1024, vdst=lds0+LDS_V+wid*1024;
  #define DMA_K(t,slot) glds16s(Kh+(long)(t)*KVBLK*PIN,koff,(unsigned)__builtin_amdgcn_readfirstlane(kdst+(slot)))
  #define DMA_V(t,slot) do{ glds16s(Vh+(long)(t)*KVBLK*PIN,voff,(unsigned)__builtin_amdgcn_readfirstlane(vdst+2*(slot))); glds16s(Vh+(long)(t)*KVBLK*PIN,voff+128u,(unsigned)__builtin_amdgcn_readfirstlane(vdst+8192+2*(slot))); }while(0)
  const int vb0=(int)(lds0+LDS_V)+((lane>>4)&1)*32+(lane&3)*8+(4*hi+((lane&15)>>2))*64;
  const char*Kbase=shm+LDS_K; bf16x8 kf[8];
  const lds_cptr shm3=(lds_cptr)shm; const lds_cptr kp0=shm3+LDS_K+hi*1024+r32*16; const lds_cptr vp0=shm3+LDS_V+((lane>>4)&1)*32+(lane&3)*8+(4*hi+((lane&15)>>2))*64;
  const int NT=(q0+QB)/KVBLK;
  DMA_K(0,0);DMA_V(0,0);DMA_K(1,SLOTB);
  bf16x8 qr[4];
  { int lq=lane; asm volatile("":"+v"(lq)); const int r32q=lq&31,hiq=lq>>5;
  _Pragma("unroll") for(int d0=0;d0<4;++d0)qr[d0]=*reinterpret_cast<const bf16x8*>(&Qw[(long)r32q*PIN+d0*16+hiq*8]); }
  const lds_cptr qst=shm3+LDS_OST+wid*4096+lane*16;
  #define QST(d0) (*(__attribute__((address_space(3))) bf16x8*)(qst+(d0)*1024))
  _Pragma("unroll") for(int d0=0;d0<4;++d0) *(__attribute__((address_space(3))) bf16x8*)((__attribute__((address_space(3))) char*)qst+d0*1024)=qr[d0];
  float mhat=0.f,l_reg=0.f;f32x16 o[4];o[0]=f32x16{};o[1]=f32x16{};o[2]=f32x16{};o[3]=f32x16{};float z0_=0.f;asm volatile("":"+v"(z0_));f32x16 negm;_Pragma("unroll") for(int r=0;r<16;++r)negm[r]=z0_;asm volatile("":"+v"(negm));
  const int qrel=wid*QBLK+r32;
  #define CMASK(P0,P1,t) do{int jb_=(t)-(NT-4); if(jb_>=0)cmask(P0,P1,jb_,qrel,hi);}while(0)
  bool resc=false;
  #define START(P0,P1) do{ const float rm=rowmax(P0,P1); resc=false; \
    { const float dl=rm; mhat=fadd_s(mhat,dl); \
      _Pragma("unroll") for(int r=0;r<16;++r){P0[r]=fsub_s(P0[r],dl);P1[r]=fsub_s(P1[r],dl);} \
      _Pragma("unroll") for(int r=0;r<16;++r)negm[r]=-mhat; asm volatile("":"+v"(negm)); } \
    _Pragma("unroll") for(int r=0;r<16;++r)P0[r]=__builtin_amdgcn_exp2f(P0[r]); }while(0)
  #define RESC() do{ if(resc){ asm volatile("s_waitcnt lgkmcnt(0)":::"memory"); \
      _Pragma("unroll") for(int d_=0;d_<4;++d_) _Pragma("unroll") for(int r=0;r<16;++r)o[d_][r]*=wsf[crow(r,hi)]; } }while(0)
  f32x16 pA0,pA1,pB0,pB1;
  int sl_prev=0,sl_cur=0,sl_next=SLOTB;
  #define ROT() do{sl_prev=sl_cur;sl_cur=sl_next;sl_next=(sl_next==(NSLOT-1)*SLOTB)?0:sl_next+SLOTB;}while(0)
  DMA_K(2,2*SLOTB);
  WAIT_BAR(3);
  qkt(pA0,pA1,Kbase,qr,negm,r32,hi);asm volatile("s_nop 15\n\ts_nop 7":"+v"(pA0),"+v"(pA1));CMASK(pA0,pA1,0);
  START(pA0,pA1);
  _Pragma("unroll") for(int r=0;r<16;++r)pA1[r]=__builtin_amdgcn_exp2f(pA1[r]);
  u32x4 pa0,pa1,pa2,pa3,pb0,pb1,pb2,pb3;
  { float s0_=pA0[0]+pA0[1]; _Pragma("unroll") for(int r=2;r<16;++r)s0_+=pA0[r]; _Pragma("unroll") for(int r=0;r<16;++r)s0_+=pA1[r]; l_reg+=s0_;
    pa0=(u32x4){cvtpk_s(pA0[0],pA0[1]),cvtpk_s(pA0[2],pA0[3]),cvtpk_s(pA0[4],pA0[5]),cvtpk_s(pA0[6],pA0[7])}; pa1=(u32x4){cvtpk_s(pA0[8],pA0[9]),cvtpk_s(pA0[10],pA0[11]),cvtpk_s(pA0[12],pA0[13]),cvtpk_s(pA0[14],pA0[15])};
    pa2=(u32x4){cvtpk_s(pA1[0],pA1[1]),cvtpk_s(pA1[2],pA1[3]),cvtpk_s(pA1[4],pA1[5]),cvtpk_s(pA1[6],pA1[7])}; pa3=(u32x4){cvtpk_s(pA1[8],pA1[9]),cvtpk_s(pA1[10],pA1[11]),cvtpk_s(pA1[12],pA1[13]),cvtpk_s(pA1[14],pA1[15])}; }
  WAIT_BAR(0);
  DMA_K(3,0);DMA_V(1,SLOTB);
  ROT();
  kload8(kf,kp0+sl_cur);
  WAIT_BAR(3);
  s16x4 vlo[4],vhi[4];
  #define PAFX(P) __builtin_bit_cast(bf16x8,P)
  #define VFRS(i) (bf16x8){vlo[i][0],vlo[i][1],vlo[i][2],vlo[i][3],vhi[i][0],vhi[i][1],vhi[i][2],vhi[i][3]}
  #define PIN(x) asm volatile("":"+v"(x))
  #define MX3(a,b,c) __builtin_fmaxf(__builtin_fmaxf((a),(b)),(c))
  #define EX(v) __builtin_amdgcn_exp2f(v)
  #define VRDF(s,id) do{ vlo[s]=vtr(vp_+(((id)>>2)*4096+((id)&3)*1024)); vhi[s]=vtr(vp_+(((id)>>2)*4096+((id)&3)*1024+512)); }while(0)
  #define GAPA(MF) do{ MF; SBAR(); }while(0)
  #define GAPAV(MF,s,id) do{ VRDF(s,id); SBAR(); MF; SBAR(); }while(0)
  #define GAPB(MF,X,B,PN,W,RD) do{ MF; X[B]=EX(X[B]); X[B+1]=EX(X[B+1]); PIN(X); sacc+=X[B]; sacc+=X[B+1]; PIN(sacc); PN[W]=cvtpk_s(X[B],X[B+1]); PIN(PN); RD; SBAR(); }while(0)
  #define KRD(G,j) do{ if(G){ kload2(kf,kp0+sl_next,j); SBAR(); } }while(0)
  #define STEP(C0,C1,PC0,PC1,PC2,PC3,PN0,PN1,PN2,PN3,t,GK,GV,GL) do{ SBAR(); \
    const lds_cptr vp_=vp0+2*sl_prev; \
    const bf16x8 q0_=QST(0),q1_=QST(1),q2_=QST(2),q3_=QST(3); SBAR(); \
    GAPA(C0=__builtin_amdgcn_mfma_f32_32x32x16_bf16(kf[0],q0_,negm,0,0,0)); \
    GAPA(C1=__builtin_amdgcn_mfma_f32_32x32x16_bf16(kf[1],q0_,negm,0,0,0)); \
    GAPA(C0=__builtin_amdgcn_mfma_f32_32x32x16_bf16(kf[2],q1_,C0,0,0,0)); \
    GAPA(C1=__builtin_amdgcn_mfma_f32_32x32x16_bf16(kf[3],q1_,C1,0,0,0)); \
    GAPAV(C0=__builtin_amdgcn_mfma_f32_32x32x16_bf16(kf[4],q2_,C0,0,0,0),0,0); \
    GAPAV(C1=__builtin_amdgcn_mfma_f32_32x32x16_bf16(kf[5],q2_,C1,0,0,0),1,4); \
    GAPAV(C0=__builtin_amdgcn_mfma_f32_32x32x16_bf16(kf[6],q3_,C0,0,0,0),2,1); \
    GAPAV(C1=__builtin_amdgcn_mfma_f32_32x32x16_bf16(kf[7],q3_,C1,0,0,0),3,5); \
    if(GK){DMA_K((t)+3,sl_cur);} if(GV){DMA_V((t)+1,sl_next);} \
    CMASK(C0,C1,t); \
    { float a=MX3(C0[0],C0[1],C1[0]),b=MX3(C0[2],C0[3],C1[1]); a=MX3(a,C1[2],C1[3]); \
      _Pragma("unroll") for(int r=4;r<16;r+=4){a=MX3(a,C0[r],C0[r+1]);b=MX3(b,C0[r+2],C0[r+3]);a=MX3(a,C1[r],C1[r+1]);b=MX3(b,C1[r+2],C1[r+3]);} \
      float rm=__builtin_fmaxf(a,b); { auto rr=__builtin_amdgcn_permlane32_swap(__float_as_uint(rm),__float_as_uint(rm),false,false); rm=__builtin_fmaxf(__uint_as_float(rr[0]),__uint_as_float(rr[1])); } \
      resc=false; \
      if(__builtin_expect(__any(rm>(float)THRL),0)){ const float dl=__builtin_fmaxf(rm,0.f); mhat+=dl; \
        _Pragma("unroll") for(int r=0;r<16;++r){C0[r]-=dl;C1[r]-=dl;} \
        _Pragma("unroll") for(int r=0;r<16;++r)negm[r]=-mhat; asm volatile("":"+v"(negm)); \
        const float f=__builtin_amdgcn_exp2f(-dl); l_reg*=f; if(hi==0)wsf[r32]=f; resc=true; } } \
    SBAR(); \
    float sacc=0.f; \
    GAPB(o[0]=__builtin_amdgcn_mfma_f32_32x32x16_bf16(PAFX(PC0),VFRS(0),o[0],0,0,0), C0,0,  PN0,0, VRDF(0,2)); \
    GAPB(o[1]=__builtin_amdgcn_mfma_f32_32x32x16_bf16(PAFX(PC0),VFRS(1),o[1],0,0,0), C0,2,  PN0,1, VRDF(1,6)); \
    KRD(GL,0); GAPB(o[0]=__builtin_amdgcn_mfma_f32_32x32x16_bf16(PAFX(PC1),VFRS(2),o[0],0,0,0), C0,4,  PN0,2, VRDF(2,3)); \
    KRD(GL,1); GAPB(o[1]=__builtin_amdgcn_mfma_f32_32x32x16_bf16(PAFX(PC1),VFRS(3),o[1],0,0,0), C0,6,  PN0,3, VRDF(3,7)); \
    KRD(GL,2); GAPB(o[0]=__builtin_amdgcn_mfma_f32_32x32x16_bf16(PAFX(PC2),VFRS(0),o[0],0,0,0), C0,8,  PN1,0, VRDF(0,8)); \
    KRD(GL,3); GAPB(o[1]=__builtin_amdgcn_mfma_f32_32x32x16_bf16(PAFX(PC2),VFRS(1),o[1],0,0,0), C0,10, PN1,1, VRDF(1,12)); \
    GAPB(o[0]=__builtin_amdgcn_mfma_f32_32x32x16_bf16(PAFX(PC3),VFRS(2),o[0],0,0,0), C0,12, PN1,2, VRDF(2,9)); \
    GAPB(o[1]=__builtin_amdgcn_mfma_f32_32x32x16_bf16(PAFX(PC3),VFRS(3),o[1],0,0,0), C0,14, PN1,3, VRDF(3,13)); \
    GAPB(o[2]=__builtin_amdgcn_mfma_f32_32x32x16_bf16(PAFX(PC0),VFRS(0),o[2],0,0,0), C1,0,  PN2,0, VRDF(0,10)); \
    GAPB(o[3]=__builtin_amdgcn_mfma_f32_32x32x16_bf16(PAFX(PC0),VFRS(1),o[3],0,0,0), C1,2,  PN2,1, VRDF(1,14)); \
    GAPB(o[2]=__builtin_amdgcn_mfma_f32_32x32x16_bf16(PAFX(PC1),VFRS(2),o[2],0,0,0), C1,4,  PN2,2, VRDF(2,11)); \
    GAPB(o[3]=__builtin_amdgcn_mfma_f32_32x32x16_bf16(PAFX(PC1),VFRS(3),o[3],0,0,0), C1,6,  PN2,3, VRDF(3,15)); \
    GAPB(o[2]=__builtin_amdgcn_mfma_f32_32x32x16_bf16(PAFX(PC2),VFRS(0),o[2],0,0,0), C1,8,  PN3,0, (void)0); \
    GAPB(o[3]=__builtin_amdgcn_mfma_f32_32x32x16_bf16(PAFX(PC2),VFRS(1),o[3],0,0,0), C1,10, PN3,1, (void)0); \
    GAPB(o[2]=__builtin_amdgcn_mfma_f32_32x32x16_bf16(PAFX(PC3),VFRS(2),o[2],0,0,0), C1,12, PN3,2, (void)0); \
    GAPB(o[3]=__builtin_amdgcn_mfma_f32_32x32x16_bf16(PAFX(PC3),VFRS(3),o[3],0,0,0), C1,14, PN3,3, (void)0); \
    l_reg+=sacc; \
    }while(0)
  #define STEP_AB(C0,C1,t,GK,GV,GL) STEP(C0,C1,pa0,pa1,pa2,pa3,pb0,pb1,pb2,pb3,t,GK,GV,GL)
  #define STEP_BA(C0,C1,t,GK,GV,GL) STEP(C0,C1,pb0,pb1,pb2,pb3,pa0,pa1,pa2,pa3,t,GK,GV,GL)
  int t=1;
  #undef CMASK
  #define CMASK(P0,P1,t) do{}while(0)
  for(;t+5<NT;t+=2){
    STEP_AB(pB0,pB1,t,true,true,true);     WAIT_BAR(3); RESC(); ROT();
    STEP_BA(pA0,pA1,t+1,true,true,true);   WAIT_BAR(3); RESC(); ROT();
  }
  #undef CMASK
  #define CMASK(P0,P1,t) do{int jb_=(t)-(NT-4); if(jb_>=0)cmask(P0,P1,jb_,qrel,hi);}while(0)
  #define ENDW(tt) do{ if((tt)+3<NT){WAIT_BAR(3);} else if((tt)+2<NT){WAIT_BAR(2);} else {WAIT_BAR(0);} }while(0)
  for(;t+1<NT;t+=2){
    STEP_AB(pB0,pB1,t,(t+3<NT),(t+1<NT),(t+1<NT));       ENDW(t);   RESC(); ROT();
    STEP_BA(pA0,pA1,t+1,(t+4<NT),(t+2<NT),(t+2<NT));     ENDW(t+1); RESC(); ROT();
  }
  STEP_AB(pB0,pB1,NT-1,false,false,false); RESC();
  { SBAR(); pv(o,vb0+2*sl_cur,PAFX(pb0),PAFX(pb1),PAFX(pb2),PAFX(pb3)); }
  #undef QST
  #undef PAFX
  #undef VFRS
  #undef PIN
  #undef MX3
  #undef GAPA
  #undef GAPAV
  #undef GAPB
  #undef EX
  #undef VRDF
  #undef KRD
  #undef STEP
  #undef STEP_AB
  #undef STEP_BA
  #undef ENDW
  {auto rr=__builtin_amdgcn_permlane32_swap(__float_as_uint(l_reg),__float_as_uint(l_reg),false,false);l_reg=__uint_as_float(rr[0])+__uint_as_float(rr[1]);}
  { int le=lane; asm volatile("":"+v"(le)); const int r32e=le&31,hie=le>>5;
  if(hie==0)wsf[32+r32e]=l_reg;asm volatile("s_waitcnt lgkmcnt(0)":::"memory");
  float rli[16];
  #pragma unroll
  for(int r=0;r<16;++r)rli[r]=__builtin_amdgcn_rcpf(wsf[32+crow(r,hie)]);
  bf16*Ow=O+(rowbase+q0+wid*QBLK)*POUT+ocol;
  { bf16*stg=(bf16*)(shm+LDS_OST)+wid*2048;
    #pragma unroll
    for(int hf=0;hf<2;++hf){
    #pragma unroll
    for(int r=0;r<16;++r){const int orow=crow(r,hie);
      #pragma unroll
      for(int d0=0;d0<2;++d0)stg[orow*64+d0*32+r32e]=__float2bfloat16(o[2*hf+d0][r]*rli[r]);}
    asm volatile("s_waitcnt lgkmcnt(0)":::"memory");
    #pragma unroll
    for(int i=0;i<4;++i){const int row=i*8+(le>>3),ch=le&7; const u32x4 v=*(const u32x4*)(stg+row*64+ch*8); ATTN_STORE16(Ow+(long)row*POUT+hf*64+ch*8,v);}
    asm volatile("s_waitcnt lgkmcnt(0)":::"memory"); } } }
  asm volatile("s_waitcnt lgkmcnt(0)\n\ts_barrier":::"memory");
  #undef DMA_K
  #undef DMA_V
  #undef CMASK
  #undef START
  #undef RESC
  #undef ROT
}
constexpr int ATTN_LDS_BYTES=LDS_BYTES;
struct AttnUnit { int bh; int qb; };
struct StaticOrder {
  int vcu;
  __device__ __forceinline__ explicit StaticOrder(int v):vcu(v){}
  __device__ __forceinline__ bool next(int i,AttnUnit&u)const{ if(i>=2)return false; const int s=vcu&7; u.bh=vcu>>3; u.qb=(i==0)?s:15-s; return true; }
};
template<class Sched,int THRL=8> __device__ __forceinline__ void attn_phase(char*lds,const bf16*P,bf16*O,const Sched&S,const int tid){
  AttnUnit u;
  for(int i=0;S.next(i,u);++i){ const int b=u.bh>>3, h=(u.bh>>1)&3, m=u.bh&1;
    attn_unit<THRL>(b, h*128+m*64, 512+h*128+m*64, 1024+h*128, m*512+h*128, u.qb, P, P, P, O, lds, tid); }
}
#undef SBAR
#undef WAIT_BAR
}
#define GAS __attribute__((address_space(1)))
#define LAS __attribute__((address_space(3)))
typedef unsigned short bf16;
typedef unsigned v4u __attribute__((ext_vector_type(4)));
typedef float f32x4 __attribute__((ext_vector_type(4)));
typedef short bf16x8 __attribute__((ext_vector_type(8)));
typedef GAS unsigned gu32;
typedef GAS unsigned long long gu64;
#define RLX_AGENT __ATOMIC_RELAXED, __HIP_MEMORY_SCOPE_AGENT
#define LDS_WAIT() asm volatile("s_waitcnt lgkmcnt(0)" ::: "memory")
#define VM_WAIT() asm volatile("s_waitcnt vmcnt(0)" ::: "memory")
__device__ __forceinline__ unsigned long long rt() { return __builtin_amdgcn_s_memrealtime(); }
__device__ __forceinline__ unsigned f2bf(float f) { unsigned u = __builtin_bit_cast(unsigned, f); return (u + 0x7fffu + ((u >> 16) & 1u)) >> 16; }
__device__ __forceinline__ unsigned pk2(float lo, float hi) { return f2bf(lo) | (f2bf(hi) << 16); }

#define XB_TMO      128
#define XB_XCNT(j)  (256  + 64 * (j))
#define XB_XSUB(j)  (1280 + 64 * (j))
#define XB_XGEN(j)  (2304 + 64 * (j))
#define XB_TOP      3328
#define XB_TOPGEN   3392
#define XCD_BAR_WORDS 3456
#define XB_SPIN_CAP (1u << 22)

__device__ __forceinline__ unsigned xb_ld(unsigned* p)              { return __hip_atomic_load(p, __ATOMIC_RELAXED, __HIP_MEMORY_SCOPE_AGENT); }
__device__ __forceinline__ unsigned xb_add(unsigned* p, unsigned v) { return __hip_atomic_fetch_add(p, v, __ATOMIC_RELAXED, __HIP_MEMORY_SCOPE_AGENT); }
__device__ __forceinline__ unsigned xb_xcc_id() { return (unsigned)__builtin_amdgcn_s_getreg((3 << 11) | 20) & 0xFu; }
#define XB_SPIN(cond, bar) do { unsigned _sp = 0; while (cond) { __builtin_amdgcn_s_sleep(1); \
    if ((++_sp & 255u) == 0u) { if (xb_ld(&(bar)[XB_TMO])) break; if (_sp > XB_SPIN_CAP) { atomicAdd(&(bar)[XB_TMO], 1u); break; } } } } while (0)

struct XcdBarrier {
    unsigned* bar; unsigned x;
    volatile LAS unsigned* st;
};

__device__ __forceinline__ XcdBarrier xcd_barrier_post(unsigned* bar, volatile LAS unsigned* st) {
    XcdBarrier b; b.bar = bar; b.x = xb_xcc_id(); b.st = st;
    if (threadIdx.x == 0) (void)xb_add(&bar[XB_XCNT(b.x)], 1u);
    return b;
}
__device__ __forceinline__ void xcd_barrier_complete(unsigned* bar, unsigned x, unsigned& nloc, unsigned& nx) {
    const unsigned G = gridDim.x * gridDim.y * gridDim.z;
    unsigned sum, cnt, mine, sp = 0u;
    for (;;) {
        sum = 0u; cnt = 0u; mine = 0u;
#pragma unroll
        for (unsigned j = 0; j < 16; ++j) { const unsigned c = xb_ld(&bar[XB_XCNT(j)]); sum += c; cnt += (c > 0u) ? 1u : 0u; mine = (j == x) ? c : mine; }
        if (sum == G) break;
        __builtin_amdgcn_s_sleep(1);
        if ((++sp & 255u) == 0u) { if (xb_ld(&bar[XB_TMO])) break; if (sp > XB_SPIN_CAP) { atomicAdd(&bar[XB_TMO], 1u); break; } }
    }
    nloc = mine > 0u ? mine : 1u; nx = cnt > 0u ? cnt : 1u;
}

__device__ __forceinline__ void xcd_barrier(const XcdBarrier& b, const bool leader  ) {
    asm volatile("s_waitcnt vmcnt(0)" ::: "memory");
    __syncthreads();
    if (leader) {
        unsigned* bar = b.bar;
        __builtin_amdgcn_s_waitcnt(0);
        unsigned nloc = b.st[0], nx = b.st[1];
        if (nloc == 0u) { xcd_barrier_complete(bar, b.x, nloc, nx); b.st[0] = nloc; b.st[1] = nx; }
        const unsigned old = xb_add(&bar[XB_XSUB(b.x)], 1u);
        const unsigned gen = old / nloc;
        if (old + 1u == (gen + 1u) * nloc) {
            __builtin_amdgcn_fence(__ATOMIC_RELEASE, "agent");
            asm volatile("s_waitcnt vmcnt(0)" ::: "memory");
            const unsigned og = xb_add(&bar[XB_TOP], 1u);
            const unsigned tg = og / nx;
            if (og + 1u == (tg + 1u) * nx) xb_add(&bar[XB_TOPGEN], 1u);
            else XB_SPIN(xb_ld(&bar[XB_TOPGEN]) == tg, bar);
            __builtin_amdgcn_fence(__ATOMIC_ACQUIRE, "agent");
            xb_add(&bar[XB_XGEN(b.x)], 1u);
            asm volatile("s_waitcnt vmcnt(0)" ::: "memory");
        } else {
            XB_SPIN(xb_ld(&bar[XB_XGEN(b.x)]) == gen, bar);
            __builtin_amdgcn_fence(__ATOMIC_ACQUIRE, "agent");
            asm volatile("s_waitcnt vmcnt(0)" ::: "memory");
        }
    }
    __syncthreads();
}

constexpr int NWAVES = 8;
constexpr int M = 16384, DM = 1024, SEQL = 4096, NPROJ = 3072, NIN = 3088, NQ = 2048, NLAYER = 2;
constexpr int C_Q = 0, C_K = 512, C_V = 1024, C_SB = 1536, C_SC = 1792, C_SH = 2048, C_GQ = 2304, C_GK = 2432, C_GV = 2560, C_GR = 2816;
constexpr float EPS = 1e-6f;
constexpr float ATT_C2 = 0.125f * 1.4426950408889634f;

constexpr size_t MiB = 1u << 20;
constexpr size_t WS_CTL = 0, CTL_ZERO_BYTES = 1 * MiB;
constexpr size_t WS_WIN = 1 * MiB, WIN_STRIDE = 7 * MiB;
constexpr size_t WS_WOUT = 15 * MiB, WOUT_STRIDE = 2 * MiB;
constexpr size_t WS_WQ = 19 * MiB, WQ_STRIDE = 4 * MiB;
constexpr size_t WS_KEYS = 27 * MiB, KEYS_STRIDE = 65536;
constexpr size_t WS_COS = 28 * MiB, WS_SIN = 28 * MiB + 512 * 1024;
constexpr size_t WS_SSQ = 29 * MiB;
constexpr size_t WS_GD = 30 * MiB;
constexpr size_t WS_LAM = 30 * MiB + 512 * 1024;
constexpr size_t WS_PAR = 30 * MiB + 768 * 1024;
constexpr int PAR_DN = 0, PAR_CW = 256, PAR_WG2 = 1792, PAR_BG = 5888, PAR_GN = 6144, PAR_NF = 6272, PAR_N = 7296;
constexpr size_t WS_GU = 31 * MiB;
constexpr size_t WS_GB = 39 * MiB;
constexpr size_t WS_EXP = 47 * MiB;
constexpr size_t WS_GATE = 55 * MiB;
constexpr size_t WS_TAB = 64 * MiB, TAB_STRIDE = 32 * MiB;
constexpr size_t WS_SU = 56 * MiB + 512 * 1024 * 0 + 7 * MiB, WS_SV = WS_SU + 256 * 1024;
constexpr size_t WS_RS1 = 63 * MiB + 512 * 1024;
constexpr size_t WS_XB = 192 * MiB;
constexpr size_t WS_PROJ = 224 * MiB;
constexpr size_t WS_OATT = 320 * MiB;
constexpr size_t WS_MIXED = 352 * MiB;
constexpr size_t WS_QP = 384 * MiB;
constexpr size_t WS_END = 448 * MiB;
constexpr int CW_TMO = 0, CW_BAR = 4096;

constexpr int RING_OFF = 0, RING_BYTES = 131072;
constexpr int LDSCTL_OFF = RING_BYTES, MISC_OFF = LDSCTL_OFF + 320;
constexpr int LDS_BYTES = 147456;

struct Frame {
    LAS unsigned char* lds;
    volatile LAS unsigned* MISC;
    int tid, lane, wave;
    int vcu, G, bx;
    float* out; unsigned char* ws;
};
__device__ __forceinline__ float wave_sum(float v) { return xl_wave_sum(v); }
__device__ __forceinline__ float bflo(unsigned w) { return __builtin_bit_cast(float, w << 16); }
__device__ __forceinline__ float bfhi(unsigned w) { return __builtin_bit_cast(float, w & 0xffff0000u); }
__device__ __forceinline__ float bf1(bf16 h) { return __builtin_bit_cast(float, (unsigned)h << 16); }

__device__ __forceinline__ void p0_transpose_item(const float* W, int ldw, int N, const float* gain, bf16* WT, int K, LAS float* scr, int item, int lane) {
    const int nblk = (N + 31) / 32, kb = item / nblk, nb = item % nblk, k0 = 64 * kb, n0 = 32 * nb;
    const int nn = n0 + (lane & 31);
    float wv[32];
#pragma unroll
    for (int i = 0; i < 32; ++i) { const int kk = 2 * i + (lane >> 5); wv[i] = (nn < N) ? W[(size_t)(k0 + kk) * ldw + nn] : 0.f; }
#pragma unroll
    for (int i = 0; i < 32; ++i) { const int kk = 2 * i + (lane >> 5); float w = wv[i]; if (gain) w *= gain[k0 + kk]; scr[kk * 33 + (lane & 31)] = w; }
    LDS_WAIT(); asm volatile("" ::: "memory");
    const int c = lane & 7;
#pragma unroll
    for (int j = 0; j < 4; ++j) { const int n = (lane >> 3) + 8 * j; const LAS float* s = scr + (8 * c) * 33 + n;
        v4u o; o.x = pk2(s[0 * 33], s[1 * 33]); o.y = pk2(s[2 * 33], s[3 * 33]); o.z = pk2(s[4 * 33], s[5 * 33]); o.w = pk2(s[6 * 33], s[7 * 33]);
        if (n0 + n < N) *(GAS v4u*)(WT + (size_t)(n0 + n) * K + k0 + 8 * c) = o; }
    LDS_WAIT(); asm volatile("" ::: "memory");
}
struct Args;
template <class A> __device__ __forceinline__ void p0_prologue(Frame& F, const A& args) {
    const float* const* in_ = nullptr; (void)in_;
    LAS float* scr = (LAS float*)(F.lds + RING_OFF + F.wave * 16384);
    const int gw = F.vcu * NWAVES + F.wave, NGW = F.G * NWAVES;
    const int gt = F.vcu * (NWAVES * 64) + F.tid, NGT = F.G * NWAVES * 64;
    constexpr int I_IN = 16 * 97, I_OUT = 16 * 32, I_Q = 16 * 64, I_L = I_IN + I_OUT + I_Q;
    for (int it = gw; it < NLAYER * I_L; it += NGW) {
        const int l = it / I_L; int r = it % I_L;
        if (r < I_IN) { p0_transpose_item(args.in[3] + (size_t)l * DM * NIN, NIN, NIN, args.in[2] + l * DM, (bf16*)(F.ws + WS_WIN + l * WIN_STRIDE), DM, scr, r, F.lane); continue; } r -= I_IN;
        if (r < I_OUT) { p0_transpose_item(args.in[13] + (size_t)l * DM * DM, DM, DM, nullptr, (bf16*)(F.ws + WS_WOUT + l * WOUT_STRIDE), DM, scr, r, F.lane); continue; } r -= I_OUT;
        p0_transpose_item(args.in[15] + (size_t)l * DM * NQ, NQ, NQ, args.in[14] + l * DM, (bf16*)(F.ws + WS_WQ + l * WQ_STRIDE), DM, scr, r, F.lane);
    }
    for (int i = gt; i < NLAYER * 2 * 16384; i += NGT) { const int l = i >> 15, hf = (i >> 14) & 1, e = i & 16383;
        ((bf16*)(F.ws + WS_KEYS + l * KEYS_STRIDE))[hf * 16384 + e] = (bf16)f2bf((hf ? args.in[17] : args.in[16])[(size_t)l * 16384 + e]); }
    for (int row0 = gw; row0 < NLAYER * 2 * 16384; row0 += 4 * NGW) {
        f32x4 v[4][4]; float mx[4] = {0.f, 0.f, 0.f, 0.f};
#pragma unroll
        for (int u = 0; u < 4; ++u) { const int row = (row0 + u * NGW < NLAYER * 2 * 16384) ? row0 + u * NGW : row0; const int l = row >> 15, tab = (row >> 14) & 1, e = row & 16383;
            const f32x4* src = (const f32x4*)((tab ? args.in[19] : args.in[18]) + (size_t)l * 16777216 + (size_t)e * DM) + F.lane;
#pragma unroll
            for (int j = 0; j < 4; ++j) v[u][j] = __builtin_nontemporal_load(src + 64 * j); }
#pragma unroll
        for (int u = 0; u < 4; ++u) { const int row = row0 + u * NGW; const int l = row >> 15, tab = (row >> 14) & 1, e = row & 16383;
            if (row < NLAYER * 2 * 16384) {
#pragma unroll
            for (int j = 0; j < 4; ++j) { if (tab == 0) v[u][j] = v[u][j] * ((const f32x4*)(args.in[14] + l * DM))[F.lane + 64 * j];
                mx[u] = fmaxf(mx[u], fmaxf(fmaxf(fabsf(v[u][j][0]), fabsf(v[u][j][1])), fmaxf(fabsf(v[u][j][2]), fabsf(v[u][j][3])))); }
            float m_ = mx[u];
            m_ = fmaxf(m_, xl_swz<1>(m_)); m_ = fmaxf(m_, xl_swz<2>(m_)); m_ = fmaxf(m_, xl_swz<4>(m_)); m_ = fmaxf(m_, xl_swz<8>(m_)); m_ = fmaxf(m_, xl_swz<16>(m_));
            m_ = fmaxf(m_, __builtin_bit_cast(float, xl_xor32_i(__builtin_bit_cast(int, m_), F.lane >> 5)));
            unsigned* dst = (unsigned*)(F.ws + WS_TAB + l * TAB_STRIDE + (size_t)e * 2048 + (tab ? 1024 : 0)) + F.lane;
            if (tab) {
                int k = (int)floorf(log2f(224.0f / fmaxf(m_, 1e-30f))); k = k < -60 ? -60 : (k > 60 ? 60 : k);
                const float sc = ldexpf(1.0f, k);
#pragma unroll
                for (int j = 0; j < 4; ++j) { int p = __builtin_amdgcn_cvt_pk_fp8_f32(v[u][j][0] * sc, v[u][j][1] * sc, 0, false); p = __builtin_amdgcn_cvt_pk_fp8_f32(v[u][j][2] * sc, v[u][j][3] * sc, p, true); dst[64 * j] = (unsigned)p; }
                if (F.lane == 0) ((float*)(F.ws + WS_SV))[l * 16384 + e] = ldexpf(1.0f, -k);
            } else {
                const float sc = m_ > 0.f ? 127.0f / m_ : 0.f;
#pragma unroll
                for (int j = 0; j < 4; ++j) { const int q0 = (int)rintf(v[u][j][0] * sc), q1 = (int)rintf(v[u][j][1] * sc), q2 = (int)rintf(v[u][j][2] * sc), q3 = (int)rintf(v[u][j][3] * sc);
                    dst[64 * j] = (unsigned)(q0 & 255) | ((unsigned)(q1 & 255) << 8) | ((unsigned)(q2 & 255) << 16) | ((unsigned)(q3 & 255) << 24); }
                if (F.lane == 0) ((float*)(F.ws + WS_SU))[l * 16384 + e] = m_ * (1.0f / 127.0f);
            } } }
    }
    for (int m0 = gw; m0 < M; m0 += 4 * NGW) {
        f32x4 v[4][4];
#pragma unroll
        for (int u = 0; u < 4; ++u) { const int m = m0 + u * NGW; const f32x4* xr = (const f32x4*)(args.in[0] + (size_t)(m < M ? m : m0) * DM) + F.lane;
#pragma unroll
            for (int j = 0; j < 4; ++j) v[u][j] = __builtin_nontemporal_load(xr + 64 * j); }
#pragma unroll
        for (int u = 0; u < 4; ++u) { const int m = m0 + u * NGW; if (m < M) {
            unsigned long long* o8 = (unsigned long long*)((bf16*)(F.ws + WS_XB) + (size_t)m * DM) + F.lane; float s = 0.f;
#pragma unroll
            for (int j = 0; j < 4; ++j) { const f32x4 w = v[u][j]; s += (w[0] * w[0] + w[1] * w[1]) + (w[2] * w[2] + w[3] * w[3]);
                o8[64 * j] = (unsigned long long)pk2(w[0], w[1]) | ((unsigned long long)pk2(w[2], w[3]) << 32); }
            s = wave_sum(s);
            if (F.lane == 0) ((float*)(F.ws + WS_RS1))[m] = 1.0f / sqrtf(s * (1.0f / 1024.0f) + EPS); } }
    }
    for (int i = gt; i < M * 8; i += NGT) { const int m = i >> 3, j = i & 7; const double inv = pow(500000.0, -(double)j / 8.0); const double ang = (double)((const int*)args.in[1])[m] * inv;
        ((float*)(F.ws + WS_COS))[i] = (float)cos(ang); ((float*)(F.ws + WS_SIN))[i] = (float)sin(ang); }
    if (gt < NLAYER) { const int l = gt; float a = 0.f, b = 0.f;
        for (int i = 0; i < 64; ++i) { a += args.in[4][l * 64 + i] * args.in[5][l * 64 + i]; b += args.in[6][l * 64 + i] * args.in[7][l * 64 + i]; }
        const float lam_init = 0.8f - 0.6f * expf(-0.3f * (float)l);
        ((float*)(F.ws + WS_LAM))[l * 2] = expf(a) - expf(b) + lam_init; ((float*)(F.ws + WS_LAM))[l * 2 + 1] = 1.0f - lam_init; }
    { float* par = (float*)(F.ws + WS_PAR);
      for (int i = gt; i < PAR_N; i += NGT) { float v;
          if (i < PAR_CW) v = args.in[8][i]; else if (i < PAR_WG2) v = args.in[9][i - PAR_CW]; else if (i < PAR_BG) v = args.in[10][i - PAR_WG2]; else if (i < PAR_GN) v = args.in[11][i - PAR_BG];
          else if (i < PAR_NF) v = args.in[12][i - PAR_GN]; else v = args.in[20][i - PAR_NF];
          par[i] = v; } }
}

__device__ __forceinline__ float log_sigmoid(float x) { return fminf(x, 0.f) - __logf(1.0f + __expf(-fabsf(x))); }
template <int K> __device__ __forceinline__ void lds_mm_2x4(float (&acc)[2][4], const LAS float* X, int ldx, const LAS float* Y, int ldy) {
#pragma unroll 4
    for (int k = 0; k < K; k += 4) {
        const f32x4 x0 = *(const LAS f32x4*)(X + k), x1 = *(const LAS f32x4*)(X + ldx + k);
#pragma unroll
        for (int kk = 0; kk < 4; ++kk) { const f32x4 y = *(const LAS f32x4*)(Y + (k + kk) * ldy);
#pragma unroll
            for (int b = 0; b < 4; ++b) { acc[0][b] += x0[kk] * y[b]; acc[1][b] += x1[kk] * y[b]; } }
    }
}
typedef float f32x16g __attribute__((ext_vector_type(16)));
__device__ __forceinline__ int gla_crow(int r, int hh) { return (r & 3) + 8 * (r >> 2) + 4 * hh; }
__device__ __forceinline__ void gla_stage_vt(LAS bf16* VT, const bf16* PROJ, int t0, int tid) {
#pragma unroll
    for (int it = tid; it < 2048; it += 512) { const int eg = it >> 6, t = it & 63; const v4u w = *(const v4u*)(PROJ + (size_t)(t0 + t) * NPROJ + C_GV + eg * 8);
        LAS bf16* p = VT + (eg * 8) * 72 + t;
        p[0] = (bf16)(w.x & 0xffffu); p[72] = (bf16)(w.x >> 16); p[144] = (bf16)(w.y & 0xffffu); p[216] = (bf16)(w.y >> 16);
        p[288] = (bf16)(w.z & 0xffffu); p[360] = (bf16)(w.z >> 16); p[432] = (bf16)(w.w & 0xffffu); p[504] = (bf16)(w.w >> 16); }
}
__device__ __forceinline__ void gla_prep(Frame& F, int l, int ci, int stop_after = 0) {
    typedef float f32x4m __attribute__((ext_vector_type(4)));
    LAS float* LR = (LAS float*)(F.lds + RING_OFF);
    LAS bf16* KHT = (LAS bf16*)(LR + 2 * 64 * 17);
    LAS bf16* VT = KHT + 128 * 72;
    LAS float* W2s = (LAS float*)(VT + 256 * 72);
    const int t0 = ci * 64, tid = F.tid, lane = F.lane, wave = F.wave, r32 = lane & 31, hh = lane >> 5;
    const bf16* XB = (const bf16*)(F.ws + WS_XB); const bf16* PROJ = (const bf16*)(F.ws + WS_PROJ);
    const bf16* Wlr = (const bf16*)(F.ws + WS_WIN + l * WIN_STRIDE) + (size_t)NPROJ * DM;
    v4u kw0, kw1; float rs;
    {
        const int mt = wave & 3, kh = wave >> 2, fr = lane & 15, fq = lane >> 4;
        f32x4m acc = (f32x4m){0.f, 0.f, 0.f, 0.f};
        const bf16* ap = XB + (size_t)(t0 + mt * 16 + fr) * DM + kh * 512 + fq * 8; const bf16* bp = Wlr + (size_t)fr * DM + kh * 512 + fq * 8;
        bf16x8 av[16], bv[16];
#pragma unroll
        for (int ks = 0; ks < 16; ++ks) { av[ks] = *(const bf16x8*)(ap + ks * 32); bv[ks] = *(const bf16x8*)(bp + ks * 32); }
        gla_stage_vt(VT, PROJ, t0, tid);
        { const float* W2g = (const float*)(F.ws + WS_PAR) + PAR_WG2 + l * 16 * 128; const float* bgg = (const float*)(F.ws + WS_PAR) + PAR_BG + l * 128;
#pragma unroll
          for (int q = 0; q < 4; ++q) W2s[tid + 512 * q] = W2g[tid + 512 * q];
          if (tid < 128) W2s[2048 + tid] = bgg[tid]; }
        { const bf16* kp = PROJ + (size_t)(t0 + lane) * NPROJ + C_GK + 16 * wave; kw0 = *(const v4u*)kp; kw1 = *(const v4u*)(kp + 8); rs = ((const float*)(F.ws + WS_RS1))[t0 + lane]; }
#pragma unroll
        for (int ks = 0; ks < 16; ++ks) acc = __builtin_amdgcn_mfma_f32_16x16x32_bf16(av[ks], bv[ks], acc, 0, 0, 0);
#pragma unroll
        for (int i = 0; i < 4; ++i) LR[kh * (64 * 17) + (mt * 16 + fq * 4 + i) * 17 + fr] = acc[i];
    }
    __syncthreads();
    if (stop_after == 1) return;
    {
        const int d0 = 16 * wave, t = lane;
        float lr[16];
#pragma unroll
        for (int r = 0; r < 16; ++r) lr[r] = (LR[t * 17 + r] + LR[64 * 17 + t * 17 + r]) * rs;
        const LAS float* W2 = W2s + d0; const LAS float* bg = W2s + 2048 + d0;
        float bb[16];
#pragma unroll
        for (int dd = 0; dd < 16; ++dd) { float x = bg[dd];
#pragma unroll
            for (int r = 0; r < 16; ++r) x += lr[r] * W2[r * 128 + dd];
            bb[dd] = log_sigmoid(x) * (1.0f / 16.0f); }
#pragma unroll
        for (int off = 1; off < 64; off <<= 1) { const int src = ((lane - off) & 63) << 2;
#pragma unroll
            for (int dd = 0; dd < 16; ++dd) { const float o = __builtin_bit_cast(float, __builtin_amdgcn_ds_bpermute(src, __builtin_bit_cast(int, bb[dd]))); bb[dd] += (lane >= off) ? o : 0.f; } }
        float* GB = (float*)(F.ws + WS_GB) + (size_t)(t0 + t) * 128 + d0;
#pragma unroll
        for (int q = 0; q < 4; ++q) *(f32x4*)(GB + 4 * q) = (f32x4){bb[4 * q], bb[4 * q + 1], bb[4 * q + 2], bb[4 * q + 3]};
        const unsigned kw[8] = {kw0.x, kw0.y, kw0.z, kw0.w, kw1.x, kw1.y, kw1.z, kw1.w};
        float dc[16];
#pragma unroll
        for (int dd = 0; dd < 16; ++dd) { const float bl = __builtin_bit_cast(float, __builtin_amdgcn_readlane(__builtin_bit_cast(int, bb[dd]), 63)); dc[dd] = expf(bl);
            const float kv = (dd & 1) ? bfhi(kw[dd >> 1]) : bflo(kw[dd >> 1]); KHT[(d0 + dd) * 72 + t] = (bf16)f2bf(kv * expf(bl - bb[dd])); }
        if (lane == 0) { float* GD = (float*)(F.ws + WS_GD) + ci * 128 + d0;
#pragma unroll
            for (int q = 0; q < 4; ++q) *(f32x4*)(GD + 4 * q) = (f32x4){dc[4 * q], dc[4 * q + 1], dc[4 * q + 2], dc[4 * q + 3]}; }
    }
    __syncthreads();
    if (stop_after == 2) return;
    {
        const int h = wave >> 1, eb = wave & 1; f32x16g U = {};
#pragma unroll
        for (int ks = 0; ks < 4; ++ks) { const bf16x8 ka = *(const LAS bf16x8*)(KHT + (h * 32 + r32) * 72 + ks * 16 + 8 * hh); const bf16x8 vb = *(const LAS bf16x8*)(VT + (h * 64 + eb * 32 + r32) * 72 + ks * 16 + 8 * hh);
            U = __builtin_amdgcn_mfma_f32_32x32x16_bf16(ka, vb, U, 0, 0, 0); }
        float* GU = (float*)(F.ws + WS_GU) + (size_t)(ci * 4 + h) * 2048 + eb * 32 + r32;
#pragma unroll
        for (int r = 0; r < 16; ++r) GU[gla_crow(r, hh) * 64] = U[r];
    }
    __syncthreads();
}
__device__ __forceinline__ void gla_scan(Frame& F) {
    if (F.tid < 128) { const int gid = F.vcu * 128 + F.tid;
        if (gid < 32768) { const int b = gid >> 13, h = (gid >> 11) & 3, d = (gid >> 6) & 31, e = gid & 63; float s = 0.f;
            float* GU = (float*)(F.ws + WS_GU); const float* GD = (const float*)(F.ws + WS_GD);
            for (int c0 = 0; c0 < 64; c0 += 16) { float u[16], dc[16];
#pragma unroll
                for (int i = 0; i < 16; ++i) { const int ci = b * 64 + c0 + i; u[i] = GU[((size_t)(ci * 4 + h) * 32 + d) * 64 + e]; dc[i] = GD[ci * 128 + h * 32 + d]; }
#pragma unroll
                for (int i = 0; i < 16; ++i) { const int ci = b * 64 + c0 + i; GU[((size_t)(ci * 4 + h) * 32 + d) * 64 + e] = s; s = dc[i] * s + u[i]; } } } }
}
__device__ __forceinline__ void mix_chunk(Frame& F, int l, int ci) {
    LAS bf16* QB = (LAS bf16*)(F.lds + RING_OFF);
    LAS bf16* KB = QB + 64 * 136;
    LAS bf16* VT = KB + 64 * 136;
    LAS bf16* ST = VT + 256 * 72;
    const int t0 = ci * 64, tid = F.tid, lane = F.lane, wave = F.wave, r32 = lane & 31, hh = lane >> 5;
    const bf16* PROJ = (const bf16*)(F.ws + WS_PROJ); bf16* MIXED = (bf16*)(F.ws + WS_MIXED);
    const float* GB = (const float*)(F.ws + WS_GB) + (size_t)t0 * 128;
    const int h = wave >> 1, ib = wave & 1, i0 = 32 * ib;
#pragma unroll
    for (int it = tid; it < 1024; it += 512) { const int t = it >> 4, d0 = (it & 15) * 8;
        const f32x4 b0 = *(const f32x4*)(GB + t * 128 + d0), b1 = *(const f32x4*)(GB + t * 128 + d0 + 4);
        const bf16* pr = PROJ + (size_t)(t0 + t) * NPROJ; const v4u qw = *(const v4u*)(pr + C_GQ + d0), kw = *(const v4u*)(pr + C_GK + d0);
        const float bv[8] = {b0[0], b0[1], b0[2], b0[3], b1[0], b1[1], b1[2], b1[3]}; const unsigned qa[4] = {qw.x, qw.y, qw.z, qw.w}, ka[4] = {kw.x, kw.y, kw.z, kw.w};
        unsigned qo[4], ko[4];
#pragma unroll
        for (int p = 0; p < 4; ++p) { const float e0 = expf(bv[2 * p]), e1 = expf(bv[2 * p + 1]), n0 = expf(-bv[2 * p]), n1 = expf(-bv[2 * p + 1]);
            qo[p] = pk2(bflo(qa[p]) * 0.17677669529663687f * e0, bfhi(qa[p]) * 0.17677669529663687f * e1); ko[p] = pk2(bflo(ka[p]) * n0, bfhi(ka[p]) * n1); }
        *(LAS v4u*)(QB + t * 136 + d0) = (v4u){qo[0], qo[1], qo[2], qo[3]}; *(LAS v4u*)(KB + t * 136 + d0) = (v4u){ko[0], ko[1], ko[2], ko[3]}; }
    gla_stage_vt(VT, PROJ, t0, tid);
    { const float* GU = (const float*)(F.ws + WS_GU) + (size_t)ci * 8192;
      float sv[16];
#pragma unroll
      for (int q = 0; q < 16; ++q) sv[q] = GU[tid + 512 * q];
#pragma unroll
      for (int q = 0; q < 16; ++q) { const int it = tid + 512 * q, hd = it >> 6, e = it & 63; ST[((hd >> 5) * 64 + e) * 40 + (hd & 31)] = (bf16)f2bf(sv[q]); } }
    const size_t row = (size_t)(t0 + i0 + r32); unsigned long long rg[8];
#pragma unroll
    for (int q = 0; q < 8; ++q) rg[q] = *(const unsigned long long*)(PROJ + row * NPROJ + C_GR + h * 64 + 32 * (q >> 2) + 8 * (q & 3) + 4 * hh);
    __syncthreads();
    {
        bf16x8 qf[2];
#pragma unroll
        for (int ks = 0; ks < 2; ++ks) qf[ks] = *(const LAS bf16x8*)(QB + (i0 + r32) * 136 + h * 32 + ks * 16 + 8 * hh);
        f32x16g OT[2] = {{}, {}};
#pragma unroll
        for (int eb = 0; eb < 2; ++eb)
#pragma unroll
            for (int ks = 0; ks < 2; ++ks) { const bf16x8 sa = *(const LAS bf16x8*)(ST + (h * 64 + eb * 32 + r32) * 40 + ks * 16 + 8 * hh); OT[eb] = __builtin_amdgcn_mfma_f32_32x32x16_bf16(sa, qf[ks], OT[eb], 0, 0, 0); }
#pragma unroll
        for (int jb = 0; jb < 2; ++jb) if (jb <= ib) {
            f32x16g X = {};
#pragma unroll
            for (int ks = 0; ks < 2; ++ks) { const bf16x8 ka = *(const LAS bf16x8*)(KB + (32 * jb + r32) * 136 + h * 32 + ks * 16 + 8 * hh); X = __builtin_amdgcn_mfma_f32_32x32x16_bf16(ka, qf[ks], X, 0, 0, 0); }
            if (jb == ib) {
#pragma unroll
                for (int r = 0; r < 16; ++r) if (gla_crow(r, hh) > r32) X[r] = 0.f;
            }
#pragma unroll
            for (int s = 0; s < 2; ++s) { v4u xw; xw.x = pk2(X[8 * s], X[8 * s + 1]); xw.y = pk2(X[8 * s + 2], X[8 * s + 3]); xw.z = pk2(X[8 * s + 4], X[8 * s + 5]); xw.w = pk2(X[8 * s + 6], X[8 * s + 7]);
                const bf16x8 xb = __builtin_bit_cast(bf16x8, xw);
#pragma unroll
                for (int eb = 0; eb < 2; ++eb) { const LAS bf16* vp = VT + (h * 64 + eb * 32 + r32) * 72 + 32 * jb + 16 * s + 4 * hh;
                    const unsigned long long lo = *(const LAS unsigned long long*)vp, hi = *(const LAS unsigned long long*)(vp + 8);
                    const v4u vw = (v4u){(unsigned)lo, (unsigned)(lo >> 32), (unsigned)hi, (unsigned)(hi >> 32)};
                    OT[eb] = __builtin_amdgcn_mfma_f32_32x32x16_bf16(__builtin_bit_cast(bf16x8, vw), xb, OT[eb], 0, 0, 0); } }
        }
        float ss = 0.f;
#pragma unroll
        for (int eb = 0; eb < 2; ++eb)
#pragma unroll
            for (int r = 0; r < 16; ++r) ss += OT[eb][r] * OT[eb][r];
        ss = xl_sum32(ss);
        const float rs = 1.0f / sqrtf(ss * (1.0f / 64.0f) + EPS); const float* gn = (const float*)(F.ws + WS_PAR) + PAR_GN + l * 64;
#pragma unroll
        for (int q = 0; q < 8; ++q) { const int eb = q >> 2, g = q & 3, e0 = 32 * eb + 8 * g + 4 * hh; const f32x4 g4 = *(const f32x4*)(gn + e0);
            const unsigned r0 = (unsigned)rg[q], r1 = (unsigned)(rg[q] >> 32); const float rr[4] = {bflo(r0), bfhi(r0), bflo(r1), bfhi(r1)}; float y[4];
#pragma unroll
            for (int k = 0; k < 4; ++k) { const float sl = rr[k] / (1.0f + expf(-rr[k])); y[k] = OT[eb][4 * g + k] * rs * g4[k] * sl; }
            *(unsigned long long*)(MIXED + row * DM + 768 + h * 64 + e0) = (unsigned long long)pk2(y[0], y[1]) | ((unsigned long long)pk2(y[2], y[3]) << 32); }
    }
    const float lam = ((const float*)(F.ws + WS_LAM))[l * 2], oscale = ((const float*)(F.ws + WS_LAM))[l * 2 + 1];
    const bf16* OATT = (const bf16*)(F.ws + WS_OATT); const float* dn = (const float*)(F.ws + WS_PAR) + PAR_DN + l * 128; const float* cw = (const float*)(F.ws + WS_PAR) + PAR_CW + l * 3 * 256;
    const float dn0 = dn[2 * lane], dn1 = dn[2 * lane + 1]; const int ch = 4 * lane;
    f32x4 wj[3];
#pragma unroll
    for (int j = 0; j < 3; ++j) wj[j] = *(const f32x4*)(cw + j * 256 + ch);
#pragma unroll 1
    for (int r0 = 0; r0 < 8; r0 += 4) {
        unsigned w1[4][4], w2[4][4]; unsigned long long cwd[6], hwd[6], bwd[4];
        const int tb = t0 + wave * 8 + r0;
#pragma unroll
        for (int u = 0; u < 4; ++u)
#pragma unroll
            for (int hq = 0; hq < 4; ++hq) { w1[u][hq] = *(const unsigned*)(OATT + (size_t)(tb + u) * DM + hq * 128 + 2 * lane); w2[u][hq] = *(const unsigned*)(OATT + (size_t)(tb + u) * DM + 512 + hq * 128 + 2 * lane); }
#pragma unroll
        for (int u = 0; u < 6; ++u) { const int tr = tb - 2 + u; const bool ok = ((tb & (SEQL - 1)) - 2 + u) >= 0;
            const bf16* pr = PROJ + (size_t)(ok ? tr : tb) * NPROJ; cwd[u] = ok ? *(const unsigned long long*)(pr + C_SC + ch) : 0ull; hwd[u] = ok ? *(const unsigned long long*)(pr + C_SH + ch) : 0ull; }
#pragma unroll
        for (int u = 0; u < 4; ++u) bwd[u] = *(const unsigned long long*)(PROJ + (size_t)(tb + u) * NPROJ + C_SB + ch);
        f32x4 z[6];
#pragma unroll
        for (int u = 0; u < 6; ++u) { const unsigned c0 = (unsigned)cwd[u], c1 = (unsigned)(cwd[u] >> 32), h0 = (unsigned)hwd[u], h1 = (unsigned)(hwd[u] >> 32); z[u] = (f32x4){bflo(c0) * bflo(h0), bfhi(c0) * bfhi(h0), bflo(c1) * bflo(h1), bfhi(c1) * bfhi(h1)}; }
#pragma unroll
        for (int u = 0; u < 4; ++u) { const int t = tb + u;
#pragma unroll
            for (int hq = 0; hq < 4; ++hq) { const float o0 = bflo(w1[u][hq]) - lam * bflo(w2[u][hq]), o1 = bfhi(w1[u][hq]) - lam * bfhi(w2[u][hq]); const float ssq = wave_sum(o0 * o0 + o1 * o1);
                const float rsq = oscale / sqrtf(ssq * (1.0f / 128.0f) + EPS);
                *(unsigned*)(MIXED + (size_t)t * DM + hq * 128 + 2 * lane) = pk2(o0 * rsq * dn0, o1 * rsq * dn1); }
            const f32x4 y = wj[0] * z[u] + wj[1] * z[u + 1] + wj[2] * z[u + 2];
            const unsigned b0 = (unsigned)bwd[u], b1 = (unsigned)(bwd[u] >> 32);
            *(unsigned long long*)(MIXED + (size_t)t * DM + 512 + ch) = (unsigned long long)pk2(bflo(b0) * y[0], bfhi(b0) * y[1]) | ((unsigned long long)pk2(bflo(b1) * y[2], bfhi(b1) * y[3]) << 32); }
    }
    __syncthreads();
}

#define TK_HD __device__ __forceinline__
#ifndef TK_HD
#define TK_HD __device__ __forceinline__
#endif
TK_HD int tk_max(int a, int b) { return a > b ? a : b; }
TK_HD int tk_min(int a, int b) { return a < b ? a : b; }
TK_HD int tk_f2key(float f) { int b = __builtin_bit_cast(int, f); return b ^ ((b >> 31) & 0x7fffffff); }
TK_HD float tk_key2f(int k) { return __builtin_bit_cast(float, k ^ ((k >> 31) & 0x7fffffff)); }
template <int N> TK_HD void tk_sort_desc(int (&a)[N]) {
#pragma unroll
    for (int k = 2; k <= N; k <<= 1)
#pragma unroll
        for (int j = k >> 1; j > 0; j >>= 1)
#pragma unroll
            for (int i = 0; i < N; ++i) { const int l = i ^ j; if (l > i) { const int hi = tk_max(a[i], a[l]), lo = tk_min(a[i], a[l]); if ((i & k) == 0) { a[i] = hi; a[l] = lo; } else { a[i] = lo; a[l] = hi; } } }
}
template <int N> TK_HD void tk_merge_desc(int (&a)[N]) {
#pragma unroll
    for (int j = N >> 1; j > 0; j >>= 1)
#pragma unroll
        for (int i = 0; i < N; ++i) { const int l = i ^ j; if (l > i) { const int hi = tk_max(a[i], a[l]), lo = tk_min(a[i], a[l]); a[i] = hi; a[l] = lo; } }
}
TK_HD void tk_top16_merge(int (&a)[16], const int (&b)[16]) {
#pragma unroll
    for (int i = 0; i < 16; ++i) a[i] = tk_max(a[i], b[15 - i]);
    tk_merge_desc<16>(a);
}
TK_HD constexpr int tk_cand_i(int set, int s) {
    if (set == 0) return s < 16 ? 0 : (s < 24 ? 1 : (s == 24 ? 8 : -1));
    return s < 5 ? 2 : s < 9 ? 3 : s < 12 ? 4 : s < 14 ? 5 : s < 16 ? 6 : s < 18 ? 7 : s < 25 ? (9 + (s - 18)) : -1;
}
TK_HD constexpr int tk_cand_j(int set, int s) {
    if (set == 0) return s < 16 ? s : (s < 24 ? s - 16 : (s == 24 ? 0 : -1));
    return s < 5 ? s : s < 9 ? s - 5 : s < 12 ? s - 9 : s < 14 ? s - 12 : s < 16 ? s - 14 : s < 18 ? s - 16 : s < 25 ? 0 : -1;
}

constexpr int PS_KSTRIDE = 136;
__device__ __forceinline__ void peer_select_task(Frame& F, int l, int t0, int h, LAS int* scr  , const LAS bf16* KL  ) {
    typedef float f32x16 __attribute__((ext_vector_type(16)));
    const int lane = F.lane, r32 = lane & 31, hi = lane >> 5;
    const bf16* QP = (const bf16*)(F.ws + WS_QP);
    int lists[2][16];
    bf16x8 qall[2][8];
#pragma unroll
    for (int half = 0; half < 2; ++half) { const bf16* qp = QP + (size_t)(t0 + r32) * NQ + h * 256 + half * 128 + hi * 8;
#pragma unroll
        for (int ks = 0; ks < 8; ++ks) qall[half][ks] = *(const bf16x8*)(qp + ks * 16); }
#pragma unroll
    for (int half = 0; half < 2; ++half) {
        const bf16x8 (&qf)[8] = qall[half];
        int cur[16];
#pragma unroll
        for (int kb = 0; kb < 4; ++kb) {
            f32x16 c = {};
            const LAS bf16* kp = KL + (half * 128 + kb * 32 + r32) * PS_KSTRIDE + hi * 8;
#pragma unroll
            for (int ks = 0; ks < 8; ++ks) { const bf16x8 kf = *(const LAS bf16x8*)(kp + ks * 16); c = __builtin_amdgcn_mfma_f32_32x32x16_bf16(kf, qf[ks], c, 0, 0, 0); }
            int g[16];
#pragma unroll
            for (int r = 0; r < 16; ++r) { const int key = kb * 32 + (r & 3) + 8 * (r >> 2) + 4 * hi; g[r] = (tk_f2key(c[r]) & ~127) | (127 - key); }
            tk_sort_desc<16>(g);
            if (kb == 0) {
#pragma unroll
                for (int r = 0; r < 16; ++r) cur[r] = g[r];
            } else tk_top16_merge(cur, g);
        }
        int oth[16];
#pragma unroll
        for (int r = 0; r < 16; ++r) oth[r] = xl_xor32_i(cur[r], hi);
        tk_top16_merge(cur, oth);
#pragma unroll
        for (int r = 0; r < 16; ++r) lists[half][r] = cur[r];
    }
#pragma unroll
    for (int r = 0; r < 16; ++r) scr[r32 * 32 + hi * 16 + r] = 127 - ((hi ? lists[1][r] : lists[0][r]) & 127);
    float v1[16], v2[16];
#pragma unroll
    for (int r = 0; r < 16; ++r) { v1[r] = tk_key2f(lists[0][r]); v2[r] = tk_key2f(lists[1][r]); }
    int c[32];
#pragma unroll
    for (int s = 0; s < 32; ++s) {
        constexpr int NEG = (int)0x80000000;
        const int ia = tk_cand_i(0, s), ja = tk_cand_j(0, s), ib = tk_cand_i(1, s), jb = tk_cand_j(1, s);
        if (ia < 0) c[s] = NEG;
        else { const int ka = (tk_f2key(v1[ia] + v2[ja]) & ~255) | (255 - (ia * 16 + ja)), kb2 = (tk_f2key(v1[ib] + v2[jb]) & ~255) | (255 - (ib * 16 + jb)); c[s] = hi ? kb2 : ka; }
    }
    tk_sort_desc<32>(c);
    int fin[16], oth[16];
#pragma unroll
    for (int r = 0; r < 16; ++r) { fin[r] = c[r]; oth[r] = xl_xor32_i(c[r], hi); }
    tk_top16_merge(fin, oth);
    float p[16]; float sum = 0.f; const float mx = tk_key2f(fin[0]);
#pragma unroll
    for (int r = 0; r < 16; ++r) { p[r] = expf(tk_key2f(fin[r]) - mx); sum += p[r]; }
    const float inv = 1.0f / sum;
    asm volatile("s_waitcnt lgkmcnt(0)" ::: "memory");
    int* EX = (int*)(F.ws + WS_EXP) + (size_t)(t0 + r32) * 128 + h * 16; float* GT = (float*)(F.ws + WS_GATE) + (size_t)(t0 + r32) * 128 + h * 16;
#pragma unroll
    for (int r = 0; r < 16; ++r) { const int code = 255 - (fin[r] & 255); const int e1 = scr[r32 * 32 + (code >> 4)], e2 = scr[r32 * 32 + 16 + (code & 15)];
        if ((r >> 3) == hi) { EX[r] = e1 * 128 + e2; GT[r] = p[r] * inv; } }
    asm volatile("s_waitcnt lgkmcnt(0)" ::: "memory");
}

__device__ __forceinline__ float gelu_erf(float v) {
    const float av = fabsf(v), t = __builtin_amdgcn_rcpf(av * 0.2316418882f + 1.0f);
    float q = t * 0.5307027145f + (-0.7265760135f); q = q * t + 0.7107068705f; q = q * t + (-0.142248368f); q = q * t + 0.127414796f; q = q * t;
    const float e = __builtin_amdgcn_exp2f((v * v) * (-0.72134752044f)); const float m_ = v * (q * e);
    return v < 0.f ? m_ : v - m_;
}
typedef __bf16 bf16x2_t __attribute__((ext_vector_type(2)));
__device__ __forceinline__ float dot2bf(unsigned a, unsigned b, float c) { return __builtin_amdgcn_fdot2_f32_bf16(__builtin_bit_cast(bf16x2_t, a), __builtin_bit_cast(bf16x2_t, b), c, false); }
template <int J> __device__ __forceinline__ int xl_xchg_i(int v, int hi) { if constexpr (J == 32) return xl_xor32_i(v, hi); else return xl_swz_i<J>(v); }
template <int K, int J> __device__ __forceinline__ void sort128_step(int& ka, int& kb, int lane) {
    if constexpr (J == 64) { const int lo = ka < kb ? ka : kb, hi = ka < kb ? kb : ka; ka = lo; kb = hi; }
    else { const int oa = xl_xchg_i<J>(ka, lane >> 5), ob = xl_xchg_i<J>(kb, lane >> 5); const bool lower = (lane & J) == 0;
        const bool upa = (K >= 64) ? true : ((lane & K) == 0), upb = (K >= 128) ? true : (K == 64 ? false : ((lane & K) == 0));
        const int mina = ka < oa ? ka : oa, maxa = ka < oa ? oa : ka, minb = kb < ob ? kb : ob, maxb = kb < ob ? ob : kb;
        ka = (upa == lower) ? mina : maxa; kb = (upb == lower) ? minb : maxb; }
}
__device__ __forceinline__ void sort128(int& ka, int& kb, int lane) {
#define S_(K, J) sort128_step<K, J>(ka, kb, lane);
    S_(2, 1) S_(4, 2) S_(4, 1) S_(8, 4) S_(8, 2) S_(8, 1) S_(16, 8) S_(16, 4) S_(16, 2) S_(16, 1) S_(32, 16) S_(32, 8) S_(32, 4) S_(32, 2) S_(32, 1)
    S_(64, 32) S_(64, 16) S_(64, 8) S_(64, 4) S_(64, 2) S_(64, 1) S_(128, 64) S_(128, 32) S_(128, 16) S_(128, 8) S_(128, 4) S_(128, 2) S_(128, 1)
#undef S_
}
typedef float f32x2g __attribute__((ext_vector_type(2)));
#define PT_WGSYNC 1
#ifndef PT_SYNC_EVERY
#define PT_SYNC_EVERY 4
#endif
#ifndef PT_FIXED_ORDER
#define PT_GREEDY 1
#endif
#ifndef PT_CH
#define PT_CH 8
#endif
constexpr int PT_T = 4;
constexpr int PT_TOK_INTS = 128 + 128 + 64 + 256 + 4 + 128;
constexpr int PT_WAVE_INTS = PT_T * PT_TOK_INTS;
__device__ __forceinline__ float pt_dot8(const v4u w, const f32x2g (&xv)[8]) {
    f32x2g a = (f32x2g){0.f, 0.f};
    a = __builtin_elementwise_fma(__builtin_amdgcn_cvt_pk_f32_fp8(w.x, false), xv[0], a); a = __builtin_elementwise_fma(__builtin_amdgcn_cvt_pk_f32_fp8(w.x, true), xv[1], a);
    a = __builtin_elementwise_fma(__builtin_amdgcn_cvt_pk_f32_fp8(w.y, false), xv[2], a); a = __builtin_elementwise_fma(__builtin_amdgcn_cvt_pk_f32_fp8(w.y, true), xv[3], a);
    a = __builtin_elementwise_fma(__builtin_amdgcn_cvt_pk_f32_fp8(w.z, false), xv[4], a); a = __builtin_elementwise_fma(__builtin_amdgcn_cvt_pk_f32_fp8(w.z, true), xv[5], a);
    a = __builtin_elementwise_fma(__builtin_amdgcn_cvt_pk_f32_fp8(w.w, false), xv[6], a); a = __builtin_elementwise_fma(__builtin_amdgcn_cvt_pk_f32_fp8(w.w, true), xv[7], a);
    return a.x + a.y;
}
__device__ __forceinline__ void pt_axpy8(const v4u w, const float c, f32x2g (&o)[8]) {
    const f32x2g cc = (f32x2g){c, c};
    o[0] = __builtin_elementwise_fma(__builtin_amdgcn_cvt_pk_f32_fp8(w.x, false), cc, o[0]); o[1] = __builtin_elementwise_fma(__builtin_amdgcn_cvt_pk_f32_fp8(w.x, true), cc, o[1]);
    o[2] = __builtin_elementwise_fma(__builtin_amdgcn_cvt_pk_f32_fp8(w.y, false), cc, o[2]); o[3] = __builtin_elementwise_fma(__builtin_amdgcn_cvt_pk_f32_fp8(w.y, true), cc, o[3]);
    o[4] = __builtin_elementwise_fma(__builtin_amdgcn_cvt_pk_f32_fp8(w.z, false), cc, o[4]); o[5] = __builtin_elementwise_fma(__builtin_amdgcn_cvt_pk_f32_fp8(w.z, true), cc, o[5]);
    o[6] = __builtin_elementwise_fma(__builtin_amdgcn_cvt_pk_f32_fp8(w.w, false), cc, o[6]); o[7] = __builtin_elementwise_fma(__builtin_amdgcn_cvt_pk_f32_fp8(w.w, true), cc, o[7]);
}
__device__ __forceinline__ int xl_sum32_i(int v) { unsigned a = (unsigned)v, b = a; asm volatile("" : "+v"(b)); auto r = __builtin_amdgcn_permlane32_swap(a, b, false, false); const unsigned r0 = r[0], r1 = r[1]; return (int)(r0 + r1); }
__device__ __forceinline__ void pt_chunk(const LAS int* se, const LAS float* sg, int base, const v4u xq, f32x2g (&out)[8], float hscale,
                                         const unsigned char* Ub, const unsigned char* Vb, const float* SU, const float* SV, int lane) {
    const int e_l = se[base + (lane & (PT_CH - 1))]; const float g_l = sg[base + (lane & (PT_CH - 1))], hu_l = sg[452 + base + (lane & (PT_CH - 1))];
    v4u uw[PT_CH], vw[PT_CH]; const int l16 = 16 * lane; int es[PT_CH];
    const __amdgpu_buffer_rsrc_t rs = __builtin_amdgcn_make_buffer_rsrc((void*)Ub, 0, 32 << 20, 0x00020000);
#pragma unroll
    for (int s = 0; s < PT_CH; ++s) { es[s] = __builtin_amdgcn_readlane(e_l, s) * 2048; uw[s] = __builtin_bit_cast(v4u, __builtin_amdgcn_raw_buffer_load_b128(rs, l16, es[s], 0)); }
#pragma unroll
    for (int s = 0; s < PT_CH; ++s) vw[s] = __builtin_bit_cast(v4u, __builtin_amdgcn_raw_buffer_load_b128(rs, l16 + 1024, es[s], 0));
    int p[PT_CH];
#pragma unroll
    for (int s = 0; s < PT_CH; ++s) { int a = __builtin_amdgcn_sdot4((int)uw[s].x, (int)xq.x, 0, false); a = __builtin_amdgcn_sdot4((int)uw[s].y, (int)xq.y, a, false);
        a = __builtin_amdgcn_sdot4((int)uw[s].z, (int)xq.z, a, false); p[s] = __builtin_amdgcn_sdot4((int)uw[s].w, (int)xq.w, a, false); }
#define PT_BFLY(S) _Pragma("unroll") for (int i = 0; i < S; ++i) { const bool up = (lane & S) != 0; const int keep = up ? p[i + S] : p[i], send = up ? p[i] : p[i + S]; p[i] = keep + xl_swz_i<S>(send); }
#if PT_CH == 16
    PT_BFLY(8)
#endif
    PT_BFLY(4) PT_BFLY(2) PT_BFLY(1)
#undef PT_BFLY
    int hi_ = p[0];
#if PT_CH == 8
    hi_ += xl_swz_i<8>(hi_);
#endif
    hi_ += xl_swz_i<16>(hi_); hi_ = xl_sum32_i(hi_);
    const float c_l = g_l * gelu_erf((float)hi_ * hu_l);
#pragma unroll
    for (int s = 0; s < PT_CH; ++s) { const float c = __builtin_bit_cast(float, __builtin_amdgcn_readlane(__builtin_bit_cast(int, c_l), s)); pt_axpy8(vw[s], c, out); }
}
__device__ __forceinline__ void pt_sort_regs(LAS int* se, LAS float* sg, LAS int* cnt, LAS float* sh, int ea, int eb, float ga, float gb, float ha, float hb, int lane) {
    cnt[lane] = 0;
    asm volatile("s_waitcnt lgkmcnt(0)" ::: "memory");
    __hip_atomic_fetch_add(cnt + (ea >> 8), 1, __ATOMIC_RELAXED, __HIP_MEMORY_SCOPE_WAVEFRONT); __hip_atomic_fetch_add(cnt + (eb >> 8), 1, __ATOMIC_RELAXED, __HIP_MEMORY_SCOPE_WAVEFRONT);
    asm volatile("s_waitcnt lgkmcnt(0)" ::: "memory");
    const int c = cnt[lane]; int incl = c;
    int ln = lane; asm volatile("" : "+v"(ln));
#pragma unroll
    for (int off = 1; off < 64; off <<= 1) { const int o = __builtin_amdgcn_ds_bpermute(((ln - off) & 63) << 2, incl); incl += (ln >= off) ? o : 0; }
    asm volatile("s_waitcnt lgkmcnt(0)" ::: "memory");
    cnt[lane] = incl - c;
    asm volatile("s_waitcnt lgkmcnt(0)" ::: "memory");
    const int pa = __hip_atomic_fetch_add(cnt + (ea >> 8), 1, __ATOMIC_RELAXED, __HIP_MEMORY_SCOPE_WAVEFRONT);
    const int pb = __hip_atomic_fetch_add(cnt + (eb >> 8), 1, __ATOMIC_RELAXED, __HIP_MEMORY_SCOPE_WAVEFRONT);
    se[pa] = ea; sg[pa] = ga; sh[pa] = ha; se[pb] = eb; sg[pb] = gb; sh[pb] = hb;
    asm volatile("s_waitcnt lgkmcnt(0)" ::: "memory");
}
__device__ __forceinline__ void pt_sort(LAS int* se, LAS float* sg, LAS int* cnt, const int* EX, const float* GT, int lane, bool dry, const float* SU = nullptr, const float* SV = nullptr, float hs = 1.0f, LAS float* sh = nullptr) {
    int ea = EX[lane], eb = EX[64 + lane];
#ifdef DRYMASK
    if (dry) { ea &= DRYMASK; eb &= DRYMASK; }
#endif
    (void)dry; float ga = GT[lane], gb = GT[64 + lane]; float ha = 0.f, hb = 0.f;
    if (sh) { ga *= SV[ea]; gb *= SV[eb]; ha = hs * SU[ea]; hb = hs * SU[eb]; }
    cnt[lane] = 0;
    asm volatile("s_waitcnt lgkmcnt(0)" ::: "memory");
    __hip_atomic_fetch_add(cnt + (ea >> 8), 1, __ATOMIC_RELAXED, __HIP_MEMORY_SCOPE_WAVEFRONT); __hip_atomic_fetch_add(cnt + (eb >> 8), 1, __ATOMIC_RELAXED, __HIP_MEMORY_SCOPE_WAVEFRONT);
    asm volatile("s_waitcnt lgkmcnt(0)" ::: "memory");
    const int c = cnt[lane];
    int incl = c;
    int ln = lane; asm volatile("" : "+v"(ln));
#pragma unroll
    for (int off = 1; off < 64; off <<= 1) { const int o = __builtin_amdgcn_ds_bpermute(((ln - off) & 63) << 2, incl); incl += (ln >= off) ? o : 0; }
    asm volatile("s_waitcnt lgkmcnt(0)" ::: "memory");
    cnt[lane] = incl - c;
    asm volatile("s_waitcnt lgkmcnt(0)" ::: "memory");
    const int pa = __hip_atomic_fetch_add(cnt + (ea >> 8), 1, __ATOMIC_RELAXED, __HIP_MEMORY_SCOPE_WAVEFRONT);
    const int pb = __hip_atomic_fetch_add(cnt + (eb >> 8), 1, __ATOMIC_RELAXED, __HIP_MEMORY_SCOPE_WAVEFRONT);
    se[pa] = ea; sg[pa] = ga; se[pb] = eb; sg[pb] = gb; if (sh) { sh[pa] = ha; sh[pb] = hb; }
    asm volatile("s_waitcnt lgkmcnt(0)" ::: "memory");
}
__device__ __forceinline__ void peer_tokens4(Frame& F, int l, int tq, bool last, LAS int* scr, unsigned* xs_word, unsigned xs_nloc, unsigned& xs_round, bool dry = false) {
    const int lane = F.lane;
    const unsigned char* Ub = F.ws + WS_TAB + l * TAB_STRIDE; const unsigned char* Vb = Ub + 1024;
    const float* SU = (const float*)(F.ws + WS_SU) + l * 16384; const float* SV = (const float*)(F.ws + WS_SV) + l * 16384;
    f32x2g out[PT_T][8];
    {
        int ls = lane; asm volatile("" : "+v"(ls));
        v4u xw_[PT_T][2]; int ea[PT_T], eb[PT_T]; float ga[PT_T], gb[PT_T], rs[PT_T], sua[PT_T], sub_[PT_T], sva[PT_T], svb[PT_T];
#pragma unroll
        for (int k = 0; k < PT_T; ++k) { const int t = tq + k; const bf16* Xr = (const bf16*)(F.ws + WS_XB) + (size_t)t * DM + 16 * ls; const int* EX = (const int*)(F.ws + WS_EXP) + (size_t)t * 128; const float* GT = (const float*)(F.ws + WS_GATE) + (size_t)t * 128;
            ea[k] = EX[ls]; eb[k] = EX[64 + ls]; ga[k] = GT[ls]; gb[k] = GT[64 + ls];
#ifdef DRYMASK
            if (dry) { ea[k] &= DRYMASK; eb[k] &= DRYMASK; }
#endif
            xw_[k][0] = *(const v4u*)(Xr); xw_[k][1] = *(const v4u*)(Xr + 8); rs[k] = pg8::row_rstd((const float*)(F.ws + WS_SSQ), t); }
#pragma unroll
        for (int k = 0; k < PT_T; ++k) { sua[k] = SU[ea[k]]; sub_[k] = SU[eb[k]]; sva[k] = SV[ea[k]]; svb[k] = SV[eb[k]]; }
#pragma unroll
        for (int k = 0; k < PT_T; ++k) { LAS int* tk = scr + k * PT_TOK_INTS;
            f32x4 xr[1][4];
#pragma unroll
            for (int j = 0; j < 4; ++j) { const v4u w = xw_[k][j >> 1]; const unsigned a = (j & 1) ? w.z : w.x, b = (j & 1) ? w.w : w.y; xr[0][j] = (f32x4){bflo(a), bfhi(a), bflo(b), bfhi(b)}; }
            float mx = 0.f;
#pragma unroll
            for (int j = 0; j < 4; ++j) mx = fmaxf(mx, fmaxf(fmaxf(fabsf(xr[0][j][0]), fabsf(xr[0][j][1])), fmaxf(fabsf(xr[0][j][2]), fabsf(xr[0][j][3]))));
            mx = fmaxf(mx, xl_swz<1>(mx)); mx = fmaxf(mx, xl_swz<2>(mx)); mx = fmaxf(mx, xl_swz<4>(mx)); mx = fmaxf(mx, xl_swz<8>(mx)); mx = fmaxf(mx, xl_swz<16>(mx));
            mx = fmaxf(mx, __builtin_bit_cast(float, xl_xor32_i(__builtin_bit_cast(int, mx), lane >> 5)));
            const float sc = mx > 0.f ? 127.0f / mx : 0.f;
#define PT_Q4(v) ((unsigned)((int)rintf((v)[0] * sc) & 255) | ((unsigned)((int)rintf((v)[1] * sc) & 255) << 8) | ((unsigned)((int)rintf((v)[2] * sc) & 255) << 16) | ((unsigned)((int)rintf((v)[3] * sc) & 255) << 24))
            *(LAS v4u*)(tk + 320 + 4 * lane) = (v4u){PT_Q4(xr[0][0]), PT_Q4(xr[0][1]), PT_Q4(xr[0][2]), PT_Q4(xr[0][3])};
#undef PT_Q4
            const float hs_ = rs[k] * mx * (1.0f / 127.0f);
            pt_sort_regs(tk, (LAS float*)(tk + 128), tk + 256, (LAS float*)(tk + 580), ea[k], eb[k], ga[k] * sva[k], gb[k] * svb[k], hs_ * sua[k], hs_ * sub_[k], lane);
            asm volatile("" ::: "memory"); }
    }
#pragma unroll
    for (int k = 0; k < PT_T; ++k)
#pragma unroll
        for (int i = 0; i < 8; ++i) out[k][i] = (f32x2g){0.f, 0.f};
#ifdef PT_GREEDY
    static_assert(PT_T == 4 && PT_CH == 8, "greedy sweep: four tokens, chunks of eight");
    int csv0, csv1, csv2, csv3;
    { int lc = lane; asm volatile("" : "+v"(lc)); const int ci = (lc & 15) * PT_CH; const bool in = lc < 16;
      csv0 = in ? scr[0 * PT_TOK_INTS + ci] : 0x7fffffff; csv1 = in ? scr[1 * PT_TOK_INTS + ci] : 0x7fffffff; csv2 = in ? scr[2 * PT_TOK_INTS + ci] : 0x7fffffff; csv3 = in ? scr[3 * PT_TOK_INTS + ci] : 0x7fffffff; }
    int pos0 = 0, pos1 = 0, pos2 = 0, pos3 = 0;
#define PT_RUN(K, POS) { const LAS int* tk = scr + K * PT_TOK_INTS; const v4u xq = *(const LAS v4u*)(tk + 320 + 4 * lane); \
        pt_chunk(tk, (const LAS float*)(tk + 128), PT_CH * POS, xq, out[K], 0.f, Ub, Vb, SU, SV, lane); ++POS; asm volatile("" ::: "memory"); }
#pragma unroll 1
    for (int ck = 0; ck < 128 / PT_CH; ++ck) {
#pragma unroll 1
        for (int j = 0; j < PT_T; ++j) {
            const int s0 = __builtin_amdgcn_readlane(csv0, pos0), s1 = __builtin_amdgcn_readlane(csv1, pos1), s2 = __builtin_amdgcn_readlane(csv2, pos2), s3 = __builtin_amdgcn_readlane(csv3, pos3);
            const int m01 = s0 <= s1 ? s0 : s1, m23 = s2 <= s3 ? s2 : s3;
            const int sel = (m01 <= m23) ? (s0 <= s1 ? 0 : 1) : (s2 <= s3 ? 2 : 3);
            if (sel == 0) PT_RUN(0, pos0)
            if (sel == 1) PT_RUN(1, pos1)
            if (sel == 2) PT_RUN(2, pos2)
            if (sel == 3) PT_RUN(3, pos3)
        }
#else
#pragma unroll 1
    for (int ck = 0; ck < 128 / PT_CH; ++ck) {
#pragma unroll
        for (int k = 0; k < PT_T; ++k) { const LAS int* tk = scr + k * PT_TOK_INTS; const v4u xq = *(const LAS v4u*)(tk + 320 + 4 * lane); const float hsc = ((const LAS float*)tk)[576];
            pt_chunk(tk, (const LAS float*)(tk + 128), PT_CH * ck, xq, out[k], hsc, Ub, Vb, SU, SV, lane); asm volatile("" ::: "memory"); }
#endif
#ifdef PT_WGSYNC
        if ((ck % PT_SYNC_EVERY) == PT_SYNC_EVERY - 1) __syncthreads();
#if PT_WGSYNC >= 2
        if ((ck % PT_XSTEP) == PT_XSTEP - 1) { if (F.tid == 0) { unsigned* w = xs_word; const unsigned tgt = (++xs_round) * xs_nloc; __hip_atomic_fetch_add(w, 1u, __ATOMIC_RELAXED, __HIP_MEMORY_SCOPE_AGENT);
                unsigned sp = 0; while (__hip_atomic_load(w, __ATOMIC_RELAXED, __HIP_MEMORY_SCOPE_AGENT) < tgt && ++sp < (1u << 16)) __builtin_amdgcn_s_sleep(1); }
            __syncthreads(); }
#endif
#endif
    }
#pragma unroll
    for (int k = 0; k < PT_T; ++k) { int lf = lane; asm volatile("" : "+v"(lf)); const int t = tq + k; float* X = F.out + (size_t)t * DM + 16 * lf; bf16* XBr = (bf16*)(F.ws + WS_XB) + (size_t)t * DM + 16 * lf;
        const v4u ra = *(const v4u*)(XBr), rb = *(const v4u*)(XBr + 8);
        f32x4 x0 = (f32x4){bflo(ra.x), bfhi(ra.x), bflo(ra.y), bfhi(ra.y)} + (f32x4){out[k][0].x, out[k][0].y, out[k][1].x, out[k][1].y}, x1 = (f32x4){bflo(ra.z), bfhi(ra.z), bflo(ra.w), bfhi(ra.w)} + (f32x4){out[k][2].x, out[k][2].y, out[k][3].x, out[k][3].y};
        f32x4 x2 = (f32x4){bflo(rb.x), bfhi(rb.x), bflo(rb.y), bfhi(rb.y)} + (f32x4){out[k][4].x, out[k][4].y, out[k][5].x, out[k][5].y}, x3 = (f32x4){bflo(rb.z), bfhi(rb.z), bflo(rb.w), bfhi(rb.w)} + (f32x4){out[k][6].x, out[k][6].y, out[k][7].x, out[k][7].y};
        float ss = 0.f;
#pragma unroll
        for (int i = 0; i < 4; ++i) ss += x0[i] * x0[i] + x1[i] * x1[i] + x2[i] * x2[i] + x3[i] * x3[i];
        ss = wave_sum(ss);
        if (dry && ss != -1.0f) continue;
        if (last) { const float rs = 1.0f / sqrtf(ss * (1.0f / 1024.0f) + EPS); const float* g = (const float*)(F.ws + WS_PAR) + PAR_NF + 16 * lane;
            x0 = x0 * rs * *(const f32x4*)(g); x1 = x1 * rs * *(const f32x4*)(g + 4); x2 = x2 * rs * *(const f32x4*)(g + 8); x3 = x3 * rs * *(const f32x4*)(g + 12);
            *(f32x4*)(X) = x0; *(f32x4*)(X + 4) = x1; *(f32x4*)(X + 8) = x2; *(f32x4*)(X + 12) = x3; }
        else { v4u wa, wb; wa.x = pk2(x0[0], x0[1]); wa.y = pk2(x0[2], x0[3]); wa.z = pk2(x1[0], x1[1]); wa.w = pk2(x1[2], x1[3]); wb.x = pk2(x2[0], x2[1]); wb.y = pk2(x2[2], x2[3]); wb.z = pk2(x3[0], x3[1]); wb.w = pk2(x3[2], x3[3]);
            *(v4u*)(XBr) = wa; *(v4u*)(XBr + 8) = wb;
            if (lf == 0) ((float*)(F.ws + WS_RS1))[t] = 1.0f / sqrtf(ss * (1.0f / 1024.0f) + EPS); }
        asm volatile("" ::: "memory"); }
}

constexpr int NPHASE = 1 + 8 * NLAYER;
struct Args { const float* in[21]; float* out; unsigned char* ws; int ph_lo, ph_hi, use_bar, pad; };
__global__ void __launch_bounds__(NWAVES * 64, 2) hymba_fwd(Args args) {
    extern __shared__ __attribute__((aligned(16))) unsigned char lds[];
    Frame F;
    F.lds = (LAS unsigned char*)lds;
    F.MISC = (volatile LAS unsigned*)(F.lds + MISC_OFF);
    F.tid = threadIdx.x; F.lane = F.tid & 63; F.wave = __builtin_amdgcn_readfirstlane(F.tid >> 6);
    F.G = gridDim.x; F.bx = blockIdx.x; { const int bx = blockIdx.x; F.vcu = (F.G % 8 == 0) ? (bx % 8) * (F.G / 8) + bx / 8 : bx; }
    F.out = args.out; F.ws = args.ws;
    for (int u = F.tid; u < (LDS_BYTES - LDSCTL_OFF) / 4; u += NWAVES * 64) ((LAS unsigned*)(F.lds + LDSCTL_OFF))[u] = 0u;
    __syncthreads();
    XcdBarrier bar; bar.bar = ((unsigned*)(args.ws + WS_CTL) + CW_BAR); bar.x = 0; bar.st = nullptr;
    if (args.use_bar) bar = xcd_barrier_post(((unsigned*)(args.ws + WS_CTL) + CW_BAR), F.MISC + 8);
    const int lo = args.ph_lo, hi = args.ph_hi;
#ifndef PHMASK
#define PHMASK 0x1ff
#endif
#ifndef REPMASK
#define REPMASK 0
#endif
#define REPS(bit) (((REPMASK >> (bit)) & 1) ? 2 : 1)
#define IN(k) (((PHMASK >> ((k) == 0 ? 0 : 1 + (((k) - 1) & 7))) & 1) && lo <= (k) && (k) < hi)
#define SEAM(k) do { if (IN(k) && IN((k) + 1)) { XcdBarrier b_ = bar; int zb_ = 0; asm volatile("" : "+s"(zb_), "+s"(b_.x)); b_.bar = bar.bar + zb_; xcd_barrier(b_, F.tid == 0); } FRESH(); } while (0)
#define FRESH() do { int ln_; int wv_ = wave0; asm volatile("v_mbcnt_lo_u32_b32 %0, -1, 0\n\tv_mbcnt_hi_u32_b32 %0, -1, %0" : "=v"(ln_)); asm volatile("" : "+s"(wv_)); F.lane = ln_; F.wave = wv_; F.tid = wv_ * 64 + ln_; \
        int z_ = 0, v_ = vcu0, g_ = (int)gridDim.x, bx_ = (int)blockIdx.x; asm volatile("" : "+s"(z_), "+s"(v_), "+s"(g_), "+s"(bx_)); F.ws = args.ws + z_; F.out = args.out + z_; F.vcu = v_; F.G = g_; F.bx = bx_; } while (0)
    if (IN(0)) { for (int rep_ = 0; rep_ < REPS(8); ++rep_) { p0_prologue(F, args); __syncthreads(); } }
    const int vcu0 = F.vcu, wave0 = F.wave;
    SEAM(0);
    { constexpr int l = 0;

        const int pb = 1 + 8 * l;
        if (IN(pb + 0)) for (int rep_ = 0; rep_ < REPS(0); ++rep_) {
            pg8::Gemm g{(const pg8::bf16_t*)(F.ws + WS_XB), (const pg8::bf16_t*)(F.ws + WS_WIN + l * WIN_STRIDE), M, NPROJ, DM}; pg8::StaticOrder S; S.init(M, NPROJ, F.G, F.bx);
            pg8::EpiScale<true> E{(pg8::bf16_t*)(F.ws + WS_PROJ), NPROJ, (const float*)(F.ws + WS_RS1), (const float*)(F.ws + WS_COS), (const float*)(F.ws + WS_SIN), ATT_C2};
            pg8::gemm_phase<pg8::EpiScale<true>, pg8::StaticOrder, PG8_ALIGN, PG8_SP2>(F.lds + RING_OFF, g, S, E, F.tid);
        }
        SEAM(pb + 0);
        if (IN(pb + 1)) for (int rep_ = 0; rep_ < REPS(1); ++rep_) {
            if (args.pad == 0) { const attn_body::StaticOrder S(F.vcu);     attn_body::attn_phase<attn_body::StaticOrder>((char*)lds + RING_OFF, (const attn_body::bf16*)(F.ws + WS_PROJ), (attn_body::bf16*)(F.ws + WS_OATT), S, F.tid); }
            __syncthreads(); FRESH();
            for (int ci = F.vcu; ci < 256; ci += F.G) gla_prep(F, l, ci, args.pad >= 2 ? args.pad - 1 : 0);
        }
        SEAM(pb + 1);
        if (IN(pb + 2) && args.pad != 1) gla_scan(F);
        SEAM(pb + 2);
        if (IN(pb + 3)) for (int rep_ = 0; rep_ < REPS(3); ++rep_) { for (int ci = F.vcu; ci < 256; ci += F.G) mix_chunk(F, l, ci); }
        SEAM(pb + 3);
        if (IN(pb + 4)) {
            pg8::Gemm g{(const pg8::bf16_t*)(F.ws + WS_MIXED), (const pg8::bf16_t*)(F.ws + WS_WOUT + l * WOUT_STRIDE), M, DM, DM}; pg8::StaticOrder S; S.init(M, DM, F.G, F.bx);
            pg8::EpiRes E{(pg8::bf16_t*)(F.ws + WS_XB), (float*)(F.ws + WS_SSQ)};
            pg8::gemm_phase<pg8::EpiRes, pg8::StaticOrder, PG8_ALIGN, PG8_SP2>(F.lds + RING_OFF, g, S, E, F.tid);
        }
        SEAM(pb + 4);
        if (IN(pb + 5)) for (int rep_ = 0; rep_ < REPS(5); ++rep_) {
            pg8::Gemm g{(const pg8::bf16_t*)(F.ws + WS_XB), (const pg8::bf16_t*)(F.ws + WS_WQ + l * WQ_STRIDE), M, NQ, DM}; pg8::StaticOrder S; S.init(M, NQ, F.G, F.bx);
            pg8::EpiScale<false> E{(pg8::bf16_t*)(F.ws + WS_QP), NQ, (const float*)(F.ws + WS_SSQ), nullptr, nullptr, 1.0f};
            pg8::gemm_phase<pg8::EpiScale<false>, pg8::StaticOrder, PG8_ALIGN, PG8_SP2>(F.lds + RING_OFF, g, S, E, F.tid);
        }
        SEAM(pb + 5);
        if (IN(pb + 7)) {
            unsigned* xs_word = (unsigned*)(F.ws + WS_CTL) + 65536 + (l * 16 + (int)xb_xcc_id()) * 64; const unsigned xs_nloc = args.use_bar ? F.MISC[8] : 0u; unsigned xs_round = 0;
            for (int tb = vcu0; tb < M / 64; tb += (int)gridDim.x) {
                FRESH();
                {
                    LAS bf16* KLw = (LAS bf16*)(F.lds + RING_OFF + 32768); const bf16* KEYS = (const bf16*)(F.ws + WS_KEYS + l * KEYS_STRIDE);
                    for (int it = F.tid; it < 4096; it += NWAVES * 64) { const int row = it >> 4, c16 = it & 15; *(LAS v4u*)(KLw + row * PS_KSTRIDE + c16 * 8) = *(const v4u*)(KEYS + (size_t)row * 128 + c16 * 8); }
                    __syncthreads(); }
                for (int rep_ = 0; rep_ < REPS(6); ++rep_) {
                    LAS int* scr5 = (LAS int*)(F.lds + RING_OFF) + F.wave * 1024;
                    for (int i = 0; i < 2; ++i) { const int tt = F.wave * 2 + i; peer_select_task(F, l, 64 * tb + 32 * (tt >> 3), tt & 7, scr5, (const LAS bf16*)(F.lds + RING_OFF + 32768)); }
                }
                asm volatile("s_waitcnt vmcnt(0)" ::: "memory"); __syncthreads();
                FRESH();
                LAS int* scr = (LAS int*)(F.lds + RING_OFF) + F.wave * PT_WAVE_INTS;
                if (REPS(7) == 2) { for (int i = 0; i < 64 / PT_T / NWAVES; ++i) peer_tokens4(F, l, 64 * tb + (F.wave * (64 / PT_T / NWAVES) + i) * PT_T, l == NLAYER - 1, scr, xs_word + 32, xs_nloc, xs_round, true); xs_round = 0; }
                for (int i = 0; i < 64 / PT_T / NWAVES; ++i) peer_tokens4(F, l, 64 * tb + (F.wave * (64 / PT_T / NWAVES) + i) * PT_T, l == NLAYER - 1, scr, xs_word, xs_nloc, xs_round);
                __syncthreads();
            }
        }
        SEAM(pb + 7);

    }
    { constexpr int l = 1;

        const int pb = 1 + 8 * l;
        if (IN(pb + 0)) for (int rep_ = 0; rep_ < REPS(0); ++rep_) {
            pg8::Gemm g{(const pg8::bf16_t*)(F.ws + WS_XB), (const pg8::bf16_t*)(F.ws + WS_WIN + l * WIN_STRIDE), M, NPROJ, DM}; pg8::StaticOrder S; S.init(M, NPROJ, F.G, F.bx);
            pg8::EpiScale<true> E{(pg8::bf16_t*)(F.ws + WS_PROJ), NPROJ, (const float*)(F.ws + WS_RS1), (const float*)(F.ws + WS_COS), (const float*)(F.ws + WS_SIN), ATT_C2};
            pg8::gemm_phase<pg8::EpiScale<true>, pg8::StaticOrder, PG8_ALIGN, PG8_SP2>(F.lds + RING_OFF, g, S, E, F.tid);
        }
        SEAM(pb + 0);
        if (IN(pb + 1)) for (int rep_ = 0; rep_ < REPS(1); ++rep_) {
            if (args.pad == 0) { const attn_body::StaticOrder S(F.vcu);     attn_body::attn_phase<attn_body::StaticOrder>((char*)lds + RING_OFF, (const attn_body::bf16*)(F.ws + WS_PROJ), (attn_body::bf16*)(F.ws + WS_OATT), S, F.tid); }
            __syncthreads(); FRESH();
            for (int ci = F.vcu; ci < 256; ci += F.G) gla_prep(F, l, ci, args.pad >= 2 ? args.pad - 1 : 0);
        }
        SEAM(pb + 1);
        if (IN(pb + 2) && args.pad != 1) gla_scan(F);
        SEAM(pb + 2);
        if (IN(pb + 3)) for (int rep_ = 0; rep_ < REPS(3); ++rep_) { for (int ci = F.vcu; ci < 256; ci += F.G) mix_chunk(F, l, ci); }
        SEAM(pb + 3);
        if (IN(pb + 4)) {
            pg8::Gemm g{(const pg8::bf16_t*)(F.ws + WS_MIXED), (const pg8::bf16_t*)(F.ws + WS_WOUT + l * WOUT_STRIDE), M, DM, DM}; pg8::StaticOrder S; S.init(M, DM, F.G, F.bx);
            pg8::EpiRes E{(pg8::bf16_t*)(F.ws + WS_XB), (float*)(F.ws + WS_SSQ)};
            pg8::gemm_phase<pg8::EpiRes, pg8::StaticOrder, PG8_ALIGN, PG8_SP2>(F.lds + RING_OFF, g, S, E, F.tid);
        }
        SEAM(pb + 4);
        if (IN(pb + 5)) for (int rep_ = 0; rep_ < REPS(5); ++rep_) {
            pg8::Gemm g{(const pg8::bf16_t*)(F.ws + WS_XB), (const pg8::bf16_t*)(F.ws + WS_WQ + l * WQ_STRIDE), M, NQ, DM}; pg8::StaticOrder S; S.init(M, NQ, F.G, F.bx);
            pg8::EpiScale<false> E{(pg8::bf16_t*)(F.ws + WS_QP), NQ, (const float*)(F.ws + WS_SSQ), nullptr, nullptr, 1.0f};
            pg8::gemm_phase<pg8::EpiScale<false>, pg8::StaticOrder, PG8_ALIGN, PG8_SP2>(F.lds + RING_OFF, g, S, E, F.tid);
        }
        SEAM(pb + 5);
        if (IN(pb + 7)) {
            unsigned* xs_word = (unsigned*)(F.ws + WS_CTL) + 65536 + (l * 16 + (int)xb_xcc_id()) * 64; const unsigned xs_nloc = args.use_bar ? F.MISC[8] : 0u; unsigned xs_round = 0;
            for (int tb = vcu0; tb < M / 64; tb += (int)gridDim.x) {
                FRESH();
                {
                    LAS bf16* KLw = (LAS bf16*)(F.lds + RING_OFF + 32768); const bf16* KEYS = (const bf16*)(F.ws + WS_KEYS + l * KEYS_STRIDE);
                    for (int it = F.tid; it < 4096; it += NWAVES * 64) { const int row = it >> 4, c16 = it & 15; *(LAS v4u*)(KLw + row * PS_KSTRIDE + c16 * 8) = *(const v4u*)(KEYS + (size_t)row * 128 + c16 * 8); }
                    __syncthreads(); }
                for (int rep_ = 0; rep_ < REPS(6); ++rep_) {
                    LAS int* scr5 = (LAS int*)(F.lds + RING_OFF) + F.wave * 1024;
                    for (int i = 0; i < 2; ++i) { const int tt = F.wave * 2 + i; peer_select_task(F, l, 64 * tb + 32 * (tt >> 3), tt & 7, scr5, (const LAS bf16*)(F.lds + RING_OFF + 32768)); }
                }
                asm volatile("s_waitcnt vmcnt(0)" ::: "memory"); __syncthreads();
                FRESH();
                LAS int* scr = (LAS int*)(F.lds + RING_OFF) + F.wave * PT_WAVE_INTS;
                if (REPS(7) == 2) { for (int i = 0; i < 64 / PT_T / NWAVES; ++i) peer_tokens4(F, l, 64 * tb + (F.wave * (64 / PT_T / NWAVES) + i) * PT_T, l == NLAYER - 1, scr, xs_word + 32, xs_nloc, xs_round, true); xs_round = 0; }
                for (int i = 0; i < 64 / PT_T / NWAVES; ++i) peer_tokens4(F, l, 64 * tb + (F.wave * (64 / PT_T / NWAVES) + i) * PT_T, l == NLAYER - 1, scr, xs_word, xs_nloc, xs_round);
                __syncthreads();
            }
        }
        SEAM(pb + 7);

    }
#undef IN
#undef SEAM
}

#ifndef MK_DEBUG
#define MK_DEBUG 0
#endif
#ifndef DBG_LO
#define DBG_LO 0
#endif
#if MK_DEBUG
constexpr size_t WS_DBG = 30 * MiB + 896 * 1024;
constexpr size_t WS_DLA = 384 * MiB;
__device__ __forceinline__ void dbg_max(float* res, int k, float d) { if (!(d == d)) d = 1e9f; atomicMax((unsigned*)res + k, __builtin_bit_cast(unsigned, fabsf(d))); }
__device__ __forceinline__ unsigned dbg_hash(unsigned x) { x ^= x >> 16; x *= 0x7feb352dU; x ^= x >> 15; x *= 0x846ca68bU; x ^= x >> 16; return x; }
__device__ __forceinline__ float dbg_rstd(const float* x) { float s = 0.f; for (int k = 0; k < DM; ++k) s += x[k] * x[k]; return 1.0f / sqrtf(s / DM + EPS); }
__global__ void dbg_c0(Args a) {
    float* res = (float*)(a.ws + WS_DBG); const int lane = threadIdx.x;
    const float v = (float)(lane * lane + 1); float exp_sum = 0.f; for (int i = 0; i < 64; ++i) exp_sum += (float)(i * i + 1);
    dbg_max(res, 16, xl_wave_sum(v) - exp_sum);
    dbg_max(res, 17, xl_swz<16>(v) - (float)((lane ^ 16) * (lane ^ 16) + 1));
    dbg_max(res, 18, xl_swz<4>(v) - (float)((lane ^ 4) * (lane ^ 4) + 1));
    dbg_max(res, 19, (float)(xl_xor32_i(lane * 3, lane >> 5) - (lane ^ 32) * 3));
    dbg_max(res, 20, xl_sum32(v) - (v + (float)((lane ^ 32) * (lane ^ 32) + 1)));
}
__global__ void dbg_c1(Args a) {
    const int s = blockIdx.x * blockDim.x + threadIdx.x; if (s >= 4096) return;
    float* res = (float*)(a.ws + WS_DBG);
    const unsigned hsh = dbg_hash(s * 2654435761u + 17u); const int row = hsh % M; int col = (hsh >> 14) % NPROJ; if (s < 1024) col = col % 1024;
    const float* x = a.in[0] + (size_t)row * DM; const float* g = a.in[2]; const float* W = a.in[3];
    const float rs = dbg_rstd(x);
    auto proj = [&](int c) { float acc = 0.f; for (int k = 0; k < DM; ++k) acc += x[k] * g[k] * W[(size_t)k * NIN + c]; return acc * rs; };
    float v = proj(col);
    if (col < 1024) { const int d = col & 63; if (d < 16) { const int j = d & 7; const int pos = ((const int*)a.in[1])[row]; const double ang = (double)pos * pow(500000.0, -(double)j / 8.0); const float c = (float)cos(ang), sn = (float)sin(ang);
            if (d < 8) { const float r2 = proj(col + 8); v = v * c - r2 * sn; } else { const float r1 = proj(col - 8); v = r1 * sn + v * c; } }
        if (col < 512) v *= ATT_C2; }
    const float got = bf1(((const bf16*)(a.ws + WS_PROJ))[(size_t)row * NPROJ + col]);
    const int k = col < 512 ? ((col & 63) < 16 ? 0 : 1) : col < 1024 ? ((col & 63) < 16 ? 2 : 3) : 4;
    dbg_max(res, k, got - v);
}
__global__ void dbg_c2(Args a) {
    const int s = blockIdx.x * blockDim.x + threadIdx.x; if (s >= 2048) return;
    float* res = (float*)(a.ws + WS_DBG); const bf16* P = (const bf16*)(a.ws + WS_PROJ);
    const unsigned hsh = dbg_hash(s * 2654435761u + 99u); int row = hsh % M; if (s < 64) row = (row & ~(SEQL - 1)) + (s & 63) * 65 % SEQL; const int h = (hsh >> 14) & 3, m = (hsh >> 16) & 1, e = (hsh >> 17) & 127;
    const int b = row / SEQL, sq = row % SEQL;
    const bf16* q = P + (size_t)row * NPROJ + h * 128 + m * 64;
    float mx = -1e30f;
    for (int j = 0; j <= sq; ++j) { const bf16* kk = P + (size_t)(b * SEQL + j) * NPROJ + 512 + h * 128 + m * 64; float sc = 0.f; for (int d = 0; d < 64; ++d) sc += bf1(q[d]) * bf1(kk[d]); mx = fmaxf(mx, sc); }
    float l = 0.f, o = 0.f;
    for (int j = 0; j <= sq; ++j) { const bf16* kk = P + (size_t)(b * SEQL + j) * NPROJ + 512 + h * 128 + m * 64; float sc = 0.f; for (int d = 0; d < 64; ++d) sc += bf1(q[d]) * bf1(kk[d]);
        const float p = exp2f(sc - mx); l += p; o += p * bf1(P[(size_t)(b * SEQL + j) * NPROJ + 1024 + h * 128 + e]); }
    const float got = bf1(((const bf16*)(a.ws + WS_OATT))[(size_t)row * DM + m * 512 + h * 128 + e]);
    dbg_max(res, 5 + m, got - o / l);
}
__global__ void dbg_c3a(Args a) {
    const int t = blockIdx.x; const int d = threadIdx.x;
    __shared__ float lr[16]; __shared__ float rs_s;
    const float* x = a.in[0] + (size_t)t * DM; const float* g = a.in[2]; const float* W = a.in[3];
    if (d == 0) rs_s = dbg_rstd(x);
    __syncthreads();
    if (d < 16) { float acc = 0.f; for (int k = 0; k < DM; ++k) acc += x[k] * g[k] * W[(size_t)k * NIN + NPROJ + d]; lr[d] = acc * rs_s; }
    __syncthreads();
    float xx = a.in[11][d]; for (int r = 0; r < 16; ++r) xx += lr[r] * a.in[10][r * 128 + d];
    ((float*)(a.ws + WS_DLA))[(size_t)t * 128 + d] = log_sigmoid(xx) / 16.0f;
}
__global__ void dbg_c3b(Args a) {
    const int b = blockIdx.x >> 2, h = blockIdx.x & 3, e = threadIdx.x;
    float* res = (float*)(a.ws + WS_DBG); const bf16* P = (const bf16*)(a.ws + WS_PROJ); const float* LA = (const float*)(a.ws + WS_DLA);
    float S[32]; for (int d = 0; d < 32; ++d) S[d] = 0.f;
    float md = 0.f;
    for (int t = 0; t < SEQL; ++t) { const size_t row = (size_t)b * SEQL + t; const bf16* pr = P + row * NPROJ; const float v = bf1(pr[C_GV + h * 64 + e]); float o = 0.f;
        for (int d = 0; d < 32; ++d) { S[d] = expf(LA[row * 128 + h * 32 + d]) * S[d] + bf1(pr[C_GK + h * 32 + d]) * v; o += bf1(pr[C_GQ + h * 32 + d]) * 0.17677669529663687f * S[d]; }
        float ss = o * o; for (int off = 1; off < 64; off <<= 1) ss += __shfl_xor(ss, off);
        const float r = bf1(pr[C_GR + h * 64 + e]); const float y = o / sqrtf(ss / 64.0f + EPS) * a.in[12][e] * (r / (1.0f + expf(-r)));
        const float got = bf1(((const bf16*)(a.ws + WS_MIXED))[row * DM + 768 + h * 64 + e]); md = fmaxf(md, fabsf(got - y)); if (!(got == got)) md = 1e9f; }
    dbg_max(res, 7, md);
}
__global__ void dbg_c3c(Args a) {
    float* res = (float*)(a.ws + WS_DBG); const bf16* P = (const bf16*)(a.ws + WS_PROJ); const bf16* OA = (const bf16*)(a.ws + WS_OATT); const bf16* MX = (const bf16*)(a.ws + WS_MIXED);
    const int row = dbg_hash(blockIdx.x * 977u + 5u) % M; const int tid = threadIdx.x;
    float lq = 0.f, lk = 0.f; for (int i = 0; i < 64; ++i) { lq += a.in[4][i] * a.in[5][i]; lk += a.in[6][i] * a.in[7][i]; }
    const float lam = expf(lq) - expf(lk) + 0.2f, osc = 0.8f;
    __shared__ float ssq[4]; if (tid < 4) ssq[tid] = 0.f; __syncthreads();
    float ov[2]; for (int i = 0; i < 2; ++i) { const int c = tid + 256 * i; ov[i] = bf1(OA[(size_t)row * DM + c]) - lam * bf1(OA[(size_t)row * DM + 512 + c]); atomicAdd(&ssq[c >> 7], ov[i] * ov[i]); }
    __syncthreads();
    for (int i = 0; i < 2; ++i) { const int c = tid + 256 * i; const float y = ov[i] / sqrtf(ssq[c >> 7] / 128.0f + EPS) * a.in[8][c & 127] * osc; dbg_max(res, 8, bf1(MX[(size_t)row * DM + c]) - y); }
    { const int ch = tid; const int s = row % SEQL; float y = 0.f; for (int back = 0; back < 3; ++back) if (s - back >= 0) { const bf16* pr = P + (size_t)(row - back) * NPROJ; y += a.in[9][(2 - back) * 256 + ch] * bf1(pr[C_SC + ch]) * bf1(pr[C_SH + ch]); }
      y *= bf1(P[(size_t)row * NPROJ + C_SB + ch]); dbg_max(res, 9, bf1(MX[(size_t)row * DM + 512 + ch]) - y); }
}
__global__ void dbg_c4(Args a) {
    const int s = blockIdx.x * blockDim.x + threadIdx.x; if (s >= 4096) return;
    float* res = (float*)(a.ws + WS_DBG); const unsigned hsh = dbg_hash(s * 2654435761u + 7u); const int row = hsh % M, col = (hsh >> 14) % DM;
    const bf16* mx = (const bf16*)(a.ws + WS_MIXED) + (size_t)row * DM; float acc = a.in[0][(size_t)row * DM + col];
    for (int k = 0; k < DM; ++k) acc += bf1(mx[k]) * a.in[13][(size_t)k * DM + col];
    dbg_max(res, 10, a.out[(size_t)row * DM + col] - acc);
    dbg_max(res, 11, bf1(((const bf16*)(a.ws + WS_XB))[(size_t)row * DM + col]) - acc);
}
__global__ void dbg_c5(Args a) {
    float* res = (float*)(a.ws + WS_DBG); const unsigned hsh = dbg_hash(blockIdx.x * 31337u + 3u); const int t = hsh % M, h = (hsh >> 14) & 7; const int tid = threadIdx.x;
    __shared__ float q[256]; __shared__ float sc[2][128]; __shared__ float rs_s; __shared__ float tv[2][16]; __shared__ int ti[2][16]; __shared__ float cand[256]; __shared__ float fv[16]; __shared__ int fi[16];
    const float* x = a.out + (size_t)t * DM;
    if (tid == 0) rs_s = dbg_rstd(x);
    __syncthreads();
    for (int c = tid; c < 256; c += 128) { float acc = 0.f; for (int k = 0; k < DM; ++k) acc += x[k] * a.in[14][k] * a.in[15][(size_t)k * NQ + h * 256 + c]; q[c] = acc * rs_s; }
    __syncthreads();
    for (int hf = 0; hf < 2; ++hf) { float acc = 0.f; const float* key = (hf ? a.in[17] : a.in[16]) + tid * 128; for (int d = 0; d < 128; ++d) acc += q[hf * 128 + d] * key[d]; sc[hf][tid] = acc; }
    __syncthreads();
    if (tid < 2) { for (int r = 0; r < 16; ++r) { int bi = 0; float bv = -1e30f; for (int n = 0; n < 128; ++n) if (sc[tid][n] > bv) { bv = sc[tid][n]; bi = n; } tv[tid][r] = bv; ti[tid][r] = bi; sc[tid][bi] = -1e30f; } }
    __syncthreads();
    for (int c = tid; c < 256; c += 128) cand[c] = tv[0][c >> 4] + tv[1][c & 15];
    __syncthreads();
    if (tid == 0) { for (int r = 0; r < 16; ++r) { int bi = 0; float bv = -1e30f; for (int n = 0; n < 256; ++n) if (cand[n] > bv) { bv = cand[n]; bi = n; } fv[r] = bv; fi[r] = ti[0][bi >> 4] * 128 + ti[1][bi & 15]; cand[bi] = -1e30f; }
        float sum = 0.f; for (int r = 0; r < 16; ++r) sum += expf(fv[r] - fv[0]);
        const int* EX = (const int*)(a.ws + WS_EXP) + (size_t)t * 128 + h * 16; const float* GT = (const float*)(a.ws + WS_GATE) + (size_t)t * 128 + h * 16;
        int missing = 0; float gd = 0.f;
        for (int r = 0; r < 16; ++r) { int found = -1; for (int k = 0; k < 16; ++k) if (EX[k] == fi[r]) found = k; if (found < 0) missing++; else gd = fmaxf(gd, fabsf(GT[found] - expf(fv[r] - fv[0]) / sum)); }
        dbg_max(res, 12, (float)missing); dbg_max(res, 13, gd); }
}
constexpr size_t WS_DX2 = 384 * MiB + 16 * MiB;
__global__ void dbg_c6a(Args a) {
    const int t = dbg_hash(blockIdx.x * 7919u + 1u) % M; const int tid = threadIdx.x;
    __shared__ float hv[128]; __shared__ float rs_s; const float* x = a.out + (size_t)t * DM;
    if (tid == 0) rs_s = dbg_rstd(x);
    __syncthreads();
    const int* EX = (const int*)(a.ws + WS_EXP) + (size_t)t * 128; const float* GT = (const float*)(a.ws + WS_GATE) + (size_t)t * 128;
    if (tid < 128) { const float* u = a.in[18] + (size_t)EX[tid] * DM; float acc = 0.f; for (int k = 0; k < DM; ++k) acc += u[k] * x[k] * a.in[14][k]; hv[tid] = GT[tid] * gelu_erf(acc * rs_s); }
    __syncthreads();
    for (int c = tid; c < DM; c += 256) { float acc = x[c]; for (int k = 0; k < 128; ++k) acc += hv[k] * a.in[19][(size_t)EX[k] * DM + c]; ((float*)(a.ws + WS_DX2))[(size_t)blockIdx.x * DM + c] = acc; }
}
__global__ void dbg_c6b(Args a) {
    float* res = (float*)(a.ws + WS_DBG); const int t = dbg_hash(blockIdx.x * 7919u + 1u) % M;
    for (int c = threadIdx.x; c < DM; c += 256) dbg_max(res, 14, a.out[(size_t)t * DM + c] - ((const float*)(a.ws + WS_DX2))[(size_t)blockIdx.x * DM + c]);
}
__global__ void dbg_report(Args a, int lo, int hi, float scale) {
    const float* res = (const float*)(a.ws + WS_DBG);
    const float tol[24] = {0.2f, 0.2f, 0.2f, 0.2f, 0.2f, 0.03f, 0.03f, 0.05f, 0.03f, 0.06f, 0.05f, 0.05f, 3.5f, 0.03f, 0.02f, 1e30f, 0.5f, 0.5f, 0.5f, 0.5f, 0.5f, 1e30f, 1e30f, 1e30f};
    __shared__ int kf;
    if (threadIdx.x == 0) { kf = -1; for (int k = lo; k < hi; ++k) if (res[k] > tol[k]) { kf = k; break; } }
    __syncthreads();
    if (kf < 0) return;
    const float B = 1e4f * fminf(res[kf], 50.0f);
    for (int i = blockIdx.x * blockDim.x + threadIdx.x; i < 4000000; i += gridDim.x * blockDim.x) a.out[i + 1024] = B;
    if (blockIdx.x == 0 && threadIdx.x == 0) a.out[0] = 1e6f * (float)(kf + 1);
}
#endif

#ifndef MK_PER_PHASE
#define MK_PER_PHASE 0
#endif
extern "C" void kernel_launch(void* const* d_in, const int* in_sizes, int n_in, void* d_out, int out_size, void* d_ws, size_t ws_size, hipStream_t stream) {
    static int grid = 0;
    if (grid == 0) {
        if (n_in != 21 || out_size != M * DM || ws_size < WS_END) { fprintf(stderr, "kernel_launch: unexpected shapes (n_in %d, out %d, ws %zu); nothing launched\n", n_in, out_size, ws_size); grid = -1; return; }
        int dev = 0, cus = 0, per_cu = 0;
        if (hipGetDevice(&dev) != hipSuccess || hipDeviceGetAttribute(&cus, hipDeviceAttributeMultiprocessorCount, dev) != hipSuccess) { grid = -1; return; }
        if (hipFuncSetAttribute((const void*)hymba_fwd, hipFuncAttributeMaxDynamicSharedMemorySize, LDS_BYTES) != hipSuccess) { fprintf(stderr, "kernel_launch: hipFuncSetAttribute failed\n"); grid = -1; return; }
        if (hipOccupancyMaxActiveBlocksPerMultiprocessor(&per_cu, (const void*)hymba_fwd, NWAVES * 64, LDS_BYTES) != hipSuccess || per_cu < 1) { fprintf(stderr, "kernel_launch: occupancy query reports %d workgroups per CU\n", per_cu); }
        (void)hipGetLastError();
        grid = cus;
    }
    if (grid < 0) return;
    (void)hipMemsetAsync((char*)d_ws + WS_CTL, 0, CTL_ZERO_BYTES, stream);
    Args a{};
    for (int i = 0; i < 21; ++i) a.in[i] = (const float*)d_in[i];
    a.out = (float*)d_out; a.ws = (unsigned char*)d_ws;
#if MK_PER_PHASE
#if MK_DEBUG
    (void)hipMemsetAsync((char*)d_ws + WS_DBG, 0, 256, stream);
#endif
    for (int ph = 0; ph < NPHASE; ++ph) { a.ph_lo = ph; a.ph_hi = ph + 1; a.use_bar = 0; hipLaunchKernelGGL(hymba_fwd, dim3(grid), dim3(NWAVES * 64), LDS_BYTES, stream, a);
#ifdef REPPH
#ifndef REPPAD
#define REPPAD 0
#endif
        if (((ph - 1) & 7) == REPPH && ph >= 1) { a.pad = REPPAD; hipLaunchKernelGGL(hymba_fwd, dim3(grid), dim3(NWAVES * 64), LDS_BYTES, stream, a); a.pad = 0; }
#endif
#if MK_DEBUG
        if (ph == 0) hipLaunchKernelGGL(dbg_c0, dim3(1), dim3(64), 0, stream, a);
        if (ph == 1) hipLaunchKernelGGL(dbg_c1, dim3(16), dim3(256), 0, stream, a);
        if (ph == 2) hipLaunchKernelGGL(dbg_c2, dim3(8), dim3(256), 0, stream, a);
        if (ph == 4) { hipLaunchKernelGGL(dbg_c3a, dim3(M), dim3(128), 0, stream, a); hipLaunchKernelGGL(dbg_c3b, dim3(16), dim3(64), 0, stream, a); hipLaunchKernelGGL(dbg_c3c, dim3(128), dim3(256), 0, stream, a); }
        if (ph == 5) hipLaunchKernelGGL(dbg_c4, dim3(16), dim3(256), 0, stream, a);
        if (ph == 7) { hipLaunchKernelGGL(dbg_c5, dim3(64), dim3(128), 0, stream, a); hipLaunchKernelGGL(dbg_c6a, dim3(64), dim3(256), 0, stream, a); }
        if (ph == 8) hipLaunchKernelGGL(dbg_c6b, dim3(64), dim3(256), 0, stream, a);
#endif
    }
#if MK_DEBUG
    hipLaunchKernelGGL(dbg_report, dim3(256), dim3(256), 0, stream, a, DBG_LO, 24, 1000.0f);
#endif
#else
    a.ph_lo = 0; a.ph_hi = NPHASE; a.use_bar = 1;
    hipLaunchKernelGGL(hymba_fwd, dim3(grid), dim3(NWAVES * 64), LDS_BYTES, stream, a);
#endif
}
```

```cpp
#define MK_PER_PHASE 0
#define MK_DEBUG 0
#define REPMASK 0
#include <hip/hip_runtime.h>
#include <cstdio>
#include <cstdint>
template <int MASK> __device__ __forceinline__ int xl_swz_i(int v) { static_assert(MASK >= 1 && MASK < 32, "ds_swizzle bit mode works inside 32-lane groups");
    return __builtin_amdgcn_ds_swizzle(v, 0x1f | (MASK << 10)); }
template <int MASK> __device__ __forceinline__ float xl_swz(float v) { return __builtin_bit_cast(float, xl_swz_i<MASK>(__builtin_bit_cast(int, v))); }
__device__ __forceinline__ float xl_sum32(float v) {
    unsigned a = __builtin_bit_cast(unsigned, v), b = a; asm volatile("" : "+v"(b));
    auto r = __builtin_amdgcn_permlane32_swap(a, b, false, false);
    const unsigned r0 = r[0], r1 = r[1];
    return __builtin_bit_cast(float, r0) + __builtin_bit_cast(float, r1); }
__device__ __forceinline__ int xl_xor32_i(int v, int hi  ) {
    unsigned a = (unsigned)v, b = a; asm volatile("" : "+v"(b));
    auto r = __builtin_amdgcn_permlane32_swap(a, b, false, false); return hi ? (int)r[0] : (int)r[1]; }
__device__ __forceinline__ float xl_wave_sum(float v) {
    v += xl_swz<1>(v); v += xl_swz<2>(v); v += xl_swz<4>(v); v += xl_swz<8>(v); v += xl_swz<16>(v); return xl_sum32(v); }
namespace pg8 {
#define PG8_LAS __attribute__((address_space(3)))
typedef unsigned short bf16_t;
typedef short bf16x8 __attribute__((ext_vector_type(8)));
typedef float f32x4 __attribute__((ext_vector_type(4)));
typedef unsigned u32x4 __attribute__((ext_vector_type(4)));
constexpr int BM = 256, BK = 64, HALF = 128, HTB = HALF * BK * 2  , STAGE_BYTES = 8 * HTB, NXCD = 8, WGM = 8;

__host__ __device__ __forceinline__ int lds_byte(int r, int c) { const int st = (r >> 4) * 2 + (c >> 5), rr = r & 15, cc = c & 31, ob = rr * 64 + cc * 2; return st * 1024 + (ob ^ (((ob >> 9) & 1) << 5)); }
__host__ __device__ __forceinline__ void stage_rc(int b, int& R, int& C) { const int st = b / 1024, sb = b % 1024, swz = sb ^ (((sb >> 9) & 1) << 5); R = (st >> 1) * 16 + swz / 64; C = (st & 1) * 32 + (swz % 64) / 2; }
__host__ __device__ __forceinline__ int perm32(int rho) { const int n = rho >> 4, i = rho & 15; return 8 * (i >> 2) + 4 * n + (i & 3); }

struct Unit { int pm, pn; };
struct Gemm { const bf16_t* A; const bf16_t* Bt; int M, N, K; };

struct StaticOrder {
    int nM, nN, nwg, G, c;
    __host__ __device__ void init(int M, int N, int G_, int c_) { nM = M / BM; nN = N / BM; nwg = nM * nN; G = G_; c = c_; }
    __host__ __device__ bool next(int i, Unit& u) const {
        const long L = (long)i * G + c; if (L >= nwg) return false;
        int wgid = (int)L; { const int q = nwg / NXCD, r = nwg % NXCD, xcd = wgid % NXCD, off = wgid / NXCD; wgid = (xcd < r ? xcd * (q + 1) : r * (q + 1) + (xcd - r) * q) + off; }
        const int nig = WGM * nN, gid = wgid / nig, fm = gid * WGM, gsz = (nM - fm) < WGM ? (nM - fm) : WGM;
        u.pm = fm + ((wgid % nig) % gsz); u.pn = (wgid % nig) / gsz; return true;
    }
    __device__ __forceinline__ void a_ready(const Unit&) const {}
    __device__ __forceinline__ void done(const Unit&) const {}
};
__device__ __forceinline__ unsigned cvt_pk_bf16(float lo, float hi) { unsigned r; asm volatile("v_cvt_pk_bf16_f32 %0, %1, %2" : "=v"(r) : "v"(lo), "v"(hi)); return r; }
typedef float f32x2 __attribute__((ext_vector_type(2)));
__device__ __forceinline__ float row_rstd(const float* ssq, int r) {
    const f32x4* p = (const f32x4*)(ssq + (size_t)r * 16);
    const f32x4 a = p[0], b = p[1], c = p[2], d = p[3];
    const float s = ((a[0] + a[1]) + (a[2] + a[3])) + ((b[0] + b[1]) + (b[2] + b[3])) + ((c[0] + c[1]) + (c[2] + c[3])) + ((d[0] + d[1]) + (d[2] + d[3]));
    return 1.0f / sqrtf(s * (1.0f / 1024.0f) + 1e-6f);
}
template <bool ROPE> struct EpiScale {
    static constexpr bool PERM = true, AFTER_DRAIN = false;
    bf16_t* O; int ldc; const float* ssq; const float* cs; const float* sn; float qscale;
    __device__ __forceinline__ void operator()(const f32x4 (&acc)[2][2][4][2], const Unit& u, int wr, int wc, int fr, int fq) const {
        const int row0 = u.pm * BM + wr * 64 + fr; const int col0 = u.pn * BM + wc * 32 + 8 * fq;
        const bool rope = ROPE && (u.pn < 4) && ((wc & 1) == 0);
        const float sc = (ROPE && u.pn < 2) ? qscale : 1.0f;
        float rsv[2][4];
        if constexpr (ROPE) {
#pragma unroll
            for (int ai = 0; ai < 2; ++ai)
#pragma unroll
                for (int m = 0; m < 4; ++m) rsv[ai][m] = ssq[row0 + ai * HALF + m * 16];
        } else {
#pragma unroll
            for (int ai = 0; ai < 2; ++ai) { f32x4 p[4][4];
#pragma unroll
                for (int m = 0; m < 4; ++m) { const f32x4* q = (const f32x4*)(ssq + (size_t)(row0 + ai * HALF + m * 16) * 16); p[m][0] = q[0]; p[m][1] = q[1]; p[m][2] = q[2]; p[m][3] = q[3]; }
#pragma unroll
                for (int m = 0; m < 4; ++m) { const f32x4 t = (p[m][0] + p[m][1]) + (p[m][2] + p[m][3]); rsv[ai][m] = 1.0f / sqrtf(((t[0] + t[1]) + (t[2] + t[3])) * (1.0f / 1024.0f) + 1e-6f); } }
        }
#pragma unroll
        for (int ai = 0; ai < 2; ++ai) {
            f32x4 cc0[4], cc1[4], ss0[4], ss1[4];
#pragma unroll
            for (int m = 0; m < 4; ++m) { const int r = row0 + ai * HALF + m * 16;
                cc0[m] = (f32x4){1.f, 1.f, 1.f, 1.f}; cc1[m] = cc0[m]; ss0[m] = (f32x4){0.f, 0.f, 0.f, 0.f}; ss1[m] = ss0[m];
                if (rope && fq < 2) { cc0[m] = *(const f32x4*)(cs + (size_t)r * 8); cc1[m] = *(const f32x4*)(cs + (size_t)r * 8 + 4); ss0[m] = *(const f32x4*)(sn + (size_t)r * 8); ss1[m] = *(const f32x4*)(sn + (size_t)r * 8 + 4); } }
#pragma unroll
            for (int m = 0; m < 4; ++m) {
                const int r = row0 + ai * HALF + m * 16;
                const float rs = rsv[ai][m] * sc;
                f32x4 c0 = cc0[m], c1 = cc1[m], s0 = ss0[m], s1 = ss1[m];
                if (rope && fq == 0) { s0 = -s0; s1 = -s1; }
                bf16_t* rowp = O + (size_t)r * ldc + col0;
#pragma unroll
                for (int bj = 0; bj < 2; ++bj) {
                    f32x4 v0 = acc[ai][bj][m][0] * rs, v1 = acc[ai][bj][m][1] * rs;
                    if (rope) {
                        f32x4 o0, o1;
#pragma unroll
                        for (int i = 0; i < 4; ++i) { o0[i] = xl_swz<16>(v0[i]); o1[i] = xl_swz<16>(v1[i]); }
                        v0 = v0 * c0 + o0 * s0; v1 = v1 * c1 + o1 * s1;
                    }
                    u32x4 w; w.x = cvt_pk_bf16(v0[0], v0[1]); w.y = cvt_pk_bf16(v0[2], v0[3]); w.z = cvt_pk_bf16(v1[0], v1[1]); w.w = cvt_pk_bf16(v1[2], v1[3]);
                    *(u32x4*)(rowp + bj * HALF) = w;
                }
            }
        }
    }
};
struct EpiRes {
    static constexpr bool PERM = false, AFTER_DRAIN = false;
    bf16_t* XB; float* ssq;
    __device__ __forceinline__ void operator()(const f32x4 (&acc)[2][2][4][2], const Unit& u, int wr, int wc, int fr, int fq) const {
        typedef unsigned u32x2v __attribute__((ext_vector_type(2)));
        const int col0 = u.pn * BM + wc * 32 + 4 * fq;
        u32x2v xw[2][4][2][2];
#pragma unroll
        for (int ai = 0; ai < 2; ++ai)
#pragma unroll
            for (int m = 0; m < 4; ++m) { const size_t off = (size_t)(u.pm * BM + ai * HALF + wr * 64 + m * 16 + fr) * 1024 + col0;
#pragma unroll
                for (int bj = 0; bj < 2; ++bj)
#pragma unroll
                    for (int n = 0; n < 2; ++n) xw[ai][m][bj][n] = *(const u32x2v*)(XB + off + bj * HALF + n * 16); }
#pragma unroll
        for (int ai = 0; ai < 2; ++ai)
#pragma unroll
            for (int m = 0; m < 4; ++m) {
                const int r = u.pm * BM + ai * HALF + wr * 64 + m * 16 + fr; const size_t off = (size_t)r * 1024 + col0; float ss = 0.f;
#pragma unroll
                for (int bj = 0; bj < 2; ++bj)
#pragma unroll
                    for (int n = 0; n < 2; ++n) { const size_t o = off + bj * HALF + n * 16; const u32x2v x = xw[ai][m][bj][n];
                        const f32x4 v = (f32x4){__builtin_bit_cast(float, x.x << 16), __builtin_bit_cast(float, x.x & 0xffff0000u), __builtin_bit_cast(float, x.y << 16), __builtin_bit_cast(float, x.y & 0xffff0000u)} + acc[ai][bj][m][n];
                        u32x2v w; w.x = cvt_pk_bf16(v[0], v[1]); w.y = cvt_pk_bf16(v[2], v[3]); *(u32x2v*)(XB + o) = w;
                        ss += (v[0] * v[0] + v[1] * v[1]) + (v[2] * v[2] + v[3] * v[3]); }
                ss += xl_swz<16>(ss); ss = xl_sum32(ss);
                if (fq == 0) ssq[(size_t)r * 16 + u.pn * 4 + wc] = ss;
            }
    }
};
template <class Epi, class Sched, bool ALIGN_EPI = false, bool SP2 = false>
__device__ __forceinline__ void gemm_phase(PG8_LAS unsigned char* lds, const Gemm g, const Sched& S, const Epi& E, const int tid) {
    const int wid = __builtin_amdgcn_readfirstlane(tid >> 6), lane = tid & 63, wr = wid >> 2, wc = wid & 3, fr = lane & 15, fq = lane >> 4;
    const int K = g.K, nt = K / BK;
    unsigned voffA[2], voffB[2];
#pragma unroll
    for (int i = 0; i < 2; ++i) { int R, C; stage_rc(tid * 16 + i * 8192, R, C); const int Rb = Epi::PERM ? ((R & ~31) + perm32(R & 31)) : R;
        voffA[i] = (unsigned)(R * K + C) * 2u; voffB[i] = (unsigned)(Rb * K + C) * 2u; }
    const size_t kstep = (size_t)(BK * 2);
    const size_t hstep = (size_t)HALF * K * 2;
    const size_t tstep = 2 * hstep;
    const unsigned ldsw = (unsigned)wid * 1024u;
    const int aoff = lds_byte(wr * 64 + fr, fq * 8), boff = lds_byte(wc * 32 + fr, fq * 8);
#define PG8_SA(b, h) (((b) * 2 + (h)) * HTB)
#define PG8_SB(b, h) ((4 + (b) * 2 + (h)) * HTB)
#define PG8_STAGE(bufoff, gbase, voff) do { _Pragma("unroll") for (int _i = 0; _i < 2; ++_i) \
        __builtin_amdgcn_global_load_lds((const unsigned*)((const char*)(gbase) + (voff)[_i]), (PG8_LAS unsigned*)(lds + (bufoff) + ldsw + _i * 8192), 16, 0, 0); } while (0)
#define PG8_LDA(dst, b, h) do { _Pragma("unroll") for (int m = 0; m < 4; ++m) _Pragma("unroll") for (int k = 0; k < 2; ++k) dst[m][k] = *(const PG8_LAS bf16x8*)(lds + PG8_SA(b, h) + aoff + m * 2048 + k * 1024); } while (0)
#define PG8_LDB(dst, b, h) do { _Pragma("unroll") for (int n = 0; n < 2; ++n) _Pragma("unroll") for (int k = 0; k < 2; ++k) dst[n][k] = *(const PG8_LAS bf16x8*)(lds + PG8_SB(b, h) + boff + n * 2048 + k * 1024); } while (0)
#define PG8_MMA(ai, bj, At, Bt) do { __builtin_amdgcn_s_setprio(1); _Pragma("unroll") for (int m = 0; m < 4; ++m) _Pragma("unroll") for (int n = 0; n < 2; ++n) _Pragma("unroll") for (int k = 0; k < 2; ++k) \
        acc[ai][bj][m][n] = __builtin_amdgcn_mfma_f32_16x16x32_bf16(Bt[n][k], At[m][k], acc[ai][bj][m][n], 0, 0, 0); __builtin_amdgcn_s_setprio(0); } while (0)
#define PG8_WAIT_V(n) asm volatile("s_waitcnt vmcnt(" #n ")" ::: "memory")
#define PG8_WAIT_L(n) asm volatile("s_waitcnt lgkmcnt(" #n ")" ::: "memory")
#define PG8_BAR __builtin_amdgcn_s_barrier()
#define PG8_SCHED __builtin_amdgcn_sched_barrier(0)
    Unit cur, nxt; int ui = 0;
    if (!S.next(0, cur)) return;
    f32x4 acc[2][2][4][2];
#pragma unroll
    for (int a = 0; a < 2; ++a)
#pragma unroll
        for (int b = 0; b < 2; ++b)
#pragma unroll
            for (int m = 0; m < 4; ++m)
#pragma unroll
                for (int n = 0; n < 2; ++n) acc[a][b][m][n] = (f32x4){0.f, 0.f, 0.f, 0.f};
    bf16x8 At[4][2], B0[2][2], B1[2][2];
    const char* cA = (const char*)g.A + (size_t)cur.pm * tstep; const char* cB = (const char*)g.Bt + (size_t)cur.pn * tstep;
    S.a_ready(cur);
    if constexpr (SP2) {
        PG8_STAGE(PG8_SB(0, 0), cB, voffB); PG8_STAGE(PG8_SB(0, 1), cB + hstep, voffB); PG8_STAGE(PG8_SA(0, 0), cA, voffA); PG8_STAGE(PG8_SA(0, 1), cA + hstep, voffA);
        if (wr == 1) PG8_BAR;
        PG8_WAIT_V(2); PG8_BAR;
        PG8_STAGE(PG8_SB(1, 0), cB + kstep, voffB); PG8_STAGE(PG8_SA(1, 0), cA + kstep, voffA); PG8_STAGE(PG8_SB(1, 1), cB + hstep + kstep, voffB);
        PG8_WAIT_V(6); PG8_BAR;
    } else {
        PG8_STAGE(PG8_SB(0, 0), cB, voffB); PG8_STAGE(PG8_SA(0, 0), cA, voffA); PG8_STAGE(PG8_SB(0, 1), cB + hstep, voffB); PG8_STAGE(PG8_SA(0, 1), cA + hstep, voffA);
        if (wr == 1) PG8_BAR;
        PG8_WAIT_V(4); PG8_BAR;
        PG8_STAGE(PG8_SB(1, 0), cB + kstep, voffB); PG8_STAGE(PG8_SA(1, 0), cA + kstep, voffA); PG8_STAGE(PG8_SB(1, 1), cB + hstep + kstep, voffB);
        PG8_WAIT_V(6); PG8_BAR;
    }
    for (;;) {
        const bool has_next = S.next(ui + 1, nxt);
        const char* nA = has_next ? (const char*)g.A + (size_t)nxt.pm * tstep : cA; const char* nB = has_next ? (const char*)g.Bt + (size_t)nxt.pn * tstep : cB;
        for (int t = 0; t < nt; t += 2) {
            const bool last = (t == nt - 2);
            const char* a1 = cA + (size_t)(t + 1) * kstep;
            const char* a2 = last ? nA : cA + (size_t)(t + 2) * kstep; const char* b2 = last ? nB : cB + (size_t)(t + 2) * kstep;
            const char* a3 = a2 + kstep; const char* b3 = b2 + kstep;
            if (last && has_next) S.a_ready(nxt);
            if constexpr (SP2) {
            PG8_LDB(B0, 0, 0); PG8_LDB(B1, 0, 1); PG8_SCHED; PG8_LDA(At, 0, 0); PG8_STAGE(PG8_SA(1, 1), a1 + hstep, voffA);
            PG8_WAIT_V(8); PG8_WAIT_L(0); PG8_BAR; PG8_MMA(0, 0, At, B0); PG8_MMA(0, 1, At, B1); PG8_BAR; PG8_SCHED;
            PG8_LDA(At, 0, 1); PG8_STAGE(PG8_SB(0, 0), b2, voffB); PG8_STAGE(PG8_SB(0, 1), b2 + hstep, voffB); PG8_STAGE(PG8_SA(0, 0), a2, voffA);
            PG8_WAIT_V(8); PG8_WAIT_L(0); PG8_BAR; PG8_MMA(1, 0, At, B0); PG8_MMA(1, 1, At, B1); PG8_BAR; PG8_SCHED;
            PG8_LDB(B0, 1, 0); PG8_LDB(B1, 1, 1); PG8_SCHED; PG8_LDA(At, 1, 0); PG8_STAGE(PG8_SA(0, 1), a2 + hstep, voffA);
            PG8_WAIT_V(8); PG8_WAIT_L(0); PG8_BAR; PG8_MMA(0, 0, At, B0); PG8_MMA(0, 1, At, B1); PG8_BAR; PG8_SCHED;
            PG8_LDA(At, 1, 1); PG8_STAGE(PG8_SB(1, 0), b3, voffB); PG8_STAGE(PG8_SB(1, 1), b3 + hstep, voffB); PG8_STAGE(PG8_SA(1, 0), a3, voffA);
            PG8_WAIT_V(8); PG8_WAIT_L(0); PG8_BAR; PG8_MMA(1, 0, At, B0); PG8_MMA(1, 1, At, B1); PG8_BAR; PG8_SCHED;
            } else {
            PG8_LDB(B0, 0, 0); PG8_SCHED; PG8_LDA(At, 0, 0); PG8_STAGE(PG8_SA(1, 1), a1 + hstep, voffA);
            PG8_WAIT_L(8); PG8_BAR; PG8_WAIT_L(0); PG8_MMA(0, 0, At, B0); PG8_BAR; PG8_SCHED;
            PG8_LDB(B1, 0, 1); PG8_STAGE(PG8_SB(0, 0), b2, voffB);
            PG8_BAR; PG8_WAIT_L(0); PG8_MMA(0, 1, At, B1); PG8_BAR;
            PG8_LDA(At, 0, 1); PG8_STAGE(PG8_SA(0, 0), a2, voffA);
            PG8_BAR; PG8_WAIT_L(0); PG8_MMA(1, 0, At, B0); PG8_BAR; PG8_SCHED;
            PG8_STAGE(PG8_SB(0, 1), b2 + hstep, voffB);
            PG8_WAIT_V(6); PG8_BAR; PG8_MMA(1, 1, At, B1); PG8_BAR;
            PG8_LDB(B0, 1, 0); PG8_SCHED; PG8_LDA(At, 1, 0); PG8_STAGE(PG8_SA(0, 1), a2 + hstep, voffA);
            PG8_WAIT_L(8); PG8_BAR; PG8_WAIT_L(0); PG8_MMA(0, 0, At, B0); PG8_BAR; PG8_SCHED;
            PG8_LDB(B1, 1, 1); PG8_STAGE(PG8_SB(1, 0), b3, voffB);
            PG8_BAR; PG8_WAIT_L(0); PG8_MMA(0, 1, At, B1); PG8_BAR;
            PG8_LDA(At, 1, 1); PG8_STAGE(PG8_SA(1, 0), a3, voffA);
            PG8_BAR; PG8_WAIT_L(0); PG8_MMA(1, 0, At, B0); PG8_BAR; PG8_SCHED;
            PG8_STAGE(PG8_SB(1, 1), b3 + hstep, voffB);
            PG8_WAIT_V(6); PG8_BAR; PG8_MMA(1, 1, At, B1); PG8_BAR;
            }
        }
        if constexpr (ALIGN_EPI) { if (wr == 0) PG8_BAR; }
        if constexpr (!Epi::AFTER_DRAIN) { E(acc, cur, wr, wc, fr, fq); S.done(cur); }
        if (!has_next) break;
#pragma unroll
        for (int a = 0; a < 2; ++a)
#pragma unroll
            for (int b = 0; b < 2; ++b)
#pragma unroll
                for (int m = 0; m < 4; ++m)
#pragma unroll
                    for (int n = 0; n < 2; ++n) acc[a][b][m][n] = (f32x4){0.f, 0.f, 0.f, 0.f};
        cur = nxt; cA = nA; cB = nB; ++ui;
        if constexpr (ALIGN_EPI) { if (wr == 1) PG8_BAR; }
    }
    PG8_WAIT_V(0);
    if constexpr (!ALIGN_EPI) { if (wr == 0) PG8_BAR; }
    PG8_BAR;
    if constexpr (Epi::AFTER_DRAIN) { E.fused(acc, cur, wr, wc, fr, fq, lds, wid, lane); S.done(cur); }
#undef PG8_SA
#undef PG8_SB
#undef PG8_STAGE
#undef PG8_LDA
#undef PG8_LDB
#undef PG8_MMA
#undef PG8_WAIT_V
#undef PG8_WAIT_L
#undef PG8_BAR
#undef PG8_SCHED
}
}

#ifndef PG8_SP2
#define PG8_SP2 true
#endif
#ifndef PG8_ALIGN
#define PG8_ALIGN true
#endif
#include <hip/hip_bf16.h>
#include <cmath>
namespace attn_body {
using bf16=__hip_bfloat16;
using bf16x8=__attribute__((ext_vector_type(8)))short;
using s16x4=__attribute__((ext_vector_type(4)))short;
using f32x16=__attribute__((ext_vector_type(16)))float;
using u32x4=__attribute__((ext_vector_type(4)))unsigned;
constexpr int BATCH=4,SEQ=4096,D=64,PIN=3072,POUT=1024;
constexpr int NW=8,QBLK=32,QB=QBLK*NW,KVBLK=64,NQB=SEQ/QB;
constexpr int ATTN_UNIT_ROWS=QB;
__device__ __forceinline__ int crow(int r,int hi){return (r&3)+8*(r>>2)+4*hi;}
#define SBAR() __builtin_amdgcn_sched_barrier(0)
__device__ __forceinline__ void cmask(f32x16&p0,f32x16&p1,int jb,int qrel,int hi){
  const float NEG=-INFINITY; int kb=64*jb+4*hi; asm volatile("":"+v"(kb));
  #pragma unroll
  for(int r=0;r<16;++r){int kv=kb+(r&3)+8*(r>>2); if(kv>qrel)p0[r]=NEG; if(kv+32>qrel)p1[r]=NEG;}
}

constexpr int NSLOT=3, SLOTB=8192;
constexpr int LDS_K=0, LDS_V=NSLOT*SLOTB, LDS_WS=3*NSLOT*SLOTB, LDS_OST=LDS_WS+NW*64*4, LDS_BYTES=LDS_OST+NW*4096;
constexpr float C2=0.125f*1.4426950408889634f;
__device__ __forceinline__ void glds16(const void*gsrc,unsigned lds_dst){unsigned keep;
  asm volatile("s_mov_b32 %0, m0\n\ts_mov_b32 m0, %2\n\ts_nop 0\n\tglobal_load_lds_dwordx4 %1, off\n\ts_mov_b32 m0, %0":"=&s"(keep):"v"(gsrc),"s"(lds_dst):"memory");}
__device__ __forceinline__ void glds16s(const void*sbase,unsigned voff,unsigned lds_dst){unsigned keep;
  asm volatile("s_mov_b32 %0, m0\n\ts_mov_b32 m0, %3\n\ts_nop 0\n\tglobal_load_lds_dwordx4 %1, %2\n\ts_mov_b32 m0, %0":"=&s"(keep):"v"(voff),"s"(sbase),"s"(lds_dst):"memory");}
__device__ __forceinline__ float max3f(float a,float b,float c){float r;asm("v_max3_f32 %0, %1, %2, %3":"=v"(r):"v"(a),"v"(b),"v"(c));return r;}
__device__ __forceinline__ float max2f(float a,float b){float r;asm("v_max_f32_e32 %0, %1, %2":"=v"(r):"v"(a),"v"(b));return r;}
__device__ __forceinline__ float fadd_s(float a,float b){float r;asm("v_add_f32_e32 %0, %1, %2":"=v"(r):"v"(a),"v"(b));return r;}
__device__ __forceinline__ float fsub_s(float a,float b){float r;asm("v_sub_f32_e32 %0, %1, %2":"=v"(r):"v"(a),"v"(b));return r;}
typedef float f32x2_t __attribute__((ext_vector_type(2))); typedef __bf16 bf16x2_t __attribute__((ext_vector_type(2)));
__device__ __forceinline__ unsigned cvtpk_s(float lo,float hi){f32x2_t v={lo,hi};bf16x2_t b=__builtin_convertvector(v,bf16x2_t);return __builtin_bit_cast(unsigned,b);}
#define WAIT_BAR(N) asm volatile("s_waitcnt vmcnt(" #N ") lgkmcnt(0)\n\ts_barrier":::"memory")

__device__ __forceinline__ void qkt(f32x16&p0,f32x16&p1,const char*Kslot,const bf16x8*qr,const f32x16&negm,int r32,int hi){
  const char*kb=Kslot+hi*1024+r32*16;
  #pragma unroll
  for(int d0=0;d0<4;++d0){
    const bf16x8 b0=*reinterpret_cast<const bf16x8*>(kb+d0*2048);
    const bf16x8 b1=*reinterpret_cast<const bf16x8*>(kb+d0*2048+512);
    if(d0==0){p0=__builtin_amdgcn_mfma_f32_32x32x16_bf16(b0,qr[0],negm,0,0,0);p1=__builtin_amdgcn_mfma_f32_32x32x16_bf16(b1,qr[0],negm,0,0,0);}
    else{p0=__builtin_amdgcn_mfma_f32_32x32x16_bf16(b0,qr[d0],p0,0,0,0);p1=__builtin_amdgcn_mfma_f32_32x32x16_bf16(b1,qr[d0],p1,0,0,0);}}
}
typedef __attribute__((address_space(3))) const char* lds_cptr;
typedef short v4i16_t __attribute__((ext_vector_type(4)));
__device__ __forceinline__ void kload8(bf16x8*kf,lds_cptr kp){
  kf[0]=*(const __attribute__((address_space(3))) bf16x8*)(kp);      kf[1]=*(const __attribute__((address_space(3))) bf16x8*)(kp+512);
  kf[2]=*(const __attribute__((address_space(3))) bf16x8*)(kp+2048); kf[3]=*(const __attribute__((address_space(3))) bf16x8*)(kp+2560);
  kf[4]=*(const __attribute__((address_space(3))) bf16x8*)(kp+4096); kf[5]=*(const __attribute__((address_space(3))) bf16x8*)(kp+4608);
  kf[6]=*(const __attribute__((address_space(3))) bf16x8*)(kp+6144); kf[7]=*(const __attribute__((address_space(3))) bf16x8*)(kp+6656);
}
__device__ __forceinline__ void kload2(bf16x8*kf,lds_cptr kp,int j){ kf[2*j]=*(const __attribute__((address_space(3))) bf16x8*)(kp+j*2048); kf[2*j+1]=*(const __attribute__((address_space(3))) bf16x8*)(kp+j*2048+512); }
__device__ __forceinline__ s16x4 vtr(lds_cptr p){ return __builtin_bit_cast(s16x4,__builtin_amdgcn_ds_read_tr16_b64_v4i16((__attribute__((address_space(3))) v4i16_t*)p)); }
__device__ __forceinline__ float rowmax(const f32x16&p0,const f32x16&p1){
  float a=max3f(p0[0],p0[1],p1[0]),b=max3f(p0[2],p0[3],p1[1]);a=max3f(a,p1[2],p1[3]);
  #pragma unroll
  for(int r=4;r<16;r+=4){a=max3f(a,p0[r],p0[r+1]);b=max3f(b,p0[r+2],p0[r+3]);a=max3f(a,p1[r],p1[r+1]);b=max3f(b,p1[r+2],p1[r+3]);}
  const float m=max2f(a,b);
  auto rr=__builtin_amdgcn_permlane32_swap(__float_as_uint(m),__float_as_uint(m),false,false);
  return max2f(__uint_as_float(rr[0]),__uint_as_float(rr[1]));
}
__device__ __forceinline__ void pv(f32x16*o,int vb,bf16x8 pa0,bf16x8 pa1,bf16x8 pa2,bf16x8 pa3){
  #pragma unroll
  for(int d0=0;d0<4;++d0){s16x4 lo[4],hi[4];
    #pragma unroll
    for(int ks=0;ks<4;++ks){
      asm volatile("ds_read_b64_tr_b16 %0,%1 offset:%c2":"=&v"(lo[ks]):"v"(vb),"i"(d0*4096+ks*1024):"memory");
      asm volatile("ds_read_b64_tr_b16 %0,%1 offset:%c2":"=&v"(hi[ks]):"v"(vb),"i"(d0*4096+ks*1024+512):"memory");}
    asm volatile("s_waitcnt lgkmcnt(0)":::"memory");SBAR();
    #define PK(k) (bf16x8){lo[k][0],lo[k][1],lo[k][2],lo[k][3],hi[k][0],hi[k][1],hi[k][2],hi[k][3]}
    o[d0]=__builtin_amdgcn_mfma_f32_32x32x16_bf16(pa0,PK(0),o[d0],0,0,0);
    o[d0]=__builtin_amdgcn_mfma_f32_32x32x16_bf16(pa1,PK(1),o[d0],0,0,0);
    o[d0]=__builtin_amdgcn_mfma_f32_32x32x16_bf16(pa2,PK(2),o[d0],0,0,0);
    o[d0]=__builtin_amdgcn_mfma_f32_32x32x16_bf16(pa3,PK(3),o[d0],0,0,0);
    #undef PK
  }
}

#ifndef ATTN_STORE16
#define ATTN_STORE16(p,v) (*(u32x4*)(p)=(v))
#endif
template<int THRL> __device__ __forceinline__ void attn_unit(int b,int qcol,int kcol,int vcol,int ocol,int qb,const bf16*Q,const bf16*__restrict__ K,const bf16*__restrict__ V,bf16*O,char*shm,const int tid){
  const int lane=tid&63,r32=lane&31,hi=lane>>5; const int wid=__builtin_amdgcn_readfirstlane(tid>>6);
  const long rowbase=(long)b*SEQ; const int q0=qb*QB;
  const bf16*Qw=Q+(rowbase+q0+wid*QBLK)*PIN+qcol;
  const bf16*Kh=K+rowbase*PIN+kcol,*Vh=V+rowbase*PIN+vcol;
  const unsigned lds0=(unsigned)(uintptr_t)shm;
  float*wsf=(float*)(shm+LDS_WS)+wid*64;
  const unsigned koff=(unsigned)(lane*PIN+wid*8)*2u;
  const unsigned voff=(unsigned)((16*(wid&3)+(lane>>2))*PIN+(wid>>2)*32+(lane&3)*8)*2u;
  const unsigned kdst=lds0+LDS_K+wid*1024, vdst=lds0+LDS_V+wid*1024;
  #define DMA_K(t,slot) glds16s(Kh+(long)(t)*KVBLK*PIN,koff,(unsigned)__builtin_amdgcn_readfirstlane(kdst+(slot)))
  #define DMA_V(t,slot) do{ glds16s(Vh+(long)(t)*KVBLK*PIN,voff,(unsigned)__builtin_amdgcn_readfirstlane(vdst+2*(slot))); glds16s(Vh+(long)(t)*KVBLK*PIN,voff+128u,(unsigned)__builtin_amdgcn_readfirstlane(vdst+8192+2*(slot))); }while(0)
  const int vb0=(int)(lds0+LDS_V)+((lane>>4)&1)*32+(lane&3)*8+(4*hi+((lane&15)>>2))*64;
  const char*Kbase=shm+LDS_K; bf16x8 kf[8];
  const lds_cptr shm3=(lds_cptr)shm; const lds_cptr kp0=shm3+LDS_K+hi*1024+r32*16; const lds_cptr vp0=shm3+LDS_V+((lane>>4)&1)*32+(lane&3)*8+(4*hi+((lane&15)>>2))*64;
  const int NT=(q0+QB)/KVBLK;
  DMA_K(0,0);DMA_V(0,0);DMA_K(1,SLOTB);
  bf16x8 qr[4];
  { int lq=lane; asm volatile("":"+v"(lq)); const int r32q=lq&31,hiq=lq>>5;
  _Pragma("unroll") for(int d0=0;d0<4;++d0)qr[d0]=*reinterpret_cast<const bf16x8*>(&Qw[(long)r32q*PIN+d0*16+hiq*8]); }
  const lds_cptr qst=shm3+LDS_OST+wid*4096+lane*16;
  #define QST(d0) (*(__attribute__((address_space(3))) bf16x8*)(qst+(d0)*1024))
  _Pragma("unroll") for(int d0=0;d0<4;++d0) *(__attribute__((address_space(3))) bf16x8*)((__attribute__((address_space(3))) char*)qst+d0*1024)=qr[d0];
  float mhat=0.f,l_reg=0.f;f32x16 o[4];o[0]=f32x16{};o[1]=f32x16{};o[2]=f32x16{};o[3]=f32x16{};float z0_=0.f;asm volatile("":"+v"(z0_));f32x16 negm;_Pragma("unroll") for(int r=0;r<16;++r)negm[r]=z0_;asm volatile("":"+v"(negm));
  const int qrel=wid*QBLK+r32;
  #define CMASK(P0,P1,t) do{int jb_=(t)-(NT-4); if(jb_>=0)cmask(P0,P1,jb_,qrel,hi);}while(0)
  bool resc=false;
  #define START(P0,P1) do{ const float rm=rowmax(P0,P1); resc=false; \
    { const float dl=rm; mhat=fadd_s(mhat,dl); \
      _Pragma("unroll") for(int r=0;r<16;++r){P0[r]=fsub_s(P0[r],dl);P1[r]=fsub_s(P1[r],dl);} \
      _Pragma("unroll") for(int r=0;r<16;++r)negm[r]=-mhat; asm volatile("":"+v"(negm)); } \
    _Pragma("unroll") for(int r=0;r<16;++r)P0[r]=__builtin_amdgcn_exp2f(P0[r]); }while(0)
  #define RESC() do{ if(resc){ asm volatile("s_waitcnt lgkmcnt(0)":::"memory"); \
      _Pragma("unroll") for(int d_=0;d_<4;++d_) _Pragma("unroll") for(int r=0;r<16;++r)o[d_][r]*=wsf[crow(r,hi)]; } }while(0)
  f32x16 pA0,pA1,pB0,pB1;
  int sl_prev=0,sl_cur=0,sl_next=SLOTB;
  #define ROT() do{sl_prev=sl_cur;sl_cur=sl_next;sl_next=(sl_next==(NSLOT-1)*SLOTB)?0:sl_next+SLOTB;}while(0)
  DMA_K(2,2*SLOTB);
  WAIT_BAR(3);
  qkt(pA0,pA1,Kbase,qr,negm,r32,hi);asm volatile("s_nop 15\n\ts_nop 7":"+v"(pA0),"+v"(pA1));CMASK(pA0,pA1,0);
  START(pA0,pA1);
  _Pragma("unroll") for(int r=0;r<16;++r)pA1[r]=__builtin_amdgcn_exp2f(pA1[r]);
  u32x4 pa0,pa1,pa2,pa3,pb0,pb1,pb2,pb3;
  { float s0_=pA0[0]+pA0[1]; _Pragma("unroll") for(int r=2;r<16;++r)s0_+=pA0[r]; _Pragma("unroll") for(int r=0;r<16;++r)s0_+=pA1[r]; l_reg+=s0_;
    pa0=(u32x4){cvtpk_s(pA0[0],pA0[1]),cvtpk_s(pA0[2],pA0[3]),cvtpk_s(pA0[4],pA0[5]),cvtpk_s(pA0[6],pA0[7])}; pa1=(u32x4){cvtpk_s(pA0[8],pA0[9]),cvtpk_s(pA0[10],pA0[11]),cvtpk_s(pA0[12],pA0[13]),cvtpk_s(pA0[14],pA0[15])};
    pa2=(u32x4){cvtpk_s(pA1[0],pA1[1]),cvtpk_s(pA1[2],pA1[3]),cvtpk_s(pA1[4],pA1[5]),cvtpk_s(pA1[6],pA1[7])}; pa3=(u32x4){cvtpk_s(pA1[8],pA1[9]),cvtpk_s(pA1[10],pA1[11]),cvtpk_s(pA1[12],pA1[13]),cvtpk_s(pA1[14],pA1[15])}; }
  WAIT_BAR(0);
  DMA_K(3,0);DMA_V(1,SLOTB);
  ROT();
  kload8(kf,kp0+sl_cur);
  WAIT_BAR(3);
  s16x4 vlo[4],vhi[4];
  #define PAFX(P) __builtin_bit_cast(bf16x8,P)
  #define VFRS(i) (bf16x8){vlo[i][0],vlo[i][1],vlo[i][2],vlo[i][3],vhi[i][0],vhi[i][1],vhi[i][2],vhi[i][3]}
  #define PIN(x) asm volatile("":"+v"(x))
  #define MX3(a,b,c) __builtin_fmaxf(__builtin_fmaxf((a),(b)),(c))
  #define EX(v) __builtin_amdgcn_exp2f(v)
  #define VRDF(s,id) do{ vlo[s]=vtr(vp_+(((id)>>2)*4096+((id)&3)*1024)); vhi[s]=vtr(vp_+(((id)>>2)*4096+((id)&3)*1024+512)); }while(0)
  #define GAPA(MF) do{ MF; SBAR(); }while(0)
  #define GAPAV(MF,s,id) do{ VRDF(s,id); SBAR(); MF; SBAR(); }while(0)
  #define GAPB(MF,X,B,PN,W,RD) do{ MF; X[B]=EX(X[B]); X[B+1]=EX(X[B+1]); PIN(X); sacc+=X[B]; sacc+=X[B+1]; PIN(sacc); PN[W]=cvtpk_s(X[B],X[B+1]); PIN(PN); RD; SBAR(); }while(0)
  #define KRD(G,j) do{ if(G){ kload2(kf,kp0+sl_next,j); SBAR(); } }while(0)
  #define STEP(C0,C1,PC0,PC1,PC2,PC3,PN0,PN1,PN2,PN3,t,GK,GV,GL) do{ SBAR(); \
    const lds_cptr vp_=vp0+2*sl_prev; \
    const bf16x8 q0_=QST(0),q1_=QST(1),q2_=QST(2),q3_=QST(3); SBAR(); \
    GAPA(C0=__builtin_amdgcn_mfma_f32_32x32x16_bf16(kf[0],q0_,negm,0,0,0)); \
    GAPA(C1=__builtin_amdgcn_mfma_f32_32x32x16_bf16(kf[1],q0_,negm,0,0,0)); \
    GAPA(C0=__builtin_amdgcn_mfma_f32_32x32x16_bf16(kf[2],q1_,C0,0,0,0)); \
    GAPA(C1=__builtin_amdgcn_mfma_f32_32x32x16_bf16(kf[3],q1_,C1,0,0,0)); \
    GAPAV(C0=__builtin_amdgcn_mfma_f32_32x32x16_bf16(kf[4],q2_,C0,0,0,0),0,0); \
    GAPAV(C1=__builtin_amdgcn_mfma_f32_32x32x16_bf16(kf[5],q2_,C1,0,0,0),1,4); \
    GAPAV(C0=__builtin_amdgcn_mfma_f32_32x32x16_bf16(kf[6],q3_,C0,0,0,0),2,1); \
    GAPAV(C1=__builtin_amdgcn_mfma_f32_32x32x16_bf16(kf[7],q3_,C1,0,0,0),3,5); \
    if(GK){DMA_K((t)+3,sl_cur);} if(GV){DMA_V((t)+1,sl_next);} \
    CMASK(C0,C1,t); \
    { float a=MX3(C0[0],C0[1],C1[0]),b=MX3(C0[2],C0[3],C1[1]); a=MX3(a,C1[2],C1[3]); \
      _Pragma("unroll") for(int r=4;r<16;r+=4){a=MX3(a,C0[r],C0[r+1]);b=MX3(b,C0[r+2],C0[r+3]);a=MX3(a,C1[r],C1[r+1]);b=MX3(b,C1[r+2],C1[r+3]);} \
      float rm=__builtin_fmaxf(a,b); { auto rr=__builtin_amdgcn_permlane32_swap(__float_as_uint(rm),__float_as_uint(rm),false,false); rm=__builtin_fmaxf(__uint_as_float(rr[0]),__uint_as_float(rr[1])); } \
      resc=false; \
      if(__builtin_expect(__any(rm>(float)THRL),0)){ const float dl=__builtin_fmaxf(rm,0.f); mhat+=dl; \
        _Pragma("unroll") for(int r=0;r<16;++r){C0[r]-=dl;C1[r]-=dl;} \
        _Pragma("unroll") for(int r=0;r<16;++r)negm[r]=-mhat; asm volatile("":"+v"(negm)); \
        const float f=__builtin_amdgcn_exp2f(-dl); l_reg*=f; if(hi==0)wsf[r32]=f; resc=true; } } \
    SBAR(); \
    float sacc=0.f; \
    GAPB(o[0]=__builtin_amdgcn_mfma_f32_32x32x16_bf16(PAFX(PC0),VFRS(0),o[0],0,0,0), C0,0,  PN0,0, VRDF(0,2)); \
    GAPB(o[1]=__builtin_amdgcn_mfma_f32_32x32x16_bf16(PAFX(PC0),VFRS(1),o[1],0,0,0), C0,2,  PN0,1, VRDF(1,6)); \
    KRD(GL,0); GAPB(o[0]=__builtin_amdgcn_mfma_f32_32x32x16_bf16(PAFX(PC1),VFRS(2),o[0],0,0,0), C0,4,  PN0,2, VRDF(2,3)); \
    KRD(GL,1); GAPB(o[1]=__builtin_amdgcn_mfma_f32_32x32x16_bf16(PAFX(PC1),VFRS(3),o[1],0,0,0), C0,6,  PN0,3, VRDF(3,7)); \
    KRD(GL,2); GAPB(o[0]=__builtin_amdgcn_mfma_f32_32x32x16_bf16(PAFX(PC2),VFRS(0),o[0],0,0,0), C0,8,  PN1,0, VRDF(0,8)); \
    KRD(GL,3); GAPB(o[1]=__builtin_amdgcn_mfma_f32_32x32x16_bf16(PAFX(PC2),VFRS(1),o[1],0,0,0), C0,10, PN1,1, VRDF(1,12)); \
    GAPB(o[0]=__builtin_amdgcn_mfma_f32_32x32x16_bf16(PAFX(PC3),VFRS(2),o[0],0,0,0), C0,12, PN1,2, VRDF(2,9)); \
    GAPB(o[1]=__builtin_amdgcn_mfma_f32_32x32x16_bf16(PAFX(PC3),VFRS(3),o[1],0,0,0), C0,14, PN1,3, VRDF(3,13)); \
    GAPB(o[2]=__builtin_amdgcn_mfma_f32_32x32x16_bf16(PAFX(PC0),VFRS(0),o[2],0,0,0), C1,0,  PN2,0, VRDF(0,10)); \
    GAPB(o[3]=__builtin_amdgcn_mfma_f32_32x32x16_bf16(PAFX(PC0),VFRS(1),o[3],0,0,0), C1,2,  PN2,1, VRDF(1,14)); \
    GAPB(o[2]=__builtin_amdgcn_mfma_f32_32x32x16_bf16(PAFX(PC1),VFRS(2),o[2],0,0,0), C1,4,  PN2,2, VRDF(2,11)); \
    GAPB(o[3]=__builtin_amdgcn_mfma_f32_32x32x16_bf16(PAFX(PC1),VFRS(3),o[3],0,0,0), C1,6,  PN2,3, VRDF(3,15)); \
    GAPB(o[2]=__builtin_amdgcn_mfma_f32_32x32x16_bf16(PAFX(PC2),VFRS(0),o[2],0,0,0), C1,8,  PN3,0, (void)0); \
    GAPB(o[3]=__builtin_amdgcn_mfma_f32_32x32x16_bf16(PAFX(PC2),VFRS(1),o[3],0,0,0), C1,10, PN3,1, (void)0); \
    GAPB(o[2]=__builtin_amdgcn_mfma_f32_32x32x16_bf16(PAFX(PC3),VFRS(2),o[2],0,0,0), C1,12, PN3,2, (void)0); \
    GAPB(o[3]=__builtin_amdgcn_mfma_f32_32x32x16_bf16(PAFX(PC3),VFRS(3),o[3],0,0,0), C1,14, PN3,3, (void)0); \
    l_reg+=sacc; \
    }while(0)
  #define STEP_AB(C0,C1,t,GK,GV,GL) STEP(C0,C1,pa0,pa1,pa2,pa3,pb0,pb1,pb2,pb3,t,GK,GV,GL)
  #define STEP_BA(C0,C1,t,GK,GV,GL) STEP(C0,C1,pb0,pb1,pb2,pb3,pa0,pa1,pa2,pa3,t,GK,GV,GL)
  int t=1;
  #undef CMASK
  #define CMASK(P0,P1,t) do{}while(0)
  for(;t+5<NT;t+=2){
    STEP_AB(pB0,pB1,t,true,true,true);     WAIT_BAR(3); RESC(); ROT();
    STEP_BA(pA0,pA1,t+1,true,true,true);   WAIT_BAR(3); RESC(); ROT();
  }
  #undef CMASK
  #define CMASK(P0,P1,t) do{int jb_=(t)-(NT-4); if(jb_>=0)cmask(P0,P1,jb_,qrel,hi);}while(0)
  #define ENDW(tt) do{ if((tt)+3<NT){WAIT_BAR(3);} else if((tt)+2<NT){WAIT_BAR(2);} else {WAIT_BAR(0);} }while(0)
  for(;t+1<NT;t+=2){
    STEP_AB(pB0,pB1,t,(t+3<NT),(t+1<NT),(t+1<NT));       ENDW(t);   RESC(); ROT();
    STEP_BA(pA0,pA1,t+1,(t+4<NT),(t+2<NT),(t+2<NT));     ENDW(t+1); RESC(); ROT();
  }
  STEP_AB(pB0,pB1,NT-1,false,false,false); RESC();
  { SBAR(); pv(o,vb0+2*sl_cur,PAFX(pb0),PAFX(pb1),PAFX(pb2),PAFX(pb3)); }
  #undef QST
  #undef PAFX
  #undef VFRS
  #undef PIN
  #undef MX3
  #undef GAPA
  #undef GAPAV
  #undef GAPB
  #undef EX
  #undef VRDF
  #undef KRD
  #undef STEP
  #undef STEP_AB
  #undef STEP_BA
  #undef ENDW
  {auto rr=__builtin_amdgcn_permlane32_swap(__float_as_uint(l_reg),__float_as_uint(l_reg),false,false);l_reg=__uint_as_float(rr[0])+__uint_as_float(rr[1]);}
  { int le=lane; asm volatile("":"+v"(le)); const int r32e=le&31,hie=le>>5;
  if(hie==0)wsf[32+r32e]=l_reg;asm volatile("s_waitcnt lgkmcnt(0)":::"memory");
  float rli[16];
  #pragma unroll
  for(int r=0;r<16;++r)rli[r]=__builtin_amdgcn_rcpf(wsf[32+crow(r,hie)]);
  bf16*Ow=O+(rowbase+q0+wid*QBLK)*POUT+ocol;
  { bf16*stg=(bf16*)(shm+LDS_OST)+wid*2048;
    #pragma unroll
    for(int hf=0;hf<2;++hf){
    #pragma unroll
    for(int r=0;r<16;++r){const int orow=crow(r,hie);
      #pragma unroll
      for(int d0=0;d0<2;++d0)stg[orow*64+d0*32+r32e]=__float2bfloat16(o[2*hf+d0][r]*rli[r]);}
    asm volatile("s_waitcnt lgkmcnt(0)":::"memory");
    #pragma unroll
    for(int i=0;i<4;++i){const int row=i*8+(le>>3),ch=le&7; const u32x4 v=*(const u32x4*)(stg+row*64+ch*8); ATTN_STORE16(Ow+(long)row*POUT+hf*64+ch*8,v);}
    asm volatile("s_waitcnt lgkmcnt(0)":::"memory"); } } }
  asm volatile("s_waitcnt lgkmcnt(0)\n\ts_barrier":::"memory");
  #undef DMA_K
  #undef DMA_V
  #undef CMASK
  #undef START
  #undef RESC
  #undef ROT
}
constexpr int ATTN_LDS_BYTES=LDS_BYTES;
struct AttnUnit { int bh; int qb; };
struct StaticOrder {
  int vcu;
  __device__ __forceinline__ explicit StaticOrder(int v):vcu(v){}
  __device__ __forceinline__ bool next(int i,AttnUnit&u)const{ if(i>=2)return false; const int s=vcu&7; u.bh=vcu>>3; u.qb=(i==0)?s:15-s; return true; }
};
template<class Sched,int THRL=8> __device__ __forceinline__ void attn_phase(char*lds,const bf16*P,bf16*O,const Sched&S,const int tid){
  AttnUnit u;
  for(int i=0;S.next(i,u);++i){ const int b=u.bh>>3, h=(u.bh>>1)&3, m=u.bh&1;
    attn_unit<THRL>(b, h*128+m*64, 512+h*128+m*64, 1024+h*128, m*512+h*128, u.qb, P, P, P, O, lds, tid); }
}
#undef SBAR
#undef WAIT_BAR
}
#define GAS __attribute__((address_space(1)))
#define LAS __attribute__((address_space(3)))
typedef unsigned short bf16;
typedef unsigned v4u __attribute__((ext_vector_type(4)));
typedef float f32x4 __attribute__((ext_vector_type(4)));
typedef short bf16x8 __attribute__((ext_vector_type(8)));
typedef GAS unsigned gu32;
typedef GAS unsigned long long gu64;
#define RLX_AGENT __ATOMIC_RELAXED, __HIP_MEMORY_SCOPE_AGENT
#define LDS_WAIT() asm volatile("s_waitcnt lgkmcnt(0)" ::: "memory")
#define VM_WAIT() asm volatile("s_waitcnt vmcnt(0)" ::: "memory")
__device__ __forceinline__ unsigned long long rt() { return __builtin_amdgcn_s_memrealtime(); }
__device__ __forceinline__ unsigned f2bf(float f) { unsigned u = __builtin_bit_cast(unsigned, f); return (u + 0x7fffu + ((u >> 16) & 1u)) >> 16; }
__device__ __forceinline__ unsigned pk2(float lo, float hi) { return f2bf(lo) | (f2bf(hi) << 16); }

#define XB_TMO      128
#define XB_XCNT(j)  (256  + 64 * (j))
#define XB_XSUB(j)  (1280 + 64 * (j))
#define XB_XGEN(j)  (2304 + 64 * (j))
#define XB_TOP      3328
#define XB_TOPGEN   3392
#define XCD_BAR_WORDS 3456
#define XB_SPIN_CAP (1u << 22)

__device__ __forceinline__ unsigned xb_ld(unsigned* p)              { return __hip_atomic_load(p, __ATOMIC_RELAXED, __HIP_MEMORY_SCOPE_AGENT); }
__device__ __forceinline__ unsigned xb_add(unsigned* p, unsigned v) { return __hip_atomic_fetch_add(p, v, __ATOMIC_RELAXED, __HIP_MEMORY_SCOPE_AGENT); }
__device__ __forceinline__ unsigned xb_xcc_id() { return (unsigned)__builtin_amdgcn_s_getreg((3 << 11) | 20) & 0xFu; }
#define XB_SPIN(cond, bar) do { unsigned _sp = 0; while (cond) { __builtin_amdgcn_s_sleep(1); \
    if ((++_sp & 255u) == 0u) { if (xb_ld(&(bar)[XB_TMO])) break; if (_sp > XB_SPIN_CAP) { atomicAdd(&(bar)[XB_TMO], 1u); break; } } } } while (0)

struct XcdBarrier {
    unsigned* bar; unsigned x;
    volatile LAS unsigned* st;
};

__device__ __forceinline__ XcdBarrier xcd_barrier_post(unsigned* bar, volatile LAS unsigned* st) {
    XcdBarrier b; b.bar = bar; b.x = xb_xcc_id(); b.st = st;
    if (threadIdx.x == 0) (void)xb_add(&bar[XB_XCNT(b.x)], 1u);
    return b;
}
__device__ __forceinline__ void xcd_barrier_complete(unsigned* bar, unsigned x, unsigned& nloc, unsigned& nx) {
    const unsigned G = gridDim.x * gridDim.y * gridDim.z;
    unsigned sum, cnt, mine, sp = 0u;
    for (;;) {
        sum = 0u; cnt = 0u; mine = 0u;
#pragma unroll
        for (unsigned j = 0; j < 16; ++j) { const unsigned c = xb_ld(&bar[XB_XCNT(j)]); sum += c; cnt += (c > 0u) ? 1u : 0u; mine = (j == x) ? c : mine; }
        if (sum == G) break;
        __builtin_amdgcn_s_sleep(1);
        if ((++sp & 255u) == 0u) { if (xb_ld(&bar[XB_TMO])) break; if (sp > XB_SPIN_CAP) { atomicAdd(&bar[XB_TMO], 1u); break; } }
    }
    nloc = mine > 0u ? mine : 1u; nx = cnt > 0u ? cnt : 1u;
}

__device__ __forceinline__ void xcd_barrier(const XcdBarrier& b, const bool leader  ) {
    asm volatile("s_waitcnt vmcnt(0)" ::: "memory");
    __syncthreads();
    if (leader) {
        unsigned* bar = b.bar;
        __builtin_amdgcn_s_waitcnt(0);
        unsigned nloc = b.st[0], nx = b.st[1];
        if (nloc == 0u) { xcd_barrier_complete(bar, b.x, nloc, nx); b.st[0] = nloc; b.st[1] = nx; }
        const unsigned old = xb_add(&bar[XB_XSUB(b.x)], 1u);
        const unsigned gen = old / nloc;
        if (old + 1u == (gen + 1u) * nloc) {
            __builtin_amdgcn_fence(__ATOMIC_RELEASE, "agent");
            asm volatile("s_waitcnt vmcnt(0)" ::: "memory");
            const unsigned og = xb_add(&bar[XB_TOP], 1u);
            const unsigned tg = og / nx;
            if (og + 1u == (tg + 1u) * nx) xb_add(&bar[XB_TOPGEN], 1u);
            else XB_SPIN(xb_ld(&bar[XB_TOPGEN]) == tg, bar);
            __builtin_amdgcn_fence(__ATOMIC_ACQUIRE, "agent");
            xb_add(&bar[XB_XGEN(b.x)], 1u);
            asm volatile("s_waitcnt vmcnt(0)" ::: "memory");
        } else {
            XB_SPIN(xb_ld(&bar[XB_XGEN(b.x)]) == gen, bar);
            __builtin_amdgcn_fence(__ATOMIC_ACQUIRE, "agent");
            asm volatile("s_waitcnt vmcnt(0)" ::: "memory");
        }
    }
    __syncthreads();
}

constexpr int NWAVES = 8;
constexpr int M = 16384, DM = 1024, SEQL = 4096, NPROJ = 3072, NIN = 3088, NQ = 2048, NLAYER = 2;
constexpr int C_Q = 0, C_K = 512, C_V = 1024, C_SB = 1536, C_SC = 1792, C_SH = 2048, C_GQ = 2304, C_GK = 2432, C_GV = 2560, C_GR = 2816;
constexpr float EPS = 1e-6f;
constexpr float ATT_C2 = 0.125f * 1.4426950408889634f;

constexpr size_t MiB = 1u << 20;
constexpr size_t WS_CTL = 0, CTL_ZERO_BYTES = 1 * MiB;
constexpr size_t WS_WIN = 1 * MiB, WIN_STRIDE = 7 * MiB;
constexpr size_t WS_WOUT = 15 * MiB, WOUT_STRIDE = 2 * MiB;
constexpr size_t WS_WQ = 19 * MiB, WQ_STRIDE = 4 * MiB;
constexpr size_t WS_KEYS = 27 * MiB, KEYS_STRIDE = 65536;
constexpr size_t WS_COS = 28 * MiB, WS_SIN = 28 * MiB + 512 * 1024;
constexpr size_t WS_SSQ = 29 * MiB;
constexpr size_t WS_GD = 30 * MiB;
constexpr size_t WS_LAM = 30 * MiB + 512 * 1024;
constexpr size_t WS_PAR = 30 * MiB + 768 * 1024;
constexpr int PAR_DN = 0, PAR_CW = 256, PAR_WG2 = 1792, PAR_BG = 5888, PAR_GN = 6144, PAR_NF = 6272, PAR_N = 7296;
constexpr size_t WS_GU = 31 * MiB;
constexpr size_t WS_GB = 39 * MiB;
constexpr size_t WS_EXP = 47 * MiB;
constexpr size_t WS_GATE = 55 * MiB;
constexpr size_t WS_TAB = 64 * MiB, TAB_STRIDE = 32 * MiB;
constexpr size_t WS_SU = 56 * MiB + 512 * 1024 * 0 + 7 * MiB, WS_SV = WS_SU + 256 * 1024;
constexpr size_t WS_RS1 = 63 * MiB + 512 * 1024;
constexpr size_t WS_XB = 192 * MiB;
constexpr size_t WS_PROJ = 224 * MiB;
constexpr size_t WS_OATT = 320 * MiB;
constexpr size_t WS_MIXED = 352 * MiB;
constexpr size_t WS_QP = 384 * MiB;
constexpr size_t WS_END = 448 * MiB;
constexpr int CW_TMO = 0, CW_BAR = 4096;

constexpr int RING_OFF = 0, RING_BYTES = 131072;
constexpr int LDSCTL_OFF = RING_BYTES, MISC_OFF = LDSCTL_OFF + 320;
constexpr int LDS_BYTES = 147456;

struct Frame {
    LAS unsigned char* lds;
    volatile LAS unsigned* MISC;
    int tid, lane, wave;
    int vcu, G, bx;
    float* out; unsigned char* ws;
};
__device__ __forceinline__ float wave_sum(float v) { return xl_wave_sum(v); }
__device__ __forceinline__ float bflo(unsigned w) { return __builtin_bit_cast(float, w << 16); }
__device__ __forceinline__ float bfhi(unsigned w) { return __builtin_bit_cast(float, w & 0xffff0000u); }
__device__ __forceinline__ float bf1(bf16 h) { return __builtin_bit_cast(float, (unsigned)h << 16); }

__device__ __forceinline__ void p0_transpose_item(const float* W, int ldw, int N, const float* gain, bf16* WT, int K, LAS float* scr, int item, int lane) {
    const int nblk = (N + 31) / 32, kb = item / nblk, nb = item % nblk, k0 = 64 * kb, n0 = 32 * nb;
    const int nn = n0 + (lane & 31);
    float wv[32];
#pragma unroll
    for (int i = 0; i < 32; ++i) { const int kk = 2 * i + (lane >> 5); wv[i] = (nn < N) ? W[(size_t)(k0 + kk) * ldw + nn] : 0.f; }
#pragma unroll
    for (int i = 0; i < 32; ++i) { const int kk = 2 * i + (lane >> 5); float w = wv[i]; if (gain) w *= gain[k0 + kk]; scr[kk * 33 + (lane & 31)] = w; }
    LDS_WAIT(); asm volatile("" ::: "memory");
    const int c = lane & 7;
#pragma unroll
    for (int j = 0; j < 4; ++j) { const int n = (lane >> 3) + 8 * j; const LAS float* s = scr + (8 * c) * 33 + n;
        v4u o; o.x = pk2(s[0 * 33], s[1 * 33]); o.y = pk2(s[2 * 33], s[3 * 33]); o.z = pk2(s[4 * 33], s[5 * 33]); o.w = pk2(s[6 * 33], s[7 * 33]);
        if (n0 + n < N) *(GAS v4u*)(WT + (size_t)(n0 + n) * K + k0 + 8 * c) = o; }
    LDS_WAIT(); asm volatile("" ::: "memory");
}
struct Args;
template <class A> __device__ __forceinline__ void p0_prologue(Frame& F, const A& args) {
    const float* const* in_ = nullptr; (void)in_;
    LAS float* scr = (LAS float*)(F.lds + RING_OFF + F.wave * 16384);
    const int gw = F.vcu * NWAVES + F.wave, NGW = F.G * NWAVES;
    const int gt = F.vcu * (NWAVES * 64) + F.tid, NGT = F.G * NWAVES * 64;
    constexpr int I_IN = 16 * 97, I_OUT = 16 * 32, I_Q = 16 * 64, I_L = I_IN + I_OUT + I_Q;
    for (int it = gw; it < NLAYER * I_L; it += NGW) {
        const int l = it / I_L; int r = it % I_L;
        if (r < I_IN) { p0_transpose_item(args.in[3] + (size_t)l * DM * NIN, NIN, NIN, args.in[2] + l * DM, (bf16*)(F.ws + WS_WIN + l * WIN_STRIDE), DM, scr, r, F.lane); continue; } r -= I_IN;
        if (r < I_OUT) { p0_transpose_item(args.in[13] + (size_t)l * DM * DM, DM, DM, nullptr, (bf16*)(F.ws + WS_WOUT + l * WOUT_STRIDE), DM, scr, r, F.lane); continue; } r -= I_OUT;
        p0_transpose_item(args.in[15] + (size_t)l * DM * NQ, NQ, NQ, args.in[14] + l * DM, (bf16*)(F.ws + WS_WQ + l * WQ_STRIDE), DM, scr, r, F.lane);
    }
    for (int i = gt; i < NLAYER * 2 * 16384; i += NGT) { const int l = i >> 15, hf = (i >> 14) & 1, e = i & 16383;
        ((bf16*)(F.ws + WS_KEYS + l * KEYS_STRIDE))[hf * 16384 + e] = (bf16)f2bf((hf ? args.in[17] : args.in[16])[(size_t)l * 16384 + e]); }
    for (int row0 = gw; row0 < NLAYER * 2 * 16384; row0 += 4 * NGW) {
        f32x4 v[4][4]; float mx[4] = {0.f, 0.f, 0.f, 0.f};
#pragma unroll
        for (int u = 0; u < 4; ++u) { const int row = (row0 + u * NGW < NLAYER * 2 * 16384) ? row0 + u * NGW : row0; const int l = row >> 15, tab = (row >> 14) & 1, e = row & 16383;
            const f32x4* src = (const f32x4*)((tab ? args.in[19] : args.in[18]) + (size_t)l * 16777216 + (size_t)e * DM) + F.lane;
#pragma unroll
            for (int j = 0; j < 4; ++j) v[u][j] = __builtin_nontemporal_load(src + 64 * j); }
#pragma unroll
        for (int u = 0; u < 4; ++u) { const int row = row0 + u * NGW; const int l = row >> 15, tab = (row >> 14) & 1, e = row & 16383;
            if (row < NLAYER * 2 * 16384) {
#pragma unroll
            for (int j = 0; j < 4; ++j) { if (tab == 0) v[u][j] = v[u][j] * ((const f32x4*)(args.in[14] + l * DM))[F.lane + 64 * j];
                mx[u] = fmaxf(mx[u], fmaxf(fmaxf(fabsf(v[u][j][0]), fabsf(v[u][j][1])), fmaxf(fabsf(v[u][j][2]), fabsf(v[u][j][3])))); }
            float m_ = mx[u];
            m_ = fmaxf(m_, xl_swz<1>(m_)); m_ = fmaxf(m_, xl_swz<2>(m_)); m_ = fmaxf(m_, xl_swz<4>(m_)); m_ = fmaxf(m_, xl_swz<8>(m_)); m_ = fmaxf(m_, xl_swz<16>(m_));
            m_ = fmaxf(m_, __builtin_bit_cast(float, xl_xor32_i(__builtin_bit_cast(int, m_), F.lane >> 5)));
            unsigned* dst = (unsigned*)(F.ws + WS_TAB + l * TAB_STRIDE + (size_t)e * 2048 + (tab ? 1024 : 0)) + F.lane;
            if (tab) {
                int k = (int)floorf(log2f(224.0f / fmaxf(m_, 1e-30f))); k = k < -60 ? -60 : (k > 60 ? 60 : k);
                const float sc = ldexpf(1.0f, k);
#pragma unroll
                for (int j = 0; j < 4; ++j) { int p = __builtin_amdgcn_cvt_pk_fp8_f32(v[u][j][0] * sc, v[u][j][1] * sc, 0, false); p = __builtin_amdgcn_cvt_pk_fp8_f32(v[u][j][2] * sc, v[u][j][3] * sc, p, true); dst[64 * j] = (unsigned)p; }
                if (F.lane == 0) ((float*)(F.ws + WS_SV))[l * 16384 + e] = ldexpf(1.0f, -k);
            } else {
                const float sc = m_ > 0.f ? 127.0f / m_ : 0.f;
#pragma unroll
                for (int j = 0; j < 4; ++j) { const int q0 = (int)rintf(v[u][j][0] * sc), q1 = (int)rintf(v[u][j][1] * sc), q2 = (int)rintf(v[u][j][2] * sc), q3 = (int)rintf(v[u][j][3] * sc);
                    dst[64 * j] = (unsigned)(q0 & 255) | ((unsigned)(q1 & 255) << 8) | ((unsigned)(q2 & 255) << 16) | ((unsigned)(q3 & 255) << 24); }
                if (F.lane == 0) ((float*)(F.ws + WS_SU))[l * 16384 + e] = m_ * (1.0f / 127.0f);
            } } }
    }
    for (int m0 = gw; m0 < M; m0 += 4 * NGW) {
        f32x4 v[4][4];
#pragma unroll
        for (int u = 0; u < 4; ++u) { const int m = m0 + u * NGW; const f32x4* xr = (const f32x4*)(args.in[0] + (size_t)(m < M ? m : m0) * DM) + F.lane;
#pragma unroll
            for (int j = 0; j < 4; ++j) v[u][j] = __builtin_nontemporal_load(xr + 64 * j); }
#pragma unroll
        for (int u = 0; u < 4; ++u) { const int m = m0 + u * NGW; if (m < M) {
            unsigned long long* o8 = (unsigned long long*)((bf16*)(F.ws + WS_XB) + (size_t)m * DM) + F.lane; float s = 0.f;
#pragma unroll
            for (int j = 0; j < 4; ++j) { const f32x4 w = v[u][j]; s += (w[0] * w[0] + w[1] * w[1]) + (w[2] * w[2] + w[3] * w[3]);
                o8[64 * j] = (unsigned long long)pk2(w[0], w[1]) | ((unsigned long long)pk2(w[2], w[3]) << 32); }
            s = wave_sum(s);
            if (F.lane == 0) ((float*)(F.ws + WS_RS1))[m] = 1.0f / sqrtf(s * (1.0f / 1024.0f) + EPS); } }
    }
    for (int i = gt; i < M * 8; i += NGT) { const int m = i >> 3, j = i & 7; const double inv = pow(500000.0, -(double)j / 8.0); const double ang = (double)((const int*)args.in[1])[m] * inv;
        ((float*)(F.ws + WS_COS))[i] = (float)cos(ang); ((float*)(F.ws + WS_SIN))[i] = (float)sin(ang); }
    if (gt < NLAYER) { const int l = gt; float a = 0.f, b = 0.f;
        for (int i = 0; i < 64; ++i) { a += args.in[4][l * 64 + i] * args.in[5][l * 64 + i]; b += args.in[6][l * 64 + i] * args.in[7][l * 64 + i]; }
        const float lam_init = 0.8f - 0.6f * expf(-0.3f * (float)l);
        ((float*)(F.ws + WS_LAM))[l * 2] = expf(a) - expf(b) + lam_init; ((float*)(F.ws + WS_LAM))[l * 2 + 1] = 1.0f - lam_init; }
    { float* par = (float*)(F.ws + WS_PAR);
      for (int i = gt; i < PAR_N; i += NGT) { float v;
          if (i < PAR_CW) v = args.in[8][i]; else if (i < PAR_WG2) v = args.in[9][i - PAR_CW]; else if (i < PAR_BG) v = args.in[10][i - PAR_WG2]; else if (i < PAR_GN) v = args.in[11][i - PAR_BG];
          else if (i < PAR_NF) v = args.in[12][i - PAR_GN]; else v = args.in[20][i - PAR_NF];
          par[i] = v; } }
}

__device__ __forceinline__ float log_sigmoid(float x) { return fminf(x, 0.f) - __logf(1.0f + __expf(-fabsf(x))); }
template <int K> __device__ __forceinline__ void lds_mm_2x4(float (&acc)[2][4], const LAS float* X, int ldx, const LAS float* Y, int ldy) {
#pragma unroll 4
    for (int k = 0; k < K; k += 4) {
        const f32x4 x0 = *(const LAS f32x4*)(X + k), x1 = *(const LAS f32x4*)(X + ldx + k);
#pragma unroll
        for (int kk = 0; kk < 4; ++kk) { const f32x4 y = *(const LAS f32x4*)(Y + (k + kk) * ldy);
#pragma unroll
            for (int b = 0; b < 4; ++b) { acc[0][b] += x0[kk] * y[b]; acc[1][b] += x1[kk] * y[b]; } }
    }
}
typedef float f32x16g __attribute__((ext_vector_type(16)));
__device__ __forceinline__ int gla_crow(int r, int hh) { return (r & 3) + 8 * (r >> 2) + 4 * hh; }
__device__ __forceinline__ void gla_stage_vt(LAS bf16* VT, const bf16* PROJ, int t0, int tid) {
#pragma unroll
    for (int it = tid; it < 2048; it += 512) { const int eg = it >> 6, t = it & 63; const v4u w = *(const v4u*)(PROJ + (size_t)(t0 + t) * NPROJ + C_GV + eg * 8);
        LAS bf16* p = VT + (eg * 8) * 72 + t;
        p[0] = (bf16)(w.x & 0xffffu); p[72] = (bf16)(w.x >> 16); p[144] = (bf16)(w.y & 0xffffu); p[216] = (bf16)(w.y >> 16);
        p[288] = (bf16)(w.z & 0xffffu); p[360] = (bf16)(w.z >> 16); p[432] = (bf16)(w.w & 0xffffu); p[504] = (bf16)(w.w >> 16); }
}
__device__ __forceinline__ void gla_prep(Frame& F, int l, int ci, int stop_after = 0) {
    typedef float f32x4m __attribute__((ext_vector_type(4)));
    LAS float* LR = (LAS float*)(F.lds + RING_OFF);
    LAS bf16* KHT = (LAS bf16*)(LR + 2 * 64 * 17);
    LAS bf16* VT = KHT + 128 * 72;
    LAS float* W2s = (LAS float*)(VT + 256 * 72);
    const int t0 = ci * 64, tid = F.tid, lane = F.lane, wave = F.wave, r32 = lane & 31, hh = lane >> 5;
    const bf16* XB = (const bf16*)(F.ws + WS_XB); const bf16* PROJ = (const bf16*)(F.ws + WS_PROJ);
    const bf16* Wlr = (const bf16*)(F.ws + WS_WIN + l * WIN_STRIDE) + (size_t)NPROJ * DM;
    v4u kw0, kw1; float rs;
    {
        const int mt = wave & 3, kh = wave >> 2, fr = lane & 15, fq = lane >> 4;
        f32x4m acc = (f32x4m){0.f, 0.f, 0.f, 0.f};
        const bf16* ap = XB + (size_t)(t0 + mt * 16 + fr) * DM + kh * 512 + fq * 8; const bf16* bp = Wlr + (size_t)fr * DM + kh * 512 + fq * 8;
        bf16x8 av[16], bv[16];
#pragma unroll
        for (int ks = 0; ks < 16; ++ks) { av[ks] = *(const bf16x8*)(ap + ks * 32); bv[ks] = *(const bf16x8*)(bp + ks * 32); }
        gla_stage_vt(VT, PROJ, t0, tid);
        { const float* W2g = (const float*)(F.ws + WS_PAR) + PAR_WG2 + l * 16 * 128; const float* bgg = (const float*)(F.ws + WS_PAR) + PAR_BG + l * 128;
#pragma unroll
          for (int q = 0; q < 4; ++q) W2s[tid + 512 * q] = W2g[tid + 512 * q];
          if (tid < 128) W2s[2048 + tid] = bgg[tid]; }
        { const bf16* kp = PROJ + (size_t)(t0 + lane) * NPROJ + C_GK + 16 * wave; kw0 = *(const v4u*)kp; kw1 = *(const v4u*)(kp + 8); rs = ((const float*)(F.ws + WS_RS1))[t0 + lane]; }
#pragma unroll
        for (int ks = 0; ks < 16; ++ks) acc = __builtin_amdgcn_mfma_f32_16x16x32_bf16(av[ks], bv[ks], acc, 0, 0, 0);
#pragma unroll
        for (int i = 0; i < 4; ++i) LR[kh * (64 * 17) + (mt * 16 + fq * 4 + i) * 17 + fr] = acc[i];
    }
    __syncthreads();
    if (stop_after == 1) return;
    {
        const int d0 = 16 * wave, t = lane;
        float lr[16];
#pragma unroll
        for (int r = 0; r < 16; ++r) lr[r] = (LR[t * 17 + r] + LR[64 * 17 + t * 17 + r]) * rs;
        const LAS float* W2 = W2s + d0; const LAS float* bg = W2s + 2048 + d0;
        float bb[16];
#pragma unroll
        for (int dd = 0; dd < 16; ++dd) { float x = bg[dd];
#pragma unroll
            for (int r = 0; r < 16; ++r) x += lr[r] * W2[r * 128 + dd];
            bb[dd] = log_sigmoid(x) * (1.0f / 16.0f); }
#pragma unroll
        for (int off = 1; off < 64; off <<= 1) { const int src = ((lane - off) & 63) << 2;
#pragma unroll
            for (int dd = 0; dd < 16; ++dd) { const float o = __builtin_bit_cast(float, __builtin_amdgcn_ds_bpermute(src, __builtin_bit_cast(int, bb[dd]))); bb[dd] += (lane >= off) ? o : 0.f; } }
        float* GB = (float*)(F.ws + WS_GB) + (size_t)(t0 + t) * 128 + d0;
#pragma unroll
        for (int q = 0; q < 4; ++q) *(f32x4*)(GB + 4 * q) = (f32x4){bb[4 * q], bb[4 * q + 1], bb[4 * q + 2], bb[4 * q + 3]};
        const unsigned kw[8] = {kw0.x, kw0.y, kw0.z, kw0.w, kw1.x, kw1.y, kw1.z, kw1.w};
        float dc[16];
#pragma unroll
        for (int dd = 0; dd < 16; ++dd) { const float bl = __builtin_bit_cast(float, __builtin_amdgcn_readlane(__builtin_bit_cast(int, bb[dd]), 63)); dc[dd] = expf(bl);
            const float kv = (dd & 1) ? bfhi(kw[dd >> 1]) : bflo(kw[dd >> 1]); KHT[(d0 + dd) * 72 + t] = (bf16)f2bf(kv * expf(bl - bb[dd])); }
        if (lane == 0) { float* GD = (float*)(F.ws + WS_GD) + ci * 128 + d0;
#pragma unroll
            for (int q = 0; q < 4; ++q) *(f32x4*)(GD + 4 * q) = (f32x4){dc[4 * q], dc[4 * q + 1], dc[4 * q + 2], dc[4 * q + 3]}; }
    }
    __syncthreads();
    if (stop_after == 2) return;
    {
        const int h = wave >> 1, eb = wave & 1; f32x16g U = {};
#pragma unroll
        for (int ks = 0; ks < 4; ++ks) { const bf16x8 ka = *(const LAS bf16x8*)(KHT + (h * 32 + r32) * 72 + ks * 16 + 8 * hh); const bf16x8 vb = *(const LAS bf16x8*)(VT + (h * 64 + eb * 32 + r32) * 72 + ks * 16 + 8 * hh);
            U = __builtin_amdgcn_mfma_f32_32x32x16_bf16(ka, vb, U, 0, 0, 0); }
        float* GU = (float*)(F.ws + WS_GU) + (size_t)(ci * 4 + h) * 2048 + eb * 32 + r32;
#pragma unroll
        for (int r = 0; r < 16; ++r) GU[gla_crow(r, hh) * 64] = U[r];
    }
    __syncthreads();
}
__device__ __forceinline__ void gla_scan(Frame& F) {
    if (F.tid < 128) { const int gid = F.vcu * 128 + F.tid;
        if (gid < 32768) { const int b = gid >> 13, h = (gid >> 11) & 3, d = (gid >> 6) & 31, e = gid & 63; float s = 0.f;
            float* GU = (float*)(F.ws + WS_GU); const float* GD = (const float*)(F.ws + WS_GD);
            for (int c0 = 0; c0 < 64; c0 += 16) { float u[16], dc[16];
#pragma unroll
                for (int i = 0; i < 16; ++i) { const int ci = b * 64 + c0 + i; u[i] = GU[((size_t)(ci * 4 + h) * 32 + d) * 64 + e]; dc[i] = GD[ci * 128 + h * 32 + d]; }
#pragma unroll
                for (int i = 0; i < 16; ++i) { const int ci = b * 64 + c0 + i; GU[((size_t)(ci * 4 + h) * 32 + d) * 64 + e] = s; s = dc[i] * s + u[i]; } } } }
}
__device__ __forceinline__ void mix_chunk(Frame& F, int l, int ci) {
    LAS bf16* QB = (LAS bf16*)(F.lds + RING_OFF);
    LAS bf16* KB = QB + 64 * 136;
    LAS bf16* VT = KB + 64 * 136;
    LAS bf16* ST = VT + 256 * 72;
    const int t0 = ci * 64, tid = F.tid, lane = F.lane, wave = F.wave, r32 = lane & 31, hh = lane >> 5;
    const bf16* PROJ = (const bf16*)(F.ws + WS_PROJ); bf16* MIXED = (bf16*)(F.ws + WS_MIXED);
    const float* GB = (const float*)(F.ws + WS_GB) + (size_t)t0 * 128;
    const int h = wave >> 1, ib = wave & 1, i0 = 32 * ib;
#pragma unroll
    for (int it = tid; it < 1024; it += 512) { const int t = it >> 4, d0 = (it & 15) * 8;
        const f32x4 b0 = *(const f32x4*)(GB + t * 128 + d0), b1 = *(const f32x4*)(GB + t * 128 + d0 + 4);
        const bf16* pr = PROJ + (size_t)(t0 + t) * NPROJ; const v4u qw = *(const v4u*)(pr + C_GQ + d0), kw = *(const v4u*)(pr + C_GK + d0);
        const float bv[8] = {b0[0], b0[1], b0[2], b0[3], b1[0], b1[1], b1[2], b1[3]}; const unsigned qa[4] = {qw.x, qw.y, qw.z, qw.w}, ka[4] = {kw.x, kw.y, kw.z, kw.w};
        unsigned qo[4], ko[4];
#pragma unroll
        for (int p = 0; p < 4; ++p) { const float e0 = expf(bv[2 * p]), e1 = expf(bv[2 * p + 1]), n0 = expf(-bv[2 * p]), n1 = expf(-bv[2 * p + 1]);
            qo[p] = pk2(bflo(qa[p]) * 0.17677669529663687f * e0, bfhi(qa[p]) * 0.17677669529663687f * e1); ko[p] = pk2(bflo(ka[p]) * n0, bfhi(ka[p]) * n1); }
        *(LAS v4u*)(QB + t * 136 + d0) = (v4u){qo[0], qo[1], qo[2], qo[3]}; *(LAS v4u*)(KB + t * 136 + d0) = (v4u){ko[0], ko[1], ko[2], ko[3]}; }
    gla_stage_vt(VT, PROJ, t0, tid);
    { const float* GU = (const float*)(F.ws + WS_GU) + (size_t)ci * 8192;
      float sv[16];
#pragma unroll
      for (int q = 0; q < 16; ++q) sv[q] = GU[tid + 512 * q];
#pragma unroll
      for (int q = 0; q < 16; ++q) { const int it = tid + 512 * q, hd = it >> 6, e = it & 63; ST[((hd >> 5) * 64 + e) * 40 + (hd & 31)] = (bf16)f2bf(sv[q]); } }
    const size_t row = (size_t)(t0 + i0 + r32); unsigned long long rg[8];
#pragma unroll
    for (int q = 0; q < 8; ++q) rg[q] = *(const unsigned long long*)(PROJ + row * NPROJ + C_GR + h * 64 + 32 * (q >> 2) + 8 * (q & 3) + 4 * hh);
    __syncthreads();
    {
        bf16x8 qf[2];
#pragma unroll
        for (int ks = 0; ks < 2; ++ks) qf[ks] = *(const LAS bf16x8*)(QB + (i0 + r32) * 136 + h * 32 + ks * 16 + 8 * hh);
        f32x16g OT[2] = {{}, {}};
#pragma unroll
        for (int eb = 0; eb < 2; ++eb)
#pragma unroll
            for (int ks = 0; ks < 2; ++ks) { const bf16x8 sa = *(const LAS bf16x8*)(ST + (h * 64 + eb * 32 + r32) * 40 + ks * 16 + 8 * hh); OT[eb] = __builtin_amdgcn_mfma_f32_32x32x16_bf16(sa, qf[ks], OT[eb], 0, 0, 0); }
#pragma unroll
        for (int jb = 0; jb < 2; ++jb) if (jb <= ib) {
            f32x16g X = {};
#pragma unroll
            for (int ks = 0; ks < 2; ++ks) { const bf16x8 ka = *(const LAS bf16x8*)(KB + (32 * jb + r32) * 136 + h * 32 + ks * 16 + 8 * hh); X = __builtin_amdgcn_mfma_f32_32x32x16_bf16(ka, qf[ks], X, 0, 0, 0); }
            if (jb == ib) {
#pragma unroll
                for (int r = 0; r < 16; ++r) if (gla_crow(r, hh) > r32) X[r] = 0.f;
            }
#pragma unroll
            for (int s = 0; s < 2; ++s) { v4u xw; xw.x = pk2(X[8 * s], X[8 * s + 1]); xw.y = pk2(X[8 * s + 2], X[8 * s + 3]); xw.z = pk2(X[8 * s + 4], X[8 * s + 5]); xw.w = pk2(X[8 * s + 6], X[8 * s + 7]);
                const bf16x8 xb = __builtin_bit_cast(bf16x8, xw);
#pragma unroll
                for (int eb = 0; eb < 2; ++eb) { const LAS bf16* vp = VT + (h * 64 + eb * 32 + r32) * 72 + 32 * jb + 16 * s + 4 * hh;
                    const unsigned long long lo = *(const LAS unsigned long long*)vp, hi = *(const LAS unsigned long long*)(vp + 8);
                    const v4u vw = (v4u){(unsigned)lo, (unsigned)(lo >> 32), (unsigned)hi, (unsigned)(hi >> 32)};
                    OT[eb] = __builtin_amdgcn_mfma_f32_32x32x16_bf16(__builtin_bit_cast(bf16x8, vw), xb, OT[eb], 0, 0, 0); } }
        }
        float ss = 0.f;
#pragma unroll
        for (int eb = 0; eb < 2; ++eb)
#pragma unroll
            for (int r = 0; r < 16; ++r) ss += OT[eb][r] * OT[eb][r];
        ss = xl_sum32(ss);
        const float rs = 1.0f / sqrtf(ss * (1.0f / 64.0f) + EPS); const float* gn = (const float*)(F.ws + WS_PAR) + PAR_GN + l * 64;
#pragma unroll
        for (int q = 0; q < 8; ++q) { const int eb = q >> 2, g = q & 3, e0 = 32 * eb + 8 * g + 4 * hh; const f32x4 g4 = *(const f32x4*)(gn + e0);
            const unsigned r0 = (unsigned)rg[q], r1 = (unsigned)(rg[q] >> 32); const float rr[4] = {bflo(r0), bfhi(r0), bflo(r1), bfhi(r1)}; float y[4];
#pragma unroll
            for (int k = 0; k < 4; ++k) { const float sl = rr[k] / (1.0f + expf(-rr[k])); y[k] = OT[eb][4 * g + k] * rs * g4[k] * sl; }
            *(unsigned long long*)(MIXED + row * DM + 768 + h * 64 + e0) = (unsigned long long)pk2(y[0], y[1]) | ((unsigned long long)pk2(y[2], y[3]) << 32); }
    }
    const float lam = ((const float*)(F.ws + WS_LAM))[l * 2], oscale = ((const float*)(F.ws + WS_LAM))[l * 2 + 1];
    const bf16* OATT = (const bf16*)(F.ws + WS_OATT); const float* dn = (const float*)(F.ws + WS_PAR) + PAR_DN + l * 128; const float* cw = (const float*)(F.ws + WS_PAR) + PAR_CW + l * 3 * 256;
    const float dn0 = dn[2 * lane], dn1 = dn[2 * lane + 1]; const int ch = 4 * lane;
    f32x4 wj[3];
#pragma unroll
    for (int j = 0; j < 3; ++j) wj[j] = *(const f32x4*)(cw + j * 256 + ch);
#pragma unroll 1
    for (int r0 = 0; r0 < 8; r0 += 4) {
        unsigned w1[4][4], w2[4][4]; unsigned long long cwd[6], hwd[6], bwd[4];
        const int tb = t0 + wave * 8 + r0;
#pragma unroll
        for (int u = 0; u < 4; ++u)
#pragma unroll
            for (int hq = 0; hq < 4; ++hq) { w1[u][hq] = *(const unsigned*)(OATT + (size_t)(tb + u) * DM + hq * 128 + 2 * lane); w2[u][hq] = *(const unsigned*)(OATT + (size_t)(tb + u) * DM + 512 + hq * 128 + 2 * lane); }
#pragma unroll
        for (int u = 0; u < 6; ++u) { const int tr = tb - 2 + u; const bool ok = ((tb & (SEQL - 1)) - 2 + u) >= 0;
            const bf16* pr = PROJ + (size_t)(ok ? tr : tb) * NPROJ; cwd[u] = ok ? *(const unsigned long long*)(pr + C_SC + ch) : 0ull; hwd[u] = ok ? *(const unsigned long long*)(pr + C_SH + ch) : 0ull; }
#pragma unroll
        for (int u = 0; u < 4; ++u) bwd[u] = *(const unsigned long long*)(PROJ + (size_t)(tb + u) * NPROJ + C_SB + ch);
        f32x4 z[6];
#pragma unroll
        for (int u = 0; u < 6; ++u) { const unsigned c0 = (unsigned)cwd[u], c1 = (unsigned)(cwd[u] >> 32), h0 = (unsigned)hwd[u], h1 = (unsigned)(hwd[u] >> 32); z[u] = (f32x4){bflo(c0) * bflo(h0), bfhi(c0) * bfhi(h0), bflo(c1) * bflo(h1), bfhi(c1) * bfhi(h1)}; }
#pragma unroll
        for (int u = 0; u < 4; ++u) { const int t = tb + u;
#pragma unroll
            for (int hq = 0; hq < 4; ++hq) { const float o0 = bflo(w1[u][hq]) - lam * bflo(w2[u][hq]), o1 = bfhi(w1[u][hq]) - lam * bfhi(w2[u][hq]); const float ssq = wave_sum(o0 * o0 + o1 * o1);
                const float rsq = oscale / sqrtf(ssq * (1.0f / 128.0f) + EPS);
                *(unsigned*)(MIXED + (size_t)t * DM + hq * 128 + 2 * lane) = pk2(o0 * rsq * dn0, o1 * rsq * dn1); }
            const f32x4 y = wj[0] * z[u] + wj[1] * z[u + 1] + wj[2] * z[u + 2];
            const unsigned b0 = (unsigned)bwd[u], b1 = (unsigned)(bwd[u] >> 32);
            *(unsigned long long*)(MIXED + (size_t)t * DM + 512 + ch) = (unsigned long long)pk2(bflo(b0) * y[0], bfhi(b0) * y[1]) | ((unsigned long long)pk2(bflo(b1) * y[2], bfhi(b1) * y[3]) << 32); }
    }
    __syncthreads();
}

#define TK_HD __device__ __forceinline__
#ifndef TK_HD
#define TK_HD __device__ __forceinline__
#endif
TK_HD int tk_max(int a, int b) { return a > b ? a : b; }
TK_HD int tk_min(int a, int b) { return a < b ? a : b; }
TK_HD int tk_f2key(float f) { int b = __builtin_bit_cast(int, f); return b ^ ((b >> 31) & 0x7fffffff); }
TK_HD float tk_key2f(int k) { return __builtin_bit_cast(float, k ^ ((k >> 31) & 0x7fffffff)); }
template <int N> TK_HD void tk_sort_desc(int (&a)[N]) {
#pragma unroll
    for (int k = 2; k <= N; k <<= 1)
#pragma unroll
        for (int j = k >> 1; j > 0; j >>= 1)
#pragma unroll
            for (int i = 0; i < N; ++i) { const int l = i ^ j; if (l > i) { const int hi = tk_max(a[i], a[l]), lo = tk_min(a[i], a[l]); if ((i & k) == 0) { a[i] = hi; a[l] = lo; } else { a[i] = lo; a[l] = hi; } } }
}
template <int N> TK_HD void tk_merge_desc(int (&a)[N]) {
#pragma unroll
    for (int j = N >> 1; j > 0; j >>= 1)
#pragma unroll
        for (int i = 0; i < N; ++i) { const int l = i ^ j; if (l > i) { const int hi = tk_max(a[i], a[l]), lo = tk_min(a[i], a[l]); a[i] = hi; a[l] = lo; } }
}
TK_HD void tk_top16_merge(int (&a)[16], const int (&b)[16]) {
#pragma unroll
    for (int i = 0; i < 16; ++i) a[i] = tk_max(a[i], b[15 - i]);
    tk_merge_desc<16>(a);
}
TK_HD constexpr int tk_cand_i(int set, int s) {
    if (set == 0) return s < 16 ? 0 : (s < 24 ? 1 : (s == 24 ? 8 : -1));
    return s < 5 ? 2 : s < 9 ? 3 : s < 12 ? 4 : s < 14 ? 5 : s < 16 ? 6 : s < 18 ? 7 : s < 25 ? (9 + (s - 18)) : -1;
}
TK_HD constexpr int tk_cand_j(int set, int s) {
    if (set == 0) return s < 16 ? s : (s < 24 ? s - 16 : (s == 24 ? 0 : -1));
    return s < 5 ? s : s < 9 ? s - 5 : s < 12 ? s - 9 : s < 14 ? s - 12 : s < 16 ? s - 14 : s < 18 ? s - 16 : s < 25 ? 0 : -1;
}

constexpr int PS_KSTRIDE = 136;
__device__ __forceinline__ void peer_select_task(Frame& F, int l, int t0, int h, LAS int* scr  , const LAS bf16* KL  ) {
    typedef float f32x16 __attribute__((ext_vector_type(16)));
    const int lane = F.lane, r32 = lane & 31, hi = lane >> 5;
    const bf16* QP = (const bf16*)(F.ws + WS_QP);
    int lists[2][16];
    bf16x8 qall[2][8];
#pragma unroll
    for (int half = 0; half < 2; ++half) { const bf16* qp = QP + (size_t)(t0 + r32) * NQ + h * 256 + half * 128 + hi * 8;
#pragma unroll
        for (int ks = 0; ks < 8; ++ks) qall[half][ks] = *(const bf16x8*)(qp + ks * 16); }
#pragma unroll
    for (int half = 0; half < 2; ++half) {
        const bf16x8 (&qf)[8] = qall[half];
        int cur[16];
#pragma unroll
        for (int kb = 0; kb < 4; ++kb) {
            f32x16 c = {};
            const LAS bf16* kp = KL + (half * 128 + kb * 32 + r32) * PS_KSTRIDE + hi * 8;
#pragma unroll
            for (int ks = 0; ks < 8; ++ks) { const bf16x8 kf = *(const LAS bf16x8*)(kp + ks * 16); c = __builtin_amdgcn_mfma_f32_32x32x16_bf16(kf, qf[ks], c, 0, 0, 0); }
            int g[16];
#pragma unroll
            for (int r = 0; r < 16; ++r) { const int key = kb * 32 + (r & 3) + 8 * (r >> 2) + 4 * hi; g[r] = (tk_f2key(c[r]) & ~127) | (127 - key); }
            tk_sort_desc<16>(g);
            if (kb == 0) {
#pragma unroll
                for (int r = 0; r < 16; ++r) cur[r] = g[r];
            } else tk_top16_merge(cur, g);
        }
        int oth[16];
#pragma unroll
        for (int r = 0; r < 16; ++r) oth[r] = xl_xor32_i(cur[r], hi);
        tk_top16_merge(cur, oth);
#pragma unroll
        for (int r = 0; r < 16; ++r) lists[half][r] = cur[r];
    }
#pragma unroll
    for (int r = 0; r < 16; ++r) scr[r32 * 32 + hi * 16 + r] = 127 - ((hi ? lists[1][r] : lists[0][r]) & 127);
    float v1[16], v2[16];
#pragma unroll
    for (int r = 0; r < 16; ++r) { v1[r] = tk_key2f(lists[0][r]); v2[r] = tk_key2f(lists[1][r]); }
    int c[32];
#pragma unroll
    for (int s = 0; s < 32; ++s) {
        constexpr int NEG = (int)0x80000000;
        const int ia = tk_cand_i(0, s), ja = tk_cand_j(0, s), ib = tk_cand_i(1, s), jb = tk_cand_j(1, s);
        if (ia < 0) c[s] = NEG;
        else { const int ka = (tk_f2key(v1[ia] + v2[ja]) & ~255) | (255 - (ia * 16 + ja)), kb2 = (tk_f2key(v1[ib] + v2[jb]) & ~255) | (255 - (ib * 16 + jb)); c[s] = hi ? kb2 : ka; }
    }
    tk_sort_desc<32>(c);
    int fin[16], oth[16];
#pragma unroll
    for (int r = 0; r < 16; ++r) { fin[r] = c[r]; oth[r] = xl_xor32_i(c[r], hi); }
    tk_top16_merge(fin, oth);
    float p[16]; float sum = 0.f; const float mx = tk_key2f(fin[0]);
#pragma unroll
    for (int r = 0; r < 16; ++r) { p[r] = expf(tk_key2f(fin[r]) - mx); sum += p[r]; }
    const float inv = 1.0f / sum;
    asm volatile("s_waitcnt lgkmcnt(0)" ::: "memory");
    int* EX = (int*)(F.ws + WS_EXP) + (size_t)(t0 + r32) * 128 + h * 16; float* GT = (float*)(F.ws + WS_GATE) + (size_t)(t0 + r32) * 128 + h * 16;
#pragma unroll
    for (int r = 0; r < 16; ++r) { const int code = 255 - (fin[r] & 255); const int e1 = scr[r32 * 32 + (code >> 4)], e2 = scr[r32 * 32 + 16 + (code & 15)];
        if ((r >> 3) == hi) { EX[r] = e1 * 128 + e2; GT[r] = p[r] * inv; } }
    asm volatile("s_waitcnt lgkmcnt(0)" ::: "memory");
}

__device__ __forceinline__ float gelu_erf(float v) {
    const float av = fabsf(v), t = __builtin_amdgcn_rcpf(av * 0.2316418882f + 1.0f);
    float q = t * 0.5307027145f + (-0.7265760135f); q = q * t + 0.7107068705f; q = q * t + (-0.142248368f); q = q * t + 0.127414796f; q = q * t;
    const float e = __builtin_amdgcn_exp2f((v * v) * (-0.72134752044f)); const float m_ = v * (q * e);
    return v < 0.f ? m_ : v - m_;
}
typedef __bf16 bf16x2_t __attribute__((ext_vector_type(2)));
__device__ __forceinline__ float dot2bf(unsigned a, unsigned b, float c) { return __builtin_amdgcn_fdot2_f32_bf16(__builtin_bit_cast(bf16x2_t, a), __builtin_bit_cast(bf16x2_t, b), c, false); }
template <int J> __device__ __forceinline__ int xl_xchg_i(int v, int hi) { if constexpr (J == 32) return xl_xor32_i(v, hi); else return xl_swz_i<J>(v); }
template <int K, int J> __device__ __forceinline__ void sort128_step(int& ka, int& kb, int lane) {
    if constexpr (J == 64) { const int lo = ka < kb ? ka : kb, hi = ka < kb ? kb : ka; ka = lo; kb = hi; }
    else { const int oa = xl_xchg_i<J>(ka, lane >> 5), ob = xl_xchg_i<J>(kb, lane >> 5); const bool lower = (lane & J) == 0;
        const bool upa = (K >= 64) ? true : ((lane & K) == 0), upb = (K >= 128) ? true : (K == 64 ? false : ((lane & K) == 0));
        const int mina = ka < oa ? ka : oa, maxa = ka < oa ? oa : ka, minb = kb < ob ? kb : ob, maxb = kb < ob ? ob : kb;
        ka = (upa == lower) ? mina : maxa; kb = (upb == lower) ? minb : maxb; }
}
__device__ __forceinline__ void sort128(int& ka, int& kb, int lane) {
#define S_(K, J) sort128_step<K, J>(ka, kb, lane);
    S_(2, 1) S_(4, 2) S_(4, 1) S_(8, 4) S_(8, 2) S_(8, 1) S_(16, 8) S_(16, 4) S_(16, 2) S_(16, 1) S_(32, 16) S_(32, 8) S_(32, 4) S_(32, 2) S_(32, 1)
    S_(64, 32) S_(64, 16) S_(64, 8) S_(64, 4) S_(64, 2) S_(64, 1) S_(128, 64) S_(128, 32) S_(128, 16) S_(128, 8) S_(128, 4) S_(128, 2) S_(128, 1)
#undef S_
}
typedef float f32x2g __attribute__((ext_vector_type(2)));
#define PT_WGSYNC 1
#ifndef PT_SYNC_EVERY
#define PT_SYNC_EVERY 4
#endif
#ifndef PT_FIXED_ORDER
#define PT_GREEDY 1
#endif
#ifndef PT_CH
#define PT_CH 8
#endif
constexpr int PT_T = 4;
constexpr int PT_TOK_INTS = 128 + 128 + 64 + 256 + 4 + 128;
constexpr int PT_WAVE_INTS = PT_T * PT_TOK_INTS;
__device__ __forceinline__ float pt_dot8(const v4u w, const f32x2g (&xv)[8]) {
    f32x2g a = (f32x2g){0.f, 0.f};
    a = __builtin_elementwise_fma(__builtin_amdgcn_cvt_pk_f32_fp8(w.x, false), xv[0], a); a = __builtin_elementwise_fma(__builtin_amdgcn_cvt_pk_f32_fp8(w.x, true), xv[1], a);
    a = __builtin_elementwise_fma(__builtin_amdgcn_cvt_pk_f32_fp8(w.y, false), xv[2], a); a = __builtin_elementwise_fma(__builtin_amdgcn_cvt_pk_f32_fp8(w.y, true), xv[3], a);
    a = __builtin_elementwise_fma(__builtin_amdgcn_cvt_pk_f32_fp8(w.z, false), xv[4], a); a = __builtin_elementwise_fma(__builtin_amdgcn_cvt_pk_f32_fp8(w.z, true), xv[5], a);
    a = __builtin_elementwise_fma(__builtin_amdgcn_cvt_pk_f32_fp8(w.w, false), xv[6], a); a = __builtin_elementwise_fma(__builtin_amdgcn_cvt_pk_f32_fp8(w.w, true), xv[7], a);
    return a.x + a.y;
}
__device__ __forceinline__ void pt_axpy8(const v4u w, const float c, f32x2g (&o)[8]) {
    const f32x2g cc = (f32x2g){c, c};
    o[0] = __builtin_elementwise_fma(__builtin_amdgcn_cvt_pk_f32_fp8(w.x, false), cc, o[0]); o[1] = __builtin_elementwise_fma(__builtin_amdgcn_cvt_pk_f32_fp8(w.x, true), cc, o[1]);
    o[2] = __builtin_elementwise_fma(__builtin_amdgcn_cvt_pk_f32_fp8(w.y, false), cc, o[2]); o[3] = __builtin_elementwise_fma(__builtin_amdgcn_cvt_pk_f32_fp8(w.y, true), cc, o[3]);
    o[4] = __builtin_elementwise_fma(__builtin_amdgcn_cvt_pk_f32_fp8(w.z, false), cc, o[4]); o[5] = __builtin_elementwise_fma(__builtin_amdgcn_cvt_pk_f32_fp8(w.z, true), cc, o[5]);
    o[6] = __builtin_elementwise_fma(__builtin_amdgcn_cvt_pk_f32_fp8(w.w, false), cc, o[6]); o[7] = __builtin_elementwise_fma(__builtin_amdgcn_cvt_pk_f32_fp8(w.w, true), cc, o[7]);
}
__device__ __forceinline__ int xl_sum32_i(int v) { unsigned a = (unsigned)v, b = a; asm volatile("" : "+v"(b)); auto r = __builtin_amdgcn_permlane32_swap(a, b, false, false); const unsigned r0 = r[0], r1 = r[1]; return (int)(r0 + r1); }
__device__ __forceinline__ void pt_chunk(const LAS int* se, const LAS float* sg, int base, const v4u xq, f32x2g (&out)[8], float hscale,
                                         const unsigned char* Ub, const unsigned char* Vb, const float* SU, const float* SV, int lane) {
    const int e_l = se[base + (lane & (PT_CH - 1))]; const float g_l = sg[base + (lane & (PT_CH - 1))], hu_l = sg[452 + base + (lane & (PT_CH - 1))];
    v4u uw[PT_CH], vw[PT_CH]; const int l16 = 16 * lane; int es[PT_CH];
    const __amdgpu_buffer_rsrc_t rs = __builtin_amdgcn_make_buffer_rsrc((void*)Ub, 0, 32 << 20, 0x00020000);
#pragma unroll
    for (int s = 0; s < PT_CH; ++s) { es[s] = __builtin_amdgcn_readlane(e_l, s) * 2048; uw[s] = __builtin_bit_cast(v4u, __builtin_amdgcn_raw_buffer_load_b128(rs, l16, es[s], 0)); }
#pragma unroll
    for (int s = 0; s < PT_CH; ++s) vw[s] = __builtin_bit_cast(v4u, __builtin_amdgcn_raw_buffer_load_b128(rs, l16 + 1024, es[s], 0));
    int p[PT_CH];
#pragma unroll
    for (int s = 0; s < PT_CH; ++s) { int a = __builtin_amdgcn_sdot4((int)uw[s].x, (int)xq.x, 0, false); a = __builtin_amdgcn_sdot4((int)uw[s].y, (int)xq.y, a, false);
        a = __builtin_amdgcn_sdot4((int)uw[s].z, (int)xq.z, a, false); p[s] = __builtin_amdgcn_sdot4((int)uw[s].w, (int)xq.w, a, false); }
#define PT_DPP(v, ctrl) __builtin_amdgcn_update_dpp(0, (v), (ctrl), 0xf, 0xf, false)
#define PT_BFLY(S, BIT, CTRL) _Pragma("unroll") for (int i = 0; i < S; ++i) { const bool up = (lane & BIT) != 0; const int keep = up ? p[i + S] : p[i], send = up ? p[i] : p[i + S]; p[i] = keep + PT_DPP(send, CTRL); }
    PT_BFLY(4, 4, 0x141) PT_BFLY(2, 2, 0x4E) PT_BFLY(1, 1, 0xB1)
#undef PT_BFLY
    int hi_ = p[0];
    hi_ += PT_DPP(hi_, 0x128);
#undef PT_DPP
    { unsigned a_ = (unsigned)hi_, b_ = a_; asm volatile("" : "+v"(b_)); auto r_ = __builtin_amdgcn_permlane16_swap(a_, b_, false, false); const unsigned r0 = r_[0], r1 = r_[1]; hi_ = (int)(r0 + r1); }
    hi_ = xl_sum32_i(hi_);
    const float c_l = g_l * gelu_erf((float)hi_ * hu_l);
#pragma unroll
    for (int s = 0; s < PT_CH; ++s) { const float c = __builtin_bit_cast(float, __builtin_amdgcn_readlane(__builtin_bit_cast(int, c_l), s)); pt_axpy8(vw[s], c, out); }
}
__device__ __forceinline__ void pt_sort_regs(LAS int* se, LAS float* sg, LAS int* cnt, LAS float* sh, int ea, int eb, float ga, float gb, float ha, float hb, int lane) {
    cnt[lane] = 0;
    asm volatile("s_waitcnt lgkmcnt(0)" ::: "memory");
    __hip_atomic_fetch_add(cnt + (ea >> 8), 1, __ATOMIC_RELAXED, __HIP_MEMORY_SCOPE_WAVEFRONT); __hip_atomic_fetch_add(cnt + (eb >> 8), 1, __ATOMIC_RELAXED, __HIP_MEMORY_SCOPE_WAVEFRONT);
    asm volatile("s_waitcnt lgkmcnt(0)" ::: "memory");
    const int c = cnt[lane]; int incl = c;
    int ln = lane; asm volatile("" : "+v"(ln));
#pragma unroll
    for (int off = 1; off < 64; off <<= 1) { const int o = __builtin_amdgcn_ds_bpermute(((ln - off) & 63) << 2, incl); incl += (ln >= off) ? o : 0; }
    asm volatile("s_waitcnt lgkmcnt(0)" ::: "memory");
    cnt[lane] = incl - c;
    asm volatile("s_waitcnt lgkmcnt(0)" ::: "memory");
    const int pa = __hip_atomic_fetch_add(cnt + (ea >> 8), 1, __ATOMIC_RELAXED, __HIP_MEMORY_SCOPE_WAVEFRONT);
    const int pb = __hip_atomic_fetch_add(cnt + (eb >> 8), 1, __ATOMIC_RELAXED, __HIP_MEMORY_SCOPE_WAVEFRONT);
    se[pa] = ea; sg[pa] = ga; sh[pa] = ha; se[pb] = eb; sg[pb] = gb; sh[pb] = hb;
    asm volatile("s_waitcnt lgkmcnt(0)" ::: "memory");
}
__device__ __forceinline__ void pt_sort(LAS int* se, LAS float* sg, LAS int* cnt, const int* EX, const float* GT, int lane, bool dry, const float* SU = nullptr, const float* SV = nullptr, float hs = 1.0f, LAS float* sh = nullptr) {
    int ea = EX[lane], eb = EX[64 + lane];
#ifdef DRYMASK
    if (dry) { ea &= DRYMASK; eb &= DRYMASK; }
#endif
    (void)dry; float ga = GT[lane], gb = GT[64 + lane]; float ha = 0.f, hb = 0.f;
    if (sh) { ga *= SV[ea]; gb *= SV[eb]; ha = hs * SU[ea]; hb = hs * SU[eb]; }
    cnt[lane] = 0;
    asm volatile("s_waitcnt lgkmcnt(0)" ::: "memory");
    __hip_atomic_fetch_add(cnt + (ea >> 8), 1, __ATOMIC_RELAXED, __HIP_MEMORY_SCOPE_WAVEFRONT); __hip_atomic_fetch_add(cnt + (eb >> 8), 1, __ATOMIC_RELAXED, __HIP_MEMORY_SCOPE_WAVEFRONT);
    asm volatile("s_waitcnt lgkmcnt(0)" ::: "memory");
    const int c = cnt[lane];
    int incl = c;
    int ln = lane; asm volatile("" : "+v"(ln));
#pragma unroll
    for (int off = 1; off < 64; off <<= 1) { const int o = __builtin_amdgcn_ds_bpermute(((ln - off) & 63) << 2, incl); incl += (ln >= off) ? o : 0; }
    asm volatile("s_waitcnt lgkmcnt(0)" ::: "memory");
    cnt[lane] = incl - c;
    asm volatile("s_waitcnt lgkmcnt(0)" ::: "memory");
    const int pa = __hip_atomic_fetch_add(cnt + (ea >> 8), 1, __ATOMIC_RELAXED, __HIP_MEMORY_SCOPE_WAVEFRONT);
    const int pb = __hip_atomic_fetch_add(cnt + (eb >> 8), 1, __ATOMIC_RELAXED, __HIP_MEMORY_SCOPE_WAVEFRONT);
    se[pa] = ea; sg[pa] = ga; se[pb] = eb; sg[pb] = gb; if (sh) { sh[pa] = ha; sh[pb] = hb; }
    asm volatile("s_waitcnt lgkmcnt(0)" ::: "memory");
}
__device__ __forceinline__ void peer_tokens4(Frame& F, int l, int tq, bool last, LAS int* scr, unsigned* xs_word, unsigned xs_nloc, unsigned& xs_round, bool dry = false) {
    const int lane = F.lane;
    const unsigned char* Ub = F.ws + WS_TAB + l * TAB_STRIDE; const unsigned char* Vb = Ub + 1024;
    const float* SU = (const float*)(F.ws + WS_SU) + l * 16384; const float* SV = (const float*)(F.ws + WS_SV) + l * 16384;
    f32x2g out[PT_T][8];
    {
        int ls = lane; asm volatile("" : "+v"(ls));
        v4u xw_[PT_T][2]; int ea[PT_T], eb[PT_T]; float ga[PT_T], gb[PT_T], rs[PT_T], sua[PT_T], sub_[PT_T], sva[PT_T], svb[PT_T];
#pragma unroll
        for (int k = 0; k < PT_T; ++k) { const int t = tq + k; const bf16* Xr = (const bf16*)(F.ws + WS_XB) + (size_t)t * DM + 16 * ls; const int* EX = (const int*)(F.ws + WS_EXP) + (size_t)t * 128; const float* GT = (const float*)(F.ws + WS_GATE) + (size_t)t * 128;
            ea[k] = EX[ls]; eb[k] = EX[64 + ls]; ga[k] = GT[ls]; gb[k] = GT[64 + ls];
#ifdef DRYMASK
            if (dry) { ea[k] &= DRYMASK; eb[k] &= DRYMASK; }
#endif
            xw_[k][0] = *(const v4u*)(Xr); xw_[k][1] = *(const v4u*)(Xr + 8); rs[k] = pg8::row_rstd((const float*)(F.ws + WS_SSQ), t); }
#pragma unroll
        for (int k = 0; k < PT_T; ++k) { sua[k] = SU[ea[k]]; sub_[k] = SU[eb[k]]; sva[k] = SV[ea[k]]; svb[k] = SV[eb[k]]; }
#pragma unroll
        for (int k = 0; k < PT_T; ++k) { LAS int* tk = scr + k * PT_TOK_INTS;
            f32x4 xr[1][4];
#pragma unroll
            for (int j = 0; j < 4; ++j) { const v4u w = xw_[k][j >> 1]; const unsigned a = (j & 1) ? w.z : w.x, b = (j & 1) ? w.w : w.y; xr[0][j] = (f32x4){bflo(a), bfhi(a), bflo(b), bfhi(b)}; }
            float mx = 0.f;
#pragma unroll
            for (int j = 0; j < 4; ++j) mx = fmaxf(mx, fmaxf(fmaxf(fabsf(xr[0][j][0]), fabsf(xr[0][j][1])), fmaxf(fabsf(xr[0][j][2]), fabsf(xr[0][j][3]))));
            mx = fmaxf(mx, xl_swz<1>(mx)); mx = fmaxf(mx, xl_swz<2>(mx)); mx = fmaxf(mx, xl_swz<4>(mx)); mx = fmaxf(mx, xl_swz<8>(mx)); mx = fmaxf(mx, xl_swz<16>(mx));
            mx = fmaxf(mx, __builtin_bit_cast(float, xl_xor32_i(__builtin_bit_cast(int, mx), lane >> 5)));
            const float sc = mx > 0.f ? 127.0f / mx : 0.f;
#define PT_Q4(v) ((unsigned)((int)rintf((v)[0] * sc) & 255) | ((unsigned)((int)rintf((v)[1] * sc) & 255) << 8) | ((unsigned)((int)rintf((v)[2] * sc) & 255) << 16) | ((unsigned)((int)rintf((v)[3] * sc) & 255) << 24))
            *(LAS v4u*)(tk + 320 + 4 * lane) = (v4u){PT_Q4(xr[0][0]), PT_Q4(xr[0][1]), PT_Q4(xr[0][2]), PT_Q4(xr[0][3])};
#undef PT_Q4
            const float hs_ = rs[k] * mx * (1.0f / 127.0f);
            pt_sort_regs(tk, (LAS float*)(tk + 128), tk + 256, (LAS float*)(tk + 580), ea[k], eb[k], ga[k] * sva[k], gb[k] * svb[k], hs_ * sua[k], hs_ * sub_[k], lane);
            asm volatile("" ::: "memory"); }
    }
#pragma unroll
    for (int k = 0; k < PT_T; ++k)
#pragma unroll
        for (int i = 0; i < 8; ++i) out[k][i] = (f32x2g){0.f, 0.f};
#ifdef PT_GREEDY
    static_assert(PT_T == 4 && PT_CH == 8, "greedy sweep: four tokens, chunks of eight");
    int csv0, csv1, csv2, csv3;
    { int lc = lane; asm volatile("" : "+v"(lc)); const int ci = (lc & 15) * PT_CH; const bool in = lc < 16;
      csv0 = in ? scr[0 * PT_TOK_INTS + ci] : 0x7fffffff; csv1 = in ? scr[1 * PT_TOK_INTS + ci] : 0x7fffffff; csv2 = in ? scr[2 * PT_TOK_INTS + ci] : 0x7fffffff; csv3 = in ? scr[3 * PT_TOK_INTS + ci] : 0x7fffffff; }
    int pos0 = 0, pos1 = 0, pos2 = 0, pos3 = 0;
#define PT_RUN(K, POS) { const LAS int* tk = scr + K * PT_TOK_INTS; const v4u xq = *(const LAS v4u*)(tk + 320 + 4 * lane); \
        pt_chunk(tk, (const LAS float*)(tk + 128), PT_CH * POS, xq, out[K], 0.f, Ub, Vb, SU, SV, lane); ++POS; asm volatile("" ::: "memory"); }
#pragma unroll 1
    for (int ck = 0; ck < 128 / PT_CH; ++ck) {
#pragma unroll 1
        for (int j = 0; j < PT_T; ++j) {
            const int s0 = __builtin_amdgcn_readlane(csv0, pos0), s1 = __builtin_amdgcn_readlane(csv1, pos1), s2 = __builtin_amdgcn_readlane(csv2, pos2), s3 = __builtin_amdgcn_readlane(csv3, pos3);
            const int m01 = s0 <= s1 ? s0 : s1, m23 = s2 <= s3 ? s2 : s3;
            const int sel = (m01 <= m23) ? (s0 <= s1 ? 0 : 1) : (s2 <= s3 ? 2 : 3);
            if (sel == 0) PT_RUN(0, pos0)
            if (sel == 1) PT_RUN(1, pos1)
            if (sel == 2) PT_RUN(2, pos2)
            if (sel == 3) PT_RUN(3, pos3)
        }
#else
#pragma unroll 1
    for (int ck = 0; ck < 128 / PT_CH; ++ck) {
#pragma unroll
        for (int k = 0; k < PT_T; ++k) { const LAS int* tk = scr + k * PT_TOK_INTS; const v4u xq = *(const LAS v4u*)(tk + 320 + 4 * lane); const float hsc = ((const LAS float*)tk)[576];
            pt_chunk(tk, (const LAS float*)(tk + 128), PT_CH * ck, xq, out[k], hsc, Ub, Vb, SU, SV, lane); asm volatile("" ::: "memory"); }
#endif
#ifdef PT_WGSYNC
        if ((ck % PT_SYNC_EVERY) == PT_SYNC_EVERY - 1) __syncthreads();
#if PT_WGSYNC >= 2
        if ((ck % PT_XSTEP) == PT_XSTEP - 1) { if (F.tid == 0) { unsigned* w = xs_word; const unsigned tgt = (++xs_round) * xs_nloc; __hip_atomic_fetch_add(w, 1u, __ATOMIC_RELAXED, __HIP_MEMORY_SCOPE_AGENT);
                unsigned sp = 0; while (__hip_atomic_load(w, __ATOMIC_RELAXED, __HIP_MEMORY_SCOPE_AGENT) < tgt && ++sp < (1u << 16)) __builtin_amdgcn_s_sleep(1); }
            __syncthreads(); }
#endif
#endif
    }
#pragma unroll
    for (int k = 0; k < PT_T; ++k) { int lf = lane; asm volatile("" : "+v"(lf)); const int t = tq + k; float* X = F.out + (size_t)t * DM + 16 * lf; bf16* XBr = (bf16*)(F.ws + WS_XB) + (size_t)t * DM + 16 * lf;
        const v4u ra = *(const v4u*)(XBr), rb = *(const v4u*)(XBr + 8);
        f32x4 x0 = (f32x4){bflo(ra.x), bfhi(ra.x), bflo(ra.y), bfhi(ra.y)} + (f32x4){out[k][0].x, out[k][0].y, out[k][1].x, out[k][1].y}, x1 = (f32x4){bflo(ra.z), bfhi(ra.z), bflo(ra.w), bfhi(ra.w)} + (f32x4){out[k][2].x, out[k][2].y, out[k][3].x, out[k][3].y};
        f32x4 x2 = (f32x4){bflo(rb.x), bfhi(rb.x), bflo(rb.y), bfhi(rb.y)} + (f32x4){out[k][4].x, out[k][4].y, out[k][5].x, out[k][5].y}, x3 = (f32x4){bflo(rb.z), bfhi(rb.z), bflo(rb.w), bfhi(rb.w)} + (f32x4){out[k][6].x, out[k][6].y, out[k][7].x, out[k][7].y};
        float ss = 0.f;
#pragma unroll
        for (int i = 0; i < 4; ++i) ss += x0[i] * x0[i] + x1[i] * x1[i] + x2[i] * x2[i] + x3[i] * x3[i];
        ss = wave_sum(ss);
        if (dry && ss != -1.0f) continue;
        if (last) { const float rs = 1.0f / sqrtf(ss * (1.0f / 1024.0f) + EPS); const float* g = (const float*)(F.ws + WS_PAR) + PAR_NF + 16 * lane;
            x0 = x0 * rs * *(const f32x4*)(g); x1 = x1 * rs * *(const f32x4*)(g + 4); x2 = x2 * rs * *(const f32x4*)(g + 8); x3 = x3 * rs * *(const f32x4*)(g + 12);
            *(f32x4*)(X) = x0; *(f32x4*)(X + 4) = x1; *(f32x4*)(X + 8) = x2; *(f32x4*)(X + 12) = x3; }
        else { v4u wa, wb; wa.x = pk2(x0[0], x0[1]); wa.y = pk2(x0[2], x0[3]); wa.z = pk2(x1[0], x1[1]); wa.w = pk2(x1[2], x1[3]); wb.x = pk2(x2[0], x2[1]); wb.y = pk2(x2[2], x2[3]); wb.z = pk2(x3[0], x3[1]); wb.w = pk2(x3[2], x3[3]);
            *(v4u*)(XBr) = wa; *(v4u*)(XBr + 8) = wb;
            if (lf == 0) ((float*)(F.ws + WS_RS1))[t] = 1.0f / sqrtf(ss * (1.0f / 1024.0f) + EPS); }
        asm volatile("" ::: "memory"); }
}

constexpr int NPHASE = 1 + 8 * NLAYER;
struct Args { const float* in[21]; float* out; unsigned char* ws; int ph_lo, ph_hi, use_bar, pad; };
__global__ void __launch_bounds__(NWAVES * 64, 2) hymba_fwd(Args args) {
    extern __shared__ __attribute__((aligned(16))) unsigned char lds[];
    Frame F;
    F.lds = (LAS unsigned char*)lds;
    F.MISC = (volatile LAS unsigned*)(F.lds + MISC_OFF);
    F.tid = threadIdx.x; F.lane = F.tid & 63; F.wave = __builtin_amdgcn_readfirstlane(F.tid >> 6);
    F.G = gridDim.x; F.bx = blockIdx.x; { const int bx = blockIdx.x; F.vcu = (F.G % 8 == 0) ? (bx % 8) * (F.G / 8) + bx / 8 : bx; }
    F.out = args.out; F.ws = args.ws;
    for (int u = F.tid; u < (LDS_BYTES - LDSCTL_OFF) / 4; u += NWAVES * 64) ((LAS unsigned*)(F.lds + LDSCTL_OFF))[u] = 0u;
    __syncthreads();
    XcdBarrier bar; bar.bar = ((unsigned*)(args.ws + WS_CTL) + CW_BAR); bar.x = 0; bar.st = nullptr;
    if (args.use_bar) bar = xcd_barrier_post(((unsigned*)(args.ws + WS_CTL) + CW_BAR), F.MISC + 8);
    const int lo = args.ph_lo, hi = args.ph_hi;
#ifndef PHMASK
#define PHMASK 0x1ff
#endif
#ifndef REPMASK
#define REPMASK 0
#endif
#define REPS(bit) (((REPMASK >> (bit)) & 1) ? 2 : 1)
#define IN(k) (((PHMASK >> ((k) == 0 ? 0 : 1 + (((k) - 1) & 7))) & 1) && lo <= (k) && (k) < hi)
#define SEAM(k) do { if (IN(k) && IN((k) + 1)) { XcdBarrier b_ = bar; int zb_ = 0; asm volatile("" : "+s"(zb_), "+s"(b_.x)); b_.bar = bar.bar + zb_; xcd_barrier(b_, F.tid == 0); } FRESH(); } while (0)
#define FRESH() do { int ln_; int wv_ = wave0; asm volatile("v_mbcnt_lo_u32_b32 %0, -1, 0\n\tv_mbcnt_hi_u32_b32 %0, -1, %0" : "=v"(ln_)); asm volatile("" : "+s"(wv_)); F.lane = ln_; F.wave = wv_; F.tid = wv_ * 64 + ln_; \
        int z_ = 0, v_ = vcu0, g_ = (int)gridDim.x, bx_ = (int)blockIdx.x; asm volatile("" : "+s"(z_), "+s"(v_), "+s"(g_), "+s"(bx_)); F.ws = args.ws + z_; F.out = args.out + z_; F.vcu = v_; F.G = g_; F.bx = bx_; } while (0)
    if (IN(0)) { for (int rep_ = 0; rep_ < REPS(8); ++rep_) { p0_prologue(F, args); __syncthreads(); } }
    const int vcu0 = F.vcu, wave0 = F.wave;
    SEAM(0);
    { constexpr int l = 0;

        const int pb = 1 + 8 * l;
        if (IN(pb + 0)) for (int rep_ = 0; rep_ < REPS(0); ++rep_) {
            pg8::Gemm g{(const pg8::bf16_t*)(F.ws + WS_XB), (const pg8::bf16_t*)(F.ws + WS_WIN + l * WIN_STRIDE), M, NPROJ, DM}; pg8::StaticOrder S; S.init(M, NPROJ, F.G, F.bx);
            pg8::EpiScale<true> E{(pg8::bf16_t*)(F.ws + WS_PROJ), NPROJ, (const float*)(F.ws + WS_RS1), (const float*)(F.ws + WS_COS), (const float*)(F.ws + WS_SIN), ATT_C2};
            pg8::gemm_phase<pg8::EpiScale<true>, pg8::StaticOrder, PG8_ALIGN, PG8_SP2>(F.lds + RING_OFF, g, S, E, F.tid);
        }
        SEAM(pb + 0);
        if (IN(pb + 1)) for (int rep_ = 0; rep_ < REPS(1); ++rep_) {
            if (args.pad == 0) { const attn_body::StaticOrder S(F.vcu);     attn_body::attn_phase<attn_body::StaticOrder>((char*)lds + RING_OFF, (const attn_body::bf16*)(F.ws + WS_PROJ), (attn_body::bf16*)(F.ws + WS_OATT), S, F.tid); }
            __syncthreads(); FRESH();
            for (int ci = F.vcu; ci < 256; ci += F.G) gla_prep(F, l, ci, args.pad >= 2 ? args.pad - 1 : 0);
        }
        SEAM(pb + 1);
        if (IN(pb + 2) && args.pad != 1) gla_scan(F);
        SEAM(pb + 2);
        if (IN(pb + 3)) for (int rep_ = 0; rep_ < REPS(3); ++rep_) { for (int ci = F.vcu; ci < 256; ci += F.G) mix_chunk(F, l, ci); }
        SEAM(pb + 3);
        if (IN(pb + 4)) {
            pg8::Gemm g{(const pg8::bf16_t*)(F.ws + WS_MIXED), (const pg8::bf16_t*)(F.ws + WS_WOUT + l * WOUT_STRIDE), M, DM, DM}; pg8::StaticOrder S; S.init(M, DM, F.G, F.bx);
            pg8::EpiRes E{(pg8::bf16_t*)(F.ws + WS_XB), (float*)(F.ws + WS_SSQ)};
            pg8::gemm_phase<pg8::EpiRes, pg8::StaticOrder, PG8_ALIGN, PG8_SP2>(F.lds + RING_OFF, g, S, E, F.tid);
        }
        SEAM(pb + 4);
        if (IN(pb + 5)) for (int rep_ = 0; rep_ < REPS(5); ++rep_) {
            pg8::Gemm g{(const pg8::bf16_t*)(F.ws + WS_XB), (const pg8::bf16_t*)(F.ws + WS_WQ + l * WQ_STRIDE), M, NQ, DM}; pg8::StaticOrder S; S.init(M, NQ, F.G, F.bx);
            pg8::EpiScale<false> E{(pg8::bf16_t*)(F.ws + WS_QP), NQ, (const float*)(F.ws + WS_SSQ), nullptr, nullptr, 1.0f};
            pg8::gemm_phase<pg8::EpiScale<false>, pg8::StaticOrder, PG8_ALIGN, PG8_SP2>(F.lds + RING_OFF, g, S, E, F.tid);
        }
        SEAM(pb + 5);
        if (IN(pb + 7)) {
            unsigned* xs_word = (unsigned*)(F.ws + WS_CTL) + 65536 + (l * 16 + (int)xb_xcc_id()) * 64; const unsigned xs_nloc = args.use_bar ? F.MISC[8] : 0u; unsigned xs_round = 0;
            for (int tb = vcu0; tb < M / 64; tb += (int)gridDim.x) {
                FRESH();
                {
                    LAS bf16* KLw = (LAS bf16*)(F.lds + RING_OFF + 32768); const bf16* KEYS = (const bf16*)(F.ws + WS_KEYS + l * KEYS_STRIDE);
                    for (int it = F.tid; it < 4096; it += NWAVES * 64) { const int row = it >> 4, c16 = it & 15; *(LAS v4u*)(KLw + row * PS_KSTRIDE + c16 * 8) = *(const v4u*)(KEYS + (size_t)row * 128 + c16 * 8); }
                    __syncthreads(); }
                for (int rep_ = 0; rep_ < REPS(6); ++rep_) {
                    LAS int* scr5 = (LAS int*)(F.lds + RING_OFF) + F.wave * 1024;
                    for (int i = 0; i < 2; ++i) { const int tt = F.wave * 2 + i; peer_select_task(F, l, 64 * tb + 32 * (tt >> 3), tt & 7, scr5, (const LAS bf16*)(F.lds + RING_OFF + 32768)); }
                }
                asm volatile("s_waitcnt vmcnt(0)" ::: "memory"); __syncthreads();
                FRESH();
                LAS int* scr = (LAS int*)(F.lds + RING_OFF) + F.wave * PT_WAVE_INTS;
                if (REPS(7) == 2) { for (int i = 0; i < 64 / PT_T / NWAVES; ++i) peer_tokens4(F, l, 64 * tb + (F.wave * (64 / PT_T / NWAVES) + i) * PT_T, l == NLAYER - 1, scr, xs_word + 32, xs_nloc, xs_round, true); xs_round = 0; }
                for (int i = 0; i < 64 / PT_T / NWAVES; ++i) peer_tokens4(F, l, 64 * tb + (F.wave * (64 / PT_T / NWAVES) + i) * PT_T, l == NLAYER - 1, scr, xs_word, xs_nloc, xs_round);
                __syncthreads();
            }
        }
        SEAM(pb + 7);

    }
    { constexpr int l = 1;

        const int pb = 1 + 8 * l;
        if (IN(pb + 0)) for (int rep_ = 0; rep_ < REPS(0); ++rep_) {
            pg8::Gemm g{(const pg8::bf16_t*)(F.ws + WS_XB), (const pg8::bf16_t*)(F.ws + WS_WIN + l * WIN_STRIDE), M, NPROJ, DM}; pg8::StaticOrder S; S.init(M, NPROJ, F.G, F.bx);
            pg8::EpiScale<true> E{(pg8::bf16_t*)(F.ws + WS_PROJ), NPROJ, (const float*)(F.ws + WS_RS1), (const float*)(F.ws + WS_COS), (const float*)(F.ws + WS_SIN), ATT_C2};
            pg8::gemm_phase<pg8::EpiScale<true>, pg8::StaticOrder, PG8_ALIGN, PG8_SP2>(F.lds + RING_OFF, g, S, E, F.tid);
        }
        SEAM(pb + 0);
        if (IN(pb + 1)) for (int rep_ = 0; rep_ < REPS(1); ++rep_) {
            if (args.pad == 0) { const attn_body::StaticOrder S(F.vcu);     attn_body::attn_phase<attn_body::StaticOrder>((char*)lds + RING_OFF, (const attn_body::bf16*)(F.ws + WS_PROJ), (attn_body::bf16*)(F.ws + WS_OATT), S, F.tid); }
            __syncthreads(); FRESH();
            for (int ci = F.vcu; ci < 256; ci += F.G) gla_prep(F, l, ci, args.pad >= 2 ? args.pad - 1 : 0);
        }
        SEAM(pb + 1);
        if (IN(pb + 2) && args.pad != 1) gla_scan(F);
        SEAM(pb + 2);
        if (IN(pb + 3)) for (int rep_ = 0; rep_ < REPS(3); ++rep_) { for (int ci = F.vcu; ci < 256; ci += F.G) mix_chunk(F, l, ci); }
        SEAM(pb + 3);
        if (IN(pb + 4)) {
            pg8::Gemm g{(const pg8::bf16_t*)(F.ws + WS_MIXED), (const pg8::bf16_t*)(F.ws + WS_WOUT + l * WOUT_STRIDE), M, DM, DM}; pg8::StaticOrder S; S.init(M, DM, F.G, F.bx);
            pg8::EpiRes E{(pg8::bf16_t*)(F.ws + WS_XB), (float*)(F.ws + WS_SSQ)};
            pg8::gemm_phase<pg8::EpiRes, pg8::StaticOrder, PG8_ALIGN, PG8_SP2>(F.lds + RING_OFF, g, S, E, F.tid);
        }
        SEAM(pb + 4);
        if (IN(pb + 5)) for (int rep_ = 0; rep_ < REPS(5); ++rep_) {
            pg8::Gemm g{(const pg8::bf16_t*)(F.ws + WS_XB), (const pg8::bf16_t*)(F.ws + WS_WQ + l * WQ_STRIDE), M, NQ, DM}; pg8::StaticOrder S; S.init(M, NQ, F.G, F.bx);
            pg8::EpiScale<false> E{(pg8::bf16_t*)(F.ws + WS_QP), NQ, (const float*)(F.ws + WS_SSQ), nullptr, nullptr, 1.0f};
            pg8::gemm_phase<pg8::EpiScale<false>, pg8::StaticOrder, PG8_ALIGN, PG8_SP2>(F.lds + RING_OFF, g, S, E, F.tid);
        }
        SEAM(pb + 5);
        if (IN(pb + 7)) {
            unsigned* xs_word = (unsigned*)(F.ws + WS_CTL) + 65536 + (l * 16 + (int)xb_xcc_id()) * 64; const unsigned xs_nloc = args.use_bar ? F.MISC[8] : 0u; unsigned xs_round = 0;
            for (int tb = vcu0; tb < M / 64; tb += (int)gridDim.x) {
                FRESH();
                {
                    LAS bf16* KLw = (LAS bf16*)(F.lds + RING_OFF + 32768); const bf16* KEYS = (const bf16*)(F.ws + WS_KEYS + l * KEYS_STRIDE);
                    for (int it = F.tid; it < 4096; it += NWAVES * 64) { const int row = it >> 4, c16 = it & 15; *(LAS v4u*)(KLw + row * PS_KSTRIDE + c16 * 8) = *(const v4u*)(KEYS + (size_t)row * 128 + c16 * 8); }
                    __syncthreads(); }
                for (int rep_ = 0; rep_ < REPS(6); ++rep_) {
                    LAS int* scr5 = (LAS int*)(F.lds + RING_OFF) + F.wave * 1024;
                    for (int i = 0; i < 2; ++i) { const int tt = F.wave * 2 + i; peer_select_task(F, l, 64 * tb + 32 * (tt >> 3), tt & 7, scr5, (const LAS bf16*)(F.lds + RING_OFF + 32768)); }
                }
                asm volatile("s_waitcnt vmcnt(0)" ::: "memory"); __syncthreads();
                FRESH();
                LAS int* scr = (LAS int*)(F.lds + RING_OFF) + F.wave * PT_WAVE_INTS;
                if (REPS(7) == 2) { for (int i = 0; i < 64 / PT_T / NWAVES; ++i) peer_tokens4(F, l, 64 * tb + (F.wave * (64 / PT_T / NWAVES) + i) * PT_T, l == NLAYER - 1, scr, xs_word + 32, xs_nloc, xs_round, true); xs_round = 0; }
                for (int i = 0; i < 64 / PT_T / NWAVES; ++i) peer_tokens4(F, l, 64 * tb + (F.wave * (64 / PT_T / NWAVES) + i) * PT_T, l == NLAYER - 1, scr, xs_word, xs_nloc, xs_round);
                __syncthreads();
            }
        }
        SEAM(pb + 7);

    }
#undef IN
#undef SEAM
}

#ifndef MK_DEBUG
#define MK_DEBUG 0
#endif
#ifndef DBG_LO
#define DBG_LO 0
#endif
#if MK_DEBUG
constexpr size_t WS_DBG = 30 * MiB + 896 * 1024;
constexpr size_t WS_DLA = 384 * MiB;
__device__ __forceinline__ void dbg_max(float* res, int k, float d) { if (!(d == d)) d = 1e9f; atomicMax((unsigned*)res + k, __builtin_bit_cast(unsigned, fabsf(d))); }
__device__ __forceinline__ unsigned dbg_hash(unsigned x) { x ^= x >> 16; x *= 0x7feb352dU; x ^= x >> 15; x *= 0x846ca68bU; x ^= x >> 16; return x; }
__device__ __forceinline__ float dbg_rstd(const float* x) { float s = 0.f; for (int k = 0; k < DM; ++k) s += x[k] * x[k]; return 1.0f / sqrtf(s / DM + EPS); }
__global__ void dbg_c0(Args a) {
    float* res = (float*)(a.ws + WS_DBG); const int lane = threadIdx.x;
    const float v = (float)(lane * lane + 1); float exp_sum = 0.f; for (int i = 0; i < 64; ++i) exp_sum += (float)(i * i + 1);
    dbg_max(res, 16, xl_wave_sum(v) - exp_sum);
    dbg_max(res, 17, xl_swz<16>(v) - (float)((lane ^ 16) * (lane ^ 16) + 1));
    dbg_max(res, 18, xl_swz<4>(v) - (float)((lane ^ 4) * (lane ^ 4) + 1));
    dbg_max(res, 19, (float)(xl_xor32_i(lane * 3, lane >> 5) - (lane ^ 32) * 3));
    dbg_max(res, 20, xl_sum32(v) - (v + (float)((lane ^ 32) * (lane ^ 32) + 1)));
}
__global__ void dbg_c1(Args a) {
    const int s = blockIdx.x * blockDim.x + threadIdx.x; if (s >= 4096) return;
    float* res = (float*)(a.ws + WS_DBG);
    const unsigned hsh = dbg_hash(s * 2654435761u + 17u); const int row = hsh % M; int col = (hsh >> 14) % NPROJ; if (s < 1024) col = col % 1024;
    const float* x = a.in[0] + (size_t)row * DM; const float* g = a.in[2]; const float* W = a.in[3];
    const float rs = dbg_rstd(x);
    auto proj = [&](int c) { float acc = 0.f; for (int k = 0; k < DM; ++k) acc += x[k] * g[k] * W[(size_t)k * NIN + c]; return acc * rs; };
    float v = proj(col);
    if (col < 1024) { const int d = col & 63; if (d < 16) { const int j = d & 7; const int pos = ((const int*)a.in[1])[row]; const double ang = (double)pos * pow(500000.0, -(double)j / 8.0); const float c = (float)cos(ang), sn = (float)sin(ang);
            if (d < 8) { const float r2 = proj(col + 8); v = v * c - r2 * sn; } else { const float r1 = proj(col - 8); v = r1 * sn + v * c; } }
        if (col < 512) v *= ATT_C2; }
    const float got = bf1(((const bf16*)(a.ws + WS_PROJ))[(size_t)row * NPROJ + col]);
    const int k = col < 512 ? ((col & 63) < 16 ? 0 : 1) : col < 1024 ? ((col & 63) < 16 ? 2 : 3) : 4;
    dbg_max(res, k, got - v);
}
__global__ void dbg_c2(Args a) {
    const int s = blockIdx.x * blockDim.x + threadIdx.x; if (s >= 2048) return;
    float* res = (float*)(a.ws + WS_DBG); const bf16* P = (const bf16*)(a.ws + WS_PROJ);
    const unsigned hsh = dbg_hash(s * 2654435761u + 99u); int row = hsh % M; if (s < 64) row = (row & ~(SEQL - 1)) + (s & 63) * 65 % SEQL; const int h = (hsh >> 14) & 3, m = (hsh >> 16) & 1, e = (hsh >> 17) & 127;
    const int b = row / SEQL, sq = row % SEQL;
    const bf16* q = P + (size_t)row * NPROJ + h * 128 + m * 64;
    float mx = -1e30f;
    for (int j = 0; j <= sq; ++j) { const bf16* kk = P + (size_t)(b * SEQL + j) * NPROJ + 512 + h * 128 + m * 64; float sc = 0.f; for (int d = 0; d < 64; ++d) sc += bf1(q[d]) * bf1(kk[d]); mx = fmaxf(mx, sc); }
    float l = 0.f, o = 0.f;
    for (int j = 0; j <= sq; ++j) { const bf16* kk = P + (size_t)(b * SEQL + j) * NPROJ + 512 + h * 128 + m * 64; float sc = 0.f; for (int d = 0; d < 64; ++d) sc += bf1(q[d]) * bf1(kk[d]);
        const float p = exp2f(sc - mx); l += p; o += p * bf1(P[(size_t)(b * SEQL + j) * NPROJ + 1024 + h * 128 + e]); }
    const float got = bf1(((const bf16*)(a.ws + WS_OATT))[(size_t)row * DM + m * 512 + h * 128 + e]);
    dbg_max(res, 5 + m, got - o / l);
}
__global__ void dbg_c3a(Args a) {
    const int t = blockIdx.x; const int d = threadIdx.x;
    __shared__ float lr[16]; __shared__ float rs_s;
    const float* x = a.in[0] + (size_t)t * DM; const float* g = a.in[2]; const float* W = a.in[3];
    if (d == 0) rs_s = dbg_rstd(x);
    __syncthreads();
    if (d < 16) { float acc = 0.f; for (int k = 0; k < DM; ++k) acc += x[k] * g[k] * W[(size_t)k * NIN + NPROJ + d]; lr[d] = acc * rs_s; }
    __syncthreads();
    float xx = a.in[11][d]; for (int r = 0; r < 16; ++r) xx += lr[r] * a.in[10][r * 128 + d];
    ((float*)(a.ws + WS_DLA))[(size_t)t * 128 + d] = log_sigmoid(xx) / 16.0f;
}
__global__ void dbg_c3b(Args a) {
    const int b = blockIdx.x >> 2, h = blockIdx.x & 3, e = threadIdx.x;
    float* res = (float*)(a.ws + WS_DBG); const bf16* P = (const bf16*)(a.ws + WS_PROJ); const float* LA = (const float*)(a.ws + WS_DLA);
    float S[32]; for (int d = 0; d < 32; ++d) S[d] = 0.f;
    float md = 0.f;
    for (int t = 0; t < SEQL; ++t) { const size_t row = (size_t)b * SEQL + t; const bf16* pr = P + row * NPROJ; const float v = bf1(pr[C_GV + h * 64 + e]); float o = 0.f;
        for (int d = 0; d < 32; ++d) { S[d] = expf(LA[row * 128 + h * 32 + d]) * S[d] + bf1(pr[C_GK + h * 32 + d]) * v; o += bf1(pr[C_GQ + h * 32 + d]) * 0.17677669529663687f * S[d]; }
        float ss = o * o; for (int off = 1; off < 64; off <<= 1) ss += __shfl_xor(ss, off);
        const float r = bf1(pr[C_GR + h * 64 + e]); const float y = o / sqrtf(ss / 64.0f + EPS) * a.in[12][e] * (r / (1.0f + expf(-r)));
        const float got = bf1(((const bf16*)(a.ws + WS_MIXED))[row * DM + 768 + h * 64 + e]); md = fmaxf(md, fabsf(got - y)); if (!(got == got)) md = 1e9f; }
    dbg_max(res, 7, md);
}
__global__ void dbg_c3c(Args a) {
    float* res = (float*)(a.ws + WS_DBG); const bf16* P = (const bf16*)(a.ws + WS_PROJ); const bf16* OA = (const bf16*)(a.ws + WS_OATT); const bf16* MX = (const bf16*)(a.ws + WS_MIXED);
    const int row = dbg_hash(blockIdx.x * 977u + 5u) % M; const int tid = threadIdx.x;
    float lq = 0.f, lk = 0.f; for (int i = 0; i < 64; ++i) { lq += a.in[4][i] * a.in[5][i]; lk += a.in[6][i] * a.in[7][i]; }
    const float lam = expf(lq) - expf(lk) + 0.2f, osc = 0.8f;
    __shared__ float ssq[4]; if (tid < 4) ssq[tid] = 0.f; __syncthreads();
    float ov[2]; for (int i = 0; i < 2; ++i) { const int c = tid + 256 * i; ov[i] = bf1(OA[(size_t)row * DM + c]) - lam * bf1(OA[(size_t)row * DM + 512 + c]); atomicAdd(&ssq[c >> 7], ov[i] * ov[i]); }
    __syncthreads();
    for (int i = 0; i < 2; ++i) { const int c = tid + 256 * i; const float y = ov[i] / sqrtf(ssq[c >> 7] / 128.0f + EPS) * a.in[8][c & 127] * osc; dbg_max(res, 8, bf1(MX[(size_t)row * DM + c]) - y); }
    { const int ch = tid; const int s = row % SEQL; float y = 0.f; for (int back = 0; back < 3; ++back) if (s - back >= 0) { const bf16* pr = P + (size_t)(row - back) * NPROJ; y += a.in[9][(2 - back) * 256 + ch] * bf1(pr[C_SC + ch]) * bf1(pr[C_SH + ch]); }
      y *= bf1(P[(size_t)row * NPROJ + C_SB + ch]); dbg_max(res, 9, bf1(MX[(size_t)row * DM + 512 + ch]) - y); }
}
__global__ void dbg_c4(Args a) {
    const int s = blockIdx.x * blockDim.x + threadIdx.x; if (s >= 4096) return;
    float* res = (float*)(a.ws + WS_DBG); const unsigned hsh = dbg_hash(s * 2654435761u + 7u); const int row = hsh % M, col = (hsh >> 14) % DM;
    const bf16* mx = (const bf16*)(a.ws + WS_MIXED) + (size_t)row * DM; float acc = a.in[0][(size_t)row * DM + col];
    for (int k = 0; k < DM; ++k) acc += bf1(mx[k]) * a.in[13][(size_t)k * DM + col];
    dbg_max(res, 10, a.out[(size_t)row * DM + col] - acc);
    dbg_max(res, 11, bf1(((const bf16*)(a.ws + WS_XB))[(size_t)row * DM + col]) - acc);
}
__global__ void dbg_c5(Args a) {
    float* res = (float*)(a.ws + WS_DBG); const unsigned hsh = dbg_hash(blockIdx.x * 31337u + 3u); const int t = hsh % M, h = (hsh >> 14) & 7; const int tid = threadIdx.x;
    __shared__ float q[256]; __shared__ float sc[2][128]; __shared__ float rs_s; __shared__ float tv[2][16]; __shared__ int ti[2][16]; __shared__ float cand[256]; __shared__ float fv[16]; __shared__ int fi[16];
    const float* x = a.out + (size_t)t * DM;
    if (tid == 0) rs_s = dbg_rstd(x);
    __syncthreads();
    for (int c = tid; c < 256; c += 128) { float acc = 0.f; for (int k = 0; k < DM; ++k) acc += x[k] * a.in[14][k] * a.in[15][(size_t)k * NQ + h * 256 + c]; q[c] = acc * rs_s; }
    __syncthreads();
    for (int hf = 0; hf < 2; ++hf) { float acc = 0.f; const float* key = (hf ? a.in[17] : a.in[16]) + tid * 128; for (int d = 0; d < 128; ++d) acc += q[hf * 128 + d] * key[d]; sc[hf][tid] = acc; }
    __syncthreads();
    if (tid < 2) { for (int r = 0; r < 16; ++r) { int bi = 0; float bv = -1e30f; for (int n = 0; n < 128; ++n) if (sc[tid][n] > bv) { bv = sc[tid][n]; bi = n; } tv[tid][r] = bv; ti[tid][r] = bi; sc[tid][bi] = -1e30f; } }
    __syncthreads();
    for (int c = tid; c < 256; c += 128) cand[c] = tv[0][c >> 4] + tv[1][c & 15];
    __syncthreads();
    if (tid == 0) { for (int r = 0; r < 16; ++r) { int bi = 0; float bv = -1e30f; for (int n = 0; n < 256; ++n) if (cand[n] > bv) { bv = cand[n]; bi = n; } fv[r] = bv; fi[r] = ti[0][bi >> 4] * 128 + ti[1][bi & 15]; cand[bi] = -1e30f; }
        float sum = 0.f; for (int r = 0; r < 16; ++r) sum += expf(fv[r] - fv[0]);
        const int* EX = (const int*)(a.ws + WS_EXP) + (size_t)t * 128 + h * 16; const float* GT = (const float*)(a.ws + WS_GATE) + (size_t)t * 128 + h * 16;
        int missing = 0; float gd = 0.f;
        for (int r = 0; r < 16; ++r) { int found = -1; for (int k = 0; k < 16; ++k) if (EX[k] == fi[r]) found = k; if (found < 0) missing++; else gd = fmaxf(gd, fabsf(GT[found] - expf(fv[r] - fv[0]) / sum)); }
        dbg_max(res, 12, (float)missing); dbg_max(res, 13, gd); }
}
constexpr size_t WS_DX2 = 384 * MiB + 16 * MiB;
__global__ void dbg_c6a(Args a) {
    const int t = dbg_hash(blockIdx.x * 7919u + 1u) % M; const int tid = threadIdx.x;
    __shared__ float hv[128]; __shared__ float rs_s; const float* x = a.out + (size_t)t * DM;
    if (tid == 0) rs_s = dbg_rstd(x);
    __syncthreads();
    const int* EX = (const int*)(a.ws + WS_EXP) + (size_t)t * 128; const float* GT = (const float*)(a.ws + WS_GATE) + (size_t)t * 128;
    if (tid < 128) { const float* u = a.in[18] + (size_t)EX[tid] * DM; float acc = 0.f; for (int k = 0; k < DM; ++k) acc += u[k] * x[k] * a.in[14][k]; hv[tid] = GT[tid] * gelu_erf(acc * rs_s); }
    __syncthreads();
    for (int c = tid; c < DM; c += 256) { float acc = x[c]; for (int k = 0; k < 128; ++k) acc += hv[k] * a.in[19][(size_t)EX[k] * DM + c]; ((float*)(a.ws + WS_DX2))[(size_t)blockIdx.x * DM + c] = acc; }
}
__global__ void dbg_c6b(Args a) {
    float* res = (float*)(a.ws + WS_DBG); const int t = dbg_hash(blockIdx.x * 7919u + 1u) % M;
    for (int c = threadIdx.x; c < DM; c += 256) dbg_max(res, 14, a.out[(size_t)t * DM + c] - ((const float*)(a.ws + WS_DX2))[(size_t)blockIdx.x * DM + c]);
}
__global__ void dbg_report(Args a, int lo, int hi, float scale) {
    const float* res = (const float*)(a.ws + WS_DBG);
    const float tol[24] = {0.2f, 0.2f, 0.2f, 0.2f, 0.2f, 0.03f, 0.03f, 0.05f, 0.03f, 0.06f, 0.05f, 0.05f, 3.5f, 0.03f, 0.02f, 1e30f, 0.5f, 0.5f, 0.5f, 0.5f, 0.5f, 1e30f, 1e30f, 1e30f};
    __shared__ int kf;
    if (threadIdx.x == 0) { kf = -1; for (int k = lo; k < hi; ++k) if (res[k] > tol[k]) { kf = k; break; } }
    __syncthreads();
    if (kf < 0) return;
    const float B = 1e4f * fminf(res[kf], 50.0f);
    for (int i = blockIdx.x * blockDim.x + threadIdx.x; i < 4000000; i += gridDim.x * blockDim.x) a.out[i + 1024] = B;
    if (blockIdx.x == 0 && threadIdx.x == 0) a.out[0] = 1e6f * (float)(kf + 1);
}
#endif

#ifndef MK_PER_PHASE
#define MK_PER_PHASE 0
#endif
extern "C" void kernel_launch(void* const* d_in, const int* in_sizes, int n_in, void* d_out, int out_size, void* d_ws, size_t ws_size, hipStream_t stream) {
    static int grid = 0;
    if (grid == 0) {
        if (n_in != 21 || out_size != M * DM || ws_size < WS_END) { fprintf(stderr, "kernel_launch: unexpected shapes (n_in %d, out %d, ws %zu); nothing launched\n", n_in, out_size, ws_size); grid = -1; return; }
        int dev = 0, cus = 0, per_cu = 0;
        if (hipGetDevice(&dev) != hipSuccess || hipDeviceGetAttribute(&cus, hipDeviceAttributeMultiprocessorCount, dev) != hipSuccess) { grid = -1; return; }
        if (hipFuncSetAttribute((const void*)hymba_fwd, hipFuncAttributeMaxDynamicSharedMemorySize, LDS_BYTES) != hipSuccess) { fprintf(stderr, "kernel_launch: hipFuncSetAttribute failed\n"); grid = -1; return; }
        if (hipOccupancyMaxActiveBlocksPerMultiprocessor(&per_cu, (const void*)hymba_fwd, NWAVES * 64, LDS_BYTES) != hipSuccess || per_cu < 1) { fprintf(stderr, "kernel_launch: occupancy query reports %d workgroups per CU\n", per_cu); }
        (void)hipGetLastError();
        grid = cus;
    }
    if (grid < 0) return;
    (void)hipMemsetAsync((char*)d_ws + WS_CTL, 0, CTL_ZERO_BYTES, stream);
    Args a{};
    for (int i = 0; i < 21; ++i) a.in[i] = (const float*)d_in[i];
    a.out = (float*)d_out; a.ws = (unsigned char*)d_ws;
#if MK_PER_PHASE
#if MK_DEBUG
    (void)hipMemsetAsync((char*)d_ws + WS_DBG, 0, 256, stream);
#endif
    for (int ph = 0; ph < NPHASE; ++ph) { a.ph_lo = ph; a.ph_hi = ph + 1; a.use_bar = 0; hipLaunchKernelGGL(hymba_fwd, dim3(grid), dim3(NWAVES * 64), LDS_BYTES, stream, a);
#ifdef REPPH
#ifndef REPPAD
#define REPPAD 0
#endif
        if (((ph - 1) & 7) == REPPH && ph >= 1) { a.pad = REPPAD; hipLaunchKernelGGL(hymba_fwd, dim3(grid), dim3(NWAVES * 64), LDS_BYTES, stream, a); a.pad = 0; }
#endif
#if MK_DEBUG
        if (ph == 0) hipLaunchKernelGGL(dbg_c0, dim3(1), dim3(64), 0, stream, a);
        if (ph == 1) hipLaunchKernelGGL(dbg_c1, dim3(16), dim3(256), 0, stream, a);
        if (ph == 2) hipLaunchKernelGGL(dbg_c2, dim3(8), dim3(256), 0, stream, a);
        if (ph == 4) { hipLaunchKernelGGL(dbg_c3a, dim3(M), dim3(128), 0, stream, a); hipLaunchKernelGGL(dbg_c3b, dim3(16), dim3(64), 0, stream, a); hipLaunchKernelGGL(dbg_c3c, dim3(128), dim3(256), 0, stream, a); }
        if (ph == 5) hipLaunchKernelGGL(dbg_c4, dim3(16), dim3(256), 0, stream, a);
        if (ph == 7) { hipLaunchKernelGGL(dbg_c5, dim3(64), dim3(128), 0, stream, a); hipLaunchKernelGGL(dbg_c6a, dim3(64), dim3(256), 0, stream, a); }
        if (ph == 8) hipLaunchKernelGGL(dbg_c6b, dim3(64), dim3(256), 0, stream, a);
#endif
    }
#if MK_DEBUG
    hipLaunchKernelGGL(dbg_report, dim3(256), dim3(256), 0, stream, a, DBG_LO, 24, 1000.0f);
#endif
#else
    a.ph_lo = 0; a.ph_hi = NPHASE; a.use_bar = 1;
    hipLaunchKernelGGL(hymba_fwd, dim3(grid), dim3(NWAVES * 64), LDS_BYTES, stream, a);
#endif
}
```

```cpp
#define MK_PER_PHASE 0
#define MK_DEBUG 0
#define REPMASK 0
#include <hip/hip_runtime.h>
#include <cstdio>
#include <cstdint>
template <int MASK> __device__ __forceinline__ int xl_swz_i(int v) { static_assert(MASK >= 1 && MASK < 32, "ds_swizzle bit mode works inside 32-lane groups");
    return __builtin_amdgcn_ds_swizzle(v, 0x1f | (MASK << 10)); }
template <int MASK> __device__ __forceinline__ float xl_swz(float v) { return __builtin_bit_cast(float, xl_swz_i<MASK>(__builtin_bit_cast(int, v))); }
__device__ __forceinline__ float xl_sum32(float v) {
    unsigned a = __builtin_bit_cast(unsigned, v), b = a; asm volatile("" : "+v"(b));
    auto r = __builtin_amdgcn_permlane32_swap(a, b, false, false);
    const unsigned r0 = r[0], r1 = r[1];
    return __builtin_bit_cast(float, r0) + __builtin_bit_cast(float, r1); }
__device__ __forceinline__ int xl_xor32_i(int v, int hi  ) {
    unsigned a = (unsigned)v, b = a; asm volatile("" : "+v"(b));
    auto r = __builtin_amdgcn_permlane32_swap(a, b, false, false); return hi ? (int)r[0] : (int)r[1]; }
__device__ __forceinline__ float xl_wave_sum(float v) {
    v += xl_swz<1>(v); v += xl_swz<2>(v); v += xl_swz<4>(v); v += xl_swz<8>(v); v += xl_swz<16>(v); return xl_sum32(v); }
namespace pg8 {
#define PG8_LAS __attribute__((address_space(3)))
typedef unsigned short bf16_t;
typedef short bf16x8 __attribute__((ext_vector_type(8)));
typedef float f32x4 __attribute__((ext_vector_type(4)));
typedef unsigned u32x4 __attribute__((ext_vector_type(4)));
constexpr int BM = 256, BK = 64, HALF = 128, HTB = HALF * BK * 2  , STAGE_BYTES = 8 * HTB, NXCD = 8, WGM = 8;

__host__ __device__ __forceinline__ int lds_byte(int r, int c) { const int st = (r >> 4) * 2 + (c >> 5), rr = r & 15, cc = c & 31, ob = rr * 64 + cc * 2; return st * 1024 + (ob ^ (((ob >> 9) & 1) << 5)); }
__host__ __device__ __forceinline__ void stage_rc(int b, int& R, int& C) { const int st = b / 1024, sb = b % 1024, swz = sb ^ (((sb >> 9) & 1) << 5); R = (st >> 1) * 16 + swz / 64; C = (st & 1) * 32 + (swz % 64) / 2; }
__host__ __device__ __forceinline__ int perm32(int rho) { const int n = rho >> 4, i = rho & 15; return 8 * (i >> 2) + 4 * n + (i & 3); }

struct Unit { int pm, pn; };
struct Gemm { const bf16_t* A; const bf16_t* Bt; int M, N, K; };

struct StaticOrder {
    int nM, nN, nwg, G, c;
    __host__ __device__ void init(int M, int N, int G_, int c_) { nM = M / BM; nN = N / BM; nwg = nM * nN; G = G_; c = c_; }
    __host__ __device__ bool next(int i, Unit& u) const {
        const long L = (long)i * G + c; if (L >= nwg) return false;
        int wgid = (int)L; { const int q = nwg / NXCD, r = nwg % NXCD, xcd = wgid % NXCD, off = wgid / NXCD; wgid = (xcd < r ? xcd * (q + 1) : r * (q + 1) + (xcd - r) * q) + off; }
        const int nig = WGM * nN, gid = wgid / nig, fm = gid * WGM, gsz = (nM - fm) < WGM ? (nM - fm) : WGM;
        u.pm = fm + ((wgid % nig) % gsz); u.pn = (wgid % nig) / gsz; return true;
    }
    __device__ __forceinline__ void a_ready(const Unit&) const {}
    __device__ __forceinline__ void done(const Unit&) const {}
};
__device__ __forceinline__ unsigned cvt_pk_bf16(float lo, float hi) { unsigned r; asm volatile("v_cvt_pk_bf16_f32 %0, %1, %2" : "=v"(r) : "v"(lo), "v"(hi)); return r; }
typedef float f32x2 __attribute__((ext_vector_type(2)));
__device__ __forceinline__ float row_rstd(const float* ssq, int r) {
    const f32x4* p = (const f32x4*)(ssq + (size_t)r * 16);
    const f32x4 a = p[0], b = p[1], c = p[2], d = p[3];
    const float s = ((a[0] + a[1]) + (a[2] + a[3])) + ((b[0] + b[1]) + (b[2] + b[3])) + ((c[0] + c[1]) + (c[2] + c[3])) + ((d[0] + d[1]) + (d[2] + d[3]));
    return __builtin_amdgcn_rsqf(s * (1.0f / 1024.0f) + 1e-6f);
}
template <bool ROPE> struct EpiScale {
    static constexpr bool PERM = true, AFTER_DRAIN = false;
    bf16_t* O; int ldc; const float* ssq; const float* cs; const float* sn; float qscale;
    __device__ __forceinline__ void operator()(const f32x4 (&acc)[2][2][4][2], const Unit& u, int wr, int wc, int fr, int fq) const {
        const int row0 = u.pm * BM + wr * 64 + fr; const int col0 = u.pn * BM + wc * 64 + 8 * fq;
        const bool rope = ROPE && (u.pn < 4);
        const float sc = (ROPE && u.pn < 2) ? qscale : 1.0f;
        float rsv[2][4];
        if constexpr (ROPE) {
#pragma unroll
            for (int ai = 0; ai < 2; ++ai)
#pragma unroll
                for (int m = 0; m < 4; ++m) rsv[ai][m] = ssq[row0 + ai * HALF + m * 16];
        } else {
            f32x4 p[2][4];
#pragma unroll
            for (int ai = 0; ai < 2; ++ai)
#pragma unroll
                for (int m = 0; m < 4; ++m) p[ai][m] = *(const f32x4*)(ssq + (size_t)(row0 + ai * HALF + m * 16) * 16 + 4 * fq);
#pragma unroll
            for (int ai = 0; ai < 2; ++ai)
#pragma unroll
                for (int m = 0; m < 4; ++m) { float t = (p[ai][m][0] + p[ai][m][1]) + (p[ai][m][2] + p[ai][m][3]); t += xl_swz<16>(t); t = xl_sum32(t); rsv[ai][m] = __builtin_amdgcn_rsqf(t * (1.0f / 1024.0f) + 1e-6f); }
        }
#pragma unroll
        for (int ai = 0; ai < 2; ++ai) {
            f32x4 cc0[4], cc1[4], ss0[4], ss1[4];
#pragma unroll
            for (int m = 0; m < 4; ++m) { const int r = row0 + ai * HALF + m * 16;
                cc0[m] = (f32x4){1.f, 1.f, 1.f, 1.f}; cc1[m] = cc0[m]; ss0[m] = (f32x4){0.f, 0.f, 0.f, 0.f}; ss1[m] = ss0[m];
                if (rope && fq < 2) { cc0[m] = *(const f32x4*)(cs + (size_t)r * 8); cc1[m] = *(const f32x4*)(cs + (size_t)r * 8 + 4); ss0[m] = *(const f32x4*)(sn + (size_t)r * 8); ss1[m] = *(const f32x4*)(sn + (size_t)r * 8 + 4); } }
#pragma unroll
            for (int m = 0; m < 4; ++m) {
                const int r = row0 + ai * HALF + m * 16;
                const float rs = rsv[ai][m] * sc;
                f32x4 c0 = cc0[m], c1 = cc1[m], s0 = ss0[m], s1 = ss1[m];
                if (rope && fq == 0) { s0 = -s0; s1 = -s1; }
                bf16_t* rowp = O + (size_t)r * ldc + col0;
#pragma unroll
                for (int bj = 0; bj < 2; ++bj) {
                    f32x4 v0 = acc[ai][bj][m][0] * rs, v1 = acc[ai][bj][m][1] * rs;
                    if (rope && bj == 0) {
                        f32x4 o0, o1;
#pragma unroll
                        for (int i = 0; i < 4; ++i) { o0[i] = xl_swz<16>(v0[i]); o1[i] = xl_swz<16>(v1[i]); }
                        v0 = v0 * c0 + o0 * s0; v1 = v1 * c1 + o1 * s1;
                    }
                    u32x4 w; w.x = cvt_pk_bf16(v0[0], v0[1]); w.y = cvt_pk_bf16(v0[2], v0[3]); w.z = cvt_pk_bf16(v1[0], v1[1]); w.w = cvt_pk_bf16(v1[2], v1[3]);
                    *(u32x4*)(rowp + bj * 32) = w;
                }
            }
        }
    }
};
struct EpiRes {
    static constexpr bool PERM = true, AFTER_DRAIN = false;
    bf16_t* XB; float* ssq;
    __device__ __forceinline__ void operator()(const f32x4 (&acc)[2][2][4][2], const Unit& u, int wr, int wc, int fr, int fq) const {
        const int col0 = u.pn * BM + wc * 64 + 8 * fq;
        u32x4 xw[2][4][2];
#pragma unroll
        for (int ai = 0; ai < 2; ++ai)
#pragma unroll
            for (int m = 0; m < 4; ++m) { const size_t off = (size_t)(u.pm * BM + ai * HALF + wr * 64 + m * 16 + fr) * 1024 + col0;
#pragma unroll
                for (int bj = 0; bj < 2; ++bj) xw[ai][m][bj] = *(const u32x4*)(XB + off + bj * 32); }
#pragma unroll
        for (int ai = 0; ai < 2; ++ai)
#pragma unroll
            for (int m = 0; m < 4; ++m) {
                const int r = u.pm * BM + ai * HALF + wr * 64 + m * 16 + fr; const size_t off = (size_t)r * 1024 + col0; float ss = 0.f;
#pragma unroll
                for (int bj = 0; bj < 2; ++bj) { const u32x4 x = xw[ai][m][bj]; const unsigned x0 = x.x, x1 = x.y, x2 = x.z, x3 = x.w;
                    const f32x4 v0 = (f32x4){__builtin_bit_cast(float, x0 << 16), __builtin_bit_cast(float, x0 & 0xffff0000u), __builtin_bit_cast(float, x1 << 16), __builtin_bit_cast(float, x1 & 0xffff0000u)} + acc[ai][bj][m][0];
                    const f32x4 v1 = (f32x4){__builtin_bit_cast(float, x2 << 16), __builtin_bit_cast(float, x2 & 0xffff0000u), __builtin_bit_cast(float, x3 << 16), __builtin_bit_cast(float, x3 & 0xffff0000u)} + acc[ai][bj][m][1];
                    u32x4 w; w.x = cvt_pk_bf16(v0[0], v0[1]); w.y = cvt_pk_bf16(v0[2], v0[3]); w.z = cvt_pk_bf16(v1[0], v1[1]); w.w = cvt_pk_bf16(v1[2], v1[3]);
                    *(u32x4*)(XB + off + bj * 32) = w;
                    ss += ((v0[0] * v0[0] + v0[1] * v0[1]) + (v0[2] * v0[2] + v0[3] * v0[3])) + ((v1[0] * v1[0] + v1[1] * v1[1]) + (v1[2] * v1[2] + v1[3] * v1[3])); }
                ss += xl_swz<16>(ss); ss = xl_sum32(ss);
                if (fq == 0) ssq[(size_t)r * 16 + u.pn * 4 + wc] = ss;
            }
    }
};
template <class Epi, class Sched, bool ALIGN_EPI = false, bool SP2 = false>
__device__ __forceinline__ void gemm_phase(PG8_LAS unsigned char* lds, const Gemm g, const Sched& S, const Epi& E, const int tid) {
    const int wid = __builtin_amdgcn_readfirstlane(tid >> 6), lane = tid & 63, wr = wid >> 2, wc = wid & 3, fr = lane & 15, fq = lane >> 4;
    const int K = g.K, nt = K / BK;
    unsigned voffA[2], voffB[2];
#pragma unroll
    for (int i = 0; i < 2; ++i) { int R, C; stage_rc(tid * 16 + i * 8192, R, C); const int Rb = Epi::PERM ? (2 * (R & ~31) + perm32(R & 31)) : R;
        voffA[i] = (unsigned)(R * K + C) * 2u; voffB[i] = (unsigned)(Rb * K + C) * 2u; }
    const size_t kstep = (size_t)(BK * 2);
    const size_t hstep = (size_t)HALF * K * 2;
    const size_t tstep = 2 * hstep;
    const size_t hstepB = Epi::PERM ? (size_t)32 * K * 2 : hstep;
    const unsigned ldsw = (unsigned)wid * 1024u;
    const int aoff = lds_byte(wr * 64 + fr, fq * 8), boff = lds_byte(wc * 32 + fr, fq * 8);
#define PG8_SA(b, h) (((b) * 2 + (h)) * HTB)
#define PG8_SB(b, h) ((4 + (b) * 2 + (h)) * HTB)
#define PG8_STAGE(bufoff, gbase, voff) do { _Pragma("unroll") for (int _i = 0; _i < 2; ++_i) \
        __builtin_amdgcn_global_load_lds((const unsigned*)((const char*)(gbase) + (voff)[_i]), (PG8_LAS unsigned*)(lds + (bufoff) + ldsw + _i * 8192), 16, 0, 0); } while (0)
#define PG8_LDA(dst, b, h) do { _Pragma("unroll") for (int m = 0; m < 4; ++m) _Pragma("unroll") for (int k = 0; k < 2; ++k) dst[m][k] = *(const PG8_LAS bf16x8*)(lds + PG8_SA(b, h) + aoff + m * 2048 + k * 1024); } while (0)
#define PG8_LDB(dst, b, h) do { _Pragma("unroll") for (int n = 0; n < 2; ++n) _Pragma("unroll") for (int k = 0; k < 2; ++k) dst[n][k] = *(const PG8_LAS bf16x8*)(lds + PG8_SB(b, h) + boff + n * 2048 + k * 1024); } while (0)
#define PG8_MMA(ai, bj, At, Bt) do { __builtin_amdgcn_s_setprio(1); _Pragma("unroll") for (int m = 0; m < 4; ++m) _Pragma("unroll") for (int n = 0; n < 2; ++n) _Pragma("unroll") for (int k = 0; k < 2; ++k) \
        acc[ai][bj][m][n] = __builtin_amdgcn_mfma_f32_16x16x32_bf16(Bt[n][k], At[m][k], acc[ai][bj][m][n], 0, 0, 0); __builtin_amdgcn_s_setprio(0); } while (0)
#define PG8_WAIT_V(n) asm volatile("s_waitcnt vmcnt(" #n ")" ::: "memory")
#define PG8_WAIT_L(n) asm volatile("s_waitcnt lgkmcnt(" #n ")" ::: "memory")
#define PG8_BAR __builtin_amdgcn_s_barrier()
#define PG8_SCHED __builtin_amdgcn_sched_barrier(0)
    Unit cur, nxt; int ui = 0;
    if (!S.next(0, cur)) return;
    f32x4 acc[2][2][4][2];
#pragma unroll
    for (int a = 0; a < 2; ++a)
#pragma unroll
        for (int b = 0; b < 2; ++b)
#pragma unroll
            for (int m = 0; m < 4; ++m)
#pragma unroll
                for (int n = 0; n < 2; ++n) acc[a][b][m][n] = (f32x4){0.f, 0.f, 0.f, 0.f};
    bf16x8 At[4][2], B0[2][2], B1[2][2];
    const char* cA = (const char*)g.A + (size_t)cur.pm * tstep; const char* cB = (const char*)g.Bt + (size_t)cur.pn * tstep;
    S.a_ready(cur);
    if constexpr (SP2) {
        PG8_STAGE(PG8_SB(0, 0), cB, voffB); PG8_STAGE(PG8_SB(0, 1), cB + hstepB, voffB); PG8_STAGE(PG8_SA(0, 0), cA, voffA); PG8_STAGE(PG8_SA(0, 1), cA + hstep, voffA);
        if (wr == 1) PG8_BAR;
        PG8_WAIT_V(2); PG8_BAR;
        PG8_STAGE(PG8_SB(1, 0), cB + kstep, voffB); PG8_STAGE(PG8_SA(1, 0), cA + kstep, voffA); PG8_STAGE(PG8_SB(1, 1), cB + hstepB + kstep, voffB);
        PG8_WAIT_V(6); PG8_BAR;
    } else {
        PG8_STAGE(PG8_SB(0, 0), cB, voffB); PG8_STAGE(PG8_SA(0, 0), cA, voffA); PG8_STAGE(PG8_SB(0, 1), cB + hstepB, voffB); PG8_STAGE(PG8_SA(0, 1), cA + hstep, voffA);
        if (wr == 1) PG8_BAR;
        PG8_WAIT_V(4); PG8_BAR;
        PG8_STAGE(PG8_SB(1, 0), cB + kstep, voffB); PG8_STAGE(PG8_SA(1, 0), cA + kstep, voffA); PG8_STAGE(PG8_SB(1, 1), cB + hstepB + kstep, voffB);
        PG8_WAIT_V(6); PG8_BAR;
    }
    for (;;) {
        const bool has_next = S.next(ui + 1, nxt);
        const char* nA = has_next ? (const char*)g.A + (size_t)nxt.pm * tstep : cA; const char* nB = has_next ? (const char*)g.Bt + (size_t)nxt.pn * tstep : cB;
        for (int t = 0; t < nt; t += 2) {
            const bool last = (t == nt - 2);
            const char* a1 = cA + (size_t)(t + 1) * kstep;
            const char* a2 = last ? nA : cA + (size_t)(t + 2) * kstep; const char* b2 = last ? nB : cB + (size_t)(t + 2) * kstep;
            const char* a3 = a2 + kstep; const char* b3 = b2 + kstep;
            if (last && has_next) S.a_ready(nxt);
            if constexpr (SP2) {
            PG8_LDB(B0, 0, 0); PG8_LDB(B1, 0, 1); PG8_SCHED; PG8_LDA(At, 0, 0); PG8_STAGE(PG8_SA(1, 1), a1 + hstep, voffA);
            PG8_WAIT_V(8); PG8_WAIT_L(0); PG8_BAR; PG8_MMA(0, 0, At, B0); PG8_MMA(0, 1, At, B1); PG8_BAR; PG8_SCHED;
            PG8_LDA(At, 0, 1); PG8_STAGE(PG8_SB(0, 0), b2, voffB); PG8_STAGE(PG8_SB(0, 1), b2 + hstepB, voffB); PG8_STAGE(PG8_SA(0, 0), a2, voffA);
            PG8_WAIT_V(8); PG8_WAIT_L(0); PG8_BAR; PG8_MMA(1, 0, At, B0); PG8_MMA(1, 1, At, B1); PG8_BAR; PG8_SCHED;
            PG8_LDB(B0, 1, 0); PG8_LDB(B1, 1, 1); PG8_SCHED; PG8_LDA(At, 1, 0); PG8_STAGE(PG8_SA(0, 1), a2 + hstep, voffA);
            PG8_WAIT_V(8); PG8_WAIT_L(0); PG8_BAR; PG8_MMA(0, 0, At, B0); PG8_MMA(0, 1, At, B1); PG8_BAR; PG8_SCHED;
            PG8_LDA(At, 1, 1); PG8_STAGE(PG8_SB(1, 0), b3, voffB); PG8_STAGE(PG8_SB(1, 1), b3 + hstepB, voffB); PG8_STAGE(PG8_SA(1, 0), a3, voffA);
            PG8_WAIT_V(8); PG8_WAIT_L(0); PG8_BAR; PG8_MMA(1, 0, At, B0); PG8_MMA(1, 1, At, B1); PG8_BAR; PG8_SCHED;
            } else {
            PG8_LDB(B0, 0, 0); PG8_SCHED; PG8_LDA(At, 0, 0); PG8_STAGE(PG8_SA(1, 1), a1 + hstep, voffA);
            PG8_WAIT_L(8); PG8_BAR; PG8_WAIT_L(0); PG8_MMA(0, 0, At, B0); PG8_BAR; PG8_SCHED;
            PG8_LDB(B1, 0, 1); PG8_STAGE(PG8_SB(0, 0), b2, voffB);
            PG8_BAR; PG8_WAIT_L(0); PG8_MMA(0, 1, At, B1); PG8_BAR;
            PG8_LDA(At, 0, 1); PG8_STAGE(PG8_SA(0, 0), a2, voffA);
            PG8_BAR; PG8_WAIT_L(0); PG8_MMA(1, 0, At, B0); PG8_BAR; PG8_SCHED;
            PG8_STAGE(PG8_SB(0, 1), b2 + hstepB, voffB);
            PG8_WAIT_V(6); PG8_BAR; PG8_MMA(1, 1, At, B1); PG8_BAR;
            PG8_LDB(B0, 1, 0); PG8_SCHED; PG8_LDA(At, 1, 0); PG8_STAGE(PG8_SA(0, 1), a2 + hstep, voffA);
            PG8_WAIT_L(8); PG8_BAR; PG8_WAIT_L(0); PG8_MMA(0, 0, At, B0); PG8_BAR; PG8_SCHED;
            PG8_LDB(B1, 1, 1); PG8_STAGE(PG8_SB(1, 0), b3, voffB);
            PG8_BAR; PG8_WAIT_L(0); PG8_MMA(0, 1, At, B1); PG8_BAR;
            PG8_LDA(At, 1, 1); PG8_STAGE(PG8_SA(1, 0), a3, voffA);
            PG8_BAR; PG8_WAIT_L(0); PG8_MMA(1, 0, At, B0); PG8_BAR; PG8_SCHED;
            PG8_STAGE(PG8_SB(1, 1), b3 + hstepB, voffB);
            PG8_WAIT_V(6); PG8_BAR; PG8_MMA(1, 1, At, B1); PG8_BAR;
            }
        }
        if constexpr (ALIGN_EPI) { if (wr == 0) PG8_BAR; }
        if constexpr (!Epi::AFTER_DRAIN) { E(acc, cur, wr, wc, fr, fq); S.done(cur); }
        if (!has_next) break;
#pragma unroll
        for (int a = 0; a < 2; ++a)
#pragma unroll
            for (int b = 0; b < 2; ++b)
#pragma unroll
                for (int m = 0; m < 4; ++m)
#pragma unroll
                    for (int n = 0; n < 2; ++n) acc[a][b][m][n] = (f32x4){0.f, 0.f, 0.f, 0.f};
        cur = nxt; cA = nA; cB = nB; ++ui;
        if constexpr (ALIGN_EPI) { if (wr == 1) PG8_BAR; }
    }
    PG8_WAIT_V(0);
    if constexpr (!ALIGN_EPI) { if (wr == 0) PG8_BAR; }
    PG8_BAR;
    if constexpr (Epi::AFTER_DRAIN) { E.fused(acc, cur, wr, wc, fr, fq, lds, wid, lane); S.done(cur); }
#undef PG8_SA
#undef PG8_SB
#undef PG8_STAGE
#undef PG8_LDA
#undef PG8_LDB
#undef PG8_MMA
#undef PG8_WAIT_V
#undef PG8_WAIT_L
#undef PG8_BAR
#undef PG8_SCHED
}
}

#ifndef PG8_SP2
#define PG8_SP2 true
#endif
#ifndef PG8_ALIGN
#define PG8_ALIGN true
#endif
#include <hip/hip_bf16.h>
#include <cmath>
namespace attn_body {
using bf16=__hip_bfloat16;
using bf16x8=__attribute__((ext_vector_type(8)))short;
using s16x4=__attribute__((ext_vector_type(4)))short;
using f32x16=__attribute__((ext_vector_type(16)))float;
using u32x4=__attribute__((ext_vector_type(4)))unsigned;
constexpr int BATCH=4,SEQ=4096,D=64,PIN=3072,POUT=1024;
constexpr int NW=8,QBLK=32,QB=QBLK*NW,KVBLK=64,NQB=SEQ/QB;
constexpr int ATTN_UNIT_ROWS=QB;
__device__ __forceinline__ int crow(int r,int hi){return (r&3)+8*(r>>2)+4*hi;}
#define SBAR() __builtin_amdgcn_sched_barrier(0)
__device__ __forceinline__ void cmask(f32x16&p0,f32x16&p1,int jb,int qrel,int hi){
  const float NEG=-INFINITY; int kb=64*jb+4*hi; asm volatile("":"+v"(kb));
  #pragma unroll
  for(int r=0;r<16;++r){int kv=kb+(r&3)+8*(r>>2); if(kv>qrel)p0[r]=NEG; if(kv+32>qrel)p1[r]=NEG;}
}

constexpr int NSLOT=3, SLOTB=8192;
constexpr int LDS_K=0, LDS_V=NSLOT*SLOTB, LDS_WS=3*NSLOT*SLOTB, LDS_OST=LDS_WS+NW*64*4, LDS_BYTES=LDS_OST+NW*4096;
constexpr float C2=0.125f*1.4426950408889634f;
__device__ __forceinline__ void glds16(const void*gsrc,unsigned lds_dst){unsigned keep;
  asm volatile("s_mov_b32 %0, m0\n\ts_mov_b32 m0, %2\n\ts_nop 0\n\tglobal_load_lds_dwordx4 %1, off\n\ts_mov_b32 m0, %0":"=&s"(keep):"v"(gsrc),"s"(lds_dst):"memory");}
__device__ __forceinline__ void glds16s(const void*sbase,unsigned voff,unsigned lds_dst){unsigned keep;
  asm volatile("s_mov_b32 %0, m0\n\ts_mov_b32 m0, %3\n\ts_nop 0\n\tglobal_load_lds_dwordx4 %1, %2\n\ts_mov_b32 m0, %0":"=&s"(keep):"v"(voff),"s"(sbase),"s"(lds_dst):"memory");}
__device__ __forceinline__ float max3f(float a,float b,float c){float r;asm("v_max3_f32 %0, %1, %2, %3":"=v"(r):"v"(a),"v"(b),"v"(c));return r;}
__device__ __forceinline__ float max2f(float a,float b){float r;asm("v_max_f32_e32 %0, %1, %2":"=v"(r):"v"(a),"v"(b));return r;}
__device__ __forceinline__ float fadd_s(float a,float b){float r;asm("v_add_f32_e32 %0, %1, %2":"=v"(r):"v"(a),"v"(b));return r;}
__device__ __forceinline__ float fsub_s(float a,float b){float r;asm("v_sub_f32_e32 %0, %1, %2":"=v"(r):"v"(a),"v"(b));return r;}
typedef float f32x2_t __attribute__((ext_vector_type(2))); typedef __bf16 bf16x2_t __attribute__((ext_vector_type(2)));
__device__ __forceinline__ unsigned cvtpk_s(float lo,float hi){f32x2_t v={lo,hi};bf16x2_t b=__builtin_convertvector(v,bf16x2_t);return __builtin_bit_cast(unsigned,b);}
#define WAIT_BAR(N) asm volatile("s_waitcnt vmcnt(" #N ") lgkmcnt(0)\n\ts_barrier":::"memory")

__device__ __forceinline__ void qkt(f32x16&p0,f32x16&p1,const char*Kslot,const bf16x8*qr,const f32x16&negm,int r32,int hi){
  const char*kb=Kslot+hi*1024+r32*16;
  #pragma unroll
  for(int d0=0;d0<4;++d0){
    const bf16x8 b0=*reinterpret_cast<const bf16x8*>(kb+d0*2048);
    const bf16x8 b1=*reinterpret_cast<const bf16x8*>(kb+d0*2048+512);
    if(d0==0){p0=__builtin_amdgcn_mfma_f32_32x32x16_bf16(b0,qr[0],negm,0,0,0);p1=__builtin_amdgcn_mfma_f32_32x32x16_bf16(b1,qr[0],negm,0,0,0);}
    else{p0=__builtin_amdgcn_mfma_f32_32x32x16_bf16(b0,qr[d0],p0,0,0,0);p1=__builtin_amdgcn_mfma_f32_32x32x16_bf16(b1,qr[d0],p1,0,0,0);}}
}
typedef __attribute__((address_space(3))) const char* lds_cptr;
typedef short v4i16_t __attribute__((ext_vector_type(4)));
__device__ __forceinline__ void kload8(bf16x8*kf,lds_cptr kp){
  kf[0]=*(const __attribute__((address_space(3))) bf16x8*)(kp);      kf[1]=*(const __attribute__((address_space(3))) bf16x8*)(kp+512);
  kf[2]=*(const __attribute__((address_space(3))) bf16x8*)(kp+2048); kf[3]=*(const __attribute__((address_space(3))) bf16x8*)(kp+2560);
  kf[4]=*(const __attribute__((address_space(3))) bf16x8*)(kp+4096); kf[5]=*(const __attribute__((address_space(3))) bf16x8*)(kp+4608);
  kf[6]=*(const __attribute__((address_space(3))) bf16x8*)(kp+6144); kf[7]=*(const __attribute__((address_space(3))) bf16x8*)(kp+6656);
}
__device__ __forceinline__ void kload2(bf16x8*kf,lds_cptr kp,int j){ kf[2*j]=*(const __attribute__((address_space(3))) bf16x8*)(kp+j*2048); kf[2*j+1]=*(const __attribute__((address_space(3))) bf16x8*)(kp+j*2048+512); }
__device__ __forceinline__ s16x4 vtr(lds_cptr p){ return __builtin_bit_cast(s16x4,__builtin_amdgcn_ds_read_tr16_b64_v4i16((__attribute__((address_space(3))) v4i16_t*)p)); }
__device__ __forceinline__ float rowmax(const f32x16&p0,const f32x16&p1){
  float a=max3f(p0[0],p0[1],p1[0]),b=max3f(p0[2],p0[3],p1[1]);a=max3f(a,p1[2],p1[3]);
  #pragma unroll
  for(int r=4;r<16;r+=4){a=max3f(a,p0[r],p0[r+1]);b=max3f(b,p0[r+2],p0[r+3]);a=max3f(a,p1[r],p1[r+1]);b=max3f(b,p1[r+2],p1[r+3]);}
  const float m=max2f(a,b);
  auto rr=__builtin_amdgcn_permlane32_swap(__float_as_uint(m),__float_as_uint(m),false,false);
  return max2f(__uint_as_float(rr[0]),__uint_as_float(rr[1]));
}
__device__ __forceinline__ void pv(f32x16*o,int vb,bf16x8 pa0,bf16x8 pa1,bf16x8 pa2,bf16x8 pa3){
  #pragma unroll
  for(int d0=0;d0<4;++d0){s16x4 lo[4],hi[4];
    #pragma unroll
    for(int ks=0;ks<4;++ks){
      asm volatile("ds_read_b64_tr_b16 %0,%1 offset:%c2":"=&v"(lo[ks]):"v"(vb),"i"(d0*4096+ks*1024):"memory");
      asm volatile("ds_read_b64_tr_b16 %0,%1 offset:%c2":"=&v"(hi[ks]):"v"(vb),"i"(d0*4096+ks*1024+512):"memory");}
    asm volatile("s_waitcnt lgkmcnt(0)":::"memory");SBAR();
    #define PK(k) (bf16x8){lo[k][0],lo[k][1],lo[k][2],lo[k][3],hi[k][0],hi[k][1],hi[k][2],hi[k][3]}
    o[d0]=__builtin_amdgcn_mfma_f32_32x32x16_bf16(pa0,PK(0),o[d0],0,0,0);
    o[d0]=__builtin_amdgcn_mfma_f32_32x32x16_bf16(pa1,PK(1),o[d0],0,0,0);
    o[d0]=__builtin_amdgcn_mfma_f32_32x32x16_bf16(pa2,PK(2),o[d0],0,0,0);
    o[d0]=__builtin_amdgcn_mfma_f32_32x32x16_bf16(pa3,PK(3),o[d0],0,0,0);
    #undef PK
  }
}

#ifndef ATTN_STORE16
#define ATTN_STORE16(p,v) (*(u32x4*)(p)=(v))
#endif
template<int THRL> __device__ __forceinline__ void attn_unit(int b,int qcol,int kcol,int vcol,int ocol,int qb,const bf16*Q,const bf16*__restrict__ K,const bf16*__restrict__ V,bf16*O,char*shm,const int tid){
  const int lane=tid&63,r32=lane&31,hi=lane>>5; const int wid=__builtin_amdgcn_readfirstlane(tid>>6);
  const long rowbase=(long)b*SEQ; const int q0=qb*QB;
  const bf16*Qw=Q+(rowbase+q0+wid*QBLK)*PIN+qcol;
  const bf16*Kh=K+rowbase*PIN+kcol,*Vh=V+rowbase*PIN+vcol;
  const unsigned lds0=(unsigned)(uintptr_t)shm;
  float*wsf=(float*)(shm+LDS_WS)+wid*64;
  const unsigned koff=(unsigned)(lane*PIN+wid*8)*2u;
  const unsigned voff=(unsigned)((16*(wid&3)+(lane>>2))*PIN+(wid>>2)*32+(lane&3)*8)*2u;
  const unsigned kdst=lds0+LDS_K+wid*1024, vdst=lds0+LDS_V+wid*1024;
  #define DMA_K(t,slot) glds16s(Kh+(long)(t)*KVBLK*PIN,koff,(unsigned)__builtin_amdgcn_readfirstlane(kdst+(slot)))
  #define DMA_V(t,slot) do{ glds16s(Vh+(long)(t)*KVBLK*PIN,voff,(unsigned)__builtin_amdgcn_readfirstlane(vdst+2*(slot))); glds16s(Vh+(long)(t)*KVBLK*PIN,voff+128u,(unsigned)__builtin_amdgcn_readfirstlane(vdst+8192+2*(slot))); }while(0)
  const int vb0=(int)(lds0+LDS_V)+((lane>>4)&1)*32+(lane&3)*8+(4*hi+((lane&15)>>2))*64;
  const char*Kbase=shm+LDS_K; bf16x8 kf[8];
  const lds_cptr shm3=(lds_cptr)shm; const lds_cptr kp0=shm3+LDS_K+hi*1024+r32*16; const lds_cptr vp0=shm3+LDS_V+((lane>>4)&1)*32+(lane&3)*8+(4*hi+((lane&15)>>2))*64;
  const int NT=(q0+QB)/KVBLK;
  DMA_K(0,0);DMA_V(0,0);DMA_K(1,SLOTB);
  bf16x8 qr[4];
  { int lq=lane; asm volatile("":"+v"(lq)); const int r32q=lq&31,hiq=lq>>5;
  _Pragma("unroll") for(int d0=0;d0<4;++d0)qr[d0]=*reinterpret_cast<const bf16x8*>(&Qw[(long)r32q*PIN+d0*16+hiq*8]); }
  const lds_cptr qst=shm3+LDS_OST+wid*4096+lane*16;
  #define QST(d0) (*(__attribute__((address_space(3))) bf16x8*)(qst+(d0)*1024))
  _Pragma("unroll") for(int d0=0;d0<4;++d0) *(__attribute__((address_space(3))) bf16x8*)((__attribute__((address_space(3))) char*)qst+d0*1024)=qr[d0];
  float mhat=0.f,l_reg=0.f;f32x16 o[4];o[0]=f32x16{};o[1]=f32x16{};o[2]=f32x16{};o[3]=f32x16{};float z0_=0.f;asm volatile("":"+v"(z0_));f32x16 negm;_Pragma("unroll") for(int r=0;r<16;++r)negm[r]=z0_;asm volatile("":"+v"(negm));
  const int qrel=wid*QBLK+r32;
  #define CMASK(P0,P1,t) do{int jb_=(t)-(NT-4); if(jb_>=0)cmask(P0,P1,jb_,qrel,hi);}while(0)
  bool resc=false;
  #define START(P0,P1) do{ const float rm=rowmax(P0,P1); resc=false; \
    { const float dl=rm; mhat=fadd_s(mhat,dl); \
      _Pragma("unroll") for(int r=0;r<16;++r){P0[r]=fsub_s(P0[r],dl);P1[r]=fsub_s(P1[r],dl);} \
      _Pragma("unroll") for(int r=0;r<16;++r)negm[r]=-mhat; asm volatile("":"+v"(negm)); } \
    _Pragma("unroll") for(int r=0;r<16;++r)P0[r]=__builtin_amdgcn_exp2f(P0[r]); }while(0)
  #define RESC() do{ if(resc){ asm volatile("s_waitcnt lgkmcnt(0)":::"memory"); \
      _Pragma("unroll") for(int d_=0;d_<4;++d_) _Pragma("unroll") for(int r=0;r<16;++r)o[d_][r]*=wsf[crow(r,hi)]; } }while(0)
  f32x16 pA0,pA1,pB0,pB1;
  int sl_prev=0,sl_cur=0,sl_next=SLOTB;
  #define ROT() do{sl_prev=sl_cur;sl_cur=sl_next;sl_next=(sl_next==(NSLOT-1)*SLOTB)?0:sl_next+SLOTB;}while(0)
  DMA_K(2,2*SLOTB);
  WAIT_BAR(3);
  qkt(pA0,pA1,Kbase,qr,negm,r32,hi);asm volatile("s_nop 15\n\ts_nop 7":"+v"(pA0),"+v"(pA1));CMASK(pA0,pA1,0);
  START(pA0,pA1);
  _Pragma("unroll") for(int r=0;r<16;++r)pA1[r]=__builtin_amdgcn_exp2f(pA1[r]);
  u32x4 pa0,pa1,pa2,pa3,pb0,pb1,pb2,pb3;
  { float s0_=pA0[0]+pA0[1]; _Pragma("unroll") for(int r=2;r<16;++r)s0_+=pA0[r]; _Pragma("unroll") for(int r=0;r<16;++r)s0_+=pA1[r]; l_reg+=s0_;
    pa0=(u32x4){cvtpk_s(pA0[0],pA0[1]),cvtpk_s(pA0[2],pA0[3]),cvtpk_s(pA0[4],pA0[5]),cvtpk_s(pA0[6],pA0[7])}; pa1=(u32x4){cvtpk_s(pA0[8],pA0[9]),cvtpk_s(pA0[10],pA0[11]),cvtpk_s(pA0[12],pA0[13]),cvtpk_s(pA0[14],pA0[15])};
    pa2=(u32x4){cvtpk_s(pA1[0],pA1[1]),cvtpk_s(pA1[2],pA1[3]),cvtpk_s(pA1[4],pA1[5]),cvtpk_s(pA1[6],pA1[7])}; pa3=(u32x4){cvtpk_s(pA1[8],pA1[9]),cvtpk_s(pA1[10],pA1[11]),cvtpk_s(pA1[12],pA1[13]),cvtpk_s(pA1[14],pA1[15])}; }
  WAIT_BAR(0);
  DMA_K(3,0);DMA_V(1,SLOTB);
  ROT();
  kload8(kf,kp0+sl_cur);
  WAIT_BAR(3);
  s16x4 vlo[4],vhi[4];
  #define PAFX(P) __builtin_bit_cast(bf16x8,P)
  #define VFRS(i) (bf16x8){vlo[i][0],vlo[i][1],vlo[i][2],vlo[i][3],vhi[i][0],vhi[i][1],vhi[i][2],vhi[i][3]}
  #define PIN(x) asm volatile("":"+v"(x))
  #define MX3(a,b,c) __builtin_fmaxf(__builtin_fmaxf((a),(b)),(c))
  #define EX(v) __builtin_amdgcn_exp2f(v)
  #define VRDF(s,id) do{ vlo[s]=vtr(vp_+(((id)>>2)*4096+((id)&3)*1024)); vhi[s]=vtr(vp_+(((id)>>2)*4096+((id)&3)*1024+512)); }while(0)
  #define GAPA(MF) do{ MF; SBAR(); }while(0)
  #define GAPAV(MF,s,id) do{ VRDF(s,id); SBAR(); MF; SBAR(); }while(0)
  #define GAPB(MF,X,B,PN,W,RD) do{ MF; X[B]=EX(X[B]); X[B+1]=EX(X[B+1]); PIN(X); sacc+=X[B]; sacc+=X[B+1]; PIN(sacc); PN[W]=cvtpk_s(X[B],X[B+1]); PIN(PN); RD; SBAR(); }while(0)
  #define KRD(G,j) do{ if(G){ kload2(kf,kp0+sl_next,j); SBAR(); } }while(0)
  #define STEP(C0,C1,PC0,PC1,PC2,PC3,PN0,PN1,PN2,PN3,t,GK,GV,GL) do{ SBAR(); \
    const lds_cptr vp_=vp0+2*sl_prev; \
    const bf16x8 q0_=QST(0),q1_=QST(1),q2_=QST(2),q3_=QST(3); SBAR(); \
    GAPA(C0=__builtin_amdgcn_mfma_f32_32x32x16_bf16(kf[0],q0_,negm,0,0,0)); \
    GAPA(C1=__builtin_amdgcn_mfma_f32_32x32x16_bf16(kf[1],q0_,negm,0,0,0)); \
    GAPA(C0=__builtin_amdgcn_mfma_f32_32x32x16_bf16(kf[2],q1_,C0,0,0,0)); \
    GAPA(C1=__builtin_amdgcn_mfma_f32_32x32x16_bf16(kf[3],q1_,C1,0,0,0)); \
    GAPAV(C0=__builtin_amdgcn_mfma_f32_32x32x16_bf16(kf[4],q2_,C0,0,0,0),0,0); \
    GAPAV(C1=__builtin_amdgcn_mfma_f32_32x32x16_bf16(kf[5],q2_,C1,0,0,0),1,4); \
    GAPAV(C0=__builtin_amdgcn_mfma_f32_32x32x16_bf16(kf[6],q3_,C0,0,0,0),2,1); \
    GAPAV(C1=__builtin_amdgcn_mfma_f32_32x32x16_bf16(kf[7],q3_,C1,0,0,0),3,5); \
    if(GK){DMA_K((t)+3,sl_cur);} if(GV){DMA_V((t)+1,sl_next);} \
    CMASK(C0,C1,t); \
    { float a=MX3(C0[0],C0[1],C1[0]),b=MX3(C0[2],C0[3],C1[1]); a=MX3(a,C1[2],C1[3]); \
      _Pragma("unroll") for(int r=4;r<16;r+=4){a=MX3(a,C0[r],C0[r+1]);b=MX3(b,C0[r+2],C0[r+3]);a=MX3(a,C1[r],C1[r+1]);b=MX3(b,C1[r+2],C1[r+3]);} \
      float rm=__builtin_fmaxf(a,b); { auto rr=__builtin_amdgcn_permlane32_swap(__float_as_uint(rm),__float_as_uint(rm),false,false); rm=__builtin_fmaxf(__uint_as_float(rr[0]),__uint_as_float(rr[1])); } \
      resc=false; \
      if(__builtin_expect(__any(rm>(float)THRL),0)){ const float dl=__builtin_fmaxf(rm,0.f); mhat+=dl; \
        _Pragma("unroll") for(int r=0;r<16;++r){C0[r]-=dl;C1[r]-=dl;} \
        _Pragma("unroll") for(int r=0;r<16;++r)negm[r]=-mhat; asm volatile("":"+v"(negm)); \
        const float f=__builtin_amdgcn_exp2f(-dl); l_reg*=f; if(hi==0)wsf[r32]=f; resc=true; } } \
    SBAR(); \
    float sacc=0.f; \
    GAPB(o[0]=__builtin_amdgcn_mfma_f32_32x32x16_bf16(PAFX(PC0),VFRS(0),o[0],0,0,0), C0,0,  PN0,0, VRDF(0,2)); \
    GAPB(o[1]=__builtin_amdgcn_mfma_f32_32x32x16_bf16(PAFX(PC0),VFRS(1),o[1],0,0,0), C0,2,  PN0,1, VRDF(1,6)); \
    KRD(GL,0); GAPB(o[0]=__builtin_amdgcn_mfma_f32_32x32x16_bf16(PAFX(PC1),VFRS(2),o[0],0,0,0), C0,4,  PN0,2, VRDF(2,3)); \
    KRD(GL,1); GAPB(o[1]=__builtin_amdgcn_mfma_f32_32x32x16_bf16(PAFX(PC1),VFRS(3),o[1],0,0,0), C0,6,  PN0,3, VRDF(3,7)); \
    KRD(GL,2); GAPB(o[0]=__builtin_amdgcn_mfma_f32_32x32x16_bf16(PAFX(PC2),VFRS(0),o[0],0,0,0), C0,8,  PN1,0, VRDF(0,8)); \
    KRD(GL,3); GAPB(o[1]=__builtin_amdgcn_mfma_f32_32x32x16_bf16(PAFX(PC2),VFRS(1),o[1],0,0,0), C0,10, PN1,1, VRDF(1,12)); \
    GAPB(o[0]=__builtin_amdgcn_mfma_f32_32x32x16_bf16(PAFX(PC3),VFRS(2),o[0],0,0,0), C0,12, PN1,2, VRDF(2,9)); \
    GAPB(o[1]=__builtin_amdgcn_mfma_f32_32x32x16_bf16(PAFX(PC3),VFRS(3),o[1],0,0,0), C0,14, PN1,3, VRDF(3,13)); \
    GAPB(o[2]=__builtin_amdgcn_mfma_f32_32x32x16_bf16(PAFX(PC0),VFRS(0),o[2],0,0,0), C1,0,  PN2,0, VRDF(0,10)); \
    GAPB(o[3]=__builtin_amdgcn_mfma_f32_32x32x16_bf16(PAFX(PC0),VFRS(1),o[3],0,0,0), C1,2,  PN2,1, VRDF(1,14)); \
    GAPB(o[2]=__builtin_amdgcn_mfma_f32_32x32x16_bf16(PAFX(PC1),VFRS(2),o[2],0,0,0), C1,4,  PN2,2, VRDF(2,11)); \
    GAPB(o[3]=__builtin_amdgcn_mfma_f32_32x32x16_bf16(PAFX(PC1),VFRS(3),o[3],0,0,0), C1,6,  PN2,3, VRDF(3,15)); \
    GAPB(o[2]=__builtin_amdgcn_mfma_f32_32x32x16_bf16(PAFX(PC2),VFRS(0),o[2],0,0,0), C1,8,  PN3,0, (void)0); \
    GAPB(o[3]=__builtin_amdgcn_mfma_f32_32x32x16_bf16(PAFX(PC2),VFRS(1),o[3],0,0,0), C1,10, PN3,1, (void)0); \
    GAPB(o[2]=__builtin_amdgcn_mfma_f32_32x32x16_bf16(PAFX(PC3),VFRS(2),o[2],0,0,0), C1,12, PN3,2, (void)0); \
    GAPB(o[3]=__builtin_amdgcn_mfma_f32_32x32x16_bf16(PAFX(PC3),VFRS(3),o[3],0,0,0), C1,14, PN3,3, (void)0); \
    l_reg+=sacc; \
    }while(0)
  #define STEP_AB(C0,C1,t,GK,GV,GL) STEP(C0,C1,pa0,pa1,pa2,pa3,pb0,pb1,pb2,pb3,t,GK,GV,GL)
  #define STEP_BA(C0,C1,t,GK,GV,GL) STEP(C0,C1,pb0,pb1,pb2,pb3,pa0,pa1,pa2,pa3,t,GK,GV,GL)
  int t=1;
  #undef CMASK
  #define CMASK(P0,P1,t) do{}while(0)
  for(;t+5<NT;t+=2){
    STEP_AB(pB0,pB1,t,true,true,true);     WAIT_BAR(3); RESC(); ROT();
    STEP_BA(pA0,pA1,t+1,true,true,true);   WAIT_BAR(3); RESC(); ROT();
  }
  #undef CMASK
  #define CMASK(P0,P1,t) do{int jb_=(t)-(NT-4); if(jb_>=0)cmask(P0,P1,jb_,qrel,hi);}while(0)
  #define ENDW(tt) do{ if((tt)+3<NT){WAIT_BAR(3);} else if((tt)+2<NT){WAIT_BAR(2);} else {WAIT_BAR(0);} }while(0)
  for(;t+1<NT;t+=2){
    STEP_AB(pB0,pB1,t,(t+3<NT),(t+1<NT),(t+1<NT));       ENDW(t);   RESC(); ROT();
    STEP_BA(pA0,pA1,t+1,(t+4<NT),(t+2<NT),(t+2<NT));     ENDW(t+1); RESC(); ROT();
  }
  STEP_AB(pB0,pB1,NT-1,false,false,false); RESC();
  { SBAR(); pv(o,vb0+2*sl_cur,PAFX(pb0),PAFX(pb1),PAFX(pb2),PAFX(pb3)); }
  #undef QST
  #undef PAFX
  #undef VFRS
  #undef PIN
  #undef MX3
  #undef GAPA
  #undef GAPAV
  #undef GAPB
  #undef EX
  #undef VRDF
  #undef KRD
  #undef STEP
  #undef STEP_AB
  #undef STEP_BA
  #undef ENDW
  {auto rr=__builtin_amdgcn_permlane32_swap(__float_as_uint(l_reg),__float_as_uint(l_reg),false,false);l_reg=__uint_as_float(rr[0])+__uint_as_float(rr[1]);}
  { int le=lane; asm volatile("":"+v"(le)); const int r32e=le&31,hie=le>>5;
  if(hie==0)wsf[32+r32e]=l_reg;asm volatile("s_waitcnt lgkmcnt(0)":::"memory");
  float rli[16];
  #pragma unroll
  for(int r=0;r<16;++r)rli[r]=__builtin_amdgcn_rcpf(wsf[32+crow(r,hie)]);
  bf16*Ow=O+(rowbase+q0+wid*QBLK)*POUT+ocol;
  { bf16*stg=(bf16*)(shm+LDS_OST)+wid*2048;
    #pragma unroll
    for(int hf=0;hf<2;++hf){
    #pragma unroll
    for(int r=0;r<16;++r){const int orow=crow(r,hie);
      #pragma unroll
      for(int d0=0;d0<2;++d0)stg[orow*64+d0*32+r32e]=__float2bfloat16(o[2*hf+d0][r]*rli[r]);}
    asm volatile("s_waitcnt lgkmcnt(0)":::"memory");
    #pragma unroll
    for(int i=0;i<4;++i){const int row=i*8+(le>>3),ch=le&7; const u32x4 v=*(const u32x4*)(stg+row*64+ch*8); ATTN_STORE16(Ow+(long)row*POUT+hf*64+ch*8,v);}
    asm volatile("s_waitcnt lgkmcnt(0)":::"memory"); } } }
  asm volatile("s_waitcnt lgkmcnt(0)\n\ts_barrier":::"memory");
  #undef DMA_K
  #undef DMA_V
  #undef CMASK
  #undef START
  #undef RESC
  #undef ROT
}
constexpr int ATTN_LDS_BYTES=LDS_BYTES;
struct AttnUnit { int bh; int qb; };
struct StaticOrder {
  int vcu;
  __device__ __forceinline__ explicit StaticOrder(int v):vcu(v){}
  __device__ __forceinline__ bool next(int i,AttnUnit&u)const{ if(i>=2)return false; const int s=vcu&7; u.bh=vcu>>3; u.qb=(i==0)?s:15-s; return true; }
};
template<class Sched,int THRL=8> __device__ __forceinline__ void attn_phase(char*lds,const bf16*P,bf16*O,const Sched&S,const int tid){
  AttnUnit u;
  for(int i=0;S.next(i,u);++i){ const int b=u.bh>>3, h=(u.bh>>1)&3, m=u.bh&1;
    attn_unit<THRL>(b, h*128+m*64, 512+h*128+m*64, 1024+h*128, m*512+h*128, u.qb, P, P, P, O, lds, tid); }
}
#undef SBAR
#undef WAIT_BAR
}
#define GAS __attribute__((address_space(1)))
#define LAS __attribute__((address_space(3)))
typedef unsigned short bf16;
typedef unsigned v4u __attribute__((ext_vector_type(4)));
typedef float f32x4 __attribute__((ext_vector_type(4)));
typedef short bf16x8 __attribute__((ext_vector_type(8)));
typedef GAS unsigned gu32;
typedef GAS unsigned long long gu64;
#define RLX_AGENT __ATOMIC_RELAXED, __HIP_MEMORY_SCOPE_AGENT
#define LDS_WAIT() asm volatile("s_waitcnt lgkmcnt(0)" ::: "memory")
#define VM_WAIT() asm volatile("s_waitcnt vmcnt(0)" ::: "memory")
__device__ __forceinline__ unsigned long long rt() { return __builtin_amdgcn_s_memrealtime(); }
__device__ __forceinline__ unsigned f2bf(float f) { unsigned u = __builtin_bit_cast(unsigned, f); return (u + 0x7fffu + ((u >> 16) & 1u)) >> 16; }
__device__ __forceinline__ unsigned pk2(float lo, float hi) { return f2bf(lo) | (f2bf(hi) << 16); }

#define XB_TMO      128
#define XB_XCNT(j)  (256  + 64 * (j))
#define XB_XSUB(j)  (1280 + 64 * (j))
#define XB_XGEN(j)  (2304 + 64 * (j))
#define XB_TOP      3328
#define XB_TOPGEN   3392
#define XCD_BAR_WORDS 3456
#define XB_SPIN_CAP (1u << 22)

__device__ __forceinline__ unsigned xb_ld(unsigned* p)              { return __hip_atomic_load(p, __ATOMIC_RELAXED, __HIP_MEMORY_SCOPE_AGENT); }
__device__ __forceinline__ unsigned xb_add(unsigned* p, unsigned v) { return __hip_atomic_fetch_add(p, v, __ATOMIC_RELAXED, __HIP_MEMORY_SCOPE_AGENT); }
__device__ __forceinline__ unsigned xb_xcc_id() { return (unsigned)__builtin_amdgcn_s_getreg((3 << 11) | 20) & 0xFu; }
#define XB_SPIN(cond, bar) do { unsigned _sp = 0; while (cond) { __builtin_amdgcn_s_sleep(1); \
    if ((++_sp & 255u) == 0u) { if (xb_ld(&(bar)[XB_TMO])) break; if (_sp > XB_SPIN_CAP) { atomicAdd(&(bar)[XB_TMO], 1u); break; } } } } while (0)

struct XcdBarrier {
    unsigned* bar; unsigned x;
    volatile LAS unsigned* st;
};

__device__ __forceinline__ XcdBarrier xcd_barrier_post(unsigned* bar, volatile LAS unsigned* st) {
    XcdBarrier b; b.bar = bar; b.x = xb_xcc_id(); b.st = st;
    if (threadIdx.x == 0) (void)xb_add(&bar[XB_XCNT(b.x)], 1u);
    return b;
}
__device__ __forceinline__ void xcd_barrier_complete(unsigned* bar, unsigned x, unsigned& nloc, unsigned& nx) {
    const unsigned G = gridDim.x * gridDim.y * gridDim.z;
    unsigned sum, cnt, mine, sp = 0u;
    for (;;) {
        sum = 0u; cnt = 0u; mine = 0u;
#pragma unroll
        for (unsigned j = 0; j < 16; ++j) { const unsigned c = xb_ld(&bar[XB_XCNT(j)]); sum += c; cnt += (c > 0u) ? 1u : 0u; mine = (j == x) ? c : mine; }
        if (sum == G) break;
        __builtin_amdgcn_s_sleep(1);
        if ((++sp & 255u) == 0u) { if (xb_ld(&bar[XB_TMO])) break; if (sp > XB_SPIN_CAP) { atomicAdd(&bar[XB_TMO], 1u); break; } }
    }
    nloc = mine > 0u ? mine : 1u; nx = cnt > 0u ? cnt : 1u;
}

__device__ __forceinline__ void xcd_barrier(const XcdBarrier& b, const bool leader  ) {
    asm volatile("s_waitcnt vmcnt(0)" ::: "memory");
    __syncthreads();
    if (leader) {
        unsigned* bar = b.bar;
        __builtin_amdgcn_s_waitcnt(0);
        unsigned nloc = b.st[0], nx = b.st[1];
        if (nloc == 0u) { xcd_barrier_complete(bar, b.x, nloc, nx); b.st[0] = nloc; b.st[1] = nx; }
        const unsigned old = xb_add(&bar[XB_XSUB(b.x)], 1u);
        const unsigned gen = old / nloc;
        if (old + 1u == (gen + 1u) * nloc) {
            __builtin_amdgcn_fence(__ATOMIC_RELEASE, "agent");
            asm volatile("s_waitcnt vmcnt(0)" ::: "memory");
            const unsigned og = xb_add(&bar[XB_TOP], 1u);
            const unsigned tg = og / nx;
            if (og + 1u == (tg + 1u) * nx) xb_add(&bar[XB_TOPGEN], 1u);
            else XB_SPIN(xb_ld(&bar[XB_TOPGEN]) == tg, bar);
            __builtin_amdgcn_fence(__ATOMIC_ACQUIRE, "agent");
            xb_add(&bar[XB_XGEN(b.x)], 1u);
            asm volatile("s_waitcnt vmcnt(0)" ::: "memory");
        } else {
            XB_SPIN(xb_ld(&bar[XB_XGEN(b.x)]) == gen, bar);
            __builtin_amdgcn_fence(__ATOMIC_ACQUIRE, "agent");
            asm volatile("s_waitcnt vmcnt(0)" ::: "memory");
        }
    }
    __syncthreads();
}

template <class W> __device__ __forceinline__ void xcd_barrier_w(const XcdBarrier& b, const bool leader  , W work) {
    asm volatile("s_waitcnt vmcnt(0)" ::: "memory");
    __syncthreads();
    if (leader) {
        unsigned* bar = b.bar;
        __builtin_amdgcn_s_waitcnt(0);
        unsigned nloc = b.st[0], nx = b.st[1];
        if (nloc == 0u) { xcd_barrier_complete(bar, b.x, nloc, nx); b.st[0] = nloc; b.st[1] = nx; }
        const unsigned old = xb_add(&bar[XB_XSUB(b.x)], 1u);
        const unsigned gen = old / nloc;
        if (old + 1u == (gen + 1u) * nloc) {
            __builtin_amdgcn_fence(__ATOMIC_RELEASE, "agent");
            asm volatile("s_waitcnt vmcnt(0)" ::: "memory");
            const unsigned og = xb_add(&bar[XB_TOP], 1u);
            const unsigned tg = og / nx;
            if (og + 1u == (tg + 1u) * nx) xb_add(&bar[XB_TOPGEN], 1u);
            else XB_SPIN(xb_ld(&bar[XB_TOPGEN]) == tg, bar);
            __builtin_amdgcn_fence(__ATOMIC_ACQUIRE, "agent");
            xb_add(&bar[XB_XGEN(b.x)], 1u);
            asm volatile("s_waitcnt vmcnt(0)" ::: "memory");
        } else {
            XB_SPIN(xb_ld(&bar[XB_XGEN(b.x)]) == gen, bar);
            __builtin_amdgcn_fence(__ATOMIC_ACQUIRE, "agent");
            asm volatile("s_waitcnt vmcnt(0)" ::: "memory");
        }
    }
    work();
    __syncthreads();
}

constexpr int NWAVES = 8;
constexpr int M = 16384, DM = 1024, SEQL = 4096, NPROJ = 3072, NIN = 3088, NQ = 2048, NLAYER = 2;
constexpr int C_Q = 0, C_K = 512, C_V = 1024, C_SB = 1536, C_SC = 1792, C_SH = 2048, C_GQ = 2304, C_GK = 2432, C_GV = 2560, C_GR = 2816;
constexpr float EPS = 1e-6f;
constexpr float ATT_C2 = 0.125f * 1.4426950408889634f;

constexpr size_t MiB = 1u << 20;
constexpr size_t WS_CTL = 0, CTL_ZERO_BYTES = 1 * MiB;
constexpr size_t WS_WIN = 1 * MiB, WIN_STRIDE = 7 * MiB;
constexpr size_t WS_WOUT = 15 * MiB, WOUT_STRIDE = 2 * MiB;
constexpr size_t WS_WQ = 19 * MiB, WQ_STRIDE = 4 * MiB;
constexpr size_t WS_KEYS = 27 * MiB, KEYS_STRIDE = 65536;
constexpr size_t WS_COS = 28 * MiB, WS_SIN = 28 * MiB + 512 * 1024;
constexpr size_t WS_SSQ = 29 * MiB;
constexpr size_t WS_GD = 30 * MiB;
constexpr size_t WS_LAM = 30 * MiB + 512 * 1024;
constexpr size_t WS_PAR = 30 * MiB + 768 * 1024;
constexpr int PAR_DN = 0, PAR_CW = 256, PAR_WG2 = 1792, PAR_BG = 5888, PAR_GN = 6144, PAR_NF = 6272, PAR_N = 7296;
constexpr size_t WS_GU = 31 * MiB;
constexpr size_t WS_GB = 39 * MiB;
constexpr size_t WS_EXP = 47 * MiB;
constexpr size_t WS_GATE = 55 * MiB;
constexpr size_t WS_TAB = 64 * MiB, TAB_STRIDE = 32 * MiB;
constexpr size_t WS_SU = 56 * MiB + 512 * 1024 * 0 + 7 * MiB, WS_SV = WS_SU + 256 * 1024;
constexpr size_t WS_RS1 = 63 * MiB + 512 * 1024;
constexpr size_t WS_XB = 192 * MiB;
constexpr size_t WS_PROJ = 224 * MiB;
constexpr size_t WS_OATT = 320 * MiB;
constexpr size_t WS_MIXED = 352 * MiB;
constexpr size_t WS_QP = 384 * MiB;
constexpr size_t WS_END = 448 * MiB;
constexpr int CW_TMO = 0, CW_BAR = 4096;

constexpr int RING_OFF = 0, RING_BYTES = 131072;
constexpr int LDSCTL_OFF = RING_BYTES, MISC_OFF = LDSCTL_OFF + 320;
constexpr int LDS_BYTES = 147456;

struct Frame {
    LAS unsigned char* lds;
    volatile LAS unsigned* MISC;
    int tid, lane, wave;
    int vcu, G, bx;
    float* out; unsigned char* ws;
};
__device__ __forceinline__ float wave_sum(float v) { return xl_wave_sum(v); }
__device__ __forceinline__ float bflo(unsigned w) { return __builtin_bit_cast(float, w << 16); }
__device__ __forceinline__ float bfhi(unsigned w) { return __builtin_bit_cast(float, w & 0xffff0000u); }
__device__ __forceinline__ float bf1(bf16 h) { return __builtin_bit_cast(float, (unsigned)h << 16); }

__device__ __forceinline__ void p0_transpose_item(const float* W, int ldw, int N, const float* gain, bf16* WT, int K, LAS float* scr, int item, int lane) {
    const int nblk = (N + 31) / 32, kb = item / nblk, nb = item % nblk, k0 = 64 * kb, n0 = 32 * nb;
    const int nn = n0 + (lane & 31);
    float wv[32];
#pragma unroll
    for (int i = 0; i < 32; ++i) { const int kk = 2 * i + (lane >> 5); wv[i] = (nn < N) ? W[(size_t)(k0 + kk) * ldw + nn] : 0.f; }
#pragma unroll
    for (int i = 0; i < 32; ++i) { const int kk = 2 * i + (lane >> 5); float w = wv[i]; if (gain) w *= gain[k0 + kk]; scr[kk * 33 + (lane & 31)] = w; }
    LDS_WAIT(); asm volatile("" ::: "memory");
    const int c = lane & 7;
#pragma unroll
    for (int j = 0; j < 4; ++j) { const int n = (lane >> 3) + 8 * j; const LAS float* s = scr + (8 * c) * 33 + n;
        v4u o; o.x = pk2(s[0 * 33], s[1 * 33]); o.y = pk2(s[2 * 33], s[3 * 33]); o.z = pk2(s[4 * 33], s[5 * 33]); o.w = pk2(s[6 * 33], s[7 * 33]);
        if (n0 + n < N) *(GAS v4u*)(WT + (size_t)(n0 + n) * K + k0 + 8 * c) = o; }
    LDS_WAIT(); asm volatile("" ::: "memory");
}
struct Args;
constexpr int TBL_SEAM_ROWS = 256 * 7 * 2;
constexpr int TBL_L0_HID = 6 * TBL_SEAM_ROWS, TBL_L1_HID = 2 * 16384;
template <int NR, class A> __device__ __forceinline__ void p0_tables_rows(Frame& F, const A& args, int row0, int step, int limit) {
        f32x4 v[NR][4]; float mx[NR]; _Pragma("unroll") for (int u = 0; u < NR; ++u) mx[u] = 0.f;
#pragma unroll
        for (int u = 0; u < NR; ++u) { const int row = (row0 + u * step < limit) ? row0 + u * step : row0; const int l = row >> 15, tab = (row >> 14) & 1, e = row & 16383;
            const f32x4* src = (const f32x4*)((tab ? args.in[19] : args.in[18]) + (size_t)l * 16777216 + (size_t)e * DM) + F.lane;
#pragma unroll
            for (int j = 0; j < 4; ++j) v[u][j] = __builtin_nontemporal_load(src + 64 * j); }
#pragma unroll
        for (int u = 0; u < NR; ++u) { const int row = row0 + u * step; const int l = row >> 15, tab = (row >> 14) & 1, e = row & 16383;
            if (row < limit) {
#pragma unroll
            for (int j = 0; j < 4; ++j) { if (tab == 0) v[u][j] = v[u][j] * ((const f32x4*)(args.in[14] + l * DM))[F.lane + 64 * j];
                mx[u] = fmaxf(mx[u], fmaxf(fmaxf(fabsf(v[u][j][0]), fabsf(v[u][j][1])), fmaxf(fabsf(v[u][j][2]), fabsf(v[u][j][3])))); }
            float m_ = mx[u];
            m_ = fmaxf(m_, xl_swz<1>(m_)); m_ = fmaxf(m_, xl_swz<2>(m_)); m_ = fmaxf(m_, xl_swz<4>(m_)); m_ = fmaxf(m_, xl_swz<8>(m_)); m_ = fmaxf(m_, xl_swz<16>(m_));
            m_ = fmaxf(m_, __builtin_bit_cast(float, xl_xor32_i(__builtin_bit_cast(int, m_), F.lane >> 5)));
            unsigned* dst = (unsigned*)(F.ws + WS_TAB + l * TAB_STRIDE + (size_t)e * 2048 + (tab ? 1024 : 0)) + F.lane;
            if (tab) {
                int k = (int)floorf(log2f(224.0f / fmaxf(m_, 1e-30f))); k = k < -60 ? -60 : (k > 60 ? 60 : k);
                const float sc = ldexpf(1.0f, k);
#pragma unroll
                for (int j = 0; j < 4; ++j) { int p = __builtin_amdgcn_cvt_pk_fp8_f32(v[u][j][0] * sc, v[u][j][1] * sc, 0, false); p = __builtin_amdgcn_cvt_pk_fp8_f32(v[u][j][2] * sc, v[u][j][3] * sc, p, true); __builtin_nontemporal_store((unsigned)p, dst + 64 * j); }
                if (F.lane == 0) ((float*)(F.ws + WS_SV))[l * 16384 + e] = ldexpf(1.0f, -k);
            } else {
                const float sc = m_ > 0.f ? 127.0f / m_ : 0.f;
#pragma unroll
                for (int j = 0; j < 4; ++j) { const int q0 = (int)rintf(v[u][j][0] * sc), q1 = (int)rintf(v[u][j][1] * sc), q2 = (int)rintf(v[u][j][2] * sc), q3 = (int)rintf(v[u][j][3] * sc);
                    __builtin_nontemporal_store((unsigned)(q0 & 255) | ((unsigned)(q1 & 255) << 8) | ((unsigned)(q2 & 255) << 16) | ((unsigned)(q3 & 255) << 24), dst + 64 * j); }
                if (F.lane == 0) ((float*)(F.ws + WS_SU))[l * 16384 + e] = m_ * (1.0f / 127.0f);
            } } }
}
template <class A> __device__ __forceinline__ void p0_prologue(Frame& F, const A& args) {
    const float* const* in_ = nullptr; (void)in_;
    LAS float* scr = (LAS float*)(F.lds + RING_OFF + F.wave * 16384);
    const int gw = F.vcu * NWAVES + F.wave, NGW = F.G * NWAVES;
    const int gt = F.vcu * (NWAVES * 64) + F.tid, NGT = F.G * NWAVES * 64;
    constexpr int I_IN = 16 * 97, I_OUT = 16 * 32, I_Q = 16 * 64, I_L = I_IN + I_OUT + I_Q;
    for (int it = gw; it < NLAYER * I_L; it += NGW) {
        const int l = it / I_L; int r = it % I_L;
        if (r < I_IN) { p0_transpose_item(args.in[3] + (size_t)l * DM * NIN, NIN, NIN, args.in[2] + l * DM, (bf16*)(F.ws + WS_WIN + l * WIN_STRIDE), DM, scr, r, F.lane); continue; } r -= I_IN;
        if (r < I_OUT) { p0_transpose_item(args.in[13] + (size_t)l * DM * DM, DM, DM, nullptr, (bf16*)(F.ws + WS_WOUT + l * WOUT_STRIDE), DM, scr, r, F.lane); continue; } r -= I_OUT;
        p0_transpose_item(args.in[15] + (size_t)l * DM * NQ, NQ, NQ, args.in[14] + l * DM, (bf16*)(F.ws + WS_WQ + l * WQ_STRIDE), DM, scr, r, F.lane);
    }
    for (int i = gt; i < NLAYER * 2 * 16384; i += NGT) { const int l = i >> 15, hf = (i >> 14) & 1, e = i & 16383;
        ((bf16*)(F.ws + WS_KEYS + l * KEYS_STRIDE))[hf * 16384 + e] = (bf16)f2bf((hf ? args.in[17] : args.in[16])[(size_t)l * 16384 + e]); }
    for (int row0 = TBL_L0_HID + gw; row0 < 2 * 16384; row0 += 4 * NGW) p0_tables_rows<4>(F, args, row0, NGW, 2 * 16384);
    for (int row0 = 2 * 16384 + TBL_L1_HID + gw; row0 < 4 * 16384; row0 += 4 * NGW) p0_tables_rows<4>(F, args, row0, NGW, 4 * 16384);
    for (int m0 = gw; m0 < M; m0 += 4 * NGW) {
        f32x4 v[4][4];
#pragma unroll
        for (int u = 0; u < 4; ++u) { const int m = m0 + u * NGW; const f32x4* xr = (const f32x4*)(args.in[0] + (size_t)(m < M ? m : m0) * DM) + F.lane;
#pragma unroll
            for (int j = 0; j < 4; ++j) v[u][j] = __builtin_nontemporal_load(xr + 64 * j); }
#pragma unroll
        for (int u = 0; u < 4; ++u) { const int m = m0 + u * NGW; if (m < M) {
            unsigned long long* o8 = (unsigned long long*)((bf16*)(F.ws + WS_XB) + (size_t)m * DM) + F.lane; float s = 0.f;
#pragma unroll
            for (int j = 0; j < 4; ++j) { const f32x4 w = v[u][j]; s += (w[0] * w[0] + w[1] * w[1]) + (w[2] * w[2] + w[3] * w[3]);
                o8[64 * j] = (unsigned long long)pk2(w[0], w[1]) | ((unsigned long long)pk2(w[2], w[3]) << 32); }
            s = wave_sum(s);
            if (F.lane == 0) ((float*)(F.ws + WS_RS1))[m] = __builtin_amdgcn_rsqf(s * (1.0f / 1024.0f) + EPS); } }
    }
    for (int i = gt; i < M * 8; i += NGT) { const int m = i >> 3, j = i & 7; const double inv = pow(500000.0, -(double)j / 8.0); const double ang = (double)((const int*)args.in[1])[m] * inv;
        ((float*)(F.ws + WS_COS))[i] = (float)cos(ang); ((float*)(F.ws + WS_SIN))[i] = (float)sin(ang); }
    if (gt < NLAYER) { const int l = gt; float a = 0.f, b = 0.f;
        for (int i = 0; i < 64; ++i) { a += args.in[4][l * 64 + i] * args.in[5][l * 64 + i]; b += args.in[6][l * 64 + i] * args.in[7][l * 64 + i]; }
        const float lam_init = 0.8f - 0.6f * expf(-0.3f * (float)l);
        ((float*)(F.ws + WS_LAM))[l * 2] = expf(a) - expf(b) + lam_init; ((float*)(F.ws + WS_LAM))[l * 2 + 1] = 1.0f - lam_init; }
    { float* par = (float*)(F.ws + WS_PAR);
      for (int i = gt; i < PAR_N; i += NGT) { float v;
          if (i < PAR_CW) v = args.in[8][i]; else if (i < PAR_WG2) v = args.in[9][i - PAR_CW]; else if (i < PAR_BG) v = args.in[10][i - PAR_WG2]; else if (i < PAR_GN) v = args.in[11][i - PAR_BG];
          else if (i < PAR_NF) v = args.in[12][i - PAR_GN]; else v = args.in[20][i - PAR_NF];
          par[i] = v; } }
}

__device__ __forceinline__ float log_sigmoid(float x) { return fminf(x, 0.f) - __logf(1.0f + __expf(-fabsf(x))); }
template <int K> __device__ __forceinline__ void lds_mm_2x4(float (&acc)[2][4], const LAS float* X, int ldx, const LAS float* Y, int ldy) {
#pragma unroll 4
    for (int k = 0; k < K; k += 4) {
        const f32x4 x0 = *(const LAS f32x4*)(X + k), x1 = *(const LAS f32x4*)(X + ldx + k);
#pragma unroll
        for (int kk = 0; kk < 4; ++kk) { const f32x4 y = *(const LAS f32x4*)(Y + (k + kk) * ldy);
#pragma unroll
            for (int b = 0; b < 4; ++b) { acc[0][b] += x0[kk] * y[b]; acc[1][b] += x1[kk] * y[b]; } }
    }
}
typedef float f32x16g __attribute__((ext_vector_type(16)));
__device__ __forceinline__ int gla_crow(int r, int hh) { return (r & 3) + 8 * (r >> 2) + 4 * hh; }
__device__ __forceinline__ void gla_stage_vt(LAS bf16* VT, const bf16* PROJ, int t0, int tid) {
#pragma unroll
    for (int it = tid; it < 2048; it += 512) { const int eg = it >> 6, t = it & 63; const v4u w = *(const v4u*)(PROJ + (size_t)(t0 + t) * NPROJ + C_GV + eg * 8);
        LAS bf16* p = VT + (eg * 8) * 72 + t;
        p[0] = (bf16)(w.x & 0xffffu); p[72] = (bf16)(w.x >> 16); p[144] = (bf16)(w.y & 0xffffu); p[216] = (bf16)(w.y >> 16);
        p[288] = (bf16)(w.z & 0xffffu); p[360] = (bf16)(w.z >> 16); p[432] = (bf16)(w.w & 0xffffu); p[504] = (bf16)(w.w >> 16); }
}
__device__ __forceinline__ void gla_prep(Frame& F, int l, int ci, int stop_after = 0) {
    typedef float f32x4m __attribute__((ext_vector_type(4)));
    LAS float* LR = (LAS float*)(F.lds + RING_OFF);
    LAS bf16* KHT = (LAS bf16*)(LR + 2 * 64 * 17);
    LAS bf16* VT = KHT + 128 * 72;
    LAS float* W2s = (LAS float*)(VT + 256 * 72);
    const int t0 = ci * 64, tid = F.tid, lane = F.lane, wave = F.wave, r32 = lane & 31, hh = lane >> 5;
    const bf16* XB = (const bf16*)(F.ws + WS_XB); const bf16* PROJ = (const bf16*)(F.ws + WS_PROJ);
    const bf16* Wlr = (const bf16*)(F.ws + WS_WIN + l * WIN_STRIDE) + (size_t)NPROJ * DM;
    v4u kw0, kw1; float rs;
    {
        const int mt = wave & 3, kh = wave >> 2, fr = lane & 15, fq = lane >> 4;
        f32x4m acc = (f32x4m){0.f, 0.f, 0.f, 0.f};
        const bf16* ap = XB + (size_t)(t0 + mt * 16 + fr) * DM + kh * 512 + fq * 8; const bf16* bp = Wlr + (size_t)fr * DM + kh * 512 + fq * 8;
        bf16x8 av[16], bv[16];
#pragma unroll
        for (int ks = 0; ks < 16; ++ks) { av[ks] = *(const bf16x8*)(ap + ks * 32); bv[ks] = *(const bf16x8*)(bp + ks * 32); }
        gla_stage_vt(VT, PROJ, t0, tid);
        { const float* W2g = (const float*)(F.ws + WS_PAR) + PAR_WG2 + l * 16 * 128; const float* bgg = (const float*)(F.ws + WS_PAR) + PAR_BG + l * 128;
#pragma unroll
          for (int q = 0; q < 4; ++q) W2s[tid + 512 * q] = W2g[tid + 512 * q];
          if (tid < 128) W2s[2048 + tid] = bgg[tid]; }
        { const bf16* kp = PROJ + (size_t)(t0 + lane) * NPROJ + C_GK + 16 * wave; kw0 = *(const v4u*)kp; kw1 = *(const v4u*)(kp + 8); rs = ((const float*)(F.ws + WS_RS1))[t0 + lane]; }
#pragma unroll
        for (int ks = 0; ks < 16; ++ks) acc = __builtin_amdgcn_mfma_f32_16x16x32_bf16(av[ks], bv[ks], acc, 0, 0, 0);
#pragma unroll
        for (int i = 0; i < 4; ++i) LR[kh * (64 * 17) + (mt * 16 + fq * 4 + i) * 17 + fr] = acc[i];
    }
    __syncthreads();
    if (stop_after == 1) return;
    {
        const int d0 = 16 * wave, t = lane;
        float lr[16];
#pragma unroll
        for (int r = 0; r < 16; ++r) lr[r] = (LR[t * 17 + r] + LR[64 * 17 + t * 17 + r]) * rs;
        const LAS float* W2 = W2s + d0; const LAS float* bg = W2s + 2048 + d0;
        float bb[16];
#pragma unroll
        for (int dd = 0; dd < 16; ++dd) { float x = bg[dd];
#pragma unroll
            for (int r = 0; r < 16; ++r) x += lr[r] * W2[r * 128 + dd];
            bb[dd] = log_sigmoid(x) * (1.0f / 16.0f); }
#pragma unroll
        for (int off = 1; off < 64; off <<= 1) { const int src = ((lane - off) & 63) << 2;
#pragma unroll
            for (int dd = 0; dd < 16; ++dd) { const float o = __builtin_bit_cast(float, __builtin_amdgcn_ds_bpermute(src, __builtin_bit_cast(int, bb[dd]))); bb[dd] += (lane >= off) ? o : 0.f; } }
        float* GB = (float*)(F.ws + WS_GB) + (size_t)(t0 + t) * 128 + d0;
#pragma unroll
        for (int q = 0; q < 4; ++q) *(f32x4*)(GB + 4 * q) = (f32x4){bb[4 * q], bb[4 * q + 1], bb[4 * q + 2], bb[4 * q + 3]};
        const unsigned kw[8] = {kw0.x, kw0.y, kw0.z, kw0.w, kw1.x, kw1.y, kw1.z, kw1.w};
        float dc[16];
#pragma unroll
        for (int dd = 0; dd < 16; ++dd) { const float bl = __builtin_bit_cast(float, __builtin_amdgcn_readlane(__builtin_bit_cast(int, bb[dd]), 63)); dc[dd] = __expf(bl);
            const float kv = (dd & 1) ? bfhi(kw[dd >> 1]) : bflo(kw[dd >> 1]); KHT[(d0 + dd) * 72 + t] = (bf16)f2bf(kv * __expf(bl - bb[dd])); }
        if (lane == 0) { float* GD = (float*)(F.ws + WS_GD) + ci * 128 + d0;
#pragma unroll
            for (int q = 0; q < 4; ++q) *(f32x4*)(GD + 4 * q) = (f32x4){dc[4 * q], dc[4 * q + 1], dc[4 * q + 2], dc[4 * q + 3]}; }
    }
    __syncthreads();
    if (stop_after == 2) return;
    {
        const int h = wave >> 1, eb = wave & 1; f32x16g U = {};
#pragma unroll
        for (int ks = 0; ks < 4; ++ks) { const bf16x8 ka = *(const LAS bf16x8*)(KHT + (h * 32 + r32) * 72 + ks * 16 + 8 * hh); const bf16x8 vb = *(const LAS bf16x8*)(VT + (h * 64 + eb * 32 + r32) * 72 + ks * 16 + 8 * hh);
            U = __builtin_amdgcn_mfma_f32_32x32x16_bf16(ka, vb, U, 0, 0, 0); }
        float* GU = (float*)(F.ws + WS_GU) + (size_t)(ci * 4 + h) * 2048 + eb * 32 + r32;
#pragma unroll
        for (int r = 0; r < 16; ++r) GU[gla_crow(r, hh) * 64] = U[r];
    }
    __syncthreads();
}
__device__ __forceinline__ void gla_scan(Frame& F) {
    if (F.tid < 128) { const int gid = F.vcu * 128 + F.tid;
        if (gid < 32768) { const int b = gid >> 13, h = (gid >> 11) & 3, d = (gid >> 6) & 31, e = gid & 63; float s = 0.f;
            float* GU = (float*)(F.ws + WS_GU); const float* GD = (const float*)(F.ws + WS_GD);
            for (int c0 = 0; c0 < 64; c0 += 16) { float u[16], dc[16];
#pragma unroll
                for (int i = 0; i < 16; ++i) { const int ci = b * 64 + c0 + i; u[i] = GU[((size_t)(ci * 4 + h) * 32 + d) * 64 + e]; dc[i] = GD[ci * 128 + h * 32 + d]; }
#pragma unroll
                for (int i = 0; i < 16; ++i) { const int ci = b * 64 + c0 + i; GU[((size_t)(ci * 4 + h) * 32 + d) * 64 + e] = s; s = dc[i] * s + u[i]; } } } }
}
__device__ __forceinline__ void xl_swap32_pair(unsigned& a, unsigned& b) { auto r = __builtin_amdgcn_permlane32_swap(a, b, false, false); const unsigned r0 = r[0], r1 = r[1]; a = r0; b = r1; }
__device__ __forceinline__ void mix_chunk(Frame& F, int l, int ci) {
    LAS bf16* QB = (LAS bf16*)(F.lds + RING_OFF);
    LAS bf16* KB = QB + 64 * 136;
    LAS bf16* VT = KB + 64 * 136;
    LAS bf16* ST = VT + 256 * 72;
    const int t0 = ci * 64, tid = F.tid, lane = F.lane, wave = F.wave, r32 = lane & 31, hh = lane >> 5;
    const bf16* PROJ = (const bf16*)(F.ws + WS_PROJ); bf16* MIXED = (bf16*)(F.ws + WS_MIXED);
    const float* GB = (const float*)(F.ws + WS_GB) + (size_t)t0 * 128;
    const int h = wave >> 1, ib = wave & 1, i0 = 32 * ib;
#pragma unroll
    for (int it = tid; it < 1024; it += 512) { const int t = it >> 4, d0 = (it & 15) * 8;
        const f32x4 b0 = *(const f32x4*)(GB + t * 128 + d0), b1 = *(const f32x4*)(GB + t * 128 + d0 + 4);
        const bf16* pr = PROJ + (size_t)(t0 + t) * NPROJ; const v4u qw = *(const v4u*)(pr + C_GQ + d0), kw = *(const v4u*)(pr + C_GK + d0);
        const float bv[8] = {b0[0], b0[1], b0[2], b0[3], b1[0], b1[1], b1[2], b1[3]}; const unsigned qa[4] = {qw.x, qw.y, qw.z, qw.w}, ka[4] = {kw.x, kw.y, kw.z, kw.w};
        unsigned qo[4], ko[4];
#pragma unroll
        for (int p = 0; p < 4; ++p) { const float e0 = __expf(bv[2 * p]), e1 = __expf(bv[2 * p + 1]), n0 = __expf(-bv[2 * p]), n1 = __expf(-bv[2 * p + 1]);
            qo[p] = pk2(bflo(qa[p]) * 0.17677669529663687f * e0, bfhi(qa[p]) * 0.17677669529663687f * e1); ko[p] = pk2(bflo(ka[p]) * n0, bfhi(ka[p]) * n1); }
        *(LAS v4u*)(QB + t * 136 + d0) = (v4u){qo[0], qo[1], qo[2], qo[3]}; *(LAS v4u*)(KB + t * 136 + d0) = (v4u){ko[0], ko[1], ko[2], ko[3]}; }
    gla_stage_vt(VT, PROJ, t0, tid);
    { const float* GU = (const float*)(F.ws + WS_GU) + (size_t)ci * 8192;
      float sv[16];
#pragma unroll
      for (int q = 0; q < 16; ++q) sv[q] = GU[tid + 512 * q];
#pragma unroll
      for (int q = 0; q < 16; ++q) { const int it = tid + 512 * q, hd = it >> 6, e = it & 63; ST[((hd >> 5) * 64 + e) * 40 + (hd & 31)] = (bf16)f2bf(sv[q]); } }
    const size_t row = (size_t)(t0 + i0 + r32); v4u rgw[4];
#pragma unroll
    for (int q2 = 0; q2 < 4; ++q2) rgw[q2] = *(const v4u*)(PROJ + row * NPROJ + C_GR + h * 64 + 32 * (q2 >> 1) + 16 * (q2 & 1) + 8 * hh);
    __syncthreads();
    {
        bf16x8 qf[2];
#pragma unroll
        for (int ks = 0; ks < 2; ++ks) qf[ks] = *(const LAS bf16x8*)(QB + (i0 + r32) * 136 + h * 32 + ks * 16 + 8 * hh);
        f32x16g OT[2] = {{}, {}};
#pragma unroll
        for (int eb = 0; eb < 2; ++eb)
#pragma unroll
            for (int ks = 0; ks < 2; ++ks) { const bf16x8 sa = *(const LAS bf16x8*)(ST + (h * 64 + eb * 32 + r32) * 40 + ks * 16 + 8 * hh); OT[eb] = __builtin_amdgcn_mfma_f32_32x32x16_bf16(sa, qf[ks], OT[eb], 0, 0, 0); }
#pragma unroll
        for (int jb = 0; jb < 2; ++jb) if (jb <= ib) {
            f32x16g X = {};
#pragma unroll
            for (int ks = 0; ks < 2; ++ks) { const bf16x8 ka = *(const LAS bf16x8*)(KB + (32 * jb + r32) * 136 + h * 32 + ks * 16 + 8 * hh); X = __builtin_amdgcn_mfma_f32_32x32x16_bf16(ka, qf[ks], X, 0, 0, 0); }
            if (jb == ib) {
#pragma unroll
                for (int r = 0; r < 16; ++r) if (gla_crow(r, hh) > r32) X[r] = 0.f;
            }
#pragma unroll
            for (int s = 0; s < 2; ++s) { v4u xw; xw.x = pk2(X[8 * s], X[8 * s + 1]); xw.y = pk2(X[8 * s + 2], X[8 * s + 3]); xw.z = pk2(X[8 * s + 4], X[8 * s + 5]); xw.w = pk2(X[8 * s + 6], X[8 * s + 7]);
                const bf16x8 xb = __builtin_bit_cast(bf16x8, xw);
#pragma unroll
                for (int eb = 0; eb < 2; ++eb) { const LAS bf16* vp = VT + (h * 64 + eb * 32 + r32) * 72 + 32 * jb + 16 * s + 4 * hh;
                    const unsigned long long lo = *(const LAS unsigned long long*)vp, hi = *(const LAS unsigned long long*)(vp + 8);
                    const v4u vw = (v4u){(unsigned)lo, (unsigned)(lo >> 32), (unsigned)hi, (unsigned)(hi >> 32)};
                    OT[eb] = __builtin_amdgcn_mfma_f32_32x32x16_bf16(__builtin_bit_cast(bf16x8, vw), xb, OT[eb], 0, 0, 0); } }
        }
        float ss = 0.f;
#pragma unroll
        for (int eb = 0; eb < 2; ++eb)
#pragma unroll
            for (int r = 0; r < 16; ++r) ss += OT[eb][r] * OT[eb][r];
        ss = xl_sum32(ss);
        const float rs = __builtin_amdgcn_rsqf(ss * (1.0f / 64.0f) + EPS); const float* gn = (const float*)(F.ws + WS_PAR) + PAR_GN + l * 64;
#pragma unroll
        for (int q2 = 0; q2 < 4; ++q2) { const int eb = q2 >> 1, j = q2 & 1;
            unsigned xa = rgw[q2].x, xb = rgw[q2].y, ya = rgw[q2].z, yb = rgw[q2].w;
            xl_swap32_pair(xa, ya); xl_swap32_pair(xb, yb);
            unsigned ow[4];
#pragma unroll
            for (int s = 0; s < 2; ++s) { const int g = 2 * j + s, e0 = 32 * eb + 8 * g + 4 * hh; const f32x4 g4 = *(const f32x4*)(gn + e0);
                const unsigned r0 = s ? ya : xa, r1 = s ? yb : xb; const float rr[4] = {bflo(r0), bfhi(r0), bflo(r1), bfhi(r1)}; float y[4];
#pragma unroll
                for (int k = 0; k < 4; ++k) { const float sl = rr[k] * __builtin_amdgcn_rcpf(1.0f + __expf(-rr[k])); y[k] = OT[eb][4 * g + k] * rs * g4[k] * sl; }
                ow[2 * s] = pk2(y[0], y[1]); ow[2 * s + 1] = pk2(y[2], y[3]); }
            xl_swap32_pair(ow[0], ow[2]); xl_swap32_pair(ow[1], ow[3]);
            *(v4u*)(MIXED + row * DM + 768 + h * 64 + 32 * eb + 16 * j + 8 * hh) = (v4u){ow[0], ow[1], ow[2], ow[3]}; }
    }
    const float lam = ((const float*)(F.ws + WS_LAM))[l * 2], oscale = ((const float*)(F.ws + WS_LAM))[l * 2 + 1];
    const bf16* OATT = (const bf16*)(F.ws + WS_OATT); const float* dn = (const float*)(F.ws + WS_PAR) + PAR_DN + l * 128; const float* cw = (const float*)(F.ws + WS_PAR) + PAR_CW + l * 3 * 256;
    const f32x4 dna = *(const f32x4*)(dn + 8 * (lane & 15)), dnb = *(const f32x4*)(dn + 8 * (lane & 15) + 4); const int ch = 4 * lane;
    f32x4 wj[3];
#pragma unroll
    for (int j = 0; j < 3; ++j) wj[j] = *(const f32x4*)(cw + j * 256 + ch);
#pragma unroll 1
    for (int r0 = 0; r0 < 8; r0 += 4) {
        v4u w1[4], w2[4]; unsigned long long cwd[6], hwd[6], bwd[4];
        const int tb = t0 + wave * 8 + r0;
#pragma unroll
        for (int u = 0; u < 4; ++u) { w1[u] = *(const v4u*)(OATT + (size_t)(tb + u) * DM + 8 * lane); w2[u] = *(const v4u*)(OATT + (size_t)(tb + u) * DM + 512 + 8 * lane); }
#pragma unroll
        for (int u = 0; u < 6; ++u) { const int tr = tb - 2 + u; const bool ok = ((tb & (SEQL - 1)) - 2 + u) >= 0;
            const bf16* pr = PROJ + (size_t)(ok ? tr : tb) * NPROJ; cwd[u] = ok ? *(const unsigned long long*)(pr + C_SC + ch) : 0ull; hwd[u] = ok ? *(const unsigned long long*)(pr + C_SH + ch) : 0ull; }
#pragma unroll
        for (int u = 0; u < 4; ++u) bwd[u] = *(const unsigned long long*)(PROJ + (size_t)(tb + u) * NPROJ + C_SB + ch);
        f32x4 z[6];
#pragma unroll
        for (int u = 0; u < 6; ++u) { const unsigned c0 = (unsigned)cwd[u], c1 = (unsigned)(cwd[u] >> 32), h0 = (unsigned)hwd[u], h1 = (unsigned)(hwd[u] >> 32); z[u] = (f32x4){bflo(c0) * bflo(h0), bfhi(c0) * bfhi(h0), bflo(c1) * bflo(h1), bfhi(c1) * bfhi(h1)}; }
#pragma unroll
        for (int u = 0; u < 4; ++u) { const int t = tb + u;
            { const unsigned a0 = w1[u].x, a1 = w1[u].y, a2 = w1[u].z, a3 = w1[u].w, b0_ = w2[u].x, b1_ = w2[u].y, b2_ = w2[u].z, b3_ = w2[u].w;
              const f32x4 oa = (f32x4){bflo(a0) - lam * bflo(b0_), bfhi(a0) - lam * bfhi(b0_), bflo(a1) - lam * bflo(b1_), bfhi(a1) - lam * bfhi(b1_)};
              const f32x4 ob = (f32x4){bflo(a2) - lam * bflo(b2_), bfhi(a2) - lam * bfhi(b2_), bflo(a3) - lam * bflo(b3_), bfhi(a3) - lam * bfhi(b3_)};
              float ssq = ((oa[0] * oa[0] + oa[1] * oa[1]) + (oa[2] * oa[2] + oa[3] * oa[3])) + ((ob[0] * ob[0] + ob[1] * ob[1]) + (ob[2] * ob[2] + ob[3] * ob[3]));
#define MX_DPP(v, ctrl) __builtin_bit_cast(float, __builtin_amdgcn_update_dpp(0, __builtin_bit_cast(int, (v)), (ctrl), 0xf, 0xf, false))
              ssq += MX_DPP(ssq, 0xB1); ssq += MX_DPP(ssq, 0x4E); ssq += MX_DPP(ssq, 0x141); ssq += MX_DPP(ssq, 0x140);
#undef MX_DPP
              const float rsq = oscale * __builtin_amdgcn_rsqf(ssq * (1.0f / 128.0f) + EPS);
              const f32x4 ya = oa * rsq * dna, yb = ob * rsq * dnb;
              *(v4u*)(MIXED + (size_t)t * DM + 8 * lane) = (v4u){pk2(ya[0], ya[1]), pk2(ya[2], ya[3]), pk2(yb[0], yb[1]), pk2(yb[2], yb[3])}; }
            const f32x4 y = wj[0] * z[u] + wj[1] * z[u + 1] + wj[2] * z[u + 2];
            const unsigned b0 = (unsigned)bwd[u], b1 = (unsigned)(bwd[u] >> 32);
            *(unsigned long long*)(MIXED + (size_t)t * DM + 512 + ch) = (unsigned long long)pk2(bflo(b0) * y[0], bfhi(b0) * y[1]) | ((unsigned long long)pk2(bflo(b1) * y[2], bfhi(b1) * y[3]) << 32); }
    }
    __syncthreads();
}

#define TK_HD __device__ __forceinline__
#ifndef TK_HD
#define TK_HD __device__ __forceinline__
#endif
TK_HD int tk_max(int a, int b) { return a > b ? a : b; }
TK_HD int tk_min(int a, int b) { return a < b ? a : b; }
TK_HD int tk_f2key(float f) { int b = __builtin_bit_cast(int, f); return b ^ ((b >> 31) & 0x7fffffff); }
TK_HD float tk_key2f(int k) { return __builtin_bit_cast(float, k ^ ((k >> 31) & 0x7fffffff)); }
template <int N> TK_HD void tk_sort_desc(int (&a)[N]) {
#pragma unroll
    for (int p = 1; p < N; p <<= 1)
#pragma unroll
        for (int k = p; k >= 1; k >>= 1)
#pragma unroll
            for (int j = k % p; j <= N - 1 - k; j += 2 * k)
#pragma unroll
                for (int i = 0; i <= (k - 1 < N - j - k - 1 ? k - 1 : N - j - k - 1); ++i)
                    if ((i + j) / (2 * p) == (i + j + k) / (2 * p)) { const int x = i + j, y = i + j + k; const int hi = tk_max(a[x], a[y]), lo = tk_min(a[x], a[y]); a[x] = hi; a[y] = lo; }
}
template <int N> TK_HD void tk_merge_desc(int (&a)[N]) {
#pragma unroll
    for (int j = N >> 1; j > 0; j >>= 1)
#pragma unroll
        for (int i = 0; i < N; ++i) { const int l = i ^ j; if (l > i) { const int hi = tk_max(a[i], a[l]), lo = tk_min(a[i], a[l]); a[i] = hi; a[l] = lo; } }
}
TK_HD void tk_top16_merge(int (&a)[16], const int (&b)[16]) {
#pragma unroll
    for (int i = 0; i < 16; ++i) a[i] = tk_max(a[i], b[15 - i]);
    tk_merge_desc<16>(a);
}
TK_HD constexpr int tk_cand_i(int set, int s) {
    if (set == 0) return s < 16 ? 0 : (s < 24 ? 1 : (s == 24 ? 8 : -1));
    return s < 5 ? 2 : s < 9 ? 3 : s < 12 ? 4 : s < 14 ? 5 : s < 16 ? 6 : s < 18 ? 7 : s < 25 ? (9 + (s - 18)) : -1;
}
TK_HD constexpr int tk_cand_j(int set, int s) {
    if (set == 0) return s < 16 ? s : (s < 24 ? s - 16 : (s == 24 ? 0 : -1));
    return s < 5 ? s : s < 9 ? s - 5 : s < 12 ? s - 9 : s < 14 ? s - 12 : s < 16 ? s - 14 : s < 18 ? s - 16 : s < 25 ? 0 : -1;
}

constexpr int PS_KSTRIDE = 136;
__device__ __forceinline__ void peer_select_task(Frame& F, int l, int t0, int h, LAS int* scr  , const LAS bf16* KL  ) {
    typedef float f32x16 __attribute__((ext_vector_type(16)));
    const int lane = F.lane, r32 = lane & 31, hi = lane >> 5;
    const bf16* QP = (const bf16*)(F.ws + WS_QP);
    int lists[2][16];
    bf16x8 qall[2][8];
#pragma unroll
    for (int half = 0; half < 2; ++half) { const bf16* qp = QP + (size_t)(t0 + r32) * NQ + h * 256 + half * 128 + hi * 8;
#pragma unroll
        for (int ks = 0; ks < 8; ++ks) qall[half][ks] = *(const bf16x8*)(qp + ks * 16); }
#pragma unroll
    for (int half = 0; half < 2; ++half) {
        const bf16x8 (&qf)[8] = qall[half];
        int cur[16];
#pragma unroll
        for (int kb = 0; kb < 4; ++kb) {
            f32x16 c = {};
            const LAS bf16* kp = KL + (half * 128 + kb * 32 + r32) * PS_KSTRIDE + hi * 8;
#pragma unroll
            for (int ks = 0; ks < 8; ++ks) { const bf16x8 kf = *(const LAS bf16x8*)(kp + ks * 16); c = __builtin_amdgcn_mfma_f32_32x32x16_bf16(kf, qf[ks], c, 0, 0, 0); }
            int g[16];
#pragma unroll
            for (int r = 0; r < 16; ++r) { const int key = kb * 32 + (r & 3) + 8 * (r >> 2) + 4 * hi; g[r] = (tk_f2key(c[r]) & ~127) | (127 - key); }
            tk_sort_desc<16>(g);
            if (kb == 0) {
#pragma unroll
                for (int r = 0; r < 16; ++r) cur[r] = g[r];
            } else tk_top16_merge(cur, g);
        }
        int oth[16];
#pragma unroll
        for (int r = 0; r < 16; ++r) oth[r] = xl_xor32_i(cur[r], hi);
        tk_top16_merge(cur, oth);
#pragma unroll
        for (int r = 0; r < 16; ++r) lists[half][r] = cur[r];
    }
#pragma unroll
    for (int r = 0; r < 16; ++r) scr[r32 * 32 + hi * 16 + r] = 127 - ((hi ? lists[1][r] : lists[0][r]) & 127);
    float v1[16], v2[16];
#pragma unroll
    for (int r = 0; r < 16; ++r) { v1[r] = tk_key2f(lists[0][r]); v2[r] = tk_key2f(lists[1][r]); }
    int c[32];
#pragma unroll
    for (int s = 0; s < 32; ++s) {
        constexpr int NEG = (int)0x80000000;
        const int ia = tk_cand_i(0, s), ja = tk_cand_j(0, s), ib = tk_cand_i(1, s), jb = tk_cand_j(1, s);
        if (ia < 0) c[s] = NEG;
        else { const int ka = (tk_f2key(v1[ia] + v2[ja]) & ~255) | (255 - (ia * 16 + ja)), kb2 = (tk_f2key(v1[ib] + v2[jb]) & ~255) | (255 - (ib * 16 + jb)); c[s] = hi ? kb2 : ka; }
    }
    tk_sort_desc<32>(c);
    int fin[16], oth[16];
#pragma unroll
    for (int r = 0; r < 16; ++r) { fin[r] = c[r]; oth[r] = xl_xor32_i(c[r], hi); }
    tk_top16_merge(fin, oth);
    float p[16]; float sum = 0.f; const float mx = tk_key2f(fin[0]);
#pragma unroll
    for (int r = 0; r < 16; ++r) { p[r] = __expf(tk_key2f(fin[r]) - mx); sum += p[r]; }
    const float inv = __builtin_amdgcn_rcpf(sum);
    asm volatile("s_waitcnt lgkmcnt(0)" ::: "memory");
    int ex8[8]; float gt8[8];
    int* EX = (int*)(F.ws + WS_EXP) + (size_t)(t0 + r32) * 128 + h * 16; float* GT = (float*)(F.ws + WS_GATE) + (size_t)(t0 + r32) * 128 + h * 16;
#pragma unroll
    for (int r = 0; r < 8; ++r) { const int fr_ = hi ? fin[r + 8] : fin[r]; const int code = 255 - (fr_ & 255); const int e1 = scr[r32 * 32 + (code >> 4)], e2 = scr[r32 * 32 + 16 + (code & 15)];
        ex8[r] = e1 * 128 + e2; gt8[r] = (hi ? p[r + 8] : p[r]) * inv; }
    asm volatile("s_waitcnt lgkmcnt(0)" ::: "memory");
    { int* ex = EX + 8 * hi; float* gt = GT + 8 * hi;
      *(v4u*)(ex) = (v4u){(unsigned)ex8[0], (unsigned)ex8[1], (unsigned)ex8[2], (unsigned)ex8[3]}; *(v4u*)(ex + 4) = (v4u){(unsigned)ex8[4], (unsigned)ex8[5], (unsigned)ex8[6], (unsigned)ex8[7]};
      *(f32x4*)(gt) = (f32x4){gt8[0], gt8[1], gt8[2], gt8[3]}; *(f32x4*)(gt + 4) = (f32x4){gt8[4], gt8[5], gt8[6], gt8[7]}; }
}

__device__ __forceinline__ float gelu_erf(float v) {
    const float av = fabsf(v), t = __builtin_amdgcn_rcpf(av * 0.2316418882f + 1.0f);
    float q = t * 0.5307027145f + (-0.7265760135f); q = q * t + 0.7107068705f; q = q * t + (-0.142248368f); q = q * t + 0.127414796f; q = q * t;
    const float e = __builtin_amdgcn_exp2f((v * v) * (-0.72134752044f)); const float m_ = v * (q * e);
    return v < 0.f ? m_ : v - m_;
}
typedef __bf16 bf16x2_t __attribute__((ext_vector_type(2)));
__device__ __forceinline__ float dot2bf(unsigned a, unsigned b, float c) { return __builtin_amdgcn_fdot2_f32_bf16(__builtin_bit_cast(bf16x2_t, a), __builtin_bit_cast(bf16x2_t, b), c, false); }
template <int J> __device__ __forceinline__ int xl_xchg_i(int v, int hi) { if constexpr (J == 32) return xl_xor32_i(v, hi); else return xl_swz_i<J>(v); }
template <int K, int J> __device__ __forceinline__ void sort128_step(int& ka, int& kb, int lane) {
    if constexpr (J == 64) { const int lo = ka < kb ? ka : kb, hi = ka < kb ? kb : ka; ka = lo; kb = hi; }
    else { const int oa = xl_xchg_i<J>(ka, lane >> 5), ob = xl_xchg_i<J>(kb, lane >> 5); const bool lower = (lane & J) == 0;
        const bool upa = (K >= 64) ? true : ((lane & K) == 0), upb = (K >= 128) ? true : (K == 64 ? false : ((lane & K) == 0));
        const int mina = ka < oa ? ka : oa, maxa = ka < oa ? oa : ka, minb = kb < ob ? kb : ob, maxb = kb < ob ? ob : kb;
        ka = (upa == lower) ? mina : maxa; kb = (upb == lower) ? minb : maxb; }
}
__device__ __forceinline__ void sort128(int& ka, int& kb, int lane) {
#define S_(K, J) sort128_step<K, J>(ka, kb, lane);
    S_(2, 1) S_(4, 2) S_(4, 1) S_(8, 4) S_(8, 2) S_(8, 1) S_(16, 8) S_(16, 4) S_(16, 2) S_(16, 1) S_(32, 16) S_(32, 8) S_(32, 4) S_(32, 2) S_(32, 1)
    S_(64, 32) S_(64, 16) S_(64, 8) S_(64, 4) S_(64, 2) S_(64, 1) S_(128, 64) S_(128, 32) S_(128, 16) S_(128, 8) S_(128, 4) S_(128, 2) S_(128, 1)
#undef S_
}
typedef float f32x2g __attribute__((ext_vector_type(2)));
#define PT_WGSYNC 1
#ifndef PT_SYNC_EVERY
#define PT_SYNC_EVERY 4
#endif
#ifndef PT_FIXED_ORDER
#define PT_GREEDY 1
#endif
#ifndef PT_CH
#define PT_CH 8
#endif
constexpr int PT_T = 4;
constexpr int PT_TOK_INTS = 128 + 128 + 64 + 256 + 4 + 128;
constexpr int PT_WAVE_INTS = PT_T * PT_TOK_INTS;
__device__ __forceinline__ float pt_dot8(const v4u w, const f32x2g (&xv)[8]) {
    f32x2g a = (f32x2g){0.f, 0.f};
    a = __builtin_elementwise_fma(__builtin_amdgcn_cvt_pk_f32_fp8(w.x, false), xv[0], a); a = __builtin_elementwise_fma(__builtin_amdgcn_cvt_pk_f32_fp8(w.x, true), xv[1], a);
    a = __builtin_elementwise_fma(__builtin_amdgcn_cvt_pk_f32_fp8(w.y, false), xv[2], a); a = __builtin_elementwise_fma(__builtin_amdgcn_cvt_pk_f32_fp8(w.y, true), xv[3], a);
    a = __builtin_elementwise_fma(__builtin_amdgcn_cvt_pk_f32_fp8(w.z, false), xv[4], a); a = __builtin_elementwise_fma(__builtin_amdgcn_cvt_pk_f32_fp8(w.z, true), xv[5], a);
    a = __builtin_elementwise_fma(__builtin_amdgcn_cvt_pk_f32_fp8(w.w, false), xv[6], a); a = __builtin_elementwise_fma(__builtin_amdgcn_cvt_pk_f32_fp8(w.w, true), xv[7], a);
    return a.x + a.y;
}
__device__ __forceinline__ void pt_axpy8(const v4u w, const float c, f32x2g (&o)[8]) {
    const f32x2g cc = (f32x2g){c, c};
    o[0] = __builtin_elementwise_fma(__builtin_amdgcn_cvt_pk_f32_fp8(w.x, false), cc, o[0]); o[1] = __builtin_elementwise_fma(__builtin_amdgcn_cvt_pk_f32_fp8(w.x, true), cc, o[1]);
    o[2] = __builtin_elementwise_fma(__builtin_amdgcn_cvt_pk_f32_fp8(w.y, false), cc, o[2]); o[3] = __builtin_elementwise_fma(__builtin_amdgcn_cvt_pk_f32_fp8(w.y, true), cc, o[3]);
    o[4] = __builtin_elementwise_fma(__builtin_amdgcn_cvt_pk_f32_fp8(w.z, false), cc, o[4]); o[5] = __builtin_elementwise_fma(__builtin_amdgcn_cvt_pk_f32_fp8(w.z, true), cc, o[5]);
    o[6] = __builtin_elementwise_fma(__builtin_amdgcn_cvt_pk_f32_fp8(w.w, false), cc, o[6]); o[7] = __builtin_elementwise_fma(__builtin_amdgcn_cvt_pk_f32_fp8(w.w, true), cc, o[7]);
}
__device__ __forceinline__ int xl_sum32_i(int v) { unsigned a = (unsigned)v, b = a; asm volatile("" : "+v"(b)); auto r = __builtin_amdgcn_permlane32_swap(a, b, false, false); const unsigned r0 = r[0], r1 = r[1]; return (int)(r0 + r1); }
__device__ __forceinline__ void pt_chunk(const LAS int* se, const LAS float* sg, int base, const v4u xq, f32x2g (&out)[8], float hscale,
                                         const unsigned char* Ub, const unsigned char* Vb, const float* SU, const float* SV, int lane) {
    const int e_l = se[base + (lane & (PT_CH - 1))]; const float g_l = sg[base + (lane & (PT_CH - 1))], hu_l = sg[452 + base + (lane & (PT_CH - 1))];
    v4u uw[PT_CH], vw[PT_CH]; const int l16 = 16 * lane; int es[PT_CH];
    const __amdgpu_buffer_rsrc_t rs = __builtin_amdgcn_make_buffer_rsrc((void*)Ub, 0, 32 << 20, 0x00020000);
#pragma unroll
    for (int s = 0; s < PT_CH; ++s) { es[s] = __builtin_amdgcn_readlane(e_l, s) * 2048; uw[s] = __builtin_bit_cast(v4u, __builtin_amdgcn_raw_buffer_load_b128(rs, l16, es[s], 0)); }
#pragma unroll
    for (int s = 0; s < PT_CH; ++s) vw[s] = __builtin_bit_cast(v4u, __builtin_amdgcn_raw_buffer_load_b128(rs, l16 + 1024, es[s], 0));
    __builtin_amdgcn_s_setprio(2);
    int p[PT_CH];
#pragma unroll
    for (int s = 0; s < PT_CH; ++s) { int a = __builtin_amdgcn_sdot4((int)uw[s].x, (int)xq.x, 0, false); a = __builtin_amdgcn_sdot4((int)uw[s].y, (int)xq.y, a, false);
        a = __builtin_amdgcn_sdot4((int)uw[s].z, (int)xq.z, a, false); p[s] = __builtin_amdgcn_sdot4((int)uw[s].w, (int)xq.w, a, false); }
#define PT_DPP(v, ctrl) __builtin_amdgcn_update_dpp(0, (v), (ctrl), 0xf, 0xf, false)
#define PT_BFLY(S, BIT, CTRL) _Pragma("unroll") for (int i = 0; i < S; ++i) { const bool up = (lane & BIT) != 0; const int keep = up ? p[i + S] : p[i], send = up ? p[i] : p[i + S]; p[i] = keep + PT_DPP(send, CTRL); }
    PT_BFLY(4, 4, 0x141) PT_BFLY(2, 2, 0x4E) PT_BFLY(1, 1, 0xB1)
#undef PT_BFLY
    int hi_ = p[0];
    hi_ += PT_DPP(hi_, 0x128);
#undef PT_DPP
    { unsigned a_ = (unsigned)hi_, b_ = a_; asm volatile("" : "+v"(b_)); auto r_ = __builtin_amdgcn_permlane16_swap(a_, b_, false, false); const unsigned r0 = r_[0], r1 = r_[1]; hi_ = (int)(r0 + r1); }
    hi_ = xl_sum32_i(hi_);
    const float c_l = g_l * gelu_erf((float)hi_ * hu_l);
    __builtin_amdgcn_s_setprio(0);
#pragma unroll
    for (int s = 0; s < PT_CH; ++s) { const float c = __builtin_bit_cast(float, __builtin_amdgcn_readlane(__builtin_bit_cast(int, c_l), s)); pt_axpy8(vw[s], c, out); }
}
__device__ __forceinline__ void pt_sort_regs(LAS int* se, LAS float* sg, LAS int* cnt, LAS float* sh, int ea, int eb, float ga, float gb, float ha, float hb, int lane) {
    cnt[lane] = 0;
    asm volatile("s_waitcnt lgkmcnt(0)" ::: "memory");
    __hip_atomic_fetch_add(cnt + (ea >> 8), 1, __ATOMIC_RELAXED, __HIP_MEMORY_SCOPE_WAVEFRONT); __hip_atomic_fetch_add(cnt + (eb >> 8), 1, __ATOMIC_RELAXED, __HIP_MEMORY_SCOPE_WAVEFRONT);
    asm volatile("s_waitcnt lgkmcnt(0)" ::: "memory");
    const int c = cnt[lane]; int incl = c;
#define PT_SCAN(ctrl, rmask) incl += __builtin_amdgcn_update_dpp(0, incl, (ctrl), (rmask), 0xf, false)
    PT_SCAN(0x111, 0xf); PT_SCAN(0x112, 0xf); PT_SCAN(0x114, 0xf); PT_SCAN(0x118, 0xf); PT_SCAN(0x142, 0xa); PT_SCAN(0x143, 0xc);
#undef PT_SCAN
    cnt[lane] = incl - c;
    asm volatile("s_waitcnt lgkmcnt(0)" ::: "memory");
    const int pa = __hip_atomic_fetch_add(cnt + (ea >> 8), 1, __ATOMIC_RELAXED, __HIP_MEMORY_SCOPE_WAVEFRONT);
    const int pb = __hip_atomic_fetch_add(cnt + (eb >> 8), 1, __ATOMIC_RELAXED, __HIP_MEMORY_SCOPE_WAVEFRONT);
    se[pa] = ea; sg[pa] = ga; sh[pa] = ha; se[pb] = eb; sg[pb] = gb; sh[pb] = hb;
    asm volatile("s_waitcnt lgkmcnt(0)" ::: "memory");
}
__device__ __forceinline__ void pt_sort(LAS int* se, LAS float* sg, LAS int* cnt, const int* EX, const float* GT, int lane, bool dry, const float* SU = nullptr, const float* SV = nullptr, float hs = 1.0f, LAS float* sh = nullptr) {
    int ea = EX[lane], eb = EX[64 + lane];
#ifdef DRYMASK
    if (dry) { ea &= DRYMASK; eb &= DRYMASK; }
#endif
    (void)dry; float ga = GT[lane], gb = GT[64 + lane]; float ha = 0.f, hb = 0.f;
    if (sh) { ga *= SV[ea]; gb *= SV[eb]; ha = hs * SU[ea]; hb = hs * SU[eb]; }
    cnt[lane] = 0;
    asm volatile("s_waitcnt lgkmcnt(0)" ::: "memory");
    __hip_atomic_fetch_add(cnt + (ea >> 8), 1, __ATOMIC_RELAXED, __HIP_MEMORY_SCOPE_WAVEFRONT); __hip_atomic_fetch_add(cnt + (eb >> 8), 1, __ATOMIC_RELAXED, __HIP_MEMORY_SCOPE_WAVEFRONT);
    asm volatile("s_waitcnt lgkmcnt(0)" ::: "memory");
    const int c = cnt[lane];
    int incl = c;
    int ln = lane; asm volatile("" : "+v"(ln));
#pragma unroll
    for (int off = 1; off < 64; off <<= 1) { const int o = __builtin_amdgcn_ds_bpermute(((ln - off) & 63) << 2, incl); incl += (ln >= off) ? o : 0; }
    asm volatile("s_waitcnt lgkmcnt(0)" ::: "memory");
    cnt[lane] = incl - c;
    asm volatile("s_waitcnt lgkmcnt(0)" ::: "memory");
    const int pa = __hip_atomic_fetch_add(cnt + (ea >> 8), 1, __ATOMIC_RELAXED, __HIP_MEMORY_SCOPE_WAVEFRONT);
    const int pb = __hip_atomic_fetch_add(cnt + (eb >> 8), 1, __ATOMIC_RELAXED, __HIP_MEMORY_SCOPE_WAVEFRONT);
    se[pa] = ea; sg[pa] = ga; se[pb] = eb; sg[pb] = gb; if (sh) { sh[pa] = ha; sh[pb] = hb; }
    asm volatile("s_waitcnt lgkmcnt(0)" ::: "memory");
}
__device__ __forceinline__ void peer_tokens4(Frame& F, int l, int tq, bool last, LAS int* scr, unsigned* xs_word, unsigned xs_nloc, unsigned& xs_round, bool dry = false) {
    const int lane = F.lane;
    const unsigned char* Ub = F.ws + WS_TAB + l * TAB_STRIDE; const unsigned char* Vb = Ub + 1024;
    const float* SU = (const float*)(F.ws + WS_SU) + l * 16384; const float* SV = (const float*)(F.ws + WS_SV) + l * 16384;
    f32x2g out[PT_T][8];
    {
        int ls = lane; asm volatile("" : "+v"(ls));
        v4u xw_[PT_T][2]; int ea[PT_T], eb[PT_T]; float ga[PT_T], gb[PT_T], rs[PT_T], pq[PT_T], sua[PT_T], sub_[PT_T], sva[PT_T], svb[PT_T];
#pragma unroll
        for (int k = 0; k < PT_T; ++k) { const int t = tq + k; const bf16* Xr = (const bf16*)(F.ws + WS_XB) + (size_t)t * DM + 16 * ls; const int* EX = (const int*)(F.ws + WS_EXP) + (size_t)t * 128; const float* GT = (const float*)(F.ws + WS_GATE) + (size_t)t * 128;
            ea[k] = EX[ls]; eb[k] = EX[64 + ls]; ga[k] = GT[ls]; gb[k] = GT[64 + ls];
#ifdef DRYMASK
            if (dry) { ea[k] &= DRYMASK; eb[k] &= DRYMASK; }
#endif
            xw_[k][0] = *(const v4u*)(Xr); xw_[k][1] = *(const v4u*)(Xr + 8);
            { const f32x4 q_ = *(const f32x4*)((const float*)(F.ws + WS_SSQ) + (size_t)t * 16 + 4 * (ls & 3)); pq[k] = (q_[0] + q_[1]) + (q_[2] + q_[3]); } }
#pragma unroll
        for (int k = 0; k < PT_T; ++k) { float s_ = pq[k];
            s_ += __builtin_bit_cast(float, __builtin_amdgcn_update_dpp(0, __builtin_bit_cast(int, s_), 0xB1, 0xf, 0xf, false)); s_ += __builtin_bit_cast(float, __builtin_amdgcn_update_dpp(0, __builtin_bit_cast(int, s_), 0x4E, 0xf, 0xf, false));
            rs[k] = __builtin_amdgcn_rsqf(s_ * (1.0f / 1024.0f) + 1e-6f); }
#pragma unroll
        for (int k = 0; k < PT_T; ++k) { sua[k] = SU[ea[k]]; sub_[k] = SU[eb[k]]; sva[k] = SV[ea[k]]; svb[k] = SV[eb[k]]; }
#pragma unroll
        for (int k = 0; k < PT_T; ++k) { LAS int* tk = scr + k * PT_TOK_INTS;
            f32x4 xr[1][4];
#pragma unroll
            for (int j = 0; j < 4; ++j) { const v4u w = xw_[k][j >> 1]; const unsigned a = (j & 1) ? w.z : w.x, b = (j & 1) ? w.w : w.y; xr[0][j] = (f32x4){bflo(a), bfhi(a), bflo(b), bfhi(b)}; }
            float mx = 0.f;
#pragma unroll
            for (int j = 0; j < 4; ++j) mx = fmaxf(mx, fmaxf(fmaxf(fabsf(xr[0][j][0]), fabsf(xr[0][j][1])), fmaxf(fabsf(xr[0][j][2]), fabsf(xr[0][j][3]))));
            mx = fmaxf(mx, xl_swz<1>(mx)); mx = fmaxf(mx, xl_swz<2>(mx)); mx = fmaxf(mx, xl_swz<4>(mx)); mx = fmaxf(mx, xl_swz<8>(mx)); mx = fmaxf(mx, xl_swz<16>(mx));
            mx = fmaxf(mx, __builtin_bit_cast(float, xl_xor32_i(__builtin_bit_cast(int, mx), lane >> 5)));
            const float sc = mx > 0.f ? 127.0f / mx : 0.f;
#define PT_Q4(v) ((unsigned)((int)rintf((v)[0] * sc) & 255) | ((unsigned)((int)rintf((v)[1] * sc) & 255) << 8) | ((unsigned)((int)rintf((v)[2] * sc) & 255) << 16) | ((unsigned)((int)rintf((v)[3] * sc) & 255) << 24))
            *(LAS v4u*)(tk + 320 + 4 * lane) = (v4u){PT_Q4(xr[0][0]), PT_Q4(xr[0][1]), PT_Q4(xr[0][2]), PT_Q4(xr[0][3])};
#undef PT_Q4
            const float hs_ = rs[k] * mx * (1.0f / 127.0f);
            pt_sort_regs(tk, (LAS float*)(tk + 128), tk + 256, (LAS float*)(tk + 580), ea[k], eb[k], ga[k] * sva[k], gb[k] * svb[k], hs_ * sua[k], hs_ * sub_[k], lane);
            asm volatile("" ::: "memory"); }
    }
#pragma unroll
    for (int k = 0; k < PT_T; ++k)
#pragma unroll
        for (int i = 0; i < 8; ++i) out[k][i] = (f32x2g){0.f, 0.f};
#ifdef PT_GREEDY
    static_assert(PT_T == 4 && PT_CH == 8, "greedy sweep: four tokens, chunks of eight");
    int csv0, csv1, csv2, csv3;
    { int lc = lane; asm volatile("" : "+v"(lc)); const int ci = (lc & 15) * PT_CH; const bool in = lc < 16;
      csv0 = in ? scr[0 * PT_TOK_INTS + ci] : 0x7fffffff; csv1 = in ? scr[1 * PT_TOK_INTS + ci] : 0x7fffffff; csv2 = in ? scr[2 * PT_TOK_INTS + ci] : 0x7fffffff; csv3 = in ? scr[3 * PT_TOK_INTS + ci] : 0x7fffffff; }
    int pos0 = 0, pos1 = 0, pos2 = 0, pos3 = 0;
#define PT_RUN(K, POS) { const LAS int* tk = scr + K * PT_TOK_INTS; const v4u xq = *(const LAS v4u*)(tk + 320 + 4 * lane); \
        pt_chunk(tk, (const LAS float*)(tk + 128), PT_CH * POS, xq, out[K], 0.f, Ub, Vb, SU, SV, lane); ++POS; asm volatile("" ::: "memory"); }
#pragma unroll 1
    for (int ck = 0; ck < 128 / PT_CH; ++ck) {
#pragma unroll 1
        for (int j = 0; j < PT_T; ++j) {
            const int s0 = __builtin_amdgcn_readlane(csv0, pos0), s1 = __builtin_amdgcn_readlane(csv1, pos1), s2 = __builtin_amdgcn_readlane(csv2, pos2), s3 = __builtin_amdgcn_readlane(csv3, pos3);
            const int m01 = s0 <= s1 ? s0 : s1, m23 = s2 <= s3 ? s2 : s3;
            const int sel = (m01 <= m23) ? (s0 <= s1 ? 0 : 1) : (s2 <= s3 ? 2 : 3);
            if (sel == 0) PT_RUN(0, pos0)
            if (sel == 1) PT_RUN(1, pos1)
            if (sel == 2) PT_RUN(2, pos2)
            if (sel == 3) PT_RUN(3, pos3)
        }
#else
#pragma unroll 1
    for (int ck = 0; ck < 128 / PT_CH; ++ck) {
#pragma unroll
        for (int k = 0; k < PT_T; ++k) { const LAS int* tk = scr + k * PT_TOK_INTS; const v4u xq = *(const LAS v4u*)(tk + 320 + 4 * lane); const float hsc = ((const LAS float*)tk)[576];
            pt_chunk(tk, (const LAS float*)(tk + 128), PT_CH * ck, xq, out[k], hsc, Ub, Vb, SU, SV, lane); asm volatile("" ::: "memory"); }
#endif
#ifdef PT_WGSYNC
        if ((ck % PT_SYNC_EVERY) == PT_SYNC_EVERY - 1) __syncthreads();
#if PT_WGSYNC >= 2
        if ((ck % PT_XSTEP) == PT_XSTEP - 1) { if (F.tid == 0) { unsigned* w = xs_word; const unsigned tgt = (++xs_round) * xs_nloc; __hip_atomic_fetch_add(w, 1u, __ATOMIC_RELAXED, __HIP_MEMORY_SCOPE_AGENT);
                unsigned sp = 0; while (__hip_atomic_load(w, __ATOMIC_RELAXED, __HIP_MEMORY_SCOPE_AGENT) < tgt && ++sp < (1u << 16)) __builtin_amdgcn_s_sleep(1); }
            __syncthreads(); }
#endif
#endif
    }
#pragma unroll
    for (int k = 0; k < PT_T; ++k) { int lf = lane; asm volatile("" : "+v"(lf)); const int t = tq + k; float* X = F.out + (size_t)t * DM + 16 * lf; bf16* XBr = (bf16*)(F.ws + WS_XB) + (size_t)t * DM + 16 * lf;
        const v4u ra = *(const v4u*)(XBr), rb = *(const v4u*)(XBr + 8);
        f32x4 x0 = (f32x4){bflo(ra.x), bfhi(ra.x), bflo(ra.y), bfhi(ra.y)} + (f32x4){out[k][0].x, out[k][0].y, out[k][1].x, out[k][1].y}, x1 = (f32x4){bflo(ra.z), bfhi(ra.z), bflo(ra.w), bfhi(ra.w)} + (f32x4){out[k][2].x, out[k][2].y, out[k][3].x, out[k][3].y};
        f32x4 x2 = (f32x4){bflo(rb.x), bfhi(rb.x), bflo(rb.y), bfhi(rb.y)} + (f32x4){out[k][4].x, out[k][4].y, out[k][5].x, out[k][5].y}, x3 = (f32x4){bflo(rb.z), bfhi(rb.z), bflo(rb.w), bfhi(rb.w)} + (f32x4){out[k][6].x, out[k][6].y, out[k][7].x, out[k][7].y};
        float ss = 0.f;
#pragma unroll
        for (int i = 0; i < 4; ++i) ss += x0[i] * x0[i] + x1[i] * x1[i] + x2[i] * x2[i] + x3[i] * x3[i];
        ss = wave_sum(ss);
        if (dry && ss != -1.0f) continue;
        if (last) { const float rs = __builtin_amdgcn_rsqf(ss * (1.0f / 1024.0f) + EPS); const float* g = (const float*)(F.ws + WS_PAR) + PAR_NF + 16 * lane;
            x0 = x0 * rs * *(const f32x4*)(g); x1 = x1 * rs * *(const f32x4*)(g + 4); x2 = x2 * rs * *(const f32x4*)(g + 8); x3 = x3 * rs * *(const f32x4*)(g + 12);
            *(f32x4*)(X) = x0; *(f32x4*)(X + 4) = x1; *(f32x4*)(X + 8) = x2; *(f32x4*)(X + 12) = x3; }
        else { v4u wa, wb; wa.x = pk2(x0[0], x0[1]); wa.y = pk2(x0[2], x0[3]); wa.z = pk2(x1[0], x1[1]); wa.w = pk2(x1[2], x1[3]); wb.x = pk2(x2[0], x2[1]); wb.y = pk2(x2[2], x2[3]); wb.z = pk2(x3[0], x3[1]); wb.w = pk2(x3[2], x3[3]);
            *(v4u*)(XBr) = wa; *(v4u*)(XBr + 8) = wb;
            if (lf == 0) ((float*)(F.ws + WS_RS1))[t] = __builtin_amdgcn_rsqf(ss * (1.0f / 1024.0f) + EPS); }
        asm volatile("" ::: "memory"); }
}

constexpr int NPHASE = 1 + 8 * NLAYER;
struct Args { const float* in[21]; float* out; unsigned char* ws; int ph_lo, ph_hi, use_bar, pad; };
__global__ void __launch_bounds__(NWAVES * 64, 2) hymba_fwd(Args args) {
    extern __shared__ __attribute__((aligned(16))) unsigned char lds[];
    Frame F;
    F.lds = (LAS unsigned char*)lds;
    F.MISC = (volatile LAS unsigned*)(F.lds + MISC_OFF);
    F.tid = threadIdx.x; F.lane = F.tid & 63; F.wave = __builtin_amdgcn_readfirstlane(F.tid >> 6);
    F.G = gridDim.x; F.bx = blockIdx.x; { const int bx = blockIdx.x; F.vcu = (F.G % 8 == 0) ? (bx % 8) * (F.G / 8) + bx / 8 : bx; }
    F.out = args.out; F.ws = args.ws;
    for (int u = F.tid; u < (LDS_BYTES - LDSCTL_OFF) / 4; u += NWAVES * 64) ((LAS unsigned*)(F.lds + LDSCTL_OFF))[u] = 0u;
    __syncthreads();
    XcdBarrier bar; bar.bar = ((unsigned*)(args.ws + WS_CTL) + CW_BAR); bar.x = 0; bar.st = nullptr;
    if (args.use_bar) bar = xcd_barrier_post(((unsigned*)(args.ws + WS_CTL) + CW_BAR), F.MISC + 8);
    const int lo = args.ph_lo, hi = args.ph_hi;
#ifndef PHMASK
#define PHMASK 0x1ff
#endif
#ifndef REPMASK
#define REPMASK 0
#endif
#define REPS(bit) (((REPMASK >> (bit)) & 1) ? 2 : 1)
#define IN(k) (((PHMASK >> ((k) == 0 ? 0 : 1 + (((k) - 1) & 7))) & 1) && lo <= (k) && (k) < hi)
#define SEAM(k) do { if (IN(k) && IN((k) + 1)) { XcdBarrier b_ = bar; int zb_ = 0; asm volatile("" : "+s"(zb_), "+s"(b_.x)); b_.bar = bar.bar + zb_; xcd_barrier(b_, F.tid == 0); } FRESH(); } while (0)
#define SEAMW(k, q) do { if (IN(k) && IN((k) + 1)) { XcdBarrier b_ = bar; int zb_ = 0; asm volatile("" : "+s"(zb_), "+s"(b_.x)); b_.bar = bar.bar + zb_; \
        xcd_barrier_w(b_, F.tid == 0, [&]() { if ((q) < 6) { const int r0_ = (((q) * 256 + F.vcu) * 7 + (F.wave - 1)) * 2; if (F.wave > 0) p0_tables_rows<2>(F, args, r0_, 1, 4 * 16384); } \
            else { const int r0_ = 2 * 16384 + ((((q) - 6) * 256 + F.vcu) * 7 + (F.wave - 1)) * 3; if (F.wave > 0 && r0_ < 4 * 16384) p0_tables_rows<3>(F, args, r0_, 1, 4 * 16384); } }); } FRESH(); } while (0)
#define FRESH() do { int ln_; int wv_ = wave0; asm volatile("v_mbcnt_lo_u32_b32 %0, -1, 0\n\tv_mbcnt_hi_u32_b32 %0, -1, %0" : "=v"(ln_)); asm volatile("" : "+s"(wv_)); F.lane = ln_; F.wave = wv_; F.tid = wv_ * 64 + ln_; \
        int z_ = 0, v_ = vcu0, g_ = (int)gridDim.x, bx_ = (int)blockIdx.x; asm volatile("" : "+s"(z_), "+s"(v_), "+s"(g_), "+s"(bx_)); F.ws = args.ws + z_; F.out = args.out + z_; F.vcu = v_; F.G = g_; F.bx = bx_; } while (0)
    if (IN(0)) { for (int rep_ = 0; rep_ < REPS(8); ++rep_) { p0_prologue(F, args); __syncthreads(); } }
    const int vcu0 = F.vcu, wave0 = F.wave;
    SEAMW(0, 0);
    { constexpr int l = 0;

        const int pb = 1 + 8 * l;
        if (IN(pb + 0)) for (int rep_ = 0; rep_ < REPS(0); ++rep_) {
            pg8::Gemm g{(const pg8::bf16_t*)(F.ws + WS_XB), (const pg8::bf16_t*)(F.ws + WS_WIN + l * WIN_STRIDE), M, NPROJ, DM}; pg8::StaticOrder S; S.init(M, NPROJ, F.G, F.bx);
            pg8::EpiScale<true> E{(pg8::bf16_t*)(F.ws + WS_PROJ), NPROJ, (const float*)(F.ws + WS_RS1), (const float*)(F.ws + WS_COS), (const float*)(F.ws + WS_SIN), ATT_C2};
            pg8::gemm_phase<pg8::EpiScale<true>, pg8::StaticOrder, PG8_ALIGN, PG8_SP2>(F.lds + RING_OFF, g, S, E, F.tid);
        }
        if (l == 0) SEAMW(pb + 0, 1); else SEAMW(pb + 0, 8);
        if (IN(pb + 1)) for (int rep_ = 0; rep_ < REPS(1); ++rep_) {
            if (args.pad == 0) { const attn_body::StaticOrder S(F.vcu);     attn_body::attn_phase<attn_body::StaticOrder>((char*)lds + RING_OFF, (const attn_body::bf16*)(F.ws + WS_PROJ), (attn_body::bf16*)(F.ws + WS_OATT), S, F.tid); }
            __syncthreads(); FRESH();
            for (int ci = F.vcu; ci < 256; ci += F.G) gla_prep(F, l, ci, args.pad >= 2 ? args.pad - 1 : 0);
        }
        if (l == 0) SEAMW(pb + 1, 2); else SEAMW(pb + 1, 9);
        if (IN(pb + 2) && args.pad != 1) gla_scan(F);
        if (l == 0) SEAMW(pb + 2, 3); else SEAMW(pb + 2, 10);
        if (IN(pb + 3)) for (int rep_ = 0; rep_ < REPS(3); ++rep_) { for (int ci = F.vcu; ci < 256; ci += F.G) mix_chunk(F, l, ci); }
        if (l == 0) SEAMW(pb + 3, 4); else SEAMW(pb + 3, 11);
        if (IN(pb + 4)) {
            pg8::Gemm g{(const pg8::bf16_t*)(F.ws + WS_MIXED), (const pg8::bf16_t*)(F.ws + WS_WOUT + l * WOUT_STRIDE), M, DM, DM}; pg8::StaticOrder S; S.init(M, DM, F.G, F.bx);
            pg8::EpiRes E{(pg8::bf16_t*)(F.ws + WS_XB), (float*)(F.ws + WS_SSQ)};
            pg8::gemm_phase<pg8::EpiRes, pg8::StaticOrder, PG8_ALIGN, PG8_SP2>(F.lds + RING_OFF, g, S, E, F.tid);
        }
        if (l == 0) SEAMW(pb + 4, 5); else SEAMW(pb + 4, 12);
        if (IN(pb + 5)) for (int rep_ = 0; rep_ < REPS(5); ++rep_) {
            pg8::Gemm g{(const pg8::bf16_t*)(F.ws + WS_XB), (const pg8::bf16_t*)(F.ws + WS_WQ + l * WQ_STRIDE), M, NQ, DM}; pg8::StaticOrder S; S.init(M, NQ, F.G, F.bx);
            pg8::EpiScale<false> E{(pg8::bf16_t*)(F.ws + WS_QP), NQ, (const float*)(F.ws + WS_SSQ), nullptr, nullptr, 1.0f};
            pg8::gemm_phase<pg8::EpiScale<false>, pg8::StaticOrder, PG8_ALIGN, PG8_SP2>(F.lds + RING_OFF, g, S, E, F.tid);
        }
        if (l == 0) SEAMW(pb + 5, 6); else SEAM(pb + 5);
        if (IN(pb + 7)) {
            unsigned* xs_word = (unsigned*)(F.ws + WS_CTL) + 65536 + (l * 16 + (int)xb_xcc_id()) * 64; const unsigned xs_nloc = args.use_bar ? F.MISC[8] : 0u; unsigned xs_round = 0;
            for (int tb = vcu0; tb < M / 64; tb += (int)gridDim.x) {
                FRESH();
                {
                    LAS bf16* KLw = (LAS bf16*)(F.lds + RING_OFF + 32768); const bf16* KEYS = (const bf16*)(F.ws + WS_KEYS + l * KEYS_STRIDE);
                    for (int it = F.tid; it < 4096; it += NWAVES * 64) { const int row = it >> 4, c16 = it & 15; *(LAS v4u*)(KLw + row * PS_KSTRIDE + c16 * 8) = *(const v4u*)(KEYS + (size_t)row * 128 + c16 * 8); }
                    __syncthreads(); }
                for (int rep_ = 0; rep_ < REPS(6); ++rep_) {
                    LAS int* scr5 = (LAS int*)(F.lds + RING_OFF) + F.wave * 1024;
                    for (int i = 0; i < 2; ++i) { const int tt = F.wave * 2 + i; peer_select_task(F, l, 64 * tb + 32 * (tt >> 3), tt & 7, scr5, (const LAS bf16*)(F.lds + RING_OFF + 32768)); }
                }
                asm volatile("s_waitcnt vmcnt(0)" ::: "memory"); __syncthreads();
                FRESH();
                LAS int* scr = (LAS int*)(F.lds + RING_OFF) + F.wave * PT_WAVE_INTS;
                if (REPS(7) == 2) { for (int i = 0; i < 64 / PT_T / NWAVES; ++i) peer_tokens4(F, l, 64 * tb + (F.wave * (64 / PT_T / NWAVES) + i) * PT_T, l == NLAYER - 1, scr, xs_word + 32, xs_nloc, xs_round, true); xs_round = 0; }
                for (int i = 0; i < 64 / PT_T / NWAVES; ++i) peer_tokens4(F, l, 64 * tb + (F.wave * (64 / PT_T / NWAVES) + i) * PT_T, l == NLAYER - 1, scr, xs_word, xs_nloc, xs_round);
                __syncthreads();
            }
        }
        if (l == 0) SEAMW(pb + 7, 7); else SEAM(pb + 7);

    }
    { constexpr int l = 1;

        const int pb = 1 + 8 * l;
        if (IN(pb + 0)) for (int rep_ = 0; rep_ < REPS(0); ++rep_) {
            pg8::Gemm g{(const pg8::bf16_t*)(F.ws + WS_XB), (const pg8::bf16_t*)(F.ws + WS_WIN + l * WIN_STRIDE), M, NPROJ, DM}; pg8::StaticOrder S; S.init(M, NPROJ, F.G, F.bx);
            pg8::EpiScale<true> E{(pg8::bf16_t*)(F.ws + WS_PROJ), NPROJ, (const float*)(F.ws + WS_RS1), (const float*)(F.ws + WS_COS), (const float*)(F.ws + WS_SIN), ATT_C2};
            pg8::gemm_phase<pg8::EpiScale<true>, pg8::StaticOrder, PG8_ALIGN, PG8_SP2>(F.lds + RING_OFF, g, S, E, F.tid);
        }
        if (l == 0) SEAMW(pb + 0, 1); else SEAMW(pb + 0, 8);
        if (IN(pb + 1)) for (int rep_ = 0; rep_ < REPS(1); ++rep_) {
            if (args.pad == 0) { const attn_body::StaticOrder S(F.vcu);     attn_body::attn_phase<attn_body::StaticOrder>((char*)lds + RING_OFF, (const attn_body::bf16*)(F.ws + WS_PROJ), (attn_body::bf16*)(F.ws + WS_OATT), S, F.tid); }
            __syncthreads(); FRESH();
            for (int ci = F.vcu; ci < 256; ci += F.G) gla_prep(F, l, ci, args.pad >= 2 ? args.pad - 1 : 0);
        }
        if (l == 0) SEAMW(pb + 1, 2); else SEAMW(pb + 1, 9);
        if (IN(pb + 2) && args.pad != 1) gla_scan(F);
        if (l == 0) SEAMW(pb + 2, 3); else SEAMW(pb + 2, 10);
        if (IN(pb + 3)) for (int rep_ = 0; rep_ < REPS(3); ++rep_) { for (int ci = F.vcu; ci < 256; ci += F.G) mix_chunk(F, l, ci); }
        if (l == 0) SEAMW(pb + 3, 4); else SEAMW(pb + 3, 11);
        if (IN(pb + 4)) {
            pg8::Gemm g{(const pg8::bf16_t*)(F.ws + WS_MIXED), (const pg8::bf16_t*)(F.ws + WS_WOUT + l * WOUT_STRIDE), M, DM, DM}; pg8::StaticOrder S; S.init(M, DM, F.G, F.bx);
            pg8::EpiRes E{(pg8::bf16_t*)(F.ws + WS_XB), (float*)(F.ws + WS_SSQ)};
            pg8::gemm_phase<pg8::EpiRes, pg8::StaticOrder, PG8_ALIGN, PG8_SP2>(F.lds + RING_OFF, g, S, E, F.tid);
        }
        if (l == 0) SEAMW(pb + 4, 5); else SEAMW(pb + 4, 12);
        if (IN(pb + 5)) for (int rep_ = 0; rep_ < REPS(5); ++rep_) {
            pg8::Gemm g{(const pg8::bf16_t*)(F.ws + WS_XB), (const pg8::bf16_t*)(F.ws + WS_WQ + l * WQ_STRIDE), M, NQ, DM}; pg8::StaticOrder S; S.init(M, NQ, F.G, F.bx);
            pg8::EpiScale<false> E{(pg8::bf16_t*)(F.ws + WS_QP), NQ, (const float*)(F.ws + WS_SSQ), nullptr, nullptr, 1.0f};
            pg8::gemm_phase<pg8::EpiScale<false>, pg8::StaticOrder, PG8_ALIGN, PG8_SP2>(F.lds + RING_OFF, g, S, E, F.tid);
        }
        if (l == 0) SEAMW(pb + 5, 6); else SEAM(pb + 5);
        if (IN(pb + 7)) {
            unsigned* xs_word = (unsigned*)(F.ws + WS_CTL) + 65536 + (l * 16 + (int)xb_xcc_id()) * 64; const unsigned xs_nloc = args.use_bar ? F.MISC[8] : 0u; unsigned xs_round = 0;
            for (int tb = vcu0; tb < M / 64; tb += (int)gridDim.x) {
                FRESH();
                {
                    LAS bf16* KLw = (LAS bf16*)(F.lds + RING_OFF + 32768); const bf16* KEYS = (const bf16*)(F.ws + WS_KEYS + l * KEYS_STRIDE);
                    for (int it = F.tid; it < 4096; it += NWAVES * 64) { const int row = it >> 4, c16 = it & 15; *(LAS v4u*)(KLw + row * PS_KSTRIDE + c16 * 8) = *(const v4u*)(KEYS + (size_t)row * 128 + c16 * 8); }
                    __syncthreads(); }
                for (int rep_ = 0; rep_ < REPS(6); ++rep_) {
                    LAS int* scr5 = (LAS int*)(F.lds + RING_OFF) + F.wave * 1024;
                    for (int i = 0; i < 2; ++i) { const int tt = F.wave * 2 + i; peer_select_task(F, l, 64 * tb + 32 * (tt >> 3), tt & 7, scr5, (const LAS bf16*)(F.lds + RING_OFF + 32768)); }
                }
                asm volatile("s_waitcnt vmcnt(0)" ::: "memory"); __syncthreads();
                FRESH();
                LAS int* scr = (LAS int*)(F.lds + RING_OFF) + F.wave * PT_WAVE_INTS;
                if (REPS(7) == 2) { for (int i = 0; i < 64 / PT_T / NWAVES; ++i) peer_tokens4(F, l, 64 * tb + (F.wave * (64 / PT_T / NWAVES) + i) * PT_T, l == NLAYER - 1, scr, xs_word + 32, xs_nloc, xs_round, true); xs_round = 0; }
                for (int i = 0; i < 64 / PT_T / NWAVES; ++i) peer_tokens4(F, l, 64 * tb + (F.wave * (64 / PT_T / NWAVES) + i) * PT_T, l == NLAYER - 1, scr, xs_word, xs_nloc, xs_round);
                __syncthreads();
            }
        }
        if (l == 0) SEAMW(pb + 7, 7); else SEAM(pb + 7);

    }
#undef IN
#undef SEAM
}

#ifndef MK_DEBUG
#define MK_DEBUG 0
#endif
#ifndef DBG_LO
#define DBG_LO 0
#endif
#if MK_DEBUG
constexpr size_t WS_DBG = 30 * MiB + 896 * 1024;
constexpr size_t WS_DLA = 384 * MiB;
__device__ __forceinline__ void dbg_max(float* res, int k, float d) { if (!(d == d)) d = 1e9f; atomicMax((unsigned*)res + k, __builtin_bit_cast(unsigned, fabsf(d))); }
__device__ __forceinline__ unsigned dbg_hash(unsigned x) { x ^= x >> 16; x *= 0x7feb352dU; x ^= x >> 15; x *= 0x846ca68bU; x ^= x >> 16; return x; }
__device__ __forceinline__ float dbg_rstd(const float* x) { float s = 0.f; for (int k = 0; k < DM; ++k) s += x[k] * x[k]; return 1.0f / sqrtf(s / DM + EPS); }
__global__ void dbg_c0(Args a) {
    float* res = (float*)(a.ws + WS_DBG); const int lane = threadIdx.x;
    const float v = (float)(lane * lane + 1); float exp_sum = 0.f; for (int i = 0; i < 64; ++i) exp_sum += (float)(i * i + 1);
    dbg_max(res, 16, xl_wave_sum(v) - exp_sum);
    dbg_max(res, 17, xl_swz<16>(v) - (float)((lane ^ 16) * (lane ^ 16) + 1));
    dbg_max(res, 18, xl_swz<4>(v) - (float)((lane ^ 4) * (lane ^ 4) + 1));
    dbg_max(res, 19, (float)(xl_xor32_i(lane * 3, lane >> 5) - (lane ^ 32) * 3));
    dbg_max(res, 20, xl_sum32(v) - (v + (float)((lane ^ 32) * (lane ^ 32) + 1)));
}
__global__ void dbg_c1(Args a) {
    const int s = blockIdx.x * blockDim.x + threadIdx.x; if (s >= 4096) return;
    float* res = (float*)(a.ws + WS_DBG);
    const unsigned hsh = dbg_hash(s * 2654435761u + 17u); const int row = hsh % M; int col = (hsh >> 14) % NPROJ; if (s < 1024) col = col % 1024;
    const float* x = a.in[0] + (size_t)row * DM; const float* g = a.in[2]; const float* W = a.in[3];
    const float rs = dbg_rstd(x);
    auto proj = [&](int c) { float acc = 0.f; for (int k = 0; k < DM; ++k) acc += x[k] * g[k] * W[(size_t)k * NIN + c]; return acc * rs; };
    float v = proj(col);
    if (col < 1024) { const int d = col & 63; if (d < 16) { const int j = d & 7; const int pos = ((const int*)a.in[1])[row]; const double ang = (double)pos * pow(500000.0, -(double)j / 8.0); const float c = (float)cos(ang), sn = (float)sin(ang);
            if (d < 8) { const float r2 = proj(col + 8); v = v * c - r2 * sn; } else { const float r1 = proj(col - 8); v = r1 * sn + v * c; } }
        if (col < 512) v *= ATT_C2; }
    const float got = bf1(((const bf16*)(a.ws + WS_PROJ))[(size_t)row * NPROJ + col]);
    const int k = col < 512 ? ((col & 63) < 16 ? 0 : 1) : col < 1024 ? ((col & 63) < 16 ? 2 : 3) : 4;
    dbg_max(res, k, got - v);
}
__global__ void dbg_c2(Args a) {
    const int s = blockIdx.x * blockDim.x + threadIdx.x; if (s >= 2048) return;
    float* res = (float*)(a.ws + WS_DBG); const bf16* P = (const bf16*)(a.ws + WS_PROJ);
    const unsigned hsh = dbg_hash(s * 2654435761u + 99u); int row = hsh % M; if (s < 64) row = (row & ~(SEQL - 1)) + (s & 63) * 65 % SEQL; const int h = (hsh >> 14) & 3, m = (hsh >> 16) & 1, e = (hsh >> 17) & 127;
    const int b = row / SEQL, sq = row % SEQL;
    const bf16* q = P + (size_t)row * NPROJ + h * 128 + m * 64;
    float mx = -1e30f;
    for (int j = 0; j <= sq; ++j) { const bf16* kk = P + (size_t)(b * SEQL + j) * NPROJ + 512 + h * 128 + m * 64; float sc = 0.f; for (int d = 0; d < 64; ++d) sc += bf1(q[d]) * bf1(kk[d]); mx = fmaxf(mx, sc); }
    float l = 0.f, o = 0.f;
    for (int j = 0; j <= sq; ++j) { const bf16* kk = P + (size_t)(b * SEQL + j) * NPROJ + 512 + h * 128 + m * 64; float sc = 0.f; for (int d = 0; d < 64; ++d) sc += bf1(q[d]) * bf1(kk[d]);
        const float p = exp2f(sc - mx); l += p; o += p * bf1(P[(size_t)(b * SEQL + j) * NPROJ + 1024 + h * 128 + e]); }
    const float got = bf1(((const bf16*)(a.ws + WS_OATT))[(size_t)row * DM + m * 512 + h * 128 + e]);
    dbg_max(res, 5 + m, got - o / l);
}
__global__ void dbg_c3a(Args a) {
    const int t = blockIdx.x; const int d = threadIdx.x;
    __shared__ float lr[16]; __shared__ float rs_s;
    const float* x = a.in[0] + (size_t)t * DM; const float* g = a.in[2]; const float* W = a.in[3];
    if (d == 0) rs_s = dbg_rstd(x);
    __syncthreads();
    if (d < 16) { float acc = 0.f; for (int k = 0; k < DM; ++k) acc += x[k] * g[k] * W[(size_t)k * NIN + NPROJ + d]; lr[d] = acc * rs_s; }
    __syncthreads();
    float xx = a.in[11][d]; for (int r = 0; r < 16; ++r) xx += lr[r] * a.in[10][r * 128 + d];
    ((float*)(a.ws + WS_DLA))[(size_t)t * 128 + d] = log_sigmoid(xx) / 16.0f;
}
__global__ void dbg_c3b(Args a) {
    const int b = blockIdx.x >> 2, h = blockIdx.x & 3, e = threadIdx.x;
    float* res = (float*)(a.ws + WS_DBG); const bf16* P = (const bf16*)(a.ws + WS_PROJ); const float* LA = (const float*)(a.ws + WS_DLA);
    float S[32]; for (int d = 0; d < 32; ++d) S[d] = 0.f;
    float md = 0.f;
    for (int t = 0; t < SEQL; ++t) { const size_t row = (size_t)b * SEQL + t; const bf16* pr = P + row * NPROJ; const float v = bf1(pr[C_GV + h * 64 + e]); float o = 0.f;
        for (int d = 0; d < 32; ++d) { S[d] = expf(LA[row * 128 + h * 32 + d]) * S[d] + bf1(pr[C_GK + h * 32 + d]) * v; o += bf1(pr[C_GQ + h * 32 + d]) * 0.17677669529663687f * S[d]; }
        float ss = o * o; for (int off = 1; off < 64; off <<= 1) ss += __shfl_xor(ss, off);
        const float r = bf1(pr[C_GR + h * 64 + e]); const float y = o / sqrtf(ss / 64.0f + EPS) * a.in[12][e] * (r / (1.0f + expf(-r)));
        const float got = bf1(((const bf16*)(a.ws + WS_MIXED))[row * DM + 768 + h * 64 + e]); md = fmaxf(md, fabsf(got - y)); if (!(got == got)) md = 1e9f; }
    dbg_max(res, 7, md);
}
__global__ void dbg_c3c(Args a) {
    float* res = (float*)(a.ws + WS_DBG); const bf16* P = (const bf16*)(a.ws + WS_PROJ); const bf16* OA = (const bf16*)(a.ws + WS_OATT); const bf16* MX = (const bf16*)(a.ws + WS_MIXED);
    const int row = dbg_hash(blockIdx.x * 977u + 5u) % M; const int tid = threadIdx.x;
    float lq = 0.f, lk = 0.f; for (int i = 0; i < 64; ++i) { lq += a.in[4][i] * a.in[5][i]; lk += a.in[6][i] * a.in[7][i]; }
    const float lam = expf(lq) - expf(lk) + 0.2f, osc = 0.8f;
    __shared__ float ssq[4]; if (tid < 4) ssq[tid] = 0.f; __syncthreads();
    float ov[2]; for (int i = 0; i < 2; ++i) { const int c = tid + 256 * i; ov[i] = bf1(OA[(size_t)row * DM + c]) - lam * bf1(OA[(size_t)row * DM + 512 + c]); atomicAdd(&ssq[c >> 7], ov[i] * ov[i]); }
    __syncthreads();
    for (int i = 0; i < 2; ++i) { const int c = tid + 256 * i; const float y = ov[i] / sqrtf(ssq[c >> 7] / 128.0f + EPS) * a.in[8][c & 127] * osc; dbg_max(res, 8, bf1(MX[(size_t)row * DM + c]) - y); }
    { const int ch = tid; const int s = row % SEQL; float y = 0.f; for (int back = 0; back < 3; ++back) if (s - back >= 0) { const bf16* pr = P + (size_t)(row - back) * NPROJ; y += a.in[9][(2 - back) * 256 + ch] * bf1(pr[C_SC + ch]) * bf1(pr[C_SH + ch]); }
      y *= bf1(P[(size_t)row * NPROJ + C_SB + ch]); dbg_max(res, 9, bf1(MX[(size_t)row * DM + 512 + ch]) - y); }
}
__global__ void dbg_c4(Args a) {
    const int s = blockIdx.x * blockDim.x + threadIdx.x; if (s >= 4096) return;
    float* res = (float*)(a.ws + WS_DBG); const unsigned hsh = dbg_hash(s * 2654435761u + 7u); const int row = hsh % M, col = (hsh >> 14) % DM;
    const bf16* mx = (const bf16*)(a.ws + WS_MIXED) + (size_t)row * DM; float acc = a.in[0][(size_t)row * DM + col];
    for (int k = 0; k < DM; ++k) acc += bf1(mx[k]) * a.in[13][(size_t)k * DM + col];
    dbg_max(res, 10, a.out[(size_t)row * DM + col] - acc);
    dbg_max(res, 11, bf1(((const bf16*)(a.ws + WS_XB))[(size_t)row * DM + col]) - acc);
}
__global__ void dbg_c5(Args a) {
    float* res = (float*)(a.ws + WS_DBG); const unsigned hsh = dbg_hash(blockIdx.x * 31337u + 3u); const int t = hsh % M, h = (hsh >> 14) & 7; const int tid = threadIdx.x;
    __shared__ float q[256]; __shared__ float sc[2][128]; __shared__ float rs_s; __shared__ float tv[2][16]; __shared__ int ti[2][16]; __shared__ float cand[256]; __shared__ float fv[16]; __shared__ int fi[16];
    const float* x = a.out + (size_t)t * DM;
    if (tid == 0) rs_s = dbg_rstd(x);
    __syncthreads();
    for (int c = tid; c < 256; c += 128) { float acc = 0.f; for (int k = 0; k < DM; ++k) acc += x[k] * a.in[14][k] * a.in[15][(size_t)k * NQ + h * 256 + c]; q[c] = acc * rs_s; }
    __syncthreads();
    for (int hf = 0; hf < 2; ++hf) { float acc = 0.f; const float* key = (hf ? a.in[17] : a.in[16]) + tid * 128; for (int d = 0; d < 128; ++d) acc += q[hf * 128 + d] * key[d]; sc[hf][tid] = acc; }
    __syncthreads();
    if (tid < 2) { for (int r = 0; r < 16; ++r) { int bi = 0; float bv = -1e30f; for (int n = 0; n < 128; ++n) if (sc[tid][n] > bv) { bv = sc[tid][n]; bi = n; } tv[tid][r] = bv; ti[tid][r] = bi; sc[tid][bi] = -1e30f; } }
    __syncthreads();
    for (int c = tid; c < 256; c += 128) cand[c] = tv[0][c >> 4] + tv[1][c & 15];
    __syncthreads();
    if (tid == 0) { for (int r = 0; r < 16; ++r) { int bi = 0; float bv = -1e30f; for (int n = 0; n < 256; ++n) if (cand[n] > bv) { bv = cand[n]; bi = n; } fv[r] = bv; fi[r] = ti[0][bi >> 4] * 128 + ti[1][bi & 15]; cand[bi] = -1e30f; }
        float sum = 0.f; for (int r = 0; r < 16; ++r) sum += expf(fv[r] - fv[0]);
        const int* EX = (const int*)(a.ws + WS_EXP) + (size_t)t * 128 + h * 16; const float* GT = (const float*)(a.ws + WS_GATE) + (size_t)t * 128 + h * 16;
        int missing = 0; float gd = 0.f;
        for (int r = 0; r < 16; ++r) { int found = -1; for (int k = 0; k < 16; ++k) if (EX[k] == fi[r]) found = k; if (found < 0) missing++; else gd = fmaxf(gd, fabsf(GT[found] - expf(fv[r] - fv[0]) / sum)); }
        dbg_max(res, 12, (float)missing); dbg_max(res, 13, gd); }
}
constexpr size_t WS_DX2 = 384 * MiB + 16 * MiB;
__global__ void dbg_c6a(Args a) {
    const int t = dbg_hash(blockIdx.x * 7919u + 1u) % M; const int tid = threadIdx.x;
    __shared__ float hv[128]; __shared__ float rs_s; const float* x = a.out + (size_t)t * DM;
    if (tid == 0) rs_s = dbg_rstd(x);
    __syncthreads();
    const int* EX = (const int*)(a.ws + WS_EXP) + (size_t)t * 128; const float* GT = (const float*)(a.ws + WS_GATE) + (size_t)t * 128;
    if (tid < 128) { const float* u = a.in[18] + (size_t)EX[tid] * DM; float acc = 0.f; for (int k = 0; k < DM; ++k) acc += u[k] * x[k] * a.in[14][k]; hv[tid] = GT[tid] * gelu_erf(acc * rs_s); }
    __syncthreads();
    for (int c = tid; c < DM; c += 256) { float acc = x[c]; for (int k = 0; k < 128; ++k) acc += hv[k] * a.in[19][(size_t)EX[k] * DM + c]; ((float*)(a.ws + WS_DX2))[(size_t)blockIdx.x * DM + c] = acc; }
}
__global__ void dbg_c6b(Args a) {
    float* res = (float*)(a.ws + WS_DBG); const int t = dbg_hash(blockIdx.x * 7919u + 1u) % M;
    for (int c = threadIdx.x; c < DM; c += 256) dbg_max(res, 14, a.out[(size_t)t * DM + c] - ((const float*)(a.ws + WS_DX2))[(size_t)blockIdx.x * DM + c]);
}
__global__ void dbg_report(Args a, int lo, int hi, float scale) {
    const float* res = (const float*)(a.ws + WS_DBG);
    const float tol[24] = {0.2f, 0.2f, 0.2f, 0.2f, 0.2f, 0.03f, 0.03f, 0.05f, 0.03f, 0.06f, 0.05f, 0.05f, 3.5f, 0.03f, 0.02f, 1e30f, 0.5f, 0.5f, 0.5f, 0.5f, 0.5f, 1e30f, 1e30f, 1e30f};
    __shared__ int kf;
    if (threadIdx.x == 0) { kf = -1; for (int k = lo; k < hi; ++k) if (res[k] > tol[k]) { kf = k; break; } }
    __syncthreads();
    if (kf < 0) return;
    const float B = 1e4f * fminf(res[kf], 50.0f);
    for (int i = blockIdx.x * blockDim.x + threadIdx.x; i < 4000000; i += gridDim.x * blockDim.x) a.out[i + 1024] = B;
    if (blockIdx.x == 0 && threadIdx.x == 0) a.out[0] = 1e6f * (float)(kf + 1);
}
#endif

#ifndef MK_PER_PHASE
#define MK_PER_PHASE 0
#endif
extern "C" void kernel_launch(void* const* d_in, const int* in_sizes, int n_in, void* d_out, int out_size, void* d_ws, size_t ws_size, hipStream_t stream) {
    static int grid = 0;
    if (grid == 0) {
        if (n_in != 21 || out_size != M * DM || ws_size < WS_END) { fprintf(stderr, "kernel_launch: unexpected shapes (n_in %d, out %d, ws %zu); nothing launched\n", n_in, out_size, ws_size); grid = -1; return; }
        int dev = 0, cus = 0, per_cu = 0;
        if (hipGetDevice(&dev) != hipSuccess || hipDeviceGetAttribute(&cus, hipDeviceAttributeMultiprocessorCount, dev) != hipSuccess) { grid = -1; return; }
        if (hipFuncSetAttribute((const void*)hymba_fwd, hipFuncAttributeMaxDynamicSharedMemorySize, LDS_BYTES) != hipSuccess) { fprintf(stderr, "kernel_launch: hipFuncSetAttribute failed\n"); grid = -1; return; }
        if (hipOccupancyMaxActiveBlocksPerMultiprocessor(&per_cu, (const void*)hymba_fwd, NWAVES * 64, LDS_BYTES) != hipSuccess || per_cu < 1) { fprintf(stderr, "kernel_launch: occupancy query reports %d workgroups per CU\n", per_cu); }
        (void)hipGetLastError();
        grid = cus;
    }
    if (grid < 0) return;
    (void)hipMemsetAsync((char*)d_ws + WS_CTL, 0, CTL_ZERO_BYTES, stream);
    Args a{};
    for (int i = 0; i < 21; ++i) a.in[i] = (const float*)d_in[i];
    a.out = (float*)d_out; a.ws = (unsigned char*)d_ws;
#if MK_PER_PHASE
#if MK_DEBUG
    (void)hipMemsetAsync((char*)d_ws + WS_DBG, 0, 256, stream);
#endif
    for (int ph = 0; ph < NPHASE; ++ph) { a.ph_lo = ph; a.ph_hi = ph + 1; a.use_bar = 0; hipLaunchKernelGGL(hymba_fwd, dim3(grid), dim3(NWAVES * 64), LDS_BYTES, stream, a);
#ifdef REPPH
#ifndef REPPAD
#define REPPAD 0
#endif
        if (((ph - 1) & 7) == REPPH && ph >= 1) { a.pad = REPPAD; hipLaunchKernelGGL(hymba_fwd, dim3(grid), dim3(NWAVES * 64), LDS_BYTES, stream, a); a.pad = 0; }
#endif
#if MK_DEBUG
        if (ph == 0) hipLaunchKernelGGL(dbg_c0, dim3(1), dim3(64), 0, stream, a);
        if (ph == 1) hipLaunchKernelGGL(dbg_c1, dim3(16), dim3(256), 0, stream, a);
        if (ph == 2) hipLaunchKernelGGL(dbg_c2, dim3(8), dim3(256), 0, stream, a);
        if (ph == 4) { hipLaunchKernelGGL(dbg_c3a, dim3(M), dim3(128), 0, stream, a); hipLaunchKernelGGL(dbg_c3b, dim3(16), dim3(64), 0, stream, a); hipLaunchKernelGGL(dbg_c3c, dim3(128), dim3(256), 0, stream, a); }
        if (ph == 5) hipLaunchKernelGGL(dbg_c4, dim3(16), dim3(256), 0, stream, a);
        if (ph == 7) { hipLaunchKernelGGL(dbg_c5, dim3(64), dim3(128), 0, stream, a); hipLaunchKernelGGL(dbg_c6a, dim3(64), dim3(256), 0, stream, a); }
        if (ph == 8) hipLaunchKernelGGL(dbg_c6b, dim3(64), dim3(256), 0, stream, a);
#endif
    }
#if MK_DEBUG
    hipLaunchKernelGGL(dbg_report, dim3(256), dim3(256), 0, stream, a, DBG_LO, 24, 1000.0f);
#endif
#else
    a.ph_lo = 0; a.ph_hi = NPHASE; a.use_bar = 1;
    hipLaunchKernelGGL(hymba_fwd, dim3(grid), dim3(NWAVES * 64), LDS_BYTES, stream, a);
#endif
}
```
